# Optimizing an MI355X kernel written in HIP

```python
import math
import jax, jax.numpy as jnp
from jax import lax
import numpy as np

D_MODEL = 1024
BATCH = 4
SEQ = 8192
DEPTH = 4

D_MIX = D_MODEL
N_MIXERS = 4
D_GROUP = D_MIX // N_MIXERS
HG_HEADS = 4
HG_DK = D_GROUP // HG_HEADS
HG_CHUNK = 64
LB_FLOOR = 1e-30
CONV_WIDTH = 31
S5_CH = 16
S5_GROUPS = D_GROUP // S5_CH
S5_STATE = 64
S5_DT_MIN = 1e-3
S5_DT_MAX = 1e-1
ATT_HEADS = 4
ATT_DH = D_GROUP // ATT_HEADS
ATT_PATTERNS = ((128, 1), (512, 4), (2048, 16))
ATT_BLOCK = 128
REL_BUCKETS = 32
REL_MAX_DIST = 2048
NEG_BIG = -1e30
D_FF = 4 * D_MODEL
N_IN_SLICES = 10
D_IN = N_IN_SLICES * D_GROUP
EPS = 1e-6

kernel_name = "hybrid_hgrn2_conv_s5_dilated_attn"


def rms_norm(x, g):
    xf = x.astype(jnp.float32)
    y = xf * lax.rsqrt(jnp.mean(xf * xf, axis=-1, keepdims=True) + EPS)
    return (y * g.astype(jnp.float32)).astype(x.dtype)


def hgrn2_mixer(q, fz, iv, g, lb, norm_g):
    bsz, s, _ = q.shape
    f32 = jnp.float32
    lb = jnp.clip(lb.astype(f32), 0.0, 1.0 - 1e-6)
    fz = fz.astype(f32)
    log_f = jnp.logaddexp(jnp.log(jnp.maximum(lb, LB_FLOOR)), jnp.log1p(-lb) + jax.nn.log_sigmoid(fz))
    k = (1.0 - lb) * jax.nn.sigmoid(-fz)
    nc = s // HG_CHUNK

    def to_chunks(t):
        t = t.astype(f32).reshape(bsz, nc, HG_CHUNK, HG_HEADS, HG_DK)
        return t.transpose(1, 0, 3, 2, 4)

    causal = jnp.tril(jnp.ones((HG_CHUNK, HG_CHUNK), dtype=bool))

    def step(state, inp):
        qc, lfc, kc, vc = inp
        gcum = jnp.cumsum(lfc, axis=2)
        o_inter = jnp.einsum('bhtk,bhkv->bhtv', qc * jnp.exp(gcum), state)
        diff = gcum[:, :, :, None, :] - gcum[:, :, None, :, :]
        decay = jnp.exp(jnp.where(causal[:, :, None], diff, NEG_BIG))
        scores = jnp.einsum('bhtk,bhsk,bhtsk->bhts', qc, kc, decay)
        o_intra = jnp.einsum('bhts,bhsv->bhtv', scores, vc)
        g_last = gcum[:, :, -1:, :]
        state = (jnp.exp(g_last[:, :, 0, :])[..., None] * state
                 + jnp.einsum('bhsk,bhsv->bhkv', kc * jnp.exp(g_last - gcum), vc))
        return state, o_inter + o_intra

    s0 = jnp.zeros((bsz, HG_HEADS, HG_DK, HG_DK), f32)
    _, o = lax.scan(step, s0, (to_chunks(q), to_chunks(log_f), to_chunks(k), to_chunks(iv)))
    o = o.transpose(1, 0, 3, 2, 4).reshape(bsz, s, HG_HEADS, HG_DK)
    o = rms_norm(o, norm_g.reshape(HG_HEADS, HG_DK)).reshape(bsz, s, D_GROUP)
    return (o * jax.nn.silu(g.astype(f32))).astype(q.dtype)


def conformer_conv_mixer(val, gate, conv_w, conv_b, ln_g, ln_b):
    h = val * jax.nn.sigmoid(gate)
    h = lax.conv_general_dilated(h, conv_w[:, None, :], window_strides=(1,),
                                 padding=((CONV_WIDTH - 1, 0),),
                                 dimension_numbers=('NWC', 'WIO', 'NWC'),
                                 feature_group_count=D_GROUP) + conv_b
    hf = h.astype(jnp.float32)
    mu = jnp.mean(hf, axis=-1, keepdims=True)
    var = jnp.mean(jnp.square(hf - mu), axis=-1, keepdims=True)
    hf = (hf - mu) * lax.rsqrt(var + EPS) * ln_g.astype(jnp.float32) + ln_b.astype(jnp.float32)
    return jax.nn.silu(hf).astype(val.dtype)


def _complex_affine_combine(e1, e2):
    a1r, a1i, b1r, b1i = e1
    a2r, a2i, b2r, b2i = e2
    ar = a2r * a1r - a2i * a1i
    ai = a2r * a1i + a2i * a1r
    br = a2r * b1r - a2i * b1i + b2r
    bi = a2r * b1i + a2i * b1r + b2i
    return (ar, ai, br, bi)


def s5_mixer(u, lam_re, lam_im, b_re, b_im, c_re, c_im, d_skip, log_dt, w_glu):
    bsz, s, _ = u.shape
    f32 = jnp.float32
    uf = u.astype(f32)
    ug = uf.reshape(bsz, s, S5_GROUPS, S5_CH)
    dt = jnp.exp(log_dt.astype(f32))[:, None]
    lr = lam_re.astype(f32)
    li = lam_im.astype(f32)
    mag = jnp.exp(lr * dt)
    a_re = mag * jnp.cos(li * dt)
    a_im = mag * jnp.sin(li * dt)
    den = lr * lr + li * li
    coef_re = ((a_re - 1.0) * lr + a_im * li) / den
    coef_im = (a_im * lr - (a_re - 1.0) * li) / den
    br = b_re.astype(f32)
    bi = b_im.astype(f32)
    bbar_re = coef_re[..., None] * br - coef_im[..., None] * bi
    bbar_im = coef_re[..., None] * bi + coef_im[..., None] * br
    bu_re = jnp.einsum('bsgc,gpc->bsgp', ug, bbar_re)
    bu_im = jnp.einsum('bsgc,gpc->bsgp', ug, bbar_im)
    shape = bu_re.shape
    elems = (jnp.broadcast_to(a_re, shape), jnp.broadcast_to(a_im, shape), bu_re, bu_im)
    _, _, h_re, h_im = lax.associative_scan(_complex_affine_combine, elems, axis=1)
    y = (jnp.einsum('bsgp,gcp->bsgc', h_re, c_re.astype(f32))
         - jnp.einsum('bsgp,gcp->bsgc', h_im, c_im.astype(f32)))
    y = y.reshape(bsz, s, D_GROUP) + d_skip.astype(f32) * uf
    y = jax.nn.gelu(y)
    y = y * jax.nn.sigmoid(y @ w_glu.astype(f32))
    return y.astype(u.dtype)


def t5_bucket(dist):
    max_exact = REL_BUCKETS // 2
    is_small = dist < max_exact
    distf = jnp.maximum(dist, max_exact).astype(jnp.float32)
    large = max_exact + (jnp.log(distf / max_exact) / math.log(REL_MAX_DIST / max_exact)
                         * (REL_BUCKETS - max_exact)).astype(jnp.int32)
    large = jnp.minimum(large, REL_BUCKETS - 1)
    return jnp.where(is_small, dist, large)


def dilated_band_attention(q, k, v, rel_bias, window, dilation):
    bsz, nh, s, dh = q.shape
    f32 = jnp.float32
    span = window // dilation
    n_sub = s // dilation
    nb = -(-n_sub // ATT_BLOCK)
    n_pad = nb * ATT_BLOCK

    def strided_blocks(t):
        t = t.reshape(bsz, nh, n_sub, dilation, dh).transpose(0, 1, 3, 2, 4)
        t = jnp.pad(t, ((0, 0), (0, 0), (0, 0), (0, n_pad - n_sub), (0, 0)))
        return t.reshape(bsz, nh, dilation, nb, ATT_BLOCK, dh)

    def band(t):
        prev = jnp.pad(t, ((0, 0), (0, 0), (0, 0), (1, 0), (0, 0), (0, 0)))[:, :, :, :-1]
        return jnp.concatenate([prev, t], axis=4)

    qb = strided_blocks(q)
    kb = band(strided_blocks(k))
    vb = band(strided_blocks(v))
    i = jnp.arange(ATT_BLOCK)[:, None]
    j = jnp.arange(2 * ATT_BLOCK)[None, :]
    delta = i + ATT_BLOCK - j
    blk = jnp.arange(nb)[:, None, None]
    valid = (delta >= 0) & (delta <= span) & (blk * ATT_BLOCK + j - ATT_BLOCK >= 0)
    bucket = t5_bucket(jnp.maximum(delta, 0) * dilation)
    bias = jnp.transpose(rel_bias[bucket], (2, 0, 1)).astype(f32)
    logits = jnp.einsum('bhrnqd,bhrnkd->bhrnqk', qb, kb).astype(f32) + bias[:, None, None]
    logits = jnp.where(valid, logits, NEG_BIG)
    m = jnp.max(logits, axis=-1, keepdims=True)
    p = jnp.exp(logits - m)
    den = jnp.sum(p, axis=-1)
    o = jnp.einsum('bhrnqk,bhrnkd->bhrnqd', p, vb.astype(f32)) / den[..., None]
    lse = m[..., 0] + jnp.log(den)

    def unstride(t):
        t = t.reshape(bsz, nh, dilation, n_pad, *t.shape[5:])[:, :, :, :n_sub]
        t = jnp.moveaxis(t, 2, 3)
        return t.reshape(bsz, nh, s, *t.shape[4:])

    return unstride(o), unstride(lse)


def dilated_attention_mixer(q, k, v, q_g, k_g, rel_bias):
    bsz, s, _ = q.shape

    def heads(t):
        return t.reshape(bsz, s, ATT_HEADS, ATT_DH).transpose(0, 2, 1, 3)

    qh = rms_norm(heads(q), q_g) * (ATT_DH ** -0.5)
    kh = rms_norm(heads(k), k_g)
    vh = heads(v)
    outs = []
    lses = []
    for window, dilation in ATT_PATTERNS:
        o_p, lse_p = dilated_band_attention(qh, kh, vh, rel_bias, window, dilation)
        outs.append(o_p)
        lses.append(lse_p)
    w = jax.nn.softmax(jnp.stack(lses, axis=0), axis=0)
    o = jnp.einsum('pbhs,pbhsd->bhsd', w, jnp.stack(outs, axis=0))
    return o.transpose(0, 2, 1, 3).reshape(bsz, s, D_GROUP).astype(q.dtype)


def setup_inputs(seed: int = 0) -> dict:
    key = jax.random.key(seed)
    ks = jax.random.split(key, 26)
    f32 = jnp.float32

    def nrm(k, shape, scale):
        return jax.random.normal(k, shape, f32) * scale

    out_scale = (2 * DEPTH) ** -0.5
    lam_im_base = math.pi * jnp.arange(S5_STATE, dtype=f32)
    return {
        "x": nrm(ks[0], (BATCH, SEQ, D_MODEL), 1.0),
        "norm_mix_g": 1.0 + nrm(ks[1], (DEPTH, D_MODEL), 0.02),
        "w_in": nrm(ks[2], (DEPTH, D_MODEL, D_IN), D_MODEL ** -0.5),
        "hgrn_lb_logits": nrm(ks[3], (DEPTH, D_GROUP), 0.1),
        "hgrn_norm_g": 1.0 + nrm(ks[4], (DEPTH, D_GROUP), 0.02),
        "conv_w": nrm(ks[5], (DEPTH, CONV_WIDTH, D_GROUP), CONV_WIDTH ** -0.5),
        "conv_b": nrm(ks[6], (DEPTH, D_GROUP), 0.02),
        "conv_ln_g": 1.0 + nrm(ks[7], (DEPTH, D_GROUP), 0.02),
        "conv_ln_b": nrm(ks[8], (DEPTH, D_GROUP), 0.02),
        "s5_lambda_re": -0.5 + nrm(ks[9], (DEPTH, S5_GROUPS, S5_STATE), 0.01),
        "s5_lambda_im": lam_im_base + nrm(ks[10], (DEPTH, S5_GROUPS, S5_STATE), 0.01),
        "s5_b_re": nrm(ks[11], (DEPTH, S5_GROUPS, S5_STATE, S5_CH), (2 * S5_CH) ** -0.5),
        "s5_b_im": nrm(ks[12], (DEPTH, S5_GROUPS, S5_STATE, S5_CH), (2 * S5_CH) ** -0.5),
        "s5_c_re": nrm(ks[13], (DEPTH, S5_GROUPS, S5_CH, S5_STATE), S5_STATE ** -0.5),
        "s5_c_im": nrm(ks[14], (DEPTH, S5_GROUPS, S5_CH, S5_STATE), S5_STATE ** -0.5),
        "s5_d": nrm(ks[15], (DEPTH, D_GROUP), 0.5),
        "s5_log_dt": jax.random.uniform(ks[16], (DEPTH, S5_GROUPS), f32,
                                        math.log(S5_DT_MIN), math.log(S5_DT_MAX)),
        "s5_w_glu": nrm(ks[17], (DEPTH, D_GROUP, D_GROUP), D_GROUP ** -0.5),
        "attn_q_norm_g": 1.0 + nrm(ks[18], (DEPTH, ATT_DH), 0.02),
        "attn_k_norm_g": 1.0 + nrm(ks[19], (DEPTH, ATT_DH), 0.02),
        "rel_bias": nrm(ks[20], (REL_BUCKETS, ATT_HEADS), 0.5),
        "mix_out_norm_g": 1.0 + nrm(ks[21], (DEPTH, D_MIX), 0.02),
        "w_out": nrm(ks[22], (DEPTH, D_MIX, D_MODEL), D_MIX ** -0.5 * out_scale),
        "norm_mlp_g": 1.0 + nrm(ks[23], (DEPTH, D_MODEL), 0.02),
        "w_mlp_up": nrm(ks[24], (DEPTH, D_MODEL, D_FF), D_MODEL ** -0.5),
        "w_mlp_down": nrm(ks[25], (DEPTH, D_FF, D_MODEL), D_FF ** -0.5 * out_scale),
    }


def reference(x, norm_mix_g, w_in, hgrn_lb_logits, hgrn_norm_g, conv_w, conv_b, conv_ln_g,
              conv_ln_b, s5_lambda_re, s5_lambda_im, s5_b_re, s5_b_im, s5_c_re, s5_c_im, s5_d,
              s5_log_dt, s5_w_glu, attn_q_norm_g, attn_k_norm_g, rel_bias, mix_out_norm_g, w_out,
              norm_mlp_g, w_mlp_up, w_mlp_down):
    bsz, s, _ = x.shape
    lb_sm = jax.nn.softmax(hgrn_lb_logits.astype(jnp.float32), axis=0)
    lb_all = jnp.maximum(jnp.cumsum(lb_sm, axis=0) - lb_sm[0], 0.0)
    for l in range(DEPTH):
        h = rms_norm(x, norm_mix_g[l])
        z = h @ w_in[l]
        (a_q, a_f, a_i, a_g, b_val, b_gate, c_u, d_q, d_k, d_v) = jnp.split(z, N_IN_SLICES, axis=-1)
        y_a = hgrn2_mixer(a_q, a_f, a_i, a_g, lb_all[l], hgrn_norm_g[l])
        y_b = conformer_conv_mixer(b_val, b_gate, conv_w[l], conv_b[l], conv_ln_g[l], conv_ln_b[l])
        y_c = s5_mixer(c_u, s5_lambda_re[l], s5_lambda_im[l], s5_b_re[l], s5_b_im[l],
                       s5_c_re[l], s5_c_im[l], s5_d[l], s5_log_dt[l], s5_w_glu[l])
        y_d = dilated_attention_mixer(d_q, d_k, d_v, attn_q_norm_g[l], attn_k_norm_g[l], rel_bias)
        y = jnp.stack([y_a, y_b, y_c, y_d], axis=2)
        y = rms_norm(y, mix_out_norm_g[l].reshape(N_MIXERS, D_GROUP)).reshape(bsz, s, D_MIX)
        x = x + y @ w_out[l]
        hm = rms_norm(x, norm_mlp_g[l]) @ w_mlp_up[l]
        x = x + jnp.square(jax.nn.relu(hm)) @ w_mlp_down[l]
    return x
```

```cpp
#include <hip/hip_runtime.h>
#include <hip/hip_cooperative_groups.h>
#include <cstdio>
#include <cstdint>
namespace cg = cooperative_groups;

#define DI __device__ __forceinline__
#define LAS __attribute__((address_space(3)))
typedef unsigned short bf16_t;
typedef short bf16x8 __attribute__((ext_vector_type(8)));
typedef short s16x4 __attribute__((ext_vector_type(4)));
typedef float f32x4 __attribute__((ext_vector_type(4)));
typedef float f32x16 __attribute__((ext_vector_type(16)));
typedef unsigned u32x4 __attribute__((ext_vector_type(4)));
typedef unsigned u32x2 __attribute__((ext_vector_type(2)));

constexpr int NB = 4, SEQ = 8192, T = NB * SEQ, D = 1024, DIN = 2560, FF = 4096, NL = 4;
constexpr int ZQ = 0, ZF = 256, ZI = 512, ZG = 768, ZBV = 1024, ZBG = 1280, ZCU = 1536, ZDQ = 1792, ZDK = 2048, ZDV = 2304;
constexpr int YA = 0, YB = 256, YC = 512, YD = 768;
constexpr int ZOD = ZBG;
constexpr float EPS = 1e-6f;
constexpr size_t MiB = 1u << 20;
constexpr size_t WS_WIN = 0, WS_WOUT = 20 * MiB, WS_WUP = 28 * MiB, WS_WDN = 60 * MiB, WS_WGLU = 92 * MiB;
constexpr size_t WS_LB = 93 * MiB;
constexpr size_t WS_BIAS = WS_LB + 4096;
constexpr size_t WS_SSQ = WS_LB + 65536;
constexpr size_t WS_LSE = WS_SSQ + 8 * (size_t)T * 4;
constexpr size_t WS_DEC = WS_LSE + (size_t)T * 16;
constexpr size_t WS_LSE1 = WS_DEC + 2048 * 64 * 4;
constexpr size_t WS_S5K = 96 * MiB;
constexpr size_t WS_S5WS = 98 * MiB;
constexpr size_t WS_S5WC = 114 * MiB;
constexpr size_t WS_XB = 130 * MiB;
constexpr size_t WS_S5H = 194 * MiB;
constexpr size_t WS_HM = 198 * MiB;
constexpr size_t WS_Z = 198 * MiB;
constexpr size_t WS_YCAT = 358 * MiB;
constexpr size_t WS_SL = 422 * MiB, WS_SL2 = 438 * MiB;
constexpr size_t WS_S5H2 = 454 * MiB;
constexpr size_t WS_O0 = 458 * MiB, WS_O1 = 474 * MiB;
constexpr size_t WS_YPRE = 490 * MiB;
constexpr size_t WS_SSQP = 506 * MiB;
constexpr size_t WS_END = 510 * MiB;
static_assert(WS_LSE1 + (size_t)T * 16 <= WS_S5K, "misc region");

constexpr int LDS_BYTES = 147456;

DI unsigned f2bf(float f) { unsigned u = __builtin_bit_cast(unsigned, f); return (u + 0x7fffu + ((u >> 16) & 1u)) >> 16; }
DI unsigned pk2(float lo, float hi) { return f2bf(lo) | (f2bf(hi) << 16); }
DI float bf2f(bf16_t v) { return __builtin_bit_cast(float, (unsigned)v << 16); }
DI float bflo(unsigned w) { return __builtin_bit_cast(float, w << 16); }
DI float bfhi(unsigned w) { return __builtin_bit_cast(float, w & 0xffff0000u); }
DI float sigmoidf_(float x) { return 1.f / (1.f + __expf(-x)); }
DI float wave_sum(float v) {
#pragma unroll
    for (int o = 1; o < 64; o <<= 1) v += __shfl_xor(v, o);
    return v;
}
DI float half_sum(float v) {
#pragma unroll
    for (int o = 1; o < 32; o <<= 1) v += __shfl_xor(v, o);
    return v;
}
#define LDS_WAIT() asm volatile("s_waitcnt lgkmcnt(0)" ::: "memory")
DI int crow(int reg, int h) { return (reg & 3) + 8 * (reg >> 2) + 4 * h; }

template <int K>
DI f32x16 mma_lds(const LAS bf16_t* A, int lda, const LAS bf16_t* B, int ldb, f32x16 acc, int lane) {
    const int r = lane & 31, h = lane >> 5;
    const LAS bf16_t* ap = A + r * lda + 8 * h; const LAS bf16_t* bp = B + r * ldb + 8 * h;
#pragma unroll
    for (int k0 = 0; k0 < K; k0 += 16) {
        const bf16x8 a = *(const LAS bf16x8*)(ap + k0); const bf16x8 b = *(const LAS bf16x8*)(bp + k0);
        acc = __builtin_amdgcn_mfma_f32_32x32x16_bf16(a, b, acc, 0, 0, 0);
    }
    return acc;
}
DI f32x16 zero16() { f32x16 z;
#pragma unroll
    for (int i = 0; i < 16; ++i) z[i] = 0.f;
    return z; }

namespace pg8 {
#define PG8_LAS __attribute__((address_space(3)))
constexpr int BM = 256, BK = 64, HALF = 128, HTB = HALF * BK * 2, STAGE_BYTES = 8 * HTB, NXCD = 8, WGM = 8;
__host__ __device__ __forceinline__ int lds_byte(int r, int c) { const int st = (r >> 4) * 2 + (c >> 5), rr = r & 15, cc = c & 31, ob = rr * 64 + cc * 2; return st * 1024 + (ob ^ (((ob >> 9) & 1) << 5)); }
__host__ __device__ __forceinline__ void stage_rc(int b, int& R, int& C) { const int st = b / 1024, sb = b % 1024, swz = sb ^ (((sb >> 9) & 1) << 5); R = (st >> 1) * 16 + swz / 64; C = (st & 1) * 32 + (swz % 64) / 2; }
__host__ __device__ __forceinline__ int perm32(int rho) { const int n = rho >> 4, i = rho & 15; return 8 * (i >> 2) + 4 * n + (i & 3); }
struct Unit { int pm, pn; };
struct Gemm { const bf16_t* A; const bf16_t* Bt; int M, N, K, lda; };
struct StaticOrder {
    int nM, nN, nwg, G, c;
    __host__ __device__ void init(int M, int N, int G_, int c_) { nM = M / BM; nN = N / BM; nwg = nM * nN; G = G_; c = c_; }
    __host__ __device__ bool next(int i, Unit& u) const {
        const long L = (long)i * G + c; if (L >= nwg) return false;
        int wgid = (int)L; { const int q = nwg / NXCD, r = nwg % NXCD, xcd = wgid % NXCD, off = wgid / NXCD; wgid = (xcd < r ? xcd * (q + 1) : r * (q + 1) + (xcd - r) * q) + off; }
        const int nig = WGM * nN, gid = wgid / nig, fm = gid * WGM, gsz = (nM - fm) < WGM ? (nM - fm) : WGM;
        u.pm = fm + ((wgid % nig) % gsz); u.pn = (wgid % nig) / gsz; return true;
    }
    __device__ __forceinline__ void a_ready(const Unit&) const {}
    __device__ __forceinline__ void done(const Unit&) const {}
};
struct EpiScale {
    static constexpr bool PERM = true, AFTER_DRAIN = false;
    bf16_t* O; int ldc; const float* ssq; int act;
    __device__ __forceinline__ void operator()(const f32x4 (&acc)[2][2][4][2], const Unit& u, int wr, int wc, int fr, int fq) const {
        const int row0 = u.pm * BM + wr * 64 + fr; const int col0 = u.pn * BM + wc * 32 + 8 * fq;
#pragma unroll
        for (int ai = 0; ai < 2; ++ai)
#pragma unroll
            for (int m = 0; m < 4; ++m) { const int r = row0 + ai * HALF + m * 16; const f32x4* sq = (const f32x4*)(ssq + (size_t)r * 16); const f32x4 q0 = sq[0], q1 = sq[1], q2 = sq[2], q3 = sq[3];
                const float tot = (((q0[0] + q0[1]) + (q0[2] + q0[3])) + ((q1[0] + q1[1]) + (q1[2] + q1[3]))) + (((q2[0] + q2[1]) + (q2[2] + q2[3])) + ((q3[0] + q3[1]) + (q3[2] + q3[3])));
                const float rs = rsqrtf(tot * (1.0f / 1024.0f) + EPS);
                bf16_t* rowp = O + (size_t)r * ldc + col0;
#pragma unroll
                for (int bj = 0; bj < 2; ++bj) { f32x4 v0 = acc[ai][bj][m][0] * rs, v1 = acc[ai][bj][m][1] * rs;
                    if (act) {
#pragma unroll
                        for (int e = 0; e < 4; ++e) { const float a = fmaxf(v0[e], 0.f), b = fmaxf(v1[e], 0.f); v0[e] = a * a; v1[e] = b * b; } }
                    u32x4 w; w.x = pk2(v0[0], v0[1]); w.y = pk2(v0[2], v0[3]); w.z = pk2(v1[0], v1[1]); w.w = pk2(v1[2], v1[3]);
                    *(u32x4*)(rowp + bj * HALF) = w; } }
    }
};
struct EpiRes {
    static constexpr bool PERM = false, AFTER_DRAIN = false;
    const float* base; float* out; bf16_t* xb; float* ssq_out;
    __device__ __forceinline__ void operator()(const f32x4 (&acc)[2][2][4][2], const Unit& u, int wr, int wc, int fr, int fq) const {
        const int col0 = u.pn * BM + wc * 32 + 4 * fq;
#pragma unroll
        for (int ai = 0; ai < 2; ++ai)
#pragma unroll
            for (int m = 0; m < 4; ++m) { const int r = u.pm * BM + ai * HALF + wr * 64 + m * 16 + fr; const size_t off = (size_t)r * D + col0; float s = 0.f;
#pragma unroll
                for (int bj = 0; bj < 2; ++bj)
#pragma unroll
                    for (int n = 0; n < 2; ++n) { const size_t o2 = off + bj * HALF + n * 16; const f32x4 o = *(const f32x4*)(base + o2) + acc[ai][bj][m][n];
                        *(f32x4*)(out + o2) = o; u32x2 w; w.x = pk2(o[0], o[1]); w.y = pk2(o[2], o[3]); *(u32x2*)(xb + o2) = w;
                        s += (o[0] * o[0] + o[1] * o[1]) + (o[2] * o[2] + o[3] * o[3]); }
                s += __shfl_xor(s, 16); s += __shfl_xor(s, 32);
                if (fq == 0 && ssq_out) ssq_out[(size_t)r * 16 + u.pn * 4 + wc] = s; }
    }
};
struct EpiGlu {
    static constexpr bool PERM = false, AFTER_DRAIN = true;
    const bf16_t* Ysrc; int lds_; bf16_t* Y;
    __device__ __forceinline__ void fused(f32x4 (&acc)[2][2][4][2], const Unit& u, int wr, int wc, int fr, int fq, PG8_LAS unsigned char* lds, int wid, int lane) const {
        PG8_LAS float* Pp = (PG8_LAS float*)lds;
        const int col0 = wc * 32 + 4 * fq;
#pragma unroll
        for (int ai = 0; ai < 2; ++ai)
#pragma unroll
            for (int m = 0; m < 4; ++m) { const int rl = ai * HALF + wr * 64 + m * 16 + fr; const size_t off = (size_t)(u.pm * BM + rl) * lds_ + col0; float s = 0.f;
#pragma unroll
                for (int bj = 0; bj < 2; ++bj)
#pragma unroll
                    for (int n = 0; n < 2; ++n) { const u32x2 w = *(const u32x2*)(Ysrc + off + bj * HALF + n * 16); f32x4 a = acc[ai][bj][m][n];
                        const float y0 = bflo(w.x), y1 = bfhi(w.x), y2 = bflo(w.y), y3 = bfhi(w.y);
                        a[0] = y0 * sigmoidf_(a[0]); a[1] = y1 * sigmoidf_(a[1]); a[2] = y2 * sigmoidf_(a[2]); a[3] = y3 * sigmoidf_(a[3]);
                        acc[ai][bj][m][n] = a; s += (a[0] * a[0] + a[1] * a[1]) + (a[2] * a[2] + a[3] * a[3]); }
                s += __shfl_xor(s, 16); s += __shfl_xor(s, 32);
                if (fq == 0) Pp[rl * 4 + wc] = s; }
        __syncthreads();
#pragma unroll
        for (int ai = 0; ai < 2; ++ai)
#pragma unroll
            for (int m = 0; m < 4; ++m) { const int rl = ai * HALF + wr * 64 + m * 16 + fr; const size_t off = (size_t)(u.pm * BM + rl) * D + col0;
                const float tot = (Pp[rl * 4 + 0] + Pp[rl * 4 + 1]) + (Pp[rl * 4 + 2] + Pp[rl * 4 + 3]); const float rs = rsqrtf(tot * (1.0f / 256.0f) + EPS);
#pragma unroll
                for (int bj = 0; bj < 2; ++bj)
#pragma unroll
                    for (int n = 0; n < 2; ++n) { const f32x4 a = acc[ai][bj][m][n] * rs; u32x2 w; w.x = pk2(a[0], a[1]); w.y = pk2(a[2], a[3]); *(u32x2*)(Y + off + bj * HALF + n * 16) = w; } }
    }
};

template <class Epi, class Sched, bool ALIGN_EPI = false, bool SP2 = false>
__device__ __forceinline__ void gemm_phase(PG8_LAS unsigned char* lds, const Gemm g, const Sched& S, const Epi& E) {
    int tid_o = threadIdx.x; asm volatile("" : "+v"(tid_o));
    const int tid = tid_o, wid = __builtin_amdgcn_readfirstlane(tid >> 6), lane = tid & 63, wr = wid >> 2, wc = wid & 3, fr = lane & 15, fq = lane >> 4;
    const int K = g.K, nt = K / BK;
    unsigned voffA[2], voffB[2];
#pragma unroll
    for (int i = 0; i < 2; ++i) { int R, C; stage_rc(tid * 16 + i * 8192, R, C); const int Rb = Epi::PERM ? ((R & ~31) + perm32(R & 31)) : R;
        voffA[i] = (unsigned)(R * g.lda + C) * 2u; voffB[i] = (unsigned)(Rb * K + C) * 2u; }
    const size_t kstep = (size_t)(BK * 2);
    const size_t hstepA = (size_t)HALF * g.lda * 2, hstepB = (size_t)HALF * K * 2;
    const size_t tstepA = 2 * hstepA, tstepB = 2 * hstepB;
    const unsigned ldsw = (unsigned)wid * 1024u;
    const int aoff = lds_byte(wr * 64 + fr, fq * 8), boff = lds_byte(wc * 32 + fr, fq * 8);
#define PG8_SA(b, h) (((b) * 2 + (h)) * HTB)
#define PG8_SB(b, h) ((4 + (b) * 2 + (h)) * HTB)
#define PG8_STAGE(bufoff, gbase, voff) do { _Pragma("unroll") for (int _i = 0; _i < 2; ++_i) \
        __builtin_amdgcn_global_load_lds((const unsigned*)((const char*)(gbase) + (voff)[_i]), (PG8_LAS unsigned*)(lds + (bufoff) + ldsw + _i * 8192), 16, 0, 0); } while (0)
#define PG8_LDA(dst, b, h) do { _Pragma("unroll") for (int m = 0; m < 4; ++m) _Pragma("unroll") for (int k = 0; k < 2; ++k) dst[m][k] = *(const PG8_LAS bf16x8*)(lds + PG8_SA(b, h) + aoff + m * 2048 + k * 1024); } while (0)
#define PG8_LDB(dst, b, h) do { _Pragma("unroll") for (int n = 0; n < 2; ++n) _Pragma("unroll") for (int k = 0; k < 2; ++k) dst[n][k] = *(const PG8_LAS bf16x8*)(lds + PG8_SB(b, h) + boff + n * 2048 + k * 1024); } while (0)
#define PG8_MMA(ai, bj, At, Bt) do { __builtin_amdgcn_s_setprio(1); _Pragma("unroll") for (int m = 0; m < 4; ++m) _Pragma("unroll") for (int n = 0; n < 2; ++n) _Pragma("unroll") for (int k = 0; k < 2; ++k) \
        acc[ai][bj][m][n] = __builtin_amdgcn_mfma_f32_16x16x32_bf16(Bt[n][k], At[m][k], acc[ai][bj][m][n], 0, 0, 0); __builtin_amdgcn_s_setprio(0); } while (0)
#define PG8_WAIT_V(n) asm volatile("s_waitcnt vmcnt(" #n ")" ::: "memory")
#define PG8_WAIT_L(n) asm volatile("s_waitcnt lgkmcnt(" #n ")" ::: "memory")
#define PG8_BAR __builtin_amdgcn_s_barrier()
#define PG8_SCHED __builtin_amdgcn_sched_barrier(0)
    Unit cur, nxt; int ui = 0;
    if (!S.next(0, cur)) return;
    f32x4 acc[2][2][4][2];
#pragma unroll
    for (int a = 0; a < 2; ++a)
#pragma unroll
        for (int b = 0; b < 2; ++b)
#pragma unroll
            for (int m = 0; m < 4; ++m)
#pragma unroll
                for (int n = 0; n < 2; ++n) acc[a][b][m][n] = (f32x4){0.f, 0.f, 0.f, 0.f};
    bf16x8 At[4][2], B0[2][2], B1[2][2];
    const char* cA = (const char*)g.A + (size_t)cur.pm * tstepA; const char* cB = (const char*)g.Bt + (size_t)cur.pn * tstepB;
    S.a_ready(cur);
    if constexpr (SP2) {
        PG8_STAGE(PG8_SB(0, 0), cB, voffB); PG8_STAGE(PG8_SB(0, 1), cB + hstepB, voffB); PG8_STAGE(PG8_SA(0, 0), cA, voffA); PG8_STAGE(PG8_SA(0, 1), cA + hstepA, voffA);
        if (wr == 1) PG8_BAR;
        PG8_WAIT_V(2); PG8_BAR;
        PG8_STAGE(PG8_SB(1, 0), cB + kstep, voffB); PG8_STAGE(PG8_SA(1, 0), cA + kstep, voffA); PG8_STAGE(PG8_SB(1, 1), cB + hstepB + kstep, voffB);
        PG8_WAIT_V(6); PG8_BAR;
    } else {
        PG8_STAGE(PG8_SB(0, 0), cB, voffB); PG8_STAGE(PG8_SA(0, 0), cA, voffA); PG8_STAGE(PG8_SB(0, 1), cB + hstepB, voffB); PG8_STAGE(PG8_SA(0, 1), cA + hstepA, voffA);
        if (wr == 1) PG8_BAR;
        PG8_WAIT_V(4); PG8_BAR;
        PG8_STAGE(PG8_SB(1, 0), cB + kstep, voffB); PG8_STAGE(PG8_SA(1, 0), cA + kstep, voffA); PG8_STAGE(PG8_SB(1, 1), cB + hstepB + kstep, voffB);
        PG8_WAIT_V(6); PG8_BAR;
    }
    for (;;) {
        const bool has_next = S.next(ui + 1, nxt);
        const char* nA = has_next ? (const char*)g.A + (size_t)nxt.pm * tstepA : cA; const char* nB = has_next ? (const char*)g.Bt + (size_t)nxt.pn * tstepB : cB;
        for (int t = 0; t < nt; t += 2) {
            const bool last = (t == nt - 2);
            const char* a1 = cA + (size_t)(t + 1) * kstep;
            const char* a2 = last ? nA : cA + (size_t)(t + 2) * kstep; const char* b2 = last ? nB : cB + (size_t)(t + 2) * kstep;
            const char* a3 = a2 + kstep; const char* b3 = b2 + kstep;
            if (last && has_next) S.a_ready(nxt);
            if constexpr (SP2) {
            PG8_LDB(B0, 0, 0); PG8_LDB(B1, 0, 1); PG8_SCHED; PG8_LDA(At, 0, 0); PG8_STAGE(PG8_SA(1, 1), a1 + hstepA, voffA);
            PG8_WAIT_V(8); PG8_WAIT_L(0); PG8_BAR; PG8_MMA(0, 0, At, B0); PG8_MMA(0, 1, At, B1); PG8_BAR; PG8_SCHED;
            PG8_LDA(At, 0, 1); PG8_STAGE(PG8_SB(0, 0), b2, voffB); PG8_STAGE(PG8_SB(0, 1), b2 + hstepB, voffB); PG8_STAGE(PG8_SA(0, 0), a2, voffA);
            PG8_WAIT_V(8); PG8_WAIT_L(0); PG8_BAR; PG8_MMA(1, 0, At, B0); PG8_MMA(1, 1, At, B1); PG8_BAR; PG8_SCHED;
            PG8_LDB(B0, 1, 0); PG8_LDB(B1, 1, 1); PG8_SCHED; PG8_LDA(At, 1, 0); PG8_STAGE(PG8_SA(0, 1), a2 + hstepA, voffA);
            PG8_WAIT_V(8); PG8_WAIT_L(0); PG8_BAR; PG8_MMA(0, 0, At, B0); PG8_MMA(0, 1, At, B1); PG8_BAR; PG8_SCHED;
            PG8_LDA(At, 1, 1); PG8_STAGE(PG8_SB(1, 0), b3, voffB); PG8_STAGE(PG8_SB(1, 1), b3 + hstepB, voffB); PG8_STAGE(PG8_SA(1, 0), a3, voffA);
            PG8_WAIT_V(8); PG8_WAIT_L(0); PG8_BAR; PG8_MMA(1, 0, At, B0); PG8_MMA(1, 1, At, B1); PG8_BAR; PG8_SCHED;
            } else {
            PG8_LDB(B0, 0, 0); PG8_SCHED; PG8_LDA(At, 0, 0); PG8_STAGE(PG8_SA(1, 1), a1 + hstepA, voffA);
            PG8_WAIT_L(8); PG8_BAR; PG8_WAIT_L(0); PG8_MMA(0, 0, At, B0); PG8_BAR; PG8_SCHED;
            PG8_LDB(B1, 0, 1); PG8_STAGE(PG8_SB(0, 0), b2, voffB);
            PG8_BAR; PG8_WAIT_L(0); PG8_MMA(0, 1, At, B1); PG8_BAR;
            PG8_LDA(At, 0, 1); PG8_STAGE(PG8_SA(0, 0), a2, voffA);
            PG8_BAR; PG8_WAIT_L(0); PG8_MMA(1, 0, At, B0); PG8_BAR; PG8_SCHED;
            PG8_STAGE(PG8_SB(0, 1), b2 + hstepB, voffB);
            PG8_WAIT_V(6); PG8_BAR; PG8_MMA(1, 1, At, B1); PG8_BAR;
            PG8_LDB(B0, 1, 0); PG8_SCHED; PG8_LDA(At, 1, 0); PG8_STAGE(PG8_SA(0, 1), a2 + hstepA, voffA);
            PG8_WAIT_L(8); PG8_BAR; PG8_WAIT_L(0); PG8_MMA(0, 0, At, B0); PG8_BAR; PG8_SCHED;
            PG8_LDB(B1, 1, 1); PG8_STAGE(PG8_SB(1, 0), b3, voffB);
            PG8_BAR; PG8_WAIT_L(0); PG8_MMA(0, 1, At, B1); PG8_BAR;
            PG8_LDA(At, 1, 1); PG8_STAGE(PG8_SA(1, 0), a3, voffA);
            PG8_BAR; PG8_WAIT_L(0); PG8_MMA(1, 0, At, B0); PG8_BAR; PG8_SCHED;
            PG8_STAGE(PG8_SB(1, 1), b3 + hstepB, voffB);
            PG8_WAIT_V(6); PG8_BAR; PG8_MMA(1, 1, At, B1); PG8_BAR;
            }
        }
        if constexpr (ALIGN_EPI) { if (wr == 0) PG8_BAR; }
        if constexpr (!Epi::AFTER_DRAIN) { E(acc, cur, wr, wc, fr, fq); S.done(cur); }
        if (!has_next) break;
#pragma unroll
        for (int a = 0; a < 2; ++a)
#pragma unroll
            for (int b = 0; b < 2; ++b)
#pragma unroll
                for (int m = 0; m < 4; ++m)
#pragma unroll
                    for (int n = 0; n < 2; ++n) acc[a][b][m][n] = (f32x4){0.f, 0.f, 0.f, 0.f};
        cur = nxt; cA = nA; cB = nB; ++ui;
        if constexpr (ALIGN_EPI) { if (wr == 1) PG8_BAR; }
    }
    PG8_WAIT_V(0);
    if constexpr (!ALIGN_EPI) { if (wr == 0) PG8_BAR; }
    PG8_BAR;
    if constexpr (Epi::AFTER_DRAIN) { E.fused(acc, cur, wr, wc, fr, fq, lds, wid, lane); S.done(cur); }
#undef PG8_SA
#undef PG8_SB
#undef PG8_STAGE
#undef PG8_LDA
#undef PG8_LDB
#undef PG8_MMA
#undef PG8_WAIT_V
#undef PG8_WAIT_L
#undef PG8_BAR
#undef PG8_SCHED
}
}

struct Params { const float* in[26]; float* out; unsigned char* ws; };
enum { I_X = 0, I_NMG, I_WIN, I_LBL, I_HNG, I_CW, I_CB, I_CLG, I_CLB, I_LRE, I_LIM, I_BRE, I_BIM, I_CRE, I_CIM, I_S5D, I_LDT, I_WGLU, I_QG, I_KG, I_RB, I_MONG, I_WOUT, I_NMLPG, I_WUP, I_WDN };

DI void p0_transpose_item(const float* W, int K, int N, bf16_t* WT, const float* gk, LAS float* scr, int item, int lane) {
    const int nblk = N / 32, kb = item / nblk, nb = item % nblk, k0 = 64 * kb, n0 = 32 * nb;
#pragma unroll 8
    for (int i = 0; i < 32; ++i) { const int kk = 2 * i + (lane >> 5); const float s = gk ? gk[k0 + kk] : 1.f; scr[kk * 33 + (lane & 31)] = W[(size_t)(k0 + kk) * N + n0 + (lane & 31)] * s; }
    LDS_WAIT();
    const int c = lane & 7;
#pragma unroll
    for (int j = 0; j < 4; ++j) { const int n = (lane >> 3) + 8 * j; const LAS float* s = scr + (8 * c) * 33 + n;
        u32x4 o; o.x = pk2(s[0 * 33], s[1 * 33]); o.y = pk2(s[2 * 33], s[3 * 33]); o.z = pk2(s[4 * 33], s[5 * 33]); o.w = pk2(s[6 * 33], s[7 * 33]);
        *(u32x4*)(WT + (size_t)(n0 + n) * K + k0 + 8 * c) = o; }
    LDS_WAIT();
}
DI void s5_params(const Params& p, int lg, int pp, float& lrdt, float& lidt, float& cr, float& ci) {
    const float dt = expf(p.in[I_LDT][lg]);
    const float lr = p.in[I_LRE][lg * 64 + pp], li = p.in[I_LIM][lg * 64 + pp];
    lrdt = lr * dt; lidt = li * dt;
    const float mag = expf(lrdt); const float ar = mag * cosf(lidt), ai = mag * sinf(lidt);
    const float den = lr * lr + li * li;
    cr = ((ar - 1.0f) * lr + ai * li) / den; ci = (ai * lr - (ar - 1.0f) * li) / den;
}
DI void s5_pow(float lrdt, float lidt, int n, float& er, float& ei) { const float m = expf((float)n * lrdt); const float a = (float)n * lidt; er = m * cosf(a); ei = m * sinf(a); }

DI void prologue(const Params& p, LAS unsigned char* lds, int G) {
    int tid_o = threadIdx.x; asm volatile("" : "+v"(tid_o));
    const int tid = tid_o, lane = tid & 63, wave = tid >> 6;
    const int gw = blockIdx.x * 8 + wave, NGW = G * 8;
    const int gt = blockIdx.x * 512 + tid, NGT = G * 512;
    unsigned char* ws = p.ws;
    LAS float* scr = (LAS float*)(lds + wave * 16384);
    {
        constexpr int I_IN = (D / 64) * (DIN / 32), I_OUT = (D / 64) * (D / 32), I_UP = (D / 64) * (FF / 32), I_DN = (FF / 64) * (D / 32), I_GL = (256 / 64) * (256 / 32);
        constexpr int PER_L = I_IN + I_OUT + I_UP + I_DN + I_GL;
        for (int it = gw; it < NL * PER_L; it += NGW) {
            const int l = it / PER_L; int r = it % PER_L;
            if (r < I_IN) { p0_transpose_item(p.in[I_WIN] + (size_t)l * D * DIN, D, DIN, (bf16_t*)(ws + WS_WIN) + (size_t)l * D * DIN, p.in[I_NMG] + l * D, scr, r, lane); continue; } r -= I_IN;
            if (r < I_OUT) { p0_transpose_item(p.in[I_WOUT] + (size_t)l * D * D, D, D, (bf16_t*)(ws + WS_WOUT) + (size_t)l * D * D, p.in[I_MONG] + l * D, scr, r, lane); continue; } r -= I_OUT;
            if (r < I_UP) { p0_transpose_item(p.in[I_WUP] + (size_t)l * D * FF, D, FF, (bf16_t*)(ws + WS_WUP) + (size_t)l * D * FF, p.in[I_NMLPG] + l * D, scr, r, lane); continue; } r -= I_UP;
            if (r < I_DN) { p0_transpose_item(p.in[I_WDN] + (size_t)l * D * FF, FF, D, (bf16_t*)(ws + WS_WDN) + (size_t)l * D * FF, nullptr, scr, r, lane); continue; } r -= I_DN;
            p0_transpose_item(p.in[I_WGLU] + (size_t)l * 65536, 256, 256, (bf16_t*)(ws + WS_WGLU) + (size_t)l * 65536, nullptr, scr, r, lane);
        }
    }
    {
        float* ssq0 = (float*)(ws + WS_SSQP); bf16_t* XB = (bf16_t*)(ws + WS_XB);
        for (int mb = gw * 16; mb < T; mb += NGW * 16) {
            float keep = 0.f;
#pragma unroll 1
            for (int i = 0; i < 16; ++i) { const int m = mb + i;
                const f32x4* xr = (const f32x4*)(p.in[I_X] + (size_t)m * D) + lane; f32x4 v[4]; float s = 0.f;
#pragma unroll
                for (int j = 0; j < 4; ++j) { v[j] = xr[64 * j]; s += (v[j][0] * v[j][0] + v[j][1] * v[j][1]) + (v[j][2] * v[j][2] + v[j][3] * v[j][3]); }
                s = wave_sum(s); if (lane == i) keep = s;
                u32x2* o8 = (u32x2*)(XB + (size_t)m * D) + lane;
#pragma unroll
                for (int j = 0; j < 4; ++j) { u32x2 w; w.x = pk2(v[j][0], v[j][1]); w.y = pk2(v[j][2], v[j][3]); o8[64 * j] = w; } }
#pragma unroll 1
            for (int i = 0; i < 16; ++i) { const float v = __shfl(keep, i); if (lane < 16) ssq0[(size_t)(mb + i) * 16 + lane] = lane == 0 ? v : 0.f; }
        }
    }
    {
        float* LB = (float*)(ws + WS_LB);
        for (int c = gt; c < 256; c += NGT) {
            const float a0 = p.in[I_LBL][c], a1 = p.in[I_LBL][256 + c], a2 = p.in[I_LBL][512 + c], a3 = p.in[I_LBL][768 + c];
            const float mx = fmaxf(fmaxf(a0, a1), fmaxf(a2, a3));
            const float e0 = expf(a0 - mx), e1 = expf(a1 - mx), e2 = expf(a2 - mx), e3 = expf(a3 - mx); const float inv = 1.f / (e0 + e1 + e2 + e3);
            const float s1 = e1 * inv, s2 = e2 * inv, s3 = e3 * inv; const float hi = 1.0f - 1e-6f;
            LB[c] = 0.f; LB[256 + c] = fminf(fmaxf(s1, 0.f), hi); LB[512 + c] = fminf(fmaxf(s1 + s2, 0.f), hi); LB[768 + c] = fminf(fmaxf(s1 + s2 + s3, 0.f), hi);
        }
        float* BT = (float*)(ws + WS_BIAS);
        for (int i = gt; i < 3 * 4 * 132; i += NGT) {
            const int pt = i / (4 * 132), hd = (i / 132) % 4, dl = i % 132; const int dil = pt == 0 ? 1 : (pt == 1 ? 4 : 16);
            float v = 0.f;
            if (dl <= 128) { const int dist = dl * dil; int bk;
                if (dist < 16) bk = dist; else { bk = 16 + (int)(logf((float)dist / 16.0f) / 4.852030263919617f * 16.0f); if (bk > 31) bk = 31; }
                v = p.in[I_RB][bk * 4 + hd]; }
            BT[i] = v;
        }
    }
    {
        bf16_t* KT = (bf16_t*)(ws + WS_S5K); bf16_t* WS_ = (bf16_t*)(ws + WS_S5WS); bf16_t* WC = (bf16_t*)(ws + WS_S5WC);
        LAS float* ebr = scr; LAS float* ebi = scr + 64 * 17;
        for (int it = gw; it < NL * 16 * 64; it += NGW) {
            const int lg = it >> 6, d = it & 63;
            float lrdt, lidt, cr, ci; s5_params(p, lg, lane, lrdt, lidt, cr, ci);
            float er, ei; s5_pow(lrdt, lidt, d, er, ei);
            const float fr_ = er * cr - ei * ci, fi_ = er * ci + ei * cr;
            const float* br = p.in[I_BRE] + ((size_t)lg * 64 + lane) * 16; const float* bi = p.in[I_BIM] + ((size_t)lg * 64 + lane) * 16;
#pragma unroll
            for (int c = 0; c < 16; ++c) { const float b0 = br[c], b1 = bi[c]; ebr[lane * 17 + c] = fr_ * b0 - fi_ * b1; ebi[lane * 17 + c] = fr_ * b1 + fi_ * b0; }
            LDS_WAIT();
            const int co = lane & 15, cb = (lane >> 4) * 4;
            const float* crp = p.in[I_CRE] + ((size_t)lg * 16 + co) * 64; const float* cip = p.in[I_CIM] + ((size_t)lg * 16 + co) * 64;
            float a0 = 0.f, a1 = 0.f, a2 = 0.f, a3 = 0.f;
            for (int q = 0; q < 64; ++q) { const float c0 = crp[q], c1 = cip[q];
                a0 += c0 * ebr[q * 17 + cb + 0] - c1 * ebi[q * 17 + cb + 0]; a1 += c0 * ebr[q * 17 + cb + 1] - c1 * ebi[q * 17 + cb + 1];
                a2 += c0 * ebr[q * 17 + cb + 2] - c1 * ebi[q * 17 + cb + 2]; a3 += c0 * ebr[q * 17 + cb + 3] - c1 * ebi[q * 17 + cb + 3]; }
            u32x2 w; w.x = pk2(a0, a1); w.y = pk2(a2, a3);
            *(u32x2*)(KT + ((size_t)it * 16 + co) * 16 + cb) = w;
            LDS_WAIT();
        }
        for (int it = gw; it < NL * 16 * 16; it += NGW) {
            const int lg = it >> 4, s4 = it & 15;
            float lrdt, lidt, cr, ci; s5_params(p, lg, lane, lrdt, lidt, cr, ci);
            const float* br = p.in[I_BRE] + ((size_t)lg * 64 + lane) * 16; const float* bi = p.in[I_BIM] + ((size_t)lg * 64 + lane) * 16;
            float b0[16], b1[16];
#pragma unroll
            for (int c = 0; c < 16; ++c) { b0[c] = br[c]; b1[c] = bi[c]; }
#pragma unroll 1
            for (int sq = 0; sq < 4; ++sq) { const int s = s4 * 4 + sq;
                float er, ei; s5_pow(lrdt, lidt, 63 - s, er, ei);
                const float fr_ = er * cr - ei * ci, fi_ = er * ci + ei * cr;
                float vr[16], vi[16];
#pragma unroll
                for (int c = 0; c < 16; ++c) { vr[c] = fr_ * b0[c] - fi_ * b1[c]; vi[c] = fr_ * b1[c] + fi_ * b0[c]; }
                bf16_t* o0 = WS_ + ((size_t)lg * 128 + lane) * 1024 + s * 16; bf16_t* o1 = WS_ + ((size_t)lg * 128 + 64 + lane) * 1024 + s * 16;
                u32x4 w;
                w.x = pk2(vr[0], vr[1]); w.y = pk2(vr[2], vr[3]); w.z = pk2(vr[4], vr[5]); w.w = pk2(vr[6], vr[7]); *(u32x4*)o0 = w;
                w.x = pk2(vr[8], vr[9]); w.y = pk2(vr[10], vr[11]); w.z = pk2(vr[12], vr[13]); w.w = pk2(vr[14], vr[15]); *(u32x4*)(o0 + 8) = w;
                w.x = pk2(vi[0], vi[1]); w.y = pk2(vi[2], vi[3]); w.z = pk2(vi[4], vi[5]); w.w = pk2(vi[6], vi[7]); *(u32x4*)o1 = w;
                w.x = pk2(vi[8], vi[9]); w.y = pk2(vi[10], vi[11]); w.z = pk2(vi[12], vi[13]); w.w = pk2(vi[14], vi[15]); *(u32x4*)(o1 + 8) = w; }
        }
        for (int it = gw; it < NL * 16 * 64; it += NGW) {
            const int lg = it >> 6, tl = it & 63;
            float lrdt, lidt, cr, ci; s5_params(p, lg, lane, lrdt, lidt, cr, ci);
            float er, ei; s5_pow(lrdt, lidt, tl + 1, er, ei);
#pragma unroll 4
            for (int co = 0; co < 16; ++co) { const float c0 = p.in[I_CRE][((size_t)lg * 16 + co) * 64 + lane], c1 = p.in[I_CIM][((size_t)lg * 16 + co) * 64 + lane];
                bf16_t* o = WC + (((size_t)lg * 64 + tl) * 16 + co) * 128;
                o[lane] = (bf16_t)f2bf(c0 * er - c1 * ei); o[64 + lane] = (bf16_t)f2bf(-(c0 * ei + c1 * er)); }
        }
    }
}

template <bool OUT>
DI void hgrn_item(const Params& p, LAS unsigned char* lds, int l, int cg) {
    int tid_o = threadIdx.x; asm volatile("" : "+v"(tid_o));
    const int tid = tid_o, lane = tid & 63, wave = tid >> 6, hd = wave >> 1, half = wave & 1;
    const bf16_t* Z = (const bf16_t*)(p.ws + WS_Z);
    LAS bf16_t* B0 = (LAS bf16_t*)(lds + hd * 27648); LAS bf16_t* B1 = B0 + 64 * 72; LAS bf16_t* B2 = B1 + 64 * 72;
    LAS float* GM = (LAS float*)(lds + 114688) + hd * 64; LAS float* GL = GM + 256; LAS float* SSA = (LAS float*)(lds + 114688) + 512;
    bf16_t* SL = (bf16_t*)(p.ws + WS_SL); const bf16_t* SL2 = (const bf16_t*)(p.ws + WS_SL2); float* DEC = (float*)(p.ws + WS_DEC);
    const int item = cg * 4 + hd;
    const bf16_t* zrow = Z + (size_t)(cg * 64 + half * 32) * DIN + hd * 64 + lane;
#ifdef FORCE_LB0
    const float lb = 0.f, oml = 1.f;
#else
    const float lb = ((const float*)(p.ws + WS_LB))[l * 256 + hd * 64 + lane], oml = 1.f - lb;
#endif
    float g[32]; float run = 0.f;
#pragma unroll
    for (int j = 0; j < 32; ++j) { const bf16_t* zp = zrow + (size_t)j * DIN; if ((j & 3) == 0) asm volatile("" : "+v"(zp));
        const float fz = bf2f(zp[ZF]); const float sg = sigmoidf_(fz); const float f = lb + oml * sg;
        run += __logf(fmaxf(f, 1e-30f)); g[j] = run; }
    __syncthreads();
    if (half == 0) GM[lane] = run;
    __syncthreads();
    const float gm = GM[lane];
    if (half) {
#pragma unroll
        for (int j = 0; j < 32; ++j) g[j] += gm; }
    const int c0 = lane & 31, h = lane >> 5;
    if constexpr (!OUT) {
        if (half) GL[lane] = run + gm;
        __syncthreads();
        const float gl = GL[lane];
#pragma unroll
        for (int j = 0; j < 32; ++j) { const int t = half * 32 + j; const bf16_t* zp = zrow + (size_t)j * DIN; asm volatile("" : "+v"(zp));
            const float e = __expf(gl - g[j]); const float kj = oml * (1.f - sigmoidf_(bf2f(zp[ZF])));
            B1[lane * 72 + t] = (bf16_t)f2bf(kj * e);
            B2[lane * 72 + t] = zp[ZI]; }
        __syncthreads();
#pragma unroll
        for (int kt = 0; kt < 2; ++kt) { const f32x16 a = mma_lds<64>(B2 + 32 * half * 72, 72, B1 + 32 * kt * 72, 72, zero16(), lane);
#pragma unroll
            for (int i = 0; i < 16; ++i) SL[(size_t)item * 4096 + (32 * half + crow(i, h)) * 64 + 32 * kt + c0] = (bf16_t)f2bf(a[i]); }
        if (half == 0) DEC[item * 64 + lane] = __expf(gl);
    } else {
#pragma unroll
        for (int j = 0; j < 32; ++j) { const int t = half * 32 + j; const bf16_t* zp = zrow + (size_t)j * DIN; asm volatile("" : "+v"(zp));
            const float q = bf2f(zp[ZQ]); const float kj = oml * (1.f - sigmoidf_(bf2f(zp[ZF])));
            const float e1 = __expf(fminf(g[j] - gm, 80.f)), e2 = __expf(fminf(gm - g[j], 80.f));
            B0[t * 72 + lane] = (bf16_t)f2bf(q * e1); B1[t * 72 + lane] = (bf16_t)f2bf(kj * e2);
            B2[lane * 72 + t] = zp[ZI]; }
        __syncthreads();
        f32x16 s0 = mma_lds<64>(B0 + 32 * half * 72, 72, B1, 72, zero16(), lane);
        f32x16 s1 = zero16(); if (half) s1 = mma_lds<64>(B0 + 32 * half * 72, 72, B1 + 32 * 72, 72, zero16(), lane);
        __syncthreads();
#pragma unroll
        for (int i = 0; i < 16; ++i) { const int row = 32 * half + crow(i, h);
            B1[row * 72 + c0] = (bf16_t)f2bf(c0 <= row ? s0[i] : 0.f); B1[row * 72 + 32 + c0] = (bf16_t)f2bf(32 + c0 <= row ? s1[i] : 0.f); }
        __syncthreads();
        f32x16 o0 = mma_lds<64>(B1 + 32 * half * 72, 72, B2, 72, zero16(), lane);
        f32x16 o1 = mma_lds<64>(B1 + 32 * half * 72, 72, B2 + 32 * 72, 72, zero16(), lane);
        __syncthreads();
        { const float eg = __expf(gm); const bf16_t* sp = SL2 + (size_t)item * 4096 + (32 * half) * 64 + lane;
#pragma unroll 8
          for (int j = 0; j < 32; ++j) B2[(32 * half + j) * 72 + lane] = (bf16_t)f2bf(bf2f(sp[j * 64]) * eg); }
        __syncthreads();
        o0 = mma_lds<64>(B0 + 32 * half * 72, 72, B2, 72, o0, lane);
        o1 = mma_lds<64>(B0 + 32 * half * 72, 72, B2 + 32 * 72, 72, o1, lane);
        const float* ng = p.in[I_HNG] + l * 256 + hd * 64; const float ng0 = ng[c0], ng1 = ng[32 + c0];
#pragma unroll
        for (int i = 0; i < 16; ++i) { const int row = 32 * half + crow(i, h); const size_t tok = (size_t)cg * 64 + row;
            const float ss = half_sum(o0[i] * o0[i] + o1[i] * o1[i]); const float rs = rsqrtf(ss * (1.0f / 64.0f) + EPS);
            const float g0 = bf2f(Z[tok * DIN + ZG + hd * 64 + c0]), g1 = bf2f(Z[tok * DIN + ZG + hd * 64 + 32 + c0]);
            const float v0 = o0[i] * rs * ng0 * g0 * sigmoidf_(g0), v1 = o1[i] * rs * ng1 * g1 * sigmoidf_(g1);
            o0[i] = v0; o1[i] = v1; const float s2 = half_sum(v0 * v0 + v1 * v1); if (c0 == 0) SSA[hd * 64 + row] = s2; }
        __syncthreads();
        bf16_t* Y = (bf16_t*)(p.ws + WS_YCAT);
#pragma unroll
        for (int i = 0; i < 16; ++i) { const int row = 32 * half + crow(i, h); const size_t tok = (size_t)cg * 64 + row;
            const float tot = (SSA[row] + SSA[64 + row]) + (SSA[128 + row] + SSA[192 + row]); const float r2 = rsqrtf(tot * (1.0f / 256.0f) + EPS);
            Y[tok * D + YA + hd * 64 + c0] = (bf16_t)f2bf(o0[i] * r2); Y[tok * D + YA + hd * 64 + 32 + c0] = (bf16_t)f2bf(o1[i] * r2); }
    }
}
DI void hgrn_scan_item(const Params& p, int hb) {
    int tid_o = threadIdx.x; asm volatile("" : "+v"(tid_o));
    const int e = hb * 512 + tid_o, bh = e >> 12, b = bh >> 2, hd = bh & 3, vk = e & 4095, k = vk & 63;
    const bf16_t* SL = (const bf16_t*)(p.ws + WS_SL); bf16_t* SL2 = (bf16_t*)(p.ws + WS_SL2); const float* DEC = (const float*)(p.ws + WS_DEC);
    float st = 0.f;
    for (int c8 = 0; c8 < 128; c8 += 8) { float tmp[8], dc[8];
#pragma unroll
        for (int u = 0; u < 8; ++u) { const int item = (b * 128 + c8 + u) * 4 + hd; tmp[u] = bf2f(SL[(size_t)item * 4096 + vk]); dc[u] = DEC[item * 64 + k]; }
#pragma unroll
        for (int u = 0; u < 8; ++u) { const int item = (b * 128 + c8 + u) * 4 + hd; SL2[(size_t)item * 4096 + vk] = (bf16_t)f2bf(st); st = dc[u] * st + tmp[u]; } }
}

DI void conv_item(const Params& p, LAS unsigned char* lds, int l, int ti) {
    int tid_o = threadIdx.x; asm volatile("" : "+v"(tid_o));
    const int tid = tid_o, lane = tid & 63, wave = tid >> 6, c = tid & 255, hf = tid >> 8, wv = wave & 3;
    LAS float* Hs = (LAS float*)lds; LAS float* ST = (LAS float*)(lds + 98304); LAS float* ST2 = ST + 512;
    const bf16_t* Z = (const bf16_t*)(p.ws + WS_Z); bf16_t* Y = (bf16_t*)(p.ws + WS_YCAT);
    const int tok0 = ti * 64, pos0 = (ti & 127) * 64;
    __syncthreads();
    for (int it = 0; it < 47; ++it) { const int row = 2 * it + hf, pos = pos0 - 30 + row; float hv = 0.f;
        if (pos >= 0) { const size_t tok = (size_t)(tok0 - 30 + row); const float val = bf2f(Z[tok * DIN + ZBV + c]), gate = bf2f(Z[tok * DIN + ZBG + c]); hv = val * sigmoidf_(gate); }
        Hs[row * 256 + c] = hv; }
    __syncthreads();
    const float* cw = p.in[I_CW] + (size_t)l * 31 * 256 + c; float w[31];
#pragma unroll
    for (int jj = 0; jj < 31; ++jj) w[jj] = cw[jj * 256];
    const float cb = p.in[I_CB][l * 256 + c];
    const float lng = p.in[I_CLG][l * 256 + c], lnb = p.in[I_CLB][l * 256 + c];
#pragma unroll 1
    for (int ps = 0; ps < 2; ++ps) { const int tb = hf * 32 + ps * 16;
        float o[16];
        { float hr[46];
#pragma unroll
          for (int r = 0; r < 46; ++r) hr[r] = Hs[(tb + r) * 256 + c];
#pragma unroll
          for (int j = 0; j < 16; ++j) { float a = cb;
#pragma unroll
            for (int jj = 0; jj < 31; ++jj) a += w[jj] * hr[j + jj];
            o[j] = a; } }
#pragma unroll
        for (int j = 0; j < 16; ++j) { const float s1 = wave_sum(o[j]), s2 = wave_sum(o[j] * o[j]); if (lane == 0) { ST[((tb + j) * 4 + wv) * 2] = s1; ST[((tb + j) * 4 + wv) * 2 + 1] = s2; } }
        __syncthreads();
#pragma unroll
        for (int j = 0; j < 16; ++j) { const LAS float* q = ST + (tb + j) * 8; const float s1 = (q[0] + q[2]) + (q[4] + q[6]), s2 = (q[1] + q[3]) + (q[5] + q[7]);
            const float mu = s1 * (1.0f / 256.0f); const float var = fmaxf(s2 * (1.0f / 256.0f) - mu * mu, 0.f);
            const float y = (o[j] - mu) * rsqrtf(var + EPS) * lng + lnb; const float sv = y * sigmoidf_(y); o[j] = sv;
            const float s3 = wave_sum(sv * sv); if (lane == 0) ST2[(tb + j) * 4 + wv] = s3; }
        __syncthreads();
#pragma unroll
        for (int j = 0; j < 16; ++j) { const LAS float* q = ST2 + (tb + j) * 4; const float tot = (q[0] + q[1]) + (q[2] + q[3]); const float rs = rsqrtf(tot * (1.0f / 256.0f) + EPS);
            Y[(size_t)(tok0 + tb + j) * D + YB + c] = (bf16_t)f2bf(o[j] * rs); }
    }
}

DI bf16x8 ldg8(const bf16_t* p) { return *(const bf16x8*)p; }
DI void s5_local_item(const Params& p, int l, int bi) {
    int tid_o = threadIdx.x; asm volatile("" : "+v"(tid_o));
    const int lane = tid_o & 63, wi = bi * 8 + (tid_o >> 6);
    const int g = wi & 15, cb = (wi >> 4) & 15, pt = wi >> 8, c0 = lane & 31, h = lane >> 5;
    const bf16_t* ua = (const bf16_t*)(p.ws + WS_Z) + (size_t)((cb * 32 + c0) * 64) * DIN + ZCU + g * 16 + 8 * h;
    const bf16_t* wb = (const bf16_t*)(p.ws + WS_S5WS) + ((size_t)(l * 16 + g) * 128 + pt * 32 + c0) * 1024 + 8 * h;
    f32x16 acc = zero16();
#pragma unroll 8
    for (int s = 0; s < 64; ++s) acc = __builtin_amdgcn_mfma_f32_32x32x16_bf16(ldg8(ua + (size_t)s * DIN), ldg8(wb + s * 16), acc, 0, 0, 0);
    float* HL = (float*)(p.ws + WS_S5H);
#pragma unroll
    for (int i = 0; i < 16; ++i) HL[((size_t)(cb * 32 + crow(i, h)) * 16 + g) * 128 + pt * 32 + c0] = acc[i];
}
DI void s5_scan_item(const Params& p, int l, int sb) {
    int tid_o = threadIdx.x; asm volatile("" : "+v"(tid_o));
    const int e = sb * 512 + tid_o, b = e >> 10, g = (e >> 6) & 15, pp = e & 63;
    float lrdt, lidt, cr, ci; s5_params(p, l * 16 + g, pp, lrdt, lidt, cr, ci);
    float ar, ai; s5_pow(lrdt, lidt, 64, ar, ai);
    const float* HL = (const float*)(p.ws + WS_S5H); float* HO = (float*)(p.ws + WS_S5H2); float hr = 0.f, hi = 0.f;
    for (int c8 = 0; c8 < 128; c8 += 8) { float tr[8], ti[8];
#pragma unroll
        for (int u = 0; u < 8; ++u) { const size_t idx = ((size_t)(b * 128 + c8 + u) * 16 + g) * 128; tr[u] = HL[idx + pp]; ti[u] = HL[idx + 64 + pp]; }
#pragma unroll
        for (int u = 0; u < 8; ++u) { const size_t idx = ((size_t)(b * 128 + c8 + u) * 16 + g) * 128; HO[idx + pp] = hr; HO[idx + 64 + pp] = hi;
            const float nr = ar * hr - ai * hi + tr[u], ni = ar * hi + ai * hr + ti[u]; hr = nr; hi = ni; } }
}
DI void s5_out_item(const Params& p, LAS unsigned char* lds, int l, int bi) {
    int tid_o = threadIdx.x; asm volatile("" : "+v"(tid_o));
    const int tid = tid_o, lane = tid & 63, wave = tid >> 6;
    const int gh = bi & 1, cb = (bi >> 1) & 15, pr = bi >> 5, g = gh * 8 + wave, c0 = lane & 31, h = lane >> 5, lg = l * 16 + g;
    LAS bf16_t* OT = (LAS bf16_t*)lds;
    const bf16_t* Z = (const bf16_t*)(p.ws + WS_Z);
    const bf16_t* ua = Z + (size_t)((cb * 32 + c0) * 64) * DIN + ZCU + g * 16 + 8 * h;
    const bf16_t* kt = (const bf16_t*)(p.ws + WS_S5K) + (size_t)lg * 64 * 256;
    const float* ha = (const float*)(p.ws + WS_S5H2) + ((size_t)(cb * 32 + c0) * 16 + g) * 128 + 8 * h;
    const int co = c0 & 15; const float dsk = p.in[I_S5D][l * 256 + g * 16 + co];
    __syncthreads();
#ifdef S5_DELAY
    for (int dd = 0; dd < 150; ++dd) __builtin_amdgcn_s_sleep(32);
#endif
    for (int q = 0; q < 2; ++q) { const int jt = q ? 31 - pr : pr; const int tl = 2 * jt + (c0 >> 4);
        f32x16 acc = zero16();
        const bf16_t* wc = (const bf16_t*)(p.ws + WS_S5WC) + (((size_t)lg * 64 + tl) * 16 + co) * 128 + 8 * h;
#ifndef NO_HTERM
#pragma unroll
        for (int ks = 0; ks < 8; ++ks) { const f32x4 x0 = *(const f32x4*)(ha + ks * 16), x1 = *(const f32x4*)(ha + ks * 16 + 4);
            u32x4 w; w.x = pk2(x0[0], x0[1]); w.y = pk2(x0[2], x0[3]); w.z = pk2(x1[0], x1[1]); w.w = pk2(x1[2], x1[3]);
            acc = __builtin_amdgcn_mfma_f32_32x32x16_bf16(__builtin_bit_cast(bf16x8, w), ldg8(wc + ks * 16), acc, 0, 0, 0); }
#endif
#ifdef NO_TOEP
        const int ns = 0;
#else
        const int ns = 2 * jt + 2;
#endif
#pragma unroll 4
        for (int s = 0; s < ns; ++s) { const int d = tl - s; const int dc = d < 0 ? 0 : d;
#ifdef SYN_KT
            const short sv = (short)(0x3c00 + ((dc * 7 + co * 3 + h) & 63));
            bf16x8 b = (bf16x8){sv, sv, sv, sv, sv, sv, sv, sv};
#else
            bf16x8 b = ldg8(kt + ((size_t)dc * 16 + co) * 16 + 8 * h);
#endif
            if (d < 0) b = (bf16x8){0, 0, 0, 0, 0, 0, 0, 0};
#ifdef SCALAR_U
            bf16x8 av; { const bf16_t* up = ua + (size_t)s * DIN;
              av[0] = (short)up[0]; av[1] = (short)up[1]; av[2] = (short)up[2]; av[3] = (short)up[3]; av[4] = (short)up[4]; av[5] = (short)up[5]; av[6] = (short)up[6]; av[7] = (short)up[7]; }
            acc = __builtin_amdgcn_mfma_f32_32x32x16_bf16(av, b, acc, 0, 0, 0); }
#else
            acc = __builtin_amdgcn_mfma_f32_32x32x16_bf16(ldg8(ua + (size_t)s * DIN), b, acc, 0, 0, 0); }
#endif
#pragma unroll
        for (int i = 0; i < 16; ++i) { const int m = crow(i, h); const size_t tok = (size_t)(cb * 32 + m) * 64 + tl; const float u = bf2f(Z[tok * DIN + ZCU + g * 16 + co]);
            const float y = acc[i] + dsk * u; const float ge = y * sigmoidf_(1.5957691216057308f * (y + 0.044715f * y * y * y));
            OT[(q * 64 + m * 2 + (c0 >> 4)) * 136 + wave * 16 + co] = (bf16_t)f2bf(ge); }
    }
    __syncthreads();
    { const int tau = tid >> 2, qq = tau >> 6, m = (tau >> 1) & 31, t2 = tau & 1, qt = tid & 3; const int jt = qq ? 31 - pr : pr;
      const size_t tok = (size_t)(cb * 32 + m) * 64 + 2 * jt + t2;
      const LAS u32x4* src = (const LAS u32x4*)(OT + tau * 136 + qt * 32); u32x4* dst = (u32x4*)((bf16_t*)(p.ws + WS_YPRE) + tok * 256 + gh * 128 + qt * 32);
#pragma unroll
      for (int e = 0; e < 4; ++e) dst[e] = src[e]; }
}

DI void attn_item(const Params& p, LAS unsigned char* lds, int l, int pt, int id) {
    int tid_o = threadIdx.x; asm volatile("" : "+v"(tid_o));
    const int tid = tid_o, lane = tid & 63, wave = tid >> 6;
    const int dil = pt == 0 ? 1 : (pt == 1 ? 4 : 16), nblk = 32 / dil;
    const int b = id >> 7, hd = (id >> 5) & 3, rn = id & 31, r = rn / nblk, n = rn % nblk;
    LAS bf16_t* Ks = (LAS bf16_t*)lds;
    LAS bf16_t* Vt = (LAS bf16_t*)(lds + 55296);
    LAS float* BT = (LAS float*)(lds + 55296 + 50176);
    const bf16_t* Z = (const bf16_t*)(p.ws + WS_Z);
    const bf16_t* OP = (const bf16_t*)(p.ws + (pt == 1 ? WS_O0 : WS_O1)); const float* LP = (const float*)(p.ws + (pt == 1 ? WS_LSE : WS_LSE1));
    bf16_t* ON = pt == 2 ? (bf16_t*)(p.ws + WS_Z) + ZOD : (bf16_t*)(p.ws + (pt == 0 ? WS_O0 : WS_O1)); const int onp = pt == 2 ? DIN : 256;
    float* LN = (float*)(p.ws + (pt == 0 ? WS_LSE : WS_LSE1));
    const size_t tokb = (size_t)b * SEQ;
    __syncthreads();
    if (tid < 132) BT[tid] = ((const float*)(p.ws + WS_BIAS))[(pt * 4 + hd) * 132 + tid];
    { const float* kg = p.in[I_KG] + l * 64 + (tid & 7) * 8; float kgv[8];
#pragma unroll
      for (int e = 0; e < 8; ++e) kgv[e] = kg[e];
      for (int it = 0; it < 6; ++it) { const int idx = tid + 512 * it, row = idx >> 3, c = idx & 7, si = n * 256 - 128 + row;
        u32x4 kw = (u32x4){0u, 0u, 0u, 0u}, vw = (u32x4){0u, 0u, 0u, 0u};
        if (si >= 0) { const size_t tok = tokb + (size_t)si * dil + r; kw = *(const u32x4*)(Z + tok * DIN + ZDK + hd * 64 + c * 8); vw = *(const u32x4*)(Z + tok * DIN + ZDV + hd * 64 + c * 8); }
        float kf[8]; kf[0] = bflo(kw.x); kf[1] = bfhi(kw.x); kf[2] = bflo(kw.y); kf[3] = bfhi(kw.y); kf[4] = bflo(kw.z); kf[5] = bfhi(kw.z); kf[6] = bflo(kw.w); kf[7] = bfhi(kw.w);
        float ss = 0.f;
#pragma unroll
        for (int e = 0; e < 8; ++e) ss += kf[e] * kf[e];
        ss += __shfl_xor(ss, 1); ss += __shfl_xor(ss, 2); ss += __shfl_xor(ss, 4);
        const float rs = rsqrtf(ss * (1.0f / 64.0f) + EPS);
        u32x4 o; o.x = pk2(kf[0] * rs * kgv[0], kf[1] * rs * kgv[1]); o.y = pk2(kf[2] * rs * kgv[2], kf[3] * rs * kgv[3]); o.z = pk2(kf[4] * rs * kgv[4], kf[5] * rs * kgv[5]); o.w = pk2(kf[6] * rs * kgv[6], kf[7] * rs * kgv[7]);
        *(LAS u32x4*)(Ks + row * 72 + c * 8) = o;
        LAS bf16_t* vp = Vt + (c * 8) * 392 + row;
        vp[0 * 392] = (bf16_t)(vw.x & 0xffffu); vp[1 * 392] = (bf16_t)(vw.x >> 16); vp[2 * 392] = (bf16_t)(vw.y & 0xffffu); vp[3 * 392] = (bf16_t)(vw.y >> 16);
        vp[4 * 392] = (bf16_t)(vw.z & 0xffffu); vp[5 * 392] = (bf16_t)(vw.z >> 16); vp[6 * 392] = (bf16_t)(vw.w & 0xffffu); vp[7 * 392] = (bf16_t)(vw.w >> 16); } }
    __syncthreads();
    const int c0 = lane & 31, h = lane >> 5;
    const int qi = 32 * wave + c0; const size_t tokq = tokb + (size_t)(n * 256 + qi) * dil + r;
    bf16x8 qf[4];
    { float qv[4][8]; float ss = 0.f;
#pragma unroll
      for (int ks = 0; ks < 4; ++ks) { const u32x4 w = *(const u32x4*)(Z + tokq * DIN + ZDQ + hd * 64 + ks * 16 + 8 * h);
        qv[ks][0] = bflo(w.x); qv[ks][1] = bfhi(w.x); qv[ks][2] = bflo(w.y); qv[ks][3] = bfhi(w.y); qv[ks][4] = bflo(w.z); qv[ks][5] = bfhi(w.z); qv[ks][6] = bflo(w.w); qv[ks][7] = bfhi(w.w);
#pragma unroll
        for (int e = 0; e < 8; ++e) ss += qv[ks][e] * qv[ks][e]; }
      ss += __shfl_xor(ss, 32);
      const float rs = rsqrtf(ss * (1.0f / 64.0f) + EPS) * 0.125f;
#pragma unroll
      for (int ks = 0; ks < 4; ++ks) { const float* qg = p.in[I_QG] + l * 64 + ks * 16 + 8 * h; const f32x4 g0 = *(const f32x4*)qg, g1 = *(const f32x4*)(qg + 4);
        u32x4 w; w.x = pk2(qv[ks][0] * rs * g0[0], qv[ks][1] * rs * g0[1]); w.y = pk2(qv[ks][2] * rs * g0[2], qv[ks][3] * rs * g0[3]);
        w.z = pk2(qv[ks][4] * rs * g1[0], qv[ks][5] * rs * g1[1]); w.w = pk2(qv[ks][6] * rs * g1[2], qv[ks][7] * rs * g1[3]);
        qf[ks] = __builtin_bit_cast(bf16x8, w); } }
    f32x16 acc[5];
#pragma unroll
    for (int c = 0; c < 5; ++c) { acc[c] = zero16(); const LAS bf16_t* kb = Ks + (32 * wave + 32 * c + c0) * 72 + 8 * h;
#pragma unroll
        for (int ks = 0; ks < 4; ++ks) acc[c] = __builtin_amdgcn_mfma_f32_32x32x16_bf16(*(const LAS bf16x8*)(kb + ks * 16), qf[ks], acc[c], 0, 0, 0); }
    float mx = -1e30f;
#pragma unroll
    for (int c = 0; c < 5; ++c)
#pragma unroll
        for (int i = 0; i < 16; ++i) { const int kr = crow(i, h); const int delta = 128 + c0 - 32 * c - kr; const int jl = 32 * wave + 32 * c + kr;
            const bool valid = (delta >= 0) && (delta <= 128) && (n * 256 - 128 + jl >= 0);
            const int dcl = delta < 0 ? 0 : (delta > 128 ? 128 : delta);
            const float lgt = valid ? acc[c][i] + BT[dcl] : -1e30f; acc[c][i] = lgt; mx = fmaxf(mx, lgt); }
    mx = fmaxf(mx, __shfl_xor(mx, 32));
    float mprev = 0.f, mnew = mx;
    if (pt > 0) { mprev = LP[tokq * 4 + hd]; mnew = fmaxf(mx, mprev); }
    float lsum = 0.f;
#pragma unroll
    for (int c = 0; c < 5; ++c)
#pragma unroll
        for (int i = 0; i < 16; ++i) { const float pv = __expf(acc[c][i] - mnew); acc[c][i] = pv; lsum += pv; }
    lsum += __shfl_xor(lsum, 32);
    f32x16 o[2]; o[0] = zero16(); o[1] = zero16();
#pragma unroll
    for (int c = 0; c < 5; ++c)
#pragma unroll
        for (int s = 0; s < 2; ++s) { u32x4 pw; pw.x = pk2(acc[c][8 * s + 0], acc[c][8 * s + 1]); pw.y = pk2(acc[c][8 * s + 2], acc[c][8 * s + 3]); pw.z = pk2(acc[c][8 * s + 4], acc[c][8 * s + 5]); pw.w = pk2(acc[c][8 * s + 6], acc[c][8 * s + 7]);
            const bf16x8 pf = __builtin_bit_cast(bf16x8, pw);
#pragma unroll
            for (int vt = 0; vt < 2; ++vt) { const LAS bf16_t* va = Vt + (32 * vt + c0) * 392 + 32 * wave + 32 * c + 16 * s + 4 * h;
                const s16x4 lo = *(const LAS s16x4*)va, hi = *(const LAS s16x4*)(va + 8);
                const bf16x8 vf = __builtin_shufflevector(lo, hi, 0, 1, 2, 3, 4, 5, 6, 7);
                o[vt] = __builtin_amdgcn_mfma_f32_32x32x16_bf16(vf, pf, o[vt], 0, 0, 0); } }
    float sp = 0.f; if (pt > 0) sp = __expf(mprev - mnew);
    const float ltot = lsum + sp, inv = 1.0f / ltot;
#pragma unroll
    for (int vt = 0; vt < 2; ++vt)
#pragma unroll
        for (int g4 = 0; g4 < 4; ++g4) { const int ch = hd * 64 + 32 * vt + 8 * g4 + 4 * h; bf16_t* yo = ON + tokq * onp + ch;
            float v0 = o[vt][4 * g4 + 0], v1 = o[vt][4 * g4 + 1], v2 = o[vt][4 * g4 + 2], v3 = o[vt][4 * g4 + 3];
            if (pt > 0) { const u32x2 w = *(const u32x2*)(OP + tokq * 256 + ch); v0 += sp * bflo(w.x); v1 += sp * bfhi(w.x); v2 += sp * bflo(w.y); v3 += sp * bfhi(w.y); }
            u32x2 w; w.x = pk2(v0 * inv, v1 * inv); w.y = pk2(v2 * inv, v3 * inv); *(u32x2*)yo = w; }
    if (h == 0 && pt < 2) __hip_atomic_store(LN + tokq * 4 + hd, mnew + __logf(ltot), __ATOMIC_RELAXED, __HIP_MEMORY_SCOPE_AGENT);
}

#ifndef MIX_A
#define MIX_A 1
#endif
#ifndef MIX_B
#define MIX_B 1
#endif
#ifndef MIX_C
#define MIX_C 1
#endif
#ifndef MIX_D
#define MIX_D 1
#endif
__global__ void __launch_bounds__(512, 2) hybrid_fwd(Params p) {
    extern __shared__ __attribute__((aligned(16))) unsigned char lds_raw[];
    LAS unsigned char* lds = (LAS unsigned char*)lds_raw;
    cg::grid_group grid = cg::this_grid();
    const int G = gridDim.x, bid = blockIdx.x;
    unsigned char* ws = p.ws;
    bf16_t* XB = (bf16_t*)(ws + WS_XB); bf16_t* Zb = (bf16_t*)(ws + WS_Z); bf16_t* YC_ = (bf16_t*)(ws + WS_YCAT); bf16_t* HM = (bf16_t*)(ws + WS_HM);
    float* SSQP = (float*)(ws + WS_SSQP);

#define GRID_SYNC() do { asm volatile("s_waitcnt vmcnt(0) lgkmcnt(0)" ::: "memory"); __syncthreads(); if (threadIdx.x == 0) { __builtin_amdgcn_fence(__ATOMIC_RELEASE, ""); asm volatile("s_waitcnt vmcnt(0)" ::: "memory"); } grid.sync(); __builtin_amdgcn_fence(__ATOMIC_ACQUIRE, ""); asm volatile("s_waitcnt vmcnt(0)" ::: "memory"); __syncthreads(); } while (0)
    prologue(p, lds, G);
#ifdef NANFILL
    { u32x4* q = (u32x4*)(ws + WS_S5H); const size_t n16 = (WS_END - WS_S5H) / 16; const u32x4 nanv = (u32x4){0xffffffffu, 0xffffffffu, 0xffffffffu, 0xffffffffu};
      for (size_t i = (size_t)bid * 512 + threadIdx.x; i < n16; i += (size_t)G * 512) q[i] = nanv;
      u32x4* q2 = (u32x4*)(ws + WS_LSE); const size_t m16 = (WS_S5K - WS_LSE) / 16;
      for (size_t i = (size_t)bid * 512 + threadIdx.x; i < m16; i += (size_t)G * 512) q2[i] = nanv; }
#endif
    GRID_SYNC();

#ifndef NL_RUN
#define NL_RUN NL
#endif
#ifndef DUMP_LAYER
#define DUMP_LAYER 0
#endif
    for (int lrun = 0; lrun < NL_RUN; ++lrun) {
#ifdef SAME_LAYER
        const int l = 0; const bool firstl = (lrun == 0), lastl = (lrun == NL_RUN - 1);
#else
        const int l = lrun; const bool firstl = (lrun == 0), lastl = (lrun == NL_RUN - 1);
#endif
        { pg8::Gemm g{XB, (const bf16_t*)(ws + WS_WIN) + (size_t)l * D * DIN, T, DIN, D, D}; pg8::StaticOrder S; S.init(T, DIN, G, bid);
          pg8::EpiScale E{Zb, DIN, SSQP, 0};
          pg8::gemm_phase<pg8::EpiScale, pg8::StaticOrder, true, true>(lds, g, S, E); }
        GRID_SYNC();
#ifndef SKIP_MIX
        if (!(MIX_A && MIX_B && MIX_C && MIX_D)) { int tq = threadIdx.x; asm volatile("" : "+v"(tq));
          for (int m = bid * 8 + (tq >> 6); m < T; m += G * 8) { u32x2* yp = (u32x2*)(YC_ + (size_t)m * D) + (tq & 63); const u32x2 z2 = (u32x2){0u, 0u};
              if (!MIX_A) yp[0] = z2; if (!MIX_B) yp[64] = z2; if (!MIX_C) yp[128] = z2; if (!MIX_D) yp[192] = z2; } }
        for (int it = bid; it < 1664; it += G) {
            if (it < 512) { if (MIX_A) hgrn_item<false>(p, lds, l, it); }
            else if (it < 1024) { if (MIX_B) conv_item(p, lds, l, it - 512); }
            else if (it < 1152) { if (MIX_C) s5_local_item(p, l, it - 1024); }
            else { if (MIX_D) attn_item(p, lds, l, 0, it - 1152); }
        }
        GRID_SYNC();
        for (int it = bid; it < 648; it += G) {
            if (it < 128) { if (MIX_A) hgrn_scan_item(p, it); }
            else if (it < 136) { if (MIX_C) s5_scan_item(p, l, it - 128); }
            else { if (MIX_D) attn_item(p, lds, l, 1, it - 136); }
        }
        GRID_SYNC();
        for (int it = bid; it < 1536; it += G) {
            if (it < 512) { if (MIX_A) hgrn_item<true>(p, lds, l, it); }
            else if (it < 1024) { if (MIX_C) s5_out_item(p, lds, l, it - 512); }
            else { if (MIX_D) attn_item(p, lds, l, 2, it - 1024); }
        }
        GRID_SYNC();
#ifndef NO_GLU
        { pg8::Gemm g{(const bf16_t*)(ws + WS_YPRE), (const bf16_t*)(ws + WS_WGLU) + (size_t)l * 65536, T, 256, 256, 256}; pg8::StaticOrder S; S.init(T, 256, G, bid);
          pg8::EpiGlu E{(const bf16_t*)(ws + WS_YPRE), 256, YC_ + YC};
          pg8::gemm_phase<pg8::EpiGlu, pg8::StaticOrder, false, true>(lds, g, S, E); }
#endif
        { int tq = threadIdx.x; asm volatile("" : "+v"(tq)); const int lane = tq & 63; const int gw = bid * 8 + (tq >> 6), NGW = G * 8;
          for (int m = gw; m < T; m += NGW) { u32x2* yp = (u32x2*)(YC_ + (size_t)m * D + YD) + lane; const u32x2 w = *((const u32x2*)(Zb + (size_t)m * DIN + ZOD) + lane);
              const float a0 = bflo(w.x), a1 = bfhi(w.x), a2 = bflo(w.y), a3 = bfhi(w.y);
              const float ss = wave_sum((a0 * a0 + a1 * a1) + (a2 * a2 + a3 * a3)); const float rs = rsqrtf(ss * (1.0f / 256.0f) + EPS);
              u32x2 o; o.x = pk2(a0 * rs, a1 * rs); o.y = pk2(a2 * rs, a3 * rs); *yp = o; } }
        GRID_SYNC();
#endif
#ifdef DUMP_SLICE
        if (lrun == DUMP_LAYER) { int tq = threadIdx.x; asm volatile("" : "+v"(tq));
          for (int m = bid * 8 + (tq >> 6); m < T; m += G * 8) { const int ln = tq & 63;
              for (int j = 0; j < 4; ++j) { const int col = j * 256 + ln * 4; const u32x2 w = *(const u32x2*)(YC_ + (size_t)m * D + col);
                  f32x4 o = (f32x4){0.f, 0.f, 0.f, 0.f}; if (j == DUMP_SLICE) o = (f32x4){bflo(w.x), bfhi(w.x), bflo(w.y), bfhi(w.y)};
                  *(f32x4*)(p.out + (size_t)m * D + col) = o; } }
          break; }
#endif
#ifdef SKIP_MIX
        { pg8::Gemm g{Zb, (const bf16_t*)(ws + WS_WOUT) + (size_t)l * D * D, T, D, D, DIN}; pg8::StaticOrder S; S.init(T, D, G, bid);
#else
        { pg8::Gemm g{YC_, (const bf16_t*)(ws + WS_WOUT) + (size_t)l * D * D, T, D, D, D}; pg8::StaticOrder S; S.init(T, D, G, bid);
#endif
          pg8::EpiRes E{firstl ? p.in[I_X] : p.out, p.out, XB, SSQP + (size_t)T * 16};
          pg8::gemm_phase<pg8::EpiRes, pg8::StaticOrder, true, true>(lds, g, S, E); }
        GRID_SYNC();
        { pg8::Gemm g{XB, (const bf16_t*)(ws + WS_WUP) + (size_t)l * D * FF, T, FF, D, D}; pg8::StaticOrder S; S.init(T, FF, G, bid);
          pg8::EpiScale E{HM, FF, SSQP + (size_t)T * 16, 1};
          pg8::gemm_phase<pg8::EpiScale, pg8::StaticOrder, true, true>(lds, g, S, E); }
        GRID_SYNC();
        { pg8::Gemm g{HM, (const bf16_t*)(ws + WS_WDN) + (size_t)l * D * FF, T, D, FF, FF}; pg8::StaticOrder S; S.init(T, D, G, bid);
          pg8::EpiRes E{p.out, p.out, XB, !lastl ? SSQP : nullptr};
          pg8::gemm_phase<pg8::EpiRes, pg8::StaticOrder, true, true>(lds, g, S, E); }
        if (!lastl) GRID_SYNC();
    }
}

extern "C" void kernel_launch(void* const* d_in, const int* in_sizes, int n_in, void* d_out, int out_size, void* d_ws, size_t ws_size, hipStream_t stream) {
    static int grid = 0;
    if (grid == 0) {
        if (n_in != 26 || out_size != T * D || ws_size < WS_END) { fprintf(stderr, "kernel_launch: unexpected shapes (n_in %d, out %d, ws %zu); nothing launched\n", n_in, out_size, ws_size); grid = -1; return; }
        int dev = 0, cus = 0, per_cu = 0;
        (void)hipGetDevice(&dev); (void)hipDeviceGetAttribute(&cus, hipDeviceAttributeMultiprocessorCount, dev);
        if (hipFuncSetAttribute((const void*)hybrid_fwd, hipFuncAttributeMaxDynamicSharedMemorySize, LDS_BYTES) != hipSuccess) { fprintf(stderr, "kernel_launch: hipFuncSetAttribute failed\n"); grid = -1; return; }
        if (hipOccupancyMaxActiveBlocksPerMultiprocessor(&per_cu, (const void*)hybrid_fwd, 512, LDS_BYTES) != hipSuccess || per_cu < 1) { fprintf(stderr, "kernel_launch: occupancy query gave %d\n", per_cu); per_cu = 1; }
        (void)hipGetLastError();
        if (cus <= 0) cus = 256;
        grid = cus * per_cu;
    }
    if (grid < 0) return;
    Params a{};
    for (int i = 0; i < 26; ++i) a.in[i] = (const float*)d_in[i];
    a.out = (float*)d_out; a.ws = (unsigned char*)d_ws;
    void* args[] = {&a};
    hipError_t e = hipLaunchCooperativeKernel((const void*)hybrid_fwd, dim3(grid), dim3(512), args, LDS_BYTES, stream);
    if (e != hipSuccess) fprintf(stderr, "cooperative launch failed: %s (grid %d)\n", hipGetErrorString(e), grid);
}
```

```cpp
#include <hip/hip_runtime.h>
#include <hip/hip_cooperative_groups.h>
#include <cstdio>
#include <cstdint>
namespace cg = cooperative_groups;

#define DI __device__ __forceinline__
#define LAS __attribute__((address_space(3)))
typedef unsigned short bf16_t;
typedef short bf16x8 __attribute__((ext_vector_type(8)));
typedef short s16x4 __attribute__((ext_vector_type(4)));
typedef float f32x4 __attribute__((ext_vector_type(4)));
typedef float f32x16 __attribute__((ext_vector_type(16)));
typedef unsigned u32x4 __attribute__((ext_vector_type(4)));
typedef unsigned u32x2 __attribute__((ext_vector_type(2)));

constexpr int NB = 4, SEQ = 8192, T = NB * SEQ, D = 1024, DIN = 2560, FF = 4096, NL = 4;
constexpr int ZQ = 0, ZF = 256, ZI = 512, ZG = 768, ZBV = 1024, ZBG = 1280, ZCU = 1536, ZDQ = 1792, ZDK = 2048, ZDV = 2304;
constexpr int YA = 0, YB = 256, YC = 512, YD = 768;
constexpr int ZOD = ZBG;
constexpr float EPS = 1e-6f;
constexpr size_t MiB = 1u << 20;
constexpr size_t WS_WIN = 0, WS_WOUT = 20 * MiB, WS_WUP = 28 * MiB, WS_WDN = 60 * MiB, WS_WGLU = 92 * MiB;
constexpr size_t WS_LB = 93 * MiB;
constexpr size_t WS_BIAS = WS_LB + 4096;
constexpr size_t WS_SSQ = WS_LB + 65536;
constexpr size_t WS_LSE = WS_SSQ + 8 * (size_t)T * 4;
constexpr size_t WS_DEC = WS_LSE + (size_t)T * 16;
constexpr size_t WS_LSE1 = WS_DEC + 2048 * 64 * 4;
constexpr size_t WS_S5K = 96 * MiB;
constexpr size_t WS_S5WS = 98 * MiB;
constexpr size_t WS_S5WC = 114 * MiB;
constexpr size_t WS_XB = 130 * MiB;
constexpr size_t WS_S5H = 194 * MiB;
constexpr size_t WS_HM = 198 * MiB;
constexpr size_t WS_Z = 198 * MiB;
constexpr size_t WS_YCAT = 358 * MiB;
constexpr size_t WS_SL = 422 * MiB, WS_SL2 = 438 * MiB;
constexpr size_t WS_S5H2 = 454 * MiB;
constexpr size_t WS_O0 = 458 * MiB, WS_O1 = 474 * MiB;
constexpr size_t WS_YPRE = 490 * MiB;
constexpr size_t WS_SSQP = 506 * MiB;
constexpr size_t WS_END = 510 * MiB;
static_assert(WS_LSE1 + (size_t)T * 16 <= WS_S5K, "misc region");

constexpr int LDS_BYTES = 147456;

DI unsigned f2bf(float f) { unsigned u = __builtin_bit_cast(unsigned, f); return (u + 0x7fffu + ((u >> 16) & 1u)) >> 16; }
DI unsigned pk2(float lo, float hi) { return f2bf(lo) | (f2bf(hi) << 16); }
DI float bf2f(bf16_t v) { return __builtin_bit_cast(float, (unsigned)v << 16); }
DI float bflo(unsigned w) { return __builtin_bit_cast(float, w << 16); }
DI float bfhi(unsigned w) { return __builtin_bit_cast(float, w & 0xffff0000u); }
DI float sigmoidf_(float x) { return 1.f / (1.f + __expf(-x)); }
DI float wave_sum(float v) {
#pragma unroll
    for (int o = 1; o < 64; o <<= 1) v += __shfl_xor(v, o);
    return v;
}
DI float half_sum(float v) {
#pragma unroll
    for (int o = 1; o < 32; o <<= 1) v += __shfl_xor(v, o);
    return v;
}
#define LDS_WAIT() asm volatile("s_waitcnt lgkmcnt(0)" ::: "memory")
DI int crow(int reg, int h) { return (reg & 3) + 8 * (reg >> 2) + 4 * h; }

template <int K>
DI f32x16 mma_lds(const LAS bf16_t* A, int lda, const LAS bf16_t* B, int ldb, f32x16 acc, int lane) {
    const int r = lane & 31, h = lane >> 5;
    const LAS bf16_t* ap = A + r * lda + 8 * h; const LAS bf16_t* bp = B + r * ldb + 8 * h;
#pragma unroll
    for (int k0 = 0; k0 < K; k0 += 16) {
        const bf16x8 a = *(const LAS bf16x8*)(ap + k0); const bf16x8 b = *(const LAS bf16x8*)(bp + k0);
        acc = __builtin_amdgcn_mfma_f32_32x32x16_bf16(a, b, acc, 0, 0, 0);
    }
    return acc;
}
DI f32x16 zero16() { f32x16 z;
#pragma unroll
    for (int i = 0; i < 16; ++i) z[i] = 0.f;
    return z; }

namespace pg8 {
#define PG8_LAS __attribute__((address_space(3)))
constexpr int BM = 256, BK = 64, HALF = 128, HTB = HALF * BK * 2, STAGE_BYTES = 8 * HTB, NXCD = 8, WGM = 8;
__host__ __device__ __forceinline__ int lds_byte(int r, int c) { const int st = (r >> 4) * 2 + (c >> 5), rr = r & 15, cc = c & 31, ob = rr * 64 + cc * 2; return st * 1024 + (ob ^ (((ob >> 9) & 1) << 5)); }
__host__ __device__ __forceinline__ void stage_rc(int b, int& R, int& C) { const int st = b / 1024, sb = b % 1024, swz = sb ^ (((sb >> 9) & 1) << 5); R = (st >> 1) * 16 + swz / 64; C = (st & 1) * 32 + (swz % 64) / 2; }
__host__ __device__ __forceinline__ int perm32(int rho) { const int n = rho >> 4, i = rho & 15; return 8 * (i >> 2) + 4 * n + (i & 3); }
struct Unit { int pm, pn; };
struct Gemm { const bf16_t* A; const bf16_t* Bt; int M, N, K, lda; };
struct StaticOrder {
    int nM, nN, nwg, G, c;
    __host__ __device__ void init(int M, int N, int G_, int c_) { nM = M / BM; nN = N / BM; nwg = nM * nN; G = G_; c = c_; }
    __host__ __device__ bool next(int i, Unit& u) const {
        const long L = (long)i * G + c; if (L >= nwg) return false;
        int wgid = (int)L; { const int q = nwg / NXCD, r = nwg % NXCD, xcd = wgid % NXCD, off = wgid / NXCD; wgid = (xcd < r ? xcd * (q + 1) : r * (q + 1) + (xcd - r) * q) + off; }
        const int nig = WGM * nN, gid = wgid / nig, fm = gid * WGM, gsz = (nM - fm) < WGM ? (nM - fm) : WGM;
        u.pm = fm + ((wgid % nig) % gsz); u.pn = (wgid % nig) / gsz; return true;
    }
    __device__ __forceinline__ void a_ready(const Unit&) const {}
    __device__ __forceinline__ void done(const Unit&) const {}
};
struct EpiScale {
    static constexpr bool PERM = true, AFTER_DRAIN = false;
    bf16_t* O; int ldc; const float* ssq; int act;
    __device__ __forceinline__ void operator()(const f32x4 (&acc)[2][2][4][2], const Unit& u, int wr, int wc, int fr, int fq) const {
        const int row0 = u.pm * BM + wr * 64 + fr; const int col0 = u.pn * BM + wc * 32 + 8 * fq;
#pragma unroll
        for (int ai = 0; ai < 2; ++ai)
#pragma unroll
            for (int m = 0; m < 4; ++m) { const int r = row0 + ai * HALF + m * 16; const f32x4* sq = (const f32x4*)(ssq + (size_t)r * 16); const f32x4 q0 = sq[0], q1 = sq[1], q2 = sq[2], q3 = sq[3];
                const float tot = (((q0[0] + q0[1]) + (q0[2] + q0[3])) + ((q1[0] + q1[1]) + (q1[2] + q1[3]))) + (((q2[0] + q2[1]) + (q2[2] + q2[3])) + ((q3[0] + q3[1]) + (q3[2] + q3[3])));
                const float rs = rsqrtf(tot * (1.0f / 1024.0f) + EPS);
                bf16_t* rowp = O + (size_t)r * ldc + col0;
#pragma unroll
                for (int bj = 0; bj < 2; ++bj) { f32x4 v0 = acc[ai][bj][m][0] * rs, v1 = acc[ai][bj][m][1] * rs;
                    if (act) {
#pragma unroll
                        for (int e = 0; e < 4; ++e) { const float a = fmaxf(v0[e], 0.f), b = fmaxf(v1[e], 0.f); v0[e] = a * a; v1[e] = b * b; } }
                    u32x4 w; w.x = pk2(v0[0], v0[1]); w.y = pk2(v0[2], v0[3]); w.z = pk2(v1[0], v1[1]); w.w = pk2(v1[2], v1[3]);
                    *(u32x4*)(rowp + bj * HALF) = w; } }
    }
};
struct EpiRes {
    static constexpr bool PERM = false, AFTER_DRAIN = false;
    const float* base; float* out; bf16_t* xb; float* ssq_out;
    __device__ __forceinline__ void operator()(const f32x4 (&acc)[2][2][4][2], const Unit& u, int wr, int wc, int fr, int fq) const {
        const int col0 = u.pn * BM + wc * 32 + 4 * fq;
#pragma unroll
        for (int ai = 0; ai < 2; ++ai)
#pragma unroll
            for (int m = 0; m < 4; ++m) { const int r = u.pm * BM + ai * HALF + wr * 64 + m * 16 + fr; const size_t off = (size_t)r * D + col0; float s = 0.f;
#pragma unroll
                for (int bj = 0; bj < 2; ++bj)
#pragma unroll
                    for (int n = 0; n < 2; ++n) { const size_t o2 = off + bj * HALF + n * 16; const f32x4 o = *(const f32x4*)(base + o2) + acc[ai][bj][m][n];
                        *(f32x4*)(out + o2) = o; u32x2 w; w.x = pk2(o[0], o[1]); w.y = pk2(o[2], o[3]); *(u32x2*)(xb + o2) = w;
                        s += (o[0] * o[0] + o[1] * o[1]) + (o[2] * o[2] + o[3] * o[3]); }
                s += __shfl_xor(s, 16); s += __shfl_xor(s, 32);
                if (fq == 0 && ssq_out) ssq_out[(size_t)r * 16 + u.pn * 4 + wc] = s; }
    }
};
struct EpiGlu {
    static constexpr bool PERM = false, AFTER_DRAIN = true;
    const bf16_t* Ysrc; int lds_; bf16_t* Y;
    __device__ __forceinline__ void fused(f32x4 (&acc)[2][2][4][2], const Unit& u, int wr, int wc, int fr, int fq, PG8_LAS unsigned char* lds, int wid, int lane) const {
        PG8_LAS float* Pp = (PG8_LAS float*)lds;
        const int col0 = wc * 32 + 4 * fq;
#pragma unroll
        for (int ai = 0; ai < 2; ++ai)
#pragma unroll
            for (int m = 0; m < 4; ++m) { const int rl = ai * HALF + wr * 64 + m * 16 + fr; const size_t off = (size_t)(u.pm * BM + rl) * lds_ + col0; float s = 0.f;
#pragma unroll
                for (int bj = 0; bj < 2; ++bj)
#pragma unroll
                    for (int n = 0; n < 2; ++n) { const u32x2 w = *(const u32x2*)(Ysrc + off + bj * HALF + n * 16); f32x4 a = acc[ai][bj][m][n];
                        const float y0 = bflo(w.x), y1 = bfhi(w.x), y2 = bflo(w.y), y3 = bfhi(w.y);
                        a[0] = y0 * sigmoidf_(a[0]); a[1] = y1 * sigmoidf_(a[1]); a[2] = y2 * sigmoidf_(a[2]); a[3] = y3 * sigmoidf_(a[3]);
                        acc[ai][bj][m][n] = a; s += (a[0] * a[0] + a[1] * a[1]) + (a[2] * a[2] + a[3] * a[3]); }
                s += __shfl_xor(s, 16); s += __shfl_xor(s, 32);
                if (fq == 0) Pp[rl * 4 + wc] = s; }
        __syncthreads();
#pragma unroll
        for (int ai = 0; ai < 2; ++ai)
#pragma unroll
            for (int m = 0; m < 4; ++m) { const int rl = ai * HALF + wr * 64 + m * 16 + fr; const size_t off = (size_t)(u.pm * BM + rl) * D + col0;
                const float tot = (Pp[rl * 4 + 0] + Pp[rl * 4 + 1]) + (Pp[rl * 4 + 2] + Pp[rl * 4 + 3]); const float rs = rsqrtf(tot * (1.0f / 256.0f) + EPS);
#pragma unroll
                for (int bj = 0; bj < 2; ++bj)
#pragma unroll
                    for (int n = 0; n < 2; ++n) { const f32x4 a = acc[ai][bj][m][n] * rs; u32x2 w; w.x = pk2(a[0], a[1]); w.y = pk2(a[2], a[3]); *(u32x2*)(Y + off + bj * HALF + n * 16) = w; } }
    }
};

template <class Epi, class Sched, bool ALIGN_EPI = false, bool SP2 = false>
__device__ __forceinline__ void gemm_phase(PG8_LAS unsigned char* lds, const Gemm g, const Sched& S, const Epi& E) {
    int tid_o = threadIdx.x; asm volatile("" : "+v"(tid_o));
    const int tid = tid_o, wid = __builtin_amdgcn_readfirstlane(tid >> 6), lane = tid & 63, wr = wid >> 2, wc = wid & 3, fr = lane & 15, fq = lane >> 4;
    const int K = g.K, nt = K / BK;
    unsigned voffA[2], voffB[2];
#pragma unroll
    for (int i = 0; i < 2; ++i) { int R, C; stage_rc(tid * 16 + i * 8192, R, C); const int Rb = Epi::PERM ? ((R & ~31) + perm32(R & 31)) : R;
        voffA[i] = (unsigned)(R * g.lda + C) * 2u; voffB[i] = (unsigned)(Rb * K + C) * 2u; }
    const size_t kstep = (size_t)(BK * 2);
    const size_t hstepA = (size_t)HALF * g.lda * 2, hstepB = (size_t)HALF * K * 2;
    const size_t tstepA = 2 * hstepA, tstepB = 2 * hstepB;
    const unsigned ldsw = (unsigned)wid * 1024u;
    const int aoff = lds_byte(wr * 64 + fr, fq * 8), boff = lds_byte(wc * 32 + fr, fq * 8);
#define PG8_SA(b, h) (((b) * 2 + (h)) * HTB)
#define PG8_SB(b, h) ((4 + (b) * 2 + (h)) * HTB)
#define PG8_STAGE(bufoff, gbase, voff) do { _Pragma("unroll") for (int _i = 0; _i < 2; ++_i) \
        __builtin_amdgcn_global_load_lds((const unsigned*)((const char*)(gbase) + (voff)[_i]), (PG8_LAS unsigned*)(lds + (bufoff) + ldsw + _i * 8192), 16, 0, 0); } while (0)
#define PG8_LDA(dst, b, h) do { _Pragma("unroll") for (int m = 0; m < 4; ++m) _Pragma("unroll") for (int k = 0; k < 2; ++k) dst[m][k] = *(const PG8_LAS bf16x8*)(lds + PG8_SA(b, h) + aoff + m * 2048 + k * 1024); } while (0)
#define PG8_LDB(dst, b, h) do { _Pragma("unroll") for (int n = 0; n < 2; ++n) _Pragma("unroll") for (int k = 0; k < 2; ++k) dst[n][k] = *(const PG8_LAS bf16x8*)(lds + PG8_SB(b, h) + boff + n * 2048 + k * 1024); } while (0)
#define PG8_MMA(ai, bj, At, Bt) do { __builtin_amdgcn_s_setprio(1); _Pragma("unroll") for (int m = 0; m < 4; ++m) _Pragma("unroll") for (int n = 0; n < 2; ++n) _Pragma("unroll") for (int k = 0; k < 2; ++k) \
        acc[ai][bj][m][n] = __builtin_amdgcn_mfma_f32_16x16x32_bf16(Bt[n][k], At[m][k], acc[ai][bj][m][n], 0, 0, 0); __builtin_amdgcn_s_setprio(0); } while (0)
#define PG8_WAIT_V(n) asm volatile("s_waitcnt vmcnt(" #n ")" ::: "memory")
#define PG8_WAIT_L(n) asm volatile("s_waitcnt lgkmcnt(" #n ")" ::: "memory")
#define PG8_BAR __builtin_amdgcn_s_barrier()
#define PG8_SCHED __builtin_amdgcn_sched_barrier(0)
    Unit cur, nxt; int ui = 0;
    if (!S.next(0, cur)) return;
    f32x4 acc[2][2][4][2];
#pragma unroll
    for (int a = 0; a < 2; ++a)
#pragma unroll
        for (int b = 0; b < 2; ++b)
#pragma unroll
            for (int m = 0; m < 4; ++m)
#pragma unroll
                for (int n = 0; n < 2; ++n) acc[a][b][m][n] = (f32x4){0.f, 0.f, 0.f, 0.f};
    bf16x8 At[4][2], B0[2][2], B1[2][2];
    const char* cA = (const char*)g.A + (size_t)cur.pm * tstepA; const char* cB = (const char*)g.Bt + (size_t)cur.pn * tstepB;
    S.a_ready(cur);
    if constexpr (SP2) {
        PG8_STAGE(PG8_SB(0, 0), cB, voffB); PG8_STAGE(PG8_SB(0, 1), cB + hstepB, voffB); PG8_STAGE(PG8_SA(0, 0), cA, voffA); PG8_STAGE(PG8_SA(0, 1), cA + hstepA, voffA);
        if (wr == 1) PG8_BAR;
        PG8_WAIT_V(2); PG8_BAR;
        PG8_STAGE(PG8_SB(1, 0), cB + kstep, voffB); PG8_STAGE(PG8_SA(1, 0), cA + kstep, voffA); PG8_STAGE(PG8_SB(1, 1), cB + hstepB + kstep, voffB);
        PG8_WAIT_V(6); PG8_BAR;
    } else {
        PG8_STAGE(PG8_SB(0, 0), cB, voffB); PG8_STAGE(PG8_SA(0, 0), cA, voffA); PG8_STAGE(PG8_SB(0, 1), cB + hstepB, voffB); PG8_STAGE(PG8_SA(0, 1), cA + hstepA, voffA);
        if (wr == 1) PG8_BAR;
        PG8_WAIT_V(4); PG8_BAR;
        PG8_STAGE(PG8_SB(1, 0), cB + kstep, voffB); PG8_STAGE(PG8_SA(1, 0), cA + kstep, voffA); PG8_STAGE(PG8_SB(1, 1), cB + hstepB + kstep, voffB);
        PG8_WAIT_V(6); PG8_BAR;
    }
    for (;;) {
        const bool has_next = S.next(ui + 1, nxt);
        const char* nA = has_next ? (const char*)g.A + (size_t)nxt.pm * tstepA : cA; const char* nB = has_next ? (const char*)g.Bt + (size_t)nxt.pn * tstepB : cB;
        for (int t = 0; t < nt; t += 2) {
            const bool last = (t == nt - 2);
            const char* a1 = cA + (size_t)(t + 1) * kstep;
            const char* a2 = last ? nA : cA + (size_t)(t + 2) * kstep; const char* b2 = last ? nB : cB + (size_t)(t + 2) * kstep;
            const char* a3 = a2 + kstep; const char* b3 = b2 + kstep;
            if (last && has_next) S.a_ready(nxt);
            if constexpr (SP2) {
            PG8_LDB(B0, 0, 0); PG8_LDB(B1, 0, 1); PG8_SCHED; PG8_LDA(At, 0, 0); PG8_STAGE(PG8_SA(1, 1), a1 + hstepA, voffA);
            PG8_WAIT_V(8); PG8_WAIT_L(0); PG8_BAR; PG8_MMA(0, 0, At, B0); PG8_MMA(0, 1, At, B1); PG8_BAR; PG8_SCHED;
            PG8_LDA(At, 0, 1); PG8_STAGE(PG8_SB(0, 0), b2, voffB); PG8_STAGE(PG8_SB(0, 1), b2 + hstepB, voffB); PG8_STAGE(PG8_SA(0, 0), a2, voffA);
            PG8_WAIT_V(8); PG8_WAIT_L(0); PG8_BAR; PG8_MMA(1, 0, At, B0); PG8_MMA(1, 1, At, B1); PG8_BAR; PG8_SCHED;
            PG8_LDB(B0, 1, 0); PG8_LDB(B1, 1, 1); PG8_SCHED; PG8_LDA(At, 1, 0); PG8_STAGE(PG8_SA(0, 1), a2 + hstepA, voffA);
            PG8_WAIT_V(8); PG8_WAIT_L(0); PG8_BAR; PG8_MMA(0, 0, At, B0); PG8_MMA(0, 1, At, B1); PG8_BAR; PG8_SCHED;
            PG8_LDA(At, 1, 1); PG8_STAGE(PG8_SB(1, 0), b3, voffB); PG8_STAGE(PG8_SB(1, 1), b3 + hstepB, voffB); PG8_STAGE(PG8_SA(1, 0), a3, voffA);
            PG8_WAIT_V(8); PG8_WAIT_L(0); PG8_BAR; PG8_MMA(1, 0, At, B0); PG8_MMA(1, 1, At, B1); PG8_BAR; PG8_SCHED;
            } else {
            PG8_LDB(B0, 0, 0); PG8_SCHED; PG8_LDA(At, 0, 0); PG8_STAGE(PG8_SA(1, 1), a1 + hstepA, voffA);
            PG8_WAIT_L(8); PG8_BAR; PG8_WAIT_L(0); PG8_MMA(0, 0, At, B0); PG8_BAR; PG8_SCHED;
            PG8_LDB(B1, 0, 1); PG8_STAGE(PG8_SB(0, 0), b2, voffB);
            PG8_BAR; PG8_WAIT_L(0); PG8_MMA(0, 1, At, B1); PG8_BAR;
            PG8_LDA(At, 0, 1); PG8_STAGE(PG8_SA(0, 0), a2, voffA);
            PG8_BAR; PG8_WAIT_L(0); PG8_MMA(1, 0, At, B0); PG8_BAR; PG8_SCHED;
            PG8_STAGE(PG8_SB(0, 1), b2 + hstepB, voffB);
            PG8_WAIT_V(6); PG8_BAR; PG8_MMA(1, 1, At, B1); PG8_BAR;
            PG8_LDB(B0, 1, 0); PG8_SCHED; PG8_LDA(At, 1, 0); PG8_STAGE(PG8_SA(0, 1), a2 + hstepA, voffA);
            PG8_WAIT_L(8); PG8_BAR; PG8_WAIT_L(0); PG8_MMA(0, 0, At, B0); PG8_BAR; PG8_SCHED;
            PG8_LDB(B1, 1, 1); PG8_STAGE(PG8_SB(1, 0), b3, voffB);
            PG8_BAR; PG8_WAIT_L(0); PG8_MMA(0, 1, At, B1); PG8_BAR;
            PG8_LDA(At, 1, 1); PG8_STAGE(PG8_SA(1, 0), a3, voffA);
            PG8_BAR; PG8_WAIT_L(0); PG8_MMA(1, 0, At, B0); PG8_BAR; PG8_SCHED;
            PG8_STAGE(PG8_SB(1, 1), b3 + hstepB, voffB);
            PG8_WAIT_V(6); PG8_BAR; PG8_MMA(1, 1, At, B1); PG8_BAR;
            }
        }
        if constexpr (ALIGN_EPI) { if (wr == 0) PG8_BAR; }
        if constexpr (!Epi::AFTER_DRAIN) { E(acc, cur, wr, wc, fr, fq); S.done(cur); }
        if (!has_next) break;
#pragma unroll
        for (int a = 0; a < 2; ++a)
#pragma unroll
            for (int b = 0; b < 2; ++b)
#pragma unroll
                for (int m = 0; m < 4; ++m)
#pragma unroll
                    for (int n = 0; n < 2; ++n) acc[a][b][m][n] = (f32x4){0.f, 0.f, 0.f, 0.f};
        cur = nxt; cA = nA; cB = nB; ++ui;
        if constexpr (ALIGN_EPI) { if (wr == 1) PG8_BAR; }
    }
    PG8_WAIT_V(0);
    if constexpr (!ALIGN_EPI) { if (wr == 0) PG8_BAR; }
    PG8_BAR;
    if constexpr (Epi::AFTER_DRAIN) { E.fused(acc, cur, wr, wc, fr, fq, lds, wid, lane); S.done(cur); }
#undef PG8_SA
#undef PG8_SB
#undef PG8_STAGE
#undef PG8_LDA
#undef PG8_LDB
#undef PG8_MMA
#undef PG8_WAIT_V
#undef PG8_WAIT_L
#undef PG8_BAR
#undef PG8_SCHED
}
}

struct Params { const float* in[26]; float* out; unsigned char* ws; };
enum { I_X = 0, I_NMG, I_WIN, I_LBL, I_HNG, I_CW, I_CB, I_CLG, I_CLB, I_LRE, I_LIM, I_BRE, I_BIM, I_CRE, I_CIM, I_S5D, I_LDT, I_WGLU, I_QG, I_KG, I_RB, I_MONG, I_WOUT, I_NMLPG, I_WUP, I_WDN };

DI void p0_transpose_item(const float* W, int K, int N, bf16_t* WT, const float* gk, LAS float* scr, int item, int lane) {
    const int nblk = N / 32, kb = item / nblk, nb = item % nblk, k0 = 64 * kb, n0 = 32 * nb;
#pragma unroll 8
    for (int i = 0; i < 32; ++i) { const int kk = 2 * i + (lane >> 5); const float s = gk ? gk[k0 + kk] : 1.f; scr[kk * 33 + (lane & 31)] = W[(size_t)(k0 + kk) * N + n0 + (lane & 31)] * s; }
    LDS_WAIT();
    const int c = lane & 7;
#pragma unroll
    for (int j = 0; j < 4; ++j) { const int n = (lane >> 3) + 8 * j; const LAS float* s = scr + (8 * c) * 33 + n;
        u32x4 o; o.x = pk2(s[0 * 33], s[1 * 33]); o.y = pk2(s[2 * 33], s[3 * 33]); o.z = pk2(s[4 * 33], s[5 * 33]); o.w = pk2(s[6 * 33], s[7 * 33]);
        *(u32x4*)(WT + (size_t)(n0 + n) * K + k0 + 8 * c) = o; }
    LDS_WAIT();
}
DI void s5_params(const Params& p, int lg, int pp, float& lrdt, float& lidt, float& cr, float& ci) {
    const float dt = expf(p.in[I_LDT][lg]);
    const float lr = p.in[I_LRE][lg * 64 + pp], li = p.in[I_LIM][lg * 64 + pp];
    lrdt = lr * dt; lidt = li * dt;
    const float mag = expf(lrdt); const float ar = mag * cosf(lidt), ai = mag * sinf(lidt);
    const float den = lr * lr + li * li;
    cr = ((ar - 1.0f) * lr + ai * li) / den; ci = (ai * lr - (ar - 1.0f) * li) / den;
}
DI void s5_pow(float lrdt, float lidt, int n, float& er, float& ei) { const float m = expf((float)n * lrdt); const float a = (float)n * lidt; er = m * cosf(a); ei = m * sinf(a); }

DI void prologue(const Params& p, LAS unsigned char* lds, int G) {
    int tid_o = threadIdx.x; asm volatile("" : "+v"(tid_o));
    const int tid = tid_o, lane = tid & 63, wave = tid >> 6;
    const int gw = blockIdx.x * 8 + wave, NGW = G * 8;
    const int gt = blockIdx.x * 512 + tid, NGT = G * 512;
    unsigned char* ws = p.ws;
    LAS float* scr = (LAS float*)(lds + wave * 16384);
    {
        constexpr int I_IN = (D / 64) * (DIN / 32), I_OUT = (D / 64) * (D / 32), I_UP = (D / 64) * (FF / 32), I_DN = (FF / 64) * (D / 32), I_GL = (256 / 64) * (256 / 32);
        constexpr int PER_L = I_IN + I_OUT + I_UP + I_DN + I_GL;
        for (int it = gw; it < NL * PER_L; it += NGW) {
            const int l = it / PER_L; int r = it % PER_L;
            if (r < I_IN) { p0_transpose_item(p.in[I_WIN] + (size_t)l * D * DIN, D, DIN, (bf16_t*)(ws + WS_WIN) + (size_t)l * D * DIN, p.in[I_NMG] + l * D, scr, r, lane); continue; } r -= I_IN;
            if (r < I_OUT) { p0_transpose_item(p.in[I_WOUT] + (size_t)l * D * D, D, D, (bf16_t*)(ws + WS_WOUT) + (size_t)l * D * D, p.in[I_MONG] + l * D, scr, r, lane); continue; } r -= I_OUT;
            if (r < I_UP) { p0_transpose_item(p.in[I_WUP] + (size_t)l * D * FF, D, FF, (bf16_t*)(ws + WS_WUP) + (size_t)l * D * FF, p.in[I_NMLPG] + l * D, scr, r, lane); continue; } r -= I_UP;
            if (r < I_DN) { p0_transpose_item(p.in[I_WDN] + (size_t)l * D * FF, FF, D, (bf16_t*)(ws + WS_WDN) + (size_t)l * D * FF, nullptr, scr, r, lane); continue; } r -= I_DN;
            p0_transpose_item(p.in[I_WGLU] + (size_t)l * 65536, 256, 256, (bf16_t*)(ws + WS_WGLU) + (size_t)l * 65536, nullptr, scr, r, lane);
        }
    }
    {
        float* ssq0 = (float*)(ws + WS_SSQP); bf16_t* XB = (bf16_t*)(ws + WS_XB);
        for (int mb = gw * 16; mb < T; mb += NGW * 16) {
            float keep = 0.f;
#pragma unroll 1
            for (int i = 0; i < 16; ++i) { const int m = mb + i;
                const f32x4* xr = (const f32x4*)(p.in[I_X] + (size_t)m * D) + lane; f32x4 v[4]; float s = 0.f;
#pragma unroll
                for (int j = 0; j < 4; ++j) { v[j] = xr[64 * j]; s += (v[j][0] * v[j][0] + v[j][1] * v[j][1]) + (v[j][2] * v[j][2] + v[j][3] * v[j][3]); }
                s = wave_sum(s); if (lane == i) keep = s;
                u32x2* o8 = (u32x2*)(XB + (size_t)m * D) + lane;
#pragma unroll
                for (int j = 0; j < 4; ++j) { u32x2 w; w.x = pk2(v[j][0], v[j][1]); w.y = pk2(v[j][2], v[j][3]); o8[64 * j] = w; } }
#pragma unroll 1
            for (int i = 0; i < 16; ++i) { const float v = __shfl(keep, i); if (lane < 16) ssq0[(size_t)(mb + i) * 16 + lane] = lane == 0 ? v : 0.f; }
        }
    }
    {
        float* LB = (float*)(ws + WS_LB);
        for (int c = gt; c < 256; c += NGT) {
            const float a0 = p.in[I_LBL][c], a1 = p.in[I_LBL][256 + c], a2 = p.in[I_LBL][512 + c], a3 = p.in[I_LBL][768 + c];
            const float mx = fmaxf(fmaxf(a0, a1), fmaxf(a2, a3));
            const float e0 = expf(a0 - mx), e1 = expf(a1 - mx), e2 = expf(a2 - mx), e3 = expf(a3 - mx); const float inv = 1.f / (e0 + e1 + e2 + e3);
            const float s1 = e1 * inv, s2 = e2 * inv, s3 = e3 * inv; const float hi = 1.0f - 1e-6f;
            LB[c] = 0.f; LB[256 + c] = fminf(fmaxf(s1, 0.f), hi); LB[512 + c] = fminf(fmaxf(s1 + s2, 0.f), hi); LB[768 + c] = fminf(fmaxf(s1 + s2 + s3, 0.f), hi);
        }
        float* BT = (float*)(ws + WS_BIAS);
        for (int i = gt; i < 3 * 4 * 132; i += NGT) {
            const int pt = i / (4 * 132), hd = (i / 132) % 4, dl = i % 132; const int dil = pt == 0 ? 1 : (pt == 1 ? 4 : 16);
            float v = 0.f;
            if (dl <= 128) { const int dist = dl * dil; int bk;
                if (dist < 16) bk = dist; else { bk = 16 + (int)(logf((float)dist / 16.0f) / 4.852030263919617f * 16.0f); if (bk > 31) bk = 31; }
                v = p.in[I_RB][bk * 4 + hd]; }
            BT[i] = v;
        }
    }
    {
        bf16_t* KT = (bf16_t*)(ws + WS_S5K); bf16_t* WS_ = (bf16_t*)(ws + WS_S5WS); bf16_t* WC = (bf16_t*)(ws + WS_S5WC);
        LAS float* ebr = scr; LAS float* ebi = scr + 64 * 17;
        for (int it = gw; it < NL * 16 * 64; it += NGW) {
            const int lg = it >> 6, d = it & 63;
            float lrdt, lidt, cr, ci; s5_params(p, lg, lane, lrdt, lidt, cr, ci);
            float er, ei; s5_pow(lrdt, lidt, d, er, ei);
            const float fr_ = er * cr - ei * ci, fi_ = er * ci + ei * cr;
            const float* br = p.in[I_BRE] + ((size_t)lg * 64 + lane) * 16; const float* bi = p.in[I_BIM] + ((size_t)lg * 64 + lane) * 16;
#pragma unroll
            for (int c = 0; c < 16; ++c) { const float b0 = br[c], b1 = bi[c]; ebr[lane * 17 + c] = fr_ * b0 - fi_ * b1; ebi[lane * 17 + c] = fr_ * b1 + fi_ * b0; }
            LDS_WAIT();
            const int co = lane & 15, cb = (lane >> 4) * 4;
            const float* crp = p.in[I_CRE] + ((size_t)lg * 16 + co) * 64; const float* cip = p.in[I_CIM] + ((size_t)lg * 16 + co) * 64;
            float a0 = 0.f, a1 = 0.f, a2 = 0.f, a3 = 0.f;
            for (int q = 0; q < 64; ++q) { const float c0 = crp[q], c1 = cip[q];
                a0 += c0 * ebr[q * 17 + cb + 0] - c1 * ebi[q * 17 + cb + 0]; a1 += c0 * ebr[q * 17 + cb + 1] - c1 * ebi[q * 17 + cb + 1];
                a2 += c0 * ebr[q * 17 + cb + 2] - c1 * ebi[q * 17 + cb + 2]; a3 += c0 * ebr[q * 17 + cb + 3] - c1 * ebi[q * 17 + cb + 3]; }
            u32x2 w; w.x = pk2(a0, a1); w.y = pk2(a2, a3);
            *(u32x2*)(KT + ((size_t)it * 16 + co) * 16 + cb) = w;
            LDS_WAIT();
        }
        for (int it = gw; it < NL * 16 * 16; it += NGW) {
            const int lg = it >> 4, s4 = it & 15;
            float lrdt, lidt, cr, ci; s5_params(p, lg, lane, lrdt, lidt, cr, ci);
            const float* br = p.in[I_BRE] + ((size_t)lg * 64 + lane) * 16; const float* bi = p.in[I_BIM] + ((size_t)lg * 64 + lane) * 16;
            float b0[16], b1[16];
#pragma unroll
            for (int c = 0; c < 16; ++c) { b0[c] = br[c]; b1[c] = bi[c]; }
#pragma unroll 1
            for (int sq = 0; sq < 4; ++sq) { const int s = s4 * 4 + sq;
                float er, ei; s5_pow(lrdt, lidt, 63 - s, er, ei);
                const float fr_ = er * cr - ei * ci, fi_ = er * ci + ei * cr;
                float vr[16], vi[16];
#pragma unroll
                for (int c = 0; c < 16; ++c) { vr[c] = fr_ * b0[c] - fi_ * b1[c]; vi[c] = fr_ * b1[c] + fi_ * b0[c]; }
                bf16_t* o0 = WS_ + ((size_t)lg * 128 + lane) * 1024 + s * 16; bf16_t* o1 = WS_ + ((size_t)lg * 128 + 64 + lane) * 1024 + s * 16;
                u32x4 w;
                w.x = pk2(vr[0], vr[1]); w.y = pk2(vr[2], vr[3]); w.z = pk2(vr[4], vr[5]); w.w = pk2(vr[6], vr[7]); *(u32x4*)o0 = w;
                w.x = pk2(vr[8], vr[9]); w.y = pk2(vr[10], vr[11]); w.z = pk2(vr[12], vr[13]); w.w = pk2(vr[14], vr[15]); *(u32x4*)(o0 + 8) = w;
                w.x = pk2(vi[0], vi[1]); w.y = pk2(vi[2], vi[3]); w.z = pk2(vi[4], vi[5]); w.w = pk2(vi[6], vi[7]); *(u32x4*)o1 = w;
                w.x = pk2(vi[8], vi[9]); w.y = pk2(vi[10], vi[11]); w.z = pk2(vi[12], vi[13]); w.w = pk2(vi[14], vi[15]); *(u32x4*)(o1 + 8) = w; }
        }
        for (int it = gw; it < NL * 16 * 64; it += NGW) {
            const int lg = it >> 6, tl = it & 63;
            float lrdt, lidt, cr, ci; s5_params(p, lg, lane, lrdt, lidt, cr, ci);
            float er, ei; s5_pow(lrdt, lidt, tl + 1, er, ei);
#pragma unroll 4
            for (int co = 0; co < 16; ++co) { const float c0 = p.in[I_CRE][((size_t)lg * 16 + co) * 64 + lane], c1 = p.in[I_CIM][((size_t)lg * 16 + co) * 64 + lane];
                bf16_t* o = WC + (((size_t)lg * 64 + tl) * 16 + co) * 128;
                o[lane] = (bf16_t)f2bf(c0 * er - c1 * ei); o[64 + lane] = (bf16_t)f2bf(-(c0 * ei + c1 * er)); }
        }
    }
}

template <bool OUT>
DI void hgrn_item(const Params& p, LAS unsigned char* lds, int l, int cg) {
    int tid_o = threadIdx.x; asm volatile("" : "+v"(tid_o));
    const int tid = tid_o, lane = tid & 63, wave = tid >> 6, hd = wave >> 1, half = wave & 1;
    const bf16_t* Z = (const bf16_t*)(p.ws + WS_Z);
    LAS bf16_t* B0 = (LAS bf16_t*)(lds + hd * 27648); LAS bf16_t* B1 = B0 + 64 * 72; LAS bf16_t* B2 = B1 + 64 * 72;
    LAS float* GM = (LAS float*)(lds + 114688) + hd * 64; LAS float* GL = GM + 256; LAS float* SSA = (LAS float*)(lds + 114688) + 512;
    bf16_t* SL = (bf16_t*)(p.ws + WS_SL); const bf16_t* SL2 = (const bf16_t*)(p.ws + WS_SL2); float* DEC = (float*)(p.ws + WS_DEC);
    const int item = cg * 4 + hd;
#ifdef FORCE_LB0
    const float lb = 0.f, oml = 1.f;
#else
    const float lb = ((const float*)(p.ws + WS_LB))[l * 256 + hd * 64 + lane], oml = 1.f - lb;
#endif
    const int srow = tid >> 5, shd = (tid >> 3) & 3, spc = tid & 7;
    const bf16_t* zsrc = Z + (size_t)(cg * 64 + srow) * DIN + shd * 64 + spc * 8;
    const int sdst = shd * 27648 + (srow * 72 + spc * 8) * 2;
    __syncthreads();
    { u32x4 wf[4], wi[4], wq[4];
#pragma unroll
      for (int sub = 0; sub < 4; ++sub) { wf[sub] = *(const u32x4*)(zsrc + (size_t)(16 * sub) * DIN + ZF); wi[sub] = *(const u32x4*)(zsrc + (size_t)(16 * sub) * DIN + ZI);
          if (OUT) wq[sub] = *(const u32x4*)(zsrc + (size_t)(16 * sub) * DIN + ZQ); }
#pragma unroll
      for (int sub = 0; sub < 4; ++sub) { *(LAS u32x4*)(lds + sdst + 9216 + sub * 16 * 144) = wf[sub]; *(LAS u32x4*)(lds + sdst + 18432 + sub * 16 * 144) = wi[sub];
          if (OUT) *(LAS u32x4*)(lds + sdst + sub * 16 * 144) = wq[sub]; } }
    __syncthreads();
    float g[32]; float run = 0.f;
#pragma unroll
    for (int j = 0; j < 32; ++j) { const float fz = bf2f(B1[(half * 32 + j) * 72 + lane]); const float sg = sigmoidf_(fz); const float f = lb + oml * sg;
        run += __logf(fmaxf(f, 1e-30f)); g[j] = run; }
    if (half == 0) GM[lane] = run;
    __syncthreads();
    const float gm = GM[lane];
    if (half) {
#pragma unroll
        for (int j = 0; j < 32; ++j) g[j] += gm; }
    const int c0 = lane & 31, h = lane >> 5;
    if constexpr (!OUT) {
        if (half) GL[lane] = run + gm;
        __syncthreads();
        const float gl = GL[lane];
        bf16_t kv[32], ivr[32];
#pragma unroll
        for (int j = 0; j < 32; ++j) { const int t = half * 32 + j; const float e = __expf(gl - g[j]); const float kj = oml * (1.f - sigmoidf_(bf2f(B1[t * 72 + lane])));
            kv[j] = (bf16_t)f2bf(kj * e); ivr[j] = B2[t * 72 + lane]; }
        __syncthreads();
#pragma unroll
        for (int j = 0; j < 32; ++j) { const int t = half * 32 + j; B1[lane * 72 + t] = kv[j]; B2[lane * 72 + t] = ivr[j]; }
        __syncthreads();
#pragma unroll
        for (int kt = 0; kt < 2; ++kt) { const f32x16 a = mma_lds<64>(B2 + 32 * half * 72, 72, B1 + 32 * kt * 72, 72, zero16(), lane);
#pragma unroll
            for (int i = 0; i < 16; ++i) SL[(size_t)item * 4096 + (32 * half + crow(i, h)) * 64 + 32 * kt + c0] = (bf16_t)f2bf(a[i]); }
        if (half == 0) DEC[item * 64 + lane] = __expf(gl);
    } else {
        if (half == 0) GL[lane] = __expf(gm);
        bf16_t ivr[32];
#pragma unroll
        for (int j = 0; j < 32; ++j) { const int t = half * 32 + j; const float q = bf2f(B0[t * 72 + lane]); const float kj = oml * (1.f - sigmoidf_(bf2f(B1[t * 72 + lane])));
            const float e1 = __expf(fminf(g[j] - gm, 80.f)), e2 = __expf(fminf(gm - g[j], 80.f));
            ivr[j] = B2[t * 72 + lane];
            B0[t * 72 + lane] = (bf16_t)f2bf(q * e1); B1[t * 72 + lane] = (bf16_t)f2bf(kj * e2); }
        __syncthreads();
#pragma unroll
        for (int j = 0; j < 32; ++j) B2[lane * 72 + half * 32 + j] = ivr[j];
        __syncthreads();
        f32x16 s0 = mma_lds<64>(B0 + 32 * half * 72, 72, B1, 72, zero16(), lane);
        f32x16 s1 = zero16(); if (half) s1 = mma_lds<64>(B0 + 32 * half * 72, 72, B1 + 32 * 72, 72, zero16(), lane);
        __syncthreads();
#pragma unroll
        for (int i = 0; i < 16; ++i) { const int row = 32 * half + crow(i, h);
            B1[row * 72 + c0] = (bf16_t)f2bf(c0 <= row ? s0[i] : 0.f); B1[row * 72 + 32 + c0] = (bf16_t)f2bf(32 + c0 <= row ? s1[i] : 0.f); }
        __syncthreads();
        f32x16 o0 = mma_lds<64>(B1 + 32 * half * 72, 72, B2, 72, zero16(), lane);
        f32x16 o1 = mma_lds<64>(B1 + 32 * half * 72, 72, B2 + 32 * 72, 72, zero16(), lane);
        __syncthreads();
        {
          u32x4 wsl[4], wg[4];
          const bf16_t* sp = SL2 + (size_t)item * 4096 + (32 * half) * 64;
#pragma unroll
          for (int e = 0; e < 4; ++e) { const int pc = lane + 64 * e; wsl[e] = *(const u32x4*)(sp + pc * 8); wg[e] = *(const u32x4*)(zsrc + (size_t)(16 * e) * DIN + ZG); }
#pragma unroll
          for (int e = 0; e < 4; ++e) { const int pc = lane + 64 * e, row = pc >> 3, k0 = (pc & 7) * 8; const LAS float* eg = GL + k0;
              u32x4 o; o.x = pk2(bflo(wsl[e].x) * eg[0], bfhi(wsl[e].x) * eg[1]); o.y = pk2(bflo(wsl[e].y) * eg[2], bfhi(wsl[e].y) * eg[3]);
              o.z = pk2(bflo(wsl[e].z) * eg[4], bfhi(wsl[e].z) * eg[5]); o.w = pk2(bflo(wsl[e].w) * eg[6], bfhi(wsl[e].w) * eg[7]);
              *(LAS u32x4*)(B2 + (32 * half + row) * 72 + k0) = o;
              *(LAS u32x4*)(lds + sdst + 9216 + e * 16 * 144) = wg[e]; } }
        __syncthreads();
        o0 = mma_lds<64>(B0 + 32 * half * 72, 72, B2, 72, o0, lane);
        o1 = mma_lds<64>(B0 + 32 * half * 72, 72, B2 + 32 * 72, 72, o1, lane);
        const float* ng = p.in[I_HNG] + l * 256 + hd * 64; const float ng0 = ng[c0], ng1 = ng[32 + c0];
#pragma unroll
        for (int i = 0; i < 16; ++i) { const int row = 32 * half + crow(i, h);
            const float ss = half_sum(o0[i] * o0[i] + o1[i] * o1[i]); const float rs = rsqrtf(ss * (1.0f / 64.0f) + EPS);
            const float g0 = bf2f(B1[row * 72 + c0]), g1 = bf2f(B1[row * 72 + 32 + c0]);
            const float v0 = o0[i] * rs * ng0 * g0 * sigmoidf_(g0), v1 = o1[i] * rs * ng1 * g1 * sigmoidf_(g1);
            o0[i] = v0; o1[i] = v1; const float s2 = half_sum(v0 * v0 + v1 * v1); if (c0 == 0) SSA[hd * 64 + row] = s2; }
        __syncthreads();
        bf16_t* Y = (bf16_t*)(p.ws + WS_YCAT);
#pragma unroll
        for (int i = 0; i < 16; ++i) { const int row = 32 * half + crow(i, h); const size_t tok = (size_t)cg * 64 + row;
            const float tot = (SSA[row] + SSA[64 + row]) + (SSA[128 + row] + SSA[192 + row]); const float r2 = rsqrtf(tot * (1.0f / 256.0f) + EPS);
            Y[tok * D + YA + hd * 64 + c0] = (bf16_t)f2bf(o0[i] * r2); Y[tok * D + YA + hd * 64 + 32 + c0] = (bf16_t)f2bf(o1[i] * r2); }
    }
}
DI void hgrn_scan_item(const Params& p, int hb) {
    int tid_o = threadIdx.x; asm volatile("" : "+v"(tid_o));
    const int e = hb * 512 + tid_o, bh = e >> 12, b = bh >> 2, hd = bh & 3, vk = e & 4095, k = vk & 63;
    const bf16_t* SL = (const bf16_t*)(p.ws + WS_SL); bf16_t* SL2 = (bf16_t*)(p.ws + WS_SL2); const float* DEC = (const float*)(p.ws + WS_DEC);
    float st = 0.f;
    for (int c8 = 0; c8 < 128; c8 += 8) { float tmp[8], dc[8];
#pragma unroll
        for (int u = 0; u < 8; ++u) { const int item = (b * 128 + c8 + u) * 4 + hd; tmp[u] = bf2f(SL[(size_t)item * 4096 + vk]); dc[u] = DEC[item * 64 + k]; }
#pragma unroll
        for (int u = 0; u < 8; ++u) { const int item = (b * 128 + c8 + u) * 4 + hd; SL2[(size_t)item * 4096 + vk] = (bf16_t)f2bf(st); st = dc[u] * st + tmp[u]; } }
}

DI void conv_item(const Params& p, LAS unsigned char* lds, int l, int ti) {
    int tid_o = threadIdx.x; asm volatile("" : "+v"(tid_o));
    const int tid = tid_o, lane = tid & 63, wave = tid >> 6, c = tid & 255, hf = tid >> 8, wv = wave & 3;
    LAS float* Hs = (LAS float*)lds; LAS float* ST = (LAS float*)(lds + 98304); LAS float* ST2 = ST + 512;
    const bf16_t* Z = (const bf16_t*)(p.ws + WS_Z); bf16_t* Y = (bf16_t*)(p.ws + WS_YCAT);
    const int tok0 = ti * 64, pos0 = (ti & 127) * 64;
    __syncthreads();
    for (int it0 = 0; it0 < 48; it0 += 8) { bf16_t vv[8], gg[8];
#pragma unroll
        for (int e = 0; e < 8; ++e) { const int row = 2 * (it0 + e) + hf, pos = pos0 - 30 + row; const bool ok = (row < 94) && (pos >= 0);
            const size_t tok = ok ? (size_t)(tok0 - 30 + row) : (size_t)tok0; vv[e] = Z[tok * DIN + ZBV + c]; gg[e] = Z[tok * DIN + ZBG + c]; }
#pragma unroll
        for (int e = 0; e < 8; ++e) { const int row = 2 * (it0 + e) + hf, pos = pos0 - 30 + row; const bool ok = (row < 94) && (pos >= 0);
            if (row < 94) Hs[row * 256 + c] = ok ? bf2f(vv[e]) * sigmoidf_(bf2f(gg[e])) : 0.f; } }
    __syncthreads();
    const float* cw = p.in[I_CW] + (size_t)l * 31 * 256 + c; float w[31];
#pragma unroll
    for (int jj = 0; jj < 31; ++jj) w[jj] = cw[jj * 256];
    const float cb = p.in[I_CB][l * 256 + c];
    const float lng = p.in[I_CLG][l * 256 + c], lnb = p.in[I_CLB][l * 256 + c];
#pragma unroll 1
    for (int ps = 0; ps < 2; ++ps) { const int tb = hf * 32 + ps * 16;
        float o[16];
        { float hr[46];
#pragma unroll
          for (int r = 0; r < 46; ++r) hr[r] = Hs[(tb + r) * 256 + c];
#pragma unroll
          for (int j = 0; j < 16; ++j) { float a = cb;
#pragma unroll
            for (int jj = 0; jj < 31; ++jj) a += w[jj] * hr[j + jj];
            o[j] = a; } }
#pragma unroll
        for (int j = 0; j < 16; ++j) { const float s1 = wave_sum(o[j]), s2 = wave_sum(o[j] * o[j]); if (lane == 0) { ST[((tb + j) * 4 + wv) * 2] = s1; ST[((tb + j) * 4 + wv) * 2 + 1] = s2; } }
        __syncthreads();
#pragma unroll
        for (int j = 0; j < 16; ++j) { const LAS float* q = ST + (tb + j) * 8; const float s1 = (q[0] + q[2]) + (q[4] + q[6]), s2 = (q[1] + q[3]) + (q[5] + q[7]);
            const float mu = s1 * (1.0f / 256.0f); const float var = fmaxf(s2 * (1.0f / 256.0f) - mu * mu, 0.f);
            const float y = (o[j] - mu) * rsqrtf(var + EPS) * lng + lnb; const float sv = y * sigmoidf_(y); o[j] = sv;
            const float s3 = wave_sum(sv * sv); if (lane == 0) ST2[(tb + j) * 4 + wv] = s3; }
        __syncthreads();
#pragma unroll
        for (int j = 0; j < 16; ++j) { const LAS float* q = ST2 + (tb + j) * 4; const float tot = (q[0] + q[1]) + (q[2] + q[3]); const float rs = rsqrtf(tot * (1.0f / 256.0f) + EPS);
            Y[(size_t)(tok0 + tb + j) * D + YB + c] = (bf16_t)f2bf(o[j] * rs); }
    }
}

DI bf16x8 ldg8(const bf16_t* p) { return *(const bf16x8*)p; }
DI void s5_local_item(const Params& p, int l, int bi) {
    int tid_o = threadIdx.x; asm volatile("" : "+v"(tid_o));
    const int lane = tid_o & 63, wi = bi * 8 + (tid_o >> 6);
    const int g = wi & 15, cb = (wi >> 4) & 15, pt = wi >> 8, c0 = lane & 31, h = lane >> 5;
    const bf16_t* ua = (const bf16_t*)(p.ws + WS_Z) + (size_t)((cb * 32 + c0) * 64) * DIN + ZCU + g * 16 + 8 * h;
    const bf16_t* wb = (const bf16_t*)(p.ws + WS_S5WS) + ((size_t)(l * 16 + g) * 128 + pt * 32 + c0) * 1024 + 8 * h;
    f32x16 acc = zero16();
#pragma unroll 8
    for (int s = 0; s < 64; ++s) acc = __builtin_amdgcn_mfma_f32_32x32x16_bf16(ldg8(ua + (size_t)s * DIN), ldg8(wb + s * 16), acc, 0, 0, 0);
    float* HL = (float*)(p.ws + WS_S5H);
#pragma unroll
    for (int i = 0; i < 16; ++i) HL[((size_t)(cb * 32 + crow(i, h)) * 16 + g) * 128 + pt * 32 + c0] = acc[i];
}
DI void s5_scan_item(const Params& p, int l, int sb) {
    int tid_o = threadIdx.x; asm volatile("" : "+v"(tid_o));
    const int e = sb * 512 + tid_o, b = e >> 10, g = (e >> 6) & 15, pp = e & 63;
    float lrdt, lidt, cr, ci; s5_params(p, l * 16 + g, pp, lrdt, lidt, cr, ci);
    float ar, ai; s5_pow(lrdt, lidt, 64, ar, ai);
    const float* HL = (const float*)(p.ws + WS_S5H); float* HO = (float*)(p.ws + WS_S5H2); float hr = 0.f, hi = 0.f;
    for (int c8 = 0; c8 < 128; c8 += 8) { float tr[8], ti[8];
#pragma unroll
        for (int u = 0; u < 8; ++u) { const size_t idx = ((size_t)(b * 128 + c8 + u) * 16 + g) * 128; tr[u] = HL[idx + pp]; ti[u] = HL[idx + 64 + pp]; }
#pragma unroll
        for (int u = 0; u < 8; ++u) { const size_t idx = ((size_t)(b * 128 + c8 + u) * 16 + g) * 128; HO[idx + pp] = hr; HO[idx + 64 + pp] = hi;
            const float nr = ar * hr - ai * hi + tr[u], ni = ar * hi + ai * hr + ti[u]; hr = nr; hi = ni; } }
}
DI void s5_out_item(const Params& p, LAS unsigned char* lds, int l, int bi) {
    int tid_o = threadIdx.x; asm volatile("" : "+v"(tid_o));
    const int tid = tid_o, lane = tid & 63, wave = tid >> 6;
    const int gh = bi & 1, cb = (bi >> 1) & 15, pr = bi >> 5, g = gh * 8 + wave, c0 = lane & 31, h = lane >> 5, lg = l * 16 + g;
    LAS bf16_t* OT = (LAS bf16_t*)lds;
    const bf16_t* Z = (const bf16_t*)(p.ws + WS_Z);
    const bf16_t* ua = Z + (size_t)((cb * 32 + c0) * 64) * DIN + ZCU + g * 16 + 8 * h;
    const bf16_t* kt = (const bf16_t*)(p.ws + WS_S5K) + (size_t)lg * 64 * 256;
    const float* ha = (const float*)(p.ws + WS_S5H2) + ((size_t)(cb * 32 + c0) * 16 + g) * 128 + 8 * h;
    const int co = c0 & 15; const float dsk = p.in[I_S5D][l * 256 + g * 16 + co];
    __syncthreads();
    for (int q = 0; q < 2; ++q) { const int jt = q ? 31 - pr : pr; const int tl = 2 * jt + (c0 >> 4);
        f32x16 acc = zero16();
        const bf16_t* wc = (const bf16_t*)(p.ws + WS_S5WC) + (((size_t)lg * 64 + tl) * 16 + co) * 128 + 8 * h;
        { f32x4 x0[8], x1[8]; bf16x8 wv[8];
#pragma unroll
          for (int ks = 0; ks < 8; ++ks) { x0[ks] = *(const f32x4*)(ha + ks * 16); x1[ks] = *(const f32x4*)(ha + ks * 16 + 4); wv[ks] = ldg8(wc + ks * 16); }
#pragma unroll
          for (int ks = 0; ks < 8; ++ks) { u32x4 w; w.x = pk2(x0[ks][0], x0[ks][1]); w.y = pk2(x0[ks][2], x0[ks][3]); w.z = pk2(x1[ks][0], x1[ks][1]); w.w = pk2(x1[ks][2], x1[ks][3]);
            acc = __builtin_amdgcn_mfma_f32_32x32x16_bf16(__builtin_bit_cast(bf16x8, w), wv[ks], acc, 0, 0, 0); } }
        const int ns = (2 * jt + 2 + 7) & ~7;
        for (int s0 = 0; s0 < ns; s0 += 8) { bf16x8 av[8], bv[8];
#pragma unroll
            for (int e = 0; e < 8; ++e) { const int s = s0 + e, d = tl - s, dc = d < 0 ? 0 : d;
                av[e] = ldg8(ua + (size_t)s * DIN); bv[e] = ldg8(kt + ((size_t)dc * 16 + co) * 16 + 8 * h); }
#pragma unroll
            for (int e = 0; e < 8; ++e) { const int d = tl - (s0 + e); bf16x8 b = bv[e]; if (d < 0) b = (bf16x8){0, 0, 0, 0, 0, 0, 0, 0};
                acc = __builtin_amdgcn_mfma_f32_32x32x16_bf16(av[e], b, acc, 0, 0, 0); } }
#pragma unroll
        for (int i = 0; i < 16; ++i) { const int m = crow(i, h); const size_t tok = (size_t)(cb * 32 + m) * 64 + tl; const float u = bf2f(Z[tok * DIN + ZCU + g * 16 + co]);
            const float y = acc[i] + dsk * u; const float ge = y * sigmoidf_(1.5957691216057308f * (y + 0.044715f * y * y * y));
            OT[(q * 64 + m * 2 + (c0 >> 4)) * 136 + wave * 16 + co] = (bf16_t)f2bf(ge); }
    }
    __syncthreads();
    { const int tau = tid >> 2, qq = tau >> 6, m = (tau >> 1) & 31, t2 = tau & 1, qt = tid & 3; const int jt = qq ? 31 - pr : pr;
      const size_t tok = (size_t)(cb * 32 + m) * 64 + 2 * jt + t2;
      const LAS u32x4* src = (const LAS u32x4*)(OT + tau * 136 + qt * 32); u32x4* dst = (u32x4*)((bf16_t*)(p.ws + WS_YPRE) + tok * 256 + gh * 128 + qt * 32);
#pragma unroll
      for (int e = 0; e < 4; ++e) dst[e] = src[e]; }
}

DI void attn_item(const Params& p, LAS unsigned char* lds, int l, int pt, int id) {
    int tid_o = threadIdx.x; asm volatile("" : "+v"(tid_o));
    const int tid = tid_o, lane = tid & 63, wave = tid >> 6;
    const int dil = pt == 0 ? 1 : (pt == 1 ? 4 : 16), nblk = 32 / dil;
    const int b = id >> 7, hd = (id >> 5) & 3, rn = id & 31, r = rn / nblk, n = rn % nblk;
    LAS bf16_t* Ks = (LAS bf16_t*)lds;
    LAS bf16_t* Vt = (LAS bf16_t*)(lds + 55296);
    LAS float* BT = (LAS float*)(lds + 55296 + 50176);
    const bf16_t* Z = (const bf16_t*)(p.ws + WS_Z);
    const bf16_t* OP = (const bf16_t*)(p.ws + (pt == 1 ? WS_O0 : WS_O1)); const float* LP = (const float*)(p.ws + (pt == 1 ? WS_LSE : WS_LSE1));
    bf16_t* ON = pt == 2 ? (bf16_t*)(p.ws + WS_Z) + ZOD : (bf16_t*)(p.ws + (pt == 0 ? WS_O0 : WS_O1)); const int onp = pt == 2 ? DIN : 256;
    float* LN = (float*)(p.ws + (pt == 0 ? WS_LSE : WS_LSE1));
    const size_t tokb = (size_t)b * SEQ;
    __syncthreads();
    if (tid < 132) BT[tid] = ((const float*)(p.ws + WS_BIAS))[(pt * 4 + hd) * 132 + tid];
    { const float* kg = p.in[I_KG] + l * 64 + (tid & 7) * 8; float kgv[8];
#pragma unroll
      for (int e = 0; e < 8; ++e) kgv[e] = kg[e];
      for (int it = 0; it < 6; ++it) { const int idx = tid + 512 * it, row = idx >> 3, c = idx & 7, si = n * 256 - 128 + row;
        u32x4 kw = (u32x4){0u, 0u, 0u, 0u}, vw = (u32x4){0u, 0u, 0u, 0u};
        if (si >= 0) { const size_t tok = tokb + (size_t)si * dil + r; kw = *(const u32x4*)(Z + tok * DIN + ZDK + hd * 64 + c * 8); vw = *(const u32x4*)(Z + tok * DIN + ZDV + hd * 64 + c * 8); }
        float kf[8]; kf[0] = bflo(kw.x); kf[1] = bfhi(kw.x); kf[2] = bflo(kw.y); kf[3] = bfhi(kw.y); kf[4] = bflo(kw.z); kf[5] = bfhi(kw.z); kf[6] = bflo(kw.w); kf[7] = bfhi(kw.w);
        float ss = 0.f;
#pragma unroll
        for (int e = 0; e < 8; ++e) ss += kf[e] * kf[e];
        ss += __shfl_xor(ss, 1); ss += __shfl_xor(ss, 2); ss += __shfl_xor(ss, 4);
        const float rs = rsqrtf(ss * (1.0f / 64.0f) + EPS);
        u32x4 o; o.x = pk2(kf[0] * rs * kgv[0], kf[1] * rs * kgv[1]); o.y = pk2(kf[2] * rs * kgv[2], kf[3] * rs * kgv[3]); o.z = pk2(kf[4] * rs * kgv[4], kf[5] * rs * kgv[5]); o.w = pk2(kf[6] * rs * kgv[6], kf[7] * rs * kgv[7]);
        *(LAS u32x4*)(Ks + row * 72 + c * 8) = o;
        LAS bf16_t* vp = Vt + (c * 8) * 392 + row;
        vp[0 * 392] = (bf16_t)(vw.x & 0xffffu); vp[1 * 392] = (bf16_t)(vw.x >> 16); vp[2 * 392] = (bf16_t)(vw.y & 0xffffu); vp[3 * 392] = (bf16_t)(vw.y >> 16);
        vp[4 * 392] = (bf16_t)(vw.z & 0xffffu); vp[5 * 392] = (bf16_t)(vw.z >> 16); vp[6 * 392] = (bf16_t)(vw.w & 0xffffu); vp[7 * 392] = (bf16_t)(vw.w >> 16); } }
    __syncthreads();
    const int c0 = lane & 31, h = lane >> 5;
    const int qi = 32 * wave + c0; const size_t tokq = tokb + (size_t)(n * 256 + qi) * dil + r;
    bf16x8 qf[4];
    { float qv[4][8]; float ss = 0.f;
#pragma unroll
      for (int ks = 0; ks < 4; ++ks) { const u32x4 w = *(const u32x4*)(Z + tokq * DIN + ZDQ + hd * 64 + ks * 16 + 8 * h);
        qv[ks][0] = bflo(w.x); qv[ks][1] = bfhi(w.x); qv[ks][2] = bflo(w.y); qv[ks][3] = bfhi(w.y); qv[ks][4] = bflo(w.z); qv[ks][5] = bfhi(w.z); qv[ks][6] = bflo(w.w); qv[ks][7] = bfhi(w.w);
#pragma unroll
        for (int e = 0; e < 8; ++e) ss += qv[ks][e] * qv[ks][e]; }
      ss += __shfl_xor(ss, 32);
      const float rs = rsqrtf(ss * (1.0f / 64.0f) + EPS) * 0.125f;
#pragma unroll
      for (int ks = 0; ks < 4; ++ks) { const float* qg = p.in[I_QG] + l * 64 + ks * 16 + 8 * h; const f32x4 g0 = *(const f32x4*)qg, g1 = *(const f32x4*)(qg + 4);
        u32x4 w; w.x = pk2(qv[ks][0] * rs * g0[0], qv[ks][1] * rs * g0[1]); w.y = pk2(qv[ks][2] * rs * g0[2], qv[ks][3] * rs * g0[3]);
        w.z = pk2(qv[ks][4] * rs * g1[0], qv[ks][5] * rs * g1[1]); w.w = pk2(qv[ks][6] * rs * g1[2], qv[ks][7] * rs * g1[3]);
        qf[ks] = __builtin_bit_cast(bf16x8, w); } }
    f32x16 acc[5];
#pragma unroll
    for (int c = 0; c < 5; ++c) { acc[c] = zero16(); const LAS bf16_t* kb = Ks + (32 * wave + 32 * c + c0) * 72 + 8 * h;
#pragma unroll
        for (int ks = 0; ks < 4; ++ks) acc[c] = __builtin_amdgcn_mfma_f32_32x32x16_bf16(*(const LAS bf16x8*)(kb + ks * 16), qf[ks], acc[c], 0, 0, 0); }
    float mx = -1e30f;
#pragma unroll
    for (int c = 0; c < 5; ++c)
#pragma unroll
        for (int i = 0; i < 16; ++i) { const int kr = crow(i, h); const int delta = 128 + c0 - 32 * c - kr; const int jl = 32 * wave + 32 * c + kr;
            const bool valid = (delta >= 0) && (delta <= 128) && (n * 256 - 128 + jl >= 0);
            const int dcl = delta < 0 ? 0 : (delta > 128 ? 128 : delta);
            const float lgt = valid ? acc[c][i] + BT[dcl] : -1e30f; acc[c][i] = lgt; mx = fmaxf(mx, lgt); }
    mx = fmaxf(mx, __shfl_xor(mx, 32));
    float mprev = 0.f, mnew = mx;
    if (pt > 0) { mprev = LP[tokq * 4 + hd]; mnew = fmaxf(mx, mprev); }
    float lsum = 0.f;
#pragma unroll
    for (int c = 0; c < 5; ++c)
#pragma unroll
        for (int i = 0; i < 16; ++i) { const float pv = __expf(acc[c][i] - mnew); acc[c][i] = pv; lsum += pv; }
    lsum += __shfl_xor(lsum, 32);
    f32x16 o[2]; o[0] = zero16(); o[1] = zero16();
#pragma unroll
    for (int c = 0; c < 5; ++c)
#pragma unroll
        for (int s = 0; s < 2; ++s) { u32x4 pw; pw.x = pk2(acc[c][8 * s + 0], acc[c][8 * s + 1]); pw.y = pk2(acc[c][8 * s + 2], acc[c][8 * s + 3]); pw.z = pk2(acc[c][8 * s + 4], acc[c][8 * s + 5]); pw.w = pk2(acc[c][8 * s + 6], acc[c][8 * s + 7]);
            const bf16x8 pf = __builtin_bit_cast(bf16x8, pw);
#pragma unroll
            for (int vt = 0; vt < 2; ++vt) { const LAS bf16_t* va = Vt + (32 * vt + c0) * 392 + 32 * wave + 32 * c + 16 * s + 4 * h;
                const s16x4 lo = *(const LAS s16x4*)va, hi = *(const LAS s16x4*)(va + 8);
                const bf16x8 vf = __builtin_shufflevector(lo, hi, 0, 1, 2, 3, 4, 5, 6, 7);
                o[vt] = __builtin_amdgcn_mfma_f32_32x32x16_bf16(vf, pf, o[vt], 0, 0, 0); } }
    float sp = 0.f; if (pt > 0) sp = __expf(mprev - mnew);
    const float ltot = lsum + sp, inv = 1.0f / ltot;
#pragma unroll
    for (int vt = 0; vt < 2; ++vt)
#pragma unroll
        for (int g4 = 0; g4 < 4; ++g4) { const int ch = hd * 64 + 32 * vt + 8 * g4 + 4 * h; bf16_t* yo = ON + tokq * onp + ch;
            float v0 = o[vt][4 * g4 + 0], v1 = o[vt][4 * g4 + 1], v2 = o[vt][4 * g4 + 2], v3 = o[vt][4 * g4 + 3];
            if (pt > 0) { const u32x2 w = *(const u32x2*)(OP + tokq * 256 + ch); v0 += sp * bflo(w.x); v1 += sp * bfhi(w.x); v2 += sp * bflo(w.y); v3 += sp * bfhi(w.y); }
            u32x2 w; w.x = pk2(v0 * inv, v1 * inv); w.y = pk2(v2 * inv, v3 * inv); *(u32x2*)yo = w; }
    if (h == 0 && pt < 2) __hip_atomic_store(LN + tokq * 4 + hd, mnew + __logf(ltot), __ATOMIC_RELAXED, __HIP_MEMORY_SCOPE_AGENT);
}

#ifndef MIX_A
#define MIX_A 1
#endif
#ifndef MIX_B
#define MIX_B 1
#endif
#ifndef MIX_C
#define MIX_C 1
#endif
#ifndef MIX_D
#define MIX_D 1
#endif
__global__ void __launch_bounds__(512, 2) hybrid_fwd(Params p) {
    extern __shared__ __attribute__((aligned(16))) unsigned char lds_raw[];
    LAS unsigned char* lds = (LAS unsigned char*)lds_raw;
    cg::grid_group grid = cg::this_grid();
    const int G = gridDim.x, bid = blockIdx.x;
    unsigned char* ws = p.ws;
    bf16_t* XB = (bf16_t*)(ws + WS_XB); bf16_t* Zb = (bf16_t*)(ws + WS_Z); bf16_t* YC_ = (bf16_t*)(ws + WS_YCAT); bf16_t* HM = (bf16_t*)(ws + WS_HM);
    float* SSQP = (float*)(ws + WS_SSQP);

#define GRID_SYNC() do { asm volatile("s_waitcnt vmcnt(0) lgkmcnt(0)" ::: "memory"); __syncthreads(); grid.sync(); if (threadIdx.x < 64) { __builtin_amdgcn_fence(__ATOMIC_ACQUIRE, "agent"); asm volatile("s_waitcnt vmcnt(0)" ::: "memory"); } __syncthreads(); } while (0)
    prologue(p, lds, G);
#ifdef NANFILL
    { u32x4* q = (u32x4*)(ws + WS_S5H); const size_t n16 = (WS_END - WS_S5H) / 16; const u32x4 nanv = (u32x4){0xffffffffu, 0xffffffffu, 0xffffffffu, 0xffffffffu};
      for (size_t i = (size_t)bid * 512 + threadIdx.x; i < n16; i += (size_t)G * 512) q[i] = nanv;
      u32x4* q2 = (u32x4*)(ws + WS_LSE); const size_t m16 = (WS_S5K - WS_LSE) / 16;
      for (size_t i = (size_t)bid * 512 + threadIdx.x; i < m16; i += (size_t)G * 512) q2[i] = nanv; }
#endif
    GRID_SYNC();

#ifndef NL_RUN
#define NL_RUN NL
#endif
#ifndef DUMP_LAYER
#define DUMP_LAYER 0
#endif
    for (int lrun = 0; lrun < NL_RUN; ++lrun) {
#ifdef SAME_LAYER
        const int l = 0; const bool firstl = (lrun == 0), lastl = (lrun == NL_RUN - 1);
#else
        const int l = lrun; const bool firstl = (lrun == 0), lastl = (lrun == NL_RUN - 1);
#endif
        { pg8::Gemm g{XB, (const bf16_t*)(ws + WS_WIN) + (size_t)l * D * DIN, T, DIN, D, D}; pg8::StaticOrder S; S.init(T, DIN, G, bid);
          pg8::EpiScale E{Zb, DIN, SSQP, 0};
          pg8::gemm_phase<pg8::EpiScale, pg8::StaticOrder, true, true>(lds, g, S, E); }
        GRID_SYNC();
#ifndef SKIP_MIX
        if (!(MIX_A && MIX_B && MIX_C && MIX_D)) { int tq = threadIdx.x; asm volatile("" : "+v"(tq));
          for (int m = bid * 8 + (tq >> 6); m < T; m += G * 8) { u32x2* yp = (u32x2*)(YC_ + (size_t)m * D) + (tq & 63); const u32x2 z2 = (u32x2){0u, 0u};
              if (!MIX_A) yp[0] = z2; if (!MIX_B) yp[64] = z2; if (!MIX_C) yp[128] = z2; if (!MIX_D) yp[192] = z2; } }
#ifndef MIX_REPEAT
#define MIX_REPEAT 1
#endif
        for (int rep = 0; rep < MIX_REPEAT; ++rep) {
        for (int it = bid; it < 1664; it += G) {
            if (it < 512) { if (MIX_A) hgrn_item<false>(p, lds, l, it); }
            else if (it < 1024) { if (MIX_B) conv_item(p, lds, l, it - 512); }
            else if (it < 1152) { if (MIX_C) s5_local_item(p, l, it - 1024); }
            else { if (MIX_D) attn_item(p, lds, l, 0, it - 1152); }
        }
        GRID_SYNC();
        for (int it = bid; it < 648; it += G) {
            if (it < 128) { if (MIX_A) hgrn_scan_item(p, it); }
            else if (it < 136) { if (MIX_C) s5_scan_item(p, l, it - 128); }
            else { if (MIX_D) attn_item(p, lds, l, 1, it - 136); }
        }
        GRID_SYNC();
        for (int it = bid; it < 1536; it += G) {
            if (it < 512) { if (MIX_A) hgrn_item<true>(p, lds, l, it); }
            else if (it < 1024) { if (MIX_C) s5_out_item(p, lds, l, it - 512); }
            else { if (MIX_D) attn_item(p, lds, l, 2, it - 1024); }
        }
        GRID_SYNC();
        }
#ifndef NO_GLU
        { pg8::Gemm g{(const bf16_t*)(ws + WS_YPRE), (const bf16_t*)(ws + WS_WGLU) + (size_t)l * 65536, T, 256, 256, 256}; pg8::StaticOrder S; S.init(T, 256, G, bid);
          pg8::EpiGlu E{(const bf16_t*)(ws + WS_YPRE), 256, YC_ + YC};
          pg8::gemm_phase<pg8::EpiGlu, pg8::StaticOrder, false, true>(lds, g, S, E); }
#endif
        { int tq = threadIdx.x; asm volatile("" : "+v"(tq)); const int lane = tq & 63; const int gw = bid * 8 + (tq >> 6), NGW = G * 8;
          for (int m = gw; m < T; m += NGW) { u32x2* yp = (u32x2*)(YC_ + (size_t)m * D + YD) + lane; const u32x2 w = *((const u32x2*)(Zb + (size_t)m * DIN + ZOD) + lane);
              const float a0 = bflo(w.x), a1 = bfhi(w.x), a2 = bflo(w.y), a3 = bfhi(w.y);
              const float ss = wave_sum((a0 * a0 + a1 * a1) + (a2 * a2 + a3 * a3)); const float rs = rsqrtf(ss * (1.0f / 256.0f) + EPS);
              u32x2 o; o.x = pk2(a0 * rs, a1 * rs); o.y = pk2(a2 * rs, a3 * rs); *yp = o; } }
        GRID_SYNC();
#endif
#ifdef DUMP_SLICE
        if (lrun == DUMP_LAYER) { int tq = threadIdx.x; asm volatile("" : "+v"(tq));
          for (int m = bid * 8 + (tq >> 6); m < T; m += G * 8) { const int ln = tq & 63;
              for (int j = 0; j < 4; ++j) { const int col = j * 256 + ln * 4; const u32x2 w = *(const u32x2*)(YC_ + (size_t)m * D + col);
                  f32x4 o = (f32x4){0.f, 0.f, 0.f, 0.f}; if (j == DUMP_SLICE) o = (f32x4){bflo(w.x), bfhi(w.x), bflo(w.y), bfhi(w.y)};
                  *(f32x4*)(p.out + (size_t)m * D + col) = o; } }
          break; }
#endif
#ifdef SKIP_MIX
        { pg8::Gemm g{Zb, (const bf16_t*)(ws + WS_WOUT) + (size_t)l * D * D, T, D, D, DIN}; pg8::StaticOrder S; S.init(T, D, G, bid);
#else
        { pg8::Gemm g{YC_, (const bf16_t*)(ws + WS_WOUT) + (size_t)l * D * D, T, D, D, D}; pg8::StaticOrder S; S.init(T, D, G, bid);
#endif
          pg8::EpiRes E{firstl ? p.in[I_X] : p.out, p.out, XB, SSQP + (size_t)T * 16};
          pg8::gemm_phase<pg8::EpiRes, pg8::StaticOrder, true, true>(lds, g, S, E); }
        GRID_SYNC();
        { pg8::Gemm g{XB, (const bf16_t*)(ws + WS_WUP) + (size_t)l * D * FF, T, FF, D, D}; pg8::StaticOrder S; S.init(T, FF, G, bid);
          pg8::EpiScale E{HM, FF, SSQP + (size_t)T * 16, 1};
          pg8::gemm_phase<pg8::EpiScale, pg8::StaticOrder, true, true>(lds, g, S, E); }
        GRID_SYNC();
        { pg8::Gemm g{HM, (const bf16_t*)(ws + WS_WDN) + (size_t)l * D * FF, T, D, FF, FF}; pg8::StaticOrder S; S.init(T, D, G, bid);
          pg8::EpiRes E{p.out, p.out, XB, !lastl ? SSQP : nullptr};
          pg8::gemm_phase<pg8::EpiRes, pg8::StaticOrder, true, true>(lds, g, S, E); }
        if (!lastl) GRID_SYNC();
    }
}

extern "C" void kernel_launch(void* const* d_in, const int* in_sizes, int n_in, void* d_out, int out_size, void* d_ws, size_t ws_size, hipStream_t stream) {
    static int grid = 0;
    if (grid == 0) {
        if (n_in != 26 || out_size != T * D || ws_size < WS_END) { fprintf(stderr, "kernel_launch: unexpected shapes (n_in %d, out %d, ws %zu); nothing launched\n", n_in, out_size, ws_size); grid = -1; return; }
        int dev = 0, cus = 0, per_cu = 0;
        (void)hipGetDevice(&dev); (void)hipDeviceGetAttribute(&cus, hipDeviceAttributeMultiprocessorCount, dev);
        if (hipFuncSetAttribute((const void*)hybrid_fwd, hipFuncAttributeMaxDynamicSharedMemorySize, LDS_BYTES) != hipSuccess) { fprintf(stderr, "kernel_launch: hipFuncSetAttribute failed\n"); grid = -1; return; }
        if (hipOccupancyMaxActiveBlocksPerMultiprocessor(&per_cu, (const void*)hybrid_fwd, 512, LDS_BYTES) != hipSuccess || per_cu < 1) { fprintf(stderr, "kernel_launch: occupancy query gave %d\n", per_cu); per_cu = 1; }
        (void)hipGetLastError();
        if (cus <= 0) cus = 256;
        grid = cus * per_cu;
    }
    if (grid < 0) return;
    Params a{};
    for (int i = 0; i < 26; ++i) a.in[i] = (const float*)d_in[i];
    a.out = (float*)d_out; a.ws = (unsigned char*)d_ws;
    void* args[] = {&a};
    hipError_t e = hipLaunchCooperativeKernel((const void*)hybrid_fwd, dim3(grid), dim3(512), args, LDS_BYTES, stream);
    if (e != hipSuccess) fprintf(stderr, "cooperative launch failed: %s (grid %d)\n", hipGetErrorString(e), grid);
}
```

```cpp
#include <hip/hip_runtime.h>
#include <hip/hip_cooperative_groups.h>
#include <cstdio>
#include <cstdint>
namespace cg = cooperative_groups;

#define DI __device__ __forceinline__
#define LAS __attribute__((address_space(3)))
typedef unsigned short bf16_t;
typedef short bf16x8 __attribute__((ext_vector_type(8)));
typedef short s16x4 __attribute__((ext_vector_type(4)));
typedef float f32x4 __attribute__((ext_vector_type(4)));
typedef float f32x16 __attribute__((ext_vector_type(16)));
typedef unsigned u32x4 __attribute__((ext_vector_type(4)));
typedef unsigned u32x2 __attribute__((ext_vector_type(2)));

constexpr int NB = 4, SEQ = 8192, T = NB * SEQ, D = 1024, DIN = 2560, FF = 4096, NL = 4;
constexpr int ZQ = 0, ZF = 256, ZI = 512, ZG = 768, ZBV = 1024, ZBG = 1280, ZCU = 1536, ZDQ = 1792, ZDK = 2048, ZDV = 2304;
constexpr int YA = 0, YB = 256, YC = 512, YD = 768;
constexpr int ZOD = ZBG;
constexpr float EPS = 1e-6f;
constexpr size_t MiB = 1u << 20;
constexpr size_t WS_WIN = 0, WS_WOUT = 20 * MiB, WS_WUP = 28 * MiB, WS_WDN = 60 * MiB, WS_WGLU = 92 * MiB;
constexpr size_t WS_LB = 93 * MiB;
constexpr size_t WS_BIAS = WS_LB + 4096;
constexpr size_t WS_SSQ = WS_LB + 65536;
constexpr size_t WS_LSE = WS_SSQ + 8 * (size_t)T * 4;
constexpr size_t WS_DEC = WS_LSE + (size_t)T * 16;
constexpr size_t WS_LSE1 = WS_DEC + 2048 * 64 * 4;
constexpr size_t WS_S5K = 96 * MiB;
constexpr size_t WS_S5WS = 98 * MiB;
constexpr size_t WS_S5WC = 114 * MiB;
constexpr size_t WS_XB = 130 * MiB;
constexpr size_t WS_S5H = 194 * MiB;
constexpr size_t WS_HM = 198 * MiB;
constexpr size_t WS_Z = 198 * MiB;
constexpr size_t WS_YCAT = 358 * MiB;
constexpr size_t WS_SL = 422 * MiB, WS_SL2 = 438 * MiB;
constexpr size_t WS_S5H2 = 454 * MiB;
constexpr size_t WS_O0 = 458 * MiB, WS_O1 = 474 * MiB;
constexpr size_t WS_YPRE = 490 * MiB;
constexpr size_t WS_SSQP = 506 * MiB;
constexpr size_t WS_END = 510 * MiB;
static_assert(WS_LSE1 + (size_t)T * 16 <= WS_S5K, "misc region");

constexpr int LDS_BYTES = 147456;

DI unsigned f2bf(float f) { unsigned u = __builtin_bit_cast(unsigned, f); return (u + 0x7fffu + ((u >> 16) & 1u)) >> 16; }
DI unsigned pk2(float lo, float hi) { return f2bf(lo) | (f2bf(hi) << 16); }
DI float bf2f(bf16_t v) { return __builtin_bit_cast(float, (unsigned)v << 16); }
DI float bflo(unsigned w) { return __builtin_bit_cast(float, w << 16); }
DI float bfhi(unsigned w) { return __builtin_bit_cast(float, w & 0xffff0000u); }
DI float sigmoidf_(float x) { return 1.f / (1.f + __expf(-x)); }
DI float wave_sum(float v) {
#pragma unroll
    for (int o = 1; o < 64; o <<= 1) v += __shfl_xor(v, o);
    return v;
}
DI float half_sum(float v) {
#pragma unroll
    for (int o = 1; o < 32; o <<= 1) v += __shfl_xor(v, o);
    return v;
}
#define LDS_WAIT() asm volatile("s_waitcnt lgkmcnt(0)" ::: "memory")
DI int crow(int reg, int h) { return (reg & 3) + 8 * (reg >> 2) + 4 * h; }

template <int K>
DI f32x16 mma_lds(const LAS bf16_t* A, int lda, const LAS bf16_t* B, int ldb, f32x16 acc, int lane) {
    const int r = lane & 31, h = lane >> 5;
    const LAS bf16_t* ap = A + r * lda + 8 * h; const LAS bf16_t* bp = B + r * ldb + 8 * h;
#pragma unroll
    for (int k0 = 0; k0 < K; k0 += 16) {
        const bf16x8 a = *(const LAS bf16x8*)(ap + k0); const bf16x8 b = *(const LAS bf16x8*)(bp + k0);
        acc = __builtin_amdgcn_mfma_f32_32x32x16_bf16(a, b, acc, 0, 0, 0);
    }
    return acc;
}
DI f32x16 zero16() { f32x16 z;
#pragma unroll
    for (int i = 0; i < 16; ++i) z[i] = 0.f;
    return z; }

namespace pg8 {
#define PG8_LAS __attribute__((address_space(3)))
constexpr int BM = 256, BK = 64, HALF = 128, HTB = HALF * BK * 2, STAGE_BYTES = 8 * HTB, NXCD = 8, WGM = 8;
__host__ __device__ __forceinline__ int lds_byte(int r, int c) { const int st = (r >> 4) * 2 + (c >> 5), rr = r & 15, cc = c & 31, ob = rr * 64 + cc * 2; return st * 1024 + (ob ^ (((ob >> 9) & 1) << 5)); }
__host__ __device__ __forceinline__ void stage_rc(int b, int& R, int& C) { const int st = b / 1024, sb = b % 1024, swz = sb ^ (((sb >> 9) & 1) << 5); R = (st >> 1) * 16 + swz / 64; C = (st & 1) * 32 + (swz % 64) / 2; }
__host__ __device__ __forceinline__ int perm32(int rho) { const int n = rho >> 4, i = rho & 15; return 8 * (i >> 2) + 4 * n + (i & 3); }
struct Unit { int pm, pn; };
struct Gemm { const bf16_t* A; const bf16_t* Bt; int M, N, K, lda; };
struct StaticOrder {
    int nM, nN, nwg, G, c;
    __host__ __device__ void init(int M, int N, int G_, int c_) { nM = M / BM; nN = N / BM; nwg = nM * nN; G = G_; c = c_; }
    __host__ __device__ bool next(int i, Unit& u) const {
        const long L = (long)i * G + c; if (L >= nwg) return false;
        int wgid = (int)L; { const int q = nwg / NXCD, r = nwg % NXCD, xcd = wgid % NXCD, off = wgid / NXCD; wgid = (xcd < r ? xcd * (q + 1) : r * (q + 1) + (xcd - r) * q) + off; }
        const int nig = WGM * nN, gid = wgid / nig, fm = gid * WGM, gsz = (nM - fm) < WGM ? (nM - fm) : WGM;
        u.pm = fm + ((wgid % nig) % gsz); u.pn = (wgid % nig) / gsz; return true;
    }
    __device__ __forceinline__ void a_ready(const Unit&) const {}
    __device__ __forceinline__ void done(const Unit&) const {}
};
struct EpiScale {
    static constexpr bool PERM = true, AFTER_DRAIN = false;
    bf16_t* O; int ldc; const float* ssq; int act;
    __device__ __forceinline__ void operator()(const f32x4 (&acc)[2][2][4][2], const Unit& u, int wr, int wc, int fr, int fq) const {
        const int row0 = u.pm * BM + wr * 64 + fr; const int col0 = u.pn * BM + wc * 32 + 8 * fq;
#pragma unroll
        for (int ai = 0; ai < 2; ++ai)
#pragma unroll
            for (int m = 0; m < 4; ++m) { const int r = row0 + ai * HALF + m * 16; const f32x4* sq = (const f32x4*)(ssq + (size_t)r * 16); const f32x4 q0 = sq[0], q1 = sq[1], q2 = sq[2], q3 = sq[3];
                const float tot = (((q0[0] + q0[1]) + (q0[2] + q0[3])) + ((q1[0] + q1[1]) + (q1[2] + q1[3]))) + (((q2[0] + q2[1]) + (q2[2] + q2[3])) + ((q3[0] + q3[1]) + (q3[2] + q3[3])));
                const float rs = rsqrtf(tot * (1.0f / 1024.0f) + EPS);
                bf16_t* rowp = O + (size_t)r * ldc + col0;
#pragma unroll
                for (int bj = 0; bj < 2; ++bj) { f32x4 v0 = acc[ai][bj][m][0] * rs, v1 = acc[ai][bj][m][1] * rs;
                    if (act) {
#pragma unroll
                        for (int e = 0; e < 4; ++e) { const float a = fmaxf(v0[e], 0.f), b = fmaxf(v1[e], 0.f); v0[e] = a * a; v1[e] = b * b; } }
                    u32x4 w; w.x = pk2(v0[0], v0[1]); w.y = pk2(v0[2], v0[3]); w.z = pk2(v1[0], v1[1]); w.w = pk2(v1[2], v1[3]);
                    *(u32x4*)(rowp + bj * HALF) = w; } }
    }
};
struct EpiRes {
    static constexpr bool PERM = false, AFTER_DRAIN = false;
    const float* base; float* out; bf16_t* xb; float* ssq_out;
    __device__ __forceinline__ void operator()(const f32x4 (&acc)[2][2][4][2], const Unit& u, int wr, int wc, int fr, int fq) const {
        const int col0 = u.pn * BM + wc * 32 + 4 * fq;
#pragma unroll
        for (int ai = 0; ai < 2; ++ai)
#pragma unroll
            for (int m = 0; m < 4; ++m) { const int r = u.pm * BM + ai * HALF + wr * 64 + m * 16 + fr; const size_t off = (size_t)r * D + col0; float s = 0.f;
#pragma unroll
                for (int bj = 0; bj < 2; ++bj)
#pragma unroll
                    for (int n = 0; n < 2; ++n) { const size_t o2 = off + bj * HALF + n * 16; const f32x4 o = *(const f32x4*)(base + o2) + acc[ai][bj][m][n];
                        *(f32x4*)(out + o2) = o; u32x2 w; w.x = pk2(o[0], o[1]); w.y = pk2(o[2], o[3]); *(u32x2*)(xb + o2) = w;
                        s += (o[0] * o[0] + o[1] * o[1]) + (o[2] * o[2] + o[3] * o[3]); }
                s += __shfl_xor(s, 16); s += __shfl_xor(s, 32);
                if (fq == 0 && ssq_out) ssq_out[(size_t)r * 16 + u.pn * 4 + wc] = s; }
    }
};
struct EpiGlu {
    static constexpr bool PERM = false, AFTER_DRAIN = true;
    const bf16_t* Ysrc; int lds_; bf16_t* Y;
    __device__ __forceinline__ void fused(f32x4 (&acc)[2][2][4][2], const Unit& u, int wr, int wc, int fr, int fq, PG8_LAS unsigned char* lds, int wid, int lane) const {
        PG8_LAS float* Pp = (PG8_LAS float*)lds;
        const int col0 = wc * 32 + 4 * fq;
#pragma unroll
        for (int ai = 0; ai < 2; ++ai)
#pragma unroll
            for (int m = 0; m < 4; ++m) { const int rl = ai * HALF + wr * 64 + m * 16 + fr; const size_t off = (size_t)(u.pm * BM + rl) * lds_ + col0; float s = 0.f;
#pragma unroll
                for (int bj = 0; bj < 2; ++bj)
#pragma unroll
                    for (int n = 0; n < 2; ++n) { const u32x2 w = *(const u32x2*)(Ysrc + off + bj * HALF + n * 16); f32x4 a = acc[ai][bj][m][n];
                        const float y0 = bflo(w.x), y1 = bfhi(w.x), y2 = bflo(w.y), y3 = bfhi(w.y);
                        a[0] = y0 * sigmoidf_(a[0]); a[1] = y1 * sigmoidf_(a[1]); a[2] = y2 * sigmoidf_(a[2]); a[3] = y3 * sigmoidf_(a[3]);
                        acc[ai][bj][m][n] = a; s += (a[0] * a[0] + a[1] * a[1]) + (a[2] * a[2] + a[3] * a[3]); }
                s += __shfl_xor(s, 16); s += __shfl_xor(s, 32);
                if (fq == 0) Pp[rl * 4 + wc] = s; }
        __syncthreads();
#pragma unroll
        for (int ai = 0; ai < 2; ++ai)
#pragma unroll
            for (int m = 0; m < 4; ++m) { const int rl = ai * HALF + wr * 64 + m * 16 + fr; const size_t off = (size_t)(u.pm * BM + rl) * D + col0;
                const float tot = (Pp[rl * 4 + 0] + Pp[rl * 4 + 1]) + (Pp[rl * 4 + 2] + Pp[rl * 4 + 3]); const float rs = rsqrtf(tot * (1.0f / 256.0f) + EPS);
#pragma unroll
                for (int bj = 0; bj < 2; ++bj)
#pragma unroll
                    for (int n = 0; n < 2; ++n) { const f32x4 a = acc[ai][bj][m][n] * rs; u32x2 w; w.x = pk2(a[0], a[1]); w.y = pk2(a[2], a[3]); *(u32x2*)(Y + off + bj * HALF + n * 16) = w; } }
    }
};

template <class Epi, class Sched, bool ALIGN_EPI = false, bool SP2 = false>
__device__ __forceinline__ void gemm_phase(PG8_LAS unsigned char* lds, const Gemm g, const Sched& S, const Epi& E) {
    int tid_o = threadIdx.x; asm volatile("" : "+v"(tid_o));
    const int tid = tid_o, wid = __builtin_amdgcn_readfirstlane(tid >> 6), lane = tid & 63, wr = wid >> 2, wc = wid & 3, fr = lane & 15, fq = lane >> 4;
    const int K = g.K, nt = K / BK;
    unsigned voffA[2], voffB[2];
#pragma unroll
    for (int i = 0; i < 2; ++i) { int R, C; stage_rc(tid * 16 + i * 8192, R, C); const int Rb = Epi::PERM ? ((R & ~31) + perm32(R & 31)) : R;
        voffA[i] = (unsigned)(R * g.lda + C) * 2u; voffB[i] = (unsigned)(Rb * K + C) * 2u; }
    const size_t kstep = (size_t)(BK * 2);
    const size_t hstepA = (size_t)HALF * g.lda * 2, hstepB = (size_t)HALF * K * 2;
    const size_t tstepA = 2 * hstepA, tstepB = 2 * hstepB;
    const unsigned ldsw = (unsigned)wid * 1024u;
    const int aoff = lds_byte(wr * 64 + fr, fq * 8), boff = lds_byte(wc * 32 + fr, fq * 8);
#define PG8_SA(b, h) (((b) * 2 + (h)) * HTB)
#define PG8_SB(b, h) ((4 + (b) * 2 + (h)) * HTB)
#define PG8_STAGE(bufoff, gbase, voff) do { _Pragma("unroll") for (int _i = 0; _i < 2; ++_i) \
        __builtin_amdgcn_global_load_lds((const unsigned*)((const char*)(gbase) + (voff)[_i]), (PG8_LAS unsigned*)(lds + (bufoff) + ldsw + _i * 8192), 16, 0, 0); } while (0)
#define PG8_LDA(dst, b, h) do { _Pragma("unroll") for (int m = 0; m < 4; ++m) _Pragma("unroll") for (int k = 0; k < 2; ++k) dst[m][k] = *(const PG8_LAS bf16x8*)(lds + PG8_SA(b, h) + aoff + m * 2048 + k * 1024); } while (0)
#define PG8_LDB(dst, b, h) do { _Pragma("unroll") for (int n = 0; n < 2; ++n) _Pragma("unroll") for (int k = 0; k < 2; ++k) dst[n][k] = *(const PG8_LAS bf16x8*)(lds + PG8_SB(b, h) + boff + n * 2048 + k * 1024); } while (0)
#define PG8_MMA(ai, bj, At, Bt) do { __builtin_amdgcn_s_setprio(1); _Pragma("unroll") for (int m = 0; m < 4; ++m) _Pragma("unroll") for (int n = 0; n < 2; ++n) _Pragma("unroll") for (int k = 0; k < 2; ++k) \
        acc[ai][bj][m][n] = __builtin_amdgcn_mfma_f32_16x16x32_bf16(Bt[n][k], At[m][k], acc[ai][bj][m][n], 0, 0, 0); __builtin_amdgcn_s_setprio(0); } while (0)
#define PG8_WAIT_V(n) asm volatile("s_waitcnt vmcnt(" #n ")" ::: "memory")
#define PG8_WAIT_L(n) asm volatile("s_waitcnt lgkmcnt(" #n ")" ::: "memory")
#define PG8_BAR __builtin_amdgcn_s_barrier()
#define PG8_SCHED __builtin_amdgcn_sched_barrier(0)
    Unit cur, nxt; int ui = 0;
    if (!S.next(0, cur)) return;
    f32x4 acc[2][2][4][2];
#pragma unroll
    for (int a = 0; a < 2; ++a)
#pragma unroll
        for (int b = 0; b < 2; ++b)
#pragma unroll
            for (int m = 0; m < 4; ++m)
#pragma unroll
                for (int n = 0; n < 2; ++n) acc[a][b][m][n] = (f32x4){0.f, 0.f, 0.f, 0.f};
    bf16x8 At[4][2], B0[2][2], B1[2][2];
    const char* cA = (const char*)g.A + (size_t)cur.pm * tstepA; const char* cB = (const char*)g.Bt + (size_t)cur.pn * tstepB;
    S.a_ready(cur);
    if constexpr (SP2) {
        PG8_STAGE(PG8_SB(0, 0), cB, voffB); PG8_STAGE(PG8_SB(0, 1), cB + hstepB, voffB); PG8_STAGE(PG8_SA(0, 0), cA, voffA); PG8_STAGE(PG8_SA(0, 1), cA + hstepA, voffA);
        if (wr == 1) PG8_BAR;
        PG8_WAIT_V(2); PG8_BAR;
        PG8_STAGE(PG8_SB(1, 0), cB + kstep, voffB); PG8_STAGE(PG8_SA(1, 0), cA + kstep, voffA); PG8_STAGE(PG8_SB(1, 1), cB + hstepB + kstep, voffB);
        PG8_WAIT_V(6); PG8_BAR;
    } else {
        PG8_STAGE(PG8_SB(0, 0), cB, voffB); PG8_STAGE(PG8_SA(0, 0), cA, voffA); PG8_STAGE(PG8_SB(0, 1), cB + hstepB, voffB); PG8_STAGE(PG8_SA(0, 1), cA + hstepA, voffA);
        if (wr == 1) PG8_BAR;
        PG8_WAIT_V(4); PG8_BAR;
        PG8_STAGE(PG8_SB(1, 0), cB + kstep, voffB); PG8_STAGE(PG8_SA(1, 0), cA + kstep, voffA); PG8_STAGE(PG8_SB(1, 1), cB + hstepB + kstep, voffB);
        PG8_WAIT_V(6); PG8_BAR;
    }
    for (;;) {
        const bool has_next = S.next(ui + 1, nxt);
        const char* nA = has_next ? (const char*)g.A + (size_t)nxt.pm * tstepA : cA; const char* nB = has_next ? (const char*)g.Bt + (size_t)nxt.pn * tstepB : cB;
        for (int t = 0; t < nt; t += 2) {
            const bool last = (t == nt - 2);
            const char* a1 = cA + (size_t)(t + 1) * kstep;
            const char* a2 = last ? nA : cA + (size_t)(t + 2) * kstep; const char* b2 = last ? nB : cB + (size_t)(t + 2) * kstep;
            const char* a3 = a2 + kstep; const char* b3 = b2 + kstep;
            if (last && has_next) S.a_ready(nxt);
            if constexpr (SP2) {
            PG8_LDB(B0, 0, 0); PG8_LDB(B1, 0, 1); PG8_SCHED; PG8_LDA(At, 0, 0); PG8_STAGE(PG8_SA(1, 1), a1 + hstepA, voffA);
            PG8_WAIT_V(8); PG8_WAIT_L(0); PG8_BAR; PG8_MMA(0, 0, At, B0); PG8_MMA(0, 1, At, B1); PG8_BAR; PG8_SCHED;
            PG8_LDA(At, 0, 1); PG8_STAGE(PG8_SB(0, 0), b2, voffB); PG8_STAGE(PG8_SB(0, 1), b2 + hstepB, voffB); PG8_STAGE(PG8_SA(0, 0), a2, voffA);
            PG8_WAIT_V(8); PG8_WAIT_L(0); PG8_BAR; PG8_MMA(1, 0, At, B0); PG8_MMA(1, 1, At, B1); PG8_BAR; PG8_SCHED;
            PG8_LDB(B0, 1, 0); PG8_LDB(B1, 1, 1); PG8_SCHED; PG8_LDA(At, 1, 0); PG8_STAGE(PG8_SA(0, 1), a2 + hstepA, voffA);
            PG8_WAIT_V(8); PG8_WAIT_L(0); PG8_BAR; PG8_MMA(0, 0, At, B0); PG8_MMA(0, 1, At, B1); PG8_BAR; PG8_SCHED;
            PG8_LDA(At, 1, 1); PG8_STAGE(PG8_SB(1, 0), b3, voffB); PG8_STAGE(PG8_SB(1, 1), b3 + hstepB, voffB); PG8_STAGE(PG8_SA(1, 0), a3, voffA);
            PG8_WAIT_V(8); PG8_WAIT_L(0); PG8_BAR; PG8_MMA(1, 0, At, B0); PG8_MMA(1, 1, At, B1); PG8_BAR; PG8_SCHED;
            } else {
            PG8_LDB(B0, 0, 0); PG8_SCHED; PG8_LDA(At, 0, 0); PG8_STAGE(PG8_SA(1, 1), a1 + hstepA, voffA);
            PG8_WAIT_L(8); PG8_BAR; PG8_WAIT_L(0); PG8_MMA(0, 0, At, B0); PG8_BAR; PG8_SCHED;
            PG8_LDB(B1, 0, 1); PG8_STAGE(PG8_SB(0, 0), b2, voffB);
            PG8_BAR; PG8_WAIT_L(0); PG8_MMA(0, 1, At, B1); PG8_BAR;
            PG8_LDA(At, 0, 1); PG8_STAGE(PG8_SA(0, 0), a2, voffA);
            PG8_BAR; PG8_WAIT_L(0); PG8_MMA(1, 0, At, B0); PG8_BAR; PG8_SCHED;
            PG8_STAGE(PG8_SB(0, 1), b2 + hstepB, voffB);
            PG8_WAIT_V(6); PG8_BAR; PG8_MMA(1, 1, At, B1); PG8_BAR;
            PG8_LDB(B0, 1, 0); PG8_SCHED; PG8_LDA(At, 1, 0); PG8_STAGE(PG8_SA(0, 1), a2 + hstepA, voffA);
            PG8_WAIT_L(8); PG8_BAR; PG8_WAIT_L(0); PG8_MMA(0, 0, At, B0); PG8_BAR; PG8_SCHED;
            PG8_LDB(B1, 1, 1); PG8_STAGE(PG8_SB(1, 0), b3, voffB);
            PG8_BAR; PG8_WAIT_L(0); PG8_MMA(0, 1, At, B1); PG8_BAR;
            PG8_LDA(At, 1, 1); PG8_STAGE(PG8_SA(1, 0), a3, voffA);
            PG8_BAR; PG8_WAIT_L(0); PG8_MMA(1, 0, At, B0); PG8_BAR; PG8_SCHED;
            PG8_STAGE(PG8_SB(1, 1), b3 + hstepB, voffB);
            PG8_WAIT_V(6); PG8_BAR; PG8_MMA(1, 1, At, B1); PG8_BAR;
            }
        }
        if constexpr (ALIGN_EPI) { if (wr == 0) PG8_BAR; }
        if constexpr (!Epi::AFTER_DRAIN) { E(acc, cur, wr, wc, fr, fq); S.done(cur); }
        if (!has_next) break;
#pragma unroll
        for (int a = 0; a < 2; ++a)
#pragma unroll
            for (int b = 0; b < 2; ++b)
#pragma unroll
                for (int m = 0; m < 4; ++m)
#pragma unroll
                    for (int n = 0; n < 2; ++n) acc[a][b][m][n] = (f32x4){0.f, 0.f, 0.f, 0.f};
        cur = nxt; cA = nA; cB = nB; ++ui;
        if constexpr (ALIGN_EPI) { if (wr == 1) PG8_BAR; }
    }
    PG8_WAIT_V(0);
    if constexpr (!ALIGN_EPI) { if (wr == 0) PG8_BAR; }
    PG8_BAR;
    if constexpr (Epi::AFTER_DRAIN) { E.fused(acc, cur, wr, wc, fr, fq, lds, wid, lane); S.done(cur); }
#undef PG8_SA
#undef PG8_SB
#undef PG8_STAGE
#undef PG8_LDA
#undef PG8_LDB
#undef PG8_MMA
#undef PG8_WAIT_V
#undef PG8_WAIT_L
#undef PG8_BAR
#undef PG8_SCHED
}
}

struct Params { const float* in[26]; float* out; unsigned char* ws; };
enum { I_X = 0, I_NMG, I_WIN, I_LBL, I_HNG, I_CW, I_CB, I_CLG, I_CLB, I_LRE, I_LIM, I_BRE, I_BIM, I_CRE, I_CIM, I_S5D, I_LDT, I_WGLU, I_QG, I_KG, I_RB, I_MONG, I_WOUT, I_NMLPG, I_WUP, I_WDN };

DI void p0_transpose_item(const float* W, int K, int N, bf16_t* WT, const float* gk, LAS float* scr, int item, int lane) {
    const int nblk = N / 32, kb = item / nblk, nb = item % nblk, k0 = 64 * kb, n0 = 32 * nb;
#pragma unroll 8
    for (int i = 0; i < 32; ++i) { const int kk = 2 * i + (lane >> 5); const float s = gk ? gk[k0 + kk] : 1.f; scr[kk * 33 + (lane & 31)] = W[(size_t)(k0 + kk) * N + n0 + (lane & 31)] * s; }
    LDS_WAIT();
    const int c = lane & 7;
#pragma unroll
    for (int j = 0; j < 4; ++j) { const int n = (lane >> 3) + 8 * j; const LAS float* s = scr + (8 * c) * 33 + n;
        u32x4 o; o.x = pk2(s[0 * 33], s[1 * 33]); o.y = pk2(s[2 * 33], s[3 * 33]); o.z = pk2(s[4 * 33], s[5 * 33]); o.w = pk2(s[6 * 33], s[7 * 33]);
        *(u32x4*)(WT + (size_t)(n0 + n) * K + k0 + 8 * c) = o; }
    LDS_WAIT();
}
DI void s5_params(const Params& p, int lg, int pp, float& lrdt, float& lidt, float& cr, float& ci) {
    const float dt = expf(p.in[I_LDT][lg]);
    const float lr = p.in[I_LRE][lg * 64 + pp], li = p.in[I_LIM][lg * 64 + pp];
    lrdt = lr * dt; lidt = li * dt;
    const float mag = expf(lrdt); const float ar = mag * cosf(lidt), ai = mag * sinf(lidt);
    const float den = lr * lr + li * li;
    cr = ((ar - 1.0f) * lr + ai * li) / den; ci = (ai * lr - (ar - 1.0f) * li) / den;
}
DI void s5_pow(float lrdt, float lidt, int n, float& er, float& ei) { const float m = expf((float)n * lrdt); const float a = (float)n * lidt; er = m * cosf(a); ei = m * sinf(a); }

DI void prologue(const Params& p, LAS unsigned char* lds, int G) {
    int tid_o = threadIdx.x; asm volatile("" : "+v"(tid_o));
    const int tid = tid_o, lane = tid & 63, wave = tid >> 6;
    const int gw = blockIdx.x * 8 + wave, NGW = G * 8;
    const int gt = blockIdx.x * 512 + tid, NGT = G * 512;
    unsigned char* ws = p.ws;
    LAS float* scr = (LAS float*)(lds + wave * 16384);
    {
        constexpr int I_IN = (D / 64) * (DIN / 32), I_OUT = (D / 64) * (D / 32), I_UP = (D / 64) * (FF / 32), I_DN = (FF / 64) * (D / 32), I_GL = (256 / 64) * (256 / 32);
        constexpr int PER_L = I_IN + I_OUT + I_UP + I_DN + I_GL;
        for (int it = gw; it < NL * PER_L; it += NGW) {
            const int l = it / PER_L; int r = it % PER_L;
            if (r < I_IN) { p0_transpose_item(p.in[I_WIN] + (size_t)l * D * DIN, D, DIN, (bf16_t*)(ws + WS_WIN) + (size_t)l * D * DIN, p.in[I_NMG] + l * D, scr, r, lane); continue; } r -= I_IN;
            if (r < I_OUT) { p0_transpose_item(p.in[I_WOUT] + (size_t)l * D * D, D, D, (bf16_t*)(ws + WS_WOUT) + (size_t)l * D * D, p.in[I_MONG] + l * D, scr, r, lane); continue; } r -= I_OUT;
            if (r < I_UP) { p0_transpose_item(p.in[I_WUP] + (size_t)l * D * FF, D, FF, (bf16_t*)(ws + WS_WUP) + (size_t)l * D * FF, p.in[I_NMLPG] + l * D, scr, r, lane); continue; } r -= I_UP;
            if (r < I_DN) { p0_transpose_item(p.in[I_WDN] + (size_t)l * D * FF, FF, D, (bf16_t*)(ws + WS_WDN) + (size_t)l * D * FF, nullptr, scr, r, lane); continue; } r -= I_DN;
            p0_transpose_item(p.in[I_WGLU] + (size_t)l * 65536, 256, 256, (bf16_t*)(ws + WS_WGLU) + (size_t)l * 65536, nullptr, scr, r, lane);
        }
    }
    {
        float* ssq0 = (float*)(ws + WS_SSQP); bf16_t* XB = (bf16_t*)(ws + WS_XB);
        for (int mb = gw * 16; mb < T; mb += NGW * 16) {
            float keep = 0.f;
#pragma unroll 1
            for (int i = 0; i < 16; ++i) { const int m = mb + i;
                const f32x4* xr = (const f32x4*)(p.in[I_X] + (size_t)m * D) + lane; f32x4 v[4]; float s = 0.f;
#pragma unroll
                for (int j = 0; j < 4; ++j) { v[j] = xr[64 * j]; s += (v[j][0] * v[j][0] + v[j][1] * v[j][1]) + (v[j][2] * v[j][2] + v[j][3] * v[j][3]); }
                s = wave_sum(s); if (lane == i) keep = s;
                u32x2* o8 = (u32x2*)(XB + (size_t)m * D) + lane;
#pragma unroll
                for (int j = 0; j < 4; ++j) { u32x2 w; w.x = pk2(v[j][0], v[j][1]); w.y = pk2(v[j][2], v[j][3]); o8[64 * j] = w; } }
#pragma unroll 1
            for (int i = 0; i < 16; ++i) { const float v = __shfl(keep, i); if (lane < 16) ssq0[(size_t)(mb + i) * 16 + lane] = lane == 0 ? v : 0.f; }
        }
    }
    {
        float* LB = (float*)(ws + WS_LB);
        for (int c = gt; c < 256; c += NGT) {
            const float a0 = p.in[I_LBL][c], a1 = p.in[I_LBL][256 + c], a2 = p.in[I_LBL][512 + c], a3 = p.in[I_LBL][768 + c];
            const float mx = fmaxf(fmaxf(a0, a1), fmaxf(a2, a3));
            const float e0 = expf(a0 - mx), e1 = expf(a1 - mx), e2 = expf(a2 - mx), e3 = expf(a3 - mx); const float inv = 1.f / (e0 + e1 + e2 + e3);
            const float s1 = e1 * inv, s2 = e2 * inv, s3 = e3 * inv; const float hi = 1.0f - 1e-6f;
            LB[c] = 0.f; LB[256 + c] = fminf(fmaxf(s1, 0.f), hi); LB[512 + c] = fminf(fmaxf(s1 + s2, 0.f), hi); LB[768 + c] = fminf(fmaxf(s1 + s2 + s3, 0.f), hi);
        }
        float* BT = (float*)(ws + WS_BIAS);
        for (int i = gt; i < 3 * 4 * 132; i += NGT) {
            const int pt = i / (4 * 132), hd = (i / 132) % 4, dl = i % 132; const int dil = pt == 0 ? 1 : (pt == 1 ? 4 : 16);
            float v = 0.f;
            if (dl <= 128) { const int dist = dl * dil; int bk;
                if (dist < 16) bk = dist; else { bk = 16 + (int)(logf((float)dist / 16.0f) / 4.852030263919617f * 16.0f); if (bk > 31) bk = 31; }
                v = p.in[I_RB][bk * 4 + hd]; }
            BT[i] = v;
        }
    }
    {
        bf16_t* KT = (bf16_t*)(ws + WS_S5K); bf16_t* WS_ = (bf16_t*)(ws + WS_S5WS); bf16_t* WC = (bf16_t*)(ws + WS_S5WC);
        LAS float* ebr = scr; LAS float* ebi = scr + 64 * 17;
        for (int it = gw; it < NL * 16 * 64; it += NGW) {
            const int lg = it >> 6, d = it & 63;
            float lrdt, lidt, cr, ci; s5_params(p, lg, lane, lrdt, lidt, cr, ci);
            float er, ei; s5_pow(lrdt, lidt, d, er, ei);
            const float fr_ = er * cr - ei * ci, fi_ = er * ci + ei * cr;
            const float* br = p.in[I_BRE] + ((size_t)lg * 64 + lane) * 16; const float* bi = p.in[I_BIM] + ((size_t)lg * 64 + lane) * 16;
#pragma unroll
            for (int c = 0; c < 16; ++c) { const float b0 = br[c], b1 = bi[c]; ebr[lane * 17 + c] = fr_ * b0 - fi_ * b1; ebi[lane * 17 + c] = fr_ * b1 + fi_ * b0; }
            LDS_WAIT();
            const int co = lane & 15, cb = (lane >> 4) * 4;
            const float* crp = p.in[I_CRE] + ((size_t)lg * 16 + co) * 64; const float* cip = p.in[I_CIM] + ((size_t)lg * 16 + co) * 64;
            float a0 = 0.f, a1 = 0.f, a2 = 0.f, a3 = 0.f;
            for (int q = 0; q < 64; ++q) { const float c0 = crp[q], c1 = cip[q];
                a0 += c0 * ebr[q * 17 + cb + 0] - c1 * ebi[q * 17 + cb + 0]; a1 += c0 * ebr[q * 17 + cb + 1] - c1 * ebi[q * 17 + cb + 1];
                a2 += c0 * ebr[q * 17 + cb + 2] - c1 * ebi[q * 17 + cb + 2]; a3 += c0 * ebr[q * 17 + cb + 3] - c1 * ebi[q * 17 + cb + 3]; }
            u32x2 w; w.x = pk2(a0, a1); w.y = pk2(a2, a3);
            *(u32x2*)(KT + ((size_t)it * 16 + co) * 16 + cb) = w;
            LDS_WAIT();
        }
        for (int it = gw; it < NL * 16 * 16; it += NGW) {
            const int lg = it >> 4, s4 = it & 15;
            float lrdt, lidt, cr, ci; s5_params(p, lg, lane, lrdt, lidt, cr, ci);
            const float* br = p.in[I_BRE] + ((size_t)lg * 64 + lane) * 16; const float* bi = p.in[I_BIM] + ((size_t)lg * 64 + lane) * 16;
            float b0[16], b1[16];
#pragma unroll
            for (int c = 0; c < 16; ++c) { b0[c] = br[c]; b1[c] = bi[c]; }
#pragma unroll 1
            for (int sq = 0; sq < 4; ++sq) { const int s = s4 * 4 + sq;
                float er, ei; s5_pow(lrdt, lidt, 63 - s, er, ei);
                const float fr_ = er * cr - ei * ci, fi_ = er * ci + ei * cr;
                float vr[16], vi[16];
#pragma unroll
                for (int c = 0; c < 16; ++c) { vr[c] = fr_ * b0[c] - fi_ * b1[c]; vi[c] = fr_ * b1[c] + fi_ * b0[c]; }
                bf16_t* o0 = WS_ + ((size_t)lg * 128 + lane) * 1024 + s * 16; bf16_t* o1 = WS_ + ((size_t)lg * 128 + 64 + lane) * 1024 + s * 16;
                u32x4 w;
                w.x = pk2(vr[0], vr[1]); w.y = pk2(vr[2], vr[3]); w.z = pk2(vr[4], vr[5]); w.w = pk2(vr[6], vr[7]); *(u32x4*)o0 = w;
                w.x = pk2(vr[8], vr[9]); w.y = pk2(vr[10], vr[11]); w.z = pk2(vr[12], vr[13]); w.w = pk2(vr[14], vr[15]); *(u32x4*)(o0 + 8) = w;
                w.x = pk2(vi[0], vi[1]); w.y = pk2(vi[2], vi[3]); w.z = pk2(vi[4], vi[5]); w.w = pk2(vi[6], vi[7]); *(u32x4*)o1 = w;
                w.x = pk2(vi[8], vi[9]); w.y = pk2(vi[10], vi[11]); w.z = pk2(vi[12], vi[13]); w.w = pk2(vi[14], vi[15]); *(u32x4*)(o1 + 8) = w; }
        }
        for (int it = gw; it < NL * 16 * 64; it += NGW) {
            const int lg = it >> 6, tl = it & 63;
            float lrdt, lidt, cr, ci; s5_params(p, lg, lane, lrdt, lidt, cr, ci);
            float er, ei; s5_pow(lrdt, lidt, tl + 1, er, ei);
#pragma unroll 4
            for (int co = 0; co < 16; ++co) { const float c0 = p.in[I_CRE][((size_t)lg * 16 + co) * 64 + lane], c1 = p.in[I_CIM][((size_t)lg * 16 + co) * 64 + lane];
                bf16_t* o = WC + (((size_t)lg * 64 + tl) * 16 + co) * 128;
                o[lane] = (bf16_t)f2bf(c0 * er - c1 * ei); o[64 + lane] = (bf16_t)f2bf(-(c0 * ei + c1 * er)); }
        }
    }
}

template <bool OUT>
DI void hgrn_item(const Params& p, LAS unsigned char* lds, int l, int cg) {
    int tid_o = threadIdx.x; asm volatile("" : "+v"(tid_o));
    const int tid = tid_o, lane = tid & 63, wave = tid >> 6, hd = wave >> 1, half = wave & 1;
    const bf16_t* Z = (const bf16_t*)(p.ws + WS_Z);
    LAS bf16_t* B0 = (LAS bf16_t*)(lds + hd * 27648); LAS bf16_t* B1 = B0 + 64 * 72; LAS bf16_t* B2 = B1 + 64 * 72;
    LAS float* GM = (LAS float*)(lds + 114688) + hd * 64; LAS float* GL = GM + 256; LAS float* SSA = (LAS float*)(lds + 114688) + 512;
    bf16_t* SL = (bf16_t*)(p.ws + WS_SL); const bf16_t* SL2 = (const bf16_t*)(p.ws + WS_SL2); float* DEC = (float*)(p.ws + WS_DEC);
    const int item = cg * 4 + hd;
#ifdef FORCE_LB0
    const float lb = 0.f, oml = 1.f;
#else
    const float lb = ((const float*)(p.ws + WS_LB))[l * 256 + hd * 64 + lane], oml = 1.f - lb;
#endif
    const int srow = tid >> 5, shd = (tid >> 3) & 3, spc = tid & 7;
    const bf16_t* zsrc = Z + (size_t)(cg * 64 + srow) * DIN + shd * 64 + spc * 8;
    const int sdst = shd * 27648 + (srow * 72 + spc * 8) * 2;
    __syncthreads();
    { u32x4 wf[4], wi[4], wq[4];
#pragma unroll
      for (int sub = 0; sub < 4; ++sub) { wf[sub] = *(const u32x4*)(zsrc + (size_t)(16 * sub) * DIN + ZF); wi[sub] = *(const u32x4*)(zsrc + (size_t)(16 * sub) * DIN + ZI);
          if (OUT) wq[sub] = *(const u32x4*)(zsrc + (size_t)(16 * sub) * DIN + ZQ); }
#pragma unroll
      for (int sub = 0; sub < 4; ++sub) { *(LAS u32x4*)(lds + sdst + 9216 + sub * 16 * 144) = wf[sub]; *(LAS u32x4*)(lds + sdst + 18432 + sub * 16 * 144) = wi[sub];
          if (OUT) *(LAS u32x4*)(lds + sdst + sub * 16 * 144) = wq[sub]; } }
    __syncthreads();
    float g[32]; float run = 0.f;
#pragma unroll
    for (int j = 0; j < 32; ++j) { const float fz = bf2f(B1[(half * 32 + j) * 72 + lane]); const float sg = sigmoidf_(fz); const float f = lb + oml * sg;
        run += __logf(fmaxf(f, 1e-30f)); g[j] = run; }
    if (half == 0) GM[lane] = run;
    __syncthreads();
    const float gm = GM[lane];
    if (half) {
#pragma unroll
        for (int j = 0; j < 32; ++j) g[j] += gm; }
    const int c0 = lane & 31, h = lane >> 5;
    if constexpr (!OUT) {
        if (half) GL[lane] = run + gm;
        __syncthreads();
        const float gl = GL[lane];
        bf16_t kv[32], ivr[32];
#pragma unroll
        for (int j = 0; j < 32; ++j) { const int t = half * 32 + j; const float e = __expf(gl - g[j]); const float kj = oml * (1.f - sigmoidf_(bf2f(B1[t * 72 + lane])));
            kv[j] = (bf16_t)f2bf(kj * e); ivr[j] = B2[t * 72 + lane]; }
        __syncthreads();
#pragma unroll
        for (int j = 0; j < 32; ++j) { const int t = half * 32 + j; B1[lane * 72 + t] = kv[j]; B2[lane * 72 + t] = ivr[j]; }
        __syncthreads();
#pragma unroll
        for (int kt = 0; kt < 2; ++kt) { const f32x16 a = mma_lds<64>(B2 + 32 * half * 72, 72, B1 + 32 * kt * 72, 72, zero16(), lane);
#pragma unroll
            for (int i = 0; i < 16; ++i) SL[(size_t)item * 4096 + (32 * half + crow(i, h)) * 64 + 32 * kt + c0] = (bf16_t)f2bf(a[i]); }
        if (half == 0) DEC[item * 64 + lane] = __expf(gl);
    } else {
        if (half == 0) GL[lane] = __expf(gm);
        bf16_t ivr[32];
#pragma unroll
        for (int j = 0; j < 32; ++j) { const int t = half * 32 + j; const float q = bf2f(B0[t * 72 + lane]); const float kj = oml * (1.f - sigmoidf_(bf2f(B1[t * 72 + lane])));
            const float e1 = __expf(fminf(g[j] - gm, 80.f)), e2 = __expf(fminf(gm - g[j], 80.f));
            ivr[j] = B2[t * 72 + lane];
            B0[t * 72 + lane] = (bf16_t)f2bf(q * e1); B1[t * 72 + lane] = (bf16_t)f2bf(kj * e2); }
        __syncthreads();
#pragma unroll
        for (int j = 0; j < 32; ++j) B2[lane * 72 + half * 32 + j] = ivr[j];
        __syncthreads();
        f32x16 s0 = mma_lds<64>(B0 + 32 * half * 72, 72, B1, 72, zero16(), lane);
        f32x16 s1 = zero16(); if (half) s1 = mma_lds<64>(B0 + 32 * half * 72, 72, B1 + 32 * 72, 72, zero16(), lane);
        __syncthreads();
#pragma unroll
        for (int i = 0; i < 16; ++i) { const int row = 32 * half + crow(i, h);
            B1[row * 72 + c0] = (bf16_t)f2bf(c0 <= row ? s0[i] : 0.f); B1[row * 72 + 32 + c0] = (bf16_t)f2bf(32 + c0 <= row ? s1[i] : 0.f); }
        __syncthreads();
        f32x16 o0 = mma_lds<64>(B1 + 32 * half * 72, 72, B2, 72, zero16(), lane);
        f32x16 o1 = mma_lds<64>(B1 + 32 * half * 72, 72, B2 + 32 * 72, 72, zero16(), lane);
        __syncthreads();
        {
          u32x4 wsl[4], wg[4];
          const bf16_t* sp = SL2 + (size_t)item * 4096 + (32 * half) * 64;
#pragma unroll
          for (int e = 0; e < 4; ++e) { const int pc = lane + 64 * e; wsl[e] = *(const u32x4*)(sp + pc * 8); wg[e] = *(const u32x4*)(zsrc + (size_t)(16 * e) * DIN + ZG); }
#pragma unroll
          for (int e = 0; e < 4; ++e) { const int pc = lane + 64 * e, row = pc >> 3, k0 = (pc & 7) * 8; const LAS float* eg = GL + k0;
              u32x4 o; o.x = pk2(bflo(wsl[e].x) * eg[0], bfhi(wsl[e].x) * eg[1]); o.y = pk2(bflo(wsl[e].y) * eg[2], bfhi(wsl[e].y) * eg[3]);
              o.z = pk2(bflo(wsl[e].z) * eg[4], bfhi(wsl[e].z) * eg[5]); o.w = pk2(bflo(wsl[e].w) * eg[6], bfhi(wsl[e].w) * eg[7]);
              *(LAS u32x4*)(B2 + (32 * half + row) * 72 + k0) = o;
              *(LAS u32x4*)(lds + sdst + 9216 + e * 16 * 144) = wg[e]; } }
        __syncthreads();
        o0 = mma_lds<64>(B0 + 32 * half * 72, 72, B2, 72, o0, lane);
        o1 = mma_lds<64>(B0 + 32 * half * 72, 72, B2 + 32 * 72, 72, o1, lane);
        const float* ng = p.in[I_HNG] + l * 256 + hd * 64; const float ng0 = ng[c0], ng1 = ng[32 + c0];
#pragma unroll
        for (int i = 0; i < 16; ++i) { const int row = 32 * half + crow(i, h);
            const float ss = half_sum(o0[i] * o0[i] + o1[i] * o1[i]); const float rs = rsqrtf(ss * (1.0f / 64.0f) + EPS);
            const float g0 = bf2f(B1[row * 72 + c0]), g1 = bf2f(B1[row * 72 + 32 + c0]);
            const float v0 = o0[i] * rs * ng0 * g0 * sigmoidf_(g0), v1 = o1[i] * rs * ng1 * g1 * sigmoidf_(g1);
            o0[i] = v0; o1[i] = v1; const float s2 = half_sum(v0 * v0 + v1 * v1); if (c0 == 0) SSA[hd * 64 + row] = s2; }
        __syncthreads();
        bf16_t* Y = (bf16_t*)(p.ws + WS_YCAT);
#pragma unroll
        for (int i = 0; i < 16; ++i) { const int row = 32 * half + crow(i, h); const size_t tok = (size_t)cg * 64 + row;
            const float tot = (SSA[row] + SSA[64 + row]) + (SSA[128 + row] + SSA[192 + row]); const float r2 = rsqrtf(tot * (1.0f / 256.0f) + EPS);
            Y[tok * D + YA + hd * 64 + c0] = (bf16_t)f2bf(o0[i] * r2); Y[tok * D + YA + hd * 64 + 32 + c0] = (bf16_t)f2bf(o1[i] * r2); }
    }
}
DI void hgrn_scan_item(const Params& p, int hb) {
    int tid_o = threadIdx.x; asm volatile("" : "+v"(tid_o));
    const int e = hb * 512 + tid_o, bh = e >> 12, b = bh >> 2, hd = bh & 3, vk = e & 4095, k = vk & 63;
    const bf16_t* SL = (const bf16_t*)(p.ws + WS_SL); bf16_t* SL2 = (bf16_t*)(p.ws + WS_SL2); const float* DEC = (const float*)(p.ws + WS_DEC);
    float st = 0.f;
    for (int c8 = 0; c8 < 128; c8 += 16) { float tmp[16], dc[16];
#pragma unroll
        for (int u = 0; u < 16; ++u) { const int item = (b * 128 + c8 + u) * 4 + hd; tmp[u] = bf2f(SL[(size_t)item * 4096 + vk]); dc[u] = DEC[item * 64 + k]; }
#pragma unroll
        for (int u = 0; u < 16; ++u) { const int item = (b * 128 + c8 + u) * 4 + hd; SL2[(size_t)item * 4096 + vk] = (bf16_t)f2bf(st); st = dc[u] * st + tmp[u]; } }
}

DI void conv_item(const Params& p, LAS unsigned char* lds, int l, int ti) {
    int tid_o = threadIdx.x; asm volatile("" : "+v"(tid_o));
    const int tid = tid_o, lane = tid & 63, wave = tid >> 6, c = tid & 255, hf = tid >> 8, wv = wave & 3;
    LAS float* Hs = (LAS float*)lds; LAS float* ST = (LAS float*)(lds + 98304); LAS float* ST2 = ST + 512;
    const bf16_t* Z = (const bf16_t*)(p.ws + WS_Z); bf16_t* Y = (bf16_t*)(p.ws + WS_YCAT);
    const int tok0 = ti * 64, pos0 = (ti & 127) * 64;
    __syncthreads();
    for (int it0 = 0; it0 < 48; it0 += 8) { bf16_t vv[8], gg[8];
#pragma unroll
        for (int e = 0; e < 8; ++e) { const int row = 2 * (it0 + e) + hf, pos = pos0 - 30 + row; const bool ok = (row < 94) && (pos >= 0);
            const size_t tok = ok ? (size_t)(tok0 - 30 + row) : (size_t)tok0; vv[e] = Z[tok * DIN + ZBV + c]; gg[e] = Z[tok * DIN + ZBG + c]; }
#pragma unroll
        for (int e = 0; e < 8; ++e) { const int row = 2 * (it0 + e) + hf, pos = pos0 - 30 + row; const bool ok = (row < 94) && (pos >= 0);
            if (row < 94) Hs[row * 256 + c] = ok ? bf2f(vv[e]) * sigmoidf_(bf2f(gg[e])) : 0.f; } }
    __syncthreads();
    const float* cw = p.in[I_CW] + (size_t)l * 31 * 256 + c; float w[31];
#pragma unroll
    for (int jj = 0; jj < 31; ++jj) w[jj] = cw[jj * 256];
    const float cb = p.in[I_CB][l * 256 + c];
    const float lng = p.in[I_CLG][l * 256 + c], lnb = p.in[I_CLB][l * 256 + c];
#pragma unroll 1
    for (int ps = 0; ps < 2; ++ps) { const int tb = hf * 32 + ps * 16;
        float o[16];
        { float hr[46];
#pragma unroll
          for (int r = 0; r < 46; ++r) hr[r] = Hs[(tb + r) * 256 + c];
#pragma unroll
          for (int j = 0; j < 16; ++j) { float a = cb;
#pragma unroll
            for (int jj = 0; jj < 31; ++jj) a += w[jj] * hr[j + jj];
            o[j] = a; } }
#pragma unroll
        for (int j = 0; j < 16; ++j) { const float s1 = wave_sum(o[j]), s2 = wave_sum(o[j] * o[j]); if (lane == 0) { ST[((tb + j) * 4 + wv) * 2] = s1; ST[((tb + j) * 4 + wv) * 2 + 1] = s2; } }
        __syncthreads();
#pragma unroll
        for (int j = 0; j < 16; ++j) { const LAS float* q = ST + (tb + j) * 8; const float s1 = (q[0] + q[2]) + (q[4] + q[6]), s2 = (q[1] + q[3]) + (q[5] + q[7]);
            const float mu = s1 * (1.0f / 256.0f); const float var = fmaxf(s2 * (1.0f / 256.0f) - mu * mu, 0.f);
            const float y = (o[j] - mu) * rsqrtf(var + EPS) * lng + lnb; const float sv = y * sigmoidf_(y); o[j] = sv;
            const float s3 = wave_sum(sv * sv); if (lane == 0) ST2[(tb + j) * 4 + wv] = s3; }
        __syncthreads();
#pragma unroll
        for (int j = 0; j < 16; ++j) { const LAS float* q = ST2 + (tb + j) * 4; const float tot = (q[0] + q[1]) + (q[2] + q[3]); const float rs = rsqrtf(tot * (1.0f / 256.0f) + EPS);
            Y[(size_t)(tok0 + tb + j) * D + YB + c] = (bf16_t)f2bf(o[j] * rs); }
    }
}

DI bf16x8 ldg8(const bf16_t* p) { return *(const bf16x8*)p; }
DI void s5_local_item(const Params& p, int l, int bi) {
    int tid_o = threadIdx.x; asm volatile("" : "+v"(tid_o));
    const int lane = tid_o & 63, wi = bi * 8 + (tid_o >> 6);
    const int g = wi & 15, cb = (wi >> 4) & 15, pt = wi >> 8, c0 = lane & 31, h = lane >> 5;
    const bf16_t* ua = (const bf16_t*)(p.ws + WS_Z) + (size_t)((cb * 32 + c0) * 64) * DIN + ZCU + g * 16 + 8 * h;
    const bf16_t* wb = (const bf16_t*)(p.ws + WS_S5WS) + ((size_t)(l * 16 + g) * 128 + pt * 32 + c0) * 1024 + 8 * h;
    f32x16 acc = zero16();
#pragma unroll 8
    for (int s = 0; s < 64; ++s) acc = __builtin_amdgcn_mfma_f32_32x32x16_bf16(ldg8(ua + (size_t)s * DIN), ldg8(wb + s * 16), acc, 0, 0, 0);
    float* HL = (float*)(p.ws + WS_S5H);
#pragma unroll
    for (int i = 0; i < 16; ++i) HL[((size_t)(cb * 32 + crow(i, h)) * 16 + g) * 128 + pt * 32 + c0] = acc[i];
}
DI void s5_scan_item(const Params& p, int l, int sb) {
    int tid_o = threadIdx.x; asm volatile("" : "+v"(tid_o));
    const int e = sb * 512 + tid_o, b = e >> 10, g = (e >> 6) & 15, pp = e & 63;
    float lrdt, lidt, cr, ci; s5_params(p, l * 16 + g, pp, lrdt, lidt, cr, ci);
    float ar, ai; s5_pow(lrdt, lidt, 64, ar, ai);
    const float* HL = (const float*)(p.ws + WS_S5H); float* HO = (float*)(p.ws + WS_S5H2); float hr = 0.f, hi = 0.f;
    for (int c8 = 0; c8 < 128; c8 += 16) { float tr[16], ti[16];
#pragma unroll
        for (int u = 0; u < 16; ++u) { const size_t idx = ((size_t)(b * 128 + c8 + u) * 16 + g) * 128; tr[u] = HL[idx + pp]; ti[u] = HL[idx + 64 + pp]; }
#pragma unroll
        for (int u = 0; u < 16; ++u) { const size_t idx = ((size_t)(b * 128 + c8 + u) * 16 + g) * 128; HO[idx + pp] = hr; HO[idx + 64 + pp] = hi;
            const float nr = ar * hr - ai * hi + tr[u], ni = ar * hi + ai * hr + ti[u]; hr = nr; hi = ni; } }
}
DI void s5_out_item(const Params& p, LAS unsigned char* lds, int l, int bi) {
    int tid_o = threadIdx.x; asm volatile("" : "+v"(tid_o));
    const int tid = tid_o, lane = tid & 63, wave = tid >> 6;
    const int gh = bi & 1, cb = (bi >> 1) & 15, pr = bi >> 5, g = gh * 8 + wave, c0 = lane & 31, h = lane >> 5, lg = l * 16 + g;
    LAS bf16_t* OT = (LAS bf16_t*)lds;
    const bf16_t* Z = (const bf16_t*)(p.ws + WS_Z);
    const bf16_t* ua = Z + (size_t)((cb * 32 + c0) * 64) * DIN + ZCU + g * 16 + 8 * h;
    const bf16_t* kt = (const bf16_t*)(p.ws + WS_S5K) + (size_t)lg * 64 * 256;
    const float* ha = (const float*)(p.ws + WS_S5H2) + ((size_t)(cb * 32 + c0) * 16 + g) * 128 + 8 * h;
    const int co = c0 & 15; const float dsk = p.in[I_S5D][l * 256 + g * 16 + co];
    __syncthreads();
    for (int q = 0; q < 2; ++q) { const int jt = q ? 31 - pr : pr; const int tl = 2 * jt + (c0 >> 4);
        f32x16 acc = zero16();
        const bf16_t* wc = (const bf16_t*)(p.ws + WS_S5WC) + (((size_t)lg * 64 + tl) * 16 + co) * 128 + 8 * h;
        { f32x4 x0[8], x1[8]; bf16x8 wv[8];
#pragma unroll
          for (int ks = 0; ks < 8; ++ks) { x0[ks] = *(const f32x4*)(ha + ks * 16); x1[ks] = *(const f32x4*)(ha + ks * 16 + 4); wv[ks] = ldg8(wc + ks * 16); }
#pragma unroll
          for (int ks = 0; ks < 8; ++ks) { u32x4 w; w.x = pk2(x0[ks][0], x0[ks][1]); w.y = pk2(x0[ks][2], x0[ks][3]); w.z = pk2(x1[ks][0], x1[ks][1]); w.w = pk2(x1[ks][2], x1[ks][3]);
            acc = __builtin_amdgcn_mfma_f32_32x32x16_bf16(__builtin_bit_cast(bf16x8, w), wv[ks], acc, 0, 0, 0); } }
        const int ns = (2 * jt + 2 + 7) & ~7;
        for (int s0 = 0; s0 < ns; s0 += 8) { bf16x8 av[8], bv[8];
#pragma unroll
            for (int e = 0; e < 8; ++e) { const int s = s0 + e, d = tl - s, dc = d < 0 ? 0 : d;
                av[e] = ldg8(ua + (size_t)s * DIN); bv[e] = ldg8(kt + ((size_t)dc * 16 + co) * 16 + 8 * h); }
#pragma unroll
            for (int e = 0; e < 8; ++e) { const int d = tl - (s0 + e); bf16x8 b = bv[e]; if (d < 0) b = (bf16x8){0, 0, 0, 0, 0, 0, 0, 0};
                acc = __builtin_amdgcn_mfma_f32_32x32x16_bf16(av[e], b, acc, 0, 0, 0); } }
#pragma unroll
        for (int i = 0; i < 16; ++i) { const int m = crow(i, h); const size_t tok = (size_t)(cb * 32 + m) * 64 + tl; const float u = bf2f(Z[tok * DIN + ZCU + g * 16 + co]);
            const float y = acc[i] + dsk * u; const float ge = y * sigmoidf_(1.5957691216057308f * (y + 0.044715f * y * y * y));
            OT[(q * 64 + m * 2 + (c0 >> 4)) * 136 + wave * 16 + co] = (bf16_t)f2bf(ge); }
    }
    __syncthreads();
    { const int tau = tid >> 2, qq = tau >> 6, m = (tau >> 1) & 31, t2 = tau & 1, qt = tid & 3; const int jt = qq ? 31 - pr : pr;
      const size_t tok = (size_t)(cb * 32 + m) * 64 + 2 * jt + t2;
      const LAS u32x4* src = (const LAS u32x4*)(OT + tau * 136 + qt * 32); u32x4* dst = (u32x4*)((bf16_t*)(p.ws + WS_YPRE) + tok * 256 + gh * 128 + qt * 32);
#pragma unroll
      for (int e = 0; e < 4; ++e) dst[e] = src[e]; }
}

DI void attn_item(const Params& p, LAS unsigned char* lds, int l, int pt, int id) {
    int tid_o = threadIdx.x; asm volatile("" : "+v"(tid_o));
    const int tid = tid_o, lane = tid & 63, wave = tid >> 6;
    const int dil = pt == 0 ? 1 : (pt == 1 ? 4 : 16), nblk = 32 / dil;
    const int b = id >> 7, hd = (id >> 5) & 3, rn = id & 31, r = rn / nblk, n = rn % nblk;
    LAS bf16_t* Ks = (LAS bf16_t*)lds;
    LAS bf16_t* Vt = (LAS bf16_t*)(lds + 55296);
    LAS float* BT = (LAS float*)(lds + 55296 + 50176);
    const bf16_t* Z = (const bf16_t*)(p.ws + WS_Z);
    const bf16_t* OP = (const bf16_t*)(p.ws + (pt == 1 ? WS_O0 : WS_O1)); const float* LP = (const float*)(p.ws + (pt == 1 ? WS_LSE : WS_LSE1));
    bf16_t* ON = pt == 2 ? (bf16_t*)(p.ws + WS_Z) + ZOD : (bf16_t*)(p.ws + (pt == 0 ? WS_O0 : WS_O1)); const int onp = pt == 2 ? DIN : 256;
    float* LN = (float*)(p.ws + (pt == 0 ? WS_LSE : WS_LSE1));
    const size_t tokb = (size_t)b * SEQ;
    __syncthreads();
    if (tid < 132) BT[tid] = ((const float*)(p.ws + WS_BIAS))[(pt * 4 + hd) * 132 + tid];
    { const float* kg = p.in[I_KG] + l * 64 + (tid & 7) * 8; float kgv[8];
#pragma unroll
      for (int e = 0; e < 8; ++e) kgv[e] = kg[e];
      u32x4 kwv[6], vwv[6];
#pragma unroll
      for (int it = 0; it < 6; ++it) { const int idx = tid + 512 * it, row = idx >> 3, c = idx & 7, si = n * 256 - 128 + row;
        const size_t tok = tokb + (size_t)(si < 0 ? 0 : si) * dil + r;
        kwv[it] = *(const u32x4*)(Z + tok * DIN + ZDK + hd * 64 + c * 8); vwv[it] = *(const u32x4*)(Z + tok * DIN + ZDV + hd * 64 + c * 8); }
#pragma unroll
      for (int it = 0; it < 6; ++it) { const int idx = tid + 512 * it, row = idx >> 3, c = idx & 7, si = n * 256 - 128 + row;
        u32x4 kw = kwv[it], vw = vwv[it];
        if (si < 0) { kw = (u32x4){0u, 0u, 0u, 0u}; vw = (u32x4){0u, 0u, 0u, 0u}; }
        float kf[8]; kf[0] = bflo(kw.x); kf[1] = bfhi(kw.x); kf[2] = bflo(kw.y); kf[3] = bfhi(kw.y); kf[4] = bflo(kw.z); kf[5] = bfhi(kw.z); kf[6] = bflo(kw.w); kf[7] = bfhi(kw.w);
        float ss = 0.f;
#pragma unroll
        for (int e = 0; e < 8; ++e) ss += kf[e] * kf[e];
        ss += __shfl_xor(ss, 1); ss += __shfl_xor(ss, 2); ss += __shfl_xor(ss, 4);
        const float rs = rsqrtf(ss * (1.0f / 64.0f) + EPS);
        u32x4 o; o.x = pk2(kf[0] * rs * kgv[0], kf[1] * rs * kgv[1]); o.y = pk2(kf[2] * rs * kgv[2], kf[3] * rs * kgv[3]); o.z = pk2(kf[4] * rs * kgv[4], kf[5] * rs * kgv[5]); o.w = pk2(kf[6] * rs * kgv[6], kf[7] * rs * kgv[7]);
        *(LAS u32x4*)(Ks + row * 72 + c * 8) = o;
        LAS bf16_t* vp = Vt + (c * 8) * 392 + row;
        vp[0 * 392] = (bf16_t)(vw.x & 0xffffu); vp[1 * 392] = (bf16_t)(vw.x >> 16); vp[2 * 392] = (bf16_t)(vw.y & 0xffffu); vp[3 * 392] = (bf16_t)(vw.y >> 16);
        vp[4 * 392] = (bf16_t)(vw.z & 0xffffu); vp[5 * 392] = (bf16_t)(vw.z >> 16); vp[6 * 392] = (bf16_t)(vw.w & 0xffffu); vp[7 * 392] = (bf16_t)(vw.w >> 16); } }
    __syncthreads();
    const int c0 = lane & 31, h = lane >> 5;
    const int qi = 32 * wave + c0; const size_t tokq = tokb + (size_t)(n * 256 + qi) * dil + r;
    bf16x8 qf[4];
    { float qv[4][8]; float ss = 0.f;
#pragma unroll
      for (int ks = 0; ks < 4; ++ks) { const u32x4 w = *(const u32x4*)(Z + tokq * DIN + ZDQ + hd * 64 + ks * 16 + 8 * h);
        qv[ks][0] = bflo(w.x); qv[ks][1] = bfhi(w.x); qv[ks][2] = bflo(w.y); qv[ks][3] = bfhi(w.y); qv[ks][4] = bflo(w.z); qv[ks][5] = bfhi(w.z); qv[ks][6] = bflo(w.w); qv[ks][7] = bfhi(w.w);
#pragma unroll
        for (int e = 0; e < 8; ++e) ss += qv[ks][e] * qv[ks][e]; }
      ss += __shfl_xor(ss, 32);
      const float rs = rsqrtf(ss * (1.0f / 64.0f) + EPS) * 0.125f;
#pragma unroll
      for (int ks = 0; ks < 4; ++ks) { const float* qg = p.in[I_QG] + l * 64 + ks * 16 + 8 * h; const f32x4 g0 = *(const f32x4*)qg, g1 = *(const f32x4*)(qg + 4);
        u32x4 w; w.x = pk2(qv[ks][0] * rs * g0[0], qv[ks][1] * rs * g0[1]); w.y = pk2(qv[ks][2] * rs * g0[2], qv[ks][3] * rs * g0[3]);
        w.z = pk2(qv[ks][4] * rs * g1[0], qv[ks][5] * rs * g1[1]); w.w = pk2(qv[ks][6] * rs * g1[2], qv[ks][7] * rs * g1[3]);
        qf[ks] = __builtin_bit_cast(bf16x8, w); } }
    f32x16 acc[5];
#pragma unroll
    for (int c = 0; c < 5; ++c) { acc[c] = zero16(); const LAS bf16_t* kb = Ks + (32 * wave + 32 * c + c0) * 72 + 8 * h;
#pragma unroll
        for (int ks = 0; ks < 4; ++ks) acc[c] = __builtin_amdgcn_mfma_f32_32x32x16_bf16(*(const LAS bf16x8*)(kb + ks * 16), qf[ks], acc[c], 0, 0, 0); }
    float mx = -1e30f;
#pragma unroll
    for (int c = 0; c < 5; ++c)
#pragma unroll
        for (int i = 0; i < 16; ++i) { const int kr = crow(i, h); const int delta = 128 + c0 - 32 * c - kr; const int jl = 32 * wave + 32 * c + kr;
            const bool valid = (delta >= 0) && (delta <= 128) && (n * 256 - 128 + jl >= 0);
            const int dcl = delta < 0 ? 0 : (delta > 128 ? 128 : delta);
            const float lgt = valid ? acc[c][i] + BT[dcl] : -1e30f; acc[c][i] = lgt; mx = fmaxf(mx, lgt); }
    mx = fmaxf(mx, __shfl_xor(mx, 32));
    float mprev = 0.f, mnew = mx;
    if (pt > 0) { mprev = LP[tokq * 4 + hd]; mnew = fmaxf(mx, mprev); }
    float lsum = 0.f;
#pragma unroll
    for (int c = 0; c < 5; ++c)
#pragma unroll
        for (int i = 0; i < 16; ++i) { const float pv = __expf(acc[c][i] - mnew); acc[c][i] = pv; lsum += pv; }
    lsum += __shfl_xor(lsum, 32);
    f32x16 o[2]; o[0] = zero16(); o[1] = zero16();
#pragma unroll
    for (int c = 0; c < 5; ++c)
#pragma unroll
        for (int s = 0; s < 2; ++s) { u32x4 pw; pw.x = pk2(acc[c][8 * s + 0], acc[c][8 * s + 1]); pw.y = pk2(acc[c][8 * s + 2], acc[c][8 * s + 3]); pw.z = pk2(acc[c][8 * s + 4], acc[c][8 * s + 5]); pw.w = pk2(acc[c][8 * s + 6], acc[c][8 * s + 7]);
            const bf16x8 pf = __builtin_bit_cast(bf16x8, pw);
#pragma unroll
            for (int vt = 0; vt < 2; ++vt) { const LAS bf16_t* va = Vt + (32 * vt + c0) * 392 + 32 * wave + 32 * c + 16 * s + 4 * h;
                const s16x4 lo = *(const LAS s16x4*)va, hi = *(const LAS s16x4*)(va + 8);
                const bf16x8 vf = __builtin_shufflevector(lo, hi, 0, 1, 2, 3, 4, 5, 6, 7);
                o[vt] = __builtin_amdgcn_mfma_f32_32x32x16_bf16(vf, pf, o[vt], 0, 0, 0); } }
    float sp = 0.f; if (pt > 0) sp = __expf(mprev - mnew);
    const float ltot = lsum + sp, inv = 1.0f / ltot;
#pragma unroll
    for (int vt = 0; vt < 2; ++vt)
#pragma unroll
        for (int g4 = 0; g4 < 4; ++g4) { const int ch = hd * 64 + 32 * vt + 8 * g4 + 4 * h; bf16_t* yo = ON + tokq * onp + ch;
            float v0 = o[vt][4 * g4 + 0], v1 = o[vt][4 * g4 + 1], v2 = o[vt][4 * g4 + 2], v3 = o[vt][4 * g4 + 3];
            if (pt > 0) { const u32x2 w = *(const u32x2*)(OP + tokq * 256 + ch); v0 += sp * bflo(w.x); v1 += sp * bfhi(w.x); v2 += sp * bflo(w.y); v3 += sp * bfhi(w.y); }
            u32x2 w; w.x = pk2(v0 * inv, v1 * inv); w.y = pk2(v2 * inv, v3 * inv); *(u32x2*)yo = w; }
    if (h == 0 && pt < 2) __hip_atomic_store(LN + tokq * 4 + hd, mnew + __logf(ltot), __ATOMIC_RELAXED, __HIP_MEMORY_SCOPE_AGENT);
}

#ifndef MIX_A
#define MIX_A 1
#endif
#ifndef MIX_B
#define MIX_B 1
#endif
#ifndef MIX_C
#define MIX_C 1
#endif
#ifndef MIX_D
#define MIX_D 1
#endif
__global__ void __launch_bounds__(512, 2) hybrid_fwd(Params p) {
    extern __shared__ __attribute__((aligned(16))) unsigned char lds_raw[];
    LAS unsigned char* lds = (LAS unsigned char*)lds_raw;
    cg::grid_group grid = cg::this_grid();
    const int G = gridDim.x, bid = blockIdx.x;
    unsigned char* ws = p.ws;
    bf16_t* XB = (bf16_t*)(ws + WS_XB); bf16_t* Zb = (bf16_t*)(ws + WS_Z); bf16_t* YC_ = (bf16_t*)(ws + WS_YCAT); bf16_t* HM = (bf16_t*)(ws + WS_HM);
    float* SSQP = (float*)(ws + WS_SSQP);

#define GRID_SYNC() do { asm volatile("s_waitcnt vmcnt(0) lgkmcnt(0)" ::: "memory"); grid.sync(); if (threadIdx.x < 64) { __builtin_amdgcn_fence(__ATOMIC_ACQUIRE, "agent"); asm volatile("s_waitcnt vmcnt(0)" ::: "memory"); } __syncthreads(); } while (0)
    prologue(p, lds, G);
#ifdef NANFILL
    { u32x4* q = (u32x4*)(ws + WS_S5H); const size_t n16 = (WS_END - WS_S5H) / 16; const u32x4 nanv = (u32x4){0xffffffffu, 0xffffffffu, 0xffffffffu, 0xffffffffu};
      for (size_t i = (size_t)bid * 512 + threadIdx.x; i < n16; i += (size_t)G * 512) q[i] = nanv;
      u32x4* q2 = (u32x4*)(ws + WS_LSE); const size_t m16 = (WS_S5K - WS_LSE) / 16;
      for (size_t i = (size_t)bid * 512 + threadIdx.x; i < m16; i += (size_t)G * 512) q2[i] = nanv; }
#endif
    GRID_SYNC();

#ifndef NL_RUN
#define NL_RUN NL
#endif
#ifndef DUMP_LAYER
#define DUMP_LAYER 0
#endif
    for (int lrun = 0; lrun < NL_RUN; ++lrun) {
#ifdef SAME_LAYER
        const int l = 0; const bool firstl = (lrun == 0), lastl = (lrun == NL_RUN - 1);
#else
        const int l = lrun; const bool firstl = (lrun == 0), lastl = (lrun == NL_RUN - 1);
#endif
        { pg8::Gemm g{XB, (const bf16_t*)(ws + WS_WIN) + (size_t)l * D * DIN, T, DIN, D, D}; pg8::StaticOrder S; S.init(T, DIN, G, bid);
          pg8::EpiScale E{Zb, DIN, SSQP, 0};
          pg8::gemm_phase<pg8::EpiScale, pg8::StaticOrder, true, true>(lds, g, S, E); }
        GRID_SYNC();
#ifndef SKIP_MIX
        if (!(MIX_A && MIX_B && MIX_C && MIX_D)) { int tq = threadIdx.x; asm volatile("" : "+v"(tq));
          for (int m = bid * 8 + (tq >> 6); m < T; m += G * 8) { u32x2* yp = (u32x2*)(YC_ + (size_t)m * D) + (tq & 63); const u32x2 z2 = (u32x2){0u, 0u};
              if (!MIX_A) yp[0] = z2; if (!MIX_B) yp[64] = z2; if (!MIX_C) yp[128] = z2; if (!MIX_D) yp[192] = z2; } }
#ifndef MIX_REPEAT
#define MIX_REPEAT 1
#endif
        for (int rep = 0; rep < MIX_REPEAT; ++rep) {
        for (int it = bid; it < 1664; it += G) {
            if (it < 512) { if (MIX_A) hgrn_item<false>(p, lds, l, it); }
            else if (it < 1024) { if (MIX_B) conv_item(p, lds, l, it - 512); }
            else if (it < 1152) { if (MIX_C) s5_local_item(p, l, it - 1024); }
            else { if (MIX_D) attn_item(p, lds, l, 0, it - 1152); }
        }
        GRID_SYNC();
        for (int it = bid; it < 648; it += G) {
            if (it < 128) { if (MIX_A) hgrn_scan_item(p, it); }
            else if (it < 136) { if (MIX_C) s5_scan_item(p, l, it - 128); }
            else { if (MIX_D) attn_item(p, lds, l, 1, it - 136); }
        }
        GRID_SYNC();
        for (int it = bid; it < 1536; it += G) {
            if (it < 512) { if (MIX_A) hgrn_item<true>(p, lds, l, it); }
            else if (it < 1024) { if (MIX_C) s5_out_item(p, lds, l, it - 512); }
            else { if (MIX_D) attn_item(p, lds, l, 2, it - 1024); }
        }
        GRID_SYNC();
        }
#ifndef NO_GLU
        { pg8::Gemm g{(const bf16_t*)(ws + WS_YPRE), (const bf16_t*)(ws + WS_WGLU) + (size_t)l * 65536, T, 256, 256, 256}; pg8::StaticOrder S; S.init(T, 256, G, bid);
          pg8::EpiGlu E{(const bf16_t*)(ws + WS_YPRE), 256, YC_ + YC};
          pg8::gemm_phase<pg8::EpiGlu, pg8::StaticOrder, false, true>(lds, g, S, E); }
#endif
        { int tq = threadIdx.x; asm volatile("" : "+v"(tq)); const int lane = tq & 63; const int gw = bid * 8 + (tq >> 6), NGW = G * 8;
          for (int m = gw; m < T; m += NGW) { u32x2* yp = (u32x2*)(YC_ + (size_t)m * D + YD) + lane; const u32x2 w = *((const u32x2*)(Zb + (size_t)m * DIN + ZOD) + lane);
              const float a0 = bflo(w.x), a1 = bfhi(w.x), a2 = bflo(w.y), a3 = bfhi(w.y);
              const float ss = wave_sum((a0 * a0 + a1 * a1) + (a2 * a2 + a3 * a3)); const float rs = rsqrtf(ss * (1.0f / 256.0f) + EPS);
              u32x2 o; o.x = pk2(a0 * rs, a1 * rs); o.y = pk2(a2 * rs, a3 * rs); *yp = o; } }
        GRID_SYNC();
#endif
#ifdef DUMP_SLICE
        if (lrun == DUMP_LAYER) { int tq = threadIdx.x; asm volatile("" : "+v"(tq));
          for (int m = bid * 8 + (tq >> 6); m < T; m += G * 8) { const int ln = tq & 63;
              for (int j = 0; j < 4; ++j) { const int col = j * 256 + ln * 4; const u32x2 w = *(const u32x2*)(YC_ + (size_t)m * D + col);
                  f32x4 o = (f32x4){0.f, 0.f, 0.f, 0.f}; if (j == DUMP_SLICE) o = (f32x4){bflo(w.x), bfhi(w.x), bflo(w.y), bfhi(w.y)};
                  *(f32x4*)(p.out + (size_t)m * D + col) = o; } }
          break; }
#endif
#ifdef SKIP_MIX
        { pg8::Gemm g{Zb, (const bf16_t*)(ws + WS_WOUT) + (size_t)l * D * D, T, D, D, DIN}; pg8::StaticOrder S; S.init(T, D, G, bid);
#else
        { pg8::Gemm g{YC_, (const bf16_t*)(ws + WS_WOUT) + (size_t)l * D * D, T, D, D, D}; pg8::StaticOrder S; S.init(T, D, G, bid);
#endif
          pg8::EpiRes E{firstl ? p.in[I_X] : p.out, p.out, XB, SSQP + (size_t)T * 16};
          pg8::gemm_phase<pg8::EpiRes, pg8::StaticOrder, true, true>(lds, g, S, E); }
        GRID_SYNC();
        { pg8::Gemm g{XB, (const bf16_t*)(ws + WS_WUP) + (size_t)l * D * FF, T, FF, D, D}; pg8::StaticOrder S; S.init(T, FF, G, bid);
          pg8::EpiScale E{HM, FF, SSQP + (size_t)T * 16, 1};
          pg8::gemm_phase<pg8::EpiScale, pg8::StaticOrder, true, true>(lds, g, S, E); }
        GRID_SYNC();
        { pg8::Gemm g{HM, (const bf16_t*)(ws + WS_WDN) + (size_t)l * D * FF, T, D, FF, FF}; pg8::StaticOrder S; S.init(T, D, G, bid);
          pg8::EpiRes E{p.out, p.out, XB, !lastl ? SSQP : nullptr};
          pg8::gemm_phase<pg8::EpiRes, pg8::StaticOrder, true, true>(lds, g, S, E); }
        if (!lastl) GRID_SYNC();
    }
}

extern "C" void kernel_launch(void* const* d_in, const int* in_sizes, int n_in, void* d_out, int out_size, void* d_ws, size_t ws_size, hipStream_t stream) {
    static int grid = 0;
    if (grid == 0) {
        if (n_in != 26 || out_size != T * D || ws_size < WS_END) { fprintf(stderr, "kernel_launch: unexpected shapes (n_in %d, out %d, ws %zu); nothing launched\n", n_in, out_size, ws_size); grid = -1; return; }
        int dev = 0, cus = 0, per_cu = 0;
        (void)hipGetDevice(&dev); (void)hipDeviceGetAttribute(&cus, hipDeviceAttributeMultiprocessorCount, dev);
        if (hipFuncSetAttribute((const void*)hybrid_fwd, hipFuncAttributeMaxDynamicSharedMemorySize, LDS_BYTES) != hipSuccess) { fprintf(stderr, "kernel_launch: hipFuncSetAttribute failed\n"); grid = -1; return; }
        if (hipOccupancyMaxActiveBlocksPerMultiprocessor(&per_cu, (const void*)hybrid_fwd, 512, LDS_BYTES) != hipSuccess || per_cu < 1) { fprintf(stderr, "kernel_launch: occupancy query gave %d\n", per_cu); per_cu = 1; }
        (void)hipGetLastError();
        if (cus <= 0) cus = 256;
        grid = cus * per_cu;
    }
    if (grid < 0) return;
    Params a{};
    for (int i = 0; i < 26; ++i) a.in[i] = (const float*)d_in[i];
    a.out = (float*)d_out; a.ws = (unsigned char*)d_ws;
    void* args[] = {&a};
    hipError_t e = hipLaunchCooperativeKernel((const void*)hybrid_fwd, dim3(grid), dim3(512), args, LDS_BYTES, stream);
    if (e != hipSuccess) fprintf(stderr, "cooperative launch failed: %s (grid %d)\n", hipGetErrorString(e), grid);
}
```

```cpp
#include <hip/hip_runtime.h>
#include <hip/hip_cooperative_groups.h>
#include <cstdio>
#include <cstdint>
namespace cg = cooperative_groups;

#define DI __device__ __forceinline__
#define LAS __attribute__((address_space(3)))
typedef unsigned short bf16_t;
typedef short bf16x8 __attribute__((ext_vector_type(8)));
typedef short s16x4 __attribute__((ext_vector_type(4)));
typedef float f32x4 __attribute__((ext_vector_type(4)));
typedef float f32x16 __attribute__((ext_vector_type(16)));
typedef unsigned u32x4 __attribute__((ext_vector_type(4)));
typedef unsigned u32x2 __attribute__((ext_vector_type(2)));

constexpr int NB = 4, SEQ = 8192, T = NB * SEQ, D = 1024, DIN = 2560, FF = 4096, NL = 4;
constexpr int ZQ = 0, ZF = 256, ZI = 512, ZG = 768, ZBV = 1024, ZBG = 1280, ZCU = 1536, ZDQ = 1792, ZDK = 2048, ZDV = 2304;
constexpr int YA = 0, YB = 256, YC = 512, YD = 768;
constexpr int ZOD = ZBG;
constexpr float EPS = 1e-6f;
constexpr size_t MiB = 1u << 20;
constexpr size_t WS_WIN = 0, WS_WOUT = 20 * MiB, WS_WUP = 28 * MiB, WS_WDN = 60 * MiB, WS_WGLU = 92 * MiB;
constexpr size_t WS_LB = 93 * MiB;
constexpr size_t WS_BIAS = WS_LB + 4096;
constexpr size_t WS_SSQ = WS_LB + 65536;
constexpr size_t WS_LSE = WS_SSQ + 8 * (size_t)T * 4;
constexpr size_t WS_DEC = WS_LSE + (size_t)T * 16;
constexpr size_t WS_LSE1 = WS_DEC + 2048 * 64 * 4;
constexpr size_t WS_S5K = 96 * MiB;
constexpr size_t WS_S5WS = 98 * MiB;
constexpr size_t WS_S5WC = 114 * MiB;
constexpr size_t WS_XB = 130 * MiB;
constexpr size_t WS_S5H = 194 * MiB;
constexpr size_t WS_HM = 198 * MiB;
constexpr size_t WS_Z = 198 * MiB;
constexpr size_t WS_YCAT = 358 * MiB;
constexpr size_t WS_SL = 422 * MiB, WS_SL2 = 438 * MiB;
constexpr size_t WS_S5H2 = 454 * MiB;
constexpr size_t WS_O0 = 458 * MiB, WS_O1 = 474 * MiB;
constexpr size_t WS_YPRE = 490 * MiB;
constexpr size_t WS_SSQP = 506 * MiB;
constexpr size_t WS_END = 510 * MiB;
static_assert(WS_LSE1 + (size_t)T * 16 <= WS_S5K, "misc region");

constexpr int LDS_BYTES = 147456;

DI unsigned f2bf(float f) { unsigned u = __builtin_bit_cast(unsigned, f); return (u + 0x7fffu + ((u >> 16) & 1u)) >> 16; }
typedef float f32x2_t __attribute__((ext_vector_type(2))); typedef __bf16 bf16x2_t __attribute__((ext_vector_type(2)));
DI unsigned pk2(float lo, float hi) { const f32x2_t v = {lo, hi}; const bf16x2_t b = __builtin_convertvector(v, bf16x2_t); return __builtin_bit_cast(unsigned, b); }
DI float bf2f(bf16_t v) { return __builtin_bit_cast(float, (unsigned)v << 16); }
DI float bflo(unsigned w) { return __builtin_bit_cast(float, w << 16); }
DI float bfhi(unsigned w) { return __builtin_bit_cast(float, w & 0xffff0000u); }
DI float sigmoidf_(float x) { return 1.f / (1.f + __expf(-x)); }
DI float wave_sum(float v) {
#pragma unroll
    for (int o = 1; o < 64; o <<= 1) v += __shfl_xor(v, o);
    return v;
}
DI float half_sum(float v) {
#pragma unroll
    for (int o = 1; o < 32; o <<= 1) v += __shfl_xor(v, o);
    return v;
}
#define LDS_WAIT() asm volatile("s_waitcnt lgkmcnt(0)" ::: "memory")
DI int crow(int reg, int h) { return (reg & 3) + 8 * (reg >> 2) + 4 * h; }

template <int K>
DI f32x16 mma_lds(const LAS bf16_t* A, int lda, const LAS bf16_t* B, int ldb, f32x16 acc, int lane) {
    const int r = lane & 31, h = lane >> 5;
    const LAS bf16_t* ap = A + r * lda + 8 * h; const LAS bf16_t* bp = B + r * ldb + 8 * h;
#pragma unroll
    for (int k0 = 0; k0 < K; k0 += 16) {
        const bf16x8 a = *(const LAS bf16x8*)(ap + k0); const bf16x8 b = *(const LAS bf16x8*)(bp + k0);
        acc = __builtin_amdgcn_mfma_f32_32x32x16_bf16(a, b, acc, 0, 0, 0);
    }
    return acc;
}
DI f32x16 zero16() { f32x16 z;
#pragma unroll
    for (int i = 0; i < 16; ++i) z[i] = 0.f;
    return z; }

namespace pg8 {
#define PG8_LAS __attribute__((address_space(3)))
constexpr int BM = 256, BK = 64, HALF = 128, HTB = HALF * BK * 2, STAGE_BYTES = 8 * HTB, NXCD = 8, WGM = 8;
__host__ __device__ __forceinline__ int lds_byte(int r, int c) { const int st = (r >> 4) * 2 + (c >> 5), rr = r & 15, cc = c & 31, ob = rr * 64 + cc * 2; return st * 1024 + (ob ^ (((ob >> 9) & 1) << 5)); }
__host__ __device__ __forceinline__ void stage_rc(int b, int& R, int& C) { const int st = b / 1024, sb = b % 1024, swz = sb ^ (((sb >> 9) & 1) << 5); R = (st >> 1) * 16 + swz / 64; C = (st & 1) * 32 + (swz % 64) / 2; }
__host__ __device__ __forceinline__ int perm32(int rho) { const int n = rho >> 4, i = rho & 15; return 8 * (i >> 2) + 4 * n + (i & 3); }
struct Unit { int pm, pn; };
struct Gemm { const bf16_t* A; const bf16_t* Bt; int M, N, K, lda; };
struct StaticOrder {
    int nM, nN, nwg, G, c;
    __host__ __device__ void init(int M, int N, int G_, int c_) { nM = M / BM; nN = N / BM; nwg = nM * nN; G = G_; c = c_; }
    __host__ __device__ bool next(int i, Unit& u) const {
        const long L = (long)i * G + c; if (L >= nwg) return false;
        int wgid = (int)L; { const int q = nwg / NXCD, r = nwg % NXCD, xcd = wgid % NXCD, off = wgid / NXCD; wgid = (xcd < r ? xcd * (q + 1) : r * (q + 1) + (xcd - r) * q) + off; }
        const int nig = WGM * nN, gid = wgid / nig, fm = gid * WGM, gsz = (nM - fm) < WGM ? (nM - fm) : WGM;
        u.pm = fm + ((wgid % nig) % gsz); u.pn = (wgid % nig) / gsz; return true;
    }
    __device__ __forceinline__ void a_ready(const Unit&) const {}
    __device__ __forceinline__ void done(const Unit&) const {}
};
struct EpiScale {
    static constexpr bool PERM = true, AFTER_DRAIN = false;
    bf16_t* O; int ldc; const float* ssq; int act;
    __device__ __forceinline__ void operator()(const f32x4 (&acc)[2][2][4][2], const Unit& u, int wr, int wc, int fr, int fq) const {
        const int row0 = u.pm * BM + wr * 64 + fr; const int col0 = u.pn * BM + wc * 32 + 8 * fq;
#pragma unroll
        for (int ai = 0; ai < 2; ++ai)
#pragma unroll
            for (int m = 0; m < 4; ++m) { const int r = row0 + ai * HALF + m * 16; const f32x4* sq = (const f32x4*)(ssq + (size_t)r * 16); const f32x4 q0 = sq[0], q1 = sq[1], q2 = sq[2], q3 = sq[3];
                const float tot = (((q0[0] + q0[1]) + (q0[2] + q0[3])) + ((q1[0] + q1[1]) + (q1[2] + q1[3]))) + (((q2[0] + q2[1]) + (q2[2] + q2[3])) + ((q3[0] + q3[1]) + (q3[2] + q3[3])));
                const float rs = rsqrtf(tot * (1.0f / 1024.0f) + EPS);
                bf16_t* rowp = O + (size_t)r * ldc + col0;
#pragma unroll
                for (int bj = 0; bj < 2; ++bj) { f32x4 v0 = acc[ai][bj][m][0] * rs, v1 = acc[ai][bj][m][1] * rs;
                    if (act) {
#pragma unroll
                        for (int e = 0; e < 4; ++e) { const float a = fmaxf(v0[e], 0.f), b = fmaxf(v1[e], 0.f); v0[e] = a * a; v1[e] = b * b; } }
                    u32x4 w; w.x = pk2(v0[0], v0[1]); w.y = pk2(v0[2], v0[3]); w.z = pk2(v1[0], v1[1]); w.w = pk2(v1[2], v1[3]);
                    *(u32x4*)(rowp + bj * HALF) = w; } }
    }
};
struct EpiRes {
    static constexpr bool PERM = false, AFTER_DRAIN = false;
    const float* base; float* out; bf16_t* xb; float* ssq_out;
    __device__ __forceinline__ void operator()(const f32x4 (&acc)[2][2][4][2], const Unit& u, int wr, int wc, int fr, int fq) const {
        const int col0 = u.pn * BM + wc * 32 + 4 * fq;
#pragma unroll
        for (int ai = 0; ai < 2; ++ai)
#pragma unroll
            for (int m = 0; m < 4; ++m) { const int r = u.pm * BM + ai * HALF + wr * 64 + m * 16 + fr; const size_t off = (size_t)r * D + col0; float s = 0.f;
#pragma unroll
                for (int bj = 0; bj < 2; ++bj)
#pragma unroll
                    for (int n = 0; n < 2; ++n) { const size_t o2 = off + bj * HALF + n * 16; const f32x4 o = *(const f32x4*)(base + o2) + acc[ai][bj][m][n];
                        *(f32x4*)(out + o2) = o; u32x2 w; w.x = pk2(o[0], o[1]); w.y = pk2(o[2], o[3]); *(u32x2*)(xb + o2) = w;
                        s += (o[0] * o[0] + o[1] * o[1]) + (o[2] * o[2] + o[3] * o[3]); }
                s += __shfl_xor(s, 16); s += __shfl_xor(s, 32);
                if (fq == 0 && ssq_out) ssq_out[(size_t)r * 16 + u.pn * 4 + wc] = s; }
    }
};
struct EpiGlu {
    static constexpr bool PERM = false, AFTER_DRAIN = true;
    const bf16_t* Ysrc; int lds_; bf16_t* Y;
    __device__ __forceinline__ void fused(f32x4 (&acc)[2][2][4][2], const Unit& u, int wr, int wc, int fr, int fq, PG8_LAS unsigned char* lds, int wid, int lane) const {
        PG8_LAS float* Pp = (PG8_LAS float*)lds;
        const int col0 = wc * 32 + 4 * fq;
#pragma unroll
        for (int ai = 0; ai < 2; ++ai)
#pragma unroll
            for (int m = 0; m < 4; ++m) { const int rl = ai * HALF + wr * 64 + m * 16 + fr; const size_t off = (size_t)(u.pm * BM + rl) * lds_ + col0; float s = 0.f;
#pragma unroll
                for (int bj = 0; bj < 2; ++bj)
#pragma unroll
                    for (int n = 0; n < 2; ++n) { const u32x2 w = *(const u32x2*)(Ysrc + off + bj * HALF + n * 16); f32x4 a = acc[ai][bj][m][n];
                        const float y0 = bflo(w.x), y1 = bfhi(w.x), y2 = bflo(w.y), y3 = bfhi(w.y);
                        a[0] = y0 * sigmoidf_(a[0]); a[1] = y1 * sigmoidf_(a[1]); a[2] = y2 * sigmoidf_(a[2]); a[3] = y3 * sigmoidf_(a[3]);
                        acc[ai][bj][m][n] = a; s += (a[0] * a[0] + a[1] * a[1]) + (a[2] * a[2] + a[3] * a[3]); }
                s += __shfl_xor(s, 16); s += __shfl_xor(s, 32);
                if (fq == 0) Pp[rl * 4 + wc] = s; }
        __syncthreads();
#pragma unroll
        for (int ai = 0; ai < 2; ++ai)
#pragma unroll
            for (int m = 0; m < 4; ++m) { const int rl = ai * HALF + wr * 64 + m * 16 + fr; const size_t off = (size_t)(u.pm * BM + rl) * D + col0;
                const float tot = (Pp[rl * 4 + 0] + Pp[rl * 4 + 1]) + (Pp[rl * 4 + 2] + Pp[rl * 4 + 3]); const float rs = rsqrtf(tot * (1.0f / 256.0f) + EPS);
#pragma unroll
                for (int bj = 0; bj < 2; ++bj)
#pragma unroll
                    for (int n = 0; n < 2; ++n) { const f32x4 a = acc[ai][bj][m][n] * rs; u32x2 w; w.x = pk2(a[0], a[1]); w.y = pk2(a[2], a[3]); *(u32x2*)(Y + off + bj * HALF + n * 16) = w; } }
    }
};

template <class Epi, class Sched, bool ALIGN_EPI = false, bool SP2 = false>
__device__ __forceinline__ void gemm_phase(PG8_LAS unsigned char* lds, const Gemm g, const Sched& S, const Epi& E) {
    int tid_o = threadIdx.x; asm volatile("" : "+v"(tid_o));
    const int tid = tid_o, wid = __builtin_amdgcn_readfirstlane(tid >> 6), lane = tid & 63, wr = wid >> 2, wc = wid & 3, fr = lane & 15, fq = lane >> 4;
    const int K = g.K, nt = K / BK;
    unsigned voffA[2], voffB[2];
#pragma unroll
    for (int i = 0; i < 2; ++i) { int R, C; stage_rc(tid * 16 + i * 8192, R, C); const int Rb = Epi::PERM ? ((R & ~31) + perm32(R & 31)) : R;
        voffA[i] = (unsigned)(R * g.lda + C) * 2u; voffB[i] = (unsigned)(Rb * K + C) * 2u; }
    const size_t kstep = (size_t)(BK * 2);
    const size_t hstepA = (size_t)HALF * g.lda * 2, hstepB = (size_t)HALF * K * 2;
    const size_t tstepA = 2 * hstepA, tstepB = 2 * hstepB;
    const unsigned ldsw = (unsigned)wid * 1024u;
    const int aoff = lds_byte(wr * 64 + fr, fq * 8), boff = lds_byte(wc * 32 + fr, fq * 8);
#define PG8_SA(b, h) (((b) * 2 + (h)) * HTB)
#define PG8_SB(b, h) ((4 + (b) * 2 + (h)) * HTB)
#define PG8_STAGE(bufoff, gbase, voff) do { _Pragma("unroll") for (int _i = 0; _i < 2; ++_i) \
        __builtin_amdgcn_global_load_lds((const unsigned*)((const char*)(gbase) + (voff)[_i]), (PG8_LAS unsigned*)(lds + (bufoff) + ldsw + _i * 8192), 16, 0, 0); } while (0)
#define PG8_LDA(dst, b, h) do { _Pragma("unroll") for (int m = 0; m < 4; ++m) _Pragma("unroll") for (int k = 0; k < 2; ++k) dst[m][k] = *(const PG8_LAS bf16x8*)(lds + PG8_SA(b, h) + aoff + m * 2048 + k * 1024); } while (0)
#define PG8_LDB(dst, b, h) do { _Pragma("unroll") for (int n = 0; n < 2; ++n) _Pragma("unroll") for (int k = 0; k < 2; ++k) dst[n][k] = *(const PG8_LAS bf16x8*)(lds + PG8_SB(b, h) + boff + n * 2048 + k * 1024); } while (0)
#define PG8_MMA(ai, bj, At, Bt) do { __builtin_amdgcn_s_setprio(1); _Pragma("unroll") for (int m = 0; m < 4; ++m) _Pragma("unroll") for (int n = 0; n < 2; ++n) _Pragma("unroll") for (int k = 0; k < 2; ++k) \
        acc[ai][bj][m][n] = __builtin_amdgcn_mfma_f32_16x16x32_bf16(Bt[n][k], At[m][k], acc[ai][bj][m][n], 0, 0, 0); __builtin_amdgcn_s_setprio(0); } while (0)
#define PG8_WAIT_V(n) asm volatile("s_waitcnt vmcnt(" #n ")" ::: "memory")
#define PG8_WAIT_L(n) asm volatile("s_waitcnt lgkmcnt(" #n ")" ::: "memory")
#define PG8_BAR __builtin_amdgcn_s_barrier()
#define PG8_SCHED __builtin_amdgcn_sched_barrier(0)
    Unit cur, nxt; int ui = 0;
    if (!S.next(0, cur)) return;
    f32x4 acc[2][2][4][2];
#pragma unroll
    for (int a = 0; a < 2; ++a)
#pragma unroll
        for (int b = 0; b < 2; ++b)
#pragma unroll
            for (int m = 0; m < 4; ++m)
#pragma unroll
                for (int n = 0; n < 2; ++n) acc[a][b][m][n] = (f32x4){0.f, 0.f, 0.f, 0.f};
    bf16x8 At[4][2], B0[2][2], B1[2][2];
    const char* cA = (const char*)g.A + (size_t)cur.pm * tstepA; const char* cB = (const char*)g.Bt + (size_t)cur.pn * tstepB;
    S.a_ready(cur);
    if constexpr (SP2) {
        PG8_STAGE(PG8_SB(0, 0), cB, voffB); PG8_STAGE(PG8_SB(0, 1), cB + hstepB, voffB); PG8_STAGE(PG8_SA(0, 0), cA, voffA); PG8_STAGE(PG8_SA(0, 1), cA + hstepA, voffA);
        if (wr == 1) PG8_BAR;
        PG8_WAIT_V(2); PG8_BAR;
        PG8_STAGE(PG8_SB(1, 0), cB + kstep, voffB); PG8_STAGE(PG8_SA(1, 0), cA + kstep, voffA); PG8_STAGE(PG8_SB(1, 1), cB + hstepB + kstep, voffB);
        PG8_WAIT_V(6); PG8_BAR;
    } else {
        PG8_STAGE(PG8_SB(0, 0), cB, voffB); PG8_STAGE(PG8_SA(0, 0), cA, voffA); PG8_STAGE(PG8_SB(0, 1), cB + hstepB, voffB); PG8_STAGE(PG8_SA(0, 1), cA + hstepA, voffA);
        if (wr == 1) PG8_BAR;
        PG8_WAIT_V(4); PG8_BAR;
        PG8_STAGE(PG8_SB(1, 0), cB + kstep, voffB); PG8_STAGE(PG8_SA(1, 0), cA + kstep, voffA); PG8_STAGE(PG8_SB(1, 1), cB + hstepB + kstep, voffB);
        PG8_WAIT_V(6); PG8_BAR;
    }
    for (;;) {
        const bool has_next = S.next(ui + 1, nxt);
        const char* nA = has_next ? (const char*)g.A + (size_t)nxt.pm * tstepA : cA; const char* nB = has_next ? (const char*)g.Bt + (size_t)nxt.pn * tstepB : cB;
        for (int t = 0; t < nt; t += 2) {
            const bool last = (t == nt - 2);
            const char* a1 = cA + (size_t)(t + 1) * kstep;
            const char* a2 = last ? nA : cA + (size_t)(t + 2) * kstep; const char* b2 = last ? nB : cB + (size_t)(t + 2) * kstep;
            const char* a3 = a2 + kstep; const char* b3 = b2 + kstep;
            if (last && has_next) S.a_ready(nxt);
            if constexpr (SP2) {
            PG8_LDB(B0, 0, 0); PG8_LDB(B1, 0, 1); PG8_SCHED; PG8_LDA(At, 0, 0); PG8_STAGE(PG8_SA(1, 1), a1 + hstepA, voffA);
            PG8_WAIT_V(8); PG8_WAIT_L(0); PG8_BAR; PG8_MMA(0, 0, At, B0); PG8_MMA(0, 1, At, B1); PG8_BAR; PG8_SCHED;
            PG8_LDA(At, 0, 1); PG8_STAGE(PG8_SB(0, 0), b2, voffB); PG8_STAGE(PG8_SB(0, 1), b2 + hstepB, voffB); PG8_STAGE(PG8_SA(0, 0), a2, voffA);
            PG8_WAIT_V(8); PG8_WAIT_L(0); PG8_BAR; PG8_MMA(1, 0, At, B0); PG8_MMA(1, 1, At, B1); PG8_BAR; PG8_SCHED;
            PG8_LDB(B0, 1, 0); PG8_LDB(B1, 1, 1); PG8_SCHED; PG8_LDA(At, 1, 0); PG8_STAGE(PG8_SA(0, 1), a2 + hstepA, voffA);
            PG8_WAIT_V(8); PG8_WAIT_L(0); PG8_BAR; PG8_MMA(0, 0, At, B0); PG8_MMA(0, 1, At, B1); PG8_BAR; PG8_SCHED;
            PG8_LDA(At, 1, 1); PG8_STAGE(PG8_SB(1, 0), b3, voffB); PG8_STAGE(PG8_SB(1, 1), b3 + hstepB, voffB); PG8_STAGE(PG8_SA(1, 0), a3, voffA);
            PG8_WAIT_V(8); PG8_WAIT_L(0); PG8_BAR; PG8_MMA(1, 0, At, B0); PG8_MMA(1, 1, At, B1); PG8_BAR; PG8_SCHED;
            } else {
            PG8_LDB(B0, 0, 0); PG8_SCHED; PG8_LDA(At, 0, 0); PG8_STAGE(PG8_SA(1, 1), a1 + hstepA, voffA);
            PG8_WAIT_L(8); PG8_BAR; PG8_WAIT_L(0); PG8_MMA(0, 0, At, B0); PG8_BAR; PG8_SCHED;
            PG8_LDB(B1, 0, 1); PG8_STAGE(PG8_SB(0, 0), b2, voffB);
            PG8_BAR; PG8_WAIT_L(0); PG8_MMA(0, 1, At, B1); PG8_BAR;
            PG8_LDA(At, 0, 1); PG8_STAGE(PG8_SA(0, 0), a2, voffA);
            PG8_BAR; PG8_WAIT_L(0); PG8_MMA(1, 0, At, B0); PG8_BAR; PG8_SCHED;
            PG8_STAGE(PG8_SB(0, 1), b2 + hstepB, voffB);
            PG8_WAIT_V(6); PG8_BAR; PG8_MMA(1, 1, At, B1); PG8_BAR;
            PG8_LDB(B0, 1, 0); PG8_SCHED; PG8_LDA(At, 1, 0); PG8_STAGE(PG8_SA(0, 1), a2 + hstepA, voffA);
            PG8_WAIT_L(8); PG8_BAR; PG8_WAIT_L(0); PG8_MMA(0, 0, At, B0); PG8_BAR; PG8_SCHED;
            PG8_LDB(B1, 1, 1); PG8_STAGE(PG8_SB(1, 0), b3, voffB);
            PG8_BAR; PG8_WAIT_L(0); PG8_MMA(0, 1, At, B1); PG8_BAR;
            PG8_LDA(At, 1, 1); PG8_STAGE(PG8_SA(1, 0), a3, voffA);
            PG8_BAR; PG8_WAIT_L(0); PG8_MMA(1, 0, At, B0); PG8_BAR; PG8_SCHED;
            PG8_STAGE(PG8_SB(1, 1), b3 + hstepB, voffB);
            PG8_WAIT_V(6); PG8_BAR; PG8_MMA(1, 1, At, B1); PG8_BAR;
            }
        }
        if constexpr (ALIGN_EPI) { if (wr == 0) PG8_BAR; }
        if constexpr (!Epi::AFTER_DRAIN) { E(acc, cur, wr, wc, fr, fq); S.done(cur); }
        if (!has_next) break;
#pragma unroll
        for (int a = 0; a < 2; ++a)
#pragma unroll
            for (int b = 0; b < 2; ++b)
#pragma unroll
                for (int m = 0; m < 4; ++m)
#pragma unroll
                    for (int n = 0; n < 2; ++n) acc[a][b][m][n] = (f32x4){0.f, 0.f, 0.f, 0.f};
        cur = nxt; cA = nA; cB = nB; ++ui;
        if constexpr (ALIGN_EPI) { if (wr == 1) PG8_BAR; }
    }
    PG8_WAIT_V(0);
    if constexpr (!ALIGN_EPI) { if (wr == 0) PG8_BAR; }
    PG8_BAR;
    if constexpr (Epi::AFTER_DRAIN) { E.fused(acc, cur, wr, wc, fr, fq, lds, wid, lane); S.done(cur); }
#undef PG8_SA
#undef PG8_SB
#undef PG8_STAGE
#undef PG8_LDA
#undef PG8_LDB
#undef PG8_MMA
#undef PG8_WAIT_V
#undef PG8_WAIT_L
#undef PG8_BAR
#undef PG8_SCHED
}
}

struct Params { const float* in[26]; float* out; unsigned char* ws; };
enum { I_X = 0, I_NMG, I_WIN, I_LBL, I_HNG, I_CW, I_CB, I_CLG, I_CLB, I_LRE, I_LIM, I_BRE, I_BIM, I_CRE, I_CIM, I_S5D, I_LDT, I_WGLU, I_QG, I_KG, I_RB, I_MONG, I_WOUT, I_NMLPG, I_WUP, I_WDN };

DI void p0_transpose_item(const float* W, int K, int N, bf16_t* WT, const float* gk, LAS float* scr, int item, int lane) {
    const int nblk = N / 32, kb = item / nblk, nb = item % nblk, k0 = 64 * kb, n0 = 32 * nb;
#pragma unroll 8
    for (int i = 0; i < 32; ++i) { const int kk = 2 * i + (lane >> 5); const float s = gk ? gk[k0 + kk] : 1.f; scr[kk * 33 + (lane & 31)] = W[(size_t)(k0 + kk) * N + n0 + (lane & 31)] * s; }
    LDS_WAIT();
    const int c = lane & 7;
#pragma unroll
    for (int j = 0; j < 4; ++j) { const int n = (lane >> 3) + 8 * j; const LAS float* s = scr + (8 * c) * 33 + n;
        u32x4 o; o.x = pk2(s[0 * 33], s[1 * 33]); o.y = pk2(s[2 * 33], s[3 * 33]); o.z = pk2(s[4 * 33], s[5 * 33]); o.w = pk2(s[6 * 33], s[7 * 33]);
        *(u32x4*)(WT + (size_t)(n0 + n) * K + k0 + 8 * c) = o; }
    LDS_WAIT();
}
DI void s5_params(const Params& p, int lg, int pp, float& lrdt, float& lidt, float& cr, float& ci) {
    const float dt = expf(p.in[I_LDT][lg]);
    const float lr = p.in[I_LRE][lg * 64 + pp], li = p.in[I_LIM][lg * 64 + pp];
    lrdt = lr * dt; lidt = li * dt;
    const float mag = expf(lrdt); const float ar = mag * cosf(lidt), ai = mag * sinf(lidt);
    const float den = lr * lr + li * li;
    cr = ((ar - 1.0f) * lr + ai * li) / den; ci = (ai * lr - (ar - 1.0f) * li) / den;
}
DI void s5_pow(float lrdt, float lidt, int n, float& er, float& ei) { const float m = expf((float)n * lrdt); const float a = (float)n * lidt; er = m * cosf(a); ei = m * sinf(a); }

DI void prologue(const Params& p, LAS unsigned char* lds, int G) {
    int tid_o = threadIdx.x; asm volatile("" : "+v"(tid_o));
    const int tid = tid_o, lane = tid & 63, wave = tid >> 6;
    const int gw = blockIdx.x * 8 + wave, NGW = G * 8;
    const int gt = blockIdx.x * 512 + tid, NGT = G * 512;
    unsigned char* ws = p.ws;
    LAS float* scr = (LAS float*)(lds + wave * 16384);
    {
        constexpr int I_IN = (D / 64) * (DIN / 32), I_OUT = (D / 64) * (D / 32), I_UP = (D / 64) * (FF / 32), I_DN = (FF / 64) * (D / 32), I_GL = (256 / 64) * (256 / 32);
        constexpr int PER_L = I_IN + I_OUT + I_UP + I_DN + I_GL;
        for (int it = gw; it < NL * PER_L; it += NGW) {
            const int l = it / PER_L; int r = it % PER_L;
            if (r < I_IN) { p0_transpose_item(p.in[I_WIN] + (size_t)l * D * DIN, D, DIN, (bf16_t*)(ws + WS_WIN) + (size_t)l * D * DIN, p.in[I_NMG] + l * D, scr, r, lane); continue; } r -= I_IN;
            if (r < I_OUT) { p0_transpose_item(p.in[I_WOUT] + (size_t)l * D * D, D, D, (bf16_t*)(ws + WS_WOUT) + (size_t)l * D * D, p.in[I_MONG] + l * D, scr, r, lane); continue; } r -= I_OUT;
            if (r < I_UP) { p0_transpose_item(p.in[I_WUP] + (size_t)l * D * FF, D, FF, (bf16_t*)(ws + WS_WUP) + (size_t)l * D * FF, p.in[I_NMLPG] + l * D, scr, r, lane); continue; } r -= I_UP;
            if (r < I_DN) { p0_transpose_item(p.in[I_WDN] + (size_t)l * D * FF, FF, D, (bf16_t*)(ws + WS_WDN) + (size_t)l * D * FF, nullptr, scr, r, lane); continue; } r -= I_DN;
            p0_transpose_item(p.in[I_WGLU] + (size_t)l * 65536, 256, 256, (bf16_t*)(ws + WS_WGLU) + (size_t)l * 65536, nullptr, scr, r, lane);
        }
    }
    {
        float* ssq0 = (float*)(ws + WS_SSQP); bf16_t* XB = (bf16_t*)(ws + WS_XB);
        for (int mb = gw * 16; mb < T; mb += NGW * 16) {
            float keep = 0.f;
#pragma unroll 1
            for (int i = 0; i < 16; ++i) { const int m = mb + i;
                const f32x4* xr = (const f32x4*)(p.in[I_X] + (size_t)m * D) + lane; f32x4 v[4]; float s = 0.f;
#pragma unroll
                for (int j = 0; j < 4; ++j) { v[j] = xr[64 * j]; s += (v[j][0] * v[j][0] + v[j][1] * v[j][1]) + (v[j][2] * v[j][2] + v[j][3] * v[j][3]); }
                s = wave_sum(s); if (lane == i) keep = s;
                u32x2* o8 = (u32x2*)(XB + (size_t)m * D) + lane;
#pragma unroll
                for (int j = 0; j < 4; ++j) { u32x2 w; w.x = pk2(v[j][0], v[j][1]); w.y = pk2(v[j][2], v[j][3]); o8[64 * j] = w; } }
#pragma unroll 1
            for (int i = 0; i < 16; ++i) { const float v = __shfl(keep, i); if (lane < 16) ssq0[(size_t)(mb + i) * 16 + lane] = lane == 0 ? v : 0.f; }
        }
    }
    {
        float* LB = (float*)(ws + WS_LB);
        for (int c = gt; c < 256; c += NGT) {
            const float a0 = p.in[I_LBL][c], a1 = p.in[I_LBL][256 + c], a2 = p.in[I_LBL][512 + c], a3 = p.in[I_LBL][768 + c];
            const float mx = fmaxf(fmaxf(a0, a1), fmaxf(a2, a3));
            const float e0 = expf(a0 - mx), e1 = expf(a1 - mx), e2 = expf(a2 - mx), e3 = expf(a3 - mx); const float inv = 1.f / (e0 + e1 + e2 + e3);
            const float s1 = e1 * inv, s2 = e2 * inv, s3 = e3 * inv; const float hi = 1.0f - 1e-6f;
            LB[c] = 0.f; LB[256 + c] = fminf(fmaxf(s1, 0.f), hi); LB[512 + c] = fminf(fmaxf(s1 + s2, 0.f), hi); LB[768 + c] = fminf(fmaxf(s1 + s2 + s3, 0.f), hi);
        }
        float* BT = (float*)(ws + WS_BIAS);
        for (int i = gt; i < 3 * 4 * 132; i += NGT) {
            const int pt = i / (4 * 132), hd = (i / 132) % 4, dl = i % 132; const int dil = pt == 0 ? 1 : (pt == 1 ? 4 : 16);
            float v = 0.f;
            if (dl <= 128) { const int dist = dl * dil; int bk;
                if (dist < 16) bk = dist; else { bk = 16 + (int)(logf((float)dist / 16.0f) / 4.852030263919617f * 16.0f); if (bk > 31) bk = 31; }
                v = p.in[I_RB][bk * 4 + hd]; }
            BT[i] = v;
        }
    }
    {
        bf16_t* KT = (bf16_t*)(ws + WS_S5K); bf16_t* WS_ = (bf16_t*)(ws + WS_S5WS); bf16_t* WC = (bf16_t*)(ws + WS_S5WC);
        LAS float* ebr = scr; LAS float* ebi = scr + 64 * 17;
        for (int it = gw; it < NL * 16 * 64; it += NGW) {
            const int lg = it >> 6, d = it & 63;
            float lrdt, lidt, cr, ci; s5_params(p, lg, lane, lrdt, lidt, cr, ci);
            float er, ei; s5_pow(lrdt, lidt, d, er, ei);
            const float fr_ = er * cr - ei * ci, fi_ = er * ci + ei * cr;
            const float* br = p.in[I_BRE] + ((size_t)lg * 64 + lane) * 16; const float* bi = p.in[I_BIM] + ((size_t)lg * 64 + lane) * 16;
#pragma unroll
            for (int c = 0; c < 16; ++c) { const float b0 = br[c], b1 = bi[c]; ebr[lane * 17 + c] = fr_ * b0 - fi_ * b1; ebi[lane * 17 + c] = fr_ * b1 + fi_ * b0; }
            LDS_WAIT();
            const int co = lane & 15, cb = (lane >> 4) * 4;
            const float* crp = p.in[I_CRE] + ((size_t)lg * 16 + co) * 64; const float* cip = p.in[I_CIM] + ((size_t)lg * 16 + co) * 64;
            float a0 = 0.f, a1 = 0.f, a2 = 0.f, a3 = 0.f;
            for (int q = 0; q < 64; ++q) { const float c0 = crp[q], c1 = cip[q];
                a0 += c0 * ebr[q * 17 + cb + 0] - c1 * ebi[q * 17 + cb + 0]; a1 += c0 * ebr[q * 17 + cb + 1] - c1 * ebi[q * 17 + cb + 1];
                a2 += c0 * ebr[q * 17 + cb + 2] - c1 * ebi[q * 17 + cb + 2]; a3 += c0 * ebr[q * 17 + cb + 3] - c1 * ebi[q * 17 + cb + 3]; }
            u32x2 w; w.x = pk2(a0, a1); w.y = pk2(a2, a3);
            *(u32x2*)(KT + ((size_t)it * 16 + co) * 16 + cb) = w;
            LDS_WAIT();
        }
        for (int it = gw; it < NL * 16 * 16; it += NGW) {
            const int lg = it >> 4, s4 = it & 15;
            float lrdt, lidt, cr, ci; s5_params(p, lg, lane, lrdt, lidt, cr, ci);
            const float* br = p.in[I_BRE] + ((size_t)lg * 64 + lane) * 16; const float* bi = p.in[I_BIM] + ((size_t)lg * 64 + lane) * 16;
            float b0[16], b1[16];
#pragma unroll
            for (int c = 0; c < 16; ++c) { b0[c] = br[c]; b1[c] = bi[c]; }
#pragma unroll 1
            for (int sq = 0; sq < 4; ++sq) { const int s = s4 * 4 + sq;
                float er, ei; s5_pow(lrdt, lidt, 63 - s, er, ei);
                const float fr_ = er * cr - ei * ci, fi_ = er * ci + ei * cr;
                float vr[16], vi[16];
#pragma unroll
                for (int c = 0; c < 16; ++c) { vr[c] = fr_ * b0[c] - fi_ * b1[c]; vi[c] = fr_ * b1[c] + fi_ * b0[c]; }
                bf16_t* o0 = WS_ + ((size_t)lg * 128 + lane) * 1024 + s * 16; bf16_t* o1 = WS_ + ((size_t)lg * 128 + 64 + lane) * 1024 + s * 16;
                u32x4 w;
                w.x = pk2(vr[0], vr[1]); w.y = pk2(vr[2], vr[3]); w.z = pk2(vr[4], vr[5]); w.w = pk2(vr[6], vr[7]); *(u32x4*)o0 = w;
                w.x = pk2(vr[8], vr[9]); w.y = pk2(vr[10], vr[11]); w.z = pk2(vr[12], vr[13]); w.w = pk2(vr[14], vr[15]); *(u32x4*)(o0 + 8) = w;
                w.x = pk2(vi[0], vi[1]); w.y = pk2(vi[2], vi[3]); w.z = pk2(vi[4], vi[5]); w.w = pk2(vi[6], vi[7]); *(u32x4*)o1 = w;
                w.x = pk2(vi[8], vi[9]); w.y = pk2(vi[10], vi[11]); w.z = pk2(vi[12], vi[13]); w.w = pk2(vi[14], vi[15]); *(u32x4*)(o1 + 8) = w; }
        }
        for (int it = gw; it < NL * 16 * 64; it += NGW) {
            const int lg = it >> 6, tl = it & 63;
            float lrdt, lidt, cr, ci; s5_params(p, lg, lane, lrdt, lidt, cr, ci);
            float er, ei; s5_pow(lrdt, lidt, tl + 1, er, ei);
#pragma unroll 4
            for (int co = 0; co < 16; ++co) { const float c0 = p.in[I_CRE][((size_t)lg * 16 + co) * 64 + lane], c1 = p.in[I_CIM][((size_t)lg * 16 + co) * 64 + lane];
                bf16_t* o = WC + (((size_t)lg * 64 + tl) * 16 + co) * 128;
                o[lane] = (bf16_t)f2bf(c0 * er - c1 * ei); o[64 + lane] = (bf16_t)f2bf(-(c0 * ei + c1 * er)); }
        }
    }
}

template <bool OUT>
DI void hgrn_item(const Params& p, LAS unsigned char* lds, int l, int cg) {
    int tid_o = threadIdx.x; asm volatile("" : "+v"(tid_o));
    const int tid = tid_o, lane = tid & 63, wave = tid >> 6, hd = wave >> 1, half = wave & 1;
    const bf16_t* Z = (const bf16_t*)(p.ws + WS_Z);
    LAS bf16_t* B0 = (LAS bf16_t*)(lds + hd * 27648); LAS bf16_t* B1 = B0 + 64 * 72; LAS bf16_t* B2 = B1 + 64 * 72;
    LAS float* GM = (LAS float*)(lds + 114688) + hd * 64; LAS float* GL = GM + 256; LAS float* SSA = (LAS float*)(lds + 114688) + 512;
    bf16_t* SL = (bf16_t*)(p.ws + WS_SL); const bf16_t* SL2 = (const bf16_t*)(p.ws + WS_SL2); float* DEC = (float*)(p.ws + WS_DEC);
    const int item = cg * 4 + hd;
#ifdef FORCE_LB0
    const float lb = 0.f, oml = 1.f;
#else
    const float lb = ((const float*)(p.ws + WS_LB))[l * 256 + hd * 64 + lane], oml = 1.f - lb;
#endif
    const int srow = tid >> 5, shd = (tid >> 3) & 3, spc = tid & 7;
    const bf16_t* zsrc = Z + (size_t)(cg * 64 + srow) * DIN + shd * 64 + spc * 8;
    const int sdst = shd * 27648 + (srow * 72 + spc * 8) * 2;
    __syncthreads();
    { u32x4 wf[4], wi[4], wq[4];
#pragma unroll
      for (int sub = 0; sub < 4; ++sub) { wf[sub] = *(const u32x4*)(zsrc + (size_t)(16 * sub) * DIN + ZF); wi[sub] = *(const u32x4*)(zsrc + (size_t)(16 * sub) * DIN + ZI);
          if (OUT) wq[sub] = *(const u32x4*)(zsrc + (size_t)(16 * sub) * DIN + ZQ); }
#pragma unroll
      for (int sub = 0; sub < 4; ++sub) { *(LAS u32x4*)(lds + sdst + 9216 + sub * 16 * 144) = wf[sub]; *(LAS u32x4*)(lds + sdst + 18432 + sub * 16 * 144) = wi[sub];
          if (OUT) *(LAS u32x4*)(lds + sdst + sub * 16 * 144) = wq[sub]; } }
    __syncthreads();
    float g[32]; float run = 0.f;
#pragma unroll
    for (int j = 0; j < 32; ++j) { const float fz = bf2f(B1[(half * 32 + j) * 72 + lane]); const float sg = sigmoidf_(fz); const float f = lb + oml * sg;
        run += __logf(fmaxf(f, 1e-30f)); g[j] = run; }
    if (half == 0) GM[lane] = run;
    __syncthreads();
    const float gm = GM[lane];
    if (half) {
#pragma unroll
        for (int j = 0; j < 32; ++j) g[j] += gm; }
    const int c0 = lane & 31, h = lane >> 5;
    if constexpr (!OUT) {
        if (half) GL[lane] = run + gm;
        __syncthreads();
        const float gl = GL[lane];
        bf16_t kv[32], ivr[32];
#pragma unroll
        for (int j = 0; j < 32; ++j) { const int t = half * 32 + j; const float e = __expf(gl - g[j]); const float kj = oml * (1.f - sigmoidf_(bf2f(B1[t * 72 + lane])));
            kv[j] = (bf16_t)f2bf(kj * e); ivr[j] = B2[t * 72 + lane]; }
        __syncthreads();
#pragma unroll
        for (int j = 0; j < 32; ++j) { const int t = half * 32 + j; B1[lane * 72 + t] = kv[j]; B2[lane * 72 + t] = ivr[j]; }
        __syncthreads();
#pragma unroll
        for (int kt = 0; kt < 2; ++kt) { const f32x16 a = mma_lds<64>(B2 + 32 * half * 72, 72, B1 + 32 * kt * 72, 72, zero16(), lane);
#pragma unroll
            for (int i = 0; i < 16; ++i) SL[(size_t)item * 4096 + (32 * half + crow(i, h)) * 64 + 32 * kt + c0] = (bf16_t)f2bf(a[i]); }
        if (half == 0) DEC[item * 64 + lane] = __expf(gl);
    } else {
        if (half == 0) GL[lane] = __expf(gm);
        bf16_t ivr[32];
#pragma unroll
        for (int j = 0; j < 32; ++j) { const int t = half * 32 + j; const float q = bf2f(B0[t * 72 + lane]); const float kj = oml * (1.f - sigmoidf_(bf2f(B1[t * 72 + lane])));
            const float e1 = __expf(fminf(g[j] - gm, 80.f)), e2 = __expf(fminf(gm - g[j], 80.f));
            ivr[j] = B2[t * 72 + lane];
            B0[t * 72 + lane] = (bf16_t)f2bf(q * e1); B1[t * 72 + lane] = (bf16_t)f2bf(kj * e2); }
        __syncthreads();
#pragma unroll
        for (int j = 0; j < 32; ++j) B2[lane * 72 + half * 32 + j] = ivr[j];
        __syncthreads();
        f32x16 s0 = mma_lds<64>(B0 + 32 * half * 72, 72, B1, 72, zero16(), lane);
        f32x16 s1 = zero16(); if (half) s1 = mma_lds<64>(B0 + 32 * half * 72, 72, B1 + 32 * 72, 72, zero16(), lane);
        __syncthreads();
#pragma unroll
        for (int i = 0; i < 16; ++i) { const int row = 32 * half + crow(i, h);
            B1[row * 72 + c0] = (bf16_t)f2bf(c0 <= row ? s0[i] : 0.f); B1[row * 72 + 32 + c0] = (bf16_t)f2bf(32 + c0 <= row ? s1[i] : 0.f); }
        __syncthreads();
        f32x16 o0 = mma_lds<64>(B1 + 32 * half * 72, 72, B2, 72, zero16(), lane);
        f32x16 o1 = mma_lds<64>(B1 + 32 * half * 72, 72, B2 + 32 * 72, 72, zero16(), lane);
        __syncthreads();
        {
          u32x4 wsl[4], wg[4];
          const bf16_t* sp = SL2 + (size_t)item * 4096 + (32 * half) * 64;
#pragma unroll
          for (int e = 0; e < 4; ++e) { const int pc = lane + 64 * e; wsl[e] = *(const u32x4*)(sp + pc * 8); wg[e] = *(const u32x4*)(zsrc + (size_t)(16 * e) * DIN + ZG); }
#pragma unroll
          for (int e = 0; e < 4; ++e) { const int pc = lane + 64 * e, row = pc >> 3, k0 = (pc & 7) * 8; const LAS float* eg = GL + k0;
              u32x4 o; o.x = pk2(bflo(wsl[e].x) * eg[0], bfhi(wsl[e].x) * eg[1]); o.y = pk2(bflo(wsl[e].y) * eg[2], bfhi(wsl[e].y) * eg[3]);
              o.z = pk2(bflo(wsl[e].z) * eg[4], bfhi(wsl[e].z) * eg[5]); o.w = pk2(bflo(wsl[e].w) * eg[6], bfhi(wsl[e].w) * eg[7]);
              *(LAS u32x4*)(B2 + (32 * half + row) * 72 + k0) = o;
              *(LAS u32x4*)(lds + sdst + 9216 + e * 16 * 144) = wg[e]; } }
        __syncthreads();
        o0 = mma_lds<64>(B0 + 32 * half * 72, 72, B2, 72, o0, lane);
        o1 = mma_lds<64>(B0 + 32 * half * 72, 72, B2 + 32 * 72, 72, o1, lane);
        const float* ng = p.in[I_HNG] + l * 256 + hd * 64; const float ng0 = ng[c0], ng1 = ng[32 + c0];
#pragma unroll
        for (int i = 0; i < 16; ++i) { const int row = 32 * half + crow(i, h);
            const float ss = half_sum(o0[i] * o0[i] + o1[i] * o1[i]); const float rs = rsqrtf(ss * (1.0f / 64.0f) + EPS);
            const float g0 = bf2f(B1[row * 72 + c0]), g1 = bf2f(B1[row * 72 + 32 + c0]);
            const float v0 = o0[i] * rs * ng0 * g0 * sigmoidf_(g0), v1 = o1[i] * rs * ng1 * g1 * sigmoidf_(g1);
            o0[i] = v0; o1[i] = v1; const float s2 = half_sum(v0 * v0 + v1 * v1); if (c0 == 0) SSA[hd * 64 + row] = s2; }
        __syncthreads();
        bf16_t* Y = (bf16_t*)(p.ws + WS_YCAT);
#pragma unroll
        for (int i = 0; i < 16; ++i) { const int row = 32 * half + crow(i, h); const size_t tok = (size_t)cg * 64 + row;
            const float tot = (SSA[row] + SSA[64 + row]) + (SSA[128 + row] + SSA[192 + row]); const float r2 = rsqrtf(tot * (1.0f / 256.0f) + EPS);
            Y[tok * D + YA + hd * 64 + c0] = (bf16_t)f2bf(o0[i] * r2); Y[tok * D + YA + hd * 64 + 32 + c0] = (bf16_t)f2bf(o1[i] * r2); }
    }
}
DI void hgrn_scan_item(const Params& p, int hb) {
    int tid_o = threadIdx.x; asm volatile("" : "+v"(tid_o));
    const int e = hb * 512 + tid_o, bh = e >> 12, b = bh >> 2, hd = bh & 3, vk = e & 4095, k = vk & 63;
    const bf16_t* SL = (const bf16_t*)(p.ws + WS_SL); bf16_t* SL2 = (bf16_t*)(p.ws + WS_SL2); const float* DEC = (const float*)(p.ws + WS_DEC);
    float st = 0.f;
    for (int c8 = 0; c8 < 128; c8 += 16) { float tmp[16], dc[16];
#pragma unroll
        for (int u = 0; u < 16; ++u) { const int item = (b * 128 + c8 + u) * 4 + hd; tmp[u] = bf2f(SL[(size_t)item * 4096 + vk]); dc[u] = DEC[item * 64 + k]; }
#pragma unroll
        for (int u = 0; u < 16; ++u) { const int item = (b * 128 + c8 + u) * 4 + hd; SL2[(size_t)item * 4096 + vk] = (bf16_t)f2bf(st); st = dc[u] * st + tmp[u]; } }
}

DI void conv_item(const Params& p, LAS unsigned char* lds, int l, int ti) {
    int tid_o = threadIdx.x; asm volatile("" : "+v"(tid_o));
    const int tid = tid_o, lane = tid & 63, wave = tid >> 6, c = tid & 255, hf = tid >> 8, wv = wave & 3;
    LAS float* Hs = (LAS float*)lds; LAS float* ST = (LAS float*)(lds + 98304); LAS float* ST2 = ST + 512;
    const bf16_t* Z = (const bf16_t*)(p.ws + WS_Z); bf16_t* Y = (bf16_t*)(p.ws + WS_YCAT);
    const int tok0 = ti * 64, pos0 = (ti & 127) * 64;
    __syncthreads();
    for (int it0 = 0; it0 < 48; it0 += 8) { bf16_t vv[8], gg[8];
#pragma unroll
        for (int e = 0; e < 8; ++e) { const int row = 2 * (it0 + e) + hf, pos = pos0 - 30 + row; const bool ok = (row < 94) && (pos >= 0);
            const size_t tok = ok ? (size_t)(tok0 - 30 + row) : (size_t)tok0; vv[e] = Z[tok * DIN + ZBV + c]; gg[e] = Z[tok * DIN + ZBG + c]; }
#pragma unroll
        for (int e = 0; e < 8; ++e) { const int row = 2 * (it0 + e) + hf, pos = pos0 - 30 + row; const bool ok = (row < 94) && (pos >= 0);
            if (row < 94) Hs[row * 256 + c] = ok ? bf2f(vv[e]) * sigmoidf_(bf2f(gg[e])) : 0.f; } }
    __syncthreads();
    const float* cw = p.in[I_CW] + (size_t)l * 31 * 256 + c; float w[31];
#pragma unroll
    for (int jj = 0; jj < 31; ++jj) w[jj] = cw[jj * 256];
    const float cb = p.in[I_CB][l * 256 + c];
    const float lng = p.in[I_CLG][l * 256 + c], lnb = p.in[I_CLB][l * 256 + c];
#pragma unroll 1
    for (int ps = 0; ps < 2; ++ps) { const int tb = hf * 32 + ps * 16;
        float o[16];
        { float hr[46];
#pragma unroll
          for (int r = 0; r < 46; ++r) hr[r] = Hs[(tb + r) * 256 + c];
#pragma unroll
          for (int j = 0; j < 16; ++j) { float a = cb;
#pragma unroll
            for (int jj = 0; jj < 31; ++jj) a += w[jj] * hr[j + jj];
            o[j] = a; } }
#pragma unroll
        for (int j = 0; j < 16; ++j) { const float s1 = wave_sum(o[j]), s2 = wave_sum(o[j] * o[j]); if (lane == 0) { ST[((tb + j) * 4 + wv) * 2] = s1; ST[((tb + j) * 4 + wv) * 2 + 1] = s2; } }
        __syncthreads();
#pragma unroll
        for (int j = 0; j < 16; ++j) { const LAS float* q = ST + (tb + j) * 8; const float s1 = (q[0] + q[2]) + (q[4] + q[6]), s2 = (q[1] + q[3]) + (q[5] + q[7]);
            const float mu = s1 * (1.0f / 256.0f); const float var = fmaxf(s2 * (1.0f / 256.0f) - mu * mu, 0.f);
            const float y = (o[j] - mu) * rsqrtf(var + EPS) * lng + lnb; const float sv = y * sigmoidf_(y); o[j] = sv;
            const float s3 = wave_sum(sv * sv); if (lane == 0) ST2[(tb + j) * 4 + wv] = s3; }
        __syncthreads();
#pragma unroll
        for (int j = 0; j < 16; ++j) { const LAS float* q = ST2 + (tb + j) * 4; const float tot = (q[0] + q[1]) + (q[2] + q[3]); const float rs = rsqrtf(tot * (1.0f / 256.0f) + EPS);
            Y[(size_t)(tok0 + tb + j) * D + YB + c] = (bf16_t)f2bf(o[j] * rs); }
    }
}

DI bf16x8 ldg8(const bf16_t* p) { return *(const bf16x8*)p; }
DI void s5_local_item(const Params& p, int l, int bi) {
    int tid_o = threadIdx.x; asm volatile("" : "+v"(tid_o));
    const int lane = tid_o & 63, wi = bi * 8 + (tid_o >> 6);
    const int g = wi & 15, cb = (wi >> 4) & 15, pt = wi >> 8, c0 = lane & 31, h = lane >> 5;
    const bf16_t* ua = (const bf16_t*)(p.ws + WS_Z) + (size_t)((cb * 32 + c0) * 64) * DIN + ZCU + g * 16 + 8 * h;
    const bf16_t* wb = (const bf16_t*)(p.ws + WS_S5WS) + ((size_t)(l * 16 + g) * 128 + pt * 32 + c0) * 1024 + 8 * h;
    f32x16 acc = zero16();
#pragma unroll 8
    for (int s = 0; s < 64; ++s) acc = __builtin_amdgcn_mfma_f32_32x32x16_bf16(ldg8(ua + (size_t)s * DIN), ldg8(wb + s * 16), acc, 0, 0, 0);
    float* HL = (float*)(p.ws + WS_S5H);
#pragma unroll
    for (int i = 0; i < 16; ++i) HL[((size_t)(cb * 32 + crow(i, h)) * 16 + g) * 128 + pt * 32 + c0] = acc[i];
}
DI void s5_scan_item(const Params& p, int l, int sb) {
    int tid_o = threadIdx.x; asm volatile("" : "+v"(tid_o));
    const int e = sb * 512 + tid_o, b = e >> 10, g = (e >> 6) & 15, pp = e & 63;
    float lrdt, lidt, cr, ci; s5_params(p, l * 16 + g, pp, lrdt, lidt, cr, ci);
    float ar, ai; s5_pow(lrdt, lidt, 64, ar, ai);
    const float* HL = (const float*)(p.ws + WS_S5H); float* HO = (float*)(p.ws + WS_S5H2); float hr = 0.f, hi = 0.f;
    for (int c8 = 0; c8 < 128; c8 += 16) { float tr[16], ti[16];
#pragma unroll
        for (int u = 0; u < 16; ++u) { const size_t idx = ((size_t)(b * 128 + c8 + u) * 16 + g) * 128; tr[u] = HL[idx + pp]; ti[u] = HL[idx + 64 + pp]; }
#pragma unroll
        for (int u = 0; u < 16; ++u) { const size_t idx = ((size_t)(b * 128 + c8 + u) * 16 + g) * 128; HO[idx + pp] = hr; HO[idx + 64 + pp] = hi;
            const float nr = ar * hr - ai * hi + tr[u], ni = ar * hi + ai * hr + ti[u]; hr = nr; hi = ni; } }
}
DI void s5_out_item(const Params& p, LAS unsigned char* lds, int l, int bi) {
    int tid_o = threadIdx.x; asm volatile("" : "+v"(tid_o));
    const int tid = tid_o, lane = tid & 63, wave = tid >> 6;
    const int gh = bi & 1, cb = (bi >> 1) & 15, pr = bi >> 5, g = gh * 8 + wave, c0 = lane & 31, h = lane >> 5, lg = l * 16 + g;
    LAS bf16_t* OT = (LAS bf16_t*)lds;
    const bf16_t* Z = (const bf16_t*)(p.ws + WS_Z);
    const bf16_t* ua = Z + (size_t)((cb * 32 + c0) * 64) * DIN + ZCU + g * 16 + 8 * h;
    const bf16_t* kt = (const bf16_t*)(p.ws + WS_S5K) + (size_t)lg * 64 * 256;
    const float* ha = (const float*)(p.ws + WS_S5H2) + ((size_t)(cb * 32 + c0) * 16 + g) * 128 + 8 * h;
    const int co = c0 & 15; const float dsk = p.in[I_S5D][l * 256 + g * 16 + co];
    __syncthreads();
    for (int q = 0; q < 2; ++q) { const int jt = q ? 31 - pr : pr; const int tl = 2 * jt + (c0 >> 4);
        f32x16 acc = zero16();
        const bf16_t* wc = (const bf16_t*)(p.ws + WS_S5WC) + (((size_t)lg * 64 + tl) * 16 + co) * 128 + 8 * h;
        { f32x4 x0[8], x1[8]; bf16x8 wv[8];
#pragma unroll
          for (int ks = 0; ks < 8; ++ks) { x0[ks] = *(const f32x4*)(ha + ks * 16); x1[ks] = *(const f32x4*)(ha + ks * 16 + 4); wv[ks] = ldg8(wc + ks * 16); }
#pragma unroll
          for (int ks = 0; ks < 8; ++ks) { u32x4 w; w.x = pk2(x0[ks][0], x0[ks][1]); w.y = pk2(x0[ks][2], x0[ks][3]); w.z = pk2(x1[ks][0], x1[ks][1]); w.w = pk2(x1[ks][2], x1[ks][3]);
            acc = __builtin_amdgcn_mfma_f32_32x32x16_bf16(__builtin_bit_cast(bf16x8, w), wv[ks], acc, 0, 0, 0); } }
        const int ns = (2 * jt + 2 + 7) & ~7;
        for (int s0 = 0; s0 < ns; s0 += 8) { bf16x8 av[8], bv[8];
#pragma unroll
            for (int e = 0; e < 8; ++e) { const int s = s0 + e, d = tl - s, dc = d < 0 ? 0 : d;
                av[e] = ldg8(ua + (size_t)s * DIN); bv[e] = ldg8(kt + ((size_t)dc * 16 + co) * 16 + 8 * h); }
#pragma unroll
            for (int e = 0; e < 8; ++e) { const int d = tl - (s0 + e); bf16x8 b = bv[e]; if (d < 0) b = (bf16x8){0, 0, 0, 0, 0, 0, 0, 0};
                acc = __builtin_amdgcn_mfma_f32_32x32x16_bf16(av[e], b, acc, 0, 0, 0); } }
#pragma unroll
        for (int i = 0; i < 16; ++i) { const int m = crow(i, h); const size_t tok = (size_t)(cb * 32 + m) * 64 + tl; const float u = bf2f(Z[tok * DIN + ZCU + g * 16 + co]);
            const float y = acc[i] + dsk * u; const float ge = y * sigmoidf_(1.5957691216057308f * (y + 0.044715f * y * y * y));
            OT[(q * 64 + m * 2 + (c0 >> 4)) * 136 + wave * 16 + co] = (bf16_t)f2bf(ge); }
    }
    __syncthreads();
    { const int tau = tid >> 2, qq = tau >> 6, m = (tau >> 1) & 31, t2 = tau & 1, qt = tid & 3; const int jt = qq ? 31 - pr : pr;
      const size_t tok = (size_t)(cb * 32 + m) * 64 + 2 * jt + t2;
      const LAS u32x4* src = (const LAS u32x4*)(OT + tau * 136 + qt * 32); u32x4* dst = (u32x4*)((bf16_t*)(p.ws + WS_YPRE) + tok * 256 + gh * 128 + qt * 32);
#pragma unroll
      for (int e = 0; e < 4; ++e) dst[e] = src[e]; }
}

DI void attn_item(const Params& p, LAS unsigned char* lds, int l, int pt, int id) {
    int tid_o = threadIdx.x; asm volatile("" : "+v"(tid_o));
    const int tid = tid_o, lane = tid & 63, wave = tid >> 6;
    const int dil = pt == 0 ? 1 : (pt == 1 ? 4 : 16), nblk = 32 / dil;
    const int b = id >> 7, hd = (id >> 5) & 3, rn = id & 31, r = rn / nblk, n = rn % nblk;
    LAS bf16_t* Ks = (LAS bf16_t*)lds;
    LAS bf16_t* Vt = (LAS bf16_t*)(lds + 55296);
    LAS float* BT = (LAS float*)(lds + 55296 + 50176);
    const bf16_t* Z = (const bf16_t*)(p.ws + WS_Z);
    const bf16_t* OP = (const bf16_t*)(p.ws + (pt == 1 ? WS_O0 : WS_O1)); const float* LP = (const float*)(p.ws + (pt == 1 ? WS_LSE : WS_LSE1));
    bf16_t* ON = pt == 2 ? (bf16_t*)(p.ws + WS_Z) + ZOD : (bf16_t*)(p.ws + (pt == 0 ? WS_O0 : WS_O1)); const int onp = pt == 2 ? DIN : 256;
    float* LN = (float*)(p.ws + (pt == 0 ? WS_LSE : WS_LSE1));
    const size_t tokb = (size_t)b * SEQ;
    __syncthreads();
    if (tid < 132) BT[tid] = ((const float*)(p.ws + WS_BIAS))[(pt * 4 + hd) * 132 + tid];
    { const float* kg = p.in[I_KG] + l * 64 + (tid & 7) * 8; float kgv[8];
#pragma unroll
      for (int e = 0; e < 8; ++e) kgv[e] = kg[e];
      u32x4 kwv[6], vwv[6];
#pragma unroll
      for (int it = 0; it < 6; ++it) { const int idx = tid + 512 * it, row = idx >> 3, c = idx & 7, si = n * 256 - 128 + row;
        const size_t tok = tokb + (size_t)(si < 0 ? 0 : si) * dil + r;
        kwv[it] = *(const u32x4*)(Z + tok * DIN + ZDK + hd * 64 + c * 8); vwv[it] = *(const u32x4*)(Z + tok * DIN + ZDV + hd * 64 + c * 8); }
#pragma unroll
      for (int it = 0; it < 6; ++it) { const int idx = tid + 512 * it, row = idx >> 3, c = idx & 7, si = n * 256 - 128 + row;
        u32x4 kw = kwv[it], vw = vwv[it];
        if (si < 0) { kw = (u32x4){0u, 0u, 0u, 0u}; vw = (u32x4){0u, 0u, 0u, 0u}; }
        float kf[8]; kf[0] = bflo(kw.x); kf[1] = bfhi(kw.x); kf[2] = bflo(kw.y); kf[3] = bfhi(kw.y); kf[4] = bflo(kw.z); kf[5] = bfhi(kw.z); kf[6] = bflo(kw.w); kf[7] = bfhi(kw.w);
        float ss = 0.f;
#pragma unroll
        for (int e = 0; e < 8; ++e) ss += kf[e] * kf[e];
        ss += __shfl_xor(ss, 1); ss += __shfl_xor(ss, 2); ss += __shfl_xor(ss, 4);
        const float rs = rsqrtf(ss * (1.0f / 64.0f) + EPS);
        u32x4 o; o.x = pk2(kf[0] * rs * kgv[0], kf[1] * rs * kgv[1]); o.y = pk2(kf[2] * rs * kgv[2], kf[3] * rs * kgv[3]); o.z = pk2(kf[4] * rs * kgv[4], kf[5] * rs * kgv[5]); o.w = pk2(kf[6] * rs * kgv[6], kf[7] * rs * kgv[7]);
        *(LAS u32x4*)(Ks + row * 72 + c * 8) = o;
        LAS bf16_t* vp = Vt + (c * 8) * 392 + row;
        vp[0 * 392] = (bf16_t)(vw.x & 0xffffu); vp[1 * 392] = (bf16_t)(vw.x >> 16); vp[2 * 392] = (bf16_t)(vw.y & 0xffffu); vp[3 * 392] = (bf16_t)(vw.y >> 16);
        vp[4 * 392] = (bf16_t)(vw.z & 0xffffu); vp[5 * 392] = (bf16_t)(vw.z >> 16); vp[6 * 392] = (bf16_t)(vw.w & 0xffffu); vp[7 * 392] = (bf16_t)(vw.w >> 16); } }
    __syncthreads();
    const int c0 = lane & 31, h = lane >> 5;
    const int qi = 32 * wave + c0; const size_t tokq = tokb + (size_t)(n * 256 + qi) * dil + r;
    bf16x8 qf[4];
    { float qv[4][8]; float ss = 0.f;
#pragma unroll
      for (int ks = 0; ks < 4; ++ks) { const u32x4 w = *(const u32x4*)(Z + tokq * DIN + ZDQ + hd * 64 + ks * 16 + 8 * h);
        qv[ks][0] = bflo(w.x); qv[ks][1] = bfhi(w.x); qv[ks][2] = bflo(w.y); qv[ks][3] = bfhi(w.y); qv[ks][4] = bflo(w.z); qv[ks][5] = bfhi(w.z); qv[ks][6] = bflo(w.w); qv[ks][7] = bfhi(w.w);
#pragma unroll
        for (int e = 0; e < 8; ++e) ss += qv[ks][e] * qv[ks][e]; }
      ss += __shfl_xor(ss, 32);
      const float rs = rsqrtf(ss * (1.0f / 64.0f) + EPS) * 0.125f;
#pragma unroll
      for (int ks = 0; ks < 4; ++ks) { const float* qg = p.in[I_QG] + l * 64 + ks * 16 + 8 * h; const f32x4 g0 = *(const f32x4*)qg, g1 = *(const f32x4*)(qg + 4);
        u32x4 w; w.x = pk2(qv[ks][0] * rs * g0[0], qv[ks][1] * rs * g0[1]); w.y = pk2(qv[ks][2] * rs * g0[2], qv[ks][3] * rs * g0[3]);
        w.z = pk2(qv[ks][4] * rs * g1[0], qv[ks][5] * rs * g1[1]); w.w = pk2(qv[ks][6] * rs * g1[2], qv[ks][7] * rs * g1[3]);
        qf[ks] = __builtin_bit_cast(bf16x8, w); } }
    f32x16 acc[5];
#pragma unroll
    for (int c = 0; c < 5; ++c) { acc[c] = zero16(); const LAS bf16_t* kb = Ks + (32 * wave + 32 * c + c0) * 72 + 8 * h;
#pragma unroll
        for (int ks = 0; ks < 4; ++ks) acc[c] = __builtin_amdgcn_mfma_f32_32x32x16_bf16(*(const LAS bf16x8*)(kb + ks * 16), qf[ks], acc[c], 0, 0, 0); }
    float mx = -1e30f;
#pragma unroll
    for (int c = 0; c < 5; ++c)
#pragma unroll
        for (int i = 0; i < 16; ++i) { const int kr = crow(i, h); const int delta = 128 + c0 - 32 * c - kr; const int jl = 32 * wave + 32 * c + kr;
            const bool valid = (delta >= 0) && (delta <= 128) && (n * 256 - 128 + jl >= 0);
            const int dcl = delta < 0 ? 0 : (delta > 128 ? 128 : delta);
            const float lgt = valid ? acc[c][i] + BT[dcl] : -1e30f; acc[c][i] = lgt; mx = fmaxf(mx, lgt); }
    mx = fmaxf(mx, __shfl_xor(mx, 32));
    float mprev = 0.f, mnew = mx;
    if (pt > 0) { mprev = LP[tokq * 4 + hd]; mnew = fmaxf(mx, mprev); }
    float lsum = 0.f;
#pragma unroll
    for (int c = 0; c < 5; ++c)
#pragma unroll
        for (int i = 0; i < 16; ++i) { const float pv = __expf(acc[c][i] - mnew); acc[c][i] = pv; lsum += pv; }
    lsum += __shfl_xor(lsum, 32);
    f32x16 o[2]; o[0] = zero16(); o[1] = zero16();
#pragma unroll
    for (int c = 0; c < 5; ++c)
#pragma unroll
        for (int s = 0; s < 2; ++s) { u32x4 pw; pw.x = pk2(acc[c][8 * s + 0], acc[c][8 * s + 1]); pw.y = pk2(acc[c][8 * s + 2], acc[c][8 * s + 3]); pw.z = pk2(acc[c][8 * s + 4], acc[c][8 * s + 5]); pw.w = pk2(acc[c][8 * s + 6], acc[c][8 * s + 7]);
            const bf16x8 pf = __builtin_bit_cast(bf16x8, pw);
#pragma unroll
            for (int vt = 0; vt < 2; ++vt) { const LAS bf16_t* va = Vt + (32 * vt + c0) * 392 + 32 * wave + 32 * c + 16 * s + 4 * h;
                const s16x4 lo = *(const LAS s16x4*)va, hi = *(const LAS s16x4*)(va + 8);
                const bf16x8 vf = __builtin_shufflevector(lo, hi, 0, 1, 2, 3, 4, 5, 6, 7);
                o[vt] = __builtin_amdgcn_mfma_f32_32x32x16_bf16(vf, pf, o[vt], 0, 0, 0); } }
    float sp = 0.f; if (pt > 0) sp = __expf(mprev - mnew);
    const float ltot = lsum + sp, inv = 1.0f / ltot;
#pragma unroll
    for (int vt = 0; vt < 2; ++vt)
#pragma unroll
        for (int g4 = 0; g4 < 4; ++g4) { const int ch = hd * 64 + 32 * vt + 8 * g4 + 4 * h; bf16_t* yo = ON + tokq * onp + ch;
            float v0 = o[vt][4 * g4 + 0], v1 = o[vt][4 * g4 + 1], v2 = o[vt][4 * g4 + 2], v3 = o[vt][4 * g4 + 3];
            if (pt > 0) { const u32x2 w = *(const u32x2*)(OP + tokq * 256 + ch); v0 += sp * bflo(w.x); v1 += sp * bfhi(w.x); v2 += sp * bflo(w.y); v3 += sp * bfhi(w.y); }
            u32x2 w; w.x = pk2(v0 * inv, v1 * inv); w.y = pk2(v2 * inv, v3 * inv); *(u32x2*)yo = w; }
    if (h == 0 && pt < 2) __hip_atomic_store(LN + tokq * 4 + hd, mnew + __logf(ltot), __ATOMIC_RELAXED, __HIP_MEMORY_SCOPE_AGENT);
}

#ifndef REP_A
#define REP_A 0
#endif
#ifndef REP_B
#define REP_B 0
#endif
#ifndef REP_C
#define REP_C 0
#endif
#ifndef REP_D
#define REP_D 0
#endif
#ifndef MIX_A
#define MIX_A 1
#endif
#ifndef MIX_B
#define MIX_B 1
#endif
#ifndef MIX_C
#define MIX_C 1
#endif
#ifndef MIX_D
#define MIX_D 1
#endif
__global__ void __launch_bounds__(512, 2) hybrid_fwd(Params p) {
    extern __shared__ __attribute__((aligned(16))) unsigned char lds_raw[];
    LAS unsigned char* lds = (LAS unsigned char*)lds_raw;
    cg::grid_group grid = cg::this_grid();
    const int G = gridDim.x, bid = blockIdx.x;
    unsigned char* ws = p.ws;
    bf16_t* XB = (bf16_t*)(ws + WS_XB); bf16_t* Zb = (bf16_t*)(ws + WS_Z); bf16_t* YC_ = (bf16_t*)(ws + WS_YCAT); bf16_t* HM = (bf16_t*)(ws + WS_HM);
    float* SSQP = (float*)(ws + WS_SSQP);

#define GRID_SYNC() do { asm volatile("s_waitcnt vmcnt(0) lgkmcnt(0)" ::: "memory"); grid.sync(); if (threadIdx.x < 64) { __builtin_amdgcn_fence(__ATOMIC_ACQUIRE, "agent"); asm volatile("s_waitcnt vmcnt(0)" ::: "memory"); } __syncthreads(); } while (0)
    prologue(p, lds, G);
#ifdef NANFILL
    { u32x4* q = (u32x4*)(ws + WS_S5H); const size_t n16 = (WS_END - WS_S5H) / 16; const u32x4 nanv = (u32x4){0xffffffffu, 0xffffffffu, 0xffffffffu, 0xffffffffu};
      for (size_t i = (size_t)bid * 512 + threadIdx.x; i < n16; i += (size_t)G * 512) q[i] = nanv;
      u32x4* q2 = (u32x4*)(ws + WS_LSE); const size_t m16 = (WS_S5K - WS_LSE) / 16;
      for (size_t i = (size_t)bid * 512 + threadIdx.x; i < m16; i += (size_t)G * 512) q2[i] = nanv; }
#endif
    GRID_SYNC();

#ifndef NL_RUN
#define NL_RUN NL
#endif
#ifndef DUMP_LAYER
#define DUMP_LAYER 0
#endif
    for (int lrun = 0; lrun < NL_RUN; ++lrun) {
#ifdef SAME_LAYER
        const int l = 0; const bool firstl = (lrun == 0), lastl = (lrun == NL_RUN - 1);
#else
        const int l = lrun; const bool firstl = (lrun == 0), lastl = (lrun == NL_RUN - 1);
#endif
        { pg8::Gemm g{XB, (const bf16_t*)(ws + WS_WIN) + (size_t)l * D * DIN, T, DIN, D, D}; pg8::StaticOrder S; S.init(T, DIN, G, bid);
          pg8::EpiScale E{Zb, DIN, SSQP, 0};
          pg8::gemm_phase<pg8::EpiScale, pg8::StaticOrder, true, true>(lds, g, S, E);
#ifdef REPEAT_GEMM
          GRID_SYNC(); pg8::gemm_phase<pg8::EpiScale, pg8::StaticOrder, true, true>(lds, g, S, E);
#endif
        }
        GRID_SYNC();
#ifndef SKIP_MIX
        if (!(MIX_A && MIX_B && MIX_C && MIX_D)) { int tq = threadIdx.x; asm volatile("" : "+v"(tq));
          for (int m = bid * 8 + (tq >> 6); m < T; m += G * 8) { u32x2* yp = (u32x2*)(YC_ + (size_t)m * D) + (tq & 63); const u32x2 z2 = (u32x2){0u, 0u};
              if (!MIX_A) yp[0] = z2; if (!MIX_B) yp[64] = z2; if (!MIX_C) yp[128] = z2; if (!MIX_D) yp[192] = z2; } }
#ifndef MIX_REPEAT
#define MIX_REPEAT 1
#endif
        for (int rep = 0; rep < MIX_REPEAT; ++rep) {
        for (int it = bid; it < 1664; it += G) {
            if (it < 512) { if (MIX_A) { hgrn_item<false>(p, lds, l, it); if (REP_A) hgrn_item<false>(p, lds, l, it); } }
            else if (it < 1024) { if (MIX_B) { conv_item(p, lds, l, it - 512); if (REP_B) conv_item(p, lds, l, it - 512); } }
            else if (it < 1152) { if (MIX_C) { s5_local_item(p, l, it - 1024); if (REP_C) s5_local_item(p, l, it - 1024); } }
            else { if (MIX_D) { attn_item(p, lds, l, 0, it - 1152); if (REP_D) attn_item(p, lds, l, 0, it - 1152); } }
        }
        GRID_SYNC();
        for (int it = bid; it < 648; it += G) {
            if (it < 128) { if (MIX_A) hgrn_scan_item(p, it); }
            else if (it < 136) { if (MIX_C) s5_scan_item(p, l, it - 128); }
            else { if (MIX_D) { attn_item(p, lds, l, 1, it - 136); if (REP_D) attn_item(p, lds, l, 1, it - 136); } }
        }
        GRID_SYNC();
        for (int it = bid; it < 1536; it += G) {
            if (it < 512) { if (MIX_A) { hgrn_item<true>(p, lds, l, it); if (REP_A) hgrn_item<true>(p, lds, l, it); } }
            else if (it < 1024) { if (MIX_C) { s5_out_item(p, lds, l, it - 512); if (REP_C) s5_out_item(p, lds, l, it - 512); } }
            else { if (MIX_D) { attn_item(p, lds, l, 2, it - 1024); if (REP_D) attn_item(p, lds, l, 2, it - 1024); } }
        }
        GRID_SYNC();
        }
#ifndef NO_GLU
        { pg8::Gemm g{(const bf16_t*)(ws + WS_YPRE), (const bf16_t*)(ws + WS_WGLU) + (size_t)l * 65536, T, 256, 256, 256}; pg8::StaticOrder S; S.init(T, 256, G, bid);
          pg8::EpiGlu E{(const bf16_t*)(ws + WS_YPRE), 256, YC_ + YC};
          pg8::gemm_phase<pg8::EpiGlu, pg8::StaticOrder, false, true>(lds, g, S, E); }
#endif
        { int tq = threadIdx.x; asm volatile("" : "+v"(tq)); const int lane = tq & 63; const int gw = bid * 8 + (tq >> 6), NGW = G * 8;
          for (int m = gw; m < T; m += NGW) { u32x2* yp = (u32x2*)(YC_ + (size_t)m * D + YD) + lane; const u32x2 w = *((const u32x2*)(Zb + (size_t)m * DIN + ZOD) + lane);
              const float a0 = bflo(w.x), a1 = bfhi(w.x), a2 = bflo(w.y), a3 = bfhi(w.y);
              const float ss = wave_sum((a0 * a0 + a1 * a1) + (a2 * a2 + a3 * a3)); const float rs = rsqrtf(ss * (1.0f / 256.0f) + EPS);
              u32x2 o; o.x = pk2(a0 * rs, a1 * rs); o.y = pk2(a2 * rs, a3 * rs); *yp = o; } }
        GRID_SYNC();
#endif
#ifdef DUMP_SLICE
        if (lrun == DUMP_LAYER) { int tq = threadIdx.x; asm volatile("" : "+v"(tq));
          for (int m = bid * 8 + (tq >> 6); m < T; m += G * 8) { const int ln = tq & 63;
              for (int j = 0; j < 4; ++j) { const int col = j * 256 + ln * 4; const u32x2 w = *(const u32x2*)(YC_ + (size_t)m * D + col);
                  f32x4 o = (f32x4){0.f, 0.f, 0.f, 0.f}; if (j == DUMP_SLICE) o = (f32x4){bflo(w.x), bfhi(w.x), bflo(w.y), bfhi(w.y)};
                  *(f32x4*)(p.out + (size_t)m * D + col) = o; } }
          break; }
#endif
#ifdef SKIP_MIX
        { pg8::Gemm g{Zb, (const bf16_t*)(ws + WS_WOUT) + (size_t)l * D * D, T, D, D, DIN}; pg8::StaticOrder S; S.init(T, D, G, bid);
#else
        { pg8::Gemm g{YC_, (const bf16_t*)(ws + WS_WOUT) + (size_t)l * D * D, T, D, D, D}; pg8::StaticOrder S; S.init(T, D, G, bid);
#endif
          pg8::EpiRes E{firstl ? p.in[I_X] : p.out, p.out, XB, SSQP + (size_t)T * 16};
          pg8::gemm_phase<pg8::EpiRes, pg8::StaticOrder, true, true>(lds, g, S, E); }
        GRID_SYNC();
        { pg8::Gemm g{XB, (const bf16_t*)(ws + WS_WUP) + (size_t)l * D * FF, T, FF, D, D}; pg8::StaticOrder S; S.init(T, FF, G, bid);
          pg8::EpiScale E{HM, FF, SSQP + (size_t)T * 16, 1};
          pg8::gemm_phase<pg8::EpiScale, pg8::StaticOrder, true, true>(lds, g, S, E);
#ifdef REPEAT_GEMM
          GRID_SYNC(); pg8::gemm_phase<pg8::EpiScale, pg8::StaticOrder, true, true>(lds, g, S, E);
#endif
        }
        GRID_SYNC();
        { pg8::Gemm g{HM, (const bf16_t*)(ws + WS_WDN) + (size_t)l * D * FF, T, D, FF, FF}; pg8::StaticOrder S; S.init(T, D, G, bid);
          pg8::EpiRes E{p.out, p.out, XB, !lastl ? SSQP : nullptr};
          pg8::gemm_phase<pg8::EpiRes, pg8::StaticOrder, true, true>(lds, g, S, E); }
        if (!lastl) GRID_SYNC();
    }
}

extern "C" void kernel_launch(void* const* d_in, const int* in_sizes, int n_in, void* d_out, int out_size, void* d_ws, size_t ws_size, hipStream_t stream) {
    static int grid = 0;
    if (grid == 0) {
        if (n_in != 26 || out_size != T * D || ws_size < WS_END) { fprintf(stderr, "kernel_launch: unexpected shapes (n_in %d, out %d, ws %zu); nothing launched\n", n_in, out_size, ws_size); grid = -1; return; }
        int dev = 0, cus = 0, per_cu = 0;
        (void)hipGetDevice(&dev); (void)hipDeviceGetAttribute(&cus, hipDeviceAttributeMultiprocessorCount, dev);
        if (hipFuncSetAttribute((const void*)hybrid_fwd, hipFuncAttributeMaxDynamicSharedMemorySize, LDS_BYTES) != hipSuccess) { fprintf(stderr, "kernel_launch: hipFuncSetAttribute failed\n"); grid = -1; return; }
        if (hipOccupancyMaxActiveBlocksPerMultiprocessor(&per_cu, (const void*)hybrid_fwd, 512, LDS_BYTES) != hipSuccess || per_cu < 1) { fprintf(stderr, "kernel_launch: occupancy query gave %d\n", per_cu); per_cu = 1; }
        (void)hipGetLastError();
        if (cus <= 0) cus = 256;
        grid = cus * per_cu;
    }
    if (grid < 0) return;
    Params a{};
    for (int i = 0; i < 26; ++i) a.in[i] = (const float*)d_in[i];
    a.out = (float*)d_out; a.ws = (unsigned char*)d_ws;
    void* args[] = {&a};
    hipError_t e = hipLaunchCooperativeKernel((const void*)hybrid_fwd, dim3(grid), dim3(512), args, LDS_BYTES, stream);
    if (e != hipSuccess) fprintf(stderr, "cooperative launch failed: %s (grid %d)\n", hipGetErrorString(e), grid);
}
```

```cpp
#include <hip/hip_runtime.h>
#include <hip/hip_cooperative_groups.h>
#include <cstdio>
#include <cstdint>
namespace cg = cooperative_groups;

#define DI __device__ __forceinline__
#define LAS __attribute__((address_space(3)))
typedef unsigned short bf16_t;
typedef short bf16x8 __attribute__((ext_vector_type(8)));
typedef short s16x4 __attribute__((ext_vector_type(4)));
typedef float f32x4 __attribute__((ext_vector_type(4)));
typedef float f32x16 __attribute__((ext_vector_type(16)));
typedef unsigned u32x4 __attribute__((ext_vector_type(4)));
typedef unsigned u32x2 __attribute__((ext_vector_type(2)));

constexpr int NB = 4, SEQ = 8192, T = NB * SEQ, D = 1024, DIN = 2560, FF = 4096, NL = 4;
constexpr int ZQ = 0, ZF = 256, ZI = 512, ZG = 768, ZBV = 1024, ZBG = 1280, ZCU = 1536, ZDQ = 1792, ZDK = 2048, ZDV = 2304;
constexpr int YA = 0, YB = 256, YC = 512, YD = 768;
constexpr int ZOD = ZBG;
constexpr float EPS = 1e-6f;
constexpr size_t MiB = 1u << 20;
constexpr size_t WS_WIN = 0, WS_WOUT = 20 * MiB, WS_WUP = 28 * MiB, WS_WDN = 60 * MiB, WS_WGLU = 92 * MiB;
constexpr size_t WS_LB = 93 * MiB;
constexpr size_t WS_BIAS = WS_LB + 4096;
constexpr size_t WS_BAR = WS_LB + 32768;
constexpr size_t WS_SSQ = WS_LB + 65536;
constexpr size_t WS_LSE = WS_SSQ + 8 * (size_t)T * 4;
constexpr size_t WS_DEC = WS_LSE + (size_t)T * 16;
constexpr size_t WS_LSE1 = WS_DEC + 2048 * 64 * 4;
constexpr size_t WS_S5K = 96 * MiB;
constexpr size_t WS_S5WS = 98 * MiB;
constexpr size_t WS_S5WC = 114 * MiB;
constexpr size_t WS_XB = 130 * MiB;
constexpr size_t WS_S5H = 194 * MiB;
constexpr size_t WS_HM = 198 * MiB;
constexpr size_t WS_Z = 198 * MiB;
constexpr size_t WS_YCAT = 358 * MiB;
constexpr size_t WS_SL = 422 * MiB, WS_SL2 = 438 * MiB;
constexpr size_t WS_S5H2 = 454 * MiB;
constexpr size_t WS_O0 = 458 * MiB, WS_O1 = 474 * MiB;
constexpr size_t WS_YPRE = 490 * MiB;
constexpr size_t WS_SSQP = 506 * MiB;
constexpr size_t WS_END = 510 * MiB;
static_assert(WS_LSE1 + (size_t)T * 16 <= WS_S5K, "misc region");

constexpr int LDS_BYTES = 147456;

DI unsigned f2bf(float f) { unsigned u = __builtin_bit_cast(unsigned, f); return (u + 0x7fffu + ((u >> 16) & 1u)) >> 16; }
typedef float f32x2_t __attribute__((ext_vector_type(2))); typedef __bf16 bf16x2_t __attribute__((ext_vector_type(2)));
DI unsigned pk2(float lo, float hi) { const f32x2_t v = {lo, hi}; const bf16x2_t b = __builtin_convertvector(v, bf16x2_t); return __builtin_bit_cast(unsigned, b); }
DI float bf2f(bf16_t v) { return __builtin_bit_cast(float, (unsigned)v << 16); }
DI float bflo(unsigned w) { return __builtin_bit_cast(float, w << 16); }
DI float bfhi(unsigned w) { return __builtin_bit_cast(float, w & 0xffff0000u); }
DI float sigmoidf_(float x) { return 1.f / (1.f + __expf(-x)); }
DI float wave_sum(float v) {
#pragma unroll
    for (int o = 1; o < 64; o <<= 1) v += __shfl_xor(v, o);
    return v;
}
DI float half_sum(float v) {
#pragma unroll
    for (int o = 1; o < 32; o <<= 1) v += __shfl_xor(v, o);
    return v;
}
#define LDS_WAIT() asm volatile("s_waitcnt lgkmcnt(0)" ::: "memory")
DI int crow(int reg, int h) { return (reg & 3) + 8 * (reg >> 2) + 4 * h; }

template <int K>
DI f32x16 mma_lds(const LAS bf16_t* A, int lda, const LAS bf16_t* B, int ldb, f32x16 acc, int lane) {
    const int r = lane & 31, h = lane >> 5;
    const LAS bf16_t* ap = A + r * lda + 8 * h; const LAS bf16_t* bp = B + r * ldb + 8 * h;
#pragma unroll
    for (int k0 = 0; k0 < K; k0 += 16) {
        const bf16x8 a = *(const LAS bf16x8*)(ap + k0); const bf16x8 b = *(const LAS bf16x8*)(bp + k0);
        acc = __builtin_amdgcn_mfma_f32_32x32x16_bf16(a, b, acc, 0, 0, 0);
    }
    return acc;
}
DI f32x16 zero16() { f32x16 z;
#pragma unroll
    for (int i = 0; i < 16; ++i) z[i] = 0.f;
    return z; }

namespace pg8 {
#define PG8_LAS __attribute__((address_space(3)))
constexpr int BM = 256, BK = 64, HALF = 128, HTB = HALF * BK * 2, STAGE_BYTES = 8 * HTB, NXCD = 8, WGM = 8;
__host__ __device__ __forceinline__ int lds_byte(int r, int c) { const int st = (r >> 4) * 2 + (c >> 5), rr = r & 15, cc = c & 31, ob = rr * 64 + cc * 2; return st * 1024 + (ob ^ (((ob >> 9) & 1) << 5)); }
__host__ __device__ __forceinline__ void stage_rc(int b, int& R, int& C) { const int st = b / 1024, sb = b % 1024, swz = sb ^ (((sb >> 9) & 1) << 5); R = (st >> 1) * 16 + swz / 64; C = (st & 1) * 32 + (swz % 64) / 2; }
__host__ __device__ __forceinline__ int perm32(int rho) { const int n = rho >> 4, i = rho & 15; return 8 * (i >> 2) + 4 * n + (i & 3); }
struct Unit { int pm, pn; };
struct Gemm { const bf16_t* A; const bf16_t* Bt; int M, N, K, lda; };
struct StaticOrder {
    int nM, nN, nwg, G, c;
    __host__ __device__ void init(int M, int N, int G_, int c_) { nM = M / BM; nN = N / BM; nwg = nM * nN; G = G_; c = c_; }
    __host__ __device__ bool next(int i, Unit& u) const {
        const long L = (long)i * G + c; if (L >= nwg) return false;
        int wgid = (int)L; { const int q = nwg / NXCD, r = nwg % NXCD, xcd = wgid % NXCD, off = wgid / NXCD; wgid = (xcd < r ? xcd * (q + 1) : r * (q + 1) + (xcd - r) * q) + off; }
        const int nig = WGM * nN, gid = wgid / nig, fm = gid * WGM, gsz = (nM - fm) < WGM ? (nM - fm) : WGM;
        u.pm = fm + ((wgid % nig) % gsz); u.pn = (wgid % nig) / gsz; return true;
    }
    __device__ __forceinline__ void a_ready(const Unit&) const {}
    __device__ __forceinline__ void done(const Unit&) const {}
};
struct EpiScale {
    static constexpr bool PERM = true, AFTER_DRAIN = false;
    bf16_t* O; int ldc; const float* ssq; int act;
    __device__ __forceinline__ void operator()(const f32x4 (&acc)[2][2][4][2], const Unit& u, int wr, int wc, int fr, int fq) const {
        const int row0 = u.pm * BM + wr * 64 + fr; const int col0 = u.pn * BM + wc * 32 + 8 * fq;
#pragma unroll
        for (int ai = 0; ai < 2; ++ai)
#pragma unroll
            for (int m = 0; m < 4; ++m) { const int r = row0 + ai * HALF + m * 16; const f32x4* sq = (const f32x4*)(ssq + (size_t)r * 16); const f32x4 q0 = sq[0], q1 = sq[1], q2 = sq[2], q3 = sq[3];
                const float tot = (((q0[0] + q0[1]) + (q0[2] + q0[3])) + ((q1[0] + q1[1]) + (q1[2] + q1[3]))) + (((q2[0] + q2[1]) + (q2[2] + q2[3])) + ((q3[0] + q3[1]) + (q3[2] + q3[3])));
                const float rs = rsqrtf(tot * (1.0f / 1024.0f) + EPS);
                bf16_t* rowp = O + (size_t)r * ldc + col0;
#pragma unroll
                for (int bj = 0; bj < 2; ++bj) { f32x4 v0 = acc[ai][bj][m][0] * rs, v1 = acc[ai][bj][m][1] * rs;
                    if (act) {
#pragma unroll
                        for (int e = 0; e < 4; ++e) { const float a = fmaxf(v0[e], 0.f), b = fmaxf(v1[e], 0.f); v0[e] = a * a; v1[e] = b * b; } }
                    u32x4 w; w.x = pk2(v0[0], v0[1]); w.y = pk2(v0[2], v0[3]); w.z = pk2(v1[0], v1[1]); w.w = pk2(v1[2], v1[3]);
                    *(u32x4*)(rowp + bj * HALF) = w; } }
    }
};
struct EpiRes {
    static constexpr bool PERM = false, AFTER_DRAIN = false;
    const float* base; float* out; bf16_t* xb; float* ssq_out;
    __device__ __forceinline__ void operator()(const f32x4 (&acc)[2][2][4][2], const Unit& u, int wr, int wc, int fr, int fq) const {
        const int col0 = u.pn * BM + wc * 32 + 4 * fq;
#pragma unroll
        for (int ai = 0; ai < 2; ++ai)
#pragma unroll
            for (int m = 0; m < 4; ++m) { const int r = u.pm * BM + ai * HALF + wr * 64 + m * 16 + fr; const size_t off = (size_t)r * D + col0; float s = 0.f;
#pragma unroll
                for (int bj = 0; bj < 2; ++bj)
#pragma unroll
                    for (int n = 0; n < 2; ++n) { const size_t o2 = off + bj * HALF + n * 16; const f32x4 o = *(const f32x4*)(base + o2) + acc[ai][bj][m][n];
                        *(f32x4*)(out + o2) = o; u32x2 w; w.x = pk2(o[0], o[1]); w.y = pk2(o[2], o[3]); *(u32x2*)(xb + o2) = w;
                        s += (o[0] * o[0] + o[1] * o[1]) + (o[2] * o[2] + o[3] * o[3]); }
                s += __shfl_xor(s, 16); s += __shfl_xor(s, 32);
                if (fq == 0 && ssq_out) ssq_out[(size_t)r * 16 + u.pn * 4 + wc] = s; }
    }
};
struct EpiGlu {
    static constexpr bool PERM = false, AFTER_DRAIN = true;
    const bf16_t* Ysrc; int lds_; bf16_t* Y;
    __device__ __forceinline__ void fused(f32x4 (&acc)[2][2][4][2], const Unit& u, int wr, int wc, int fr, int fq, PG8_LAS unsigned char* lds, int wid, int lane) const {
        PG8_LAS float* Pp = (PG8_LAS float*)lds;
        const int col0 = wc * 32 + 4 * fq;
#pragma unroll
        for (int ai = 0; ai < 2; ++ai)
#pragma unroll
            for (int m = 0; m < 4; ++m) { const int rl = ai * HALF + wr * 64 + m * 16 + fr; const size_t off = (size_t)(u.pm * BM + rl) * lds_ + col0; float s = 0.f;
#pragma unroll
                for (int bj = 0; bj < 2; ++bj)
#pragma unroll
                    for (int n = 0; n < 2; ++n) { const u32x2 w = *(const u32x2*)(Ysrc + off + bj * HALF + n * 16); f32x4 a = acc[ai][bj][m][n];
                        const float y0 = bflo(w.x), y1 = bfhi(w.x), y2 = bflo(w.y), y3 = bfhi(w.y);
                        a[0] = y0 * sigmoidf_(a[0]); a[1] = y1 * sigmoidf_(a[1]); a[2] = y2 * sigmoidf_(a[2]); a[3] = y3 * sigmoidf_(a[3]);
                        acc[ai][bj][m][n] = a; s += (a[0] * a[0] + a[1] * a[1]) + (a[2] * a[2] + a[3] * a[3]); }
                s += __shfl_xor(s, 16); s += __shfl_xor(s, 32);
                if (fq == 0) Pp[rl * 4 + wc] = s; }
        __syncthreads();
#pragma unroll
        for (int ai = 0; ai < 2; ++ai)
#pragma unroll
            for (int m = 0; m < 4; ++m) { const int rl = ai * HALF + wr * 64 + m * 16 + fr; const size_t off = (size_t)(u.pm * BM + rl) * D + col0;
                const float tot = (Pp[rl * 4 + 0] + Pp[rl * 4 + 1]) + (Pp[rl * 4 + 2] + Pp[rl * 4 + 3]); const float rs = rsqrtf(tot * (1.0f / 256.0f) + EPS);
#pragma unroll
                for (int bj = 0; bj < 2; ++bj)
#pragma unroll
                    for (int n = 0; n < 2; ++n) { const f32x4 a = acc[ai][bj][m][n] * rs; u32x2 w; w.x = pk2(a[0], a[1]); w.y = pk2(a[2], a[3]); *(u32x2*)(Y + off + bj * HALF + n * 16) = w; } }
    }
};

template <class Epi, class Sched, bool ALIGN_EPI = false, bool SP2 = false>
__device__ __forceinline__ void gemm_phase(PG8_LAS unsigned char* lds, const Gemm g, const Sched& S, const Epi& E) {
    int tid_o = threadIdx.x; asm volatile("" : "+v"(tid_o));
    const int tid = tid_o, wid = __builtin_amdgcn_readfirstlane(tid >> 6), lane = tid & 63, wr = wid >> 2, wc = wid & 3, fr = lane & 15, fq = lane >> 4;
    const int K = g.K, nt = K / BK;
    unsigned voffA[2], voffB[2];
#pragma unroll
    for (int i = 0; i < 2; ++i) { int R, C; stage_rc(tid * 16 + i * 8192, R, C); const int Rb = Epi::PERM ? ((R & ~31) + perm32(R & 31)) : R;
        voffA[i] = (unsigned)(R * g.lda + C) * 2u; voffB[i] = (unsigned)(Rb * K + C) * 2u; }
    const size_t kstep = (size_t)(BK * 2);
    const size_t hstepA = (size_t)HALF * g.lda * 2, hstepB = (size_t)HALF * K * 2;
    const size_t tstepA = 2 * hstepA, tstepB = 2 * hstepB;
    const unsigned ldsw = (unsigned)wid * 1024u;
    const int aoff = lds_byte(wr * 64 + fr, fq * 8), boff = lds_byte(wc * 32 + fr, fq * 8);
#define PG8_SA(b, h) (((b) * 2 + (h)) * HTB)
#define PG8_SB(b, h) ((4 + (b) * 2 + (h)) * HTB)
#define PG8_STAGE(bufoff, gbase, voff) do { _Pragma("unroll") for (int _i = 0; _i < 2; ++_i) \
        __builtin_amdgcn_global_load_lds((const unsigned*)((const char*)(gbase) + (voff)[_i]), (PG8_LAS unsigned*)(lds + (bufoff) + ldsw + _i * 8192), 16, 0, 0); } while (0)
#define PG8_LDA(dst, b, h) do { _Pragma("unroll") for (int m = 0; m < 4; ++m) _Pragma("unroll") for (int k = 0; k < 2; ++k) dst[m][k] = *(const PG8_LAS bf16x8*)(lds + PG8_SA(b, h) + aoff + m * 2048 + k * 1024); } while (0)
#define PG8_LDB(dst, b, h) do { _Pragma("unroll") for (int n = 0; n < 2; ++n) _Pragma("unroll") for (int k = 0; k < 2; ++k) dst[n][k] = *(const PG8_LAS bf16x8*)(lds + PG8_SB(b, h) + boff + n * 2048 + k * 1024); } while (0)
#define PG8_MMA(ai, bj, At, Bt) do { __builtin_amdgcn_s_setprio(1); _Pragma("unroll") for (int m = 0; m < 4; ++m) _Pragma("unroll") for (int n = 0; n < 2; ++n) _Pragma("unroll") for (int k = 0; k < 2; ++k) \
        acc[ai][bj][m][n] = __builtin_amdgcn_mfma_f32_16x16x32_bf16(Bt[n][k], At[m][k], acc[ai][bj][m][n], 0, 0, 0); __builtin_amdgcn_s_setprio(0); } while (0)
#define PG8_WAIT_V(n) asm volatile("s_waitcnt vmcnt(" #n ")" ::: "memory")
#define PG8_WAIT_L(n) asm volatile("s_waitcnt lgkmcnt(" #n ")" ::: "memory")
#define PG8_BAR __builtin_amdgcn_s_barrier()
#define PG8_SCHED __builtin_amdgcn_sched_barrier(0)
    Unit cur, nxt; int ui = 0;
    if (!S.next(0, cur)) return;
    f32x4 acc[2][2][4][2];
#pragma unroll
    for (int a = 0; a < 2; ++a)
#pragma unroll
        for (int b = 0; b < 2; ++b)
#pragma unroll
            for (int m = 0; m < 4; ++m)
#pragma unroll
                for (int n = 0; n < 2; ++n) acc[a][b][m][n] = (f32x4){0.f, 0.f, 0.f, 0.f};
    bf16x8 At[4][2], B0[2][2], B1[2][2];
    const char* cA = (const char*)g.A + (size_t)cur.pm * tstepA; const char* cB = (const char*)g.Bt + (size_t)cur.pn * tstepB;
    S.a_ready(cur);
    if constexpr (SP2) {
        PG8_STAGE(PG8_SB(0, 0), cB, voffB); PG8_STAGE(PG8_SB(0, 1), cB + hstepB, voffB); PG8_STAGE(PG8_SA(0, 0), cA, voffA); PG8_STAGE(PG8_SA(0, 1), cA + hstepA, voffA);
        if (wr == 1) PG8_BAR;
        PG8_WAIT_V(2); PG8_BAR;
        PG8_STAGE(PG8_SB(1, 0), cB + kstep, voffB); PG8_STAGE(PG8_SA(1, 0), cA + kstep, voffA); PG8_STAGE(PG8_SB(1, 1), cB + hstepB + kstep, voffB);
        PG8_WAIT_V(6); PG8_BAR;
    } else {
        PG8_STAGE(PG8_SB(0, 0), cB, voffB); PG8_STAGE(PG8_SA(0, 0), cA, voffA); PG8_STAGE(PG8_SB(0, 1), cB + hstepB, voffB); PG8_STAGE(PG8_SA(0, 1), cA + hstepA, voffA);
        if (wr == 1) PG8_BAR;
        PG8_WAIT_V(4); PG8_BAR;
        PG8_STAGE(PG8_SB(1, 0), cB + kstep, voffB); PG8_STAGE(PG8_SA(1, 0), cA + kstep, voffA); PG8_STAGE(PG8_SB(1, 1), cB + hstepB + kstep, voffB);
        PG8_WAIT_V(6); PG8_BAR;
    }
    for (;;) {
        const bool has_next = S.next(ui + 1, nxt);
        const char* nA = has_next ? (const char*)g.A + (size_t)nxt.pm * tstepA : cA; const char* nB = has_next ? (const char*)g.Bt + (size_t)nxt.pn * tstepB : cB;
        for (int t = 0; t < nt; t += 2) {
            const bool last = (t == nt - 2);
            const char* a1 = cA + (size_t)(t + 1) * kstep;
            const char* a2 = last ? nA : cA + (size_t)(t + 2) * kstep; const char* b2 = last ? nB : cB + (size_t)(t + 2) * kstep;
            const char* a3 = a2 + kstep; const char* b3 = b2 + kstep;
            if (last && has_next) S.a_ready(nxt);
            if constexpr (SP2) {
            PG8_LDB(B0, 0, 0); PG8_LDB(B1, 0, 1); PG8_SCHED; PG8_LDA(At, 0, 0); PG8_STAGE(PG8_SA(1, 1), a1 + hstepA, voffA);
            PG8_WAIT_V(8); PG8_WAIT_L(0); PG8_BAR; PG8_MMA(0, 0, At, B0); PG8_MMA(0, 1, At, B1); PG8_BAR; PG8_SCHED;
            PG8_LDA(At, 0, 1); PG8_STAGE(PG8_SB(0, 0), b2, voffB); PG8_STAGE(PG8_SB(0, 1), b2 + hstepB, voffB); PG8_STAGE(PG8_SA(0, 0), a2, voffA);
            PG8_WAIT_V(8); PG8_WAIT_L(0); PG8_BAR; PG8_MMA(1, 0, At, B0); PG8_MMA(1, 1, At, B1); PG8_BAR; PG8_SCHED;
            PG8_LDB(B0, 1, 0); PG8_LDB(B1, 1, 1); PG8_SCHED; PG8_LDA(At, 1, 0); PG8_STAGE(PG8_SA(0, 1), a2 + hstepA, voffA);
            PG8_WAIT_V(8); PG8_WAIT_L(0); PG8_BAR; PG8_MMA(0, 0, At, B0); PG8_MMA(0, 1, At, B1); PG8_BAR; PG8_SCHED;
            PG8_LDA(At, 1, 1); PG8_STAGE(PG8_SB(1, 0), b3, voffB); PG8_STAGE(PG8_SB(1, 1), b3 + hstepB, voffB); PG8_STAGE(PG8_SA(1, 0), a3, voffA);
            PG8_WAIT_V(8); PG8_WAIT_L(0); PG8_BAR; PG8_MMA(1, 0, At, B0); PG8_MMA(1, 1, At, B1); PG8_BAR; PG8_SCHED;
            } else {
            PG8_LDB(B0, 0, 0); PG8_SCHED; PG8_LDA(At, 0, 0); PG8_STAGE(PG8_SA(1, 1), a1 + hstepA, voffA);
            PG8_WAIT_L(8); PG8_BAR; PG8_WAIT_L(0); PG8_MMA(0, 0, At, B0); PG8_BAR; PG8_SCHED;
            PG8_LDB(B1, 0, 1); PG8_STAGE(PG8_SB(0, 0), b2, voffB);
            PG8_BAR; PG8_WAIT_L(0); PG8_MMA(0, 1, At, B1); PG8_BAR;
            PG8_LDA(At, 0, 1); PG8_STAGE(PG8_SA(0, 0), a2, voffA);
            PG8_BAR; PG8_WAIT_L(0); PG8_MMA(1, 0, At, B0); PG8_BAR; PG8_SCHED;
            PG8_STAGE(PG8_SB(0, 1), b2 + hstepB, voffB);
            PG8_WAIT_V(6); PG8_BAR; PG8_MMA(1, 1, At, B1); PG8_BAR;
            PG8_LDB(B0, 1, 0); PG8_SCHED; PG8_LDA(At, 1, 0); PG8_STAGE(PG8_SA(0, 1), a2 + hstepA, voffA);
            PG8_WAIT_L(8); PG8_BAR; PG8_WAIT_L(0); PG8_MMA(0, 0, At, B0); PG8_BAR; PG8_SCHED;
            PG8_LDB(B1, 1, 1); PG8_STAGE(PG8_SB(1, 0), b3, voffB);
            PG8_BAR; PG8_WAIT_L(0); PG8_MMA(0, 1, At, B1); PG8_BAR;
            PG8_LDA(At, 1, 1); PG8_STAGE(PG8_SA(1, 0), a3, voffA);
            PG8_BAR; PG8_WAIT_L(0); PG8_MMA(1, 0, At, B0); PG8_BAR; PG8_SCHED;
            PG8_STAGE(PG8_SB(1, 1), b3 + hstepB, voffB);
            PG8_WAIT_V(6); PG8_BAR; PG8_MMA(1, 1, At, B1); PG8_BAR;
            }
        }
        if constexpr (ALIGN_EPI) { if (wr == 0) PG8_BAR; }
        if constexpr (!Epi::AFTER_DRAIN) { E(acc, cur, wr, wc, fr, fq); S.done(cur); }
        if (!has_next) break;
#pragma unroll
        for (int a = 0; a < 2; ++a)
#pragma unroll
            for (int b = 0; b < 2; ++b)
#pragma unroll
                for (int m = 0; m < 4; ++m)
#pragma unroll
                    for (int n = 0; n < 2; ++n) acc[a][b][m][n] = (f32x4){0.f, 0.f, 0.f, 0.f};
        cur = nxt; cA = nA; cB = nB; ++ui;
        if constexpr (ALIGN_EPI) { if (wr == 1) PG8_BAR; }
    }
    PG8_WAIT_V(0);
    if constexpr (!ALIGN_EPI) { if (wr == 0) PG8_BAR; }
    PG8_BAR;
    if constexpr (Epi::AFTER_DRAIN) { E.fused(acc, cur, wr, wc, fr, fq, lds, wid, lane); S.done(cur); }
#undef PG8_SA
#undef PG8_SB
#undef PG8_STAGE
#undef PG8_LDA
#undef PG8_LDB
#undef PG8_MMA
#undef PG8_WAIT_V
#undef PG8_WAIT_L
#undef PG8_BAR
#undef PG8_SCHED
}
}

struct Params { const float* in[26]; float* out; unsigned char* ws; };
enum { I_X = 0, I_NMG, I_WIN, I_LBL, I_HNG, I_CW, I_CB, I_CLG, I_CLB, I_LRE, I_LIM, I_BRE, I_BIM, I_CRE, I_CIM, I_S5D, I_LDT, I_WGLU, I_QG, I_KG, I_RB, I_MONG, I_WOUT, I_NMLPG, I_WUP, I_WDN };

DI void p0_transpose_item(const float* W, int K, int N, bf16_t* WT, const float* gk, LAS float* scr, int item, int lane) {
    const int nblk = N / 32, kb = item / nblk, nb = item % nblk, k0 = 64 * kb, n0 = 32 * nb;
#pragma unroll 8
    for (int i = 0; i < 32; ++i) { const int kk = 2 * i + (lane >> 5); const float s = gk ? gk[k0 + kk] : 1.f; scr[kk * 33 + (lane & 31)] = W[(size_t)(k0 + kk) * N + n0 + (lane & 31)] * s; }
    LDS_WAIT();
    const int c = lane & 7;
#pragma unroll
    for (int j = 0; j < 4; ++j) { const int n = (lane >> 3) + 8 * j; const LAS float* s = scr + (8 * c) * 33 + n;
        u32x4 o; o.x = pk2(s[0 * 33], s[1 * 33]); o.y = pk2(s[2 * 33], s[3 * 33]); o.z = pk2(s[4 * 33], s[5 * 33]); o.w = pk2(s[6 * 33], s[7 * 33]);
        *(u32x4*)(WT + (size_t)(n0 + n) * K + k0 + 8 * c) = o; }
    LDS_WAIT();
}
DI void s5_params(const Params& p, int lg, int pp, float& lrdt, float& lidt, float& cr, float& ci) {
    const float dt = expf(p.in[I_LDT][lg]);
    const float lr = p.in[I_LRE][lg * 64 + pp], li = p.in[I_LIM][lg * 64 + pp];
    lrdt = lr * dt; lidt = li * dt;
    const float mag = expf(lrdt); const float ar = mag * cosf(lidt), ai = mag * sinf(lidt);
    const float den = lr * lr + li * li;
    cr = ((ar - 1.0f) * lr + ai * li) / den; ci = (ai * lr - (ar - 1.0f) * li) / den;
}
DI void s5_pow(float lrdt, float lidt, int n, float& er, float& ei) { const float m = expf((float)n * lrdt); const float a = (float)n * lidt; er = m * cosf(a); ei = m * sinf(a); }

DI void prologue(const Params& p, LAS unsigned char* lds, int G) {
    int tid_o = threadIdx.x; asm volatile("" : "+v"(tid_o));
    const int tid = tid_o, lane = tid & 63, wave = tid >> 6;
    const int gw = blockIdx.x * 8 + wave, NGW = G * 8;
    const int gt = blockIdx.x * 512 + tid, NGT = G * 512;
    unsigned char* ws = p.ws;
    LAS float* scr = (LAS float*)(lds + wave * 16384);
    {
        constexpr int I_IN = (D / 64) * (DIN / 32), I_OUT = (D / 64) * (D / 32), I_UP = (D / 64) * (FF / 32), I_DN = (FF / 64) * (D / 32), I_GL = (256 / 64) * (256 / 32);
        constexpr int PER_L = I_IN + I_OUT + I_UP + I_DN + I_GL;
        for (int it = gw; it < NL * PER_L; it += NGW) {
            const int l = it / PER_L; int r = it % PER_L;
            if (r < I_IN) { p0_transpose_item(p.in[I_WIN] + (size_t)l * D * DIN, D, DIN, (bf16_t*)(ws + WS_WIN) + (size_t)l * D * DIN, p.in[I_NMG] + l * D, scr, r, lane); continue; } r -= I_IN;
            if (r < I_OUT) { p0_transpose_item(p.in[I_WOUT] + (size_t)l * D * D, D, D, (bf16_t*)(ws + WS_WOUT) + (size_t)l * D * D, p.in[I_MONG] + l * D, scr, r, lane); continue; } r -= I_OUT;
            if (r < I_UP) { p0_transpose_item(p.in[I_WUP] + (size_t)l * D * FF, D, FF, (bf16_t*)(ws + WS_WUP) + (size_t)l * D * FF, p.in[I_NMLPG] + l * D, scr, r, lane); continue; } r -= I_UP;
            if (r < I_DN) { p0_transpose_item(p.in[I_WDN] + (size_t)l * D * FF, FF, D, (bf16_t*)(ws + WS_WDN) + (size_t)l * D * FF, nullptr, scr, r, lane); continue; } r -= I_DN;
            p0_transpose_item(p.in[I_WGLU] + (size_t)l * 65536, 256, 256, (bf16_t*)(ws + WS_WGLU) + (size_t)l * 65536, nullptr, scr, r, lane);
        }
    }
    {
        float* ssq0 = (float*)(ws + WS_SSQP); bf16_t* XB = (bf16_t*)(ws + WS_XB);
        for (int mb = gw * 16; mb < T; mb += NGW * 16) {
            float keep = 0.f;
#pragma unroll 1
            for (int i = 0; i < 16; ++i) { const int m = mb + i;
                const f32x4* xr = (const f32x4*)(p.in[I_X] + (size_t)m * D) + lane; f32x4 v[4]; float s = 0.f;
#pragma unroll
                for (int j = 0; j < 4; ++j) { v[j] = xr[64 * j]; s += (v[j][0] * v[j][0] + v[j][1] * v[j][1]) + (v[j][2] * v[j][2] + v[j][3] * v[j][3]); }
                s = wave_sum(s); if (lane == i) keep = s;
                u32x2* o8 = (u32x2*)(XB + (size_t)m * D) + lane;
#pragma unroll
                for (int j = 0; j < 4; ++j) { u32x2 w; w.x = pk2(v[j][0], v[j][1]); w.y = pk2(v[j][2], v[j][3]); o8[64 * j] = w; } }
#pragma unroll 1
            for (int i = 0; i < 16; ++i) { const float v = __shfl(keep, i); if (lane < 16) ssq0[(size_t)(mb + i) * 16 + lane] = lane == 0 ? v : 0.f; }
        }
    }
    {
        float* LB = (float*)(ws + WS_LB);
        for (int c = gt; c < 256; c += NGT) {
            const float a0 = p.in[I_LBL][c], a1 = p.in[I_LBL][256 + c], a2 = p.in[I_LBL][512 + c], a3 = p.in[I_LBL][768 + c];
            const float mx = fmaxf(fmaxf(a0, a1), fmaxf(a2, a3));
            const float e0 = expf(a0 - mx), e1 = expf(a1 - mx), e2 = expf(a2 - mx), e3 = expf(a3 - mx); const float inv = 1.f / (e0 + e1 + e2 + e3);
            const float s1 = e1 * inv, s2 = e2 * inv, s3 = e3 * inv; const float hi = 1.0f - 1e-6f;
            LB[c] = 0.f; LB[256 + c] = fminf(fmaxf(s1, 0.f), hi); LB[512 + c] = fminf(fmaxf(s1 + s2, 0.f), hi); LB[768 + c] = fminf(fmaxf(s1 + s2 + s3, 0.f), hi);
        }
        float* BT = (float*)(ws + WS_BIAS);
        for (int i = gt; i < 3 * 4 * 132; i += NGT) {
            const int pt = i / (4 * 132), hd = (i / 132) % 4, dl = i % 132; const int dil = pt == 0 ? 1 : (pt == 1 ? 4 : 16);
            float v = 0.f;
            if (dl <= 128) { const int dist = dl * dil; int bk;
                if (dist < 16) bk = dist; else { bk = 16 + (int)(logf((float)dist / 16.0f) / 4.852030263919617f * 16.0f); if (bk > 31) bk = 31; }
                v = p.in[I_RB][bk * 4 + hd]; }
            BT[i] = v;
        }
    }
    {
        bf16_t* KT = (bf16_t*)(ws + WS_S5K); bf16_t* WS_ = (bf16_t*)(ws + WS_S5WS); bf16_t* WC = (bf16_t*)(ws + WS_S5WC);
        LAS float* ebr = scr; LAS float* ebi = scr + 64 * 17;
        for (int it = gw; it < NL * 16 * 64; it += NGW) {
            const int lg = it >> 6, d = it & 63;
            float lrdt, lidt, cr, ci; s5_params(p, lg, lane, lrdt, lidt, cr, ci);
            float er, ei; s5_pow(lrdt, lidt, d, er, ei);
            const float fr_ = er * cr - ei * ci, fi_ = er * ci + ei * cr;
            const float* br = p.in[I_BRE] + ((size_t)lg * 64 + lane) * 16; const float* bi = p.in[I_BIM] + ((size_t)lg * 64 + lane) * 16;
#pragma unroll
            for (int c = 0; c < 16; ++c) { const float b0 = br[c], b1 = bi[c]; ebr[lane * 17 + c] = fr_ * b0 - fi_ * b1; ebi[lane * 17 + c] = fr_ * b1 + fi_ * b0; }
            LDS_WAIT();
            const int co = lane & 15, cb = (lane >> 4) * 4;
            const float* crp = p.in[I_CRE] + ((size_t)lg * 16 + co) * 64; const float* cip = p.in[I_CIM] + ((size_t)lg * 16 + co) * 64;
            float a0 = 0.f, a1 = 0.f, a2 = 0.f, a3 = 0.f;
            for (int q = 0; q < 64; ++q) { const float c0 = crp[q], c1 = cip[q];
                a0 += c0 * ebr[q * 17 + cb + 0] - c1 * ebi[q * 17 + cb + 0]; a1 += c0 * ebr[q * 17 + cb + 1] - c1 * ebi[q * 17 + cb + 1];
                a2 += c0 * ebr[q * 17 + cb + 2] - c1 * ebi[q * 17 + cb + 2]; a3 += c0 * ebr[q * 17 + cb + 3] - c1 * ebi[q * 17 + cb + 3]; }
            u32x2 w; w.x = pk2(a0, a1); w.y = pk2(a2, a3);
            *(u32x2*)(KT + ((size_t)it * 16 + co) * 16 + cb) = w;
            LDS_WAIT();
        }
        for (int it = gw; it < NL * 16 * 16; it += NGW) {
            const int lg = it >> 4, s4 = it & 15;
            float lrdt, lidt, cr, ci; s5_params(p, lg, lane, lrdt, lidt, cr, ci);
            const float* br = p.in[I_BRE] + ((size_t)lg * 64 + lane) * 16; const float* bi = p.in[I_BIM] + ((size_t)lg * 64 + lane) * 16;
            float b0[16], b1[16];
#pragma unroll
            for (int c = 0; c < 16; ++c) { b0[c] = br[c]; b1[c] = bi[c]; }
#pragma unroll 1
            for (int sq = 0; sq < 4; ++sq) { const int s = s4 * 4 + sq;
                float er, ei; s5_pow(lrdt, lidt, 63 - s, er, ei);
                const float fr_ = er * cr - ei * ci, fi_ = er * ci + ei * cr;
                float vr[16], vi[16];
#pragma unroll
                for (int c = 0; c < 16; ++c) { vr[c] = fr_ * b0[c] - fi_ * b1[c]; vi[c] = fr_ * b1[c] + fi_ * b0[c]; }
                bf16_t* o0 = WS_ + ((size_t)lg * 128 + lane) * 1024 + s * 16; bf16_t* o1 = WS_ + ((size_t)lg * 128 + 64 + lane) * 1024 + s * 16;
                u32x4 w;
                w.x = pk2(vr[0], vr[1]); w.y = pk2(vr[2], vr[3]); w.z = pk2(vr[4], vr[5]); w.w = pk2(vr[6], vr[7]); *(u32x4*)o0 = w;
                w.x = pk2(vr[8], vr[9]); w.y = pk2(vr[10], vr[11]); w.z = pk2(vr[12], vr[13]); w.w = pk2(vr[14], vr[15]); *(u32x4*)(o0 + 8) = w;
                w.x = pk2(vi[0], vi[1]); w.y = pk2(vi[2], vi[3]); w.z = pk2(vi[4], vi[5]); w.w = pk2(vi[6], vi[7]); *(u32x4*)o1 = w;
                w.x = pk2(vi[8], vi[9]); w.y = pk2(vi[10], vi[11]); w.z = pk2(vi[12], vi[13]); w.w = pk2(vi[14], vi[15]); *(u32x4*)(o1 + 8) = w; }
        }
        for (int it = gw; it < NL * 16 * 64; it += NGW) {
            const int lg = it >> 6, tl = it & 63;
            float lrdt, lidt, cr, ci; s5_params(p, lg, lane, lrdt, lidt, cr, ci);
            float er, ei; s5_pow(lrdt, lidt, tl + 1, er, ei);
#pragma unroll 4
            for (int co = 0; co < 16; ++co) { const float c0 = p.in[I_CRE][((size_t)lg * 16 + co) * 64 + lane], c1 = p.in[I_CIM][((size_t)lg * 16 + co) * 64 + lane];
                bf16_t* o = WC + (((size_t)lg * 64 + tl) * 16 + co) * 128;
                o[lane] = (bf16_t)f2bf(c0 * er - c1 * ei); o[64 + lane] = (bf16_t)f2bf(-(c0 * ei + c1 * er)); }
        }
    }
}

template <bool OUT>
DI void hgrn_item(const Params& p, LAS unsigned char* lds, int l, int cg) {
    int tid_o = threadIdx.x; asm volatile("" : "+v"(tid_o));
    const int tid = tid_o, lane = tid & 63, wave = tid >> 6, hd = wave >> 1, half = wave & 1;
    const bf16_t* Z = (const bf16_t*)(p.ws + WS_Z);
    LAS bf16_t* B0 = (LAS bf16_t*)(lds + hd * 27648); LAS bf16_t* B1 = B0 + 64 * 72; LAS bf16_t* B2 = B1 + 64 * 72;
    LAS float* GM = (LAS float*)(lds + 114688) + hd * 64; LAS float* GL = GM + 256; LAS float* SSA = (LAS float*)(lds + 114688) + 512;
    bf16_t* SL = (bf16_t*)(p.ws + WS_SL); const bf16_t* SL2 = (const bf16_t*)(p.ws + WS_SL2); float* DEC = (float*)(p.ws + WS_DEC);
    const int item = cg * 4 + hd;
#ifdef FORCE_LB0
    const float lb = 0.f, oml = 1.f;
#else
    const float lb = ((const float*)(p.ws + WS_LB))[l * 256 + hd * 64 + lane], oml = 1.f - lb;
#endif
    const int srow = tid >> 5, shd = (tid >> 3) & 3, spc = tid & 7;
    const bf16_t* zsrc = Z + (size_t)(cg * 64 + srow) * DIN + shd * 64 + spc * 8;
    const int sdst = shd * 27648 + (srow * 72 + spc * 8) * 2;
    __syncthreads();
    { u32x4 wf[4], wi[4], wq[4];
#pragma unroll
      for (int sub = 0; sub < 4; ++sub) { wf[sub] = *(const u32x4*)(zsrc + (size_t)(16 * sub) * DIN + ZF); wi[sub] = *(const u32x4*)(zsrc + (size_t)(16 * sub) * DIN + ZI);
          if (OUT) wq[sub] = *(const u32x4*)(zsrc + (size_t)(16 * sub) * DIN + ZQ); }
#pragma unroll
      for (int sub = 0; sub < 4; ++sub) { *(LAS u32x4*)(lds + sdst + 9216 + sub * 16 * 144) = wf[sub]; *(LAS u32x4*)(lds + sdst + 18432 + sub * 16 * 144) = wi[sub];
          if (OUT) *(LAS u32x4*)(lds + sdst + sub * 16 * 144) = wq[sub]; } }
    __syncthreads();
    float g[32]; float run = 0.f;
#pragma unroll
    for (int j = 0; j < 32; ++j) { const float fz = bf2f(B1[(half * 32 + j) * 72 + lane]); const float sg = sigmoidf_(fz); const float f = lb + oml * sg;
        run += __logf(fmaxf(f, 1e-30f)); g[j] = run; }
    if (half == 0) GM[lane] = run;
    __syncthreads();
    const float gm = GM[lane];
    if (half) {
#pragma unroll
        for (int j = 0; j < 32; ++j) g[j] += gm; }
    const int c0 = lane & 31, h = lane >> 5;
    if constexpr (!OUT) {
        if (half) GL[lane] = run + gm;
        __syncthreads();
        const float gl = GL[lane];
        bf16_t kv[32], ivr[32];
#pragma unroll
        for (int j = 0; j < 32; ++j) { const int t = half * 32 + j; const float e = __expf(gl - g[j]); const float kj = oml * (1.f - sigmoidf_(bf2f(B1[t * 72 + lane])));
            kv[j] = (bf16_t)f2bf(kj * e); ivr[j] = B2[t * 72 + lane]; }
        __syncthreads();
#pragma unroll
        for (int j = 0; j < 32; ++j) { const int t = half * 32 + j; B1[lane * 72 + t] = kv[j]; B2[lane * 72 + t] = ivr[j]; }
        __syncthreads();
#pragma unroll
        for (int kt = 0; kt < 2; ++kt) { const f32x16 a = mma_lds<64>(B2 + 32 * half * 72, 72, B1 + 32 * kt * 72, 72, zero16(), lane);
#pragma unroll
            for (int i = 0; i < 16; ++i) SL[(size_t)item * 4096 + (32 * half + crow(i, h)) * 64 + 32 * kt + c0] = (bf16_t)f2bf(a[i]); }
        if (half == 0) DEC[item * 64 + lane] = __expf(gl);
    } else {
        if (half == 0) GL[lane] = __expf(gm);
        bf16_t ivr[32];
#pragma unroll
        for (int j = 0; j < 32; ++j) { const int t = half * 32 + j; const float q = bf2f(B0[t * 72 + lane]); const float kj = oml * (1.f - sigmoidf_(bf2f(B1[t * 72 + lane])));
            const float e1 = __expf(fminf(g[j] - gm, 80.f)), e2 = __expf(fminf(gm - g[j], 80.f));
            ivr[j] = B2[t * 72 + lane];
            B0[t * 72 + lane] = (bf16_t)f2bf(q * e1); B1[t * 72 + lane] = (bf16_t)f2bf(kj * e2); }
        __syncthreads();
#pragma unroll
        for (int j = 0; j < 32; ++j) B2[lane * 72 + half * 32 + j] = ivr[j];
        __syncthreads();
        f32x16 s0 = mma_lds<64>(B0 + 32 * half * 72, 72, B1, 72, zero16(), lane);
        f32x16 s1 = zero16(); if (half) s1 = mma_lds<64>(B0 + 32 * half * 72, 72, B1 + 32 * 72, 72, zero16(), lane);
        __syncthreads();
#pragma unroll
        for (int i = 0; i < 16; ++i) { const int row = 32 * half + crow(i, h);
            B1[row * 72 + c0] = (bf16_t)f2bf(c0 <= row ? s0[i] : 0.f); B1[row * 72 + 32 + c0] = (bf16_t)f2bf(32 + c0 <= row ? s1[i] : 0.f); }
        __syncthreads();
        f32x16 o0 = mma_lds<64>(B1 + 32 * half * 72, 72, B2, 72, zero16(), lane);
        f32x16 o1 = mma_lds<64>(B1 + 32 * half * 72, 72, B2 + 32 * 72, 72, zero16(), lane);
        __syncthreads();
        {
          u32x4 wsl[4], wg[4];
          const bf16_t* sp = SL2 + (size_t)item * 4096 + (32 * half) * 64;
#pragma unroll
          for (int e = 0; e < 4; ++e) { const int pc = lane + 64 * e; wsl[e] = *(const u32x4*)(sp + pc * 8); wg[e] = *(const u32x4*)(zsrc + (size_t)(16 * e) * DIN + ZG); }
#pragma unroll
          for (int e = 0; e < 4; ++e) { const int pc = lane + 64 * e, row = pc >> 3, k0 = (pc & 7) * 8; const LAS float* eg = GL + k0;
              u32x4 o; o.x = pk2(bflo(wsl[e].x) * eg[0], bfhi(wsl[e].x) * eg[1]); o.y = pk2(bflo(wsl[e].y) * eg[2], bfhi(wsl[e].y) * eg[3]);
              o.z = pk2(bflo(wsl[e].z) * eg[4], bfhi(wsl[e].z) * eg[5]); o.w = pk2(bflo(wsl[e].w) * eg[6], bfhi(wsl[e].w) * eg[7]);
              *(LAS u32x4*)(B2 + (32 * half + row) * 72 + k0) = o;
              *(LAS u32x4*)(lds + sdst + 9216 + e * 16 * 144) = wg[e]; } }
        __syncthreads();
        o0 = mma_lds<64>(B0 + 32 * half * 72, 72, B2, 72, o0, lane);
        o1 = mma_lds<64>(B0 + 32 * half * 72, 72, B2 + 32 * 72, 72, o1, lane);
        const float* ng = p.in[I_HNG] + l * 256 + hd * 64; const float ng0 = ng[c0], ng1 = ng[32 + c0];
#pragma unroll
        for (int i = 0; i < 16; ++i) { const int row = 32 * half + crow(i, h);
            const float ss = half_sum(o0[i] * o0[i] + o1[i] * o1[i]); const float rs = rsqrtf(ss * (1.0f / 64.0f) + EPS);
            const float g0 = bf2f(B1[row * 72 + c0]), g1 = bf2f(B1[row * 72 + 32 + c0]);
            const float v0 = o0[i] * rs * ng0 * g0 * sigmoidf_(g0), v1 = o1[i] * rs * ng1 * g1 * sigmoidf_(g1);
            o0[i] = v0; o1[i] = v1; const float s2 = half_sum(v0 * v0 + v1 * v1); if (c0 == 0) SSA[hd * 64 + row] = s2; }
        __syncthreads();
        bf16_t* Y = (bf16_t*)(p.ws + WS_YCAT);
#pragma unroll
        for (int i = 0; i < 16; ++i) { const int row = 32 * half + crow(i, h); const size_t tok = (size_t)cg * 64 + row;
            const float tot = (SSA[row] + SSA[64 + row]) + (SSA[128 + row] + SSA[192 + row]); const float r2 = rsqrtf(tot * (1.0f / 256.0f) + EPS);
            Y[tok * D + YA + hd * 64 + c0] = (bf16_t)f2bf(o0[i] * r2); Y[tok * D + YA + hd * 64 + 32 + c0] = (bf16_t)f2bf(o1[i] * r2); }
    }
}
DI void hgrn_scan_item(const Params& p, int hb) {
    int tid_o = threadIdx.x; asm volatile("" : "+v"(tid_o));
    const int e = hb * 512 + tid_o, bh = e >> 12, b = bh >> 2, hd = bh & 3, vk = e & 4095, k = vk & 63;
    const bf16_t* SL = (const bf16_t*)(p.ws + WS_SL); bf16_t* SL2 = (bf16_t*)(p.ws + WS_SL2); const float* DEC = (const float*)(p.ws + WS_DEC);
    float st = 0.f;
    for (int c8 = 0; c8 < 128; c8 += 16) { float tmp[16], dc[16];
#pragma unroll
        for (int u = 0; u < 16; ++u) { const int item = (b * 128 + c8 + u) * 4 + hd; tmp[u] = bf2f(SL[(size_t)item * 4096 + vk]); dc[u] = DEC[item * 64 + k]; }
#pragma unroll
        for (int u = 0; u < 16; ++u) { const int item = (b * 128 + c8 + u) * 4 + hd; SL2[(size_t)item * 4096 + vk] = (bf16_t)f2bf(st); st = dc[u] * st + tmp[u]; } }
}

DI void conv_item(const Params& p, LAS unsigned char* lds, int l, int ti) {
    int tid_o = threadIdx.x; asm volatile("" : "+v"(tid_o));
    const int tid = tid_o, lane = tid & 63, wave = tid >> 6, c = tid & 255, hf = tid >> 8, wv = wave & 3;
    LAS float* Hs = (LAS float*)lds; LAS float* ST = (LAS float*)(lds + 98304); LAS float* ST2 = ST + 512;
    const bf16_t* Z = (const bf16_t*)(p.ws + WS_Z); bf16_t* Y = (bf16_t*)(p.ws + WS_YCAT);
    const int tok0 = ti * 64, pos0 = (ti & 127) * 64;
    __syncthreads();
    for (int it0 = 0; it0 < 48; it0 += 8) { bf16_t vv[8], gg[8];
#pragma unroll
        for (int e = 0; e < 8; ++e) { const int row = 2 * (it0 + e) + hf, pos = pos0 - 30 + row; const bool ok = (row < 94) && (pos >= 0);
            const size_t tok = ok ? (size_t)(tok0 - 30 + row) : (size_t)tok0; vv[e] = Z[tok * DIN + ZBV + c]; gg[e] = Z[tok * DIN + ZBG + c]; }
#pragma unroll
        for (int e = 0; e < 8; ++e) { const int row = 2 * (it0 + e) + hf, pos = pos0 - 30 + row; const bool ok = (row < 94) && (pos >= 0);
            if (row < 94) Hs[row * 256 + c] = ok ? bf2f(vv[e]) * sigmoidf_(bf2f(gg[e])) : 0.f; } }
    __syncthreads();
    const float* cw = p.in[I_CW] + (size_t)l * 31 * 256 + c; float w[31];
#pragma unroll
    for (int jj = 0; jj < 31; ++jj) w[jj] = cw[jj * 256];
    const float cb = p.in[I_CB][l * 256 + c];
    const float lng = p.in[I_CLG][l * 256 + c], lnb = p.in[I_CLB][l * 256 + c];
#pragma unroll 1
    for (int ps = 0; ps < 2; ++ps) { const int tb = hf * 32 + ps * 16;
        float o[16];
        { float hr[46];
#pragma unroll
          for (int r = 0; r < 46; ++r) hr[r] = Hs[(tb + r) * 256 + c];
#pragma unroll
          for (int j = 0; j < 16; ++j) { float a = cb;
#pragma unroll
            for (int jj = 0; jj < 31; ++jj) a += w[jj] * hr[j + jj];
            o[j] = a; } }
#pragma unroll
        for (int j = 0; j < 16; ++j) { const float s1 = wave_sum(o[j]), s2 = wave_sum(o[j] * o[j]); if (lane == 0) { ST[((tb + j) * 4 + wv) * 2] = s1; ST[((tb + j) * 4 + wv) * 2 + 1] = s2; } }
        __syncthreads();
#pragma unroll
        for (int j = 0; j < 16; ++j) { const LAS float* q = ST + (tb + j) * 8; const float s1 = (q[0] + q[2]) + (q[4] + q[6]), s2 = (q[1] + q[3]) + (q[5] + q[7]);
            const float mu = s1 * (1.0f / 256.0f); const float var = fmaxf(s2 * (1.0f / 256.0f) - mu * mu, 0.f);
            const float y = (o[j] - mu) * rsqrtf(var + EPS) * lng + lnb; const float sv = y * sigmoidf_(y); o[j] = sv;
            const float s3 = wave_sum(sv * sv); if (lane == 0) ST2[(tb + j) * 4 + wv] = s3; }
        __syncthreads();
#pragma unroll
        for (int j = 0; j < 16; ++j) { const LAS float* q = ST2 + (tb + j) * 4; const float tot = (q[0] + q[1]) + (q[2] + q[3]); const float rs = rsqrtf(tot * (1.0f / 256.0f) + EPS);
            Y[(size_t)(tok0 + tb + j) * D + YB + c] = (bf16_t)f2bf(o[j] * rs); }
    }
}

DI bf16x8 ldg8(const bf16_t* p) { return *(const bf16x8*)p; }
DI void s5_local_item(const Params& p, int l, int bi) {
    int tid_o = threadIdx.x; asm volatile("" : "+v"(tid_o));
    const int lane = tid_o & 63, wi = bi * 8 + (tid_o >> 6);
    const int g = wi & 15, cb = (wi >> 4) & 15, pt = wi >> 8, c0 = lane & 31, h = lane >> 5;
    const bf16_t* ua = (const bf16_t*)(p.ws + WS_Z) + (size_t)((cb * 32 + c0) * 64) * DIN + ZCU + g * 16 + 8 * h;
    const bf16_t* wb = (const bf16_t*)(p.ws + WS_S5WS) + ((size_t)(l * 16 + g) * 128 + pt * 32 + c0) * 1024 + 8 * h;
    f32x16 acc = zero16();
#pragma unroll 8
    for (int s = 0; s < 64; ++s) acc = __builtin_amdgcn_mfma_f32_32x32x16_bf16(ldg8(ua + (size_t)s * DIN), ldg8(wb + s * 16), acc, 0, 0, 0);
    float* HL = (float*)(p.ws + WS_S5H);
#pragma unroll
    for (int i = 0; i < 16; ++i) HL[((size_t)(cb * 32 + crow(i, h)) * 16 + g) * 128 + pt * 32 + c0] = acc[i];
}
DI void s5_scan_item(const Params& p, int l, int sb) {
    int tid_o = threadIdx.x; asm volatile("" : "+v"(tid_o));
    const int e = sb * 512 + tid_o, b = e >> 10, g = (e >> 6) & 15, pp = e & 63;
    float lrdt, lidt, cr, ci; s5_params(p, l * 16 + g, pp, lrdt, lidt, cr, ci);
    float ar, ai; s5_pow(lrdt, lidt, 64, ar, ai);
    const float* HL = (const float*)(p.ws + WS_S5H); float* HO = (float*)(p.ws + WS_S5H2); float hr = 0.f, hi = 0.f;
    for (int c8 = 0; c8 < 128; c8 += 16) { float tr[16], ti[16];
#pragma unroll
        for (int u = 0; u < 16; ++u) { const size_t idx = ((size_t)(b * 128 + c8 + u) * 16 + g) * 128; tr[u] = HL[idx + pp]; ti[u] = HL[idx + 64 + pp]; }
#pragma unroll
        for (int u = 0; u < 16; ++u) { const size_t idx = ((size_t)(b * 128 + c8 + u) * 16 + g) * 128; HO[idx + pp] = hr; HO[idx + 64 + pp] = hi;
            const float nr = ar * hr - ai * hi + tr[u], ni = ar * hi + ai * hr + ti[u]; hr = nr; hi = ni; } }
}
DI void s5_out_item(const Params& p, LAS unsigned char* lds, int l, int bi) {
    int tid_o = threadIdx.x; asm volatile("" : "+v"(tid_o));
    const int tid = tid_o, lane = tid & 63, wave = tid >> 6;
    const int gh = bi & 1, cb = (bi >> 1) & 15, pr = bi >> 5, g = gh * 8 + wave, c0 = lane & 31, h = lane >> 5, lg = l * 16 + g;
    LAS bf16_t* OT = (LAS bf16_t*)lds;
    const bf16_t* Z = (const bf16_t*)(p.ws + WS_Z);
    const bf16_t* ua = Z + (size_t)((cb * 32 + c0) * 64) * DIN + ZCU + g * 16 + 8 * h;
    const bf16_t* kt = (const bf16_t*)(p.ws + WS_S5K) + (size_t)lg * 64 * 256;
    const float* ha = (const float*)(p.ws + WS_S5H2) + ((size_t)(cb * 32 + c0) * 16 + g) * 128 + 8 * h;
    const int co = c0 & 15; const float dsk = p.in[I_S5D][l * 256 + g * 16 + co];
    __syncthreads();
    for (int q = 0; q < 2; ++q) { const int jt = q ? 31 - pr : pr; const int tl = 2 * jt + (c0 >> 4);
        f32x16 acc = zero16();
        const bf16_t* wc = (const bf16_t*)(p.ws + WS_S5WC) + (((size_t)lg * 64 + tl) * 16 + co) * 128 + 8 * h;
        { f32x4 x0[8], x1[8]; bf16x8 wv[8];
#pragma unroll
          for (int ks = 0; ks < 8; ++ks) { x0[ks] = *(const f32x4*)(ha + ks * 16); x1[ks] = *(const f32x4*)(ha + ks * 16 + 4); wv[ks] = ldg8(wc + ks * 16); }
#pragma unroll
          for (int ks = 0; ks < 8; ++ks) { u32x4 w; w.x = pk2(x0[ks][0], x0[ks][1]); w.y = pk2(x0[ks][2], x0[ks][3]); w.z = pk2(x1[ks][0], x1[ks][1]); w.w = pk2(x1[ks][2], x1[ks][3]);
            acc = __builtin_amdgcn_mfma_f32_32x32x16_bf16(__builtin_bit_cast(bf16x8, w), wv[ks], acc, 0, 0, 0); } }
        const int ns = (2 * jt + 2 + 7) & ~7;
        for (int s0 = 0; s0 < ns; s0 += 8) { bf16x8 av[8], bv[8];
#pragma unroll
            for (int e = 0; e < 8; ++e) { const int s = s0 + e, d = tl - s, dc = d < 0 ? 0 : d;
                av[e] = ldg8(ua + (size_t)s * DIN); bv[e] = ldg8(kt + ((size_t)dc * 16 + co) * 16 + 8 * h); }
#pragma unroll
            for (int e = 0; e < 8; ++e) { const int d = tl - (s0 + e); bf16x8 b = bv[e]; if (d < 0) b = (bf16x8){0, 0, 0, 0, 0, 0, 0, 0};
                acc = __builtin_amdgcn_mfma_f32_32x32x16_bf16(av[e], b, acc, 0, 0, 0); } }
#pragma unroll
        for (int i = 0; i < 16; ++i) { const int m = crow(i, h); const size_t tok = (size_t)(cb * 32 + m) * 64 + tl; const float u = bf2f(Z[tok * DIN + ZCU + g * 16 + co]);
            const float y = acc[i] + dsk * u; const float ge = y * sigmoidf_(1.5957691216057308f * (y + 0.044715f * y * y * y));
            OT[(q * 64 + m * 2 + (c0 >> 4)) * 136 + wave * 16 + co] = (bf16_t)f2bf(ge); }
    }
    __syncthreads();
    { const int tau = tid >> 2, qq = tau >> 6, m = (tau >> 1) & 31, t2 = tau & 1, qt = tid & 3; const int jt = qq ? 31 - pr : pr;
      const size_t tok = (size_t)(cb * 32 + m) * 64 + 2 * jt + t2;
      const LAS u32x4* src = (const LAS u32x4*)(OT + tau * 136 + qt * 32); u32x4* dst = (u32x4*)((bf16_t*)(p.ws + WS_YPRE) + tok * 256 + gh * 128 + qt * 32);
#pragma unroll
      for (int e = 0; e < 4; ++e) dst[e] = src[e]; }
}

DI void attn_item(const Params& p, LAS unsigned char* lds, int l, int pt, int id) {
    int tid_o = threadIdx.x; asm volatile("" : "+v"(tid_o));
    const int tid = tid_o, lane = tid & 63, wave = tid >> 6;
    const int dil = pt == 0 ? 1 : (pt == 1 ? 4 : 16), nblk = 32 / dil;
    const int b = id >> 7, hd = (id >> 5) & 3, rn = id & 31, r = rn / nblk, n = rn % nblk;
    LAS bf16_t* Ks = (LAS bf16_t*)lds;
    LAS bf16_t* Vt = (LAS bf16_t*)(lds + 55296);
    LAS float* BT = (LAS float*)(lds + 55296 + 50176);
    const bf16_t* Z = (const bf16_t*)(p.ws + WS_Z);
    const bf16_t* OP = (const bf16_t*)(p.ws + (pt == 1 ? WS_O0 : WS_O1)); const float* LP = (const float*)(p.ws + (pt == 1 ? WS_LSE : WS_LSE1));
    bf16_t* ON = pt == 2 ? (bf16_t*)(p.ws + WS_Z) + ZOD : (bf16_t*)(p.ws + (pt == 0 ? WS_O0 : WS_O1)); const int onp = pt == 2 ? DIN : 256;
    float* LN = (float*)(p.ws + (pt == 0 ? WS_LSE : WS_LSE1));
    const size_t tokb = (size_t)b * SEQ;
    __syncthreads();
    if (tid < 132) BT[tid] = ((const float*)(p.ws + WS_BIAS))[(pt * 4 + hd) * 132 + tid];
    { const float* kg = p.in[I_KG] + l * 64 + (tid & 7) * 8; float kgv[8];
#pragma unroll
      for (int e = 0; e < 8; ++e) kgv[e] = kg[e];
      u32x4 kwv[6], vwv[6];
#pragma unroll
      for (int it = 0; it < 6; ++it) { const int idx = tid + 512 * it, row = idx >> 3, c = idx & 7, si = n * 256 - 128 + row;
        const size_t tok = tokb + (size_t)(si < 0 ? 0 : si) * dil + r;
        kwv[it] = *(const u32x4*)(Z + tok * DIN + ZDK + hd * 64 + c * 8); vwv[it] = *(const u32x4*)(Z + tok * DIN + ZDV + hd * 64 + c * 8); }
#pragma unroll
      for (int it = 0; it < 6; ++it) { const int idx = tid + 512 * it, row = idx >> 3, c = idx & 7, si = n * 256 - 128 + row;
        u32x4 kw = kwv[it], vw = vwv[it];
        if (si < 0) { kw = (u32x4){0u, 0u, 0u, 0u}; vw = (u32x4){0u, 0u, 0u, 0u}; }
        float kf[8]; kf[0] = bflo(kw.x); kf[1] = bfhi(kw.x); kf[2] = bflo(kw.y); kf[3] = bfhi(kw.y); kf[4] = bflo(kw.z); kf[5] = bfhi(kw.z); kf[6] = bflo(kw.w); kf[7] = bfhi(kw.w);
        float ss = 0.f;
#pragma unroll
        for (int e = 0; e < 8; ++e) ss += kf[e] * kf[e];
        ss += __shfl_xor(ss, 1); ss += __shfl_xor(ss, 2); ss += __shfl_xor(ss, 4);
        const float rs = rsqrtf(ss * (1.0f / 64.0f) + EPS);
        u32x4 o; o.x = pk2(kf[0] * rs * kgv[0], kf[1] * rs * kgv[1]); o.y = pk2(kf[2] * rs * kgv[2], kf[3] * rs * kgv[3]); o.z = pk2(kf[4] * rs * kgv[4], kf[5] * rs * kgv[5]); o.w = pk2(kf[6] * rs * kgv[6], kf[7] * rs * kgv[7]);
        *(LAS u32x4*)(Ks + row * 72 + c * 8) = o;
        LAS bf16_t* vp = Vt + (c * 8) * 392 + row;
        vp[0 * 392] = (bf16_t)(vw.x & 0xffffu); vp[1 * 392] = (bf16_t)(vw.x >> 16); vp[2 * 392] = (bf16_t)(vw.y & 0xffffu); vp[3 * 392] = (bf16_t)(vw.y >> 16);
        vp[4 * 392] = (bf16_t)(vw.z & 0xffffu); vp[5 * 392] = (bf16_t)(vw.z >> 16); vp[6 * 392] = (bf16_t)(vw.w & 0xffffu); vp[7 * 392] = (bf16_t)(vw.w >> 16); } }
    __syncthreads();
    const int c0 = lane & 31, h = lane >> 5;
    const int qi = 32 * wave + c0; const size_t tokq = tokb + (size_t)(n * 256 + qi) * dil + r;
    bf16x8 qf[4];
    { float qv[4][8]; float ss = 0.f;
#pragma unroll
      for (int ks = 0; ks < 4; ++ks) { const u32x4 w = *(const u32x4*)(Z + tokq * DIN + ZDQ + hd * 64 + ks * 16 + 8 * h);
        qv[ks][0] = bflo(w.x); qv[ks][1] = bfhi(w.x); qv[ks][2] = bflo(w.y); qv[ks][3] = bfhi(w.y); qv[ks][4] = bflo(w.z); qv[ks][5] = bfhi(w.z); qv[ks][6] = bflo(w.w); qv[ks][7] = bfhi(w.w);
#pragma unroll
        for (int e = 0; e < 8; ++e) ss += qv[ks][e] * qv[ks][e]; }
      ss += __shfl_xor(ss, 32);
      const float rs = rsqrtf(ss * (1.0f / 64.0f) + EPS) * 0.125f;
#pragma unroll
      for (int ks = 0; ks < 4; ++ks) { const float* qg = p.in[I_QG] + l * 64 + ks * 16 + 8 * h; const f32x4 g0 = *(const f32x4*)qg, g1 = *(const f32x4*)(qg + 4);
        u32x4 w; w.x = pk2(qv[ks][0] * rs * g0[0], qv[ks][1] * rs * g0[1]); w.y = pk2(qv[ks][2] * rs * g0[2], qv[ks][3] * rs * g0[3]);
        w.z = pk2(qv[ks][4] * rs * g1[0], qv[ks][5] * rs * g1[1]); w.w = pk2(qv[ks][6] * rs * g1[2], qv[ks][7] * rs * g1[3]);
        qf[ks] = __builtin_bit_cast(bf16x8, w); } }
    f32x16 acc[5];
#pragma unroll
    for (int c = 0; c < 5; ++c) { acc[c] = zero16(); const LAS bf16_t* kb = Ks + (32 * wave + 32 * c + c0) * 72 + 8 * h;
#pragma unroll
        for (int ks = 0; ks < 4; ++ks) acc[c] = __builtin_amdgcn_mfma_f32_32x32x16_bf16(*(const LAS bf16x8*)(kb + ks * 16), qf[ks], acc[c], 0, 0, 0); }
    float mx = -1e30f;
#pragma unroll
    for (int c = 0; c < 5; ++c)
#pragma unroll
        for (int i = 0; i < 16; ++i) { const int kr = crow(i, h); const int delta = 128 + c0 - 32 * c - kr; const int jl = 32 * wave + 32 * c + kr;
            const bool valid = (delta >= 0) && (delta <= 128) && (n * 256 - 128 + jl >= 0);
            const int dcl = delta < 0 ? 0 : (delta > 128 ? 128 : delta);
            const float lgt = valid ? acc[c][i] + BT[dcl] : -1e30f; acc[c][i] = lgt; mx = fmaxf(mx, lgt); }
    mx = fmaxf(mx, __shfl_xor(mx, 32));
    float mprev = 0.f, mnew = mx;
    if (pt > 0) { mprev = LP[tokq * 4 + hd]; mnew = fmaxf(mx, mprev); }
    float lsum = 0.f;
#pragma unroll
    for (int c = 0; c < 5; ++c)
#pragma unroll
        for (int i = 0; i < 16; ++i) { const float pv = __expf(acc[c][i] - mnew); acc[c][i] = pv; lsum += pv; }
    lsum += __shfl_xor(lsum, 32);
    f32x16 o[2]; o[0] = zero16(); o[1] = zero16();
#pragma unroll
    for (int c = 0; c < 5; ++c)
#pragma unroll
        for (int s = 0; s < 2; ++s) { u32x4 pw; pw.x = pk2(acc[c][8 * s + 0], acc[c][8 * s + 1]); pw.y = pk2(acc[c][8 * s + 2], acc[c][8 * s + 3]); pw.z = pk2(acc[c][8 * s + 4], acc[c][8 * s + 5]); pw.w = pk2(acc[c][8 * s + 6], acc[c][8 * s + 7]);
            const bf16x8 pf = __builtin_bit_cast(bf16x8, pw);
#pragma unroll
            for (int vt = 0; vt < 2; ++vt) { const LAS bf16_t* va = Vt + (32 * vt + c0) * 392 + 32 * wave + 32 * c + 16 * s + 4 * h;
                const s16x4 lo = *(const LAS s16x4*)va, hi = *(const LAS s16x4*)(va + 8);
                const bf16x8 vf = __builtin_shufflevector(lo, hi, 0, 1, 2, 3, 4, 5, 6, 7);
                o[vt] = __builtin_amdgcn_mfma_f32_32x32x16_bf16(vf, pf, o[vt], 0, 0, 0); } }
    float sp = 0.f; if (pt > 0) sp = __expf(mprev - mnew);
    const float ltot = lsum + sp, inv = 1.0f / ltot;
#pragma unroll
    for (int vt = 0; vt < 2; ++vt)
#pragma unroll
        for (int g4 = 0; g4 < 4; ++g4) { const int ch = hd * 64 + 32 * vt + 8 * g4 + 4 * h; bf16_t* yo = ON + tokq * onp + ch;
            float v0 = o[vt][4 * g4 + 0], v1 = o[vt][4 * g4 + 1], v2 = o[vt][4 * g4 + 2], v3 = o[vt][4 * g4 + 3];
            if (pt > 0) { const u32x2 w = *(const u32x2*)(OP + tokq * 256 + ch); v0 += sp * bflo(w.x); v1 += sp * bfhi(w.x); v2 += sp * bflo(w.y); v3 += sp * bfhi(w.y); }
            u32x2 w; w.x = pk2(v0 * inv, v1 * inv); w.y = pk2(v2 * inv, v3 * inv); *(u32x2*)yo = w; }
    if (h == 0 && pt < 2) __hip_atomic_store(LN + tokq * 4 + hd, mnew + __logf(ltot), __ATOMIC_RELAXED, __HIP_MEMORY_SCOPE_AGENT);
}

#define RLX_AGENT __ATOMIC_RELAXED, __HIP_MEMORY_SCOPE_AGENT
#define XB_TMO      128
#define XB_XCNT(j)  (256  + 64 * (j))
#define XB_XSUB(j)  (1280 + 64 * (j))
#define XB_XGEN(j)  (2304 + 64 * (j))
#define XB_TOP      3328
#define XB_TOPGEN   3392
#define XCD_BAR_WORDS 3456
#define XB_SPIN_CAP (1u << 18)

__device__ __forceinline__ unsigned xb_ld(unsigned* p)              { return __hip_atomic_load(p, __ATOMIC_RELAXED, __HIP_MEMORY_SCOPE_AGENT); }
__device__ __forceinline__ unsigned xb_add(unsigned* p, unsigned v) { return __hip_atomic_fetch_add(p, v, __ATOMIC_RELAXED, __HIP_MEMORY_SCOPE_AGENT); }
__device__ __forceinline__ unsigned xb_xcc_id() { return (unsigned)__builtin_amdgcn_s_getreg((3 << 11) | 20) & 0xFu; }
#define XB_SPIN(cond, bar) do { unsigned _sp = 0; while (cond) { __builtin_amdgcn_s_sleep(1); \
    if ((++_sp & 255u) == 0u) { if (xb_ld(&(bar)[XB_TMO])) break; if (_sp > XB_SPIN_CAP) { atomicAdd(&(bar)[XB_TMO], 1u); break; } } } } while (0)

struct XcdBarrier {
    unsigned* bar; unsigned x;
    volatile LAS unsigned* st;
};

__device__ __forceinline__ XcdBarrier xcd_barrier_post(unsigned* bar, volatile LAS unsigned* st) {
    XcdBarrier b; b.bar = bar; b.x = xb_xcc_id(); b.st = st;
    if (threadIdx.x == 0) (void)xb_add(&bar[XB_XCNT(b.x)], 1u);
    return b;
}
__device__ __forceinline__ void xcd_barrier_complete(unsigned* bar, unsigned x, unsigned& nloc, unsigned& nx) {
    const unsigned G = gridDim.x * gridDim.y * gridDim.z;
    unsigned sum, cnt, mine, sp = 0u;
    for (;;) {
        sum = 0u; cnt = 0u; mine = 0u;
#pragma unroll
        for (unsigned j = 0; j < 16; ++j) { const unsigned c = xb_ld(&bar[XB_XCNT(j)]); sum += c; cnt += (c > 0u) ? 1u : 0u; mine = (j == x) ? c : mine; }
        if (sum == G) break;
        __builtin_amdgcn_s_sleep(1);
        if ((++sp & 255u) == 0u) { if (xb_ld(&bar[XB_TMO])) break; if (sp > XB_SPIN_CAP) { atomicAdd(&bar[XB_TMO], 1u); break; } }
    }
    nloc = mine > 0u ? mine : 1u; nx = cnt > 0u ? cnt : 1u;
}

__device__ __forceinline__ void xcd_barrier(const XcdBarrier& b) {
    asm volatile("s_waitcnt vmcnt(0)" ::: "memory");
    __syncthreads();
    if (threadIdx.x == 0) {
        unsigned* bar = b.bar;
        __builtin_amdgcn_s_waitcnt(0);
        unsigned nloc = b.st[0], nx = b.st[1];
        if (nloc == 0u) { xcd_barrier_complete(bar, b.x, nloc, nx); b.st[0] = nloc; b.st[1] = nx; }
        const unsigned old = xb_add(&bar[XB_XSUB(b.x)], 1u);
        const unsigned gen = old / nloc;
        if (old + 1u == (gen + 1u) * nloc) {
            __builtin_amdgcn_fence(__ATOMIC_RELEASE, "agent");
            asm volatile("s_waitcnt vmcnt(0)" ::: "memory");
            const unsigned og = xb_add(&bar[XB_TOP], 1u);
            const unsigned tg = og / nx;
            if (og + 1u == (tg + 1u) * nx) xb_add(&bar[XB_TOPGEN], 1u);
            else XB_SPIN(xb_ld(&bar[XB_TOPGEN]) == tg, bar);
            __builtin_amdgcn_fence(__ATOMIC_ACQUIRE, "agent");
            xb_add(&bar[XB_XGEN(b.x)], 1u);
            asm volatile("s_waitcnt vmcnt(0)" ::: "memory");
        } else {
            XB_SPIN(xb_ld(&bar[XB_XGEN(b.x)]) == gen, bar);
            __builtin_amdgcn_fence(__ATOMIC_ACQUIRE, "agent");
            asm volatile("s_waitcnt vmcnt(0)" ::: "memory");
        }
    }
    __syncthreads();
}

#ifndef REP_A
#define REP_A 0
#endif
#ifndef REP_B
#define REP_B 0
#endif
#ifndef REP_C
#define REP_C 0
#endif
#ifndef REP_D
#define REP_D 0
#endif
#ifndef MIX_A
#define MIX_A 1
#endif
#ifndef MIX_B
#define MIX_B 1
#endif
#ifndef MIX_C
#define MIX_C 1
#endif
#ifndef MIX_D
#define MIX_D 1
#endif
__global__ void __launch_bounds__(512, 2) hybrid_fwd(Params p) {
    extern __shared__ __attribute__((aligned(16))) unsigned char lds_raw[];
    LAS unsigned char* lds = (LAS unsigned char*)lds_raw;
    cg::grid_group grid = cg::this_grid();
    { volatile LAS unsigned* st0 = (volatile LAS unsigned*)(lds + LDS_BYTES - 64); if (threadIdx.x < 2) st0[threadIdx.x] = 0u; }
    __syncthreads();
    XcdBarrier xbar = xcd_barrier_post((unsigned*)(p.ws + WS_BAR), (volatile LAS unsigned*)(lds + LDS_BYTES - 64));
    const int G = gridDim.x, bid = blockIdx.x;
    unsigned char* ws = p.ws;
    bf16_t* XB = (bf16_t*)(ws + WS_XB); bf16_t* Zb = (bf16_t*)(ws + WS_Z); bf16_t* YC_ = (bf16_t*)(ws + WS_YCAT); bf16_t* HM = (bf16_t*)(ws + WS_HM);
    float* SSQP = (float*)(ws + WS_SSQP);

#define GRID_SYNC_() do { asm volatile("s_waitcnt vmcnt(0) lgkmcnt(0)" ::: "memory"); grid.sync(); if (threadIdx.x < 64) { __builtin_amdgcn_fence(__ATOMIC_ACQUIRE, "agent"); asm volatile("s_waitcnt vmcnt(0)" ::: "memory"); } __syncthreads(); } while (0)
#ifdef REP_SYNC
#define GRID_SYNC() do { xcd_barrier(xbar); xcd_barrier(xbar); } while (0)
#else
#define GRID_SYNC() xcd_barrier(xbar)
#endif
    prologue(p, lds, G);
#ifdef REP_PRO
    GRID_SYNC_(); prologue(p, lds, G);
#endif
#ifdef NANFILL
    { u32x4* q = (u32x4*)(ws + WS_S5H); const size_t n16 = (WS_END - WS_S5H) / 16; const u32x4 nanv = (u32x4){0xffffffffu, 0xffffffffu, 0xffffffffu, 0xffffffffu};
      for (size_t i = (size_t)bid * 512 + threadIdx.x; i < n16; i += (size_t)G * 512) q[i] = nanv;
      u32x4* q2 = (u32x4*)(ws + WS_LSE); const size_t m16 = (WS_S5K - WS_LSE) / 16;
      for (size_t i = (size_t)bid * 512 + threadIdx.x; i < m16; i += (size_t)G * 512) q2[i] = nanv; }
#endif
    GRID_SYNC_();

#ifndef NL_RUN
#define NL_RUN NL
#endif
#ifndef DUMP_LAYER
#define DUMP_LAYER 0
#endif
    for (int lrun = 0; lrun < NL_RUN; ++lrun) {
#ifdef SAME_LAYER
        const int l = 0; const bool firstl = (lrun == 0), lastl = (lrun == NL_RUN - 1);
#else
        const int l = lrun; const bool firstl = (lrun == 0), lastl = (lrun == NL_RUN - 1);
#endif
        { pg8::Gemm g{XB, (const bf16_t*)(ws + WS_WIN) + (size_t)l * D * DIN, T, DIN, D, D}; pg8::StaticOrder S; S.init(T, DIN, G, bid);
          pg8::EpiScale E{Zb, DIN, SSQP, 0};
          pg8::gemm_phase<pg8::EpiScale, pg8::StaticOrder, true, true>(lds, g, S, E);
#ifdef REPEAT_GEMM
          GRID_SYNC(); pg8::gemm_phase<pg8::EpiScale, pg8::StaticOrder, true, true>(lds, g, S, E);
#endif
        }
        GRID_SYNC();
#ifndef SKIP_MIX
        if (!(MIX_A && MIX_B && MIX_C && MIX_D)) { int tq = threadIdx.x; asm volatile("" : "+v"(tq));
          for (int m = bid * 8 + (tq >> 6); m < T; m += G * 8) { u32x2* yp = (u32x2*)(YC_ + (size_t)m * D) + (tq & 63); const u32x2 z2 = (u32x2){0u, 0u};
              if (!MIX_A) yp[0] = z2; if (!MIX_B) yp[64] = z2; if (!MIX_C) yp[128] = z2; if (!MIX_D) yp[192] = z2; } }
#ifndef MIX_REPEAT
#define MIX_REPEAT 1
#endif
        for (int rep = 0; rep < MIX_REPEAT; ++rep) {
        for (int it = bid; it < 1664; it += G) {
            if (it < 512) { if (MIX_A) { hgrn_item<false>(p, lds, l, it); if (REP_A) hgrn_item<false>(p, lds, l, it); } }
            else if (it < 1024) { if (MIX_B) { conv_item(p, lds, l, it - 512); if (REP_B) conv_item(p, lds, l, it - 512); } }
            else if (it < 1152) { if (MIX_C) { s5_local_item(p, l, it - 1024); if (REP_C) s5_local_item(p, l, it - 1024); } }
            else { if (MIX_D) { attn_item(p, lds, l, 0, it - 1152); if (REP_D) attn_item(p, lds, l, 0, it - 1152); } }
        }
        GRID_SYNC();
        for (int it = bid; it < 648; it += G) {
            if (it < 128) { if (MIX_A) hgrn_scan_item(p, it); }
            else if (it < 136) { if (MIX_C) s5_scan_item(p, l, it - 128); }
            else { if (MIX_D) { attn_item(p, lds, l, 1, it - 136); if (REP_D) attn_item(p, lds, l, 1, it - 136); } }
        }
        GRID_SYNC();
#ifdef REP_P3
        for (int it = bid; it < 648; it += G) {
            if (it < 128) { if (MIX_A) hgrn_scan_item(p, it); }
            else if (it < 136) { if (MIX_C) s5_scan_item(p, l, it - 128); }
            else { if (MIX_D) { attn_item(p, lds, l, 1, it - 136); if (REP_D) attn_item(p, lds, l, 1, it - 136); } }
        }
        GRID_SYNC();
#endif
        for (int it = bid; it < 1536; it += G) {
            if (it < 512) { if (MIX_A) { hgrn_item<true>(p, lds, l, it); if (REP_A) hgrn_item<true>(p, lds, l, it); } }
            else if (it < 1024) { if (MIX_C) { s5_out_item(p, lds, l, it - 512); if (REP_C) s5_out_item(p, lds, l, it - 512); } }
            else { if (MIX_D) { attn_item(p, lds, l, 2, it - 1024); if (REP_D) attn_item(p, lds, l, 2, it - 1024); } }
        }
        GRID_SYNC();
        }
#ifndef NO_GLU
        { pg8::Gemm g{(const bf16_t*)(ws + WS_YPRE), (const bf16_t*)(ws + WS_WGLU) + (size_t)l * 65536, T, 256, 256, 256}; pg8::StaticOrder S; S.init(T, 256, G, bid);
          pg8::EpiGlu E{(const bf16_t*)(ws + WS_YPRE), 256, YC_ + YC};
          pg8::gemm_phase<pg8::EpiGlu, pg8::StaticOrder, false, true>(lds, g, S, E); }
#endif
        { int tq = threadIdx.x; asm volatile("" : "+v"(tq)); const int lane = tq & 63; const int gw = bid * 8 + (tq >> 6), NGW = G * 8;
          for (int m = gw; m < T; m += NGW) { u32x2* yp = (u32x2*)(YC_ + (size_t)m * D + YD) + lane; const u32x2 w = *((const u32x2*)(Zb + (size_t)m * DIN + ZOD) + lane);
              const float a0 = bflo(w.x), a1 = bfhi(w.x), a2 = bflo(w.y), a3 = bfhi(w.y);
              const float ss = wave_sum((a0 * a0 + a1 * a1) + (a2 * a2 + a3 * a3)); const float rs = rsqrtf(ss * (1.0f / 256.0f) + EPS);
              u32x2 o; o.x = pk2(a0 * rs, a1 * rs); o.y = pk2(a2 * rs, a3 * rs); *yp = o; } }
        GRID_SYNC();
#endif
#ifdef REP_P5
#ifndef NO_GLU
        { pg8::Gemm g{(const bf16_t*)(ws + WS_YPRE), (const bf16_t*)(ws + WS_WGLU) + (size_t)l * 65536, T, 256, 256, 256}; pg8::StaticOrder S; S.init(T, 256, G, bid);
          pg8::EpiGlu E{(const bf16_t*)(ws + WS_YPRE), 256, YC_ + YC};
          pg8::gemm_phase<pg8::EpiGlu, pg8::StaticOrder, false, true>(lds, g, S, E); }
#endif
        { int tq = threadIdx.x; asm volatile("" : "+v"(tq)); const int lane = tq & 63; const int gw = bid * 8 + (tq >> 6), NGW = G * 8;
          for (int m = gw; m < T; m += NGW) { u32x2* yp = (u32x2*)(YC_ + (size_t)m * D + YD) + lane; const u32x2 w = *((const u32x2*)(Zb + (size_t)m * DIN + ZOD) + lane);
              const float a0 = bflo(w.x), a1 = bfhi(w.x), a2 = bflo(w.y), a3 = bfhi(w.y);
              const float ss = wave_sum((a0 * a0 + a1 * a1) + (a2 * a2 + a3 * a3)); const float rs = rsqrtf(ss * (1.0f / 256.0f) + EPS);
              u32x2 o; o.x = pk2(a0 * rs, a1 * rs); o.y = pk2(a2 * rs, a3 * rs); *yp = o; } }
        GRID_SYNC();
#endif
#ifdef DUMP_SLICE
        if (lrun == DUMP_LAYER) { int tq = threadIdx.x; asm volatile("" : "+v"(tq));
          for (int m = bid * 8 + (tq >> 6); m < T; m += G * 8) { const int ln = tq & 63;
              for (int j = 0; j < 4; ++j) { const int col = j * 256 + ln * 4; const u32x2 w = *(const u32x2*)(YC_ + (size_t)m * D + col);
                  f32x4 o = (f32x4){0.f, 0.f, 0.f, 0.f}; if (j == DUMP_SLICE) o = (f32x4){bflo(w.x), bfhi(w.x), bflo(w.y), bfhi(w.y)};
                  *(f32x4*)(p.out + (size_t)m * D + col) = o; } }
          break; }
#endif
#ifdef SKIP_MIX
        { pg8::Gemm g{Zb, (const bf16_t*)(ws + WS_WOUT) + (size_t)l * D * D, T, D, D, DIN}; pg8::StaticOrder S; S.init(T, D, G, bid);
#else
        { pg8::Gemm g{YC_, (const bf16_t*)(ws + WS_WOUT) + (size_t)l * D * D, T, D, D, D}; pg8::StaticOrder S; S.init(T, D, G, bid);
#endif
          pg8::EpiRes E{firstl ? p.in[I_X] : p.out, p.out, XB, SSQP + (size_t)T * 16};
          pg8::gemm_phase<pg8::EpiRes, pg8::StaticOrder, true, true>(lds, g, S, E); }
        GRID_SYNC();
        { pg8::Gemm g{XB, (const bf16_t*)(ws + WS_WUP) + (size_t)l * D * FF, T, FF, D, D}; pg8::StaticOrder S; S.init(T, FF, G, bid);
          pg8::EpiScale E{HM, FF, SSQP + (size_t)T * 16, 1};
          pg8::gemm_phase<pg8::EpiScale, pg8::StaticOrder, true, true>(lds, g, S, E);
#ifdef REPEAT_GEMM
          GRID_SYNC(); pg8::gemm_phase<pg8::EpiScale, pg8::StaticOrder, true, true>(lds, g, S, E);
#endif
        }
        GRID_SYNC();
        { pg8::Gemm g{HM, (const bf16_t*)(ws + WS_WDN) + (size_t)l * D * FF, T, D, FF, FF}; pg8::StaticOrder S; S.init(T, D, G, bid);
          pg8::EpiRes E{p.out, p.out, XB, !lastl ? SSQP : nullptr};
          pg8::gemm_phase<pg8::EpiRes, pg8::StaticOrder, true, true>(lds, g, S, E); }
        if (!lastl) GRID_SYNC();
    }
}

extern "C" void kernel_launch(void* const* d_in, const int* in_sizes, int n_in, void* d_out, int out_size, void* d_ws, size_t ws_size, hipStream_t stream) {
    static int grid = 0;
    if (grid == 0) {
        if (n_in != 26 || out_size != T * D || ws_size < WS_END) { fprintf(stderr, "kernel_launch: unexpected shapes (n_in %d, out %d, ws %zu); nothing launched\n", n_in, out_size, ws_size); grid = -1; return; }
        int dev = 0, cus = 0, per_cu = 0;
        (void)hipGetDevice(&dev); (void)hipDeviceGetAttribute(&cus, hipDeviceAttributeMultiprocessorCount, dev);
        if (hipFuncSetAttribute((const void*)hybrid_fwd, hipFuncAttributeMaxDynamicSharedMemorySize, LDS_BYTES) != hipSuccess) { fprintf(stderr, "kernel_launch: hipFuncSetAttribute failed\n"); grid = -1; return; }
        if (hipOccupancyMaxActiveBlocksPerMultiprocessor(&per_cu, (const void*)hybrid_fwd, 512, LDS_BYTES) != hipSuccess || per_cu < 1) { fprintf(stderr, "kernel_launch: occupancy query gave %d\n", per_cu); per_cu = 1; }
        (void)hipGetLastError();
        if (cus <= 0) cus = 256;
        grid = cus * per_cu;
    }
    if (grid < 0) return;
    if (hipMemsetAsync((char*)d_ws + WS_BAR, 0, XCD_BAR_WORDS * 4, stream) != hipSuccess) { fprintf(stderr, "kernel_launch: hipMemsetAsync of the barrier words failed\n"); return; }
    Params a{};
    for (int i = 0; i < 26; ++i) a.in[i] = (const float*)d_in[i];
    a.out = (float*)d_out; a.ws = (unsigned char*)d_ws;
    void* args[] = {&a};
    hipError_t e = hipLaunchCooperativeKernel((const void*)hybrid_fwd, dim3(grid), dim3(512), args, LDS_BYTES, stream);
    if (e != hipSuccess) fprintf(stderr, "cooperative launch failed: %s (grid %d)\n", hipGetErrorString(e), grid);
}
```

```cpp
#include <hip/hip_runtime.h>
#include <hip/hip_cooperative_groups.h>
#include <cstdio>
#include <cstdint>
namespace cg = cooperative_groups;

#define DI __device__ __forceinline__
#define LAS __attribute__((address_space(3)))
typedef unsigned short bf16_t;
typedef short bf16x8 __attribute__((ext_vector_type(8)));
typedef short s16x4 __attribute__((ext_vector_type(4)));
typedef float f32x4 __attribute__((ext_vector_type(4)));
typedef float f32x16 __attribute__((ext_vector_type(16)));
typedef unsigned u32x4 __attribute__((ext_vector_type(4)));
typedef unsigned u32x2 __attribute__((ext_vector_type(2)));

constexpr int NB = 4, SEQ = 8192, T = NB * SEQ, D = 1024, DIN = 2560, FF = 4096, NL = 4;
constexpr int ZQ = 0, ZF = 256, ZI = 512, ZG = 768, ZBV = 1024, ZBG = 1280, ZCU = 1536, ZDQ = 1792, ZDK = 2048, ZDV = 2304;
constexpr int YA = 0, YB = 256, YC = 512, YD = 768;
constexpr int ZOD = ZBG;
constexpr float EPS = 1e-6f;
constexpr size_t MiB = 1u << 20;
constexpr size_t WS_WIN = 0, WS_WOUT = 20 * MiB, WS_WUP = 28 * MiB, WS_WDN = 60 * MiB, WS_WGLU = 92 * MiB;
constexpr size_t WS_LB = 93 * MiB;
constexpr size_t WS_BIAS = WS_LB + 4096;
constexpr size_t WS_BAR = WS_LB + 32768;
constexpr size_t WS_SSQ = WS_LB + 65536;
constexpr size_t WS_LSE = WS_SSQ + 8 * (size_t)T * 4;
constexpr size_t WS_DEC = WS_LSE + (size_t)T * 16;
constexpr size_t WS_LSE1 = WS_DEC + 2048 * 64 * 4;
constexpr size_t WS_S5K = 96 * MiB;
constexpr size_t WS_S5WS = 98 * MiB;
constexpr size_t WS_S5WC = 114 * MiB;
constexpr size_t WS_XB = 130 * MiB;
constexpr size_t WS_S5H = 194 * MiB;
constexpr size_t WS_HM = 198 * MiB;
constexpr size_t WS_Z = 198 * MiB;
constexpr size_t WS_YCAT = 358 * MiB;
constexpr size_t WS_SL = 422 * MiB, WS_SL2 = 438 * MiB;
constexpr size_t WS_S5H2 = 454 * MiB;
constexpr size_t WS_O0 = 458 * MiB, WS_O1 = 474 * MiB;
constexpr size_t WS_YPRE = 490 * MiB;
constexpr size_t WS_SSQP = 506 * MiB;
constexpr size_t WS_END = 510 * MiB;
static_assert(WS_LSE1 + (size_t)T * 16 <= WS_S5K, "misc region");

constexpr int LDS_BYTES = 147456;

DI unsigned f2bf(float f) { unsigned u = __builtin_bit_cast(unsigned, f); return (u + 0x7fffu + ((u >> 16) & 1u)) >> 16; }
typedef float f32x2_t __attribute__((ext_vector_type(2))); typedef __bf16 bf16x2_t __attribute__((ext_vector_type(2)));
DI unsigned pk2(float lo, float hi) { const f32x2_t v = {lo, hi}; const bf16x2_t b = __builtin_convertvector(v, bf16x2_t); return __builtin_bit_cast(unsigned, b); }
DI float bf2f(bf16_t v) { return __builtin_bit_cast(float, (unsigned)v << 16); }
DI float bflo(unsigned w) { return __builtin_bit_cast(float, w << 16); }
DI float bfhi(unsigned w) { return __builtin_bit_cast(float, w & 0xffff0000u); }
DI float sigmoidf_(float x) { return 1.f / (1.f + __expf(-x)); }
DI float wave_sum(float v) {
#pragma unroll
    for (int o = 1; o < 64; o <<= 1) v += __shfl_xor(v, o);
    return v;
}
DI float half_sum(float v) {
#pragma unroll
    for (int o = 1; o < 32; o <<= 1) v += __shfl_xor(v, o);
    return v;
}
#define LDS_WAIT() asm volatile("s_waitcnt lgkmcnt(0)" ::: "memory")
DI int crow(int reg, int h) { return (reg & 3) + 8 * (reg >> 2) + 4 * h; }

template <int K>
DI f32x16 mma_lds(const LAS bf16_t* A, int lda, const LAS bf16_t* B, int ldb, f32x16 acc, int lane) {
    const int r = lane & 31, h = lane >> 5;
    const LAS bf16_t* ap = A + r * lda + 8 * h; const LAS bf16_t* bp = B + r * ldb + 8 * h;
#pragma unroll
    for (int k0 = 0; k0 < K; k0 += 16) {
        const bf16x8 a = *(const LAS bf16x8*)(ap + k0); const bf16x8 b = *(const LAS bf16x8*)(bp + k0);
        acc = __builtin_amdgcn_mfma_f32_32x32x16_bf16(a, b, acc, 0, 0, 0);
    }
    return acc;
}
DI f32x16 zero16() { f32x16 z;
#pragma unroll
    for (int i = 0; i < 16; ++i) z[i] = 0.f;
    return z; }

namespace pg8 {
#define PG8_LAS __attribute__((address_space(3)))
constexpr int BM = 256, BK = 64, HALF = 128, HTB = HALF * BK * 2, STAGE_BYTES = 8 * HTB, NXCD = 8, WGM = 8;
__host__ __device__ __forceinline__ int lds_byte(int r, int c) { const int st = (r >> 4) * 2 + (c >> 5), rr = r & 15, cc = c & 31, ob = rr * 64 + cc * 2; return st * 1024 + (ob ^ (((ob >> 9) & 1) << 5)); }
__host__ __device__ __forceinline__ void stage_rc(int b, int& R, int& C) { const int st = b / 1024, sb = b % 1024, swz = sb ^ (((sb >> 9) & 1) << 5); R = (st >> 1) * 16 + swz / 64; C = (st & 1) * 32 + (swz % 64) / 2; }
__host__ __device__ __forceinline__ int perm32(int rho) { const int n = rho >> 4, i = rho & 15; return 8 * (i >> 2) + 4 * n + (i & 3); }
struct Unit { int pm, pn; };
struct Gemm { const bf16_t* A; const bf16_t* Bt; int M, N, K, lda; };
struct StaticOrder {
    int nM, nN, nwg, G, c;
    __host__ __device__ void init(int M, int N, int G_, int c_) { nM = M / BM; nN = N / BM; nwg = nM * nN; G = G_; c = c_; }
    __host__ __device__ bool next(int i, Unit& u) const {
        const long L = (long)i * G + c; if (L >= nwg) return false;
        int wgid = (int)L; { const int q = nwg / NXCD, r = nwg % NXCD, xcd = wgid % NXCD, off = wgid / NXCD; wgid = (xcd < r ? xcd * (q + 1) : r * (q + 1) + (xcd - r) * q) + off; }
        const int nig = WGM * nN, gid = wgid / nig, fm = gid * WGM, gsz = (nM - fm) < WGM ? (nM - fm) : WGM;
        u.pm = fm + ((wgid % nig) % gsz); u.pn = (wgid % nig) / gsz; return true;
    }
    __device__ __forceinline__ void a_ready(const Unit&) const {}
    __device__ __forceinline__ void done(const Unit&) const {}
};
struct EpiScale {
    static constexpr bool PERM = true, AFTER_DRAIN = false;
    bf16_t* O; int ldc; const float* ssq; int act;
    __device__ __forceinline__ void operator()(const f32x4 (&acc)[2][2][4][2], const Unit& u, int wr, int wc, int fr, int fq) const {
        const int row0 = u.pm * BM + wr * 64 + fr; const int col0 = u.pn * BM + wc * 32 + 8 * fq;
#pragma unroll
        for (int ai = 0; ai < 2; ++ai)
#pragma unroll
            for (int m = 0; m < 4; ++m) { const int r = row0 + ai * HALF + m * 16; const f32x4* sq = (const f32x4*)(ssq + (size_t)r * 16); const f32x4 q0 = sq[0], q1 = sq[1], q2 = sq[2], q3 = sq[3];
                const float tot = (((q0[0] + q0[1]) + (q0[2] + q0[3])) + ((q1[0] + q1[1]) + (q1[2] + q1[3]))) + (((q2[0] + q2[1]) + (q2[2] + q2[3])) + ((q3[0] + q3[1]) + (q3[2] + q3[3])));
                const float rs = rsqrtf(tot * (1.0f / 1024.0f) + EPS);
                bf16_t* rowp = O + (size_t)r * ldc + col0;
#pragma unroll
                for (int bj = 0; bj < 2; ++bj) { f32x4 v0 = acc[ai][bj][m][0] * rs, v1 = acc[ai][bj][m][1] * rs;
                    if (act) {
#pragma unroll
                        for (int e = 0; e < 4; ++e) { const float a = fmaxf(v0[e], 0.f), b = fmaxf(v1[e], 0.f); v0[e] = a * a; v1[e] = b * b; } }
                    u32x4 w; w.x = pk2(v0[0], v0[1]); w.y = pk2(v0[2], v0[3]); w.z = pk2(v1[0], v1[1]); w.w = pk2(v1[2], v1[3]);
                    *(u32x4*)(rowp + bj * HALF) = w; } }
    }
};
struct EpiRes {
    static constexpr bool PERM = false, AFTER_DRAIN = false;
    const float* base; float* out; bf16_t* xb; float* ssq_out;
    __device__ __forceinline__ void operator()(const f32x4 (&acc)[2][2][4][2], const Unit& u, int wr, int wc, int fr, int fq) const {
        const int col0 = u.pn * BM + wc * 32 + 4 * fq;
#pragma unroll
        for (int ai = 0; ai < 2; ++ai)
#pragma unroll
            for (int m = 0; m < 4; ++m) { const int r = u.pm * BM + ai * HALF + wr * 64 + m * 16 + fr; const size_t off = (size_t)r * D + col0; float s = 0.f;
#pragma unroll
                for (int bj = 0; bj < 2; ++bj)
#pragma unroll
                    for (int n = 0; n < 2; ++n) { const size_t o2 = off + bj * HALF + n * 16; const f32x4 o = *(const f32x4*)(base + o2) + acc[ai][bj][m][n];
                        *(f32x4*)(out + o2) = o; u32x2 w; w.x = pk2(o[0], o[1]); w.y = pk2(o[2], o[3]); *(u32x2*)(xb + o2) = w;
                        s += (o[0] * o[0] + o[1] * o[1]) + (o[2] * o[2] + o[3] * o[3]); }
                s += __shfl_xor(s, 16); s += __shfl_xor(s, 32);
                if (fq == 0 && ssq_out) ssq_out[(size_t)r * 16 + u.pn * 4 + wc] = s; }
    }
};
struct EpiGlu {
    static constexpr bool PERM = false, AFTER_DRAIN = true;
    const bf16_t* Ysrc; int lds_; bf16_t* Y;
    __device__ __forceinline__ void fused(f32x4 (&acc)[2][2][4][2], const Unit& u, int wr, int wc, int fr, int fq, PG8_LAS unsigned char* lds, int wid, int lane) const {
        PG8_LAS float* Pp = (PG8_LAS float*)lds;
        const int col0 = wc * 32 + 4 * fq;
#pragma unroll
        for (int ai = 0; ai < 2; ++ai)
#pragma unroll
            for (int m = 0; m < 4; ++m) { const int rl = ai * HALF + wr * 64 + m * 16 + fr; const size_t off = (size_t)(u.pm * BM + rl) * lds_ + col0; float s = 0.f;
#pragma unroll
                for (int bj = 0; bj < 2; ++bj)
#pragma unroll
                    for (int n = 0; n < 2; ++n) { const u32x2 w = *(const u32x2*)(Ysrc + off + bj * HALF + n * 16); f32x4 a = acc[ai][bj][m][n];
                        const float y0 = bflo(w.x), y1 = bfhi(w.x), y2 = bflo(w.y), y3 = bfhi(w.y);
                        a[0] = y0 * sigmoidf_(a[0]); a[1] = y1 * sigmoidf_(a[1]); a[2] = y2 * sigmoidf_(a[2]); a[3] = y3 * sigmoidf_(a[3]);
                        acc[ai][bj][m][n] = a; s += (a[0] * a[0] + a[1] * a[1]) + (a[2] * a[2] + a[3] * a[3]); }
                s += __shfl_xor(s, 16); s += __shfl_xor(s, 32);
                if (fq == 0) Pp[rl * 4 + wc] = s; }
        __syncthreads();
#pragma unroll
        for (int ai = 0; ai < 2; ++ai)
#pragma unroll
            for (int m = 0; m < 4; ++m) { const int rl = ai * HALF + wr * 64 + m * 16 + fr; const size_t off = (size_t)(u.pm * BM + rl) * D + col0;
                const float tot = (Pp[rl * 4 + 0] + Pp[rl * 4 + 1]) + (Pp[rl * 4 + 2] + Pp[rl * 4 + 3]); const float rs = rsqrtf(tot * (1.0f / 256.0f) + EPS);
#pragma unroll
                for (int bj = 0; bj < 2; ++bj)
#pragma unroll
                    for (int n = 0; n < 2; ++n) { const f32x4 a = acc[ai][bj][m][n] * rs; u32x2 w; w.x = pk2(a[0], a[1]); w.y = pk2(a[2], a[3]); *(u32x2*)(Y + off + bj * HALF + n * 16) = w; } }
    }
};

template <class Epi, class Sched, bool ALIGN_EPI = false, bool SP2 = false>
__device__ __forceinline__ void gemm_phase(PG8_LAS unsigned char* lds, const Gemm g, const Sched& S, const Epi& E) {
    int tid_o = threadIdx.x; asm volatile("" : "+v"(tid_o));
    const int tid = tid_o, wid = __builtin_amdgcn_readfirstlane(tid >> 6), lane = tid & 63, wr = wid >> 2, wc = wid & 3, fr = lane & 15, fq = lane >> 4;
    const int K = g.K, nt = K / BK;
    unsigned voffA[2], voffB[2];
#pragma unroll
    for (int i = 0; i < 2; ++i) { int R, C; stage_rc(tid * 16 + i * 8192, R, C); const int Rb = Epi::PERM ? ((R & ~31) + perm32(R & 31)) : R;
        voffA[i] = (unsigned)(R * g.lda + C) * 2u; voffB[i] = (unsigned)(Rb * K + C) * 2u; }
    const size_t kstep = (size_t)(BK * 2);
    const size_t hstepA = (size_t)HALF * g.lda * 2, hstepB = (size_t)HALF * K * 2;
    const size_t tstepA = 2 * hstepA, tstepB = 2 * hstepB;
    const unsigned ldsw = (unsigned)wid * 1024u;
    const int aoff = lds_byte(wr * 64 + fr, fq * 8), boff = lds_byte(wc * 32 + fr, fq * 8);
#define PG8_SA(b, h) (((b) * 2 + (h)) * HTB)
#define PG8_SB(b, h) ((4 + (b) * 2 + (h)) * HTB)
#define PG8_STAGE(bufoff, gbase, voff) do { _Pragma("unroll") for (int _i = 0; _i < 2; ++_i) \
        __builtin_amdgcn_global_load_lds((const unsigned*)((const char*)(gbase) + (voff)[_i]), (PG8_LAS unsigned*)(lds + (bufoff) + ldsw + _i * 8192), 16, 0, 0); } while (0)
#define PG8_LDA(dst, b, h) do { _Pragma("unroll") for (int m = 0; m < 4; ++m) _Pragma("unroll") for (int k = 0; k < 2; ++k) dst[m][k] = *(const PG8_LAS bf16x8*)(lds + PG8_SA(b, h) + aoff + m * 2048 + k * 1024); } while (0)
#define PG8_LDB(dst, b, h) do { _Pragma("unroll") for (int n = 0; n < 2; ++n) _Pragma("unroll") for (int k = 0; k < 2; ++k) dst[n][k] = *(const PG8_LAS bf16x8*)(lds + PG8_SB(b, h) + boff + n * 2048 + k * 1024); } while (0)
#define PG8_MMA(ai, bj, At, Bt) do { __builtin_amdgcn_s_setprio(1); _Pragma("unroll") for (int m = 0; m < 4; ++m) _Pragma("unroll") for (int n = 0; n < 2; ++n) _Pragma("unroll") for (int k = 0; k < 2; ++k) \
        acc[ai][bj][m][n] = __builtin_amdgcn_mfma_f32_16x16x32_bf16(Bt[n][k], At[m][k], acc[ai][bj][m][n], 0, 0, 0); __builtin_amdgcn_s_setprio(0); } while (0)
#define PG8_WAIT_V(n) asm volatile("s_waitcnt vmcnt(" #n ")" ::: "memory")
#define PG8_WAIT_L(n) asm volatile("s_waitcnt lgkmcnt(" #n ")" ::: "memory")
#define PG8_BAR __builtin_amdgcn_s_barrier()
#define PG8_SCHED __builtin_amdgcn_sched_barrier(0)
    Unit cur, nxt; int ui = 0;
    if (!S.next(0, cur)) return;
    f32x4 acc[2][2][4][2];
#pragma unroll
    for (int a = 0; a < 2; ++a)
#pragma unroll
        for (int b = 0; b < 2; ++b)
#pragma unroll
            for (int m = 0; m < 4; ++m)
#pragma unroll
                for (int n = 0; n < 2; ++n) acc[a][b][m][n] = (f32x4){0.f, 0.f, 0.f, 0.f};
    bf16x8 At[4][2], B0[2][2], B1[2][2];
    const char* cA = (const char*)g.A + (size_t)cur.pm * tstepA; const char* cB = (const char*)g.Bt + (size_t)cur.pn * tstepB;
    S.a_ready(cur);
    if constexpr (SP2) {
        PG8_STAGE(PG8_SB(0, 0), cB, voffB); PG8_STAGE(PG8_SB(0, 1), cB + hstepB, voffB); PG8_STAGE(PG8_SA(0, 0), cA, voffA); PG8_STAGE(PG8_SA(0, 1), cA + hstepA, voffA);
        if (wr == 1) PG8_BAR;
        PG8_WAIT_V(2); PG8_BAR;
        PG8_STAGE(PG8_SB(1, 0), cB + kstep, voffB); PG8_STAGE(PG8_SA(1, 0), cA + kstep, voffA); PG8_STAGE(PG8_SB(1, 1), cB + hstepB + kstep, voffB);
        PG8_WAIT_V(6); PG8_BAR;
    } else {
        PG8_STAGE(PG8_SB(0, 0), cB, voffB); PG8_STAGE(PG8_SA(0, 0), cA, voffA); PG8_STAGE(PG8_SB(0, 1), cB + hstepB, voffB); PG8_STAGE(PG8_SA(0, 1), cA + hstepA, voffA);
        if (wr == 1) PG8_BAR;
        PG8_WAIT_V(4); PG8_BAR;
        PG8_STAGE(PG8_SB(1, 0), cB + kstep, voffB); PG8_STAGE(PG8_SA(1, 0), cA + kstep, voffA); PG8_STAGE(PG8_SB(1, 1), cB + hstepB + kstep, voffB);
        PG8_WAIT_V(6); PG8_BAR;
    }
    for (;;) {
        const bool has_next = S.next(ui + 1, nxt);
        const char* nA = has_next ? (const char*)g.A + (size_t)nxt.pm * tstepA : cA; const char* nB = has_next ? (const char*)g.Bt + (size_t)nxt.pn * tstepB : cB;
        for (int t = 0; t < nt; t += 2) {
            const bool last = (t == nt - 2);
            const char* a1 = cA + (size_t)(t + 1) * kstep;
            const char* a2 = last ? nA : cA + (size_t)(t + 2) * kstep; const char* b2 = last ? nB : cB + (size_t)(t + 2) * kstep;
            const char* a3 = a2 + kstep; const char* b3 = b2 + kstep;
            if (last && has_next) S.a_ready(nxt);
            if constexpr (SP2) {
            PG8_LDB(B0, 0, 0); PG8_LDB(B1, 0, 1); PG8_SCHED; PG8_LDA(At, 0, 0); PG8_STAGE(PG8_SA(1, 1), a1 + hstepA, voffA);
            PG8_WAIT_V(8); PG8_WAIT_L(0); PG8_BAR; PG8_MMA(0, 0, At, B0); PG8_MMA(0, 1, At, B1); PG8_BAR; PG8_SCHED;
            PG8_LDA(At, 0, 1); PG8_STAGE(PG8_SB(0, 0), b2, voffB); PG8_STAGE(PG8_SB(0, 1), b2 + hstepB, voffB); PG8_STAGE(PG8_SA(0, 0), a2, voffA);
            PG8_WAIT_V(8); PG8_WAIT_L(0); PG8_BAR; PG8_MMA(1, 0, At, B0); PG8_MMA(1, 1, At, B1); PG8_BAR; PG8_SCHED;
            PG8_LDB(B0, 1, 0); PG8_LDB(B1, 1, 1); PG8_SCHED; PG8_LDA(At, 1, 0); PG8_STAGE(PG8_SA(0, 1), a2 + hstepA, voffA);
            PG8_WAIT_V(8); PG8_WAIT_L(0); PG8_BAR; PG8_MMA(0, 0, At, B0); PG8_MMA(0, 1, At, B1); PG8_BAR; PG8_SCHED;
            PG8_LDA(At, 1, 1); PG8_STAGE(PG8_SB(1, 0), b3, voffB); PG8_STAGE(PG8_SB(1, 1), b3 + hstepB, voffB); PG8_STAGE(PG8_SA(1, 0), a3, voffA);
            PG8_WAIT_V(8); PG8_WAIT_L(0); PG8_BAR; PG8_MMA(1, 0, At, B0); PG8_MMA(1, 1, At, B1); PG8_BAR; PG8_SCHED;
            } else {
            PG8_LDB(B0, 0, 0); PG8_SCHED; PG8_LDA(At, 0, 0); PG8_STAGE(PG8_SA(1, 1), a1 + hstepA, voffA);
            PG8_WAIT_L(8); PG8_BAR; PG8_WAIT_L(0); PG8_MMA(0, 0, At, B0); PG8_BAR; PG8_SCHED;
            PG8_LDB(B1, 0, 1); PG8_STAGE(PG8_SB(0, 0), b2, voffB);
            PG8_BAR; PG8_WAIT_L(0); PG8_MMA(0, 1, At, B1); PG8_BAR;
            PG8_LDA(At, 0, 1); PG8_STAGE(PG8_SA(0, 0), a2, voffA);
            PG8_BAR; PG8_WAIT_L(0); PG8_MMA(1, 0, At, B0); PG8_BAR; PG8_SCHED;
            PG8_STAGE(PG8_SB(0, 1), b2 + hstepB, voffB);
            PG8_WAIT_V(6); PG8_BAR; PG8_MMA(1, 1, At, B1); PG8_BAR;
            PG8_LDB(B0, 1, 0); PG8_SCHED; PG8_LDA(At, 1, 0); PG8_STAGE(PG8_SA(0, 1), a2 + hstepA, voffA);
            PG8_WAIT_L(8); PG8_BAR; PG8_WAIT_L(0); PG8_MMA(0, 0, At, B0); PG8_BAR; PG8_SCHED;
            PG8_LDB(B1, 1, 1); PG8_STAGE(PG8_SB(1, 0), b3, voffB);
            PG8_BAR; PG8_WAIT_L(0); PG8_MMA(0, 1, At, B1); PG8_BAR;
            PG8_LDA(At, 1, 1); PG8_STAGE(PG8_SA(1, 0), a3, voffA);
            PG8_BAR; PG8_WAIT_L(0); PG8_MMA(1, 0, At, B0); PG8_BAR; PG8_SCHED;
            PG8_STAGE(PG8_SB(1, 1), b3 + hstepB, voffB);
            PG8_WAIT_V(6); PG8_BAR; PG8_MMA(1, 1, At, B1); PG8_BAR;
            }
        }
        if constexpr (ALIGN_EPI) { if (wr == 0) PG8_BAR; }
        if constexpr (!Epi::AFTER_DRAIN) { E(acc, cur, wr, wc, fr, fq); S.done(cur); }
        if (!has_next) break;
#pragma unroll
        for (int a = 0; a < 2; ++a)
#pragma unroll
            for (int b = 0; b < 2; ++b)
#pragma unroll
                for (int m = 0; m < 4; ++m)
#pragma unroll
                    for (int n = 0; n < 2; ++n) acc[a][b][m][n] = (f32x4){0.f, 0.f, 0.f, 0.f};
        cur = nxt; cA = nA; cB = nB; ++ui;
        if constexpr (ALIGN_EPI) { if (wr == 1) PG8_BAR; }
    }
    PG8_WAIT_V(0);
    if constexpr (!ALIGN_EPI) { if (wr == 0) PG8_BAR; }
    PG8_BAR;
    if constexpr (Epi::AFTER_DRAIN) { E.fused(acc, cur, wr, wc, fr, fq, lds, wid, lane); S.done(cur); }
#undef PG8_SA
#undef PG8_SB
#undef PG8_STAGE
#undef PG8_LDA
#undef PG8_LDB
#undef PG8_MMA
#undef PG8_WAIT_V
#undef PG8_WAIT_L
#undef PG8_BAR
#undef PG8_SCHED
}
}

struct Params { const float* in[26]; float* out; unsigned char* ws; };
enum { I_X = 0, I_NMG, I_WIN, I_LBL, I_HNG, I_CW, I_CB, I_CLG, I_CLB, I_LRE, I_LIM, I_BRE, I_BIM, I_CRE, I_CIM, I_S5D, I_LDT, I_WGLU, I_QG, I_KG, I_RB, I_MONG, I_WOUT, I_NMLPG, I_WUP, I_WDN };

DI void p0_transpose_item(const float* W, int K, int N, bf16_t* WT, const float* gk, LAS float* scr, int item, int lane) {
    const int nblk = N / 32, kb = item / nblk, nb = item % nblk, k0 = 64 * kb, n0 = 32 * nb;
#pragma unroll 8
    for (int i = 0; i < 32; ++i) { const int kk = 2 * i + (lane >> 5); const float s = gk ? gk[k0 + kk] : 1.f; scr[kk * 33 + (lane & 31)] = W[(size_t)(k0 + kk) * N + n0 + (lane & 31)] * s; }
    LDS_WAIT();
    const int c = lane & 7;
#pragma unroll
    for (int j = 0; j < 4; ++j) { const int n = (lane >> 3) + 8 * j; const LAS float* s = scr + (8 * c) * 33 + n;
        u32x4 o; o.x = pk2(s[0 * 33], s[1 * 33]); o.y = pk2(s[2 * 33], s[3 * 33]); o.z = pk2(s[4 * 33], s[5 * 33]); o.w = pk2(s[6 * 33], s[7 * 33]);
        *(u32x4*)(WT + (size_t)(n0 + n) * K + k0 + 8 * c) = o; }
    LDS_WAIT();
}
DI void s5_params(const Params& p, int lg, int pp, float& lrdt, float& lidt, float& cr, float& ci) {
    const float dt = expf(p.in[I_LDT][lg]);
    const float lr = p.in[I_LRE][lg * 64 + pp], li = p.in[I_LIM][lg * 64 + pp];
    lrdt = lr * dt; lidt = li * dt;
    const float mag = expf(lrdt); const float ar = mag * cosf(lidt), ai = mag * sinf(lidt);
    const float den = lr * lr + li * li;
    cr = ((ar - 1.0f) * lr + ai * li) / den; ci = (ai * lr - (ar - 1.0f) * li) / den;
}
DI void s5_pow(float lrdt, float lidt, int n, float& er, float& ei) { const float m = expf((float)n * lrdt); const float a = (float)n * lidt; er = m * cosf(a); ei = m * sinf(a); }

DI void prologue(const Params& p, LAS unsigned char* lds, int G) {
    int tid_o = threadIdx.x; asm volatile("" : "+v"(tid_o));
    const int tid = tid_o, lane = tid & 63, wave = tid >> 6;
    const int gw = blockIdx.x * 8 + wave, NGW = G * 8;
    const int gt = blockIdx.x * 512 + tid, NGT = G * 512;
    unsigned char* ws = p.ws;
    LAS float* scr = (LAS float*)(lds + wave * 16384);
    {
        constexpr int I_IN = (D / 64) * (DIN / 32), I_OUT = (D / 64) * (D / 32), I_UP = (D / 64) * (FF / 32), I_DN = (FF / 64) * (D / 32), I_GL = (256 / 64) * (256 / 32);
        constexpr int PER_L = I_IN + I_OUT + I_UP + I_DN + I_GL;
        for (int it = gw; it < NL * PER_L; it += NGW) {
            const int l = it / PER_L; int r = it % PER_L;
            if (r < I_IN) { p0_transpose_item(p.in[I_WIN] + (size_t)l * D * DIN, D, DIN, (bf16_t*)(ws + WS_WIN) + (size_t)l * D * DIN, p.in[I_NMG] + l * D, scr, r, lane); continue; } r -= I_IN;
            if (r < I_OUT) { p0_transpose_item(p.in[I_WOUT] + (size_t)l * D * D, D, D, (bf16_t*)(ws + WS_WOUT) + (size_t)l * D * D, p.in[I_MONG] + l * D, scr, r, lane); continue; } r -= I_OUT;
            if (r < I_UP) { p0_transpose_item(p.in[I_WUP] + (size_t)l * D * FF, D, FF, (bf16_t*)(ws + WS_WUP) + (size_t)l * D * FF, p.in[I_NMLPG] + l * D, scr, r, lane); continue; } r -= I_UP;
            if (r < I_DN) { p0_transpose_item(p.in[I_WDN] + (size_t)l * D * FF, FF, D, (bf16_t*)(ws + WS_WDN) + (size_t)l * D * FF, nullptr, scr, r, lane); continue; } r -= I_DN;
            p0_transpose_item(p.in[I_WGLU] + (size_t)l * 65536, 256, 256, (bf16_t*)(ws + WS_WGLU) + (size_t)l * 65536, nullptr, scr, r, lane);
        }
    }
    {
        float* ssq0 = (float*)(ws + WS_SSQP); bf16_t* XB = (bf16_t*)(ws + WS_XB);
        for (int mb = gw * 16; mb < T; mb += NGW * 16) {
            float keep = 0.f;
#pragma unroll 4
            for (int i = 0; i < 16; ++i) { const int m = mb + i;
                const f32x4* xr = (const f32x4*)(p.in[I_X] + (size_t)m * D) + lane; f32x4 v[4]; float s = 0.f;
#pragma unroll
                for (int j = 0; j < 4; ++j) { v[j] = xr[64 * j]; s += (v[j][0] * v[j][0] + v[j][1] * v[j][1]) + (v[j][2] * v[j][2] + v[j][3] * v[j][3]); }
                s = wave_sum(s); if (lane == i) keep = s;
                u32x2* o8 = (u32x2*)(XB + (size_t)m * D) + lane;
#pragma unroll
                for (int j = 0; j < 4; ++j) { u32x2 w; w.x = pk2(v[j][0], v[j][1]); w.y = pk2(v[j][2], v[j][3]); o8[64 * j] = w; } }
#pragma unroll 1
            for (int i = 0; i < 16; ++i) { const float v = __shfl(keep, i); if (lane < 16) ssq0[(size_t)(mb + i) * 16 + lane] = lane == 0 ? v : 0.f; }
        }
    }
    {
        float* LB = (float*)(ws + WS_LB);
        for (int c = gt; c < 256; c += NGT) {
            const float a0 = p.in[I_LBL][c], a1 = p.in[I_LBL][256 + c], a2 = p.in[I_LBL][512 + c], a3 = p.in[I_LBL][768 + c];
            const float mx = fmaxf(fmaxf(a0, a1), fmaxf(a2, a3));
            const float e0 = expf(a0 - mx), e1 = expf(a1 - mx), e2 = expf(a2 - mx), e3 = expf(a3 - mx); const float inv = 1.f / (e0 + e1 + e2 + e3);
            const float s1 = e1 * inv, s2 = e2 * inv, s3 = e3 * inv; const float hi = 1.0f - 1e-6f;
            LB[c] = 0.f; LB[256 + c] = fminf(fmaxf(s1, 0.f), hi); LB[512 + c] = fminf(fmaxf(s1 + s2, 0.f), hi); LB[768 + c] = fminf(fmaxf(s1 + s2 + s3, 0.f), hi);
        }
        float* BT = (float*)(ws + WS_BIAS);
        for (int i = gt; i < 3 * 4 * 132; i += NGT) {
            const int pt = i / (4 * 132), hd = (i / 132) % 4, dl = i % 132; const int dil = pt == 0 ? 1 : (pt == 1 ? 4 : 16);
            float v = 0.f;
            if (dl <= 128) { const int dist = dl * dil; int bk;
                if (dist < 16) bk = dist; else { bk = 16 + (int)(logf((float)dist / 16.0f) / 4.852030263919617f * 16.0f); if (bk > 31) bk = 31; }
                v = p.in[I_RB][bk * 4 + hd]; }
            BT[i] = v;
        }
    }
    {
        bf16_t* KT = (bf16_t*)(ws + WS_S5K); bf16_t* WS_ = (bf16_t*)(ws + WS_S5WS); bf16_t* WC = (bf16_t*)(ws + WS_S5WC);
        LAS float* ebr = scr; LAS float* ebi = scr + 64 * 17;
        for (int it = gw; it < NL * 16 * 64; it += NGW) {
            const int lg = it >> 6, d = it & 63;
            float lrdt, lidt, cr, ci; s5_params(p, lg, lane, lrdt, lidt, cr, ci);
            float er, ei; s5_pow(lrdt, lidt, d, er, ei);
            const float fr_ = er * cr - ei * ci, fi_ = er * ci + ei * cr;
            const float* br = p.in[I_BRE] + ((size_t)lg * 64 + lane) * 16; const float* bi = p.in[I_BIM] + ((size_t)lg * 64 + lane) * 16;
#pragma unroll
            for (int c = 0; c < 16; ++c) { const float b0 = br[c], b1 = bi[c]; ebr[lane * 17 + c] = fr_ * b0 - fi_ * b1; ebi[lane * 17 + c] = fr_ * b1 + fi_ * b0; }
            LDS_WAIT();
            const int co = lane & 15, cb = (lane >> 4) * 4;
            const float* crp = p.in[I_CRE] + ((size_t)lg * 16 + co) * 64; const float* cip = p.in[I_CIM] + ((size_t)lg * 16 + co) * 64;
            float a0 = 0.f, a1 = 0.f, a2 = 0.f, a3 = 0.f;
            for (int q = 0; q < 64; ++q) { const float c0 = crp[q], c1 = cip[q];
                a0 += c0 * ebr[q * 17 + cb + 0] - c1 * ebi[q * 17 + cb + 0]; a1 += c0 * ebr[q * 17 + cb + 1] - c1 * ebi[q * 17 + cb + 1];
                a2 += c0 * ebr[q * 17 + cb + 2] - c1 * ebi[q * 17 + cb + 2]; a3 += c0 * ebr[q * 17 + cb + 3] - c1 * ebi[q * 17 + cb + 3]; }
            u32x2 w; w.x = pk2(a0, a1); w.y = pk2(a2, a3);
            *(u32x2*)(KT + ((size_t)it * 16 + co) * 16 + cb) = w;
            LDS_WAIT();
        }
        for (int it = gw; it < NL * 16 * 16; it += NGW) {
            const int lg = it >> 4, s4 = it & 15;
            float lrdt, lidt, cr, ci; s5_params(p, lg, lane, lrdt, lidt, cr, ci);
            const float* br = p.in[I_BRE] + ((size_t)lg * 64 + lane) * 16; const float* bi = p.in[I_BIM] + ((size_t)lg * 64 + lane) * 16;
            float b0[16], b1[16];
#pragma unroll
            for (int c = 0; c < 16; ++c) { b0[c] = br[c]; b1[c] = bi[c]; }
#pragma unroll 1
            for (int sq = 0; sq < 4; ++sq) { const int s = s4 * 4 + sq;
                float er, ei; s5_pow(lrdt, lidt, 63 - s, er, ei);
                const float fr_ = er * cr - ei * ci, fi_ = er * ci + ei * cr;
                float vr[16], vi[16];
#pragma unroll
                for (int c = 0; c < 16; ++c) { vr[c] = fr_ * b0[c] - fi_ * b1[c]; vi[c] = fr_ * b1[c] + fi_ * b0[c]; }
                bf16_t* o0 = WS_ + ((size_t)lg * 128 + lane) * 1024 + s * 16; bf16_t* o1 = WS_ + ((size_t)lg * 128 + 64 + lane) * 1024 + s * 16;
                u32x4 w;
                w.x = pk2(vr[0], vr[1]); w.y = pk2(vr[2], vr[3]); w.z = pk2(vr[4], vr[5]); w.w = pk2(vr[6], vr[7]); *(u32x4*)o0 = w;
                w.x = pk2(vr[8], vr[9]); w.y = pk2(vr[10], vr[11]); w.z = pk2(vr[12], vr[13]); w.w = pk2(vr[14], vr[15]); *(u32x4*)(o0 + 8) = w;
                w.x = pk2(vi[0], vi[1]); w.y = pk2(vi[2], vi[3]); w.z = pk2(vi[4], vi[5]); w.w = pk2(vi[6], vi[7]); *(u32x4*)o1 = w;
                w.x = pk2(vi[8], vi[9]); w.y = pk2(vi[10], vi[11]); w.z = pk2(vi[12], vi[13]); w.w = pk2(vi[14], vi[15]); *(u32x4*)(o1 + 8) = w; }
        }
        for (int it = gw; it < NL * 16 * 64; it += NGW) {
            const int lg = it >> 6, tl = it & 63;
            float lrdt, lidt, cr, ci; s5_params(p, lg, lane, lrdt, lidt, cr, ci);
            float er, ei; s5_pow(lrdt, lidt, tl + 1, er, ei);
#pragma unroll 4
            for (int co = 0; co < 16; ++co) { const float c0 = p.in[I_CRE][((size_t)lg * 16 + co) * 64 + lane], c1 = p.in[I_CIM][((size_t)lg * 16 + co) * 64 + lane];
                bf16_t* o = WC + (((size_t)lg * 64 + tl) * 16 + co) * 128;
                o[lane] = (bf16_t)f2bf(c0 * er - c1 * ei); o[64 + lane] = (bf16_t)f2bf(-(c0 * ei + c1 * er)); }
        }
    }
}

template <bool OUT>
DI void hgrn_item(const Params& p, LAS unsigned char* lds, int l, int cg) {
    int tid_o = threadIdx.x; asm volatile("" : "+v"(tid_o));
    const int tid = tid_o, lane = tid & 63, wave = tid >> 6, hd = wave >> 1, half = wave & 1;
    const bf16_t* Z = (const bf16_t*)(p.ws + WS_Z);
    LAS bf16_t* B0 = (LAS bf16_t*)(lds + hd * 27648); LAS bf16_t* B1 = B0 + 64 * 72; LAS bf16_t* B2 = B1 + 64 * 72;
    LAS float* GM = (LAS float*)(lds + 114688) + hd * 64; LAS float* GL = GM + 256; LAS float* SSA = (LAS float*)(lds + 114688) + 512;
    bf16_t* SL = (bf16_t*)(p.ws + WS_SL); const bf16_t* SL2 = (const bf16_t*)(p.ws + WS_SL2); float* DEC = (float*)(p.ws + WS_DEC);
    const int item = cg * 4 + hd;
#ifdef FORCE_LB0
    const float lb = 0.f, oml = 1.f;
#else
    const float lb = ((const float*)(p.ws + WS_LB))[l * 256 + hd * 64 + lane], oml = 1.f - lb;
#endif
    const int srow = tid >> 5, shd = (tid >> 3) & 3, spc = tid & 7;
    const bf16_t* zsrc = Z + (size_t)(cg * 64 + srow) * DIN + shd * 64 + spc * 8;
    const int sdst = shd * 27648 + (srow * 72 + spc * 8) * 2;
    __syncthreads();
    { u32x4 wf[4], wi[4], wq[4];
#pragma unroll
      for (int sub = 0; sub < 4; ++sub) { wf[sub] = *(const u32x4*)(zsrc + (size_t)(16 * sub) * DIN + ZF); wi[sub] = *(const u32x4*)(zsrc + (size_t)(16 * sub) * DIN + ZI);
          if (OUT) wq[sub] = *(const u32x4*)(zsrc + (size_t)(16 * sub) * DIN + ZQ); }
#pragma unroll
      for (int sub = 0; sub < 4; ++sub) { *(LAS u32x4*)(lds + sdst + 9216 + sub * 16 * 144) = wf[sub]; *(LAS u32x4*)(lds + sdst + 18432 + sub * 16 * 144) = wi[sub];
          if (OUT) *(LAS u32x4*)(lds + sdst + sub * 16 * 144) = wq[sub]; } }
    __syncthreads();
    float g[32]; float run = 0.f;
#pragma unroll
    for (int j = 0; j < 32; ++j) { const float fz = bf2f(B1[(half * 32 + j) * 72 + lane]); const float sg = sigmoidf_(fz); const float f = lb + oml * sg;
        run += __logf(fmaxf(f, 1e-30f)); g[j] = run; }
    if (half == 0) GM[lane] = run;
    __syncthreads();
    const float gm = GM[lane];
    if (half) {
#pragma unroll
        for (int j = 0; j < 32; ++j) g[j] += gm; }
    const int c0 = lane & 31, h = lane >> 5;
    if constexpr (!OUT) {
        if (half) GL[lane] = run + gm;
        __syncthreads();
        const float gl = GL[lane];
        bf16_t kv[32], ivr[32];
#pragma unroll
        for (int j = 0; j < 32; ++j) { const int t = half * 32 + j; const float e = __expf(gl - g[j]); const float kj = oml * (1.f - sigmoidf_(bf2f(B1[t * 72 + lane])));
            kv[j] = (bf16_t)f2bf(kj * e); ivr[j] = B2[t * 72 + lane]; }
        __syncthreads();
#pragma unroll
        for (int j = 0; j < 32; ++j) { const int t = half * 32 + j; B1[lane * 72 + t] = kv[j]; B2[lane * 72 + t] = ivr[j]; }
        __syncthreads();
#pragma unroll
        for (int kt = 0; kt < 2; ++kt) { const f32x16 a = mma_lds<64>(B2 + 32 * half * 72, 72, B1 + 32 * kt * 72, 72, zero16(), lane);
#pragma unroll
            for (int i = 0; i < 16; ++i) SL[(size_t)item * 4096 + (32 * half + crow(i, h)) * 64 + 32 * kt + c0] = (bf16_t)f2bf(a[i]); }
        if (half == 0) DEC[item * 64 + lane] = __expf(gl);
    } else {
        if (half == 0) GL[lane] = __expf(gm);
        bf16_t ivr[32];
#pragma unroll
        for (int j = 0; j < 32; ++j) { const int t = half * 32 + j; const float q = bf2f(B0[t * 72 + lane]); const float kj = oml * (1.f - sigmoidf_(bf2f(B1[t * 72 + lane])));
            const float e1 = __expf(fminf(g[j] - gm, 80.f)), e2 = __expf(fminf(gm - g[j], 80.f));
            ivr[j] = B2[t * 72 + lane];
            B0[t * 72 + lane] = (bf16_t)f2bf(q * e1); B1[t * 72 + lane] = (bf16_t)f2bf(kj * e2); }
        __syncthreads();
#pragma unroll
        for (int j = 0; j < 32; ++j) B2[lane * 72 + half * 32 + j] = ivr[j];
        __syncthreads();
        f32x16 s0 = mma_lds<64>(B0 + 32 * half * 72, 72, B1, 72, zero16(), lane);
        f32x16 s1 = zero16(); if (half) s1 = mma_lds<64>(B0 + 32 * half * 72, 72, B1 + 32 * 72, 72, zero16(), lane);
        __syncthreads();
#pragma unroll
        for (int i = 0; i < 16; ++i) { const int row = 32 * half + crow(i, h);
            B1[row * 72 + c0] = (bf16_t)f2bf(c0 <= row ? s0[i] : 0.f); B1[row * 72 + 32 + c0] = (bf16_t)f2bf(32 + c0 <= row ? s1[i] : 0.f); }
        __syncthreads();
        f32x16 o0 = mma_lds<64>(B1 + 32 * half * 72, 72, B2, 72, zero16(), lane);
        f32x16 o1 = mma_lds<64>(B1 + 32 * half * 72, 72, B2 + 32 * 72, 72, zero16(), lane);
        __syncthreads();
        {
          u32x4 wsl[4], wg[4];
          const bf16_t* sp = SL2 + (size_t)item * 4096 + (32 * half) * 64;
#pragma unroll
          for (int e = 0; e < 4; ++e) { const int pc = lane + 64 * e; wsl[e] = *(const u32x4*)(sp + pc * 8); wg[e] = *(const u32x4*)(zsrc + (size_t)(16 * e) * DIN + ZG); }
#pragma unroll
          for (int e = 0; e < 4; ++e) { const int pc = lane + 64 * e, row = pc >> 3, k0 = (pc & 7) * 8; const LAS float* eg = GL + k0;
              u32x4 o; o.x = pk2(bflo(wsl[e].x) * eg[0], bfhi(wsl[e].x) * eg[1]); o.y = pk2(bflo(wsl[e].y) * eg[2], bfhi(wsl[e].y) * eg[3]);
              o.z = pk2(bflo(wsl[e].z) * eg[4], bfhi(wsl[e].z) * eg[5]); o.w = pk2(bflo(wsl[e].w) * eg[6], bfhi(wsl[e].w) * eg[7]);
              *(LAS u32x4*)(B2 + (32 * half + row) * 72 + k0) = o;
              *(LAS u32x4*)(lds + sdst + 9216 + e * 16 * 144) = wg[e]; } }
        __syncthreads();
        o0 = mma_lds<64>(B0 + 32 * half * 72, 72, B2, 72, o0, lane);
        o1 = mma_lds<64>(B0 + 32 * half * 72, 72, B2 + 32 * 72, 72, o1, lane);
        const float* ng = p.in[I_HNG] + l * 256 + hd * 64; const float ng0 = ng[c0], ng1 = ng[32 + c0];
#pragma unroll
        for (int i = 0; i < 16; ++i) { const int row = 32 * half + crow(i, h);
            const float ss = half_sum(o0[i] * o0[i] + o1[i] * o1[i]); const float rs = rsqrtf(ss * (1.0f / 64.0f) + EPS);
            const float g0 = bf2f(B1[row * 72 + c0]), g1 = bf2f(B1[row * 72 + 32 + c0]);
            const float v0 = o0[i] * rs * ng0 * g0 * sigmoidf_(g0), v1 = o1[i] * rs * ng1 * g1 * sigmoidf_(g1);
            o0[i] = v0; o1[i] = v1; const float s2 = half_sum(v0 * v0 + v1 * v1); if (c0 == 0) SSA[hd * 64 + row] = s2; }
        __syncthreads();
        bf16_t* Y = (bf16_t*)(p.ws + WS_YCAT);
#pragma unroll
        for (int i = 0; i < 16; ++i) { const int row = 32 * half + crow(i, h); const size_t tok = (size_t)cg * 64 + row;
            const float tot = (SSA[row] + SSA[64 + row]) + (SSA[128 + row] + SSA[192 + row]); const float r2 = rsqrtf(tot * (1.0f / 256.0f) + EPS);
            Y[tok * D + YA + hd * 64 + c0] = (bf16_t)f2bf(o0[i] * r2); Y[tok * D + YA + hd * 64 + 32 + c0] = (bf16_t)f2bf(o1[i] * r2); }
    }
}
DI void hgrn_scan_item(const Params& p, int hb) {
    int tid_o = threadIdx.x; asm volatile("" : "+v"(tid_o));
    const int e = hb * 512 + tid_o, bh = e >> 12, b = bh >> 2, hd = bh & 3, vk = e & 4095, k = vk & 63;
    const bf16_t* SL = (const bf16_t*)(p.ws + WS_SL); bf16_t* SL2 = (bf16_t*)(p.ws + WS_SL2); const float* DEC = (const float*)(p.ws + WS_DEC);
    float st = 0.f;
    for (int c8 = 0; c8 < 128; c8 += 16) { float tmp[16], dc[16];
#pragma unroll
        for (int u = 0; u < 16; ++u) { const int item = (b * 128 + c8 + u) * 4 + hd; tmp[u] = bf2f(SL[(size_t)item * 4096 + vk]); dc[u] = DEC[item * 64 + k]; }
#pragma unroll
        for (int u = 0; u < 16; ++u) { const int item = (b * 128 + c8 + u) * 4 + hd; SL2[(size_t)item * 4096 + vk] = (bf16_t)f2bf(st); st = dc[u] * st + tmp[u]; } }
}

DI void conv_item(const Params& p, LAS unsigned char* lds, int l, int ti) {
    int tid_o = threadIdx.x; asm volatile("" : "+v"(tid_o));
    const int tid = tid_o, lane = tid & 63, wave = tid >> 6, c = tid & 255, hf = tid >> 8, wv = wave & 3;
    LAS float* Hs = (LAS float*)lds; LAS float* ST = (LAS float*)(lds + 98304); LAS float* ST2 = ST + 512;
    const bf16_t* Z = (const bf16_t*)(p.ws + WS_Z); bf16_t* Y = (bf16_t*)(p.ws + WS_YCAT);
    const int tok0 = ti * 64, pos0 = (ti & 127) * 64;
    __syncthreads();
    { u32x4 vw[6], gw_[6];
#pragma unroll
      for (int k = 0; k < 6; ++k) { const int pid = tid + 512 * k, row = pid >> 5, pc = pid & 31, pos = pos0 - 30 + row; const bool ok = (row < 94) && (pos >= 0);
          const size_t tok = ok ? (size_t)(tok0 - 30 + row) : (size_t)tok0; vw[k] = *(const u32x4*)(Z + tok * DIN + ZBV + pc * 8); gw_[k] = *(const u32x4*)(Z + tok * DIN + ZBG + pc * 8); }
#pragma unroll
      for (int k = 0; k < 6; ++k) { const int pid = tid + 512 * k, row = pid >> 5, pc = pid & 31, pos = pos0 - 30 + row; const bool ok = (row < 94) && (pos >= 0);
          if (row < 94) { f32x4 h0, h1;
              h0[0] = bflo(vw[k].x) * sigmoidf_(bflo(gw_[k].x)); h0[1] = bfhi(vw[k].x) * sigmoidf_(bfhi(gw_[k].x)); h0[2] = bflo(vw[k].y) * sigmoidf_(bflo(gw_[k].y)); h0[3] = bfhi(vw[k].y) * sigmoidf_(bfhi(gw_[k].y));
              h1[0] = bflo(vw[k].z) * sigmoidf_(bflo(gw_[k].z)); h1[1] = bfhi(vw[k].z) * sigmoidf_(bfhi(gw_[k].z)); h1[2] = bflo(vw[k].w) * sigmoidf_(bflo(gw_[k].w)); h1[3] = bfhi(vw[k].w) * sigmoidf_(bfhi(gw_[k].w));
              if (!ok) { h0 = (f32x4){0.f, 0.f, 0.f, 0.f}; h1 = h0; }
              *(LAS f32x4*)(Hs + row * 256 + pc * 8) = h0; *(LAS f32x4*)(Hs + row * 256 + pc * 8 + 4) = h1; } } }
    __syncthreads();
    const float* cw = p.in[I_CW] + (size_t)l * 31 * 256 + c; float w[31];
#pragma unroll
    for (int jj = 0; jj < 31; ++jj) w[jj] = cw[jj * 256];
    const float cb = p.in[I_CB][l * 256 + c];
    const float lng = p.in[I_CLG][l * 256 + c], lnb = p.in[I_CLB][l * 256 + c];
#pragma unroll 1
    for (int ps = 0; ps < 2; ++ps) { const int tb = hf * 32 + ps * 16;
        float o[16];
        { float hr[46];
#pragma unroll
          for (int r = 0; r < 46; ++r) hr[r] = Hs[(tb + r) * 256 + c];
#pragma unroll
          for (int j = 0; j < 16; ++j) { float a = cb;
#pragma unroll
            for (int jj = 0; jj < 31; ++jj) a += w[jj] * hr[j + jj];
            o[j] = a; } }
#pragma unroll
        for (int j = 0; j < 16; ++j) { const float s1 = wave_sum(o[j]), s2 = wave_sum(o[j] * o[j]); if (lane == 0) { ST[((tb + j) * 4 + wv) * 2] = s1; ST[((tb + j) * 4 + wv) * 2 + 1] = s2; } }
        __syncthreads();
#pragma unroll
        for (int j = 0; j < 16; ++j) { const LAS float* q = ST + (tb + j) * 8; const float s1 = (q[0] + q[2]) + (q[4] + q[6]), s2 = (q[1] + q[3]) + (q[5] + q[7]);
            const float mu = s1 * (1.0f / 256.0f); const float var = fmaxf(s2 * (1.0f / 256.0f) - mu * mu, 0.f);
            const float y = (o[j] - mu) * rsqrtf(var + EPS) * lng + lnb; const float sv = y * sigmoidf_(y); o[j] = sv;
            const float s3 = wave_sum(sv * sv); if (lane == 0) ST2[(tb + j) * 4 + wv] = s3; }
        __syncthreads();
#pragma unroll
        for (int j = 0; j < 16; ++j) { const LAS float* q = ST2 + (tb + j) * 4; const float tot = (q[0] + q[1]) + (q[2] + q[3]); const float rs = rsqrtf(tot * (1.0f / 256.0f) + EPS);
            Y[(size_t)(tok0 + tb + j) * D + YB + c] = (bf16_t)f2bf(o[j] * rs); }
    }
}

DI bf16x8 ldg8(const bf16_t* p) { return *(const bf16x8*)p; }
DI void s5_local_item(const Params& p, int l, int bi) {
    int tid_o = threadIdx.x; asm volatile("" : "+v"(tid_o));
    const int lane = tid_o & 63, wi = bi * 8 + (tid_o >> 6);
    const int g = wi & 15, cb = (wi >> 4) & 15, pt = wi >> 8, c0 = lane & 31, h = lane >> 5;
    const bf16_t* ua = (const bf16_t*)(p.ws + WS_Z) + (size_t)((cb * 32 + c0) * 64) * DIN + ZCU + g * 16 + 8 * h;
    const bf16_t* wb = (const bf16_t*)(p.ws + WS_S5WS) + ((size_t)(l * 16 + g) * 128 + pt * 32 + c0) * 1024 + 8 * h;
    f32x16 acc = zero16();
#pragma unroll 8
    for (int s = 0; s < 64; ++s) acc = __builtin_amdgcn_mfma_f32_32x32x16_bf16(ldg8(ua + (size_t)s * DIN), ldg8(wb + s * 16), acc, 0, 0, 0);
    float* HL = (float*)(p.ws + WS_S5H);
#pragma unroll
    for (int i = 0; i < 16; ++i) HL[((size_t)(cb * 32 + crow(i, h)) * 16 + g) * 128 + pt * 32 + c0] = acc[i];
}
DI void s5_scan_item(const Params& p, int l, int sb) {
    int tid_o = threadIdx.x; asm volatile("" : "+v"(tid_o));
    const int e = sb * 512 + tid_o, b = e >> 10, g = (e >> 6) & 15, pp = e & 63;
    float lrdt, lidt, cr, ci; s5_params(p, l * 16 + g, pp, lrdt, lidt, cr, ci);
    float ar, ai; s5_pow(lrdt, lidt, 64, ar, ai);
    const float* HL = (const float*)(p.ws + WS_S5H); float* HO = (float*)(p.ws + WS_S5H2); float hr = 0.f, hi = 0.f;
    for (int c8 = 0; c8 < 128; c8 += 16) { float tr[16], ti[16];
#pragma unroll
        for (int u = 0; u < 16; ++u) { const size_t idx = ((size_t)(b * 128 + c8 + u) * 16 + g) * 128; tr[u] = HL[idx + pp]; ti[u] = HL[idx + 64 + pp]; }
#pragma unroll
        for (int u = 0; u < 16; ++u) { const size_t idx = ((size_t)(b * 128 + c8 + u) * 16 + g) * 128; HO[idx + pp] = hr; HO[idx + 64 + pp] = hi;
            const float nr = ar * hr - ai * hi + tr[u], ni = ar * hi + ai * hr + ti[u]; hr = nr; hi = ni; } }
}
DI void s5_out_item(const Params& p, LAS unsigned char* lds, int l, int bi) {
    int tid_o = threadIdx.x; asm volatile("" : "+v"(tid_o));
    const int tid = tid_o, lane = tid & 63, wave = tid >> 6;
    const int gh = bi & 1, cb = (bi >> 1) & 15, pr = bi >> 5, g = gh * 8 + wave, c0 = lane & 31, h = lane >> 5, lg = l * 16 + g;
    LAS bf16_t* OT = (LAS bf16_t*)lds;
    const bf16_t* Z = (const bf16_t*)(p.ws + WS_Z);
    const bf16_t* ua = Z + (size_t)((cb * 32 + c0) * 64) * DIN + ZCU + g * 16 + 8 * h;
    const bf16_t* kt = (const bf16_t*)(p.ws + WS_S5K) + (size_t)lg * 64 * 256;
    const float* ha = (const float*)(p.ws + WS_S5H2) + ((size_t)(cb * 32 + c0) * 16 + g) * 128 + 8 * h;
    const int co = c0 & 15; const float dsk = p.in[I_S5D][l * 256 + g * 16 + co];
    __syncthreads();
    for (int q = 0; q < 2; ++q) { const int jt = q ? 31 - pr : pr; const int tl = 2 * jt + (c0 >> 4);
        f32x16 acc = zero16();
        const bf16_t* wc = (const bf16_t*)(p.ws + WS_S5WC) + (((size_t)lg * 64 + tl) * 16 + co) * 128 + 8 * h;
        { f32x4 x0[8], x1[8]; bf16x8 wv[8];
#pragma unroll
          for (int ks = 0; ks < 8; ++ks) { x0[ks] = *(const f32x4*)(ha + ks * 16); x1[ks] = *(const f32x4*)(ha + ks * 16 + 4); wv[ks] = ldg8(wc + ks * 16); }
#pragma unroll
          for (int ks = 0; ks < 8; ++ks) { u32x4 w; w.x = pk2(x0[ks][0], x0[ks][1]); w.y = pk2(x0[ks][2], x0[ks][3]); w.z = pk2(x1[ks][0], x1[ks][1]); w.w = pk2(x1[ks][2], x1[ks][3]);
            acc = __builtin_amdgcn_mfma_f32_32x32x16_bf16(__builtin_bit_cast(bf16x8, w), wv[ks], acc, 0, 0, 0); } }
        const int ns = (2 * jt + 2 + 7) & ~7;
        for (int s0 = 0; s0 < ns; s0 += 8) { bf16x8 av[8], bv[8];
#pragma unroll
            for (int e = 0; e < 8; ++e) { const int s = s0 + e, d = tl - s, dc = d < 0 ? 0 : d;
                av[e] = ldg8(ua + (size_t)s * DIN); bv[e] = ldg8(kt + ((size_t)dc * 16 + co) * 16 + 8 * h); }
#pragma unroll
            for (int e = 0; e < 8; ++e) { const int d = tl - (s0 + e); bf16x8 b = bv[e]; if (d < 0) b = (bf16x8){0, 0, 0, 0, 0, 0, 0, 0};
                acc = __builtin_amdgcn_mfma_f32_32x32x16_bf16(av[e], b, acc, 0, 0, 0); } }
#pragma unroll
        for (int i = 0; i < 16; ++i) { const int m = crow(i, h); const size_t tok = (size_t)(cb * 32 + m) * 64 + tl; const float u = bf2f(Z[tok * DIN + ZCU + g * 16 + co]);
            const float y = acc[i] + dsk * u; const float ge = y * sigmoidf_(1.5957691216057308f * (y + 0.044715f * y * y * y));
            OT[(q * 64 + m * 2 + (c0 >> 4)) * 136 + wave * 16 + co] = (bf16_t)f2bf(ge); }
    }
    __syncthreads();
    { const int tau = tid >> 2, qq = tau >> 6, m = (tau >> 1) & 31, t2 = tau & 1, qt = tid & 3; const int jt = qq ? 31 - pr : pr;
      const size_t tok = (size_t)(cb * 32 + m) * 64 + 2 * jt + t2;
      const LAS u32x4* src = (const LAS u32x4*)(OT + tau * 136 + qt * 32); u32x4* dst = (u32x4*)((bf16_t*)(p.ws + WS_YPRE) + tok * 256 + gh * 128 + qt * 32);
#pragma unroll
      for (int e = 0; e < 4; ++e) dst[e] = src[e]; }
}

DI void attn_item(const Params& p, LAS unsigned char* lds, int l, int pt, int id) {
    int tid_o = threadIdx.x; asm volatile("" : "+v"(tid_o));
    const int tid = tid_o, lane = tid & 63, wave = tid >> 6;
    const int dil = pt == 0 ? 1 : (pt == 1 ? 4 : 16), nblk = 32 / dil;
    const int b = id >> 7, hd = (id >> 5) & 3, rn = id & 31, r = rn / nblk, n = rn % nblk;
    LAS bf16_t* Ks = (LAS bf16_t*)lds;
    LAS bf16_t* Vt = (LAS bf16_t*)(lds + 55296);
    LAS float* BT = (LAS float*)(lds + 55296 + 50176);
    const bf16_t* Z = (const bf16_t*)(p.ws + WS_Z);
    const bf16_t* OP = (const bf16_t*)(p.ws + (pt == 1 ? WS_O0 : WS_O1)); const float* LP = (const float*)(p.ws + (pt == 1 ? WS_LSE : WS_LSE1));
    bf16_t* ON = pt == 2 ? (bf16_t*)(p.ws + WS_Z) + ZOD : (bf16_t*)(p.ws + (pt == 0 ? WS_O0 : WS_O1)); const int onp = pt == 2 ? DIN : 256;
    float* LN = (float*)(p.ws + (pt == 0 ? WS_LSE : WS_LSE1));
    const size_t tokb = (size_t)b * SEQ;
    const int c0 = lane & 31, h = lane >> 5;
    const int qi = 32 * wave + c0; const size_t tokq = tokb + (size_t)(n * 256 + qi) * dil + r;
    u32x4 qraw[4]; u32x2 oprev[2][4]; float mprev = 0.f;
#pragma unroll
    for (int ks = 0; ks < 4; ++ks) qraw[ks] = *(const u32x4*)(Z + tokq * DIN + ZDQ + hd * 64 + ks * 16 + 8 * h);
    if (pt > 0) { mprev = LP[tokq * 4 + hd];
#pragma unroll
        for (int vt = 0; vt < 2; ++vt)
#pragma unroll
            for (int g4 = 0; g4 < 4; ++g4) oprev[vt][g4] = *(const u32x2*)(OP + tokq * 256 + hd * 64 + 32 * vt + 8 * g4 + 4 * h); }
    __syncthreads();
    if (tid < 132) BT[tid] = ((const float*)(p.ws + WS_BIAS))[(pt * 4 + hd) * 132 + tid];
    { const float* kg = p.in[I_KG] + l * 64 + (tid & 7) * 8; float kgv[8];
#pragma unroll
      for (int e = 0; e < 8; ++e) kgv[e] = kg[e];
      u32x4 kwv[6], vwv[6];
#pragma unroll
      for (int it = 0; it < 6; ++it) { const int idx = tid + 512 * it, row = idx >> 3, c = idx & 7, si = n * 256 - 128 + row;
        const size_t tok = tokb + (size_t)(si < 0 ? 0 : si) * dil + r;
        kwv[it] = *(const u32x4*)(Z + tok * DIN + ZDK + hd * 64 + c * 8); vwv[it] = *(const u32x4*)(Z + tok * DIN + ZDV + hd * 64 + c * 8); }
#pragma unroll
      for (int it = 0; it < 6; ++it) { const int idx = tid + 512 * it, row = idx >> 3, c = idx & 7, si = n * 256 - 128 + row;
        u32x4 kw = kwv[it], vw = vwv[it];
        if (si < 0) { kw = (u32x4){0u, 0u, 0u, 0u}; vw = (u32x4){0u, 0u, 0u, 0u}; }
        float kf[8]; kf[0] = bflo(kw.x); kf[1] = bfhi(kw.x); kf[2] = bflo(kw.y); kf[3] = bfhi(kw.y); kf[4] = bflo(kw.z); kf[5] = bfhi(kw.z); kf[6] = bflo(kw.w); kf[7] = bfhi(kw.w);
        float ss = 0.f;
#pragma unroll
        for (int e = 0; e < 8; ++e) ss += kf[e] * kf[e];
        ss += __shfl_xor(ss, 1); ss += __shfl_xor(ss, 2); ss += __shfl_xor(ss, 4);
        const float rs = rsqrtf(ss * (1.0f / 64.0f) + EPS);
        u32x4 o; o.x = pk2(kf[0] * rs * kgv[0], kf[1] * rs * kgv[1]); o.y = pk2(kf[2] * rs * kgv[2], kf[3] * rs * kgv[3]); o.z = pk2(kf[4] * rs * kgv[4], kf[5] * rs * kgv[5]); o.w = pk2(kf[6] * rs * kgv[6], kf[7] * rs * kgv[7]);
        *(LAS u32x4*)(Ks + row * 72 + c * 8) = o;
        LAS bf16_t* vp = Vt + (c * 8) * 392 + row;
        vp[0 * 392] = (bf16_t)(vw.x & 0xffffu); vp[1 * 392] = (bf16_t)(vw.x >> 16); vp[2 * 392] = (bf16_t)(vw.y & 0xffffu); vp[3 * 392] = (bf16_t)(vw.y >> 16);
        vp[4 * 392] = (bf16_t)(vw.z & 0xffffu); vp[5 * 392] = (bf16_t)(vw.z >> 16); vp[6 * 392] = (bf16_t)(vw.w & 0xffffu); vp[7 * 392] = (bf16_t)(vw.w >> 16); } }
    __syncthreads();
    bf16x8 qf[4];
    { float qv[4][8]; float ss = 0.f;
#pragma unroll
      for (int ks = 0; ks < 4; ++ks) { const u32x4 w = qraw[ks];
        qv[ks][0] = bflo(w.x); qv[ks][1] = bfhi(w.x); qv[ks][2] = bflo(w.y); qv[ks][3] = bfhi(w.y); qv[ks][4] = bflo(w.z); qv[ks][5] = bfhi(w.z); qv[ks][6] = bflo(w.w); qv[ks][7] = bfhi(w.w);
#pragma unroll
        for (int e = 0; e < 8; ++e) ss += qv[ks][e] * qv[ks][e]; }
      ss += __shfl_xor(ss, 32);
      const float rs = rsqrtf(ss * (1.0f / 64.0f) + EPS) * 0.125f;
#pragma unroll
      for (int ks = 0; ks < 4; ++ks) { const float* qg = p.in[I_QG] + l * 64 + ks * 16 + 8 * h; const f32x4 g0 = *(const f32x4*)qg, g1 = *(const f32x4*)(qg + 4);
        u32x4 w; w.x = pk2(qv[ks][0] * rs * g0[0], qv[ks][1] * rs * g0[1]); w.y = pk2(qv[ks][2] * rs * g0[2], qv[ks][3] * rs * g0[3]);
        w.z = pk2(qv[ks][4] * rs * g1[0], qv[ks][5] * rs * g1[1]); w.w = pk2(qv[ks][6] * rs * g1[2], qv[ks][7] * rs * g1[3]);
        qf[ks] = __builtin_bit_cast(bf16x8, w); } }
    f32x16 acc[5];
#pragma unroll
    for (int c = 0; c < 5; ++c) { acc[c] = zero16(); const LAS bf16_t* kb = Ks + (32 * wave + 32 * c + c0) * 72 + 8 * h;
#pragma unroll
        for (int ks = 0; ks < 4; ++ks) acc[c] = __builtin_amdgcn_mfma_f32_32x32x16_bf16(*(const LAS bf16x8*)(kb + ks * 16), qf[ks], acc[c], 0, 0, 0); }
    float mx = -1e30f;
#pragma unroll
    for (int c = 0; c < 5; ++c)
#pragma unroll
        for (int i = 0; i < 16; ++i) { const int kr = crow(i, h); const int delta = 128 + c0 - 32 * c - kr; const int jl = 32 * wave + 32 * c + kr;
            const bool valid = (delta >= 0) && (delta <= 128) && (n * 256 - 128 + jl >= 0);
            const int dcl = delta < 0 ? 0 : (delta > 128 ? 128 : delta);
            const float lgt = valid ? acc[c][i] + BT[dcl] : -1e30f; acc[c][i] = lgt; mx = fmaxf(mx, lgt); }
    mx = fmaxf(mx, __shfl_xor(mx, 32));
    float mnew = mx;
    if (pt > 0) mnew = fmaxf(mx, mprev);
    float lsum = 0.f;
#pragma unroll
    for (int c = 0; c < 5; ++c)
#pragma unroll
        for (int i = 0; i < 16; ++i) { const float pv = __expf(acc[c][i] - mnew); acc[c][i] = pv; lsum += pv; }
    lsum += __shfl_xor(lsum, 32);
    f32x16 o[2]; o[0] = zero16(); o[1] = zero16();
#pragma unroll
    for (int c = 0; c < 5; ++c)
#pragma unroll
        for (int s = 0; s < 2; ++s) { u32x4 pw; pw.x = pk2(acc[c][8 * s + 0], acc[c][8 * s + 1]); pw.y = pk2(acc[c][8 * s + 2], acc[c][8 * s + 3]); pw.z = pk2(acc[c][8 * s + 4], acc[c][8 * s + 5]); pw.w = pk2(acc[c][8 * s + 6], acc[c][8 * s + 7]);
            const bf16x8 pf = __builtin_bit_cast(bf16x8, pw);
#pragma unroll
            for (int vt = 0; vt < 2; ++vt) { const LAS bf16_t* va = Vt + (32 * vt + c0) * 392 + 32 * wave + 32 * c + 16 * s + 4 * h;
                const s16x4 lo = *(const LAS s16x4*)va, hi = *(const LAS s16x4*)(va + 8);
                const bf16x8 vf = __builtin_shufflevector(lo, hi, 0, 1, 2, 3, 4, 5, 6, 7);
                o[vt] = __builtin_amdgcn_mfma_f32_32x32x16_bf16(vf, pf, o[vt], 0, 0, 0); } }
    float sp = 0.f; if (pt > 0) sp = __expf(mprev - mnew);
    const float ltot = lsum + sp, inv = 1.0f / ltot;
#pragma unroll
    for (int vt = 0; vt < 2; ++vt)
#pragma unroll
        for (int g4 = 0; g4 < 4; ++g4) { const int ch = hd * 64 + 32 * vt + 8 * g4 + 4 * h; bf16_t* yo = ON + tokq * onp + ch;
            float v0 = o[vt][4 * g4 + 0], v1 = o[vt][4 * g4 + 1], v2 = o[vt][4 * g4 + 2], v3 = o[vt][4 * g4 + 3];
            if (pt > 0) { const u32x2 w = oprev[vt][g4]; v0 += sp * bflo(w.x); v1 += sp * bfhi(w.x); v2 += sp * bflo(w.y); v3 += sp * bfhi(w.y); }
            u32x2 w; w.x = pk2(v0 * inv, v1 * inv); w.y = pk2(v2 * inv, v3 * inv); *(u32x2*)yo = w; }
    if (h == 0 && pt < 2) __hip_atomic_store(LN + tokq * 4 + hd, mnew + __logf(ltot), __ATOMIC_RELAXED, __HIP_MEMORY_SCOPE_AGENT);
}

#define RLX_AGENT __ATOMIC_RELAXED, __HIP_MEMORY_SCOPE_AGENT
#define XB_TMO      128
#define XB_XCNT(j)  (256  + 64 * (j))
#define XB_XSUB(j)  (1280 + 64 * (j))
#define XB_XGEN(j)  (2304 + 64 * (j))
#define XB_TOP      3328
#define XB_TOPGEN   3392
#define XCD_BAR_WORDS 3456
#define XB_SPIN_CAP (1u << 18)

__device__ __forceinline__ unsigned xb_ld(unsigned* p)              { return __hip_atomic_load(p, __ATOMIC_RELAXED, __HIP_MEMORY_SCOPE_AGENT); }
__device__ __forceinline__ unsigned xb_add(unsigned* p, unsigned v) { return __hip_atomic_fetch_add(p, v, __ATOMIC_RELAXED, __HIP_MEMORY_SCOPE_AGENT); }
__device__ __forceinline__ unsigned xb_xcc_id() { return (unsigned)__builtin_amdgcn_s_getreg((3 << 11) | 20) & 0xFu; }
#define XB_SPIN(cond, bar) do { unsigned _sp = 0; while (cond) { __builtin_amdgcn_s_sleep(1); \
    if ((++_sp & 255u) == 0u) { if (xb_ld(&(bar)[XB_TMO])) break; if (_sp > XB_SPIN_CAP) { atomicAdd(&(bar)[XB_TMO], 1u); break; } } } } while (0)

struct XcdBarrier {
    unsigned* bar; unsigned x;
    volatile LAS unsigned* st;
};

__device__ __forceinline__ XcdBarrier xcd_barrier_post(unsigned* bar, volatile LAS unsigned* st) {
    XcdBarrier b; b.bar = bar; b.x = xb_xcc_id(); b.st = st;
    if (threadIdx.x == 0) (void)xb_add(&bar[XB_XCNT(b.x)], 1u);
    return b;
}
__device__ __forceinline__ void xcd_barrier_complete(unsigned* bar, unsigned x, unsigned& nloc, unsigned& nx) {
    const unsigned G = gridDim.x * gridDim.y * gridDim.z;
    unsigned sum, cnt, mine, sp = 0u;
    for (;;) {
        sum = 0u; cnt = 0u; mine = 0u;
#pragma unroll
        for (unsigned j = 0; j < 16; ++j) { const unsigned c = xb_ld(&bar[XB_XCNT(j)]); sum += c; cnt += (c > 0u) ? 1u : 0u; mine = (j == x) ? c : mine; }
        if (sum == G) break;
        __builtin_amdgcn_s_sleep(1);
        if ((++sp & 255u) == 0u) { if (xb_ld(&bar[XB_TMO])) break; if (sp > XB_SPIN_CAP) { atomicAdd(&bar[XB_TMO], 1u); break; } }
    }
    nloc = mine > 0u ? mine : 1u; nx = cnt > 0u ? cnt : 1u;
}

__device__ __forceinline__ void xcd_barrier(const XcdBarrier& b) {
    asm volatile("s_waitcnt vmcnt(0)" ::: "memory");
    __syncthreads();
    if (threadIdx.x == 0) {
        unsigned* bar = b.bar;
        __builtin_amdgcn_s_waitcnt(0);
        unsigned nloc = b.st[0], nx = b.st[1];
        if (nloc == 0u) { xcd_barrier_complete(bar, b.x, nloc, nx); b.st[0] = nloc; b.st[1] = nx; }
        const unsigned old = xb_add(&bar[XB_XSUB(b.x)], 1u);
        const unsigned gen = old / nloc;
        if (old + 1u == (gen + 1u) * nloc) {
            __builtin_amdgcn_fence(__ATOMIC_RELEASE, "agent");
            asm volatile("s_waitcnt vmcnt(0)" ::: "memory");
            const unsigned og = xb_add(&bar[XB_TOP], 1u);
            const unsigned tg = og / nx;
            if (og + 1u == (tg + 1u) * nx) xb_add(&bar[XB_TOPGEN], 1u);
            else XB_SPIN(xb_ld(&bar[XB_TOPGEN]) == tg, bar);
            __builtin_amdgcn_fence(__ATOMIC_ACQUIRE, "agent");
            xb_add(&bar[XB_XGEN(b.x)], 1u);
            asm volatile("s_waitcnt vmcnt(0)" ::: "memory");
        } else {
            XB_SPIN(xb_ld(&bar[XB_XGEN(b.x)]) == gen, bar);
            __builtin_amdgcn_fence(__ATOMIC_ACQUIRE, "agent");
            asm volatile("s_waitcnt vmcnt(0)" ::: "memory");
        }
    }
    __syncthreads();
}

#ifndef REP_A
#define REP_A 0
#endif
#ifndef REP_B
#define REP_B 0
#endif
#ifndef REP_C
#define REP_C 0
#endif
#ifndef REP_D
#define REP_D 0
#endif
#ifndef MIX_A
#define MIX_A 1
#endif
#ifndef MIX_B
#define MIX_B 1
#endif
#ifndef MIX_C
#define MIX_C 1
#endif
#ifndef MIX_D
#define MIX_D 1
#endif
__global__ void __launch_bounds__(512, 2) hybrid_fwd(Params p) {
    extern __shared__ __attribute__((aligned(16))) unsigned char lds_raw[];
    LAS unsigned char* lds = (LAS unsigned char*)lds_raw;
    cg::grid_group grid = cg::this_grid();
    { volatile LAS unsigned* st0 = (volatile LAS unsigned*)(lds + LDS_BYTES - 64); if (threadIdx.x < 2) st0[threadIdx.x] = 0u; }
    __syncthreads();
    XcdBarrier xbar = xcd_barrier_post((unsigned*)(p.ws + WS_BAR), (volatile LAS unsigned*)(lds + LDS_BYTES - 64));
    const int G = gridDim.x, bid = blockIdx.x;
    unsigned char* ws = p.ws;
    bf16_t* XB = (bf16_t*)(ws + WS_XB); bf16_t* Zb = (bf16_t*)(ws + WS_Z); bf16_t* YC_ = (bf16_t*)(ws + WS_YCAT); bf16_t* HM = (bf16_t*)(ws + WS_HM);
    float* SSQP = (float*)(ws + WS_SSQP);

#define GRID_SYNC_() do { asm volatile("s_waitcnt vmcnt(0) lgkmcnt(0)" ::: "memory"); grid.sync(); if (threadIdx.x < 64) { __builtin_amdgcn_fence(__ATOMIC_ACQUIRE, "agent"); asm volatile("s_waitcnt vmcnt(0)" ::: "memory"); } __syncthreads(); } while (0)
#ifdef REP_SYNC
#define GRID_SYNC() do { xcd_barrier(xbar); xcd_barrier(xbar); } while (0)
#else
#define GRID_SYNC() xcd_barrier(xbar)
#endif
    prologue(p, lds, G);
#ifdef REP_PRO
    GRID_SYNC_(); prologue(p, lds, G);
#endif
#ifdef NANFILL
    { u32x4* q = (u32x4*)(ws + WS_S5H); const size_t n16 = (WS_END - WS_S5H) / 16; const u32x4 nanv = (u32x4){0xffffffffu, 0xffffffffu, 0xffffffffu, 0xffffffffu};
      for (size_t i = (size_t)bid * 512 + threadIdx.x; i < n16; i += (size_t)G * 512) q[i] = nanv;
      u32x4* q2 = (u32x4*)(ws + WS_LSE); const size_t m16 = (WS_S5K - WS_LSE) / 16;
      for (size_t i = (size_t)bid * 512 + threadIdx.x; i < m16; i += (size_t)G * 512) q2[i] = nanv; }
#endif
    if (gridDim.y == 0x7fffffffu) GRID_SYNC_();
    GRID_SYNC();

#ifndef NL_RUN
#define NL_RUN NL
#endif
#ifndef DUMP_LAYER
#define DUMP_LAYER 0
#endif
    for (int lrun = 0; lrun < NL_RUN; ++lrun) {
#ifdef SAME_LAYER
        const int l = 0; const bool firstl = (lrun == 0), lastl = (lrun == NL_RUN - 1);
#else
        const int l = lrun; const bool firstl = (lrun == 0), lastl = (lrun == NL_RUN - 1);
#endif
        { pg8::Gemm g{XB, (const bf16_t*)(ws + WS_WIN) + (size_t)l * D * DIN, T, DIN, D, D}; pg8::StaticOrder S; S.init(T, DIN, G, bid);
          pg8::EpiScale E{Zb, DIN, SSQP, 0};
          pg8::gemm_phase<pg8::EpiScale, pg8::StaticOrder, true, true>(lds, g, S, E);
#ifdef REPEAT_GEMM
          GRID_SYNC(); pg8::gemm_phase<pg8::EpiScale, pg8::StaticOrder, true, true>(lds, g, S, E);
#endif
        }
        GRID_SYNC();
#ifndef SKIP_MIX
        if (!(MIX_A && MIX_B && MIX_C && MIX_D)) { int tq = threadIdx.x; asm volatile("" : "+v"(tq));
          for (int m = bid * 8 + (tq >> 6); m < T; m += G * 8) { u32x2* yp = (u32x2*)(YC_ + (size_t)m * D) + (tq & 63); const u32x2 z2 = (u32x2){0u, 0u};
              if (!MIX_A) yp[0] = z2; if (!MIX_B) yp[64] = z2; if (!MIX_C) yp[128] = z2; if (!MIX_D) yp[192] = z2; } }
#ifndef MIX_REPEAT
#define MIX_REPEAT 1
#endif
        for (int rep = 0; rep < MIX_REPEAT; ++rep) {
        for (int it = bid; it < 1664; it += G) {
            if (it < 512) { if (MIX_A) { hgrn_item<false>(p, lds, l, it); if (REP_A) hgrn_item<false>(p, lds, l, it); } }
            else if (it < 1024) { if (MIX_B) { conv_item(p, lds, l, it - 512); if (REP_B) conv_item(p, lds, l, it - 512); } }
            else if (it < 1152) { if (MIX_C) { s5_local_item(p, l, it - 1024); if (REP_C) s5_local_item(p, l, it - 1024); } }
            else { if (MIX_D) { attn_item(p, lds, l, 0, it - 1152); if (REP_D) attn_item(p, lds, l, 0, it - 1152); } }
        }
        GRID_SYNC();
        for (int it = bid; it < 648; it += G) {
            if (it < 128) { if (MIX_A) hgrn_scan_item(p, it); }
            else if (it < 136) { if (MIX_C) s5_scan_item(p, l, it - 128); }
            else { if (MIX_D) { attn_item(p, lds, l, 1, it - 136); if (REP_D) attn_item(p, lds, l, 1, it - 136); } }
        }
        GRID_SYNC();
#ifdef REP_P3
        for (int it = bid; it < 648; it += G) {
            if (it < 128) { if (MIX_A) hgrn_scan_item(p, it); }
            else if (it < 136) { if (MIX_C) s5_scan_item(p, l, it - 128); }
            else { if (MIX_D) { attn_item(p, lds, l, 1, it - 136); if (REP_D) attn_item(p, lds, l, 1, it - 136); } }
        }
        GRID_SYNC();
#endif
        for (int it = bid; it < 1536; it += G) {
            if (it < 512) { if (MIX_A) { hgrn_item<true>(p, lds, l, it); if (REP_A) hgrn_item<true>(p, lds, l, it); } }
            else if (it < 1024) { if (MIX_C) { s5_out_item(p, lds, l, it - 512); if (REP_C) s5_out_item(p, lds, l, it - 512); } }
            else { if (MIX_D) { attn_item(p, lds, l, 2, it - 1024); if (REP_D) attn_item(p, lds, l, 2, it - 1024); } }
        }
        GRID_SYNC();
        }
#ifndef NO_GLU
        { pg8::Gemm g{(const bf16_t*)(ws + WS_YPRE), (const bf16_t*)(ws + WS_WGLU) + (size_t)l * 65536, T, 256, 256, 256}; pg8::StaticOrder S; S.init(T, 256, G, bid);
          pg8::EpiGlu E{(const bf16_t*)(ws + WS_YPRE), 256, YC_ + YC};
          pg8::gemm_phase<pg8::EpiGlu, pg8::StaticOrder, false, true>(lds, g, S, E); }
#endif
        { int tq = threadIdx.x; asm volatile("" : "+v"(tq)); const int lane = tq & 63; const int gw = bid * 8 + (tq >> 6), NGW = G * 8;
          for (int m = gw; m < T; m += NGW) { u32x2* yp = (u32x2*)(YC_ + (size_t)m * D + YD) + lane; const u32x2 w = *((const u32x2*)(Zb + (size_t)m * DIN + ZOD) + lane);
              const float a0 = bflo(w.x), a1 = bfhi(w.x), a2 = bflo(w.y), a3 = bfhi(w.y);
              const float ss = wave_sum((a0 * a0 + a1 * a1) + (a2 * a2 + a3 * a3)); const float rs = rsqrtf(ss * (1.0f / 256.0f) + EPS);
              u32x2 o; o.x = pk2(a0 * rs, a1 * rs); o.y = pk2(a2 * rs, a3 * rs); *yp = o; } }
        GRID_SYNC();
#endif
#ifdef REP_P5
#ifndef NO_GLU
        { pg8::Gemm g{(const bf16_t*)(ws + WS_YPRE), (const bf16_t*)(ws + WS_WGLU) + (size_t)l * 65536, T, 256, 256, 256}; pg8::StaticOrder S; S.init(T, 256, G, bid);
          pg8::EpiGlu E{(const bf16_t*)(ws + WS_YPRE), 256, YC_ + YC};
          pg8::gemm_phase<pg8::EpiGlu, pg8::StaticOrder, false, true>(lds, g, S, E); }
#endif
        { int tq = threadIdx.x; asm volatile("" : "+v"(tq)); const int lane = tq & 63; const int gw = bid * 8 + (tq >> 6), NGW = G * 8;
          for (int m = gw; m < T; m += NGW) { u32x2* yp = (u32x2*)(YC_ + (size_t)m * D + YD) + lane; const u32x2 w = *((const u32x2*)(Zb + (size_t)m * DIN + ZOD) + lane);
              const float a0 = bflo(w.x), a1 = bfhi(w.x), a2 = bflo(w.y), a3 = bfhi(w.y);
              const float ss = wave_sum((a0 * a0 + a1 * a1) + (a2 * a2 + a3 * a3)); const float rs = rsqrtf(ss * (1.0f / 256.0f) + EPS);
              u32x2 o; o.x = pk2(a0 * rs, a1 * rs); o.y = pk2(a2 * rs, a3 * rs); *yp = o; } }
        GRID_SYNC();
#endif
#ifdef DUMP_SLICE
        if (lrun == DUMP_LAYER) { int tq = threadIdx.x; asm volatile("" : "+v"(tq));
          for (int m = bid * 8 + (tq >> 6); m < T; m += G * 8) { const int ln = tq & 63;
              for (int j = 0; j < 4; ++j) { const int col = j * 256 + ln * 4; const u32x2 w = *(const u32x2*)(YC_ + (size_t)m * D + col);
                  f32x4 o = (f32x4){0.f, 0.f, 0.f, 0.f}; if (j == DUMP_SLICE) o = (f32x4){bflo(w.x), bfhi(w.x), bflo(w.y), bfhi(w.y)};
                  *(f32x4*)(p.out + (size_t)m * D + col) = o; } }
          break; }
#endif
#ifdef SKIP_MIX
        { pg8::Gemm g{Zb, (const bf16_t*)(ws + WS_WOUT) + (size_t)l * D * D, T, D, D, DIN}; pg8::StaticOrder S; S.init(T, D, G, bid);
#else
        { pg8::Gemm g{YC_, (const bf16_t*)(ws + WS_WOUT) + (size_t)l * D * D, T, D, D, D}; pg8::StaticOrder S; S.init(T, D, G, bid);
#endif
          pg8::EpiRes E{firstl ? p.in[I_X] : p.out, p.out, XB, SSQP + (size_t)T * 16};
          pg8::gemm_phase<pg8::EpiRes, pg8::StaticOrder, true, true>(lds, g, S, E); }
        GRID_SYNC();
        { pg8::Gemm g{XB, (const bf16_t*)(ws + WS_WUP) + (size_t)l * D * FF, T, FF, D, D}; pg8::StaticOrder S; S.init(T, FF, G, bid);
          pg8::EpiScale E{HM, FF, SSQP + (size_t)T * 16, 1};
          pg8::gemm_phase<pg8::EpiScale, pg8::StaticOrder, true, true>(lds, g, S, E);
#ifdef REPEAT_GEMM
          GRID_SYNC(); pg8::gemm_phase<pg8::EpiScale, pg8::StaticOrder, true, true>(lds, g, S, E);
#endif
        }
        GRID_SYNC();
        { pg8::Gemm g{HM, (const bf16_t*)(ws + WS_WDN) + (size_t)l * D * FF, T, D, FF, FF}; pg8::StaticOrder S; S.init(T, D, G, bid);
          pg8::EpiRes E{p.out, p.out, XB, !lastl ? SSQP : nullptr};
          pg8::gemm_phase<pg8::EpiRes, pg8::StaticOrder, true, true>(lds, g, S, E); }
        if (!lastl) GRID_SYNC();
    }
}

extern "C" void kernel_launch(void* const* d_in, const int* in_sizes, int n_in, void* d_out, int out_size, void* d_ws, size_t ws_size, hipStream_t stream) {
    static int grid = 0;
    if (grid == 0) {
        if (n_in != 26 || out_size != T * D || ws_size < WS_END) { fprintf(stderr, "kernel_launch: unexpected shapes (n_in %d, out %d, ws %zu); nothing launched\n", n_in, out_size, ws_size); grid = -1; return; }
        int dev = 0, cus = 0, per_cu = 0;
        (void)hipGetDevice(&dev); (void)hipDeviceGetAttribute(&cus, hipDeviceAttributeMultiprocessorCount, dev);
        if (hipFuncSetAttribute((const void*)hybrid_fwd, hipFuncAttributeMaxDynamicSharedMemorySize, LDS_BYTES) != hipSuccess) { fprintf(stderr, "kernel_launch: hipFuncSetAttribute failed\n"); grid = -1; return; }
        if (hipOccupancyMaxActiveBlocksPerMultiprocessor(&per_cu, (const void*)hybrid_fwd, 512, LDS_BYTES) != hipSuccess || per_cu < 1) { fprintf(stderr, "kernel_launch: occupancy query gave %d\n", per_cu); per_cu = 1; }
        (void)hipGetLastError();
        if (cus <= 0) cus = 256;
        grid = cus * per_cu;
    }
    if (grid < 0) return;
    if (hipMemsetAsync((char*)d_ws + WS_BAR, 0, XCD_BAR_WORDS * 4, stream) != hipSuccess) { fprintf(stderr, "kernel_launch: hipMemsetAsync of the barrier words failed\n"); return; }
    Params a{};
    for (int i = 0; i < 26; ++i) a.in[i] = (const float*)d_in[i];
    a.out = (float*)d_out; a.ws = (unsigned char*)d_ws;
    void* args[] = {&a};
    hipError_t e = hipLaunchCooperativeKernel((const void*)hybrid_fwd, dim3(grid), dim3(512), args, LDS_BYTES, stream);
    if (e != hipSuccess) fprintf(stderr, "cooperative launch failed: %s (grid %d)\n", hipGetErrorString(e), grid);
}
```

```cpp
#include <hip/hip_runtime.h>
#include <hip/hip_cooperative_groups.h>
#include <cstdio>
#include <cstdint>
namespace cg = cooperative_groups;

#define DI __device__ __forceinline__
#define LAS __attribute__((address_space(3)))
typedef unsigned short bf16_t;
typedef short bf16x8 __attribute__((ext_vector_type(8)));
typedef short s16x4 __attribute__((ext_vector_type(4)));
typedef float f32x4 __attribute__((ext_vector_type(4)));
typedef float f32x16 __attribute__((ext_vector_type(16)));
typedef unsigned u32x4 __attribute__((ext_vector_type(4)));
typedef unsigned u32x2 __attribute__((ext_vector_type(2)));

constexpr int NB = 4, SEQ = 8192, T = NB * SEQ, D = 1024, DIN = 2560, FF = 4096, NL = 4;
constexpr int ZQ = 0, ZF = 256, ZI = 512, ZG = 768, ZBV = 1024, ZBG = 1280, ZCU = 1536, ZDQ = 1792, ZDK = 2048, ZDV = 2304;
constexpr int YA = 0, YB = 256, YC = 512, YD = 768;
constexpr int ZOD = ZBG;
constexpr float EPS = 1e-6f;
constexpr size_t MiB = 1u << 20;
constexpr size_t WS_WIN = 0, WS_WOUT = 20 * MiB, WS_WUP = 28 * MiB, WS_WDN = 60 * MiB, WS_WGLU = 92 * MiB;
constexpr size_t WS_LB = 93 * MiB;
constexpr size_t WS_BIAS = WS_LB + 4096;
constexpr size_t WS_BAR = WS_LB + 32768;
constexpr size_t WS_SSQ = WS_LB + 65536;
constexpr size_t WS_LSE = WS_SSQ + 8 * (size_t)T * 4;
constexpr size_t WS_DEC = WS_LSE + (size_t)T * 16;
constexpr size_t WS_LSE1 = WS_DEC + 2048 * 64 * 4;
constexpr size_t WS_S5K = 96 * MiB;
constexpr size_t WS_S5WS = 98 * MiB;
constexpr size_t WS_S5WC = 114 * MiB;
constexpr size_t WS_XB = 130 * MiB;
constexpr size_t WS_S5H = 194 * MiB;
constexpr size_t WS_HM = 198 * MiB;
constexpr size_t WS_Z = 198 * MiB;
constexpr size_t WS_YCAT = 358 * MiB;
constexpr size_t WS_SL = 422 * MiB, WS_SL2 = 438 * MiB;
constexpr size_t WS_S5H2 = 454 * MiB;
constexpr size_t WS_O0 = 458 * MiB, WS_O1 = 474 * MiB;
constexpr size_t WS_YPRE = 490 * MiB;
constexpr size_t WS_SSQP = 506 * MiB;
constexpr size_t WS_END = 510 * MiB;
static_assert(WS_LSE1 + (size_t)T * 16 <= WS_S5K, "misc region");

constexpr int LDS_BYTES = 147456;

DI unsigned f2bf(float f) { unsigned u = __builtin_bit_cast(unsigned, f); return (u + 0x7fffu + ((u >> 16) & 1u)) >> 16; }
typedef float f32x2_t __attribute__((ext_vector_type(2))); typedef __bf16 bf16x2_t __attribute__((ext_vector_type(2)));
DI unsigned pk2(float lo, float hi) { const f32x2_t v = {lo, hi}; const bf16x2_t b = __builtin_convertvector(v, bf16x2_t); return __builtin_bit_cast(unsigned, b); }
DI float bf2f(bf16_t v) { return __builtin_bit_cast(float, (unsigned)v << 16); }
DI float bflo(unsigned w) { return __builtin_bit_cast(float, w << 16); }
DI float bfhi(unsigned w) { return __builtin_bit_cast(float, w & 0xffff0000u); }
DI float sigmoidf_(float x) { return 1.f / (1.f + __expf(-x)); }
DI float wave_sum(float v) {
#pragma unroll
    for (int o = 1; o < 64; o <<= 1) v += __shfl_xor(v, o);
    return v;
}
DI float half_sum(float v) {
#pragma unroll
    for (int o = 1; o < 32; o <<= 1) v += __shfl_xor(v, o);
    return v;
}
#define LDS_WAIT() asm volatile("s_waitcnt lgkmcnt(0)" ::: "memory")
DI int crow(int reg, int h) { return (reg & 3) + 8 * (reg >> 2) + 4 * h; }

template <int K>
DI f32x16 mma_lds(const LAS bf16_t* A, int lda, const LAS bf16_t* B, int ldb, f32x16 acc, int lane) {
    const int r = lane & 31, h = lane >> 5;
    const LAS bf16_t* ap = A + r * lda + 8 * h; const LAS bf16_t* bp = B + r * ldb + 8 * h;
#pragma unroll
    for (int k0 = 0; k0 < K; k0 += 16) {
        const bf16x8 a = *(const LAS bf16x8*)(ap + k0); const bf16x8 b = *(const LAS bf16x8*)(bp + k0);
        acc = __builtin_amdgcn_mfma_f32_32x32x16_bf16(a, b, acc, 0, 0, 0);
    }
    return acc;
}
DI f32x16 zero16() { f32x16 z;
#pragma unroll
    for (int i = 0; i < 16; ++i) z[i] = 0.f;
    return z; }

namespace pg8 {
#define PG8_LAS __attribute__((address_space(3)))
constexpr int BM = 256, BK = 64, HALF = 128, HTB = HALF * BK * 2, STAGE_BYTES = 8 * HTB, NXCD = 8, WGM = 8;
__host__ __device__ __forceinline__ int lds_byte(int r, int c) { const int st = (r >> 4) * 2 + (c >> 5), rr = r & 15, cc = c & 31, ob = rr * 64 + cc * 2; return st * 1024 + (ob ^ (((ob >> 9) & 1) << 5)); }
__host__ __device__ __forceinline__ void stage_rc(int b, int& R, int& C) { const int st = b / 1024, sb = b % 1024, swz = sb ^ (((sb >> 9) & 1) << 5); R = (st >> 1) * 16 + swz / 64; C = (st & 1) * 32 + (swz % 64) / 2; }
__host__ __device__ __forceinline__ int perm32(int rho) { const int n = rho >> 4, i = rho & 15; return 8 * (i >> 2) + 4 * n + (i & 3); }
struct Unit { int pm, pn; };
struct Gemm { const bf16_t* A; const bf16_t* Bt; int M, N, K, lda; };
struct StaticOrder {
    int nM, nN, nwg, G, c;
    __host__ __device__ __forceinline__ void init(int M, int N, int G_, int c_) { nM = M / BM; nN = N / BM; nwg = nM * nN; G = G_; c = c_; }
    __host__ __device__ __forceinline__ bool next(int i, Unit& u) const {
        const long L = (long)i * G + c; if (L >= nwg) return false;
        int wgid = (int)L; { const int q = nwg / NXCD, r = nwg % NXCD, xcd = wgid % NXCD, off = wgid / NXCD; wgid = (xcd < r ? xcd * (q + 1) : r * (q + 1) + (xcd - r) * q) + off; }
        const int nig = WGM * nN, gid = wgid / nig, fm = gid * WGM, gsz = (nM - fm) < WGM ? (nM - fm) : WGM;
        u.pm = fm + ((wgid % nig) % gsz); u.pn = (wgid % nig) / gsz; return true;
    }
    __device__ __forceinline__ void a_ready(const Unit&) const {}
    __device__ __forceinline__ void done(const Unit&) const {}
};
struct EpiScale {
    static constexpr bool PERM = true, AFTER_DRAIN = false;
    bf16_t* O; int ldc; int act; const PG8_LAS float* rsl;
    __device__ __forceinline__ void operator()(const f32x4 (&acc)[2][2][4][2], const Unit& u, int wr, int wc, int fr, int fq) const {
        const int row0 = u.pm * BM + wr * 64 + fr; const int col0 = u.pn * BM + wc * 32 + 8 * fq;
        const int slot = ((u.pm >> 3) & 1) * 256;
#pragma unroll
        for (int ai = 0; ai < 2; ++ai)
#pragma unroll
            for (int m = 0; m < 4; ++m) { const int r = row0 + ai * HALF + m * 16; float rs;
                rs = rsl[slot + ai * HALF + wr * 64 + m * 16 + fr];
                bf16_t* rowp = O + (size_t)r * ldc + col0;
#pragma unroll
                for (int bj = 0; bj < 2; ++bj) { f32x4 v0 = acc[ai][bj][m][0] * rs, v1 = acc[ai][bj][m][1] * rs;
                    if (act) {
#pragma unroll
                        for (int e = 0; e < 4; ++e) { const float a = fmaxf(v0[e], 0.f), b = fmaxf(v1[e], 0.f); v0[e] = a * a; v1[e] = b * b; } }
                    u32x4 w; w.x = pk2(v0[0], v0[1]); w.y = pk2(v0[2], v0[3]); w.z = pk2(v1[0], v1[1]); w.w = pk2(v1[2], v1[3]);
                    *(u32x4*)(rowp + bj * HALF) = w; } }
    }
};
struct EpiRes {
    static constexpr bool PERM = false, AFTER_DRAIN = false;
    const float* base; float* out; bf16_t* xb; float* ssq_out;
    __device__ __forceinline__ void operator()(const f32x4 (&acc)[2][2][4][2], const Unit& u, int wr, int wc, int fr, int fq) const {
        const int col0 = u.pn * BM + wc * 32 + 4 * fq;
#pragma unroll
        for (int ai = 0; ai < 2; ++ai)
#pragma unroll
            for (int m = 0; m < 4; ++m) { const int r = u.pm * BM + ai * HALF + wr * 64 + m * 16 + fr; const size_t off = (size_t)r * D + col0; float s = 0.f;
#pragma unroll
                for (int bj = 0; bj < 2; ++bj)
#pragma unroll
                    for (int n = 0; n < 2; ++n) { const size_t o2 = off + bj * HALF + n * 16; const f32x4 o = *(const f32x4*)(base + o2) + acc[ai][bj][m][n];
                        *(f32x4*)(out + o2) = o; u32x2 w; w.x = pk2(o[0], o[1]); w.y = pk2(o[2], o[3]); *(u32x2*)(xb + o2) = w;
                        s += (o[0] * o[0] + o[1] * o[1]) + (o[2] * o[2] + o[3] * o[3]); }
                s += __shfl_xor(s, 16); s += __shfl_xor(s, 32);
                if (fq == 0 && ssq_out) ssq_out[(size_t)r * 16 + u.pn * 4 + wc] = s; }
    }
};
struct EpiGlu {
    static constexpr bool PERM = false, AFTER_DRAIN = true;
    const bf16_t* Ysrc; int lds_; bf16_t* Y;
    __device__ __forceinline__ void fused(f32x4 (&acc)[2][2][4][2], const Unit& u, int wr, int wc, int fr, int fq, PG8_LAS unsigned char* lds, int wid, int lane) const {
        PG8_LAS float* Pp = (PG8_LAS float*)lds;
        const int col0 = wc * 32 + 4 * fq;
#pragma unroll
        for (int ai = 0; ai < 2; ++ai)
#pragma unroll
            for (int m = 0; m < 4; ++m) { const int rl = ai * HALF + wr * 64 + m * 16 + fr; const size_t off = (size_t)(u.pm * BM + rl) * lds_ + col0; float s = 0.f;
#pragma unroll
                for (int bj = 0; bj < 2; ++bj)
#pragma unroll
                    for (int n = 0; n < 2; ++n) { const u32x2 w = *(const u32x2*)(Ysrc + off + bj * HALF + n * 16); f32x4 a = acc[ai][bj][m][n];
                        const float y0 = bflo(w.x), y1 = bfhi(w.x), y2 = bflo(w.y), y3 = bfhi(w.y);
                        a[0] = y0 * sigmoidf_(a[0]); a[1] = y1 * sigmoidf_(a[1]); a[2] = y2 * sigmoidf_(a[2]); a[3] = y3 * sigmoidf_(a[3]);
                        acc[ai][bj][m][n] = a; s += (a[0] * a[0] + a[1] * a[1]) + (a[2] * a[2] + a[3] * a[3]); }
                s += __shfl_xor(s, 16); s += __shfl_xor(s, 32);
                if (fq == 0) Pp[rl * 4 + wc] = s; }
        __syncthreads();
#pragma unroll
        for (int ai = 0; ai < 2; ++ai)
#pragma unroll
            for (int m = 0; m < 4; ++m) { const int rl = ai * HALF + wr * 64 + m * 16 + fr; const size_t off = (size_t)(u.pm * BM + rl) * D + col0;
                const float tot = (Pp[rl * 4 + 0] + Pp[rl * 4 + 1]) + (Pp[rl * 4 + 2] + Pp[rl * 4 + 3]); const float rs = rsqrtf(tot * (1.0f / 256.0f) + EPS);
#pragma unroll
                for (int bj = 0; bj < 2; ++bj)
#pragma unroll
                    for (int n = 0; n < 2; ++n) { const f32x4 a = acc[ai][bj][m][n] * rs; u32x2 w; w.x = pk2(a[0], a[1]); w.y = pk2(a[2], a[3]); *(u32x2*)(Y + off + bj * HALF + n * 16) = w; } }
    }
};

template <class Epi, class Sched, bool ALIGN_EPI = false, bool SP2 = false>
__device__ __forceinline__ void gemm_phase(PG8_LAS unsigned char* lds, const Gemm g, const Sched& S, const Epi& E) {
    int tid_o = threadIdx.x; asm volatile("" : "+v"(tid_o));
    const int tid = tid_o, wid = __builtin_amdgcn_readfirstlane(tid >> 6), lane = tid & 63, wr = wid >> 2, wc = wid & 3, fr = lane & 15, fq = lane >> 4;
    const int K = g.K, nt = K / BK;
    unsigned voffA[2], voffB[2];
#pragma unroll
    for (int i = 0; i < 2; ++i) { int R, C; stage_rc(tid * 16 + i * 8192, R, C); const int Rb = Epi::PERM ? ((R & ~31) + perm32(R & 31)) : R;
        voffA[i] = (unsigned)(R * g.lda + C) * 2u; voffB[i] = (unsigned)(Rb * K + C) * 2u; }
    const size_t kstep = (size_t)(BK * 2);
    const size_t hstepA = (size_t)HALF * g.lda * 2, hstepB = (size_t)HALF * K * 2;
    const size_t tstepA = 2 * hstepA, tstepB = 2 * hstepB;
    const unsigned ldsw = (unsigned)wid * 1024u;
    const int aoff = lds_byte(wr * 64 + fr, fq * 8), boff = lds_byte(wc * 32 + fr, fq * 8);
#define PG8_SA(b, h) (((b) * 2 + (h)) * HTB)
#define PG8_SB(b, h) ((4 + (b) * 2 + (h)) * HTB)
#define PG8_STAGE(bufoff, gbase, voff) do { _Pragma("unroll") for (int _i = 0; _i < 2; ++_i) \
        __builtin_amdgcn_global_load_lds((const unsigned*)((const char*)(gbase) + (voff)[_i]), (PG8_LAS unsigned*)(lds + (bufoff) + ldsw + _i * 8192), 16, 0, 0); } while (0)
#define PG8_LDA(dst, b, h) do { _Pragma("unroll") for (int m = 0; m < 4; ++m) _Pragma("unroll") for (int k = 0; k < 2; ++k) dst[m][k] = *(const PG8_LAS bf16x8*)(lds + PG8_SA(b, h) + aoff + m * 2048 + k * 1024); } while (0)
#define PG8_LDB(dst, b, h) do { _Pragma("unroll") for (int n = 0; n < 2; ++n) _Pragma("unroll") for (int k = 0; k < 2; ++k) dst[n][k] = *(const PG8_LAS bf16x8*)(lds + PG8_SB(b, h) + boff + n * 2048 + k * 1024); } while (0)
#define PG8_MMA(ai, bj, At, Bt) do { __builtin_amdgcn_s_setprio(1); _Pragma("unroll") for (int m = 0; m < 4; ++m) _Pragma("unroll") for (int n = 0; n < 2; ++n) _Pragma("unroll") for (int k = 0; k < 2; ++k) \
        acc[ai][bj][m][n] = __builtin_amdgcn_mfma_f32_16x16x32_bf16(Bt[n][k], At[m][k], acc[ai][bj][m][n], 0, 0, 0); __builtin_amdgcn_s_setprio(0); } while (0)
#define PG8_WAIT_V(n) asm volatile("s_waitcnt vmcnt(" #n ")" ::: "memory")
#define PG8_WAIT_L(n) asm volatile("s_waitcnt lgkmcnt(" #n ")" ::: "memory")
#define PG8_BAR __builtin_amdgcn_s_barrier()
#define PG8_SCHED __builtin_amdgcn_sched_barrier(0)
    Unit cur, nxt; int ui = 0;
    if (!S.next(0, cur)) return;
    f32x4 acc[2][2][4][2];
#pragma unroll
    for (int a = 0; a < 2; ++a)
#pragma unroll
        for (int b = 0; b < 2; ++b)
#pragma unroll
            for (int m = 0; m < 4; ++m)
#pragma unroll
                for (int n = 0; n < 2; ++n) acc[a][b][m][n] = (f32x4){0.f, 0.f, 0.f, 0.f};
    bf16x8 At[4][2], B0[2][2], B1[2][2];
    const char* cA = (const char*)g.A + (size_t)cur.pm * tstepA; const char* cB = (const char*)g.Bt + (size_t)cur.pn * tstepB;
    S.a_ready(cur);
    if constexpr (SP2) {
        PG8_STAGE(PG8_SB(0, 0), cB, voffB); PG8_STAGE(PG8_SB(0, 1), cB + hstepB, voffB); PG8_STAGE(PG8_SA(0, 0), cA, voffA); PG8_STAGE(PG8_SA(0, 1), cA + hstepA, voffA);
        if (wr == 1) PG8_BAR;
        PG8_WAIT_V(2); PG8_BAR;
        PG8_STAGE(PG8_SB(1, 0), cB + kstep, voffB); PG8_STAGE(PG8_SA(1, 0), cA + kstep, voffA); PG8_STAGE(PG8_SB(1, 1), cB + hstepB + kstep, voffB);
        PG8_WAIT_V(6); PG8_BAR;
    } else {
        PG8_STAGE(PG8_SB(0, 0), cB, voffB); PG8_STAGE(PG8_SA(0, 0), cA, voffA); PG8_STAGE(PG8_SB(0, 1), cB + hstepB, voffB); PG8_STAGE(PG8_SA(0, 1), cA + hstepA, voffA);
        if (wr == 1) PG8_BAR;
        PG8_WAIT_V(4); PG8_BAR;
        PG8_STAGE(PG8_SB(1, 0), cB + kstep, voffB); PG8_STAGE(PG8_SA(1, 0), cA + kstep, voffA); PG8_STAGE(PG8_SB(1, 1), cB + hstepB + kstep, voffB);
        PG8_WAIT_V(6); PG8_BAR;
    }
    for (;;) {
        const bool has_next = S.next(ui + 1, nxt);
        const char* nA = has_next ? (const char*)g.A + (size_t)nxt.pm * tstepA : cA; const char* nB = has_next ? (const char*)g.Bt + (size_t)nxt.pn * tstepB : cB;
        for (int t = 0; t < nt; t += 2) {
            const bool last = (t == nt - 2);
            const char* a1 = cA + (size_t)(t + 1) * kstep;
            const char* a2 = last ? nA : cA + (size_t)(t + 2) * kstep; const char* b2 = last ? nB : cB + (size_t)(t + 2) * kstep;
            const char* a3 = a2 + kstep; const char* b3 = b2 + kstep;
            if (last && has_next) S.a_ready(nxt);
            if constexpr (SP2) {
            PG8_LDB(B0, 0, 0); PG8_LDB(B1, 0, 1); PG8_SCHED; PG8_LDA(At, 0, 0); PG8_STAGE(PG8_SA(1, 1), a1 + hstepA, voffA);
            PG8_WAIT_V(8); PG8_WAIT_L(0); PG8_BAR; PG8_MMA(0, 0, At, B0); PG8_MMA(0, 1, At, B1); PG8_BAR; PG8_SCHED;
            PG8_LDA(At, 0, 1); PG8_STAGE(PG8_SB(0, 0), b2, voffB); PG8_STAGE(PG8_SB(0, 1), b2 + hstepB, voffB); PG8_STAGE(PG8_SA(0, 0), a2, voffA);
            PG8_WAIT_V(8); PG8_WAIT_L(0); PG8_BAR; PG8_MMA(1, 0, At, B0); PG8_MMA(1, 1, At, B1); PG8_BAR; PG8_SCHED;
            PG8_LDB(B0, 1, 0); PG8_LDB(B1, 1, 1); PG8_SCHED; PG8_LDA(At, 1, 0); PG8_STAGE(PG8_SA(0, 1), a2 + hstepA, voffA);
            PG8_WAIT_V(8); PG8_WAIT_L(0); PG8_BAR; PG8_MMA(0, 0, At, B0); PG8_MMA(0, 1, At, B1); PG8_BAR; PG8_SCHED;
            PG8_LDA(At, 1, 1); PG8_STAGE(PG8_SB(1, 0), b3, voffB); PG8_STAGE(PG8_SB(1, 1), b3 + hstepB, voffB); PG8_STAGE(PG8_SA(1, 0), a3, voffA);
            PG8_WAIT_V(8); PG8_WAIT_L(0); PG8_BAR; PG8_MMA(1, 0, At, B0); PG8_MMA(1, 1, At, B1); PG8_BAR; PG8_SCHED;
            } else {
            PG8_LDB(B0, 0, 0); PG8_SCHED; PG8_LDA(At, 0, 0); PG8_STAGE(PG8_SA(1, 1), a1 + hstepA, voffA);
            PG8_WAIT_L(8); PG8_BAR; PG8_WAIT_L(0); PG8_MMA(0, 0, At, B0); PG8_BAR; PG8_SCHED;
            PG8_LDB(B1, 0, 1); PG8_STAGE(PG8_SB(0, 0), b2, voffB);
            PG8_BAR; PG8_WAIT_L(0); PG8_MMA(0, 1, At, B1); PG8_BAR;
            PG8_LDA(At, 0, 1); PG8_STAGE(PG8_SA(0, 0), a2, voffA);
            PG8_BAR; PG8_WAIT_L(0); PG8_MMA(1, 0, At, B0); PG8_BAR; PG8_SCHED;
            PG8_STAGE(PG8_SB(0, 1), b2 + hstepB, voffB);
            PG8_WAIT_V(6); PG8_BAR; PG8_MMA(1, 1, At, B1); PG8_BAR;
            PG8_LDB(B0, 1, 0); PG8_SCHED; PG8_LDA(At, 1, 0); PG8_STAGE(PG8_SA(0, 1), a2 + hstepA, voffA);
            PG8_WAIT_L(8); PG8_BAR; PG8_WAIT_L(0); PG8_MMA(0, 0, At, B0); PG8_BAR; PG8_SCHED;
            PG8_LDB(B1, 1, 1); PG8_STAGE(PG8_SB(1, 0), b3, voffB);
            PG8_BAR; PG8_WAIT_L(0); PG8_MMA(0, 1, At, B1); PG8_BAR;
            PG8_LDA(At, 1, 1); PG8_STAGE(PG8_SA(1, 0), a3, voffA);
            PG8_BAR; PG8_WAIT_L(0); PG8_MMA(1, 0, At, B0); PG8_BAR; PG8_SCHED;
            PG8_STAGE(PG8_SB(1, 1), b3 + hstepB, voffB);
            PG8_WAIT_V(6); PG8_BAR; PG8_MMA(1, 1, At, B1); PG8_BAR;
            }
        }
        if constexpr (ALIGN_EPI) { if (wr == 0) PG8_BAR; }
        if constexpr (!Epi::AFTER_DRAIN) { E(acc, cur, wr, wc, fr, fq); S.done(cur); }
        if (!has_next) break;
#pragma unroll
        for (int a = 0; a < 2; ++a)
#pragma unroll
            for (int b = 0; b < 2; ++b)
#pragma unroll
                for (int m = 0; m < 4; ++m)
#pragma unroll
                    for (int n = 0; n < 2; ++n) acc[a][b][m][n] = (f32x4){0.f, 0.f, 0.f, 0.f};
        cur = nxt; cA = nA; cB = nB; ++ui;
        if constexpr (ALIGN_EPI) { if (wr == 1) PG8_BAR; }
    }
    PG8_WAIT_V(0);
    if constexpr (!ALIGN_EPI) { if (wr == 0) PG8_BAR; }
    PG8_BAR;
    if constexpr (Epi::AFTER_DRAIN) { E.fused(acc, cur, wr, wc, fr, fq, lds, wid, lane); S.done(cur); }
#undef PG8_SA
#undef PG8_SB
#undef PG8_STAGE
#undef PG8_LDA
#undef PG8_LDB
#undef PG8_MMA
#undef PG8_WAIT_V
#undef PG8_WAIT_L
#undef PG8_BAR
#undef PG8_SCHED
}
}

struct Params { const float* in[26]; float* out; unsigned char* ws; int rs_lds; int pad; };
enum { I_X = 0, I_NMG, I_WIN, I_LBL, I_HNG, I_CW, I_CB, I_CLG, I_CLB, I_LRE, I_LIM, I_BRE, I_BIM, I_CRE, I_CIM, I_S5D, I_LDT, I_WGLU, I_QG, I_KG, I_RB, I_MONG, I_WOUT, I_NMLPG, I_WUP, I_WDN };

DI void p0_transpose_item(const float* W, int K, int N, bf16_t* WT, const float* gk, LAS float* scr, int item, int lane) {
    const int nblk = N / 32, kb = item / nblk, nb = item % nblk, k0 = 64 * kb, n0 = 32 * nb;
#pragma unroll 8
    for (int i = 0; i < 32; ++i) { const int kk = 2 * i + (lane >> 5); const float s = gk ? gk[k0 + kk] : 1.f; scr[kk * 33 + (lane & 31)] = W[(size_t)(k0 + kk) * N + n0 + (lane & 31)] * s; }
    LDS_WAIT();
    const int c = lane & 7;
#pragma unroll
    for (int j = 0; j < 4; ++j) { const int n = (lane >> 3) + 8 * j; const LAS float* s = scr + (8 * c) * 33 + n;
        u32x4 o; o.x = pk2(s[0 * 33], s[1 * 33]); o.y = pk2(s[2 * 33], s[3 * 33]); o.z = pk2(s[4 * 33], s[5 * 33]); o.w = pk2(s[6 * 33], s[7 * 33]);
        *(u32x4*)(WT + (size_t)(n0 + n) * K + k0 + 8 * c) = o; }
    LDS_WAIT();
}
DI void s5_params(const Params& p, int lg, int pp, float& lrdt, float& lidt, float& cr, float& ci) {
    const float dt = expf(p.in[I_LDT][lg]);
    const float lr = p.in[I_LRE][lg * 64 + pp], li = p.in[I_LIM][lg * 64 + pp];
    lrdt = lr * dt; lidt = li * dt;
    const float mag = expf(lrdt); const float ar = mag * cosf(lidt), ai = mag * sinf(lidt);
    const float den = lr * lr + li * li;
    cr = ((ar - 1.0f) * lr + ai * li) / den; ci = (ai * lr - (ar - 1.0f) * li) / den;
}
DI void s5_pow(float lrdt, float lidt, int n, float& er, float& ei) { const float m = expf((float)n * lrdt); const float a = (float)n * lidt; er = m * cosf(a); ei = m * sinf(a); }

DI void prologue(const Params& p, LAS unsigned char* lds, int G) {
    int tid_o = threadIdx.x; asm volatile("" : "+v"(tid_o));
    const int tid = tid_o, lane = tid & 63, wave = tid >> 6;
    const int gw = blockIdx.x * 8 + wave, NGW = G * 8;
    const int gt = blockIdx.x * 512 + tid, NGT = G * 512;
    unsigned char* ws = p.ws;
    LAS float* scr = (LAS float*)(lds + wave * 16384);
    {
        constexpr int I_IN = (D / 64) * (DIN / 32), I_OUT = (D / 64) * (D / 32), I_UP = (D / 64) * (FF / 32), I_DN = (FF / 64) * (D / 32), I_GL = (256 / 64) * (256 / 32);
        constexpr int PER_L = I_IN + I_OUT + I_UP + I_DN + I_GL;
        for (int it = gw; it < NL * PER_L; it += NGW) {
            const int l = it / PER_L; int r = it % PER_L;
            if (r < I_IN) { p0_transpose_item(p.in[I_WIN] + (size_t)l * D * DIN, D, DIN, (bf16_t*)(ws + WS_WIN) + (size_t)l * D * DIN, p.in[I_NMG] + l * D, scr, r, lane); continue; } r -= I_IN;
            if (r < I_OUT) { p0_transpose_item(p.in[I_WOUT] + (size_t)l * D * D, D, D, (bf16_t*)(ws + WS_WOUT) + (size_t)l * D * D, p.in[I_MONG] + l * D, scr, r, lane); continue; } r -= I_OUT;
            if (r < I_UP) { p0_transpose_item(p.in[I_WUP] + (size_t)l * D * FF, D, FF, (bf16_t*)(ws + WS_WUP) + (size_t)l * D * FF, p.in[I_NMLPG] + l * D, scr, r, lane); continue; } r -= I_UP;
            if (r < I_DN) { p0_transpose_item(p.in[I_WDN] + (size_t)l * D * FF, FF, D, (bf16_t*)(ws + WS_WDN) + (size_t)l * D * FF, nullptr, scr, r, lane); continue; } r -= I_DN;
            p0_transpose_item(p.in[I_WGLU] + (size_t)l * 65536, 256, 256, (bf16_t*)(ws + WS_WGLU) + (size_t)l * 65536, nullptr, scr, r, lane);
        }
    }
    {
        float* ssq0 = (float*)(ws + WS_SSQP); bf16_t* XB = (bf16_t*)(ws + WS_XB);
        for (int mb = gw * 16; mb < T; mb += NGW * 16) {
            float keep = 0.f;
#pragma unroll 4
            for (int i = 0; i < 16; ++i) { const int m = mb + i;
                const f32x4* xr = (const f32x4*)(p.in[I_X] + (size_t)m * D) + lane; f32x4 v[4]; float s = 0.f;
#pragma unroll
                for (int j = 0; j < 4; ++j) { v[j] = xr[64 * j]; s += (v[j][0] * v[j][0] + v[j][1] * v[j][1]) + (v[j][2] * v[j][2] + v[j][3] * v[j][3]); }
                s = wave_sum(s); if (lane == i) keep = s;
                u32x2* o8 = (u32x2*)(XB + (size_t)m * D) + lane;
#pragma unroll
                for (int j = 0; j < 4; ++j) { u32x2 w; w.x = pk2(v[j][0], v[j][1]); w.y = pk2(v[j][2], v[j][3]); o8[64 * j] = w; } }
#pragma unroll 1
            for (int i = 0; i < 16; ++i) { const float v = __shfl(keep, i); if (lane < 16) ssq0[(size_t)(mb + i) * 16 + lane] = lane == 0 ? v : 0.f; }
        }
    }
    {
        float* LB = (float*)(ws + WS_LB);
        for (int c = gt; c < 256; c += NGT) {
            const float a0 = p.in[I_LBL][c], a1 = p.in[I_LBL][256 + c], a2 = p.in[I_LBL][512 + c], a3 = p.in[I_LBL][768 + c];
            const float mx = fmaxf(fmaxf(a0, a1), fmaxf(a2, a3));
            const float e0 = expf(a0 - mx), e1 = expf(a1 - mx), e2 = expf(a2 - mx), e3 = expf(a3 - mx); const float inv = 1.f / (e0 + e1 + e2 + e3);
            const float s1 = e1 * inv, s2 = e2 * inv, s3 = e3 * inv; const float hi = 1.0f - 1e-6f;
            LB[c] = 0.f; LB[256 + c] = fminf(fmaxf(s1, 0.f), hi); LB[512 + c] = fminf(fmaxf(s1 + s2, 0.f), hi); LB[768 + c] = fminf(fmaxf(s1 + s2 + s3, 0.f), hi);
        }
        float* BT = (float*)(ws + WS_BIAS);
        for (int i = gt; i < 3 * 4 * 132; i += NGT) {
            const int pt = i / (4 * 132), hd = (i / 132) % 4, dl = i % 132; const int dil = pt == 0 ? 1 : (pt == 1 ? 4 : 16);
            float v = 0.f;
            if (dl <= 128) { const int dist = dl * dil; int bk;
                if (dist < 16) bk = dist; else { bk = 16 + (int)(logf((float)dist / 16.0f) / 4.852030263919617f * 16.0f); if (bk > 31) bk = 31; }
                v = p.in[I_RB][bk * 4 + hd]; }
            BT[i] = v;
        }
    }
    {
        bf16_t* KT = (bf16_t*)(ws + WS_S5K); bf16_t* WS_ = (bf16_t*)(ws + WS_S5WS); bf16_t* WC = (bf16_t*)(ws + WS_S5WC);
        LAS float* ebr = scr; LAS float* ebi = scr + 64 * 17;
        for (int it = gw; it < NL * 16 * 64; it += NGW) {
            const int lg = it >> 6, d = it & 63;
            float lrdt, lidt, cr, ci; s5_params(p, lg, lane, lrdt, lidt, cr, ci);
            float er, ei; s5_pow(lrdt, lidt, d, er, ei);
            const float fr_ = er * cr - ei * ci, fi_ = er * ci + ei * cr;
            const float* br = p.in[I_BRE] + ((size_t)lg * 64 + lane) * 16; const float* bi = p.in[I_BIM] + ((size_t)lg * 64 + lane) * 16;
#pragma unroll
            for (int c = 0; c < 16; ++c) { const float b0 = br[c], b1 = bi[c]; ebr[lane * 17 + c] = fr_ * b0 - fi_ * b1; ebi[lane * 17 + c] = fr_ * b1 + fi_ * b0; }
            LDS_WAIT();
            const int co = lane & 15, cb = (lane >> 4) * 4;
            const float* crp = p.in[I_CRE] + ((size_t)lg * 16 + co) * 64; const float* cip = p.in[I_CIM] + ((size_t)lg * 16 + co) * 64;
            float a0 = 0.f, a1 = 0.f, a2 = 0.f, a3 = 0.f;
            for (int q = 0; q < 64; ++q) { const float c0 = crp[q], c1 = cip[q];
                a0 += c0 * ebr[q * 17 + cb + 0] - c1 * ebi[q * 17 + cb + 0]; a1 += c0 * ebr[q * 17 + cb + 1] - c1 * ebi[q * 17 + cb + 1];
                a2 += c0 * ebr[q * 17 + cb + 2] - c1 * ebi[q * 17 + cb + 2]; a3 += c0 * ebr[q * 17 + cb + 3] - c1 * ebi[q * 17 + cb + 3]; }
            u32x2 w; w.x = pk2(a0, a1); w.y = pk2(a2, a3);
            *(u32x2*)(KT + ((size_t)it * 16 + co) * 16 + cb) = w;
            LDS_WAIT();
        }
        for (int it = gw; it < NL * 16 * 16; it += NGW) {
            const int lg = it >> 4, s4 = it & 15;
            float lrdt, lidt, cr, ci; s5_params(p, lg, lane, lrdt, lidt, cr, ci);
            const float* br = p.in[I_BRE] + ((size_t)lg * 64 + lane) * 16; const float* bi = p.in[I_BIM] + ((size_t)lg * 64 + lane) * 16;
            float b0[16], b1[16];
#pragma unroll
            for (int c = 0; c < 16; ++c) { b0[c] = br[c]; b1[c] = bi[c]; }
#pragma unroll 1
            for (int sq = 0; sq < 4; ++sq) { const int s = s4 * 4 + sq;
                float er, ei; s5_pow(lrdt, lidt, 63 - s, er, ei);
                const float fr_ = er * cr - ei * ci, fi_ = er * ci + ei * cr;
                float vr[16], vi[16];
#pragma unroll
                for (int c = 0; c < 16; ++c) { vr[c] = fr_ * b0[c] - fi_ * b1[c]; vi[c] = fr_ * b1[c] + fi_ * b0[c]; }
                bf16_t* o0 = WS_ + ((size_t)lg * 128 + lane) * 1024 + s * 16; bf16_t* o1 = WS_ + ((size_t)lg * 128 + 64 + lane) * 1024 + s * 16;
                u32x4 w;
                w.x = pk2(vr[0], vr[1]); w.y = pk2(vr[2], vr[3]); w.z = pk2(vr[4], vr[5]); w.w = pk2(vr[6], vr[7]); *(u32x4*)o0 = w;
                w.x = pk2(vr[8], vr[9]); w.y = pk2(vr[10], vr[11]); w.z = pk2(vr[12], vr[13]); w.w = pk2(vr[14], vr[15]); *(u32x4*)(o0 + 8) = w;
                w.x = pk2(vi[0], vi[1]); w.y = pk2(vi[2], vi[3]); w.z = pk2(vi[4], vi[5]); w.w = pk2(vi[6], vi[7]); *(u32x4*)o1 = w;
                w.x = pk2(vi[8], vi[9]); w.y = pk2(vi[10], vi[11]); w.z = pk2(vi[12], vi[13]); w.w = pk2(vi[14], vi[15]); *(u32x4*)(o1 + 8) = w; }
        }
        for (int it = gw; it < NL * 16 * 64; it += NGW) {
            const int lg = it >> 6, tl = it & 63;
            float lrdt, lidt, cr, ci; s5_params(p, lg, lane, lrdt, lidt, cr, ci);
            float er, ei; s5_pow(lrdt, lidt, tl + 1, er, ei);
#pragma unroll 4
            for (int co = 0; co < 16; ++co) { const float c0 = p.in[I_CRE][((size_t)lg * 16 + co) * 64 + lane], c1 = p.in[I_CIM][((size_t)lg * 16 + co) * 64 + lane];
                bf16_t* o = WC + (((size_t)lg * 64 + tl) * 16 + co) * 128;
                o[lane] = (bf16_t)f2bf(c0 * er - c1 * ei); o[64 + lane] = (bf16_t)f2bf(-(c0 * ei + c1 * er)); }
        }
    }
}

template <bool OUT>
DI void hgrn_item(const Params& p, LAS unsigned char* lds, int l, int cg) {
    int tid_o = threadIdx.x; asm volatile("" : "+v"(tid_o));
    const int tid = tid_o, lane = tid & 63, wave = tid >> 6, hd = wave >> 1, half = wave & 1;
    const bf16_t* Z = (const bf16_t*)(p.ws + WS_Z);
    LAS bf16_t* B0 = (LAS bf16_t*)(lds + hd * 27648); LAS bf16_t* B1 = B0 + 64 * 72; LAS bf16_t* B2 = B1 + 64 * 72;
    LAS float* GM = (LAS float*)(lds + 114688) + hd * 64; LAS float* GL = GM + 256; LAS float* SSA = (LAS float*)(lds + 114688) + 512;
    bf16_t* SL = (bf16_t*)(p.ws + WS_SL); const bf16_t* SL2 = (const bf16_t*)(p.ws + WS_SL2); float* DEC = (float*)(p.ws + WS_DEC);
    const int item = cg * 4 + hd;
#ifdef FORCE_LB0
    const float lb = 0.f, oml = 1.f;
#else
    const float lb = ((const float*)(p.ws + WS_LB))[l * 256 + hd * 64 + lane], oml = 1.f - lb;
#endif
    const int srow = tid >> 5, shd = (tid >> 3) & 3, spc = tid & 7;
    const bf16_t* zsrc = Z + (size_t)(cg * 64 + srow) * DIN + shd * 64 + spc * 8;
    const int sdst = shd * 27648 + (srow * 72 + spc * 8) * 2;
    __syncthreads();
    { u32x4 wf[4], wi[4], wq[4];
#pragma unroll
      for (int sub = 0; sub < 4; ++sub) { wf[sub] = *(const u32x4*)(zsrc + (size_t)(16 * sub) * DIN + ZF); wi[sub] = *(const u32x4*)(zsrc + (size_t)(16 * sub) * DIN + ZI);
          if (OUT) wq[sub] = *(const u32x4*)(zsrc + (size_t)(16 * sub) * DIN + ZQ); }
#pragma unroll
      for (int sub = 0; sub < 4; ++sub) { *(LAS u32x4*)(lds + sdst + 9216 + sub * 16 * 144) = wf[sub]; *(LAS u32x4*)(lds + sdst + 18432 + sub * 16 * 144) = wi[sub];
          if (OUT) *(LAS u32x4*)(lds + sdst + sub * 16 * 144) = wq[sub]; } }
    __syncthreads();
    float g[32]; float run = 0.f;
#pragma unroll
    for (int j = 0; j < 32; ++j) { const float fz = bf2f(B1[(half * 32 + j) * 72 + lane]); const float sg = sigmoidf_(fz); const float f = lb + oml * sg;
        run += __logf(fmaxf(f, 1e-30f)); g[j] = run; }
    if (half == 0) GM[lane] = run;
    __syncthreads();
    const float gm = GM[lane];
    if (half) {
#pragma unroll
        for (int j = 0; j < 32; ++j) g[j] += gm; }
    const int c0 = lane & 31, h = lane >> 5;
    if constexpr (!OUT) {
        if (half) GL[lane] = run + gm;
        __syncthreads();
        const float gl = GL[lane];
        bf16_t kv[32], ivr[32];
#pragma unroll
        for (int j = 0; j < 32; ++j) { const int t = half * 32 + j; const float e = __expf(gl - g[j]); const float kj = oml * (1.f - sigmoidf_(bf2f(B1[t * 72 + lane])));
            kv[j] = (bf16_t)f2bf(kj * e); ivr[j] = B2[t * 72 + lane]; }
        __syncthreads();
#pragma unroll
        for (int j = 0; j < 32; ++j) { const int t = half * 32 + j; B1[lane * 72 + t] = kv[j]; B2[lane * 72 + t] = ivr[j]; }
        __syncthreads();
#pragma unroll
        for (int kt = 0; kt < 2; ++kt) { const f32x16 a = mma_lds<64>(B2 + 32 * half * 72, 72, B1 + 32 * kt * 72, 72, zero16(), lane);
#pragma unroll
            for (int i = 0; i < 16; ++i) SL[(size_t)item * 4096 + (32 * half + crow(i, h)) * 64 + 32 * kt + c0] = (bf16_t)f2bf(a[i]); }
        if (half == 0) DEC[item * 64 + lane] = __expf(gl);
    } else {
        if (half == 0) GL[lane] = __expf(gm);
        bf16_t ivr[32];
#pragma unroll
        for (int j = 0; j < 32; ++j) { const int t = half * 32 + j; const float q = bf2f(B0[t * 72 + lane]); const float kj = oml * (1.f - sigmoidf_(bf2f(B1[t * 72 + lane])));
            const float e1 = __expf(fminf(g[j] - gm, 80.f)), e2 = __expf(fminf(gm - g[j], 80.f));
            ivr[j] = B2[t * 72 + lane];
            B0[t * 72 + lane] = (bf16_t)f2bf(q * e1); B1[t * 72 + lane] = (bf16_t)f2bf(kj * e2); }
        __syncthreads();
#pragma unroll
        for (int j = 0; j < 32; ++j) B2[lane * 72 + half * 32 + j] = ivr[j];
        __syncthreads();
        f32x16 s0 = mma_lds<64>(B0 + 32 * half * 72, 72, B1, 72, zero16(), lane);
        f32x16 s1 = zero16(); if (half) s1 = mma_lds<64>(B0 + 32 * half * 72, 72, B1 + 32 * 72, 72, zero16(), lane);
        __syncthreads();
#pragma unroll
        for (int i = 0; i < 16; ++i) { const int row = 32 * half + crow(i, h);
            B1[row * 72 + c0] = (bf16_t)f2bf(c0 <= row ? s0[i] : 0.f); B1[row * 72 + 32 + c0] = (bf16_t)f2bf(32 + c0 <= row ? s1[i] : 0.f); }
        __syncthreads();
        f32x16 o0 = mma_lds<64>(B1 + 32 * half * 72, 72, B2, 72, zero16(), lane);
        f32x16 o1 = mma_lds<64>(B1 + 32 * half * 72, 72, B2 + 32 * 72, 72, zero16(), lane);
        __syncthreads();
        {
          u32x4 wsl[4], wg[4];
          const bf16_t* sp = SL2 + (size_t)item * 4096 + (32 * half) * 64;
#pragma unroll
          for (int e = 0; e < 4; ++e) { const int pc = lane + 64 * e; wsl[e] = *(const u32x4*)(sp + pc * 8); wg[e] = *(const u32x4*)(zsrc + (size_t)(16 * e) * DIN + ZG); }
#pragma unroll
          for (int e = 0; e < 4; ++e) { const int pc = lane + 64 * e, row = pc >> 3, k0 = (pc & 7) * 8; const LAS float* eg = GL + k0;
              u32x4 o; o.x = pk2(bflo(wsl[e].x) * eg[0], bfhi(wsl[e].x) * eg[1]); o.y = pk2(bflo(wsl[e].y) * eg[2], bfhi(wsl[e].y) * eg[3]);
              o.z = pk2(bflo(wsl[e].z) * eg[4], bfhi(wsl[e].z) * eg[5]); o.w = pk2(bflo(wsl[e].w) * eg[6], bfhi(wsl[e].w) * eg[7]);
              *(LAS u32x4*)(B2 + (32 * half + row) * 72 + k0) = o;
              *(LAS u32x4*)(lds + sdst + 9216 + e * 16 * 144) = wg[e]; } }
        __syncthreads();
        o0 = mma_lds<64>(B0 + 32 * half * 72, 72, B2, 72, o0, lane);
        o1 = mma_lds<64>(B0 + 32 * half * 72, 72, B2 + 32 * 72, 72, o1, lane);
        const float* ng = p.in[I_HNG] + l * 256 + hd * 64; const float ng0 = ng[c0], ng1 = ng[32 + c0];
#pragma unroll
        for (int i = 0; i < 16; ++i) { const int row = 32 * half + crow(i, h);
            const float ss = half_sum(o0[i] * o0[i] + o1[i] * o1[i]); const float rs = rsqrtf(ss * (1.0f / 64.0f) + EPS);
            const float g0 = bf2f(B1[row * 72 + c0]), g1 = bf2f(B1[row * 72 + 32 + c0]);
            const float v0 = o0[i] * rs * ng0 * g0 * sigmoidf_(g0), v1 = o1[i] * rs * ng1 * g1 * sigmoidf_(g1);
            o0[i] = v0; o1[i] = v1; const float s2 = half_sum(v0 * v0 + v1 * v1); if (c0 == 0) SSA[hd * 64 + row] = s2; }
        __syncthreads();
        bf16_t* Y = (bf16_t*)(p.ws + WS_YCAT);
#pragma unroll
        for (int i = 0; i < 16; ++i) { const int row = 32 * half + crow(i, h); const size_t tok = (size_t)cg * 64 + row;
            const float tot = (SSA[row] + SSA[64 + row]) + (SSA[128 + row] + SSA[192 + row]); const float r2 = rsqrtf(tot * (1.0f / 256.0f) + EPS);
            Y[tok * D + YA + hd * 64 + c0] = (bf16_t)f2bf(o0[i] * r2); Y[tok * D + YA + hd * 64 + 32 + c0] = (bf16_t)f2bf(o1[i] * r2); }
    }
}
DI void hgrn_scan_item(const Params& p, int hb) {
    int tid_o = threadIdx.x; asm volatile("" : "+v"(tid_o));
    const int e = hb * 512 + tid_o, bh = e >> 12, b = bh >> 2, hd = bh & 3, vk = e & 4095, k = vk & 63;
    const bf16_t* SL = (const bf16_t*)(p.ws + WS_SL); bf16_t* SL2 = (bf16_t*)(p.ws + WS_SL2); const float* DEC = (const float*)(p.ws + WS_DEC);
    float st = 0.f;
    for (int c8 = 0; c8 < 128; c8 += 16) { float tmp[16], dc[16];
#pragma unroll
        for (int u = 0; u < 16; ++u) { const int item = (b * 128 + c8 + u) * 4 + hd; tmp[u] = bf2f(SL[(size_t)item * 4096 + vk]); dc[u] = DEC[item * 64 + k]; }
#pragma unroll
        for (int u = 0; u < 16; ++u) { const int item = (b * 128 + c8 + u) * 4 + hd; SL2[(size_t)item * 4096 + vk] = (bf16_t)f2bf(st); st = dc[u] * st + tmp[u]; } }
}

DI void conv_item(const Params& p, LAS unsigned char* lds, int l, int ti) {
    int tid_o = threadIdx.x; asm volatile("" : "+v"(tid_o));
    const int tid = tid_o, lane = tid & 63, wave = tid >> 6, c = tid & 255, hf = tid >> 8, wv = wave & 3;
    LAS float* Hs = (LAS float*)lds; LAS float* ST = (LAS float*)(lds + 98304); LAS float* ST2 = ST + 512;
    const bf16_t* Z = (const bf16_t*)(p.ws + WS_Z); bf16_t* Y = (bf16_t*)(p.ws + WS_YCAT);
    const int tok0 = ti * 64, pos0 = (ti & 127) * 64;
    __syncthreads();
    { u32x4 vw[6], gw_[6];
#pragma unroll
      for (int k = 0; k < 6; ++k) { const int pid = tid + 512 * k, row = pid >> 5, pc = pid & 31, pos = pos0 - 30 + row; const bool ok = (row < 94) && (pos >= 0);
          const size_t tok = ok ? (size_t)(tok0 - 30 + row) : (size_t)tok0; vw[k] = *(const u32x4*)(Z + tok * DIN + ZBV + pc * 8); gw_[k] = *(const u32x4*)(Z + tok * DIN + ZBG + pc * 8); }
#pragma unroll
      for (int k = 0; k < 6; ++k) { const int pid = tid + 512 * k, row = pid >> 5, pc = pid & 31, pos = pos0 - 30 + row; const bool ok = (row < 94) && (pos >= 0);
          if (row < 94) { f32x4 h0, h1;
              h0[0] = bflo(vw[k].x) * sigmoidf_(bflo(gw_[k].x)); h0[1] = bfhi(vw[k].x) * sigmoidf_(bfhi(gw_[k].x)); h0[2] = bflo(vw[k].y) * sigmoidf_(bflo(gw_[k].y)); h0[3] = bfhi(vw[k].y) * sigmoidf_(bfhi(gw_[k].y));
              h1[0] = bflo(vw[k].z) * sigmoidf_(bflo(gw_[k].z)); h1[1] = bfhi(vw[k].z) * sigmoidf_(bfhi(gw_[k].z)); h1[2] = bflo(vw[k].w) * sigmoidf_(bflo(gw_[k].w)); h1[3] = bfhi(vw[k].w) * sigmoidf_(bfhi(gw_[k].w));
              if (!ok) { h0 = (f32x4){0.f, 0.f, 0.f, 0.f}; h1 = h0; }
              *(LAS f32x4*)(Hs + row * 256 + pc * 8) = h0; *(LAS f32x4*)(Hs + row * 256 + pc * 8 + 4) = h1; } } }
    __syncthreads();
    const float* cw = p.in[I_CW] + (size_t)l * 31 * 256 + c; float w[31];
#pragma unroll
    for (int jj = 0; jj < 31; ++jj) w[jj] = cw[jj * 256];
    const float cb = p.in[I_CB][l * 256 + c];
    const float lng = p.in[I_CLG][l * 256 + c], lnb = p.in[I_CLB][l * 256 + c];
#pragma unroll 1
    for (int ps = 0; ps < 2; ++ps) { const int tb = hf * 32 + ps * 16;
        float o[16];
        { float hr[46];
#pragma unroll
          for (int r = 0; r < 46; ++r) hr[r] = Hs[(tb + r) * 256 + c];
#pragma unroll
          for (int j = 0; j < 16; ++j) { float a = cb;
#pragma unroll
            for (int jj = 0; jj < 31; ++jj) a += w[jj] * hr[j + jj];
            o[j] = a; } }
#pragma unroll
        for (int j = 0; j < 16; ++j) { const float s1 = wave_sum(o[j]), s2 = wave_sum(o[j] * o[j]); if (lane == 0) { ST[((tb + j) * 4 + wv) * 2] = s1; ST[((tb + j) * 4 + wv) * 2 + 1] = s2; } }
        __syncthreads();
#pragma unroll
        for (int j = 0; j < 16; ++j) { const LAS float* q = ST + (tb + j) * 8; const float s1 = (q[0] + q[2]) + (q[4] + q[6]), s2 = (q[1] + q[3]) + (q[5] + q[7]);
            const float mu = s1 * (1.0f / 256.0f); const float var = fmaxf(s2 * (1.0f / 256.0f) - mu * mu, 0.f);
            const float y = (o[j] - mu) * rsqrtf(var + EPS) * lng + lnb; const float sv = y * sigmoidf_(y); o[j] = sv;
            const float s3 = wave_sum(sv * sv); if (lane == 0) ST2[(tb + j) * 4 + wv] = s3; }
        __syncthreads();
#pragma unroll
        for (int j = 0; j < 16; ++j) { const LAS float* q = ST2 + (tb + j) * 4; const float tot = (q[0] + q[1]) + (q[2] + q[3]); const float rs = rsqrtf(tot * (1.0f / 256.0f) + EPS);
            Y[(size_t)(tok0 + tb + j) * D + YB + c] = (bf16_t)f2bf(o[j] * rs); }
    }
}

DI bf16x8 ldg8(const bf16_t* p) { return *(const bf16x8*)p; }
DI void s5_local_item(const Params& p, int l, int bi) {
    int tid_o = threadIdx.x; asm volatile("" : "+v"(tid_o));
    const int lane = tid_o & 63, wi = bi * 8 + (tid_o >> 6);
    const int g = wi & 15, cb = (wi >> 4) & 15, pt = wi >> 8, c0 = lane & 31, h = lane >> 5;
    const bf16_t* ua = (const bf16_t*)(p.ws + WS_Z) + (size_t)((cb * 32 + c0) * 64) * DIN + ZCU + g * 16 + 8 * h;
    const bf16_t* wb = (const bf16_t*)(p.ws + WS_S5WS) + ((size_t)(l * 16 + g) * 128 + pt * 32 + c0) * 1024 + 8 * h;
    f32x16 acc = zero16();
#pragma unroll 8
    for (int s = 0; s < 64; ++s) acc = __builtin_amdgcn_mfma_f32_32x32x16_bf16(ldg8(ua + (size_t)s * DIN), ldg8(wb + s * 16), acc, 0, 0, 0);
    float* HL = (float*)(p.ws + WS_S5H);
#pragma unroll
    for (int i = 0; i < 16; ++i) HL[((size_t)(cb * 32 + crow(i, h)) * 16 + g) * 128 + pt * 32 + c0] = acc[i];
}
DI void s5_scan_item(const Params& p, int l, int sb) {
    int tid_o = threadIdx.x; asm volatile("" : "+v"(tid_o));
    const int e = sb * 512 + tid_o, b = e >> 10, g = (e >> 6) & 15, pp = e & 63;
    float lrdt, lidt, cr, ci; s5_params(p, l * 16 + g, pp, lrdt, lidt, cr, ci);
    float ar, ai; s5_pow(lrdt, lidt, 64, ar, ai);
    const float* HL = (const float*)(p.ws + WS_S5H); float* HO = (float*)(p.ws + WS_S5H2); float hr = 0.f, hi = 0.f;
    for (int c8 = 0; c8 < 128; c8 += 16) { float tr[16], ti[16];
#pragma unroll
        for (int u = 0; u < 16; ++u) { const size_t idx = ((size_t)(b * 128 + c8 + u) * 16 + g) * 128; tr[u] = HL[idx + pp]; ti[u] = HL[idx + 64 + pp]; }
#pragma unroll
        for (int u = 0; u < 16; ++u) { const size_t idx = ((size_t)(b * 128 + c8 + u) * 16 + g) * 128; HO[idx + pp] = hr; HO[idx + 64 + pp] = hi;
            const float nr = ar * hr - ai * hi + tr[u], ni = ar * hi + ai * hr + ti[u]; hr = nr; hi = ni; } }
}
DI void s5_out_item(const Params& p, LAS unsigned char* lds, int l, int bi) {
    int tid_o = threadIdx.x; asm volatile("" : "+v"(tid_o));
    const int tid = tid_o, lane = tid & 63, wave = tid >> 6;
    const int gh = bi & 1, cb = (bi >> 1) & 15, pr = bi >> 5, g = gh * 8 + wave, c0 = lane & 31, h = lane >> 5, lg = l * 16 + g;
    LAS bf16_t* OT = (LAS bf16_t*)lds;
    const bf16_t* Z = (const bf16_t*)(p.ws + WS_Z);
    const bf16_t* ua = Z + (size_t)((cb * 32 + c0) * 64) * DIN + ZCU + g * 16 + 8 * h;
    const bf16_t* kt = (const bf16_t*)(p.ws + WS_S5K) + (size_t)lg * 64 * 256;
    const float* ha = (const float*)(p.ws + WS_S5H2) + ((size_t)(cb * 32 + c0) * 16 + g) * 128 + 8 * h;
    const int co = c0 & 15; const float dsk = p.in[I_S5D][l * 256 + g * 16 + co];
    __syncthreads();
    for (int q = 0; q < 2; ++q) { const int jt = q ? 31 - pr : pr; const int tl = 2 * jt + (c0 >> 4);
        f32x16 acc = zero16();
        const bf16_t* wc = (const bf16_t*)(p.ws + WS_S5WC) + (((size_t)lg * 64 + tl) * 16 + co) * 128 + 8 * h;
        { f32x4 x0[8], x1[8]; bf16x8 wv[8];
#pragma unroll
          for (int ks = 0; ks < 8; ++ks) { x0[ks] = *(const f32x4*)(ha + ks * 16); x1[ks] = *(const f32x4*)(ha + ks * 16 + 4); wv[ks] = ldg8(wc + ks * 16); }
#pragma unroll
          for (int ks = 0; ks < 8; ++ks) { u32x4 w; w.x = pk2(x0[ks][0], x0[ks][1]); w.y = pk2(x0[ks][2], x0[ks][3]); w.z = pk2(x1[ks][0], x1[ks][1]); w.w = pk2(x1[ks][2], x1[ks][3]);
            acc = __builtin_amdgcn_mfma_f32_32x32x16_bf16(__builtin_bit_cast(bf16x8, w), wv[ks], acc, 0, 0, 0); } }
        const int ns = (2 * jt + 2 + 7) & ~7;
        for (int s0 = 0; s0 < ns; s0 += 8) { bf16x8 av[8], bv[8];
#pragma unroll
            for (int e = 0; e < 8; ++e) { const int s = s0 + e, d = tl - s, dc = d < 0 ? 0 : d;
                av[e] = ldg8(ua + (size_t)s * DIN); bv[e] = ldg8(kt + ((size_t)dc * 16 + co) * 16 + 8 * h); }
#pragma unroll
            for (int e = 0; e < 8; ++e) { const int d = tl - (s0 + e); bf16x8 b = bv[e]; if (d < 0) b = (bf16x8){0, 0, 0, 0, 0, 0, 0, 0};
                acc = __builtin_amdgcn_mfma_f32_32x32x16_bf16(av[e], b, acc, 0, 0, 0); } }
#pragma unroll
        for (int i = 0; i < 16; ++i) { const int m = crow(i, h); const size_t tok = (size_t)(cb * 32 + m) * 64 + tl; const float u = bf2f(Z[tok * DIN + ZCU + g * 16 + co]);
            const float y = acc[i] + dsk * u; const float ge = y * sigmoidf_(1.5957691216057308f * (y + 0.044715f * y * y * y));
            OT[(q * 64 + m * 2 + (c0 >> 4)) * 136 + wave * 16 + co] = (bf16_t)f2bf(ge); }
    }
    __syncthreads();
    { const int tau = tid >> 2, qq = tau >> 6, m = (tau >> 1) & 31, t2 = tau & 1, qt = tid & 3; const int jt = qq ? 31 - pr : pr;
      const size_t tok = (size_t)(cb * 32 + m) * 64 + 2 * jt + t2;
      const LAS u32x4* src = (const LAS u32x4*)(OT + tau * 136 + qt * 32); u32x4* dst = (u32x4*)((bf16_t*)(p.ws + WS_YPRE) + tok * 256 + gh * 128 + qt * 32);
#pragma unroll
      for (int e = 0; e < 4; ++e) dst[e] = src[e]; }
}

DI void attn_item(const Params& p, LAS unsigned char* lds, int l, int pt, int id) {
    int tid_o = threadIdx.x; asm volatile("" : "+v"(tid_o));
    const int tid = tid_o, lane = tid & 63, wave = tid >> 6;
    const int dil = pt == 0 ? 1 : (pt == 1 ? 4 : 16), nblk = 32 / dil;
    const int b = id >> 7, hd = (id >> 5) & 3, rn = id & 31, r = rn / nblk, n = rn % nblk;
    LAS bf16_t* Ks = (LAS bf16_t*)lds;
    LAS bf16_t* Vt = (LAS bf16_t*)(lds + 55296);
    LAS float* BT = (LAS float*)(lds + 55296 + 50176);
    const bf16_t* Z = (const bf16_t*)(p.ws + WS_Z);
    const bf16_t* OP = (const bf16_t*)(p.ws + (pt == 1 ? WS_O0 : WS_O1)); const float* LP = (const float*)(p.ws + (pt == 1 ? WS_LSE : WS_LSE1));
    bf16_t* ON = pt == 2 ? (bf16_t*)(p.ws + WS_Z) + ZOD : (bf16_t*)(p.ws + (pt == 0 ? WS_O0 : WS_O1)); const int onp = pt == 2 ? DIN : 256;
    float* LN = (float*)(p.ws + (pt == 0 ? WS_LSE : WS_LSE1));
    const size_t tokb = (size_t)b * SEQ;
    const int c0 = lane & 31, h = lane >> 5;
    const int qi = 32 * wave + c0; const size_t tokq = tokb + (size_t)(n * 256 + qi) * dil + r;
    u32x4 qraw[4]; u32x2 oprev[2][4]; float mprev = 0.f;
#pragma unroll
    for (int ks = 0; ks < 4; ++ks) qraw[ks] = *(const u32x4*)(Z + tokq * DIN + ZDQ + hd * 64 + ks * 16 + 8 * h);
    if (pt > 0) { mprev = LP[tokq * 4 + hd];
#pragma unroll
        for (int vt = 0; vt < 2; ++vt)
#pragma unroll
            for (int g4 = 0; g4 < 4; ++g4) oprev[vt][g4] = *(const u32x2*)(OP + tokq * 256 + hd * 64 + 32 * vt + 8 * g4 + 4 * h); }
    __syncthreads();
    if (tid < 132) BT[tid] = ((const float*)(p.ws + WS_BIAS))[(pt * 4 + hd) * 132 + tid];
    { const float* kg = p.in[I_KG] + l * 64 + (tid & 7) * 8; float kgv[8];
#pragma unroll
      for (int e = 0; e < 8; ++e) kgv[e] = kg[e];
      u32x4 kwv[6], vwv[6];
#pragma unroll
      for (int it = 0; it < 6; ++it) { const int idx = tid + 512 * it, row = idx >> 3, c = idx & 7, si = n * 256 - 128 + row;
        const size_t tok = tokb + (size_t)(si < 0 ? 0 : si) * dil + r;
        kwv[it] = *(const u32x4*)(Z + tok * DIN + ZDK + hd * 64 + c * 8); vwv[it] = *(const u32x4*)(Z + tok * DIN + ZDV + hd * 64 + c * 8); }
#pragma unroll
      for (int it = 0; it < 6; ++it) { const int idx = tid + 512 * it, row = idx >> 3, c = idx & 7, si = n * 256 - 128 + row;
        u32x4 kw = kwv[it], vw = vwv[it];
        if (si < 0) { kw = (u32x4){0u, 0u, 0u, 0u}; vw = (u32x4){0u, 0u, 0u, 0u}; }
        float kf[8]; kf[0] = bflo(kw.x); kf[1] = bfhi(kw.x); kf[2] = bflo(kw.y); kf[3] = bfhi(kw.y); kf[4] = bflo(kw.z); kf[5] = bfhi(kw.z); kf[6] = bflo(kw.w); kf[7] = bfhi(kw.w);
        float ss = 0.f;
#pragma unroll
        for (int e = 0; e < 8; ++e) ss += kf[e] * kf[e];
        ss += __shfl_xor(ss, 1); ss += __shfl_xor(ss, 2); ss += __shfl_xor(ss, 4);
        const float rs = rsqrtf(ss * (1.0f / 64.0f) + EPS);
        u32x4 o; o.x = pk2(kf[0] * rs * kgv[0], kf[1] * rs * kgv[1]); o.y = pk2(kf[2] * rs * kgv[2], kf[3] * rs * kgv[3]); o.z = pk2(kf[4] * rs * kgv[4], kf[5] * rs * kgv[5]); o.w = pk2(kf[6] * rs * kgv[6], kf[7] * rs * kgv[7]);
        *(LAS u32x4*)(Ks + row * 72 + c * 8) = o;
        LAS bf16_t* vp = Vt + (c * 8) * 392 + row;
        vp[0 * 392] = (bf16_t)(vw.x & 0xffffu); vp[1 * 392] = (bf16_t)(vw.x >> 16); vp[2 * 392] = (bf16_t)(vw.y & 0xffffu); vp[3 * 392] = (bf16_t)(vw.y >> 16);
        vp[4 * 392] = (bf16_t)(vw.z & 0xffffu); vp[5 * 392] = (bf16_t)(vw.z >> 16); vp[6 * 392] = (bf16_t)(vw.w & 0xffffu); vp[7 * 392] = (bf16_t)(vw.w >> 16); } }
    __syncthreads();
    bf16x8 qf[4];
    { float qv[4][8]; float ss = 0.f;
#pragma unroll
      for (int ks = 0; ks < 4; ++ks) { const u32x4 w = qraw[ks];
        qv[ks][0] = bflo(w.x); qv[ks][1] = bfhi(w.x); qv[ks][2] = bflo(w.y); qv[ks][3] = bfhi(w.y); qv[ks][4] = bflo(w.z); qv[ks][5] = bfhi(w.z); qv[ks][6] = bflo(w.w); qv[ks][7] = bfhi(w.w);
#pragma unroll
        for (int e = 0; e < 8; ++e) ss += qv[ks][e] * qv[ks][e]; }
      ss += __shfl_xor(ss, 32);
      const float rs = rsqrtf(ss * (1.0f / 64.0f) + EPS) * 0.125f;
#pragma unroll
      for (int ks = 0; ks < 4; ++ks) { const float* qg = p.in[I_QG] + l * 64 + ks * 16 + 8 * h; const f32x4 g0 = *(const f32x4*)qg, g1 = *(const f32x4*)(qg + 4);
        u32x4 w; w.x = pk2(qv[ks][0] * rs * g0[0], qv[ks][1] * rs * g0[1]); w.y = pk2(qv[ks][2] * rs * g0[2], qv[ks][3] * rs * g0[3]);
        w.z = pk2(qv[ks][4] * rs * g1[0], qv[ks][5] * rs * g1[1]); w.w = pk2(qv[ks][6] * rs * g1[2], qv[ks][7] * rs * g1[3]);
        qf[ks] = __builtin_bit_cast(bf16x8, w); } }
    f32x16 acc[5];
#pragma unroll
    for (int c = 0; c < 5; ++c) { acc[c] = zero16(); const LAS bf16_t* kb = Ks + (32 * wave + 32 * c + c0) * 72 + 8 * h;
#pragma unroll
        for (int ks = 0; ks < 4; ++ks) acc[c] = __builtin_amdgcn_mfma_f32_32x32x16_bf16(*(const LAS bf16x8*)(kb + ks * 16), qf[ks], acc[c], 0, 0, 0); }
    float mx = -1e30f;
#pragma unroll
    for (int c = 0; c < 5; ++c)
#pragma unroll
        for (int i = 0; i < 16; ++i) { const int kr = crow(i, h); const int delta = 128 + c0 - 32 * c - kr; const int jl = 32 * wave + 32 * c + kr;
            const bool valid = (delta >= 0) && (delta <= 128) && (n * 256 - 128 + jl >= 0);
            const int dcl = delta < 0 ? 0 : (delta > 128 ? 128 : delta);
            const float lgt = valid ? acc[c][i] + BT[dcl] : -1e30f; acc[c][i] = lgt; mx = fmaxf(mx, lgt); }
    mx = fmaxf(mx, __shfl_xor(mx, 32));
    float mnew = mx;
    if (pt > 0) mnew = fmaxf(mx, mprev);
    float lsum = 0.f;
#pragma unroll
    for (int c = 0; c < 5; ++c)
#pragma unroll
        for (int i = 0; i < 16; ++i) { const float pv = __expf(acc[c][i] - mnew); acc[c][i] = pv; lsum += pv; }
    lsum += __shfl_xor(lsum, 32);
    f32x16 o[2]; o[0] = zero16(); o[1] = zero16();
#pragma unroll
    for (int c = 0; c < 5; ++c)
#pragma unroll
        for (int s = 0; s < 2; ++s) { u32x4 pw; pw.x = pk2(acc[c][8 * s + 0], acc[c][8 * s + 1]); pw.y = pk2(acc[c][8 * s + 2], acc[c][8 * s + 3]); pw.z = pk2(acc[c][8 * s + 4], acc[c][8 * s + 5]); pw.w = pk2(acc[c][8 * s + 6], acc[c][8 * s + 7]);
            const bf16x8 pf = __builtin_bit_cast(bf16x8, pw);
#pragma unroll
            for (int vt = 0; vt < 2; ++vt) { const LAS bf16_t* va = Vt + (32 * vt + c0) * 392 + 32 * wave + 32 * c + 16 * s + 4 * h;
                const s16x4 lo = *(const LAS s16x4*)va, hi = *(const LAS s16x4*)(va + 8);
                const bf16x8 vf = __builtin_shufflevector(lo, hi, 0, 1, 2, 3, 4, 5, 6, 7);
                o[vt] = __builtin_amdgcn_mfma_f32_32x32x16_bf16(vf, pf, o[vt], 0, 0, 0); } }
    float sp = 0.f; if (pt > 0) sp = __expf(mprev - mnew);
    const float ltot = lsum + sp, inv = 1.0f / ltot;
#pragma unroll
    for (int vt = 0; vt < 2; ++vt)
#pragma unroll
        for (int g4 = 0; g4 < 4; ++g4) { const int ch = hd * 64 + 32 * vt + 8 * g4 + 4 * h; bf16_t* yo = ON + tokq * onp + ch;
            float v0 = o[vt][4 * g4 + 0], v1 = o[vt][4 * g4 + 1], v2 = o[vt][4 * g4 + 2], v3 = o[vt][4 * g4 + 3];
            if (pt > 0) { const u32x2 w = oprev[vt][g4]; v0 += sp * bflo(w.x); v1 += sp * bfhi(w.x); v2 += sp * bflo(w.y); v3 += sp * bfhi(w.y); }
            u32x2 w; w.x = pk2(v0 * inv, v1 * inv); w.y = pk2(v2 * inv, v3 * inv); *(u32x2*)yo = w; }
    if (h == 0 && pt < 2) __hip_atomic_store(LN + tokq * 4 + hd, mnew + __logf(ltot), __ATOMIC_RELAXED, __HIP_MEMORY_SCOPE_AGENT);
}

#define RLX_AGENT __ATOMIC_RELAXED, __HIP_MEMORY_SCOPE_AGENT
#define XB_TMO      128
#define XB_XCNT(j)  (256  + 64 * (j))
#define XB_XSUB(j)  (1280 + 64 * (j))
#define XB_XGEN(j)  (2304 + 64 * (j))
#define XB_TOP      3328
#define XB_TOPGEN   3392
#define XCD_BAR_WORDS 3456
#define XB_SPIN_CAP (1u << 18)

__device__ __forceinline__ unsigned xb_ld(unsigned* p)              { return __hip_atomic_load(p, __ATOMIC_RELAXED, __HIP_MEMORY_SCOPE_AGENT); }
__device__ __forceinline__ unsigned xb_add(unsigned* p, unsigned v) { return __hip_atomic_fetch_add(p, v, __ATOMIC_RELAXED, __HIP_MEMORY_SCOPE_AGENT); }
__device__ __forceinline__ unsigned xb_xcc_id() { return (unsigned)__builtin_amdgcn_s_getreg((3 << 11) | 20) & 0xFu; }
#define XB_SPIN(cond, bar) do { unsigned _sp = 0; while (cond) { __builtin_amdgcn_s_sleep(1); \
    if ((++_sp & 255u) == 0u) { if (xb_ld(&(bar)[XB_TMO])) break; if (_sp > XB_SPIN_CAP) { atomicAdd(&(bar)[XB_TMO], 1u); break; } } } } while (0)

struct XcdBarrier {
    unsigned* bar; unsigned x;
    volatile LAS unsigned* st;
};

__device__ __forceinline__ XcdBarrier xcd_barrier_post(unsigned* bar, volatile LAS unsigned* st) {
    XcdBarrier b; b.bar = bar; b.x = xb_xcc_id(); b.st = st;
    if (threadIdx.x == 0) (void)xb_add(&bar[XB_XCNT(b.x)], 1u);
    return b;
}
__device__ __forceinline__ void xcd_barrier_complete(unsigned* bar, unsigned x, unsigned& nloc, unsigned& nx) {
    const unsigned G = gridDim.x * gridDim.y * gridDim.z;
    unsigned sum, cnt, mine, sp = 0u;
    for (;;) {
        sum = 0u; cnt = 0u; mine = 0u;
#pragma unroll
        for (unsigned j = 0; j < 16; ++j) { const unsigned c = xb_ld(&bar[XB_XCNT(j)]); sum += c; cnt += (c > 0u) ? 1u : 0u; mine = (j == x) ? c : mine; }
        if (sum == G) break;
        __builtin_amdgcn_s_sleep(1);
        if ((++sp & 255u) == 0u) { if (xb_ld(&bar[XB_TMO])) break; if (sp > XB_SPIN_CAP) { atomicAdd(&bar[XB_TMO], 1u); break; } }
    }
    nloc = mine > 0u ? mine : 1u; nx = cnt > 0u ? cnt : 1u;
}

__device__ __forceinline__ void xcd_barrier(const XcdBarrier& b) {
    asm volatile("s_waitcnt vmcnt(0)" ::: "memory");
    __syncthreads();
    if (threadIdx.x == 0) {
        unsigned* bar = b.bar;
        __builtin_amdgcn_s_waitcnt(0);
        unsigned nloc = b.st[0], nx = b.st[1];
        if (nloc == 0u) { xcd_barrier_complete(bar, b.x, nloc, nx); b.st[0] = nloc; b.st[1] = nx; }
        const unsigned old = xb_add(&bar[XB_XSUB(b.x)], 1u);
        const unsigned gen = old / nloc;
        if (old + 1u == (gen + 1u) * nloc) {
            __builtin_amdgcn_fence(__ATOMIC_RELEASE, "agent");
            asm volatile("s_waitcnt vmcnt(0)" ::: "memory");
            const unsigned og = xb_add(&bar[XB_TOP], 1u);
            const unsigned tg = og / nx;
            if (og + 1u == (tg + 1u) * nx) xb_add(&bar[XB_TOPGEN], 1u);
            else XB_SPIN(xb_ld(&bar[XB_TOPGEN]) == tg, bar);
            __builtin_amdgcn_fence(__ATOMIC_ACQUIRE, "agent");
            xb_add(&bar[XB_XGEN(b.x)], 1u);
            asm volatile("s_waitcnt vmcnt(0)" ::: "memory");
        } else {
            XB_SPIN(xb_ld(&bar[XB_XGEN(b.x)]) == gen, bar);
            __builtin_amdgcn_fence(__ATOMIC_ACQUIRE, "agent");
            asm volatile("s_waitcnt vmcnt(0)" ::: "memory");
        }
    }
    __syncthreads();
}

#ifndef REP_A
#define REP_A 0
#endif
#ifndef REP_B
#define REP_B 0
#endif
#ifndef REP_C
#define REP_C 0
#endif
#ifndef REP_D
#define REP_D 0
#endif
#ifndef MIX_A
#define MIX_A 1
#endif
#ifndef MIX_B
#define MIX_B 1
#endif
#ifndef MIX_C
#define MIX_C 1
#endif
#ifndef MIX_D
#define MIX_D 1
#endif
__global__ void __launch_bounds__(512, 2) hybrid_fwd(Params p) {
    extern __shared__ __attribute__((aligned(16))) unsigned char lds_raw[];
    LAS unsigned char* lds = (LAS unsigned char*)lds_raw;
    cg::grid_group grid = cg::this_grid();
    { volatile LAS unsigned* st0 = (volatile LAS unsigned*)(lds + LDS_BYTES - 64); if (threadIdx.x < 2) st0[threadIdx.x] = 0u; }
    __syncthreads();
    (void)xcd_barrier_post((unsigned*)(p.ws + WS_BAR), (volatile LAS unsigned*)(lds + LDS_BYTES - 64));
    const int G = gridDim.x, bid = blockIdx.x;
    unsigned char* ws = p.ws;
    bf16_t* XB = (bf16_t*)(ws + WS_XB); bf16_t* Zb = (bf16_t*)(ws + WS_Z); bf16_t* YC_ = (bf16_t*)(ws + WS_YCAT); bf16_t* HM = (bf16_t*)(ws + WS_HM);
    float* SSQP = (float*)(ws + WS_SSQP);

#define GRID_SYNC_() do { asm volatile("s_waitcnt vmcnt(0) lgkmcnt(0)" ::: "memory"); grid.sync(); if (threadIdx.x < 64) { __builtin_amdgcn_fence(__ATOMIC_ACQUIRE, "agent"); asm volatile("s_waitcnt vmcnt(0)" ::: "memory"); } __syncthreads(); } while (0)
#define XBAR_ONCE() do { XcdBarrier b_; b_.bar = (unsigned*)(p.ws + WS_BAR); b_.x = xb_xcc_id(); b_.st = (volatile LAS unsigned*)(lds + LDS_BYTES - 64); xcd_barrier(b_); } while (0)
#ifdef REP_SYNC
#define GRID_SYNC() do { XBAR_ONCE(); XBAR_ONCE(); } while (0)
#else
#define GRID_SYNC() XBAR_ONCE()
#endif
    prologue(p, lds, G);
#ifdef REP_PRO
    GRID_SYNC_(); prologue(p, lds, G);
#endif
#ifdef NANFILL
    { u32x4* q = (u32x4*)(ws + WS_S5H); const size_t n16 = (WS_END - WS_S5H) / 16; const u32x4 nanv = (u32x4){0xffffffffu, 0xffffffffu, 0xffffffffu, 0xffffffffu};
      for (size_t i = (size_t)bid * 512 + threadIdx.x; i < n16; i += (size_t)G * 512) q[i] = nanv;
      u32x4* q2 = (u32x4*)(ws + WS_LSE); const size_t m16 = (WS_S5K - WS_LSE) / 16;
      for (size_t i = (size_t)bid * 512 + threadIdx.x; i < m16; i += (size_t)G * 512) q2[i] = nanv; }
#endif
    if (gridDim.y == 0x7fffffffu) GRID_SYNC_();
    GRID_SYNC();

#ifndef NL_RUN
#define NL_RUN NL
#endif
#ifndef DUMP_LAYER
#define DUMP_LAYER 0
#endif
    for (int lrun = 0; lrun < NL_RUN; ++lrun) {
#ifdef SAME_LAYER
        const int l = 0; const bool firstl = (lrun == 0), lastl = (lrun == NL_RUN - 1);
#else
        const int l = lrun; const bool firstl = (lrun == 0), lastl = (lrun == NL_RUN - 1);
#endif
#define RS_TABLE(SSQ_, NUNITS_) \
          { pg8::Unit ua_, ub_; (void)S.next(0, ua_); (void)S.next((NUNITS_) - 1, ub_); \
              int tq_ = threadIdx.x; asm volatile("" : "+v"(tq_)); const int pm_ = (tq_ >> 8) ? ub_.pm : ua_.pm; \
              const f32x4* sq_ = (const f32x4*)((SSQ_) + ((size_t)pm_ * 256 + (tq_ & 255)) * 16); const f32x4 q0 = sq_[0], q1 = sq_[1], q2 = sq_[2], q3 = sq_[3]; \
              const float tot_ = (((q0[0] + q0[1]) + (q0[2] + q0[3])) + ((q1[0] + q1[1]) + (q1[2] + q1[3]))) + (((q2[0] + q2[1]) + (q2[2] + q2[3])) + ((q3[0] + q3[1]) + (q3[2] + q3[3]))); \
              ((LAS float*)(lds + 131072))[tq_] = rsqrtf(tot_ * (1.0f / 1024.0f) + EPS); __syncthreads(); }
        { pg8::Gemm g{XB, (const bf16_t*)(ws + WS_WIN) + (size_t)l * D * DIN, T, DIN, D, D}; pg8::StaticOrder S; S.init(T, DIN, G, bid);
          RS_TABLE(SSQP, (T / 256) * (DIN / 256) / 256)
          pg8::EpiScale E{Zb, DIN, 0, (const PG8_LAS float*)(lds + 131072)};
          pg8::gemm_phase<pg8::EpiScale, pg8::StaticOrder, true, true>(lds, g, S, E);
#ifdef REPEAT_GEMM
          GRID_SYNC(); pg8::gemm_phase<pg8::EpiScale, pg8::StaticOrder, true, true>(lds, g, S, E);
#endif
        }
        GRID_SYNC();
#ifndef SKIP_MIX
        if (!(MIX_A && MIX_B && MIX_C && MIX_D)) { int tq = threadIdx.x; asm volatile("" : "+v"(tq));
          for (int m = bid * 8 + (tq >> 6); m < T; m += G * 8) { u32x2* yp = (u32x2*)(YC_ + (size_t)m * D) + (tq & 63); const u32x2 z2 = (u32x2){0u, 0u};
              if (!MIX_A) yp[0] = z2; if (!MIX_B) yp[64] = z2; if (!MIX_C) yp[128] = z2; if (!MIX_D) yp[192] = z2; } }
#ifndef MIX_REPEAT
#define MIX_REPEAT 1
#endif
        for (int rep = 0; rep < MIX_REPEAT; ++rep) {
        for (int it = bid; it < 1664; it += G) {
            if (it < 512) { if (MIX_A) { hgrn_item<false>(p, lds, l, it); if (REP_A) hgrn_item<false>(p, lds, l, it); } }
            else if (it < 1024) { if (MIX_B) { conv_item(p, lds, l, it - 512); if (REP_B) conv_item(p, lds, l, it - 512); } }
            else if (it < 1152) { if (MIX_C) { s5_local_item(p, l, it - 1024); if (REP_C) s5_local_item(p, l, it - 1024); } }
            else { if (MIX_D) { attn_item(p, lds, l, 0, it - 1152); if (REP_D) attn_item(p, lds, l, 0, it - 1152); } }
        }
        GRID_SYNC();
        for (int it = bid; it < 648; it += G) {
            if (it < 128) { if (MIX_A) hgrn_scan_item(p, it); }
            else if (it < 136) { if (MIX_C) s5_scan_item(p, l, it - 128); }
            else { if (MIX_D) { attn_item(p, lds, l, 1, it - 136); if (REP_D) attn_item(p, lds, l, 1, it - 136); } }
        }
        GRID_SYNC();
#ifdef REP_P3
        for (int it = bid; it < 648; it += G) {
            if (it < 128) { if (MIX_A) hgrn_scan_item(p, it); }
            else if (it < 136) { if (MIX_C) s5_scan_item(p, l, it - 128); }
            else { if (MIX_D) { attn_item(p, lds, l, 1, it - 136); if (REP_D) attn_item(p, lds, l, 1, it - 136); } }
        }
        GRID_SYNC();
#endif
        for (int it = bid; it < 1536; it += G) {
            if (it < 512) { if (MIX_A) { hgrn_item<true>(p, lds, l, it); if (REP_A) hgrn_item<true>(p, lds, l, it); } }
            else if (it < 1024) { if (MIX_C) { s5_out_item(p, lds, l, it - 512); if (REP_C) s5_out_item(p, lds, l, it - 512); } }
            else { if (MIX_D) { attn_item(p, lds, l, 2, it - 1024); if (REP_D) attn_item(p, lds, l, 2, it - 1024); } }
        }
        GRID_SYNC();
        }
#ifndef NO_GLU
        { pg8::Gemm g{(const bf16_t*)(ws + WS_YPRE), (const bf16_t*)(ws + WS_WGLU) + (size_t)l * 65536, T, 256, 256, 256}; pg8::StaticOrder S; S.init(T, 256, G, bid);
          pg8::EpiGlu E{(const bf16_t*)(ws + WS_YPRE), 256, YC_ + YC};
          pg8::gemm_phase<pg8::EpiGlu, pg8::StaticOrder, false, true>(lds, g, S, E); }
#endif
        { int tq = threadIdx.x; asm volatile("" : "+v"(tq)); const int lane = tq & 63; const int gw = bid * 8 + (tq >> 6), NGW = G * 8;
          for (int m = gw; m < T; m += NGW) { u32x2* yp = (u32x2*)(YC_ + (size_t)m * D + YD) + lane; const u32x2 w = *((const u32x2*)(Zb + (size_t)m * DIN + ZOD) + lane);
              const float a0 = bflo(w.x), a1 = bfhi(w.x), a2 = bflo(w.y), a3 = bfhi(w.y);
              const float ss = wave_sum((a0 * a0 + a1 * a1) + (a2 * a2 + a3 * a3)); const float rs = rsqrtf(ss * (1.0f / 256.0f) + EPS);
              u32x2 o; o.x = pk2(a0 * rs, a1 * rs); o.y = pk2(a2 * rs, a3 * rs); *yp = o; } }
        GRID_SYNC();
#endif
#ifdef REP_P5
#ifndef NO_GLU
        { pg8::Gemm g{(const bf16_t*)(ws + WS_YPRE), (const bf16_t*)(ws + WS_WGLU) + (size_t)l * 65536, T, 256, 256, 256}; pg8::StaticOrder S; S.init(T, 256, G, bid);
          pg8::EpiGlu E{(const bf16_t*)(ws + WS_YPRE), 256, YC_ + YC};
          pg8::gemm_phase<pg8::EpiGlu, pg8::StaticOrder, false, true>(lds, g, S, E); }
#endif
        { int tq = threadIdx.x; asm volatile("" : "+v"(tq)); const int lane = tq & 63; const int gw = bid * 8 + (tq >> 6), NGW = G * 8;
          for (int m = gw; m < T; m += NGW) { u32x2* yp = (u32x2*)(YC_ + (size_t)m * D + YD) + lane; const u32x2 w = *((const u32x2*)(Zb + (size_t)m * DIN + ZOD) + lane);
              const float a0 = bflo(w.x), a1 = bfhi(w.x), a2 = bflo(w.y), a3 = bfhi(w.y);
              const float ss = wave_sum((a0 * a0 + a1 * a1) + (a2 * a2 + a3 * a3)); const float rs = rsqrtf(ss * (1.0f / 256.0f) + EPS);
              u32x2 o; o.x = pk2(a0 * rs, a1 * rs); o.y = pk2(a2 * rs, a3 * rs); *yp = o; } }
        GRID_SYNC();
#endif
#ifdef DUMP_SLICE
        if (lrun == DUMP_LAYER) { int tq = threadIdx.x; asm volatile("" : "+v"(tq));
          for (int m = bid * 8 + (tq >> 6); m < T; m += G * 8) { const int ln = tq & 63;
              for (int j = 0; j < 4; ++j) { const int col = j * 256 + ln * 4; const u32x2 w = *(const u32x2*)(YC_ + (size_t)m * D + col);
                  f32x4 o = (f32x4){0.f, 0.f, 0.f, 0.f}; if (j == DUMP_SLICE) o = (f32x4){bflo(w.x), bfhi(w.x), bflo(w.y), bfhi(w.y)};
                  *(f32x4*)(p.out + (size_t)m * D + col) = o; } }
          break; }
#endif
#ifdef SKIP_MIX
        { pg8::Gemm g{Zb, (const bf16_t*)(ws + WS_WOUT) + (size_t)l * D * D, T, D, D, DIN}; pg8::StaticOrder S; S.init(T, D, G, bid);
#else
        { pg8::Gemm g{YC_, (const bf16_t*)(ws + WS_WOUT) + (size_t)l * D * D, T, D, D, D}; pg8::StaticOrder S; S.init(T, D, G, bid);
#endif
          pg8::EpiRes E{firstl ? p.in[I_X] : p.out, p.out, XB, SSQP + (size_t)T * 16};
          pg8::gemm_phase<pg8::EpiRes, pg8::StaticOrder, true, true>(lds, g, S, E); }
        GRID_SYNC();
        { pg8::Gemm g{XB, (const bf16_t*)(ws + WS_WUP) + (size_t)l * D * FF, T, FF, D, D}; pg8::StaticOrder S; S.init(T, FF, G, bid);
          RS_TABLE(SSQP + (size_t)T * 16, (T / 256) * (FF / 256) / 256)
          pg8::EpiScale E{HM, FF, 1, (const PG8_LAS float*)(lds + 131072)};
          pg8::gemm_phase<pg8::EpiScale, pg8::StaticOrder, true, true>(lds, g, S, E);
#ifdef REPEAT_GEMM
          GRID_SYNC(); pg8::gemm_phase<pg8::EpiScale, pg8::StaticOrder, true, true>(lds, g, S, E);
#endif
        }
        GRID_SYNC();
        { pg8::Gemm g{HM, (const bf16_t*)(ws + WS_WDN) + (size_t)l * D * FF, T, D, FF, FF}; pg8::StaticOrder S; S.init(T, D, G, bid);
          pg8::EpiRes E{p.out, p.out, XB, !lastl ? SSQP : nullptr};
          pg8::gemm_phase<pg8::EpiRes, pg8::StaticOrder, true, true>(lds, g, S, E); }
        if (!lastl) GRID_SYNC();
    }
}

extern "C" void kernel_launch(void* const* d_in, const int* in_sizes, int n_in, void* d_out, int out_size, void* d_ws, size_t ws_size, hipStream_t stream) {
    static int grid = 0;
    if (grid == 0) {
        if (n_in != 26 || out_size != T * D || ws_size < WS_END) { fprintf(stderr, "kernel_launch: unexpected shapes (n_in %d, out %d, ws %zu); nothing launched\n", n_in, out_size, ws_size); grid = -1; return; }
        int dev = 0, cus = 0, per_cu = 0;
        (void)hipGetDevice(&dev); (void)hipDeviceGetAttribute(&cus, hipDeviceAttributeMultiprocessorCount, dev);
        if (hipFuncSetAttribute((const void*)hybrid_fwd, hipFuncAttributeMaxDynamicSharedMemorySize, LDS_BYTES) != hipSuccess) { fprintf(stderr, "kernel_launch: hipFuncSetAttribute failed\n"); grid = -1; return; }
        if (hipOccupancyMaxActiveBlocksPerMultiprocessor(&per_cu, (const void*)hybrid_fwd, 512, LDS_BYTES) != hipSuccess || per_cu < 1) { fprintf(stderr, "kernel_launch: occupancy query gave %d\n", per_cu); per_cu = 1; }
        (void)hipGetLastError();
        if (cus <= 0) cus = 256;
        grid = cus * per_cu;
    }
    if (grid < 0) return;
    if (hipMemsetAsync((char*)d_ws + WS_BAR, 0, XCD_BAR_WORDS * 4, stream) != hipSuccess) { fprintf(stderr, "kernel_launch: hipMemsetAsync of the barrier words failed\n"); return; }
    static int rs_ok = -1;
    if (rs_ok < 0) { rs_ok = (grid == 256) ? 1 : 0;
        const int ncol[2] = {DIN / 256, FF / 256};
        for (int ph = 0; ph < 2 && rs_ok; ++ph) { const int nun = (T / 256) * ncol[ph] / 256;
            for (int c = 0; c < grid && rs_ok; ++c) { pg8::StaticOrder S; S.init(T, ncol[ph] * 256, grid, c); pg8::Unit u0, u1, ui; if (!S.next(0, u0) || !S.next(nun - 1, u1) || S.next(nun, ui)) { rs_ok = 0; break; }
                if (((u0.pm >> 3) & 1) != 0 || ((u1.pm >> 3) & 1) != 1) { rs_ok = 0; break; }
                for (int i = 0; i < nun; ++i) { S.next(i, ui); if (ui.pm != (((ui.pm >> 3) & 1) ? u1.pm : u0.pm)) { rs_ok = 0; break; } } } } }
    Params a{};
    for (int i = 0; i < 26; ++i) a.in[i] = (const float*)d_in[i];
    if (!rs_ok) { fprintf(stderr, "kernel_launch: unit order does not keep a workgroup inside two row panels (grid %d); nothing launched\n", grid); return; }
    a.out = (float*)d_out; a.ws = (unsigned char*)d_ws; a.rs_lds = rs_ok; a.pad = 0;
    void* args[] = {&a};
    hipError_t e = hipLaunchCooperativeKernel((const void*)hybrid_fwd, dim3(grid), dim3(512), args, LDS_BYTES, stream);
    if (e != hipSuccess) fprintf(stderr, "cooperative launch failed: %s (grid %d)\n", hipGetErrorString(e), grid);
}
```

```cpp
#include <hip/hip_runtime.h>
#include <hip/hip_cooperative_groups.h>
#include <cstdio>
#include <cstdint>
namespace cg = cooperative_groups;

#define DI __device__ __forceinline__
#define LAS __attribute__((address_space(3)))
typedef unsigned short bf16_t;
typedef short bf16x8 __attribute__((ext_vector_type(8)));
typedef short s16x4 __attribute__((ext_vector_type(4)));
typedef float f32x4 __attribute__((ext_vector_type(4)));
typedef float f32x16 __attribute__((ext_vector_type(16)));
typedef unsigned u32x4 __attribute__((ext_vector_type(4)));
typedef unsigned u32x2 __attribute__((ext_vector_type(2)));

constexpr int NB = 4, SEQ = 8192, T = NB * SEQ, D = 1024, DIN = 2560, FF = 4096, NL = 4;
constexpr int ZQ = 0, ZF = 256, ZI = 512, ZG = 768, ZBV = 1024, ZBG = 1280, ZCU = 1536, ZDQ = 1792, ZDK = 2048, ZDV = 2304;
constexpr int YA = 0, YB = 256, YC = 512, YD = 768;
constexpr int ZOD = ZBG;
constexpr float EPS = 1e-6f;
constexpr size_t MiB = 1u << 20;
constexpr size_t WS_WIN = 0, WS_WOUT = 20 * MiB, WS_WUP = 28 * MiB, WS_WDN = 60 * MiB, WS_WGLU = 92 * MiB;
constexpr size_t WS_LB = 93 * MiB;
constexpr size_t WS_BIAS = WS_LB + 4096;
constexpr size_t WS_BAR = WS_LB + 32768;
constexpr size_t WS_SSQ = WS_LB + 65536;
constexpr size_t WS_LSE = WS_SSQ + 8 * (size_t)T * 4;
constexpr size_t WS_DEC = WS_LSE + (size_t)T * 16;
constexpr size_t WS_LSE1 = WS_DEC + 2048 * 64 * 4;
constexpr size_t WS_S5K = 96 * MiB;
constexpr size_t WS_S5WS = 98 * MiB;
constexpr size_t WS_S5WC = 114 * MiB;
constexpr size_t WS_XB = 130 * MiB;
constexpr size_t WS_S5H = 194 * MiB;
constexpr size_t WS_HM = 198 * MiB;
constexpr size_t WS_Z = 198 * MiB;
constexpr size_t WS_YCAT = 358 * MiB;
constexpr size_t WS_SL = 422 * MiB, WS_SL2 = 438 * MiB;
constexpr size_t WS_S5H2 = 454 * MiB;
constexpr size_t WS_O0 = 458 * MiB, WS_O1 = 474 * MiB;
constexpr size_t WS_YPRE = 490 * MiB;
constexpr size_t WS_SSQP = 506 * MiB;
constexpr size_t WS_END = 510 * MiB;
static_assert(WS_LSE1 + (size_t)T * 16 <= WS_S5K, "misc region");

constexpr int LDS_BYTES = 147456;

DI unsigned f2bf(float f) { unsigned u = __builtin_bit_cast(unsigned, f); return (u + 0x7fffu + ((u >> 16) & 1u)) >> 16; }
typedef float f32x2_t __attribute__((ext_vector_type(2))); typedef __bf16 bf16x2_t __attribute__((ext_vector_type(2)));
DI unsigned pk2(float lo, float hi) { const f32x2_t v = {lo, hi}; const bf16x2_t b = __builtin_convertvector(v, bf16x2_t); return __builtin_bit_cast(unsigned, b); }
DI float bf2f(bf16_t v) { return __builtin_bit_cast(float, (unsigned)v << 16); }
DI float bflo(unsigned w) { return __builtin_bit_cast(float, w << 16); }
DI float bfhi(unsigned w) { return __builtin_bit_cast(float, w & 0xffff0000u); }
DI float sigmoidf_(float x) { return 1.f / (1.f + __expf(-x)); }
DI float wave_sum(float v) {
#pragma unroll
    for (int o = 1; o < 64; o <<= 1) v += __shfl_xor(v, o);
    return v;
}
DI float half_sum(float v) {
#pragma unroll
    for (int o = 1; o < 32; o <<= 1) v += __shfl_xor(v, o);
    return v;
}
#define LDS_WAIT() asm volatile("s_waitcnt lgkmcnt(0)" ::: "memory")
DI int crow(int reg, int h) { return (reg & 3) + 8 * (reg >> 2) + 4 * h; }

template <int K>
DI f32x16 mma_lds(const LAS bf16_t* A, int lda, const LAS bf16_t* B, int ldb, f32x16 acc, int lane) {
    const int r = lane & 31, h = lane >> 5;
    const LAS bf16_t* ap = A + r * lda + 8 * h; const LAS bf16_t* bp = B + r * ldb + 8 * h;
#pragma unroll
    for (int k0 = 0; k0 < K; k0 += 16) {
        const bf16x8 a = *(const LAS bf16x8*)(ap + k0); const bf16x8 b = *(const LAS bf16x8*)(bp + k0);
        acc = __builtin_amdgcn_mfma_f32_32x32x16_bf16(a, b, acc, 0, 0, 0);
    }
    return acc;
}
DI f32x16 zero16() { f32x16 z;
#pragma unroll
    for (int i = 0; i < 16; ++i) z[i] = 0.f;
    return z; }

namespace pg8 {
#define PG8_LAS __attribute__((address_space(3)))
constexpr int BM = 256, BK = 64, HALF = 128, HTB = HALF * BK * 2, STAGE_BYTES = 8 * HTB, NXCD = 8, WGM = 8;
__host__ __device__ __forceinline__ int lds_byte(int r, int c) { const int st = (r >> 4) * 2 + (c >> 5), rr = r & 15, cc = c & 31, ob = rr * 64 + cc * 2; return st * 1024 + (ob ^ (((ob >> 9) & 1) << 5)); }
__host__ __device__ __forceinline__ void stage_rc(int b, int& R, int& C) { const int st = b / 1024, sb = b % 1024, swz = sb ^ (((sb >> 9) & 1) << 5); R = (st >> 1) * 16 + swz / 64; C = (st & 1) * 32 + (swz % 64) / 2; }
__host__ __device__ __forceinline__ int perm32(int rho) { const int n = rho >> 4, i = rho & 15; return 8 * (i >> 2) + 4 * n + (i & 3); }
struct Unit { int pm, pn; };
struct Gemm { const bf16_t* A; const bf16_t* Bt; int M, N, K, lda; };
struct StaticOrder {
    int nM, nN, nwg, G, c;
    __host__ __device__ __forceinline__ void init(int M, int N, int G_, int c_) { nM = M / BM; nN = N / BM; nwg = nM * nN; G = G_; c = c_; }
    __host__ __device__ __forceinline__ bool next(int i, Unit& u) const {
        const long L = (long)i * G + c; if (L >= nwg) return false;
        int wgid = (int)L; { const int q = nwg / NXCD, r = nwg % NXCD, xcd = wgid % NXCD, off = wgid / NXCD; wgid = (xcd < r ? xcd * (q + 1) : r * (q + 1) + (xcd - r) * q) + off; }
        const int nig = WGM * nN, gid = wgid / nig, fm = gid * WGM, gsz = (nM - fm) < WGM ? (nM - fm) : WGM;
        u.pm = fm + ((wgid % nig) % gsz); u.pn = (wgid % nig) / gsz; return true;
    }
    __device__ __forceinline__ void a_ready(const Unit&) const {}
    __device__ __forceinline__ void done(const Unit&) const {}
};
struct EpiScale {
    static constexpr bool PERM = true, AFTER_DRAIN = false;
    bf16_t* O; int ldc; int act; const PG8_LAS float* rsl;
    __device__ __forceinline__ void operator()(const f32x4 (&acc)[2][2][4][2], const Unit& u, int wr, int wc, int fr, int fq) const {
        const int row0 = u.pm * BM + wr * 64 + fr; const int col0 = u.pn * BM + wc * 32 + 8 * fq;
        const int slot = ((u.pm >> 3) & 1) * 256;
#pragma unroll
        for (int ai = 0; ai < 2; ++ai)
#pragma unroll
            for (int m = 0; m < 4; ++m) { const int r = row0 + ai * HALF + m * 16; float rs;
                rs = rsl[slot + ai * HALF + wr * 64 + m * 16 + fr];
                bf16_t* rowp = O + (size_t)r * ldc + col0;
#pragma unroll
                for (int bj = 0; bj < 2; ++bj) { f32x4 v0 = acc[ai][bj][m][0] * rs, v1 = acc[ai][bj][m][1] * rs;
                    if (act) {
#pragma unroll
                        for (int e = 0; e < 4; ++e) { const float a = fmaxf(v0[e], 0.f), b = fmaxf(v1[e], 0.f); v0[e] = a * a; v1[e] = b * b; } }
                    u32x4 w; w.x = pk2(v0[0], v0[1]); w.y = pk2(v0[2], v0[3]); w.z = pk2(v1[0], v1[1]); w.w = pk2(v1[2], v1[3]);
                    *(u32x4*)(rowp + bj * HALF) = w; } }
    }
};
struct EpiRes {
    static constexpr bool PERM = false, AFTER_DRAIN = false;
    const float* base; float* out; bf16_t* xb; float* ssq_out;
    __device__ __forceinline__ void operator()(const f32x4 (&acc)[2][2][4][2], const Unit& u, int wr, int wc, int fr, int fq) const {
        const int col0 = u.pn * BM + wc * 32 + 4 * fq;
#pragma unroll
        for (int ai = 0; ai < 2; ++ai)
#pragma unroll
            for (int m = 0; m < 4; ++m) { const int r = u.pm * BM + ai * HALF + wr * 64 + m * 16 + fr; const size_t off = (size_t)r * D + col0; float s = 0.f;
#pragma unroll
                for (int bj = 0; bj < 2; ++bj)
#pragma unroll
                    for (int n = 0; n < 2; ++n) { const size_t o2 = off + bj * HALF + n * 16; const f32x4 o = *(const f32x4*)(base + o2) + acc[ai][bj][m][n];
                        *(f32x4*)(out + o2) = o; u32x2 w; w.x = pk2(o[0], o[1]); w.y = pk2(o[2], o[3]); *(u32x2*)(xb + o2) = w;
                        s += (o[0] * o[0] + o[1] * o[1]) + (o[2] * o[2] + o[3] * o[3]); }
                s += __shfl_xor(s, 16); s += __shfl_xor(s, 32);
                if (fq == 0 && ssq_out) ssq_out[(size_t)r * 16 + u.pn * 4 + wc] = s; }
    }
};
struct EpiGlu {
    static constexpr bool PERM = false, AFTER_DRAIN = true;
    const bf16_t* Ysrc; int lds_; bf16_t* Y;
    __device__ __forceinline__ void fused(f32x4 (&acc)[2][2][4][2], const Unit& u, int wr, int wc, int fr, int fq, PG8_LAS unsigned char* lds, int wid, int lane) const {
        PG8_LAS float* Pp = (PG8_LAS float*)lds;
        const int col0 = wc * 32 + 4 * fq;
#pragma unroll
        for (int ai = 0; ai < 2; ++ai)
#pragma unroll
            for (int m = 0; m < 4; ++m) { const int rl = ai * HALF + wr * 64 + m * 16 + fr; const size_t off = (size_t)(u.pm * BM + rl) * lds_ + col0; float s = 0.f;
#pragma unroll
                for (int bj = 0; bj < 2; ++bj)
#pragma unroll
                    for (int n = 0; n < 2; ++n) { const u32x2 w = *(const u32x2*)(Ysrc + off + bj * HALF + n * 16); f32x4 a = acc[ai][bj][m][n];
                        const float y0 = bflo(w.x), y1 = bfhi(w.x), y2 = bflo(w.y), y3 = bfhi(w.y);
                        a[0] = y0 * sigmoidf_(a[0]); a[1] = y1 * sigmoidf_(a[1]); a[2] = y2 * sigmoidf_(a[2]); a[3] = y3 * sigmoidf_(a[3]);
                        acc[ai][bj][m][n] = a; s += (a[0] * a[0] + a[1] * a[1]) + (a[2] * a[2] + a[3] * a[3]); }
                s += __shfl_xor(s, 16); s += __shfl_xor(s, 32);
                if (fq == 0) Pp[rl * 4 + wc] = s; }
        __syncthreads();
#pragma unroll
        for (int ai = 0; ai < 2; ++ai)
#pragma unroll
            for (int m = 0; m < 4; ++m) { const int rl = ai * HALF + wr * 64 + m * 16 + fr; const size_t off = (size_t)(u.pm * BM + rl) * D + col0;
                const float tot = (Pp[rl * 4 + 0] + Pp[rl * 4 + 1]) + (Pp[rl * 4 + 2] + Pp[rl * 4 + 3]); const float rs = rsqrtf(tot * (1.0f / 256.0f) + EPS);
#pragma unroll
                for (int bj = 0; bj < 2; ++bj)
#pragma unroll
                    for (int n = 0; n < 2; ++n) { const f32x4 a = acc[ai][bj][m][n] * rs; u32x2 w; w.x = pk2(a[0], a[1]); w.y = pk2(a[2], a[3]); *(u32x2*)(Y + off + bj * HALF + n * 16) = w; } }
    }
};

template <class Epi, class Sched, bool ALIGN_EPI = false, bool SP2 = false>
__device__ __forceinline__ void gemm_phase(PG8_LAS unsigned char* lds, const Gemm g, const Sched& S, const Epi& E) {
    int tid_o = threadIdx.x; asm volatile("" : "+v"(tid_o));
    const int tid = tid_o, wid = __builtin_amdgcn_readfirstlane(tid >> 6), lane = tid & 63, wr = wid >> 2, wc = wid & 3, fr = lane & 15, fq = lane >> 4;
    const int K = g.K, nt = K / BK;
    unsigned voffA[2], voffB[2];
#pragma unroll
    for (int i = 0; i < 2; ++i) { int R, C; stage_rc(tid * 16 + i * 8192, R, C); const int Rb = Epi::PERM ? ((R & ~31) + perm32(R & 31)) : R;
        voffA[i] = (unsigned)(R * g.lda + C) * 2u; voffB[i] = (unsigned)(Rb * K + C) * 2u; }
    const size_t kstep = (size_t)(BK * 2);
    const size_t hstepA = (size_t)HALF * g.lda * 2, hstepB = (size_t)HALF * K * 2;
    const size_t tstepA = 2 * hstepA, tstepB = 2 * hstepB;
    const unsigned ldsw = (unsigned)wid * 1024u;
    const int aoff = lds_byte(wr * 64 + fr, fq * 8), boff = lds_byte(wc * 32 + fr, fq * 8);
#define PG8_SA(b, h) (((b) * 2 + (h)) * HTB)
#define PG8_SB(b, h) ((4 + (b) * 2 + (h)) * HTB)
#define PG8_STAGE(bufoff, gbase, voff) do { _Pragma("unroll") for (int _i = 0; _i < 2; ++_i) \
        __builtin_amdgcn_global_load_lds((const unsigned*)((const char*)(gbase) + (voff)[_i]), (PG8_LAS unsigned*)(lds + (bufoff) + ldsw + _i * 8192), 16, 0, 0); } while (0)
#define PG8_LDA(dst, b, h) do { _Pragma("unroll") for (int m = 0; m < 4; ++m) _Pragma("unroll") for (int k = 0; k < 2; ++k) dst[m][k] = *(const PG8_LAS bf16x8*)(lds + PG8_SA(b, h) + aoff + m * 2048 + k * 1024); } while (0)
#define PG8_LDB(dst, b, h) do { _Pragma("unroll") for (int n = 0; n < 2; ++n) _Pragma("unroll") for (int k = 0; k < 2; ++k) dst[n][k] = *(const PG8_LAS bf16x8*)(lds + PG8_SB(b, h) + boff + n * 2048 + k * 1024); } while (0)
#define PG8_MMA(ai, bj, At, Bt) do { __builtin_amdgcn_s_setprio(1); _Pragma("unroll") for (int m = 0; m < 4; ++m) _Pragma("unroll") for (int n = 0; n < 2; ++n) _Pragma("unroll") for (int k = 0; k < 2; ++k) \
        acc[ai][bj][m][n] = __builtin_amdgcn_mfma_f32_16x16x32_bf16(Bt[n][k], At[m][k], acc[ai][bj][m][n], 0, 0, 0); __builtin_amdgcn_s_setprio(0); } while (0)
#define PG8_WAIT_V(n) asm volatile("s_waitcnt vmcnt(" #n ")" ::: "memory")
#define PG8_WAIT_L(n) asm volatile("s_waitcnt lgkmcnt(" #n ")" ::: "memory")
#define PG8_BAR __builtin_amdgcn_s_barrier()
#define PG8_SCHED __builtin_amdgcn_sched_barrier(0)
    Unit cur, nxt; int ui = 0;
    if (!S.next(0, cur)) return;
    f32x4 acc[2][2][4][2];
#pragma unroll
    for (int a = 0; a < 2; ++a)
#pragma unroll
        for (int b = 0; b < 2; ++b)
#pragma unroll
            for (int m = 0; m < 4; ++m)
#pragma unroll
                for (int n = 0; n < 2; ++n) acc[a][b][m][n] = (f32x4){0.f, 0.f, 0.f, 0.f};
    bf16x8 At[4][2], B0[2][2], B1[2][2];
    const char* cA = (const char*)g.A + (size_t)cur.pm * tstepA; const char* cB = (const char*)g.Bt + (size_t)cur.pn * tstepB;
    S.a_ready(cur);
    if constexpr (SP2) {
        PG8_STAGE(PG8_SB(0, 0), cB, voffB); PG8_STAGE(PG8_SB(0, 1), cB + hstepB, voffB); PG8_STAGE(PG8_SA(0, 0), cA, voffA); PG8_STAGE(PG8_SA(0, 1), cA + hstepA, voffA);
        if (wr == 1) PG8_BAR;
        PG8_WAIT_V(2); PG8_BAR;
        PG8_STAGE(PG8_SB(1, 0), cB + kstep, voffB); PG8_STAGE(PG8_SA(1, 0), cA + kstep, voffA); PG8_STAGE(PG8_SB(1, 1), cB + hstepB + kstep, voffB);
        PG8_WAIT_V(6); PG8_BAR;
    } else {
        PG8_STAGE(PG8_SB(0, 0), cB, voffB); PG8_STAGE(PG8_SA(0, 0), cA, voffA); PG8_STAGE(PG8_SB(0, 1), cB + hstepB, voffB); PG8_STAGE(PG8_SA(0, 1), cA + hstepA, voffA);
        if (wr == 1) PG8_BAR;
        PG8_WAIT_V(4); PG8_BAR;
        PG8_STAGE(PG8_SB(1, 0), cB + kstep, voffB); PG8_STAGE(PG8_SA(1, 0), cA + kstep, voffA); PG8_STAGE(PG8_SB(1, 1), cB + hstepB + kstep, voffB);
        PG8_WAIT_V(6); PG8_BAR;
    }
    for (;;) {
        const bool has_next = S.next(ui + 1, nxt);
        const char* nA = has_next ? (const char*)g.A + (size_t)nxt.pm * tstepA : cA; const char* nB = has_next ? (const char*)g.Bt + (size_t)nxt.pn * tstepB : cB;
        for (int t = 0; t < nt; t += 2) {
            const bool last = (t == nt - 2);
            const char* a1 = cA + (size_t)(t + 1) * kstep;
            const char* a2 = last ? nA : cA + (size_t)(t + 2) * kstep; const char* b2 = last ? nB : cB + (size_t)(t + 2) * kstep;
            const char* a3 = a2 + kstep; const char* b3 = b2 + kstep;
            if (last && has_next) S.a_ready(nxt);
            if constexpr (SP2) {
            PG8_LDB(B0, 0, 0); PG8_LDB(B1, 0, 1); PG8_SCHED; PG8_LDA(At, 0, 0); PG8_STAGE(PG8_SA(1, 1), a1 + hstepA, voffA);
            PG8_WAIT_V(8); PG8_WAIT_L(0); PG8_BAR; PG8_MMA(0, 0, At, B0); PG8_MMA(0, 1, At, B1); PG8_BAR; PG8_SCHED;
            PG8_LDA(At, 0, 1); PG8_STAGE(PG8_SB(0, 0), b2, voffB); PG8_STAGE(PG8_SB(0, 1), b2 + hstepB, voffB); PG8_STAGE(PG8_SA(0, 0), a2, voffA);
            PG8_WAIT_V(8); PG8_WAIT_L(0); PG8_BAR; PG8_MMA(1, 0, At, B0); PG8_MMA(1, 1, At, B1); PG8_BAR; PG8_SCHED;
            PG8_LDB(B0, 1, 0); PG8_LDB(B1, 1, 1); PG8_SCHED; PG8_LDA(At, 1, 0); PG8_STAGE(PG8_SA(0, 1), a2 + hstepA, voffA);
            PG8_WAIT_V(8); PG8_WAIT_L(0); PG8_BAR; PG8_MMA(0, 0, At, B0); PG8_MMA(0, 1, At, B1); PG8_BAR; PG8_SCHED;
            PG8_LDA(At, 1, 1); PG8_STAGE(PG8_SB(1, 0), b3, voffB); PG8_STAGE(PG8_SB(1, 1), b3 + hstepB, voffB); PG8_STAGE(PG8_SA(1, 0), a3, voffA);
            PG8_WAIT_V(8); PG8_WAIT_L(0); PG8_BAR; PG8_MMA(1, 0, At, B0); PG8_MMA(1, 1, At, B1); PG8_BAR; PG8_SCHED;
            } else {
            PG8_LDB(B0, 0, 0); PG8_SCHED; PG8_LDA(At, 0, 0); PG8_STAGE(PG8_SA(1, 1), a1 + hstepA, voffA);
            PG8_WAIT_L(8); PG8_BAR; PG8_WAIT_L(0); PG8_MMA(0, 0, At, B0); PG8_BAR; PG8_SCHED;
            PG8_LDB(B1, 0, 1); PG8_STAGE(PG8_SB(0, 0), b2, voffB);
            PG8_BAR; PG8_WAIT_L(0); PG8_MMA(0, 1, At, B1); PG8_BAR;
            PG8_LDA(At, 0, 1); PG8_STAGE(PG8_SA(0, 0), a2, voffA);
            PG8_BAR; PG8_WAIT_L(0); PG8_MMA(1, 0, At, B0); PG8_BAR; PG8_SCHED;
            PG8_STAGE(PG8_SB(0, 1), b2 + hstepB, voffB);
            PG8_WAIT_V(6); PG8_BAR; PG8_MMA(1, 1, At, B1); PG8_BAR;
            PG8_LDB(B0, 1, 0); PG8_SCHED; PG8_LDA(At, 1, 0); PG8_STAGE(PG8_SA(0, 1), a2 + hstepA, voffA);
            PG8_WAIT_L(8); PG8_BAR; PG8_WAIT_L(0); PG8_MMA(0, 0, At, B0); PG8_BAR; PG8_SCHED;
            PG8_LDB(B1, 1, 1); PG8_STAGE(PG8_SB(1, 0), b3, voffB);
            PG8_BAR; PG8_WAIT_L(0); PG8_MMA(0, 1, At, B1); PG8_BAR;
            PG8_LDA(At, 1, 1); PG8_STAGE(PG8_SA(1, 0), a3, voffA);
            PG8_BAR; PG8_WAIT_L(0); PG8_MMA(1, 0, At, B0); PG8_BAR; PG8_SCHED;
            PG8_STAGE(PG8_SB(1, 1), b3 + hstepB, voffB);
            PG8_WAIT_V(6); PG8_BAR; PG8_MMA(1, 1, At, B1); PG8_BAR;
            }
        }
        if constexpr (ALIGN_EPI) { if (wr == 0) PG8_BAR; }
        if constexpr (!Epi::AFTER_DRAIN) { E(acc, cur, wr, wc, fr, fq); S.done(cur); }
        if (!has_next) break;
#pragma unroll
        for (int a = 0; a < 2; ++a)
#pragma unroll
            for (int b = 0; b < 2; ++b)
#pragma unroll
                for (int m = 0; m < 4; ++m)
#pragma unroll
                    for (int n = 0; n < 2; ++n) acc[a][b][m][n] = (f32x4){0.f, 0.f, 0.f, 0.f};
        cur = nxt; cA = nA; cB = nB; ++ui;
        if constexpr (ALIGN_EPI) { if (wr == 1) PG8_BAR; }
    }
    PG8_WAIT_V(0);
    if constexpr (!ALIGN_EPI) { if (wr == 0) PG8_BAR; }
    PG8_BAR;
    if constexpr (Epi::AFTER_DRAIN) { E.fused(acc, cur, wr, wc, fr, fq, lds, wid, lane); S.done(cur); }
#undef PG8_SA
#undef PG8_SB
#undef PG8_STAGE
#undef PG8_LDA
#undef PG8_LDB
#undef PG8_MMA
#undef PG8_WAIT_V
#undef PG8_WAIT_L
#undef PG8_BAR
#undef PG8_SCHED
}
}

struct Params { const float* in[26]; float* out; unsigned char* ws; int rs_lds; int pad; };
enum { I_X = 0, I_NMG, I_WIN, I_LBL, I_HNG, I_CW, I_CB, I_CLG, I_CLB, I_LRE, I_LIM, I_BRE, I_BIM, I_CRE, I_CIM, I_S5D, I_LDT, I_WGLU, I_QG, I_KG, I_RB, I_MONG, I_WOUT, I_NMLPG, I_WUP, I_WDN };

DI void p0_transpose_item(const float* W, int K, int N, bf16_t* WT, const float* gk, LAS float* scr, int item, int lane) {
    const int nblk = N / 32, kb = item / nblk, nb = item % nblk, k0 = 64 * kb, n0 = 32 * nb;
#pragma unroll 8
    for (int i = 0; i < 32; ++i) { const int kk = 2 * i + (lane >> 5); const float s = gk ? gk[k0 + kk] : 1.f; scr[kk * 33 + (lane & 31)] = W[(size_t)(k0 + kk) * N + n0 + (lane & 31)] * s; }
    LDS_WAIT();
    const int c = lane & 7;
#pragma unroll
    for (int j = 0; j < 4; ++j) { const int n = (lane >> 3) + 8 * j; const LAS float* s = scr + (8 * c) * 33 + n;
        u32x4 o; o.x = pk2(s[0 * 33], s[1 * 33]); o.y = pk2(s[2 * 33], s[3 * 33]); o.z = pk2(s[4 * 33], s[5 * 33]); o.w = pk2(s[6 * 33], s[7 * 33]);
        *(u32x4*)(WT + (size_t)(n0 + n) * K + k0 + 8 * c) = o; }
    LDS_WAIT();
}
DI void s5_params(const Params& p, int lg, int pp, float& lrdt, float& lidt, float& cr, float& ci) {
    const float dt = expf(p.in[I_LDT][lg]);
    const float lr = p.in[I_LRE][lg * 64 + pp], li = p.in[I_LIM][lg * 64 + pp];
    lrdt = lr * dt; lidt = li * dt;
    const float mag = expf(lrdt); const float ar = mag * cosf(lidt), ai = mag * sinf(lidt);
    const float den = lr * lr + li * li;
    cr = ((ar - 1.0f) * lr + ai * li) / den; ci = (ai * lr - (ar - 1.0f) * li) / den;
}
DI void s5_pow(float lrdt, float lidt, int n, float& er, float& ei) { const float m = expf((float)n * lrdt); const float a = (float)n * lidt; er = m * cosf(a); ei = m * sinf(a); }

DI void prologue(const Params& p, LAS unsigned char* lds, int G) {
    int tid_o = threadIdx.x; asm volatile("" : "+v"(tid_o));
    const int tid = tid_o, lane = tid & 63, wave = tid >> 6;
    const int gw = blockIdx.x * 8 + wave, NGW = G * 8;
    const int gt = blockIdx.x * 512 + tid, NGT = G * 512;
    unsigned char* ws = p.ws;
    LAS float* scr = (LAS float*)(lds + wave * 16384);
    {
        constexpr int I_IN = (D / 64) * (DIN / 32), I_OUT = (D / 64) * (D / 32), I_UP = (D / 64) * (FF / 32), I_DN = (FF / 64) * (D / 32), I_GL = (256 / 64) * (256 / 32);
        constexpr int PER_L = I_IN + I_OUT + I_UP + I_DN + I_GL;
        for (int it = gw; it < NL * PER_L; it += NGW) {
            const int l = it / PER_L; int r = it % PER_L;
            if (r < I_IN) { p0_transpose_item(p.in[I_WIN] + (size_t)l * D * DIN, D, DIN, (bf16_t*)(ws + WS_WIN) + (size_t)l * D * DIN, p.in[I_NMG] + l * D, scr, r, lane); continue; } r -= I_IN;
            if (r < I_OUT) { p0_transpose_item(p.in[I_WOUT] + (size_t)l * D * D, D, D, (bf16_t*)(ws + WS_WOUT) + (size_t)l * D * D, p.in[I_MONG] + l * D, scr, r, lane); continue; } r -= I_OUT;
            if (r < I_UP) { p0_transpose_item(p.in[I_WUP] + (size_t)l * D * FF, D, FF, (bf16_t*)(ws + WS_WUP) + (size_t)l * D * FF, p.in[I_NMLPG] + l * D, scr, r, lane); continue; } r -= I_UP;
            if (r < I_DN) { p0_transpose_item(p.in[I_WDN] + (size_t)l * D * FF, FF, D, (bf16_t*)(ws + WS_WDN) + (size_t)l * D * FF, nullptr, scr, r, lane); continue; } r -= I_DN;
            p0_transpose_item(p.in[I_WGLU] + (size_t)l * 65536, 256, 256, (bf16_t*)(ws + WS_WGLU) + (size_t)l * 65536, nullptr, scr, r, lane);
        }
    }
    {
        float* ssq0 = (float*)(ws + WS_SSQP); bf16_t* XB = (bf16_t*)(ws + WS_XB);
        for (int mb = gw * 16; mb < T; mb += NGW * 16) {
            float keep = 0.f;
#pragma unroll 4
            for (int i = 0; i < 16; ++i) { const int m = mb + i;
                const f32x4* xr = (const f32x4*)(p.in[I_X] + (size_t)m * D) + lane; f32x4 v[4]; float s = 0.f;
#pragma unroll
                for (int j = 0; j < 4; ++j) { v[j] = xr[64 * j]; s += (v[j][0] * v[j][0] + v[j][1] * v[j][1]) + (v[j][2] * v[j][2] + v[j][3] * v[j][3]); }
                s = wave_sum(s); if (lane == i) keep = s;
                u32x2* o8 = (u32x2*)(XB + (size_t)m * D) + lane;
#pragma unroll
                for (int j = 0; j < 4; ++j) { u32x2 w; w.x = pk2(v[j][0], v[j][1]); w.y = pk2(v[j][2], v[j][3]); o8[64 * j] = w; } }
#pragma unroll 1
            for (int i = 0; i < 16; ++i) { const float v = __shfl(keep, i); if (lane < 16) ssq0[(size_t)(mb + i) * 16 + lane] = lane == 0 ? v : 0.f; }
        }
    }
    {
        float* LB = (float*)(ws + WS_LB);
        for (int c = gt; c < 256; c += NGT) {
            const float a0 = p.in[I_LBL][c], a1 = p.in[I_LBL][256 + c], a2 = p.in[I_LBL][512 + c], a3 = p.in[I_LBL][768 + c];
            const float mx = fmaxf(fmaxf(a0, a1), fmaxf(a2, a3));
            const float e0 = expf(a0 - mx), e1 = expf(a1 - mx), e2 = expf(a2 - mx), e3 = expf(a3 - mx); const float inv = 1.f / (e0 + e1 + e2 + e3);
            const float s1 = e1 * inv, s2 = e2 * inv, s3 = e3 * inv; const float hi = 1.0f - 1e-6f;
            LB[c] = 0.f; LB[256 + c] = fminf(fmaxf(s1, 0.f), hi); LB[512 + c] = fminf(fmaxf(s1 + s2, 0.f), hi); LB[768 + c] = fminf(fmaxf(s1 + s2 + s3, 0.f), hi);
        }
        float* BT = (float*)(ws + WS_BIAS);
        for (int i = gt; i < 3 * 4 * 132; i += NGT) {
            const int pt = i / (4 * 132), hd = (i / 132) % 4, dl = i % 132; const int dil = pt == 0 ? 1 : (pt == 1 ? 4 : 16);
            float v = 0.f;
            if (dl <= 128) { const int dist = dl * dil; int bk;
                if (dist < 16) bk = dist; else { bk = 16 + (int)(logf((float)dist / 16.0f) / 4.852030263919617f * 16.0f); if (bk > 31) bk = 31; }
                v = p.in[I_RB][bk * 4 + hd]; }
            BT[i] = v;
        }
    }
    {
        bf16_t* KT = (bf16_t*)(ws + WS_S5K); bf16_t* WS_ = (bf16_t*)(ws + WS_S5WS); bf16_t* WC = (bf16_t*)(ws + WS_S5WC);
        LAS float* ebr = scr; LAS float* ebi = scr + 64 * 17;
        for (int it = gw; it < NL * 16 * 64; it += NGW) {
            const int lg = it >> 6, d = it & 63;
            float lrdt, lidt, cr, ci; s5_params(p, lg, lane, lrdt, lidt, cr, ci);
            float er, ei; s5_pow(lrdt, lidt, d, er, ei);
            const float fr_ = er * cr - ei * ci, fi_ = er * ci + ei * cr;
            const float* br = p.in[I_BRE] + ((size_t)lg * 64 + lane) * 16; const float* bi = p.in[I_BIM] + ((size_t)lg * 64 + lane) * 16;
#pragma unroll
            for (int c = 0; c < 16; ++c) { const float b0 = br[c], b1 = bi[c]; ebr[lane * 17 + c] = fr_ * b0 - fi_ * b1; ebi[lane * 17 + c] = fr_ * b1 + fi_ * b0; }
            LDS_WAIT();
            const int co = lane & 15, cb = (lane >> 4) * 4;
            const float* crp = p.in[I_CRE] + ((size_t)lg * 16 + co) * 64; const float* cip = p.in[I_CIM] + ((size_t)lg * 16 + co) * 64;
            float a0 = 0.f, a1 = 0.f, a2 = 0.f, a3 = 0.f;
            for (int q = 0; q < 64; ++q) { const float c0 = crp[q], c1 = cip[q];
                a0 += c0 * ebr[q * 17 + cb + 0] - c1 * ebi[q * 17 + cb + 0]; a1 += c0 * ebr[q * 17 + cb + 1] - c1 * ebi[q * 17 + cb + 1];
                a2 += c0 * ebr[q * 17 + cb + 2] - c1 * ebi[q * 17 + cb + 2]; a3 += c0 * ebr[q * 17 + cb + 3] - c1 * ebi[q * 17 + cb + 3]; }
            u32x2 w; w.x = pk2(a0, a1); w.y = pk2(a2, a3);
            *(u32x2*)(KT + ((size_t)it * 16 + co) * 16 + cb) = w;
            LDS_WAIT();
        }
        for (int it = gw; it < NL * 16 * 16; it += NGW) {
            const int lg = it >> 4, s4 = it & 15;
            float lrdt, lidt, cr, ci; s5_params(p, lg, lane, lrdt, lidt, cr, ci);
            const float* br = p.in[I_BRE] + ((size_t)lg * 64 + lane) * 16; const float* bi = p.in[I_BIM] + ((size_t)lg * 64 + lane) * 16;
            float b0[16], b1[16];
#pragma unroll
            for (int c = 0; c < 16; ++c) { b0[c] = br[c]; b1[c] = bi[c]; }
#pragma unroll 1
            for (int sq = 0; sq < 4; ++sq) { const int s = s4 * 4 + sq;
                float er, ei; s5_pow(lrdt, lidt, 63 - s, er, ei);
                const float fr_ = er * cr - ei * ci, fi_ = er * ci + ei * cr;
                float vr[16], vi[16];
#pragma unroll
                for (int c = 0; c < 16; ++c) { vr[c] = fr_ * b0[c] - fi_ * b1[c]; vi[c] = fr_ * b1[c] + fi_ * b0[c]; }
                bf16_t* o0 = WS_ + ((size_t)lg * 128 + lane) * 1024 + s * 16; bf16_t* o1 = WS_ + ((size_t)lg * 128 + 64 + lane) * 1024 + s * 16;
                u32x4 w;
                w.x = pk2(vr[0], vr[1]); w.y = pk2(vr[2], vr[3]); w.z = pk2(vr[4], vr[5]); w.w = pk2(vr[6], vr[7]); *(u32x4*)o0 = w;
                w.x = pk2(vr[8], vr[9]); w.y = pk2(vr[10], vr[11]); w.z = pk2(vr[12], vr[13]); w.w = pk2(vr[14], vr[15]); *(u32x4*)(o0 + 8) = w;
                w.x = pk2(vi[0], vi[1]); w.y = pk2(vi[2], vi[3]); w.z = pk2(vi[4], vi[5]); w.w = pk2(vi[6], vi[7]); *(u32x4*)o1 = w;
                w.x = pk2(vi[8], vi[9]); w.y = pk2(vi[10], vi[11]); w.z = pk2(vi[12], vi[13]); w.w = pk2(vi[14], vi[15]); *(u32x4*)(o1 + 8) = w; }
        }
        for (int it = gw; it < NL * 16 * 64; it += NGW) {
            const int lg = it >> 6, tl = it & 63;
            float lrdt, lidt, cr, ci; s5_params(p, lg, lane, lrdt, lidt, cr, ci);
            float er, ei; s5_pow(lrdt, lidt, tl + 1, er, ei);
#pragma unroll 4
            for (int co = 0; co < 16; ++co) { const float c0 = p.in[I_CRE][((size_t)lg * 16 + co) * 64 + lane], c1 = p.in[I_CIM][((size_t)lg * 16 + co) * 64 + lane];
                bf16_t* o = WC + (((size_t)lg * 64 + tl) * 16 + co) * 128;
                o[lane] = (bf16_t)f2bf(c0 * er - c1 * ei); o[64 + lane] = (bf16_t)f2bf(-(c0 * ei + c1 * er)); }
        }
    }
}

template <bool OUT>
DI void hgrn_item(const Params& p, LAS unsigned char* lds, int l, int cg) {
    int tid_o = threadIdx.x; asm volatile("" : "+v"(tid_o));
    const int tid = tid_o, lane = tid & 63, wave = tid >> 6, hd = wave >> 1, half = wave & 1;
    const bf16_t* Z = (const bf16_t*)(p.ws + WS_Z);
    LAS bf16_t* B0 = (LAS bf16_t*)(lds + hd * 27648); LAS bf16_t* B1 = B0 + 64 * 72; LAS bf16_t* B2 = B1 + 64 * 72;
    LAS float* GM = (LAS float*)(lds + 114688) + hd * 64; LAS float* GL = GM + 256; LAS float* SSA = (LAS float*)(lds + 114688) + 512;
    bf16_t* SL = (bf16_t*)(p.ws + WS_SL); const bf16_t* SL2 = (const bf16_t*)(p.ws + WS_SL2); float* DEC = (float*)(p.ws + WS_DEC);
    const int item = cg * 4 + hd;
#ifdef FORCE_LB0
    const float lb = 0.f, oml = 1.f;
#else
    const float lb = ((const float*)(p.ws + WS_LB))[l * 256 + hd * 64 + lane], oml = 1.f - lb;
#endif
    const int srow = tid >> 5, shd = (tid >> 3) & 3, spc = tid & 7;
    const bf16_t* zsrc = Z + (size_t)(cg * 64 + srow) * DIN + shd * 64 + spc * 8;
    const int sdst = shd * 27648 + (srow * 72 + spc * 8) * 2;
    __syncthreads();
    { u32x4 wf[4], wi[4], wq[4];
#pragma unroll
      for (int sub = 0; sub < 4; ++sub) { wf[sub] = *(const u32x4*)(zsrc + (size_t)(16 * sub) * DIN + ZF); wi[sub] = *(const u32x4*)(zsrc + (size_t)(16 * sub) * DIN + ZI);
          if (OUT) wq[sub] = *(const u32x4*)(zsrc + (size_t)(16 * sub) * DIN + ZQ); }
#pragma unroll
      for (int sub = 0; sub < 4; ++sub) { *(LAS u32x4*)(lds + sdst + 9216 + sub * 16 * 144) = wf[sub]; *(LAS u32x4*)(lds + sdst + 18432 + sub * 16 * 144) = wi[sub];
          if (OUT) *(LAS u32x4*)(lds + sdst + sub * 16 * 144) = wq[sub]; } }
    __syncthreads();
    float g[32]; float run = 0.f;
#pragma unroll
    for (int j = 0; j < 32; ++j) { const float fz = bf2f(B1[(half * 32 + j) * 72 + lane]); const float sg = sigmoidf_(fz); const float f = lb + oml * sg;
        run += __logf(fmaxf(f, 1e-30f)); g[j] = run; }
    if (half == 0) GM[lane] = run;
    __syncthreads();
    const float gm = GM[lane];
    if (half) {
#pragma unroll
        for (int j = 0; j < 32; ++j) g[j] += gm; }
    const int c0 = lane & 31, h = lane >> 5;
    if constexpr (!OUT) {
        if (half) GL[lane] = run + gm;
        __syncthreads();
        const float gl = GL[lane];
        bf16_t kv[32], ivr[32];
#pragma unroll
        for (int j = 0; j < 32; ++j) { const int t = half * 32 + j; const float e = __expf(gl - g[j]); const float kj = oml * (1.f - sigmoidf_(bf2f(B1[t * 72 + lane])));
            kv[j] = (bf16_t)f2bf(kj * e); ivr[j] = B2[t * 72 + lane]; }
        __syncthreads();
#pragma unroll
        for (int j = 0; j < 32; ++j) { const int t = half * 32 + j; B1[lane * 72 + t] = kv[j]; B2[lane * 72 + t] = ivr[j]; }
        __syncthreads();
#pragma unroll
        for (int kt = 0; kt < 2; ++kt) { const f32x16 a = mma_lds<64>(B2 + 32 * half * 72, 72, B1 + 32 * kt * 72, 72, zero16(), lane);
#pragma unroll
            for (int i = 0; i < 16; ++i) SL[(size_t)item * 4096 + (32 * half + crow(i, h)) * 64 + 32 * kt + c0] = (bf16_t)f2bf(a[i]); }
        if (half == 0) DEC[item * 64 + lane] = __expf(gl);
    } else {
        if (half == 0) GL[lane] = __expf(gm);
        bf16_t ivr[32];
#pragma unroll
        for (int j = 0; j < 32; ++j) { const int t = half * 32 + j; const float q = bf2f(B0[t * 72 + lane]); const float kj = oml * (1.f - sigmoidf_(bf2f(B1[t * 72 + lane])));
            const float e1 = __expf(fminf(g[j] - gm, 80.f)), e2 = __expf(fminf(gm - g[j], 80.f));
            ivr[j] = B2[t * 72 + lane];
            B0[t * 72 + lane] = (bf16_t)f2bf(q * e1); B1[t * 72 + lane] = (bf16_t)f2bf(kj * e2); }
        __syncthreads();
#pragma unroll
        for (int j = 0; j < 32; ++j) B2[lane * 72 + half * 32 + j] = ivr[j];
        __syncthreads();
        f32x16 s0 = mma_lds<64>(B0 + 32 * half * 72, 72, B1, 72, zero16(), lane);
        f32x16 s1 = zero16(); if (half) s1 = mma_lds<64>(B0 + 32 * half * 72, 72, B1 + 32 * 72, 72, zero16(), lane);
        __syncthreads();
#pragma unroll
        for (int i = 0; i < 16; ++i) { const int row = 32 * half + crow(i, h);
            B1[row * 72 + c0] = (bf16_t)f2bf(c0 <= row ? s0[i] : 0.f); B1[row * 72 + 32 + c0] = (bf16_t)f2bf(32 + c0 <= row ? s1[i] : 0.f); }
        __syncthreads();
        f32x16 o0 = mma_lds<64>(B1 + 32 * half * 72, 72, B2, 72, zero16(), lane);
        f32x16 o1 = mma_lds<64>(B1 + 32 * half * 72, 72, B2 + 32 * 72, 72, zero16(), lane);
        __syncthreads();
        {
          u32x4 wsl[4], wg[4];
          const bf16_t* sp = SL2 + (size_t)item * 4096 + (32 * half) * 64;
#pragma unroll
          for (int e = 0; e < 4; ++e) { const int pc = lane + 64 * e; wsl[e] = *(const u32x4*)(sp + pc * 8); wg[e] = *(const u32x4*)(zsrc + (size_t)(16 * e) * DIN + ZG); }
#pragma unroll
          for (int e = 0; e < 4; ++e) { const int pc = lane + 64 * e, row = pc >> 3, k0 = (pc & 7) * 8; const LAS float* eg = GL + k0;
              u32x4 o; o.x = pk2(bflo(wsl[e].x) * eg[0], bfhi(wsl[e].x) * eg[1]); o.y = pk2(bflo(wsl[e].y) * eg[2], bfhi(wsl[e].y) * eg[3]);
              o.z = pk2(bflo(wsl[e].z) * eg[4], bfhi(wsl[e].z) * eg[5]); o.w = pk2(bflo(wsl[e].w) * eg[6], bfhi(wsl[e].w) * eg[7]);
              *(LAS u32x4*)(B2 + (32 * half + row) * 72 + k0) = o;
              *(LAS u32x4*)(lds + sdst + 9216 + e * 16 * 144) = wg[e]; } }
        __syncthreads();
        o0 = mma_lds<64>(B0 + 32 * half * 72, 72, B2, 72, o0, lane);
        o1 = mma_lds<64>(B0 + 32 * half * 72, 72, B2 + 32 * 72, 72, o1, lane);
        const float* ng = p.in[I_HNG] + l * 256 + hd * 64; const float ng0 = ng[c0], ng1 = ng[32 + c0];
#pragma unroll
        for (int i = 0; i < 16; ++i) { const int row = 32 * half + crow(i, h);
            const float ss = half_sum(o0[i] * o0[i] + o1[i] * o1[i]); const float rs = rsqrtf(ss * (1.0f / 64.0f) + EPS);
            const float g0 = bf2f(B1[row * 72 + c0]), g1 = bf2f(B1[row * 72 + 32 + c0]);
            const float v0 = o0[i] * rs * ng0 * g0 * sigmoidf_(g0), v1 = o1[i] * rs * ng1 * g1 * sigmoidf_(g1);
            o0[i] = v0; o1[i] = v1; const float s2 = half_sum(v0 * v0 + v1 * v1); if (c0 == 0) SSA[hd * 64 + row] = s2; }
        __syncthreads();
        bf16_t* Y = (bf16_t*)(p.ws + WS_YCAT);
#pragma unroll
        for (int i = 0; i < 16; ++i) { const int row = 32 * half + crow(i, h); const size_t tok = (size_t)cg * 64 + row;
            const float tot = (SSA[row] + SSA[64 + row]) + (SSA[128 + row] + SSA[192 + row]); const float r2 = rsqrtf(tot * (1.0f / 256.0f) + EPS);
            Y[tok * D + YA + hd * 64 + c0] = (bf16_t)f2bf(o0[i] * r2); Y[tok * D + YA + hd * 64 + 32 + c0] = (bf16_t)f2bf(o1[i] * r2); }
    }
}
DI void hgrn_scan_item(const Params& p, int hb) {
    int tid_o = threadIdx.x; asm volatile("" : "+v"(tid_o));
    const int e = hb * 512 + tid_o, bh = e >> 12, b = bh >> 2, hd = bh & 3, vk = e & 4095, k = vk & 63;
    const bf16_t* SL = (const bf16_t*)(p.ws + WS_SL); bf16_t* SL2 = (bf16_t*)(p.ws + WS_SL2); const float* DEC = (const float*)(p.ws + WS_DEC);
    float st = 0.f;
    for (int c8 = 0; c8 < 128; c8 += 16) { float tmp[16], dc[16];
#pragma unroll
        for (int u = 0; u < 16; ++u) { const int item = (b * 128 + c8 + u) * 4 + hd; tmp[u] = bf2f(SL[(size_t)item * 4096 + vk]); dc[u] = DEC[item * 64 + k]; }
#pragma unroll
        for (int u = 0; u < 16; ++u) { const int item = (b * 128 + c8 + u) * 4 + hd; SL2[(size_t)item * 4096 + vk] = (bf16_t)f2bf(st); st = dc[u] * st + tmp[u]; } }
}

DI void conv_item(const Params& p, LAS unsigned char* lds, int l, int ti) {
    int tid_o = threadIdx.x; asm volatile("" : "+v"(tid_o));
    const int tid = tid_o, lane = tid & 63, wave = tid >> 6, c = tid & 255, hf = tid >> 8, wv = wave & 3;
    LAS float* Hs = (LAS float*)lds; LAS float* ST = (LAS float*)(lds + 98304); LAS float* ST2 = ST + 512;
    const bf16_t* Z = (const bf16_t*)(p.ws + WS_Z); bf16_t* Y = (bf16_t*)(p.ws + WS_YCAT);
    const int tok0 = ti * 64, pos0 = (ti & 127) * 64;
    __syncthreads();
    { u32x4 vw[6], gw_[6];
#pragma unroll
      for (int k = 0; k < 6; ++k) { const int pid = tid + 512 * k, row = pid >> 5, pc = pid & 31, pos = pos0 - 30 + row; const bool ok = (row < 94) && (pos >= 0);
          const size_t tok = ok ? (size_t)(tok0 - 30 + row) : (size_t)tok0; vw[k] = *(const u32x4*)(Z + tok * DIN + ZBV + pc * 8); gw_[k] = *(const u32x4*)(Z + tok * DIN + ZBG + pc * 8); }
#pragma unroll
      for (int k = 0; k < 6; ++k) { const int pid = tid + 512 * k, row = pid >> 5, pc = pid & 31, pos = pos0 - 30 + row; const bool ok = (row < 94) && (pos >= 0);
          if (row < 94) { f32x4 h0, h1;
              h0[0] = bflo(vw[k].x) * sigmoidf_(bflo(gw_[k].x)); h0[1] = bfhi(vw[k].x) * sigmoidf_(bfhi(gw_[k].x)); h0[2] = bflo(vw[k].y) * sigmoidf_(bflo(gw_[k].y)); h0[3] = bfhi(vw[k].y) * sigmoidf_(bfhi(gw_[k].y));
              h1[0] = bflo(vw[k].z) * sigmoidf_(bflo(gw_[k].z)); h1[1] = bfhi(vw[k].z) * sigmoidf_(bfhi(gw_[k].z)); h1[2] = bflo(vw[k].w) * sigmoidf_(bflo(gw_[k].w)); h1[3] = bfhi(vw[k].w) * sigmoidf_(bfhi(gw_[k].w));
              if (!ok) { h0 = (f32x4){0.f, 0.f, 0.f, 0.f}; h1 = h0; }
              *(LAS f32x4*)(Hs + row * 256 + pc * 8) = h0; *(LAS f32x4*)(Hs + row * 256 + pc * 8 + 4) = h1; } } }
    __syncthreads();
    const float* cw = p.in[I_CW] + (size_t)l * 31 * 256 + c; float w[31];
#pragma unroll
    for (int jj = 0; jj < 31; ++jj) w[jj] = cw[jj * 256];
    const float cb = p.in[I_CB][l * 256 + c];
    const float lng = p.in[I_CLG][l * 256 + c], lnb = p.in[I_CLB][l * 256 + c];
#pragma unroll 1
    for (int ps = 0; ps < 2; ++ps) { const int tb = hf * 32 + ps * 16;
        float o[16];
        { float hr[46];
#pragma unroll
          for (int r = 0; r < 46; ++r) hr[r] = Hs[(tb + r) * 256 + c];
#pragma unroll
          for (int j = 0; j < 16; ++j) { float a = cb;
#pragma unroll
            for (int jj = 0; jj < 31; ++jj) a += w[jj] * hr[j + jj];
            o[j] = a; } }
#pragma unroll
        for (int j = 0; j < 16; ++j) { const float s1 = wave_sum(o[j]), s2 = wave_sum(o[j] * o[j]); if (lane == 0) { ST[((tb + j) * 4 + wv) * 2] = s1; ST[((tb + j) * 4 + wv) * 2 + 1] = s2; } }
        __syncthreads();
#pragma unroll
        for (int j = 0; j < 16; ++j) { const LAS float* q = ST + (tb + j) * 8; const float s1 = (q[0] + q[2]) + (q[4] + q[6]), s2 = (q[1] + q[3]) + (q[5] + q[7]);
            const float mu = s1 * (1.0f / 256.0f); const float var = fmaxf(s2 * (1.0f / 256.0f) - mu * mu, 0.f);
            const float y = (o[j] - mu) * rsqrtf(var + EPS) * lng + lnb; const float sv = y * sigmoidf_(y); o[j] = sv;
            const float s3 = wave_sum(sv * sv); if (lane == 0) ST2[(tb + j) * 4 + wv] = s3; }
        __syncthreads();
#pragma unroll
        for (int j = 0; j < 16; ++j) { const LAS float* q = ST2 + (tb + j) * 4; const float tot = (q[0] + q[1]) + (q[2] + q[3]); const float rs = rsqrtf(tot * (1.0f / 256.0f) + EPS);
            Y[(size_t)(tok0 + tb + j) * D + YB + c] = (bf16_t)f2bf(o[j] * rs); }
    }
}

DI bf16x8 ldg8(const bf16_t* p) { return *(const bf16x8*)p; }
DI void s5_local_item(const Params& p, int l, int bi) {
    int tid_o = threadIdx.x; asm volatile("" : "+v"(tid_o));
    const int lane = tid_o & 63, wi = bi * 8 + (tid_o >> 6);
    const int g = wi & 15, cb = (wi >> 4) & 15, pt = wi >> 8, c0 = lane & 31, h = lane >> 5;
    const bf16_t* ua = (const bf16_t*)(p.ws + WS_Z) + (size_t)((cb * 32 + c0) * 64) * DIN + ZCU + g * 16 + 8 * h;
    const bf16_t* wb = (const bf16_t*)(p.ws + WS_S5WS) + ((size_t)(l * 16 + g) * 128 + pt * 32 + c0) * 1024 + 8 * h;
    f32x16 acc = zero16();
#pragma unroll 8
    for (int s = 0; s < 64; ++s) acc = __builtin_amdgcn_mfma_f32_32x32x16_bf16(ldg8(ua + (size_t)s * DIN), ldg8(wb + s * 16), acc, 0, 0, 0);
    float* HL = (float*)(p.ws + WS_S5H);
#pragma unroll
    for (int i = 0; i < 16; ++i) HL[((size_t)(cb * 32 + crow(i, h)) * 16 + g) * 128 + pt * 32 + c0] = acc[i];
}
DI void s5_scan_item(const Params& p, int l, int sb) {
    int tid_o = threadIdx.x; asm volatile("" : "+v"(tid_o));
    const int e = sb * 512 + tid_o, b = e >> 10, g = (e >> 6) & 15, pp = e & 63;
    float lrdt, lidt, cr, ci; s5_params(p, l * 16 + g, pp, lrdt, lidt, cr, ci);
    float ar, ai; s5_pow(lrdt, lidt, 64, ar, ai);
    const float* HL = (const float*)(p.ws + WS_S5H); float* HO = (float*)(p.ws + WS_S5H2); float hr = 0.f, hi = 0.f;
    for (int c8 = 0; c8 < 128; c8 += 16) { float tr[16], ti[16];
#pragma unroll
        for (int u = 0; u < 16; ++u) { const size_t idx = ((size_t)(b * 128 + c8 + u) * 16 + g) * 128; tr[u] = HL[idx + pp]; ti[u] = HL[idx + 64 + pp]; }
#pragma unroll
        for (int u = 0; u < 16; ++u) { const size_t idx = ((size_t)(b * 128 + c8 + u) * 16 + g) * 128; HO[idx + pp] = hr; HO[idx + 64 + pp] = hi;
            const float nr = ar * hr - ai * hi + tr[u], ni = ar * hi + ai * hr + ti[u]; hr = nr; hi = ni; } }
}
DI void s5_out_item(const Params& p, LAS unsigned char* lds, int l, int bi) {
    int tid_o = threadIdx.x; asm volatile("" : "+v"(tid_o));
    const int tid = tid_o, lane = tid & 63, wave = tid >> 6;
    const int gh = bi & 1, cb = (bi >> 1) & 15, pr = bi >> 5, g = gh * 8 + wave, c0 = lane & 31, h = lane >> 5, lg = l * 16 + g;
    LAS bf16_t* UT = (LAS bf16_t*)lds;
    LAS bf16_t* OT = (LAS bf16_t*)(lds + 69632);
    const bf16_t* Z = (const bf16_t*)(p.ws + WS_Z);
    const bf16_t* kt = (const bf16_t*)(p.ws + WS_S5K) + (size_t)lg * 64 * 256;
    const float* ha = (const float*)(p.ws + WS_S5H2) + ((size_t)(cb * 32 + c0) * 16 + g) * 128 + 8 * h;
    const int co = c0 & 15; const float dsk = p.in[I_S5D][l * 256 + g * 16 + co];
    const int jt0 = pr, jt1 = 31 - pr, tl0 = 2 * jt0 + (c0 >> 4), tl1 = 2 * jt1 + (c0 >> 4);
    const int sm = tid >> 4, spc = tid & 15;
    const bf16_t* zst = Z + (size_t)((cb * 32 + sm) * 64) * DIN + ZCU + gh * 128 + spc * 8;
    const int ust = (sm * 136 + spc * 8) * 2;
    const int nb = (2 * jt1 + 2 + 7) >> 3;
    u32x4 pf[8];
#pragma unroll
    for (int e = 0; e < 8; ++e) pf[e] = *(const u32x4*)(zst + (size_t)e * DIN);
    f32x16 acc0 = zero16(), acc1 = zero16();
    { const bf16_t* wc0 = (const bf16_t*)(p.ws + WS_S5WC) + (((size_t)lg * 64 + tl0) * 16 + co) * 128 + 8 * h;
      const bf16_t* wc1 = (const bf16_t*)(p.ws + WS_S5WC) + (((size_t)lg * 64 + tl1) * 16 + co) * 128 + 8 * h;
      f32x4 x0[8], x1[8];
#pragma unroll
      for (int ks = 0; ks < 8; ++ks) { x0[ks] = *(const f32x4*)(ha + ks * 16); x1[ks] = *(const f32x4*)(ha + ks * 16 + 4); }
#pragma unroll
      for (int ks = 0; ks < 8; ++ks) { u32x4 w; w.x = pk2(x0[ks][0], x0[ks][1]); w.y = pk2(x0[ks][2], x0[ks][3]); w.z = pk2(x1[ks][0], x1[ks][1]); w.w = pk2(x1[ks][2], x1[ks][3]);
        const bf16x8 af = __builtin_bit_cast(bf16x8, w);
        acc0 = __builtin_amdgcn_mfma_f32_32x32x16_bf16(af, ldg8(wc0 + ks * 16), acc0, 0, 0, 0);
        acc1 = __builtin_amdgcn_mfma_f32_32x32x16_bf16(af, ldg8(wc1 + ks * 16), acc1, 0, 0, 0); } }
    __syncthreads();
    for (int b = 0; b < nb; ++b) { const int s0 = 8 * b;
#pragma unroll
        for (int e = 0; e < 8; ++e) *(LAS u32x4*)(lds + ust + e * (32 * 136 * 2)) = pf[e];
        __syncthreads();
        if (b + 1 < nb) {
#pragma unroll
            for (int e = 0; e < 8; ++e) pf[e] = *(const u32x4*)(zst + (size_t)(s0 + 8 + e) * DIN); }
        const bool use0 = s0 <= 2 * jt0 + 1;
        bf16x8 b0[8], b1[8];
#pragma unroll
        for (int e = 0; e < 8; ++e) { const int d1 = tl1 - (s0 + e); b1[e] = ldg8(kt + ((size_t)(d1 < 0 ? 0 : d1) * 16 + co) * 16 + 8 * h);
            if (use0) { const int d0 = tl0 - (s0 + e); b0[e] = ldg8(kt + ((size_t)(d0 < 0 ? 0 : d0) * 16 + co) * 16 + 8 * h); } }
#pragma unroll
        for (int e = 0; e < 8; ++e) { const bf16x8 af = *(const LAS bf16x8*)(UT + (e * 32 + c0) * 136 + wave * 16 + 8 * h);
            const int d1 = tl1 - (s0 + e); bf16x8 bb = b1[e]; if (d1 < 0) bb = (bf16x8){0, 0, 0, 0, 0, 0, 0, 0};
            acc1 = __builtin_amdgcn_mfma_f32_32x32x16_bf16(af, bb, acc1, 0, 0, 0);
            if (use0) { const int d0 = tl0 - (s0 + e); bf16x8 ba = b0[e]; if (d0 < 0) ba = (bf16x8){0, 0, 0, 0, 0, 0, 0, 0};
                acc0 = __builtin_amdgcn_mfma_f32_32x32x16_bf16(af, ba, acc0, 0, 0, 0); } }
        __syncthreads();
    }
#pragma unroll
    for (int q = 0; q < 2; ++q) { const int tl = q ? tl1 : tl0;
#pragma unroll
        for (int i = 0; i < 16; ++i) { const int m = crow(i, h); const size_t tok = (size_t)(cb * 32 + m) * 64 + tl; const float u = bf2f(Z[tok * DIN + ZCU + g * 16 + co]);
            const float y = (q ? acc1[i] : acc0[i]) + dsk * u; const float ge = y * sigmoidf_(1.5957691216057308f * (y + 0.044715f * y * y * y));
            OT[(q * 64 + m * 2 + (c0 >> 4)) * 136 + wave * 16 + co] = (bf16_t)f2bf(ge); } }
    __syncthreads();
    { const int tau = tid >> 2, qq = tau >> 6, m = (tau >> 1) & 31, t2 = tau & 1, qt = tid & 3; const int jt = qq ? jt1 : jt0;
      const size_t tok = (size_t)(cb * 32 + m) * 64 + 2 * jt + t2;
      const LAS u32x4* src = (const LAS u32x4*)(OT + tau * 136 + qt * 32); u32x4* dst = (u32x4*)((bf16_t*)(p.ws + WS_YPRE) + tok * 256 + gh * 128 + qt * 32);
#pragma unroll
      for (int e = 0; e < 4; ++e) dst[e] = src[e]; }
}

DI void attn_item(const Params& p, LAS unsigned char* lds, int l, int pt, int id) {
    int tid_o = threadIdx.x; asm volatile("" : "+v"(tid_o));
    const int tid = tid_o, lane = tid & 63, wave = tid >> 6;
    const int dil = pt == 0 ? 1 : (pt == 1 ? 4 : 16), nblk = 32 / dil;
    const int b = id >> 7, hd = (id >> 5) & 3, rn = id & 31, r = rn / nblk, n = rn % nblk;
    LAS bf16_t* Ks = (LAS bf16_t*)lds;
    LAS bf16_t* Vt = (LAS bf16_t*)(lds + 55296);
    LAS float* BT = (LAS float*)(lds + 55296 + 50176);
    const bf16_t* Z = (const bf16_t*)(p.ws + WS_Z);
    const bf16_t* OP = (const bf16_t*)(p.ws + (pt == 1 ? WS_O0 : WS_O1)); const float* LP = (const float*)(p.ws + (pt == 1 ? WS_LSE : WS_LSE1));
    bf16_t* ON = pt == 2 ? (bf16_t*)(p.ws + WS_Z) + ZOD : (bf16_t*)(p.ws + (pt == 0 ? WS_O0 : WS_O1)); const int onp = pt == 2 ? DIN : 256;
    float* LN = (float*)(p.ws + (pt == 0 ? WS_LSE : WS_LSE1));
    const size_t tokb = (size_t)b * SEQ;
    const int c0 = lane & 31, h = lane >> 5;
    const int qi = 32 * wave + c0; const size_t tokq = tokb + (size_t)(n * 256 + qi) * dil + r;
    u32x4 qraw[4]; u32x2 oprev[2][4]; float mprev = 0.f;
#pragma unroll
    for (int ks = 0; ks < 4; ++ks) qraw[ks] = *(const u32x4*)(Z + tokq * DIN + ZDQ + hd * 64 + ks * 16 + 8 * h);
    if (pt > 0) { mprev = LP[tokq * 4 + hd];
#pragma unroll
        for (int vt = 0; vt < 2; ++vt)
#pragma unroll
            for (int g4 = 0; g4 < 4; ++g4) oprev[vt][g4] = *(const u32x2*)(OP + tokq * 256 + hd * 64 + 32 * vt + 8 * g4 + 4 * h); }
    __syncthreads();
    if (tid < 132) BT[tid] = ((const float*)(p.ws + WS_BIAS))[(pt * 4 + hd) * 132 + tid];
    { const float* kg = p.in[I_KG] + l * 64 + (tid & 7) * 8; float kgv[8];
#pragma unroll
      for (int e = 0; e < 8; ++e) kgv[e] = kg[e];
      u32x4 kwv[6], vwv[6];
#pragma unroll
      for (int it = 0; it < 6; ++it) { const int idx = tid + 512 * it, row = idx >> 3, c = idx & 7, si = n * 256 - 128 + row;
        const size_t tok = tokb + (size_t)(si < 0 ? 0 : si) * dil + r;
        kwv[it] = *(const u32x4*)(Z + tok * DIN + ZDK + hd * 64 + c * 8); vwv[it] = *(const u32x4*)(Z + tok * DIN + ZDV + hd * 64 + c * 8); }
#pragma unroll
      for (int it = 0; it < 6; ++it) { const int idx = tid + 512 * it, row = idx >> 3, c = idx & 7, si = n * 256 - 128 + row;
        u32x4 kw = kwv[it], vw = vwv[it];
        if (si < 0) { kw = (u32x4){0u, 0u, 0u, 0u}; vw = (u32x4){0u, 0u, 0u, 0u}; }
        float kf[8]; kf[0] = bflo(kw.x); kf[1] = bfhi(kw.x); kf[2] = bflo(kw.y); kf[3] = bfhi(kw.y); kf[4] = bflo(kw.z); kf[5] = bfhi(kw.z); kf[6] = bflo(kw.w); kf[7] = bfhi(kw.w);
        float ss = 0.f;
#pragma unroll
        for (int e = 0; e < 8; ++e) ss += kf[e] * kf[e];
        ss += __shfl_xor(ss, 1); ss += __shfl_xor(ss, 2); ss += __shfl_xor(ss, 4);
        const float rs = rsqrtf(ss * (1.0f / 64.0f) + EPS);
        u32x4 o; o.x = pk2(kf[0] * rs * kgv[0], kf[1] * rs * kgv[1]); o.y = pk2(kf[2] * rs * kgv[2], kf[3] * rs * kgv[3]); o.z = pk2(kf[4] * rs * kgv[4], kf[5] * rs * kgv[5]); o.w = pk2(kf[6] * rs * kgv[6], kf[7] * rs * kgv[7]);
        *(LAS u32x4*)(Ks + row * 72 + c * 8) = o;
        LAS bf16_t* vp = Vt + (c * 8) * 392 + row;
        vp[0 * 392] = (bf16_t)(vw.x & 0xffffu); vp[1 * 392] = (bf16_t)(vw.x >> 16); vp[2 * 392] = (bf16_t)(vw.y & 0xffffu); vp[3 * 392] = (bf16_t)(vw.y >> 16);
        vp[4 * 392] = (bf16_t)(vw.z & 0xffffu); vp[5 * 392] = (bf16_t)(vw.z >> 16); vp[6 * 392] = (bf16_t)(vw.w & 0xffffu); vp[7 * 392] = (bf16_t)(vw.w >> 16); } }
    __syncthreads();
    bf16x8 qf[4];
    { float qv[4][8]; float ss = 0.f;
#pragma unroll
      for (int ks = 0; ks < 4; ++ks) { const u32x4 w = qraw[ks];
        qv[ks][0] = bflo(w.x); qv[ks][1] = bfhi(w.x); qv[ks][2] = bflo(w.y); qv[ks][3] = bfhi(w.y); qv[ks][4] = bflo(w.z); qv[ks][5] = bfhi(w.z); qv[ks][6] = bflo(w.w); qv[ks][7] = bfhi(w.w);
#pragma unroll
        for (int e = 0; e < 8; ++e) ss += qv[ks][e] * qv[ks][e]; }
      ss += __shfl_xor(ss, 32);
      const float rs = rsqrtf(ss * (1.0f / 64.0f) + EPS) * 0.125f;
#pragma unroll
      for (int ks = 0; ks < 4; ++ks) { const float* qg = p.in[I_QG] + l * 64 + ks * 16 + 8 * h; const f32x4 g0 = *(const f32x4*)qg, g1 = *(const f32x4*)(qg + 4);
        u32x4 w; w.x = pk2(qv[ks][0] * rs * g0[0], qv[ks][1] * rs * g0[1]); w.y = pk2(qv[ks][2] * rs * g0[2], qv[ks][3] * rs * g0[3]);
        w.z = pk2(qv[ks][4] * rs * g1[0], qv[ks][5] * rs * g1[1]); w.w = pk2(qv[ks][6] * rs * g1[2], qv[ks][7] * rs * g1[3]);
        qf[ks] = __builtin_bit_cast(bf16x8, w); } }
    f32x16 acc[5];
#pragma unroll
    for (int c = 0; c < 5; ++c) { acc[c] = zero16(); const LAS bf16_t* kb = Ks + (32 * wave + 32 * c + c0) * 72 + 8 * h;
#pragma unroll
        for (int ks = 0; ks < 4; ++ks) acc[c] = __builtin_amdgcn_mfma_f32_32x32x16_bf16(*(const LAS bf16x8*)(kb + ks * 16), qf[ks], acc[c], 0, 0, 0); }
    float mx = -1e30f;
#pragma unroll
    for (int c = 0; c < 5; ++c)
#pragma unroll
        for (int i = 0; i < 16; ++i) { const int kr = crow(i, h); const int delta = 128 + c0 - 32 * c - kr; const int jl = 32 * wave + 32 * c + kr;
            const bool valid = (delta >= 0) && (delta <= 128) && (n * 256 - 128 + jl >= 0);
            const int dcl = delta < 0 ? 0 : (delta > 128 ? 128 : delta);
            const float lgt = valid ? acc[c][i] + BT[dcl] : -1e30f; acc[c][i] = lgt; mx = fmaxf(mx, lgt); }
    mx = fmaxf(mx, __shfl_xor(mx, 32));
    float mnew = mx;
    if (pt > 0) mnew = fmaxf(mx, mprev);
    float lsum = 0.f;
#pragma unroll
    for (int c = 0; c < 5; ++c)
#pragma unroll
        for (int i = 0; i < 16; ++i) { const float pv = __expf(acc[c][i] - mnew); acc[c][i] = pv; lsum += pv; }
    lsum += __shfl_xor(lsum, 32);
    f32x16 o[2]; o[0] = zero16(); o[1] = zero16();
#pragma unroll
    for (int c = 0; c < 5; ++c)
#pragma unroll
        for (int s = 0; s < 2; ++s) { u32x4 pw; pw.x = pk2(acc[c][8 * s + 0], acc[c][8 * s + 1]); pw.y = pk2(acc[c][8 * s + 2], acc[c][8 * s + 3]); pw.z = pk2(acc[c][8 * s + 4], acc[c][8 * s + 5]); pw.w = pk2(acc[c][8 * s + 6], acc[c][8 * s + 7]);
            const bf16x8 pf = __builtin_bit_cast(bf16x8, pw);
#pragma unroll
            for (int vt = 0; vt < 2; ++vt) { const LAS bf16_t* va = Vt + (32 * vt + c0) * 392 + 32 * wave + 32 * c + 16 * s + 4 * h;
                const s16x4 lo = *(const LAS s16x4*)va, hi = *(const LAS s16x4*)(va + 8);
                const bf16x8 vf = __builtin_shufflevector(lo, hi, 0, 1, 2, 3, 4, 5, 6, 7);
                o[vt] = __builtin_amdgcn_mfma_f32_32x32x16_bf16(vf, pf, o[vt], 0, 0, 0); } }
    float sp = 0.f; if (pt > 0) sp = __expf(mprev - mnew);
    const float ltot = lsum + sp, inv = 1.0f / ltot;
#pragma unroll
    for (int vt = 0; vt < 2; ++vt)
#pragma unroll
        for (int g4 = 0; g4 < 4; ++g4) { const int ch = hd * 64 + 32 * vt + 8 * g4 + 4 * h; bf16_t* yo = ON + tokq * onp + ch;
            float v0 = o[vt][4 * g4 + 0], v1 = o[vt][4 * g4 + 1], v2 = o[vt][4 * g4 + 2], v3 = o[vt][4 * g4 + 3];
            if (pt > 0) { const u32x2 w = oprev[vt][g4]; v0 += sp * bflo(w.x); v1 += sp * bfhi(w.x); v2 += sp * bflo(w.y); v3 += sp * bfhi(w.y); }
            u32x2 w; w.x = pk2(v0 * inv, v1 * inv); w.y = pk2(v2 * inv, v3 * inv); *(u32x2*)yo = w; }
    if (h == 0 && pt < 2) __hip_atomic_store(LN + tokq * 4 + hd, mnew + __logf(ltot), __ATOMIC_RELAXED, __HIP_MEMORY_SCOPE_AGENT);
}

#define RLX_AGENT __ATOMIC_RELAXED, __HIP_MEMORY_SCOPE_AGENT
#define XB_TMO      128
#define XB_XCNT(j)  (256  + 64 * (j))
#define XB_XSUB(j)  (1280 + 64 * (j))
#define XB_XGEN(j)  (2304 + 64 * (j))
#define XB_TOP      3328
#define XB_TOPGEN   3392
#define XCD_BAR_WORDS 3456
#define XB_SPIN_CAP (1u << 18)

__device__ __forceinline__ unsigned xb_ld(unsigned* p)              { return __hip_atomic_load(p, __ATOMIC_RELAXED, __HIP_MEMORY_SCOPE_AGENT); }
__device__ __forceinline__ unsigned xb_add(unsigned* p, unsigned v) { return __hip_atomic_fetch_add(p, v, __ATOMIC_RELAXED, __HIP_MEMORY_SCOPE_AGENT); }
__device__ __forceinline__ unsigned xb_xcc_id() { return (unsigned)__builtin_amdgcn_s_getreg((3 << 11) | 20) & 0xFu; }
#define XB_SPIN(cond, bar) do { unsigned _sp = 0; while (cond) { __builtin_amdgcn_s_sleep(1); \
    if ((++_sp & 255u) == 0u) { if (xb_ld(&(bar)[XB_TMO])) break; if (_sp > XB_SPIN_CAP) { atomicAdd(&(bar)[XB_TMO], 1u); break; } } } } while (0)

struct XcdBarrier {
    unsigned* bar; unsigned x;
    volatile LAS unsigned* st;
};

__device__ __forceinline__ XcdBarrier xcd_barrier_post(unsigned* bar, volatile LAS unsigned* st) {
    XcdBarrier b; b.bar = bar; b.x = xb_xcc_id(); b.st = st;
    if (threadIdx.x == 0) (void)xb_add(&bar[XB_XCNT(b.x)], 1u);
    return b;
}
__device__ __forceinline__ void xcd_barrier_complete(unsigned* bar, unsigned x, unsigned& nloc, unsigned& nx) {
    const unsigned G = gridDim.x * gridDim.y * gridDim.z;
    unsigned sum, cnt, mine, sp = 0u;
    for (;;) {
        sum = 0u; cnt = 0u; mine = 0u;
#pragma unroll
        for (unsigned j = 0; j < 16; ++j) { const unsigned c = xb_ld(&bar[XB_XCNT(j)]); sum += c; cnt += (c > 0u) ? 1u : 0u; mine = (j == x) ? c : mine; }
        if (sum == G) break;
        __builtin_amdgcn_s_sleep(1);
        if ((++sp & 255u) == 0u) { if (xb_ld(&bar[XB_TMO])) break; if (sp > XB_SPIN_CAP) { atomicAdd(&bar[XB_TMO], 1u); break; } }
    }
    nloc = mine > 0u ? mine : 1u; nx = cnt > 0u ? cnt : 1u;
}

__device__ __forceinline__ void xcd_barrier(const XcdBarrier& b) {
    asm volatile("s_waitcnt vmcnt(0)" ::: "memory");
    __syncthreads();
    if (threadIdx.x == 0) {
        unsigned* bar = b.bar;
        __builtin_amdgcn_s_waitcnt(0);
        unsigned nloc = b.st[0], nx = b.st[1];
        if (nloc == 0u) { xcd_barrier_complete(bar, b.x, nloc, nx); b.st[0] = nloc; b.st[1] = nx; }
        const unsigned old = xb_add(&bar[XB_XSUB(b.x)], 1u);
        const unsigned gen = old / nloc;
        if (old + 1u == (gen + 1u) * nloc) {
            __builtin_amdgcn_fence(__ATOMIC_RELEASE, "agent");
            asm volatile("s_waitcnt vmcnt(0)" ::: "memory");
            const unsigned og = xb_add(&bar[XB_TOP], 1u);
            const unsigned tg = og / nx;
            if (og + 1u == (tg + 1u) * nx) xb_add(&bar[XB_TOPGEN], 1u);
            else XB_SPIN(xb_ld(&bar[XB_TOPGEN]) == tg, bar);
            __builtin_amdgcn_fence(__ATOMIC_ACQUIRE, "agent");
            xb_add(&bar[XB_XGEN(b.x)], 1u);
            asm volatile("s_waitcnt vmcnt(0)" ::: "memory");
        } else {
            XB_SPIN(xb_ld(&bar[XB_XGEN(b.x)]) == gen, bar);
            __builtin_amdgcn_fence(__ATOMIC_ACQUIRE, "agent");
            asm volatile("s_waitcnt vmcnt(0)" ::: "memory");
        }
    }
    __syncthreads();
}

#ifndef REP_A
#define REP_A 0
#endif
#ifndef REP_B
#define REP_B 0
#endif
#ifndef REP_C
#define REP_C 0
#endif
#ifndef REP_D
#define REP_D 0
#endif
#ifndef MIX_A
#define MIX_A 1
#endif
#ifndef MIX_B
#define MIX_B 1
#endif
#ifndef MIX_C
#define MIX_C 1
#endif
#ifndef MIX_D
#define MIX_D 1
#endif
__global__ void __launch_bounds__(512, 2) hybrid_fwd(Params p) {
    extern __shared__ __attribute__((aligned(16))) unsigned char lds_raw[];
    LAS unsigned char* lds = (LAS unsigned char*)lds_raw;
    cg::grid_group grid = cg::this_grid();
    { volatile LAS unsigned* st0 = (volatile LAS unsigned*)(lds + LDS_BYTES - 64); if (threadIdx.x < 2) st0[threadIdx.x] = 0u; }
    __syncthreads();
    (void)xcd_barrier_post((unsigned*)(p.ws + WS_BAR), (volatile LAS unsigned*)(lds + LDS_BYTES - 64));
    const int G = gridDim.x, bid = blockIdx.x;
    unsigned char* ws = p.ws;
    bf16_t* XB = (bf16_t*)(ws + WS_XB); bf16_t* Zb = (bf16_t*)(ws + WS_Z); bf16_t* YC_ = (bf16_t*)(ws + WS_YCAT); bf16_t* HM = (bf16_t*)(ws + WS_HM);
    float* SSQP = (float*)(ws + WS_SSQP);

#define GRID_SYNC_() do { asm volatile("s_waitcnt vmcnt(0) lgkmcnt(0)" ::: "memory"); grid.sync(); if (threadIdx.x < 64) { __builtin_amdgcn_fence(__ATOMIC_ACQUIRE, "agent"); asm volatile("s_waitcnt vmcnt(0)" ::: "memory"); } __syncthreads(); } while (0)
#define XBAR_ONCE() do { XcdBarrier b_; b_.bar = (unsigned*)(p.ws + WS_BAR); b_.x = xb_xcc_id(); b_.st = (volatile LAS unsigned*)(lds + LDS_BYTES - 64); xcd_barrier(b_); } while (0)
#ifdef REP_SYNC
#define GRID_SYNC() do { XBAR_ONCE(); XBAR_ONCE(); } while (0)
#else
#define GRID_SYNC() XBAR_ONCE()
#endif
    prologue(p, lds, G);
#ifdef REP_PRO
    GRID_SYNC_(); prologue(p, lds, G);
#endif
#ifdef NANFILL
    { u32x4* q = (u32x4*)(ws + WS_S5H); const size_t n16 = (WS_END - WS_S5H) / 16; const u32x4 nanv = (u32x4){0xffffffffu, 0xffffffffu, 0xffffffffu, 0xffffffffu};
      for (size_t i = (size_t)bid * 512 + threadIdx.x; i < n16; i += (size_t)G * 512) q[i] = nanv;
      u32x4* q2 = (u32x4*)(ws + WS_LSE); const size_t m16 = (WS_S5K - WS_LSE) / 16;
      for (size_t i = (size_t)bid * 512 + threadIdx.x; i < m16; i += (size_t)G * 512) q2[i] = nanv; }
#endif
    if (gridDim.y == 0x7fffffffu) GRID_SYNC_();
    GRID_SYNC();

#ifndef NL_RUN
#define NL_RUN NL
#endif
#ifndef DUMP_LAYER
#define DUMP_LAYER 0
#endif
    for (int lrun = 0; lrun < NL_RUN; ++lrun) {
#ifdef SAME_LAYER
        const int l = 0; const bool firstl = (lrun == 0), lastl = (lrun == NL_RUN - 1);
#else
        const int l = lrun; const bool firstl = (lrun == 0), lastl = (lrun == NL_RUN - 1);
#endif
#define RS_TABLE(SSQ_, NUNITS_) \
          { pg8::Unit ua_, ub_; (void)S.next(0, ua_); (void)S.next((NUNITS_) - 1, ub_); \
              int tq_ = threadIdx.x; asm volatile("" : "+v"(tq_)); const int pm_ = (tq_ >> 8) ? ub_.pm : ua_.pm; \
              const f32x4* sq_ = (const f32x4*)((SSQ_) + ((size_t)pm_ * 256 + (tq_ & 255)) * 16); const f32x4 q0 = sq_[0], q1 = sq_[1], q2 = sq_[2], q3 = sq_[3]; \
              const float tot_ = (((q0[0] + q0[1]) + (q0[2] + q0[3])) + ((q1[0] + q1[1]) + (q1[2] + q1[3]))) + (((q2[0] + q2[1]) + (q2[2] + q2[3])) + ((q3[0] + q3[1]) + (q3[2] + q3[3]))); \
              ((LAS float*)(lds + 131072))[tq_] = rsqrtf(tot_ * (1.0f / 1024.0f) + EPS); __syncthreads(); }
        { pg8::Gemm g{XB, (const bf16_t*)(ws + WS_WIN) + (size_t)l * D * DIN, T, DIN, D, D}; pg8::StaticOrder S; S.init(T, DIN, G, bid);
          RS_TABLE(SSQP, (T / 256) * (DIN / 256) / 256)
          pg8::EpiScale E{Zb, DIN, 0, (const PG8_LAS float*)(lds + 131072)};
          pg8::gemm_phase<pg8::EpiScale, pg8::StaticOrder, true, true>(lds, g, S, E);
#ifdef REPEAT_GEMM
          GRID_SYNC(); pg8::gemm_phase<pg8::EpiScale, pg8::StaticOrder, true, true>(lds, g, S, E);
#endif
        }
        GRID_SYNC();
#ifndef SKIP_MIX
        if (!(MIX_A && MIX_B && MIX_C && MIX_D)) { int tq = threadIdx.x; asm volatile("" : "+v"(tq));
          for (int m = bid * 8 + (tq >> 6); m < T; m += G * 8) { u32x2* yp = (u32x2*)(YC_ + (size_t)m * D) + (tq & 63); const u32x2 z2 = (u32x2){0u, 0u};
              if (!MIX_A) yp[0] = z2; if (!MIX_B) yp[64] = z2; if (!MIX_C) yp[128] = z2; if (!MIX_D) yp[192] = z2; } }
#ifndef MIX_REPEAT
#define MIX_REPEAT 1
#endif
        for (int rep = 0; rep < MIX_REPEAT; ++rep) {
        for (int it = bid; it < 1664; it += G) {
            if (it < 512) { if (MIX_A) { hgrn_item<false>(p, lds, l, it); if (REP_A) hgrn_item<false>(p, lds, l, it); } }
            else if (it < 1024) { if (MIX_B) { conv_item(p, lds, l, it - 512); if (REP_B) conv_item(p, lds, l, it - 512); } }
            else if (it < 1152) { if (MIX_C) { s5_local_item(p, l, it - 1024); if (REP_C) s5_local_item(p, l, it - 1024); } }
            else { if (MIX_D) { attn_item(p, lds, l, 0, it - 1152); if (REP_D) attn_item(p, lds, l, 0, it - 1152); } }
        }
        GRID_SYNC();
        if (bid < 128) { if (MIX_A) hgrn_scan_item(p, bid); } else if (bid < 136) { if (MIX_C) s5_scan_item(p, l, bid - 128); }
        if (bid < 136) { if (MIX_D) { attn_item(p, lds, l, 1, 376 + bid); if (REP_D) attn_item(p, lds, l, 1, 376 + bid); } }
        else for (int it = bid - 136; it < 376; it += 120) { if (MIX_D) { attn_item(p, lds, l, 1, it); if (REP_D) attn_item(p, lds, l, 1, it); } }
        GRID_SYNC();
#ifdef REP_P3
        if (bid < 128) { if (MIX_A) hgrn_scan_item(p, bid); } else if (bid < 136) { if (MIX_C) s5_scan_item(p, l, bid - 128); }
        if (bid < 136) { if (MIX_D) { attn_item(p, lds, l, 1, 376 + bid); if (REP_D) attn_item(p, lds, l, 1, 376 + bid); } }
        else for (int it = bid - 136; it < 376; it += 120) { if (MIX_D) { attn_item(p, lds, l, 1, it); if (REP_D) attn_item(p, lds, l, 1, it); } }
        GRID_SYNC();
#endif
        for (int it = bid; it < 1536; it += G) {
            if (it < 512) { if (MIX_A) { hgrn_item<true>(p, lds, l, it); if (REP_A) hgrn_item<true>(p, lds, l, it); } }
            else if (it < 1024) { if (MIX_C) { s5_out_item(p, lds, l, it - 512); if (REP_C) s5_out_item(p, lds, l, it - 512); } }
            else { if (MIX_D) { attn_item(p, lds, l, 2, it - 1024); if (REP_D) attn_item(p, lds, l, 2, it - 1024); } }
        }
        GRID_SYNC();
        }
#ifndef NO_GLU
        { pg8::Gemm g{(const bf16_t*)(ws + WS_YPRE), (const bf16_t*)(ws + WS_WGLU) + (size_t)l * 65536, T, 256, 256, 256}; pg8::StaticOrder S; S.init(T, 256, G, bid);
          pg8::EpiGlu E{(const bf16_t*)(ws + WS_YPRE), 256, YC_ + YC};
          pg8::gemm_phase<pg8::EpiGlu, pg8::StaticOrder, false, true>(lds, g, S, E); }
#endif
        { int tq = threadIdx.x; asm volatile("" : "+v"(tq)); const int lane = tq & 63; const int gw = (bid - 128) * 8 + (tq >> 6), NGW = 128 * 8;
          if (bid >= 128) for (int m = gw; m < T; m += NGW) { u32x2* yp = (u32x2*)(YC_ + (size_t)m * D + YD) + lane; const u32x2 w = *((const u32x2*)(Zb + (size_t)m * DIN + ZOD) + lane);
              const float a0 = bflo(w.x), a1 = bfhi(w.x), a2 = bflo(w.y), a3 = bfhi(w.y);
              const float ss = wave_sum((a0 * a0 + a1 * a1) + (a2 * a2 + a3 * a3)); const float rs = rsqrtf(ss * (1.0f / 256.0f) + EPS);
              u32x2 o; o.x = pk2(a0 * rs, a1 * rs); o.y = pk2(a2 * rs, a3 * rs); *yp = o; } }
        GRID_SYNC();
#endif
#ifdef REP_P5
#ifndef NO_GLU
        { pg8::Gemm g{(const bf16_t*)(ws + WS_YPRE), (const bf16_t*)(ws + WS_WGLU) + (size_t)l * 65536, T, 256, 256, 256}; pg8::StaticOrder S; S.init(T, 256, G, bid);
          pg8::EpiGlu E{(const bf16_t*)(ws + WS_YPRE), 256, YC_ + YC};
          pg8::gemm_phase<pg8::EpiGlu, pg8::StaticOrder, false, true>(lds, g, S, E); }
#endif
        { int tq = threadIdx.x; asm volatile("" : "+v"(tq)); const int lane = tq & 63; const int gw = (bid - 128) * 8 + (tq >> 6), NGW = 128 * 8;
          if (bid >= 128) for (int m = gw; m < T; m += NGW) { u32x2* yp = (u32x2*)(YC_ + (size_t)m * D + YD) + lane; const u32x2 w = *((const u32x2*)(Zb + (size_t)m * DIN + ZOD) + lane);
              const float a0 = bflo(w.x), a1 = bfhi(w.x), a2 = bflo(w.y), a3 = bfhi(w.y);
              const float ss = wave_sum((a0 * a0 + a1 * a1) + (a2 * a2 + a3 * a3)); const float rs = rsqrtf(ss * (1.0f / 256.0f) + EPS);
              u32x2 o; o.x = pk2(a0 * rs, a1 * rs); o.y = pk2(a2 * rs, a3 * rs); *yp = o; } }
        GRID_SYNC();
#endif
#ifdef DUMP_SLICE
        if (lrun == DUMP_LAYER) { int tq = threadIdx.x; asm volatile("" : "+v"(tq));
          for (int m = bid * 8 + (tq >> 6); m < T; m += G * 8) { const int ln = tq & 63;
              for (int j = 0; j < 4; ++j) { const int col = j * 256 + ln * 4; const u32x2 w = *(const u32x2*)(YC_ + (size_t)m * D + col);
                  f32x4 o = (f32x4){0.f, 0.f, 0.f, 0.f}; if (j == DUMP_SLICE) o = (f32x4){bflo(w.x), bfhi(w.x), bflo(w.y), bfhi(w.y)};
                  *(f32x4*)(p.out + (size_t)m * D + col) = o; } }
          break; }
#endif
#ifdef SKIP_MIX
        { pg8::Gemm g{Zb, (const bf16_t*)(ws + WS_WOUT) + (size_t)l * D * D, T, D, D, DIN}; pg8::StaticOrder S; S.init(T, D, G, bid);
#else
        { pg8::Gemm g{YC_, (const bf16_t*)(ws + WS_WOUT) + (size_t)l * D * D, T, D, D, D}; pg8::StaticOrder S; S.init(T, D, G, bid);
#endif
          pg8::EpiRes E{firstl ? p.in[I_X] : p.out, p.out, XB, SSQP + (size_t)T * 16};
          pg8::gemm_phase<pg8::EpiRes, pg8::StaticOrder, true, true>(lds, g, S, E); }
        GRID_SYNC();
        { pg8::Gemm g{XB, (const bf16_t*)(ws + WS_WUP) + (size_t)l * D * FF, T, FF, D, D}; pg8::StaticOrder S; S.init(T, FF, G, bid);
          RS_TABLE(SSQP + (size_t)T * 16, (T / 256) * (FF / 256) / 256)
          pg8::EpiScale E{HM, FF, 1, (const PG8_LAS float*)(lds + 131072)};
          pg8::gemm_phase<pg8::EpiScale, pg8::StaticOrder, true, true>(lds, g, S, E);
#ifdef REPEAT_GEMM
          GRID_SYNC(); pg8::gemm_phase<pg8::EpiScale, pg8::StaticOrder, true, true>(lds, g, S, E);
#endif
        }
        GRID_SYNC();
        { pg8::Gemm g{HM, (const bf16_t*)(ws + WS_WDN) + (size_t)l * D * FF, T, D, FF, FF}; pg8::StaticOrder S; S.init(T, D, G, bid);
          pg8::EpiRes E{p.out, p.out, XB, !lastl ? SSQP : nullptr};
          pg8::gemm_phase<pg8::EpiRes, pg8::StaticOrder, true, true>(lds, g, S, E); }
        if (!lastl) GRID_SYNC();
    }
}

extern "C" void kernel_launch(void* const* d_in, const int* in_sizes, int n_in, void* d_out, int out_size, void* d_ws, size_t ws_size, hipStream_t stream) {
    static int grid = 0;
    if (grid == 0) {
        if (n_in != 26 || out_size != T * D || ws_size < WS_END) { fprintf(stderr, "kernel_launch: unexpected shapes (n_in %d, out %d, ws %zu); nothing launched\n", n_in, out_size, ws_size); grid = -1; return; }
        int dev = 0, cus = 0, per_cu = 0;
        (void)hipGetDevice(&dev); (void)hipDeviceGetAttribute(&cus, hipDeviceAttributeMultiprocessorCount, dev);
        if (hipFuncSetAttribute((const void*)hybrid_fwd, hipFuncAttributeMaxDynamicSharedMemorySize, LDS_BYTES) != hipSuccess) { fprintf(stderr, "kernel_launch: hipFuncSetAttribute failed\n"); grid = -1; return; }
        if (hipOccupancyMaxActiveBlocksPerMultiprocessor(&per_cu, (const void*)hybrid_fwd, 512, LDS_BYTES) != hipSuccess || per_cu < 1) { fprintf(stderr, "kernel_launch: occupancy query gave %d\n", per_cu); per_cu = 1; }
        (void)hipGetLastError();
        if (cus <= 0) cus = 256;
        grid = cus * per_cu;
    }
    if (grid < 0) return;
    if (hipMemsetAsync((char*)d_ws + WS_BAR, 0, XCD_BAR_WORDS * 4, stream) != hipSuccess) { fprintf(stderr, "kernel_launch: hipMemsetAsync of the barrier words failed\n"); return; }
    static int rs_ok = -1;
    if (rs_ok < 0) { rs_ok = (grid == 256) ? 1 : 0;
        const int ncol[2] = {DIN / 256, FF / 256};
        for (int ph = 0; ph < 2 && rs_ok; ++ph) { const int nun = (T / 256) * ncol[ph] / 256;
            for (int c = 0; c < grid && rs_ok; ++c) { pg8::StaticOrder S; S.init(T, ncol[ph] * 256, grid, c); pg8::Unit u0, u1, ui; if (!S.next(0, u0) || !S.next(nun - 1, u1) || S.next(nun, ui)) { rs_ok = 0; break; }
                if (((u0.pm >> 3) & 1) != 0 || ((u1.pm >> 3) & 1) != 1) { rs_ok = 0; break; }
                for (int i = 0; i < nun; ++i) { S.next(i, ui); if (ui.pm != (((ui.pm >> 3) & 1) ? u1.pm : u0.pm)) { rs_ok = 0; break; } } } } }
    Params a{};
    for (int i = 0; i < 26; ++i) a.in[i] = (const float*)d_in[i];
    if (!rs_ok) { fprintf(stderr, "kernel_launch: unit order does not keep a workgroup inside two row panels (grid %d); nothing launched\n", grid); return; }
    a.out = (float*)d_out; a.ws = (unsigned char*)d_ws; a.rs_lds = rs_ok; a.pad = 0;
    void* args[] = {&a};
    hipError_t e = hipLaunchCooperativeKernel((const void*)hybrid_fwd, dim3(grid), dim3(512), args, LDS_BYTES, stream);
    if (e != hipSuccess) fprintf(stderr, "cooperative launch failed: %s (grid %d)\n", hipGetErrorString(e), grid);
}
```

```cpp
#include <hip/hip_runtime.h>
#include <hip/hip_cooperative_groups.h>
#include <cstdio>
#include <cstdint>
namespace cg = cooperative_groups;

#define DI __device__ __forceinline__
#define LAS __attribute__((address_space(3)))
typedef unsigned short bf16_t;
typedef short bf16x8 __attribute__((ext_vector_type(8)));
typedef short s16x4 __attribute__((ext_vector_type(4)));
typedef float f32x4 __attribute__((ext_vector_type(4)));
typedef float f32x16 __attribute__((ext_vector_type(16)));
typedef unsigned u32x4 __attribute__((ext_vector_type(4)));
typedef unsigned u32x2 __attribute__((ext_vector_type(2)));

constexpr int NB = 4, SEQ = 8192, T = NB * SEQ, D = 1024, DIN = 2560, FF = 4096, NL = 4;
constexpr int ZQ = 0, ZF = 256, ZI = 512, ZG = 768, ZBV = 1024, ZBG = 1280, ZCU = 1536, ZDQ = 1792, ZDK = 2048, ZDV = 2304;
constexpr int YA = 0, YB = 256, YC = 512, YD = 768;
constexpr int ZOD = ZBG;
constexpr float EPS = 1e-6f;
constexpr size_t MiB = 1u << 20;
constexpr size_t WS_WIN = 0, WS_WOUT = 20 * MiB, WS_WUP = 28 * MiB, WS_WDN = 60 * MiB, WS_WGLU = 92 * MiB;
constexpr size_t WS_LB = 93 * MiB;
constexpr size_t WS_BIAS = WS_LB + 4096;
constexpr size_t WS_BAR = WS_LB + 32768;
constexpr size_t WS_SSQ = WS_LB + 65536;
constexpr size_t WS_LSE = WS_SSQ + 8 * (size_t)T * 4;
constexpr size_t WS_DEC = WS_LSE + (size_t)T * 16;
constexpr size_t WS_LSE1 = WS_DEC + 2048 * 64 * 4;
constexpr size_t WS_S5K = 96 * MiB;
constexpr size_t WS_S5WS = 98 * MiB;
constexpr size_t WS_S5WC = 114 * MiB;
constexpr size_t WS_XB = 130 * MiB;
constexpr size_t WS_S5H = 194 * MiB;
constexpr size_t WS_HM = 198 * MiB;
constexpr size_t WS_Z = 198 * MiB;
constexpr size_t WS_YCAT = 358 * MiB;
constexpr size_t WS_SL = 422 * MiB, WS_SL2 = 438 * MiB;
constexpr size_t WS_S5H2 = 454 * MiB;
constexpr size_t WS_O0 = 458 * MiB, WS_O1 = 474 * MiB;
constexpr size_t WS_YPRE = 490 * MiB;
constexpr size_t WS_SSQP = 506 * MiB;
constexpr size_t WS_END = 510 * MiB;
static_assert(WS_LSE1 + (size_t)T * 16 <= WS_S5K, "misc region");

constexpr int LDS_BYTES = 147456;

DI unsigned f2bf(float f) { unsigned u = __builtin_bit_cast(unsigned, f); return (u + 0x7fffu + ((u >> 16) & 1u)) >> 16; }
typedef float f32x2_t __attribute__((ext_vector_type(2))); typedef __bf16 bf16x2_t __attribute__((ext_vector_type(2)));
DI unsigned pk2(float lo, float hi) { const f32x2_t v = {lo, hi}; const bf16x2_t b = __builtin_convertvector(v, bf16x2_t); return __builtin_bit_cast(unsigned, b); }
DI float bf2f(bf16_t v) { return __builtin_bit_cast(float, (unsigned)v << 16); }
DI float bflo(unsigned w) { return __builtin_bit_cast(float, w << 16); }
DI float bfhi(unsigned w) { return __builtin_bit_cast(float, w & 0xffff0000u); }
DI float sigmoidf_(float x) { return 1.f / (1.f + __expf(-x)); }
DI float wave_sum(float v) {
#pragma unroll
    for (int o = 1; o < 64; o <<= 1) v += __shfl_xor(v, o);
    return v;
}
DI float half_sum(float v) {
#pragma unroll
    for (int o = 1; o < 32; o <<= 1) v += __shfl_xor(v, o);
    return v;
}
#define LDS_WAIT() asm volatile("s_waitcnt lgkmcnt(0)" ::: "memory")
DI int crow(int reg, int h) { return (reg & 3) + 8 * (reg >> 2) + 4 * h; }

template <int K>
DI f32x16 mma_lds(const LAS bf16_t* A, int lda, const LAS bf16_t* B, int ldb, f32x16 acc, int lane) {
    const int r = lane & 31, h = lane >> 5;
    const LAS bf16_t* ap = A + r * lda + 8 * h; const LAS bf16_t* bp = B + r * ldb + 8 * h;
#pragma unroll
    for (int k0 = 0; k0 < K; k0 += 16) {
        const bf16x8 a = *(const LAS bf16x8*)(ap + k0); const bf16x8 b = *(const LAS bf16x8*)(bp + k0);
        acc = __builtin_amdgcn_mfma_f32_32x32x16_bf16(a, b, acc, 0, 0, 0);
    }
    return acc;
}
DI f32x16 zero16() { f32x16 z;
#pragma unroll
    for (int i = 0; i < 16; ++i) z[i] = 0.f;
    return z; }

namespace pg8 {
#define PG8_LAS __attribute__((address_space(3)))
constexpr int BM = 256, BK = 64, HALF = 128, HTB = HALF * BK * 2, STAGE_BYTES = 8 * HTB, NXCD = 8, WGM = 8;
__host__ __device__ __forceinline__ int lds_byte(int r, int c) { const int st = (r >> 4) * 2 + (c >> 5), rr = r & 15, cc = c & 31, ob = rr * 64 + cc * 2; return st * 1024 + (ob ^ (((ob >> 9) & 1) << 5)); }
__host__ __device__ __forceinline__ void stage_rc(int b, int& R, int& C) { const int st = b / 1024, sb = b % 1024, swz = sb ^ (((sb >> 9) & 1) << 5); R = (st >> 1) * 16 + swz / 64; C = (st & 1) * 32 + (swz % 64) / 2; }
__host__ __device__ __forceinline__ int perm32(int rho) { const int n = rho >> 4, i = rho & 15; return 8 * (i >> 2) + 4 * n + (i & 3); }
struct Unit { int pm, pn; };
struct Gemm { const bf16_t* A; const bf16_t* Bt; int M, N, K, lda; };
struct StaticOrder {
    int nM, nN, nwg, G, c;
    __host__ __device__ __forceinline__ void init(int M, int N, int G_, int c_) { nM = M / BM; nN = N / BM; nwg = nM * nN; G = G_; c = c_; }
    __host__ __device__ __forceinline__ bool next(int i, Unit& u) const {
        const long L = (long)i * G + c; if (L >= nwg) return false;
        int wgid = (int)L; { const int q = nwg / NXCD, r = nwg % NXCD, xcd = wgid % NXCD, off = wgid / NXCD; wgid = (xcd < r ? xcd * (q + 1) : r * (q + 1) + (xcd - r) * q) + off; }
        const int nig = WGM * nN, gid = wgid / nig, fm = gid * WGM, gsz = (nM - fm) < WGM ? (nM - fm) : WGM;
        u.pm = fm + ((wgid % nig) % gsz); u.pn = (wgid % nig) / gsz; return true;
    }
    __device__ __forceinline__ void a_ready(const Unit&) const {}
    __device__ __forceinline__ void done(const Unit&) const {}
};
struct EpiScale {
    static constexpr bool PERM = true, AFTER_DRAIN = false;
    bf16_t* O; int ldc; int act; const PG8_LAS float* rsl;
    __device__ __forceinline__ void operator()(const f32x4 (&acc)[2][2][4][2], const Unit& u, int wr, int wc, int fr, int fq) const {
        const int row0 = u.pm * BM + wr * 64 + fr; const int col0 = u.pn * BM + wc * 32 + 8 * fq;
        const int slot = ((u.pm >> 3) & 1) * 256;
#pragma unroll
        for (int ai = 0; ai < 2; ++ai)
#pragma unroll
            for (int m = 0; m < 4; ++m) { const int r = row0 + ai * HALF + m * 16; float rs;
                rs = rsl[slot + ai * HALF + wr * 64 + m * 16 + fr];
                bf16_t* rowp = O + (size_t)r * ldc + col0;
#pragma unroll
                for (int bj = 0; bj < 2; ++bj) { f32x4 v0 = acc[ai][bj][m][0] * rs, v1 = acc[ai][bj][m][1] * rs;
                    if (act) {
#pragma unroll
                        for (int e = 0; e < 4; ++e) { const float a = fmaxf(v0[e], 0.f), b = fmaxf(v1[e], 0.f); v0[e] = a * a; v1[e] = b * b; } }
                    u32x4 w; w.x = pk2(v0[0], v0[1]); w.y = pk2(v0[2], v0[3]); w.z = pk2(v1[0], v1[1]); w.w = pk2(v1[2], v1[3]);
                    *(u32x4*)(rowp + bj * HALF) = w; } }
    }
};
struct EpiRes {
    static constexpr bool PERM = false, AFTER_DRAIN = false;
    const float* base; float* out; bf16_t* xb; float* ssq_out;
    __device__ __forceinline__ void operator()(const f32x4 (&acc)[2][2][4][2], const Unit& u, int wr, int wc, int fr, int fq) const {
        const int col0 = u.pn * BM + wc * 32 + 4 * fq;
#pragma unroll
        for (int ai = 0; ai < 2; ++ai)
#pragma unroll
            for (int m = 0; m < 4; ++m) { const int r = u.pm * BM + ai * HALF + wr * 64 + m * 16 + fr; const size_t off = (size_t)r * D + col0; float s = 0.f;
#pragma unroll
                for (int bj = 0; bj < 2; ++bj)
#pragma unroll
                    for (int n = 0; n < 2; ++n) { const size_t o2 = off + bj * HALF + n * 16; const f32x4 o = *(const f32x4*)(base + o2) + acc[ai][bj][m][n];
                        *(f32x4*)(out + o2) = o; u32x2 w; w.x = pk2(o[0], o[1]); w.y = pk2(o[2], o[3]); *(u32x2*)(xb + o2) = w;
                        s += (o[0] * o[0] + o[1] * o[1]) + (o[2] * o[2] + o[3] * o[3]); }
                s += __shfl_xor(s, 16); s += __shfl_xor(s, 32);
                if (fq == 0 && ssq_out) ssq_out[(size_t)r * 16 + u.pn * 4 + wc] = s; }
    }
};
struct EpiGlu {
    static constexpr bool PERM = false, AFTER_DRAIN = true;
    const bf16_t* Ysrc; int lds_; bf16_t* Y;
    __device__ __forceinline__ void fused(f32x4 (&acc)[2][2][4][2], const Unit& u, int wr, int wc, int fr, int fq, PG8_LAS unsigned char* lds, int wid, int lane) const {
        PG8_LAS float* Pp = (PG8_LAS float*)lds;
        const int col0 = wc * 32 + 4 * fq;
#pragma unroll
        for (int ai = 0; ai < 2; ++ai)
#pragma unroll
            for (int m = 0; m < 4; ++m) { const int rl = ai * HALF + wr * 64 + m * 16 + fr; const size_t off = (size_t)(u.pm * BM + rl) * lds_ + col0; float s = 0.f;
#pragma unroll
                for (int bj = 0; bj < 2; ++bj)
#pragma unroll
                    for (int n = 0; n < 2; ++n) { const u32x2 w = *(const u32x2*)(Ysrc + off + bj * HALF + n * 16); f32x4 a = acc[ai][bj][m][n];
                        const float y0 = bflo(w.x), y1 = bfhi(w.x), y2 = bflo(w.y), y3 = bfhi(w.y);
                        a[0] = y0 * sigmoidf_(a[0]); a[1] = y1 * sigmoidf_(a[1]); a[2] = y2 * sigmoidf_(a[2]); a[3] = y3 * sigmoidf_(a[3]);
                        acc[ai][bj][m][n] = a; s += (a[0] * a[0] + a[1] * a[1]) + (a[2] * a[2] + a[3] * a[3]); }
                s += __shfl_xor(s, 16); s += __shfl_xor(s, 32);
                if (fq == 0) Pp[rl * 4 + wc] = s; }
        __syncthreads();
#pragma unroll
        for (int ai = 0; ai < 2; ++ai)
#pragma unroll
            for (int m = 0; m < 4; ++m) { const int rl = ai * HALF + wr * 64 + m * 16 + fr; const size_t off = (size_t)(u.pm * BM + rl) * D + col0;
                const float tot = (Pp[rl * 4 + 0] + Pp[rl * 4 + 1]) + (Pp[rl * 4 + 2] + Pp[rl * 4 + 3]); const float rs = rsqrtf(tot * (1.0f / 256.0f) + EPS);
#pragma unroll
                for (int bj = 0; bj < 2; ++bj)
#pragma unroll
                    for (int n = 0; n < 2; ++n) { const f32x4 a = acc[ai][bj][m][n] * rs; u32x2 w; w.x = pk2(a[0], a[1]); w.y = pk2(a[2], a[3]); *(u32x2*)(Y + off + bj * HALF + n * 16) = w; } }
    }
};

template <class Epi, class Sched, bool ALIGN_EPI = false, bool SP2 = false>
__device__ __forceinline__ void gemm_phase(PG8_LAS unsigned char* lds, const Gemm g, const Sched& S, const Epi& E) {
    int tid_o = threadIdx.x; asm volatile("" : "+v"(tid_o));
    const int tid = tid_o, wid = __builtin_amdgcn_readfirstlane(tid >> 6), lane = tid & 63, wr = wid >> 2, wc = wid & 3, fr = lane & 15, fq = lane >> 4;
    const int K = g.K, nt = K / BK;
    unsigned voffA[2], voffB[2];
#pragma unroll
    for (int i = 0; i < 2; ++i) { int R, C; stage_rc(tid * 16 + i * 8192, R, C); const int Rb = Epi::PERM ? ((R & ~31) + perm32(R & 31)) : R;
        voffA[i] = (unsigned)(R * g.lda + C) * 2u; voffB[i] = (unsigned)(Rb * K + C) * 2u; }
    const size_t kstep = (size_t)(BK * 2);
    const size_t hstepA = (size_t)HALF * g.lda * 2, hstepB = (size_t)HALF * K * 2;
    const size_t tstepA = 2 * hstepA, tstepB = 2 * hstepB;
    const unsigned ldsw = (unsigned)wid * 1024u;
    const int aoff = lds_byte(wr * 64 + fr, fq * 8), boff = lds_byte(wc * 32 + fr, fq * 8);
#define PG8_SA(b, h) (((b) * 2 + (h)) * HTB)
#define PG8_SB(b, h) ((4 + (b) * 2 + (h)) * HTB)
#define PG8_STAGE(bufoff, gbase, voff) do { _Pragma("unroll") for (int _i = 0; _i < 2; ++_i) \
        __builtin_amdgcn_global_load_lds((const unsigned*)((const char*)(gbase) + (voff)[_i]), (PG8_LAS unsigned*)(lds + (bufoff) + ldsw + _i * 8192), 16, 0, 0); } while (0)
#define PG8_LDA(dst, b, h) do { _Pragma("unroll") for (int m = 0; m < 4; ++m) _Pragma("unroll") for (int k = 0; k < 2; ++k) dst[m][k] = *(const PG8_LAS bf16x8*)(lds + PG8_SA(b, h) + aoff + m * 2048 + k * 1024); } while (0)
#define PG8_LDB(dst, b, h) do { _Pragma("unroll") for (int n = 0; n < 2; ++n) _Pragma("unroll") for (int k = 0; k < 2; ++k) dst[n][k] = *(const PG8_LAS bf16x8*)(lds + PG8_SB(b, h) + boff + n * 2048 + k * 1024); } while (0)
#define PG8_MMA(ai, bj, At, Bt) do { __builtin_amdgcn_s_setprio(1); _Pragma("unroll") for (int m = 0; m < 4; ++m) _Pragma("unroll") for (int n = 0; n < 2; ++n) _Pragma("unroll") for (int k = 0; k < 2; ++k) \
        acc[ai][bj][m][n] = __builtin_amdgcn_mfma_f32_16x16x32_bf16(Bt[n][k], At[m][k], acc[ai][bj][m][n], 0, 0, 0); __builtin_amdgcn_s_setprio(0); } while (0)
#define PG8_WAIT_V(n) asm volatile("s_waitcnt vmcnt(" #n ")" ::: "memory")
#define PG8_WAIT_L(n) asm volatile("s_waitcnt lgkmcnt(" #n ")" ::: "memory")
#define PG8_BAR __builtin_amdgcn_s_barrier()
#define PG8_SCHED __builtin_amdgcn_sched_barrier(0)
    Unit cur, nxt; int ui = 0;
    if (!S.next(0, cur)) return;
    f32x4 acc[2][2][4][2];
#pragma unroll
    for (int a = 0; a < 2; ++a)
#pragma unroll
        for (int b = 0; b < 2; ++b)
#pragma unroll
            for (int m = 0; m < 4; ++m)
#pragma unroll
                for (int n = 0; n < 2; ++n) acc[a][b][m][n] = (f32x4){0.f, 0.f, 0.f, 0.f};
    bf16x8 At[4][2], B0[2][2], B1[2][2];
    const char* cA = (const char*)g.A + (size_t)cur.pm * tstepA; const char* cB = (const char*)g.Bt + (size_t)cur.pn * tstepB;
    S.a_ready(cur);
    if constexpr (SP2) {
        PG8_STAGE(PG8_SB(0, 0), cB, voffB); PG8_STAGE(PG8_SB(0, 1), cB + hstepB, voffB); PG8_STAGE(PG8_SA(0, 0), cA, voffA); PG8_STAGE(PG8_SA(0, 1), cA + hstepA, voffA);
        if (wr == 1) PG8_BAR;
        PG8_WAIT_V(2); PG8_BAR;
        PG8_STAGE(PG8_SB(1, 0), cB + kstep, voffB); PG8_STAGE(PG8_SA(1, 0), cA + kstep, voffA); PG8_STAGE(PG8_SB(1, 1), cB + hstepB + kstep, voffB);
        PG8_WAIT_V(6); PG8_BAR;
    } else {
        PG8_STAGE(PG8_SB(0, 0), cB, voffB); PG8_STAGE(PG8_SA(0, 0), cA, voffA); PG8_STAGE(PG8_SB(0, 1), cB + hstepB, voffB); PG8_STAGE(PG8_SA(0, 1), cA + hstepA, voffA);
        if (wr == 1) PG8_BAR;
        PG8_WAIT_V(4); PG8_BAR;
        PG8_STAGE(PG8_SB(1, 0), cB + kstep, voffB); PG8_STAGE(PG8_SA(1, 0), cA + kstep, voffA); PG8_STAGE(PG8_SB(1, 1), cB + hstepB + kstep, voffB);
        PG8_WAIT_V(6); PG8_BAR;
    }
    for (;;) {
        const bool has_next = S.next(ui + 1, nxt);
        const char* nA = has_next ? (const char*)g.A + (size_t)nxt.pm * tstepA : cA; const char* nB = has_next ? (const char*)g.Bt + (size_t)nxt.pn * tstepB : cB;
        for (int t = 0; t < nt; t += 2) {
            const bool last = (t == nt - 2);
            const char* a1 = cA + (size_t)(t + 1) * kstep;
            const char* a2 = last ? nA : cA + (size_t)(t + 2) * kstep; const char* b2 = last ? nB : cB + (size_t)(t + 2) * kstep;
            const char* a3 = a2 + kstep; const char* b3 = b2 + kstep;
            if (last && has_next) S.a_ready(nxt);
            if constexpr (SP2) {
            PG8_LDB(B0, 0, 0); PG8_LDB(B1, 0, 1); PG8_SCHED; PG8_LDA(At, 0, 0); PG8_STAGE(PG8_SA(1, 1), a1 + hstepA, voffA);
            PG8_WAIT_V(8); PG8_WAIT_L(0); PG8_BAR; PG8_MMA(0, 0, At, B0); PG8_MMA(0, 1, At, B1); PG8_BAR; PG8_SCHED;
            PG8_LDA(At, 0, 1); PG8_STAGE(PG8_SB(0, 0), b2, voffB); PG8_STAGE(PG8_SB(0, 1), b2 + hstepB, voffB); PG8_STAGE(PG8_SA(0, 0), a2, voffA);
            PG8_WAIT_V(8); PG8_WAIT_L(0); PG8_BAR; PG8_MMA(1, 0, At, B0); PG8_MMA(1, 1, At, B1); PG8_BAR; PG8_SCHED;
            PG8_LDB(B0, 1, 0); PG8_LDB(B1, 1, 1); PG8_SCHED; PG8_LDA(At, 1, 0); PG8_STAGE(PG8_SA(0, 1), a2 + hstepA, voffA);
            PG8_WAIT_V(8); PG8_WAIT_L(0); PG8_BAR; PG8_MMA(0, 0, At, B0); PG8_MMA(0, 1, At, B1); PG8_BAR; PG8_SCHED;
            PG8_LDA(At, 1, 1); PG8_STAGE(PG8_SB(1, 0), b3, voffB); PG8_STAGE(PG8_SB(1, 1), b3 + hstepB, voffB); PG8_STAGE(PG8_SA(1, 0), a3, voffA);
            PG8_WAIT_V(8); PG8_WAIT_L(0); PG8_BAR; PG8_MMA(1, 0, At, B0); PG8_MMA(1, 1, At, B1); PG8_BAR; PG8_SCHED;
            } else {
            PG8_LDB(B0, 0, 0); PG8_SCHED; PG8_LDA(At, 0, 0); PG8_STAGE(PG8_SA(1, 1), a1 + hstepA, voffA);
            PG8_WAIT_L(8); PG8_BAR; PG8_WAIT_L(0); PG8_MMA(0, 0, At, B0); PG8_BAR; PG8_SCHED;
            PG8_LDB(B1, 0, 1); PG8_STAGE(PG8_SB(0, 0), b2, voffB);
            PG8_BAR; PG8_WAIT_L(0); PG8_MMA(0, 1, At, B1); PG8_BAR;
            PG8_LDA(At, 0, 1); PG8_STAGE(PG8_SA(0, 0), a2, voffA);
            PG8_BAR; PG8_WAIT_L(0); PG8_MMA(1, 0, At, B0); PG8_BAR; PG8_SCHED;
            PG8_STAGE(PG8_SB(0, 1), b2 + hstepB, voffB);
            PG8_WAIT_V(6); PG8_BAR; PG8_MMA(1, 1, At, B1); PG8_BAR;
            PG8_LDB(B0, 1, 0); PG8_SCHED; PG8_LDA(At, 1, 0); PG8_STAGE(PG8_SA(0, 1), a2 + hstepA, voffA);
            PG8_WAIT_L(8); PG8_BAR; PG8_WAIT_L(0); PG8_MMA(0, 0, At, B0); PG8_BAR; PG8_SCHED;
            PG8_LDB(B1, 1, 1); PG8_STAGE(PG8_SB(1, 0), b3, voffB);
            PG8_BAR; PG8_WAIT_L(0); PG8_MMA(0, 1, At, B1); PG8_BAR;
            PG8_LDA(At, 1, 1); PG8_STAGE(PG8_SA(1, 0), a3, voffA);
            PG8_BAR; PG8_WAIT_L(0); PG8_MMA(1, 0, At, B0); PG8_BAR; PG8_SCHED;
            PG8_STAGE(PG8_SB(1, 1), b3 + hstepB, voffB);
            PG8_WAIT_V(6); PG8_BAR; PG8_MMA(1, 1, At, B1); PG8_BAR;
            }
        }
        if constexpr (ALIGN_EPI) { if (wr == 0) PG8_BAR; }
        if constexpr (!Epi::AFTER_DRAIN) { E(acc, cur, wr, wc, fr, fq); S.done(cur); }
        if (!has_next) break;
#pragma unroll
        for (int a = 0; a < 2; ++a)
#pragma unroll
            for (int b = 0; b < 2; ++b)
#pragma unroll
                for (int m = 0; m < 4; ++m)
#pragma unroll
                    for (int n = 0; n < 2; ++n) acc[a][b][m][n] = (f32x4){0.f, 0.f, 0.f, 0.f};
        cur = nxt; cA = nA; cB = nB; ++ui;
        if constexpr (ALIGN_EPI) { if (wr == 1) PG8_BAR; }
    }
    PG8_WAIT_V(0);
    if constexpr (!ALIGN_EPI) { if (wr == 0) PG8_BAR; }
    PG8_BAR;
    if constexpr (Epi::AFTER_DRAIN) { E.fused(acc, cur, wr, wc, fr, fq, lds, wid, lane); S.done(cur); }
#undef PG8_SA
#undef PG8_SB
#undef PG8_STAGE
#undef PG8_LDA
#undef PG8_LDB
#undef PG8_MMA
#undef PG8_WAIT_V
#undef PG8_WAIT_L
#undef PG8_BAR
#undef PG8_SCHED
}
}

struct Params { const float* in[26]; float* out; unsigned char* ws; int rs_lds; int pad; };
enum { I_X = 0, I_NMG, I_WIN, I_LBL, I_HNG, I_CW, I_CB, I_CLG, I_CLB, I_LRE, I_LIM, I_BRE, I_BIM, I_CRE, I_CIM, I_S5D, I_LDT, I_WGLU, I_QG, I_KG, I_RB, I_MONG, I_WOUT, I_NMLPG, I_WUP, I_WDN };

DI void p0_transpose_item(const float* W, int K, int N, bf16_t* WT, const float* gk, LAS float* scr, int item, int lane) {
    const int nblk = N / 32, kb = item / nblk, nb = item % nblk, k0 = 64 * kb, n0 = 32 * nb;
#pragma unroll 8
    for (int i = 0; i < 32; ++i) { const int kk = 2 * i + (lane >> 5); const float s = gk ? gk[k0 + kk] : 1.f; scr[kk * 33 + (lane & 31)] = W[(size_t)(k0 + kk) * N + n0 + (lane & 31)] * s; }
    LDS_WAIT();
    const int c = lane & 7;
#pragma unroll
    for (int j = 0; j < 4; ++j) { const int n = (lane >> 3) + 8 * j; const LAS float* s = scr + (8 * c) * 33 + n;
        u32x4 o; o.x = pk2(s[0 * 33], s[1 * 33]); o.y = pk2(s[2 * 33], s[3 * 33]); o.z = pk2(s[4 * 33], s[5 * 33]); o.w = pk2(s[6 * 33], s[7 * 33]);
        *(u32x4*)(WT + (size_t)(n0 + n) * K + k0 + 8 * c) = o; }
    LDS_WAIT();
}
DI void s5_params(const Params& p, int lg, int pp, float& lrdt, float& lidt, float& cr, float& ci) {
    const float dt = expf(p.in[I_LDT][lg]);
    const float lr = p.in[I_LRE][lg * 64 + pp], li = p.in[I_LIM][lg * 64 + pp];
    lrdt = lr * dt; lidt = li * dt;
    const float mag = expf(lrdt); const float ar = mag * cosf(lidt), ai = mag * sinf(lidt);
    const float den = lr * lr + li * li;
    cr = ((ar - 1.0f) * lr + ai * li) / den; ci = (ai * lr - (ar - 1.0f) * li) / den;
}
DI void s5_pow(float lrdt, float lidt, int n, float& er, float& ei) { const float m = expf((float)n * lrdt); const float a = (float)n * lidt; er = m * cosf(a); ei = m * sinf(a); }

DI void prologue(const Params& p, LAS unsigned char* lds, int G) {
    int tid_o = threadIdx.x; asm volatile("" : "+v"(tid_o));
    const int tid = tid_o, lane = tid & 63, wave = tid >> 6;
    const int gw = blockIdx.x * 8 + wave, NGW = G * 8;
    const int gt = blockIdx.x * 512 + tid, NGT = G * 512;
    unsigned char* ws = p.ws;
    LAS float* scr = (LAS float*)(lds + wave * 16384);
    {
        constexpr int I_IN = (D / 64) * (DIN / 32), I_OUT = (D / 64) * (D / 32), I_UP = (D / 64) * (FF / 32), I_DN = (FF / 64) * (D / 32), I_GL = (256 / 64) * (256 / 32);
        constexpr int PER_L = I_IN + I_OUT + I_UP + I_DN + I_GL;
        for (int it = gw; it < NL * PER_L; it += NGW) {
            const int l = it / PER_L; int r = it % PER_L;
            if (r < I_IN) { p0_transpose_item(p.in[I_WIN] + (size_t)l * D * DIN, D, DIN, (bf16_t*)(ws + WS_WIN) + (size_t)l * D * DIN, p.in[I_NMG] + l * D, scr, r, lane); continue; } r -= I_IN;
            if (r < I_OUT) { p0_transpose_item(p.in[I_WOUT] + (size_t)l * D * D, D, D, (bf16_t*)(ws + WS_WOUT) + (size_t)l * D * D, p.in[I_MONG] + l * D, scr, r, lane); continue; } r -= I_OUT;
            if (r < I_UP) { p0_transpose_item(p.in[I_WUP] + (size_t)l * D * FF, D, FF, (bf16_t*)(ws + WS_WUP) + (size_t)l * D * FF, p.in[I_NMLPG] + l * D, scr, r, lane); continue; } r -= I_UP;
            if (r < I_DN) { p0_transpose_item(p.in[I_WDN] + (size_t)l * D * FF, FF, D, (bf16_t*)(ws + WS_WDN) + (size_t)l * D * FF, nullptr, scr, r, lane); continue; } r -= I_DN;
            p0_transpose_item(p.in[I_WGLU] + (size_t)l * 65536, 256, 256, (bf16_t*)(ws + WS_WGLU) + (size_t)l * 65536, nullptr, scr, r, lane);
        }
    }
    {
        float* ssq0 = (float*)(ws + WS_SSQP); bf16_t* XB = (bf16_t*)(ws + WS_XB);
        for (int mb = gw * 16; mb < T; mb += NGW * 16) {
            float keep = 0.f;
#pragma unroll 4
            for (int i = 0; i < 16; ++i) { const int m = mb + i;
                const f32x4* xr = (const f32x4*)(p.in[I_X] + (size_t)m * D) + lane; f32x4 v[4]; float s = 0.f;
#pragma unroll
                for (int j = 0; j < 4; ++j) { v[j] = xr[64 * j]; s += (v[j][0] * v[j][0] + v[j][1] * v[j][1]) + (v[j][2] * v[j][2] + v[j][3] * v[j][3]); }
                s = wave_sum(s); if (lane == i) keep = s;
                u32x2* o8 = (u32x2*)(XB + (size_t)m * D) + lane;
#pragma unroll
                for (int j = 0; j < 4; ++j) { u32x2 w; w.x = pk2(v[j][0], v[j][1]); w.y = pk2(v[j][2], v[j][3]); o8[64 * j] = w; } }
#pragma unroll 1
            for (int i = 0; i < 16; ++i) { const float v = __shfl(keep, i); if (lane < 16) ssq0[(size_t)(mb + i) * 16 + lane] = lane == 0 ? v : 0.f; }
        }
    }
    {
        float* LB = (float*)(ws + WS_LB);
        for (int c = gt; c < 256; c += NGT) {
            const float a0 = p.in[I_LBL][c], a1 = p.in[I_LBL][256 + c], a2 = p.in[I_LBL][512 + c], a3 = p.in[I_LBL][768 + c];
            const float mx = fmaxf(fmaxf(a0, a1), fmaxf(a2, a3));
            const float e0 = expf(a0 - mx), e1 = expf(a1 - mx), e2 = expf(a2 - mx), e3 = expf(a3 - mx); const float inv = 1.f / (e0 + e1 + e2 + e3);
            const float s1 = e1 * inv, s2 = e2 * inv, s3 = e3 * inv; const float hi = 1.0f - 1e-6f;
            LB[c] = 0.f; LB[256 + c] = fminf(fmaxf(s1, 0.f), hi); LB[512 + c] = fminf(fmaxf(s1 + s2, 0.f), hi); LB[768 + c] = fminf(fmaxf(s1 + s2 + s3, 0.f), hi);
        }
        float* BT = (float*)(ws + WS_BIAS);
        for (int i = gt; i < 3 * 4 * 132; i += NGT) {
            const int pt = i / (4 * 132), hd = (i / 132) % 4, dl = i % 132; const int dil = pt == 0 ? 1 : (pt == 1 ? 4 : 16);
            float v = 0.f;
            if (dl <= 128) { const int dist = dl * dil; int bk;
                if (dist < 16) bk = dist; else { bk = 16 + (int)(logf((float)dist / 16.0f) / 4.852030263919617f * 16.0f); if (bk > 31) bk = 31; }
                v = p.in[I_RB][bk * 4 + hd]; }
            BT[i] = v;
        }
    }
    {
        bf16_t* KT = (bf16_t*)(ws + WS_S5K); bf16_t* WS_ = (bf16_t*)(ws + WS_S5WS); bf16_t* WC = (bf16_t*)(ws + WS_S5WC);
        LAS float* ebr = scr; LAS float* ebi = scr + 64 * 17;
        for (int it = gw; it < NL * 16 * 64; it += NGW) {
            const int lg = it >> 6, d = it & 63;
            float lrdt, lidt, cr, ci; s5_params(p, lg, lane, lrdt, lidt, cr, ci);
            float er, ei; s5_pow(lrdt, lidt, d, er, ei);
            const float fr_ = er * cr - ei * ci, fi_ = er * ci + ei * cr;
            const float* br = p.in[I_BRE] + ((size_t)lg * 64 + lane) * 16; const float* bi = p.in[I_BIM] + ((size_t)lg * 64 + lane) * 16;
#pragma unroll
            for (int c = 0; c < 16; ++c) { const float b0 = br[c], b1 = bi[c]; ebr[lane * 17 + c] = fr_ * b0 - fi_ * b1; ebi[lane * 17 + c] = fr_ * b1 + fi_ * b0; }
            LDS_WAIT();
            const int co = lane & 15, cb = (lane >> 4) * 4;
            const float* crp = p.in[I_CRE] + ((size_t)lg * 16 + co) * 64; const float* cip = p.in[I_CIM] + ((size_t)lg * 16 + co) * 64;
            float a0 = 0.f, a1 = 0.f, a2 = 0.f, a3 = 0.f;
            for (int q = 0; q < 64; ++q) { const float c0 = crp[q], c1 = cip[q];
                a0 += c0 * ebr[q * 17 + cb + 0] - c1 * ebi[q * 17 + cb + 0]; a1 += c0 * ebr[q * 17 + cb + 1] - c1 * ebi[q * 17 + cb + 1];
                a2 += c0 * ebr[q * 17 + cb + 2] - c1 * ebi[q * 17 + cb + 2]; a3 += c0 * ebr[q * 17 + cb + 3] - c1 * ebi[q * 17 + cb + 3]; }
            u32x2 w; w.x = pk2(a0, a1); w.y = pk2(a2, a3);
            *(u32x2*)(KT + ((size_t)it * 16 + co) * 16 + cb) = w;
            LDS_WAIT();
        }
        for (int it = gw; it < NL * 16 * 16; it += NGW) {
            const int lg = it >> 4, s4 = it & 15;
            float lrdt, lidt, cr, ci; s5_params(p, lg, lane, lrdt, lidt, cr, ci);
            const float* br = p.in[I_BRE] + ((size_t)lg * 64 + lane) * 16; const float* bi = p.in[I_BIM] + ((size_t)lg * 64 + lane) * 16;
            float b0[16], b1[16];
#pragma unroll
            for (int c = 0; c < 16; ++c) { b0[c] = br[c]; b1[c] = bi[c]; }
#pragma unroll 1
            for (int sq = 0; sq < 4; ++sq) { const int s = s4 * 4 + sq;
                float er, ei; s5_pow(lrdt, lidt, 63 - s, er, ei);
                const float fr_ = er * cr - ei * ci, fi_ = er * ci + ei * cr;
                float vr[16], vi[16];
#pragma unroll
                for (int c = 0; c < 16; ++c) { vr[c] = fr_ * b0[c] - fi_ * b1[c]; vi[c] = fr_ * b1[c] + fi_ * b0[c]; }
                bf16_t* o0 = WS_ + (((size_t)lg * 64 + s) * 128 + lane) * 16; bf16_t* o1 = WS_ + (((size_t)lg * 64 + s) * 128 + 64 + lane) * 16;
                u32x4 w;
                w.x = pk2(vr[0], vr[1]); w.y = pk2(vr[2], vr[3]); w.z = pk2(vr[4], vr[5]); w.w = pk2(vr[6], vr[7]); *(u32x4*)o0 = w;
                w.x = pk2(vr[8], vr[9]); w.y = pk2(vr[10], vr[11]); w.z = pk2(vr[12], vr[13]); w.w = pk2(vr[14], vr[15]); *(u32x4*)(o0 + 8) = w;
                w.x = pk2(vi[0], vi[1]); w.y = pk2(vi[2], vi[3]); w.z = pk2(vi[4], vi[5]); w.w = pk2(vi[6], vi[7]); *(u32x4*)o1 = w;
                w.x = pk2(vi[8], vi[9]); w.y = pk2(vi[10], vi[11]); w.z = pk2(vi[12], vi[13]); w.w = pk2(vi[14], vi[15]); *(u32x4*)(o1 + 8) = w; }
        }
        for (int it = gw; it < NL * 16 * 64; it += NGW) {
            const int lg = it >> 6, tl = it & 63;
            float lrdt, lidt, cr, ci; s5_params(p, lg, lane, lrdt, lidt, cr, ci);
            float er, ei; s5_pow(lrdt, lidt, tl + 1, er, ei);
#pragma unroll 4
            for (int co = 0; co < 16; ++co) { const float c0 = p.in[I_CRE][((size_t)lg * 16 + co) * 64 + lane], c1 = p.in[I_CIM][((size_t)lg * 16 + co) * 64 + lane];
                bf16_t* o = WC + (((size_t)lg * 64 + tl) * 16 + co) * 128;
                o[lane] = (bf16_t)f2bf(c0 * er - c1 * ei); o[64 + lane] = (bf16_t)f2bf(-(c0 * ei + c1 * er)); }
        }
    }
}

template <bool OUT>
DI void hgrn_item(const Params& p, LAS unsigned char* lds, int l, int cg) {
    int tid_o = threadIdx.x; asm volatile("" : "+v"(tid_o));
    const int tid = tid_o, lane = tid & 63, wave = tid >> 6, hd = wave >> 1, half = wave & 1;
    const bf16_t* Z = (const bf16_t*)(p.ws + WS_Z);
    LAS bf16_t* B0 = (LAS bf16_t*)(lds + hd * 27648); LAS bf16_t* B1 = B0 + 64 * 72; LAS bf16_t* B2 = B1 + 64 * 72;
    LAS float* GM = (LAS float*)(lds + 114688) + hd * 64; LAS float* GL = GM + 256; LAS float* SSA = (LAS float*)(lds + 114688) + 512;
    bf16_t* SL = (bf16_t*)(p.ws + WS_SL); const bf16_t* SL2 = (const bf16_t*)(p.ws + WS_SL2); float* DEC = (float*)(p.ws + WS_DEC);
    const int item = cg * 4 + hd;
#ifdef FORCE_LB0
    const float lb = 0.f, oml = 1.f;
#else
    const float lb = ((const float*)(p.ws + WS_LB))[l * 256 + hd * 64 + lane], oml = 1.f - lb;
#endif
    const int srow = tid >> 5, shd = (tid >> 3) & 3, spc = tid & 7;
    const bf16_t* zsrc = Z + (size_t)(cg * 64 + srow) * DIN + shd * 64 + spc * 8;
    const int sdst = shd * 27648 + (srow * 72 + spc * 8) * 2;
    __syncthreads();
    { u32x4 wf[4], wi[4], wq[4];
#pragma unroll
      for (int sub = 0; sub < 4; ++sub) { wf[sub] = *(const u32x4*)(zsrc + (size_t)(16 * sub) * DIN + ZF); wi[sub] = *(const u32x4*)(zsrc + (size_t)(16 * sub) * DIN + ZI);
          if (OUT) wq[sub] = *(const u32x4*)(zsrc + (size_t)(16 * sub) * DIN + ZQ); }
#pragma unroll
      for (int sub = 0; sub < 4; ++sub) { *(LAS u32x4*)(lds + sdst + 9216 + sub * 16 * 144) = wf[sub]; *(LAS u32x4*)(lds + sdst + 18432 + sub * 16 * 144) = wi[sub];
          if (OUT) *(LAS u32x4*)(lds + sdst + sub * 16 * 144) = wq[sub]; } }
    __syncthreads();
    float g[32]; float run = 0.f;
#pragma unroll
    for (int j = 0; j < 32; ++j) { const float fz = bf2f(B1[(half * 32 + j) * 72 + lane]); const float sg = sigmoidf_(fz); const float f = lb + oml * sg;
        run += __logf(fmaxf(f, 1e-30f)); g[j] = run; }
    if (half == 0) GM[lane] = run;
    __syncthreads();
    const float gm = GM[lane];
    if (half) {
#pragma unroll
        for (int j = 0; j < 32; ++j) g[j] += gm; }
    const int c0 = lane & 31, h = lane >> 5;
    if constexpr (!OUT) {
        if (half) GL[lane] = run + gm;
        __syncthreads();
        const float gl = GL[lane];
        bf16_t kv[32], ivr[32];
#pragma unroll
        for (int j = 0; j < 32; ++j) { const int t = half * 32 + j; const float e = __expf(gl - g[j]); const float kj = oml * (1.f - sigmoidf_(bf2f(B1[t * 72 + lane])));
            kv[j] = (bf16_t)f2bf(kj * e); ivr[j] = B2[t * 72 + lane]; }
        __syncthreads();
#pragma unroll
        for (int j = 0; j < 32; ++j) { const int t = half * 32 + j; B1[lane * 72 + t] = kv[j]; B2[lane * 72 + t] = ivr[j]; }
        __syncthreads();
#pragma unroll
        for (int kt = 0; kt < 2; ++kt) { const f32x16 a = mma_lds<64>(B2 + 32 * half * 72, 72, B1 + 32 * kt * 72, 72, zero16(), lane);
#pragma unroll
            for (int i = 0; i < 16; ++i) SL[(size_t)item * 4096 + (32 * half + crow(i, h)) * 64 + 32 * kt + c0] = (bf16_t)f2bf(a[i]); }
        if (half == 0) DEC[item * 64 + lane] = __expf(gl);
    } else {
        if (half == 0) GL[lane] = __expf(gm);
        bf16_t ivr[32];
#pragma unroll
        for (int j = 0; j < 32; ++j) { const int t = half * 32 + j; const float q = bf2f(B0[t * 72 + lane]); const float kj = oml * (1.f - sigmoidf_(bf2f(B1[t * 72 + lane])));
            const float e1 = __expf(fminf(g[j] - gm, 80.f)), e2 = __expf(fminf(gm - g[j], 80.f));
            ivr[j] = B2[t * 72 + lane];
            B0[t * 72 + lane] = (bf16_t)f2bf(q * e1); B1[t * 72 + lane] = (bf16_t)f2bf(kj * e2); }
        __syncthreads();
#pragma unroll
        for (int j = 0; j < 32; ++j) B2[lane * 72 + half * 32 + j] = ivr[j];
        __syncthreads();
        f32x16 s0 = mma_lds<64>(B0 + 32 * half * 72, 72, B1, 72, zero16(), lane);
        f32x16 s1 = zero16(); if (half) s1 = mma_lds<64>(B0 + 32 * half * 72, 72, B1 + 32 * 72, 72, zero16(), lane);
        __syncthreads();
#pragma unroll
        for (int i = 0; i < 16; ++i) { const int row = 32 * half + crow(i, h);
            B1[row * 72 + c0] = (bf16_t)f2bf(c0 <= row ? s0[i] : 0.f); B1[row * 72 + 32 + c0] = (bf16_t)f2bf(32 + c0 <= row ? s1[i] : 0.f); }
        __syncthreads();
        f32x16 o0 = mma_lds<64>(B1 + 32 * half * 72, 72, B2, 72, zero16(), lane);
        f32x16 o1 = mma_lds<64>(B1 + 32 * half * 72, 72, B2 + 32 * 72, 72, zero16(), lane);
        __syncthreads();
        {
          u32x4 wsl[4], wg[4];
          const bf16_t* sp = SL2 + (size_t)item * 4096 + (32 * half) * 64;
#pragma unroll
          for (int e = 0; e < 4; ++e) { const int pc = lane + 64 * e; wsl[e] = *(const u32x4*)(sp + pc * 8); wg[e] = *(const u32x4*)(zsrc + (size_t)(16 * e) * DIN + ZG); }
#pragma unroll
          for (int e = 0; e < 4; ++e) { const int pc = lane + 64 * e, row = pc >> 3, k0 = (pc & 7) * 8; const LAS float* eg = GL + k0;
              u32x4 o; o.x = pk2(bflo(wsl[e].x) * eg[0], bfhi(wsl[e].x) * eg[1]); o.y = pk2(bflo(wsl[e].y) * eg[2], bfhi(wsl[e].y) * eg[3]);
              o.z = pk2(bflo(wsl[e].z) * eg[4], bfhi(wsl[e].z) * eg[5]); o.w = pk2(bflo(wsl[e].w) * eg[6], bfhi(wsl[e].w) * eg[7]);
              *(LAS u32x4*)(B2 + (32 * half + row) * 72 + k0) = o;
              *(LAS u32x4*)(lds + sdst + 9216 + e * 16 * 144) = wg[e]; } }
        __syncthreads();
        o0 = mma_lds<64>(B0 + 32 * half * 72, 72, B2, 72, o0, lane);
        o1 = mma_lds<64>(B0 + 32 * half * 72, 72, B2 + 32 * 72, 72, o1, lane);
        const float* ng = p.in[I_HNG] + l * 256 + hd * 64; const float ng0 = ng[c0], ng1 = ng[32 + c0];
#pragma unroll
        for (int i = 0; i < 16; ++i) { const int row = 32 * half + crow(i, h);
            const float ss = half_sum(o0[i] * o0[i] + o1[i] * o1[i]); const float rs = rsqrtf(ss * (1.0f / 64.0f) + EPS);
            const float g0 = bf2f(B1[row * 72 + c0]), g1 = bf2f(B1[row * 72 + 32 + c0]);
            const float v0 = o0[i] * rs * ng0 * g0 * sigmoidf_(g0), v1 = o1[i] * rs * ng1 * g1 * sigmoidf_(g1);
            o0[i] = v0; o1[i] = v1; const float s2 = half_sum(v0 * v0 + v1 * v1); if (c0 == 0) SSA[hd * 64 + row] = s2; }
        __syncthreads();
        bf16_t* Y = (bf16_t*)(p.ws + WS_YCAT);
#pragma unroll
        for (int i = 0; i < 16; ++i) { const int row = 32 * half + crow(i, h); const size_t tok = (size_t)cg * 64 + row;
            const float tot = (SSA[row] + SSA[64 + row]) + (SSA[128 + row] + SSA[192 + row]); const float r2 = rsqrtf(tot * (1.0f / 256.0f) + EPS);
            Y[tok * D + YA + hd * 64 + c0] = (bf16_t)f2bf(o0[i] * r2); Y[tok * D + YA + hd * 64 + 32 + c0] = (bf16_t)f2bf(o1[i] * r2); }
    }
}
DI void hgrn_scan_item(const Params& p, int hb) {
    int tid_o = threadIdx.x; asm volatile("" : "+v"(tid_o));
    const int e = hb * 512 + tid_o, bh = e >> 12, b = bh >> 2, hd = bh & 3, vk = e & 4095, k = vk & 63;
    const bf16_t* SL = (const bf16_t*)(p.ws + WS_SL); bf16_t* SL2 = (bf16_t*)(p.ws + WS_SL2); const float* DEC = (const float*)(p.ws + WS_DEC);
    float st = 0.f;
    for (int c8 = 0; c8 < 128; c8 += 16) { float tmp[16], dc[16];
#pragma unroll
        for (int u = 0; u < 16; ++u) { const int item = (b * 128 + c8 + u) * 4 + hd; tmp[u] = bf2f(SL[(size_t)item * 4096 + vk]); dc[u] = DEC[item * 64 + k]; }
#pragma unroll
        for (int u = 0; u < 16; ++u) { const int item = (b * 128 + c8 + u) * 4 + hd; SL2[(size_t)item * 4096 + vk] = (bf16_t)f2bf(st); st = dc[u] * st + tmp[u]; } }
}

DI void conv_item(const Params& p, LAS unsigned char* lds, int l, int ti) {
    int tid_o = threadIdx.x; asm volatile("" : "+v"(tid_o));
    const int tid = tid_o, lane = tid & 63, wave = tid >> 6, c = tid & 255, hf = tid >> 8, wv = wave & 3;
    LAS float* Hs = (LAS float*)lds; LAS float* ST = (LAS float*)(lds + 98304); LAS float* ST2 = ST + 512;
    const bf16_t* Z = (const bf16_t*)(p.ws + WS_Z); bf16_t* Y = (bf16_t*)(p.ws + WS_YCAT);
    const int tok0 = ti * 64, pos0 = (ti & 127) * 64;
    __syncthreads();
    { u32x4 vw[6], gw_[6];
#pragma unroll
      for (int k = 0; k < 6; ++k) { const int pid = tid + 512 * k, row = pid >> 5, pc = pid & 31, pos = pos0 - 30 + row; const bool ok = (row < 94) && (pos >= 0);
          const size_t tok = ok ? (size_t)(tok0 - 30 + row) : (size_t)tok0; vw[k] = *(const u32x4*)(Z + tok * DIN + ZBV + pc * 8); gw_[k] = *(const u32x4*)(Z + tok * DIN + ZBG + pc * 8); }
#pragma unroll
      for (int k = 0; k < 6; ++k) { const int pid = tid + 512 * k, row = pid >> 5, pc = pid & 31, pos = pos0 - 30 + row; const bool ok = (row < 94) && (pos >= 0);
          if (row < 94) { f32x4 h0, h1;
              h0[0] = bflo(vw[k].x) * sigmoidf_(bflo(gw_[k].x)); h0[1] = bfhi(vw[k].x) * sigmoidf_(bfhi(gw_[k].x)); h0[2] = bflo(vw[k].y) * sigmoidf_(bflo(gw_[k].y)); h0[3] = bfhi(vw[k].y) * sigmoidf_(bfhi(gw_[k].y));
              h1[0] = bflo(vw[k].z) * sigmoidf_(bflo(gw_[k].z)); h1[1] = bfhi(vw[k].z) * sigmoidf_(bfhi(gw_[k].z)); h1[2] = bflo(vw[k].w) * sigmoidf_(bflo(gw_[k].w)); h1[3] = bfhi(vw[k].w) * sigmoidf_(bfhi(gw_[k].w));
              if (!ok) { h0 = (f32x4){0.f, 0.f, 0.f, 0.f}; h1 = h0; }
              *(LAS f32x4*)(Hs + row * 256 + pc * 8) = h0; *(LAS f32x4*)(Hs + row * 256 + pc * 8 + 4) = h1; } } }
    __syncthreads();
    const float* cw = p.in[I_CW] + (size_t)l * 31 * 256 + c; float w[31];
#pragma unroll
    for (int jj = 0; jj < 31; ++jj) w[jj] = cw[jj * 256];
    const float cb = p.in[I_CB][l * 256 + c];
    const float lng = p.in[I_CLG][l * 256 + c], lnb = p.in[I_CLB][l * 256 + c];
    LAS float* OT2 = (LAS float*)(lds + 98304);
    LAS float* STAT = (LAS float*)(lds + 131072); LAS float* STAT2 = STAT + 64;
    const int rtl = tid >> 4, rpart = tid & 15;
#pragma unroll 1
    for (int ps = 0; ps < 2; ++ps) { const int tb = hf * 32 + ps * 16;
        float o[16];
        { float hr[46];
#pragma unroll
          for (int r = 0; r < 46; ++r) hr[r] = Hs[(tb + r) * 256 + c];
#pragma unroll
          for (int j = 0; j < 16; ++j) { float a = cb;
#pragma unroll
            for (int jj = 0; jj < 31; ++jj) a += w[jj] * hr[j + jj];
            o[j] = a; } }
#pragma unroll
        for (int j = 0; j < 16; ++j) OT2[(hf * 16 + j) * 256 + c] = o[j];
        __syncthreads();
        { const LAS f32x4* q = (const LAS f32x4*)(OT2 + rtl * 256 + rpart * 16); float s1 = 0.f, s2 = 0.f;
#pragma unroll
          for (int e = 0; e < 4; ++e) { const f32x4 v = q[e]; s1 += (v[0] + v[1]) + (v[2] + v[3]); s2 += (v[0] * v[0] + v[1] * v[1]) + (v[2] * v[2] + v[3] * v[3]); }
#pragma unroll
          for (int off = 1; off < 16; off <<= 1) { s1 += __shfl_xor(s1, off); s2 += __shfl_xor(s2, off); }
          if (rpart == 0) { const float mu = s1 * (1.0f / 256.0f); const float var = fmaxf(s2 * (1.0f / 256.0f) - mu * mu, 0.f); STAT[rtl * 2] = mu; STAT[rtl * 2 + 1] = rsqrtf(var + EPS); } }
        __syncthreads();
#pragma unroll
        for (int j = 0; j < 16; ++j) { const float mu = STAT[(hf * 16 + j) * 2], rsd = STAT[(hf * 16 + j) * 2 + 1];
            const float y = (o[j] - mu) * rsd * lng + lnb; const float sv = y * sigmoidf_(y); o[j] = sv; OT2[(hf * 16 + j) * 256 + c] = sv; }
        __syncthreads();
        { const LAS f32x4* q = (const LAS f32x4*)(OT2 + rtl * 256 + rpart * 16); float s3 = 0.f;
#pragma unroll
          for (int e = 0; e < 4; ++e) { const f32x4 v = q[e]; s3 += (v[0] * v[0] + v[1] * v[1]) + (v[2] * v[2] + v[3] * v[3]); }
#pragma unroll
          for (int off = 1; off < 16; off <<= 1) s3 += __shfl_xor(s3, off);
          if (rpart == 0) STAT2[rtl] = rsqrtf(s3 * (1.0f / 256.0f) + EPS); }
        __syncthreads();
#pragma unroll
        for (int j = 0; j < 16; ++j) Y[(size_t)(tok0 + tb + j) * D + YB + c] = (bf16_t)f2bf(o[j] * STAT2[hf * 16 + j]);
    }
}

DI bf16x8 ldg8(const bf16_t* p) { return *(const bf16x8*)p; }
DI void s5_local_item(const Params& p, LAS unsigned char* lds, int l, int bi) {
    int tid_o = threadIdx.x; asm volatile("" : "+v"(tid_o));
    const int tid = tid_o, lane = tid & 63, wave = tid >> 6;
    const int gh = bi & 1, cb = (bi >> 1) & 15, pt = bi >> 5, g = gh * 8 + wave, c0 = lane & 31, h = lane >> 5, lg = l * 16 + g;
    LAS bf16_t* UT = (LAS bf16_t*)lds;
    const bf16_t* Z = (const bf16_t*)(p.ws + WS_Z);
    const int sm = tid >> 4, spc = tid & 15;
    const bf16_t* zst = Z + (size_t)((cb * 32 + sm) * 64) * DIN + ZCU + gh * 128 + spc * 8;
    const int ust = (sm * 136 + spc * 8) * 2;
    const bf16_t* wsp = (const bf16_t*)(p.ws + WS_S5WS) + ((size_t)lg * 64 * 128 + pt * 32 + c0) * 16 + 8 * h;
    u32x4 pf[8];
#pragma unroll
    for (int e = 0; e < 8; ++e) pf[e] = *(const u32x4*)(zst + (size_t)e * DIN);
    f32x16 acc = zero16();
    __syncthreads();
    for (int b = 0; b < 8; ++b) { const int s0 = 8 * b;
#pragma unroll
        for (int e = 0; e < 8; ++e) *(LAS u32x4*)(lds + ust + e * (32 * 136 * 2)) = pf[e];
        __syncthreads();
        if (b + 1 < 8) {
#pragma unroll
            for (int e = 0; e < 8; ++e) pf[e] = *(const u32x4*)(zst + (size_t)(s0 + 8 + e) * DIN); }
        bf16x8 bf[8];
#pragma unroll
        for (int e = 0; e < 8; ++e) bf[e] = ldg8(wsp + (size_t)(s0 + e) * 2048);
#pragma unroll
        for (int e = 0; e < 8; ++e) acc = __builtin_amdgcn_mfma_f32_32x32x16_bf16(*(const LAS bf16x8*)(UT + (e * 32 + c0) * 136 + wave * 16 + 8 * h), bf[e], acc, 0, 0, 0);
        __syncthreads();
    }
    float* HL = (float*)(p.ws + WS_S5H);
#pragma unroll
    for (int i = 0; i < 16; ++i) HL[((size_t)(cb * 32 + crow(i, h)) * 16 + g) * 128 + pt * 32 + c0] = acc[i];
}
DI void s5_scan_item(const Params& p, int l, int sb) {
    int tid_o = threadIdx.x; asm volatile("" : "+v"(tid_o));
    const int e = sb * 512 + tid_o, b = e >> 10, g = (e >> 6) & 15, pp = e & 63;
    float lrdt, lidt, cr, ci; s5_params(p, l * 16 + g, pp, lrdt, lidt, cr, ci);
    float ar, ai; s5_pow(lrdt, lidt, 64, ar, ai);
    const float* HL = (const float*)(p.ws + WS_S5H); float* HO = (float*)(p.ws + WS_S5H2); float hr = 0.f, hi = 0.f;
    for (int c8 = 0; c8 < 128; c8 += 16) { float tr[16], ti[16];
#pragma unroll
        for (int u = 0; u < 16; ++u) { const size_t idx = ((size_t)(b * 128 + c8 + u) * 16 + g) * 128; tr[u] = HL[idx + pp]; ti[u] = HL[idx + 64 + pp]; }
#pragma unroll
        for (int u = 0; u < 16; ++u) { const size_t idx = ((size_t)(b * 128 + c8 + u) * 16 + g) * 128; HO[idx + pp] = hr; HO[idx + 64 + pp] = hi;
            const float nr = ar * hr - ai * hi + tr[u], ni = ar * hi + ai * hr + ti[u]; hr = nr; hi = ni; } }
}
DI void s5_out_item(const Params& p, LAS unsigned char* lds, int l, int bi) {
    int tid_o = threadIdx.x; asm volatile("" : "+v"(tid_o));
    const int tid = tid_o, lane = tid & 63, wave = tid >> 6;
    const int gh = bi & 1, cb = (bi >> 1) & 15, pr = bi >> 5, g = gh * 8 + wave, c0 = lane & 31, h = lane >> 5, lg = l * 16 + g;
    LAS bf16_t* UT = (LAS bf16_t*)lds;
    LAS bf16_t* OT = (LAS bf16_t*)(lds + 69632);
    const bf16_t* Z = (const bf16_t*)(p.ws + WS_Z);
    const bf16_t* kt = (const bf16_t*)(p.ws + WS_S5K) + (size_t)lg * 64 * 256;
    const float* ha = (const float*)(p.ws + WS_S5H2) + ((size_t)(cb * 32 + c0) * 16 + g) * 128 + 8 * h;
    const int co = c0 & 15; const float dsk = p.in[I_S5D][l * 256 + g * 16 + co];
    const int jt0 = pr, jt1 = 31 - pr, tl0 = 2 * jt0 + (c0 >> 4), tl1 = 2 * jt1 + (c0 >> 4);
    const int sm = tid >> 4, spc = tid & 15;
    const bf16_t* zst = Z + (size_t)((cb * 32 + sm) * 64) * DIN + ZCU + gh * 128 + spc * 8;
    const int ust = (sm * 136 + spc * 8) * 2;
    const int nb = (2 * jt1 + 2 + 7) >> 3;
    u32x4 pf[8];
#pragma unroll
    for (int e = 0; e < 8; ++e) pf[e] = *(const u32x4*)(zst + (size_t)e * DIN);
    f32x16 acc0 = zero16(), acc1 = zero16();
    { const bf16_t* wc0 = (const bf16_t*)(p.ws + WS_S5WC) + (((size_t)lg * 64 + tl0) * 16 + co) * 128 + 8 * h;
      const bf16_t* wc1 = (const bf16_t*)(p.ws + WS_S5WC) + (((size_t)lg * 64 + tl1) * 16 + co) * 128 + 8 * h;
      f32x4 x0[8], x1[8];
#pragma unroll
      for (int ks = 0; ks < 8; ++ks) { x0[ks] = *(const f32x4*)(ha + ks * 16); x1[ks] = *(const f32x4*)(ha + ks * 16 + 4); }
#pragma unroll
      for (int ks = 0; ks < 8; ++ks) { u32x4 w; w.x = pk2(x0[ks][0], x0[ks][1]); w.y = pk2(x0[ks][2], x0[ks][3]); w.z = pk2(x1[ks][0], x1[ks][1]); w.w = pk2(x1[ks][2], x1[ks][3]);
        const bf16x8 af = __builtin_bit_cast(bf16x8, w);
        acc0 = __builtin_amdgcn_mfma_f32_32x32x16_bf16(af, ldg8(wc0 + ks * 16), acc0, 0, 0, 0);
        acc1 = __builtin_amdgcn_mfma_f32_32x32x16_bf16(af, ldg8(wc1 + ks * 16), acc1, 0, 0, 0); } }
    __syncthreads();
    for (int b = 0; b < nb; ++b) { const int s0 = 8 * b;
#pragma unroll
        for (int e = 0; e < 8; ++e) *(LAS u32x4*)(lds + ust + e * (32 * 136 * 2)) = pf[e];
        __syncthreads();
        if (b + 1 < nb) {
#pragma unroll
            for (int e = 0; e < 8; ++e) pf[e] = *(const u32x4*)(zst + (size_t)(s0 + 8 + e) * DIN); }
        const bool use0 = s0 <= 2 * jt0 + 1;
        bf16x8 b0[8], b1[8];
#pragma unroll
        for (int e = 0; e < 8; ++e) { const int d1 = tl1 - (s0 + e); b1[e] = ldg8(kt + ((size_t)(d1 < 0 ? 0 : d1) * 16 + co) * 16 + 8 * h);
            if (use0) { const int d0 = tl0 - (s0 + e); b0[e] = ldg8(kt + ((size_t)(d0 < 0 ? 0 : d0) * 16 + co) * 16 + 8 * h); } }
#pragma unroll
        for (int e = 0; e < 8; ++e) { const bf16x8 af = *(const LAS bf16x8*)(UT + (e * 32 + c0) * 136 + wave * 16 + 8 * h);
            const int d1 = tl1 - (s0 + e); bf16x8 bb = b1[e]; if (d1 < 0) bb = (bf16x8){0, 0, 0, 0, 0, 0, 0, 0};
            acc1 = __builtin_amdgcn_mfma_f32_32x32x16_bf16(af, bb, acc1, 0, 0, 0);
            if (use0) { const int d0 = tl0 - (s0 + e); bf16x8 ba = b0[e]; if (d0 < 0) ba = (bf16x8){0, 0, 0, 0, 0, 0, 0, 0};
                acc0 = __builtin_amdgcn_mfma_f32_32x32x16_bf16(af, ba, acc0, 0, 0, 0); } }
        __syncthreads();
    }
#pragma unroll
    for (int q = 0; q < 2; ++q) { const int tl = q ? tl1 : tl0;
#pragma unroll
        for (int i = 0; i < 16; ++i) { const int m = crow(i, h); const size_t tok = (size_t)(cb * 32 + m) * 64 + tl; const float u = bf2f(Z[tok * DIN + ZCU + g * 16 + co]);
            const float y = (q ? acc1[i] : acc0[i]) + dsk * u; const float ge = y * sigmoidf_(1.5957691216057308f * (y + 0.044715f * y * y * y));
            OT[(q * 64 + m * 2 + (c0 >> 4)) * 136 + wave * 16 + co] = (bf16_t)f2bf(ge); } }
    __syncthreads();
    { const int tau = tid >> 2, qq = tau >> 6, m = (tau >> 1) & 31, t2 = tau & 1, qt = tid & 3; const int jt = qq ? jt1 : jt0;
      const size_t tok = (size_t)(cb * 32 + m) * 64 + 2 * jt + t2;
      const LAS u32x4* src = (const LAS u32x4*)(OT + tau * 136 + qt * 32); u32x4* dst = (u32x4*)((bf16_t*)(p.ws + WS_YPRE) + tok * 256 + gh * 128 + qt * 32);
#pragma unroll
      for (int e = 0; e < 4; ++e) dst[e] = src[e]; }
}

DI void attn_item(const Params& p, LAS unsigned char* lds, int l, int pt, int id) {
    int tid_o = threadIdx.x; asm volatile("" : "+v"(tid_o));
    const int tid = tid_o, lane = tid & 63, wave = tid >> 6;
    const int dil = pt == 0 ? 1 : (pt == 1 ? 4 : 16), nblk = 32 / dil;
    const int b = id >> 7, hd = (id >> 5) & 3, rn = id & 31, r = rn / nblk, n = rn % nblk;
    LAS bf16_t* Ks = (LAS bf16_t*)lds;
    LAS bf16_t* Vt = (LAS bf16_t*)(lds + 55296);
    LAS float* BT = (LAS float*)(lds + 55296 + 50176);
    const bf16_t* Z = (const bf16_t*)(p.ws + WS_Z);
    const bf16_t* OP = (const bf16_t*)(p.ws + (pt == 1 ? WS_O0 : WS_O1)); const float* LP = (const float*)(p.ws + (pt == 1 ? WS_LSE : WS_LSE1));
    bf16_t* ON = pt == 2 ? (bf16_t*)(p.ws + WS_Z) + ZOD : (bf16_t*)(p.ws + (pt == 0 ? WS_O0 : WS_O1)); const int onp = pt == 2 ? DIN : 256;
    float* LN = (float*)(p.ws + (pt == 0 ? WS_LSE : WS_LSE1));
    const size_t tokb = (size_t)b * SEQ;
    const int c0 = lane & 31, h = lane >> 5;
    const int qi = 32 * wave + c0; const size_t tokq = tokb + (size_t)(n * 256 + qi) * dil + r;
    u32x4 qraw[4]; u32x2 oprev[2][4]; float mprev = 0.f;
#pragma unroll
    for (int ks = 0; ks < 4; ++ks) qraw[ks] = *(const u32x4*)(Z + tokq * DIN + ZDQ + hd * 64 + ks * 16 + 8 * h);
    if (pt > 0) { mprev = LP[tokq * 4 + hd];
#pragma unroll
        for (int vt = 0; vt < 2; ++vt)
#pragma unroll
            for (int g4 = 0; g4 < 4; ++g4) oprev[vt][g4] = *(const u32x2*)(OP + tokq * 256 + hd * 64 + 32 * vt + 8 * g4 + 4 * h); }
    __syncthreads();
    if (tid < 132) BT[tid] = ((const float*)(p.ws + WS_BIAS))[(pt * 4 + hd) * 132 + tid];
    { const float* kg = p.in[I_KG] + l * 64 + (tid & 7) * 8; float kgv[8];
#pragma unroll
      for (int e = 0; e < 8; ++e) kgv[e] = kg[e];
      u32x4 kwv[6], vwv[6];
#pragma unroll
      for (int it = 0; it < 6; ++it) { const int idx = tid + 512 * it, row = idx >> 3, c = idx & 7, si = n * 256 - 128 + row;
        const size_t tok = tokb + (size_t)(si < 0 ? 0 : si) * dil + r;
        kwv[it] = *(const u32x4*)(Z + tok * DIN + ZDK + hd * 64 + c * 8); vwv[it] = *(const u32x4*)(Z + tok * DIN + ZDV + hd * 64 + c * 8); }
#pragma unroll
      for (int it = 0; it < 6; ++it) { const int idx = tid + 512 * it, row = idx >> 3, c = idx & 7, si = n * 256 - 128 + row;
        u32x4 kw = kwv[it], vw = vwv[it];
        if (si < 0) { kw = (u32x4){0u, 0u, 0u, 0u}; vw = (u32x4){0u, 0u, 0u, 0u}; }
        float kf[8]; kf[0] = bflo(kw.x); kf[1] = bfhi(kw.x); kf[2] = bflo(kw.y); kf[3] = bfhi(kw.y); kf[4] = bflo(kw.z); kf[5] = bfhi(kw.z); kf[6] = bflo(kw.w); kf[7] = bfhi(kw.w);
        float ss = 0.f;
#pragma unroll
        for (int e = 0; e < 8; ++e) ss += kf[e] * kf[e];
        ss += __shfl_xor(ss, 1); ss += __shfl_xor(ss, 2); ss += __shfl_xor(ss, 4);
        const float rs = rsqrtf(ss * (1.0f / 64.0f) + EPS);
        u32x4 o; o.x = pk2(kf[0] * rs * kgv[0], kf[1] * rs * kgv[1]); o.y = pk2(kf[2] * rs * kgv[2], kf[3] * rs * kgv[3]); o.z = pk2(kf[4] * rs * kgv[4], kf[5] * rs * kgv[5]); o.w = pk2(kf[6] * rs * kgv[6], kf[7] * rs * kgv[7]);
        *(LAS u32x4*)(Ks + row * 72 + c * 8) = o;
        LAS bf16_t* vp = Vt + (c * 8) * 392 + row;
        vp[0 * 392] = (bf16_t)(vw.x & 0xffffu); vp[1 * 392] = (bf16_t)(vw.x >> 16); vp[2 * 392] = (bf16_t)(vw.y & 0xffffu); vp[3 * 392] = (bf16_t)(vw.y >> 16);
        vp[4 * 392] = (bf16_t)(vw.z & 0xffffu); vp[5 * 392] = (bf16_t)(vw.z >> 16); vp[6 * 392] = (bf16_t)(vw.w & 0xffffu); vp[7 * 392] = (bf16_t)(vw.w >> 16); } }
    __syncthreads();
    bf16x8 qf[4];
    { float qv[4][8]; float ss = 0.f;
#pragma unroll
      for (int ks = 0; ks < 4; ++ks) { const u32x4 w = qraw[ks];
        qv[ks][0] = bflo(w.x); qv[ks][1] = bfhi(w.x); qv[ks][2] = bflo(w.y); qv[ks][3] = bfhi(w.y); qv[ks][4] = bflo(w.z); qv[ks][5] = bfhi(w.z); qv[ks][6] = bflo(w.w); qv[ks][7] = bfhi(w.w);
#pragma unroll
        for (int e = 0; e < 8; ++e) ss += qv[ks][e] * qv[ks][e]; }
      ss += __shfl_xor(ss, 32);
      const float rs = rsqrtf(ss * (1.0f / 64.0f) + EPS) * 0.125f;
#pragma unroll
      for (int ks = 0; ks < 4; ++ks) { const float* qg = p.in[I_QG] + l * 64 + ks * 16 + 8 * h; const f32x4 g0 = *(const f32x4*)qg, g1 = *(const f32x4*)(qg + 4);
        u32x4 w; w.x = pk2(qv[ks][0] * rs * g0[0], qv[ks][1] * rs * g0[1]); w.y = pk2(qv[ks][2] * rs * g0[2], qv[ks][3] * rs * g0[3]);
        w.z = pk2(qv[ks][4] * rs * g1[0], qv[ks][5] * rs * g1[1]); w.w = pk2(qv[ks][6] * rs * g1[2], qv[ks][7] * rs * g1[3]);
        qf[ks] = __builtin_bit_cast(bf16x8, w); } }
    f32x16 acc[5];
#pragma unroll
    for (int c = 0; c < 5; ++c) { acc[c] = zero16(); const LAS bf16_t* kb = Ks + (32 * wave + 32 * c + c0) * 72 + 8 * h;
#pragma unroll
        for (int ks = 0; ks < 4; ++ks) acc[c] = __builtin_amdgcn_mfma_f32_32x32x16_bf16(*(const LAS bf16x8*)(kb + ks * 16), qf[ks], acc[c], 0, 0, 0); }
    float mx = -1e30f;
#pragma unroll
    for (int c = 0; c < 5; ++c)
#pragma unroll
        for (int i = 0; i < 16; ++i) { const int kr = crow(i, h); const int delta = 128 + c0 - 32 * c - kr; const int jl = 32 * wave + 32 * c + kr;
            const bool valid = (delta >= 0) && (delta <= 128) && (n * 256 - 128 + jl >= 0);
            const int dcl = delta < 0 ? 0 : (delta > 128 ? 128 : delta);
            const float lgt = valid ? acc[c][i] + BT[dcl] : -1e30f; acc[c][i] = lgt; mx = fmaxf(mx, lgt); }
    mx = fmaxf(mx, __shfl_xor(mx, 32));
    float mnew = mx;
    if (pt > 0) mnew = fmaxf(mx, mprev);
    float lsum = 0.f;
#pragma unroll
    for (int c = 0; c < 5; ++c)
#pragma unroll
        for (int i = 0; i < 16; ++i) { const float pv = __expf(acc[c][i] - mnew); acc[c][i] = pv; lsum += pv; }
    lsum += __shfl_xor(lsum, 32);
    f32x16 o[2]; o[0] = zero16(); o[1] = zero16();
#pragma unroll
    for (int c = 0; c < 5; ++c)
#pragma unroll
        for (int s = 0; s < 2; ++s) { u32x4 pw; pw.x = pk2(acc[c][8 * s + 0], acc[c][8 * s + 1]); pw.y = pk2(acc[c][8 * s + 2], acc[c][8 * s + 3]); pw.z = pk2(acc[c][8 * s + 4], acc[c][8 * s + 5]); pw.w = pk2(acc[c][8 * s + 6], acc[c][8 * s + 7]);
            const bf16x8 pf = __builtin_bit_cast(bf16x8, pw);
#pragma unroll
            for (int vt = 0; vt < 2; ++vt) { const LAS bf16_t* va = Vt + (32 * vt + c0) * 392 + 32 * wave + 32 * c + 16 * s + 4 * h;
                const s16x4 lo = *(const LAS s16x4*)va, hi = *(const LAS s16x4*)(va + 8);
                const bf16x8 vf = __builtin_shufflevector(lo, hi, 0, 1, 2, 3, 4, 5, 6, 7);
                o[vt] = __builtin_amdgcn_mfma_f32_32x32x16_bf16(vf, pf, o[vt], 0, 0, 0); } }
    float sp = 0.f; if (pt > 0) sp = __expf(mprev - mnew);
    const float ltot = lsum + sp, inv = 1.0f / ltot;
#pragma unroll
    for (int vt = 0; vt < 2; ++vt)
#pragma unroll
        for (int g4 = 0; g4 < 4; ++g4) { const int ch = hd * 64 + 32 * vt + 8 * g4 + 4 * h; bf16_t* yo = ON + tokq * onp + ch;
            float v0 = o[vt][4 * g4 + 0], v1 = o[vt][4 * g4 + 1], v2 = o[vt][4 * g4 + 2], v3 = o[vt][4 * g4 + 3];
            if (pt > 0) { const u32x2 w = oprev[vt][g4]; v0 += sp * bflo(w.x); v1 += sp * bfhi(w.x); v2 += sp * bflo(w.y); v3 += sp * bfhi(w.y); }
            u32x2 w; w.x = pk2(v0 * inv, v1 * inv); w.y = pk2(v2 * inv, v3 * inv); *(u32x2*)yo = w; }
    if (h == 0 && pt < 2) __hip_atomic_store(LN + tokq * 4 + hd, mnew + __logf(ltot), __ATOMIC_RELAXED, __HIP_MEMORY_SCOPE_AGENT);
}

#define RLX_AGENT __ATOMIC_RELAXED, __HIP_MEMORY_SCOPE_AGENT
#define XB_TMO      128
#define XB_XCNT(j)  (256  + 64 * (j))
#define XB_XSUB(j)  (1280 + 64 * (j))
#define XB_XGEN(j)  (2304 + 64 * (j))
#define XB_TOP      3328
#define XB_TOPGEN   3392
#define XCD_BAR_WORDS 3456
#define XB_SPIN_CAP (1u << 18)

__device__ __forceinline__ unsigned xb_ld(unsigned* p)              { return __hip_atomic_load(p, __ATOMIC_RELAXED, __HIP_MEMORY_SCOPE_AGENT); }
__device__ __forceinline__ unsigned xb_add(unsigned* p, unsigned v) { return __hip_atomic_fetch_add(p, v, __ATOMIC_RELAXED, __HIP_MEMORY_SCOPE_AGENT); }
__device__ __forceinline__ unsigned xb_xcc_id() { return (unsigned)__builtin_amdgcn_s_getreg((3 << 11) | 20) & 0xFu; }
#define XB_SPIN(cond, bar) do { unsigned _sp = 0; while (cond) { __builtin_amdgcn_s_sleep(1); \
    if ((++_sp & 255u) == 0u) { if (xb_ld(&(bar)[XB_TMO])) break; if (_sp > XB_SPIN_CAP) { atomicAdd(&(bar)[XB_TMO], 1u); break; } } } } while (0)

struct XcdBarrier {
    unsigned* bar; unsigned x;
    volatile LAS unsigned* st;
};

__device__ __forceinline__ XcdBarrier xcd_barrier_post(unsigned* bar, volatile LAS unsigned* st) {
    XcdBarrier b; b.bar = bar; b.x = xb_xcc_id(); b.st = st;
    if (threadIdx.x == 0) (void)xb_add(&bar[XB_XCNT(b.x)], 1u);
    return b;
}
__device__ __forceinline__ void xcd_barrier_complete(unsigned* bar, unsigned x, unsigned& nloc, unsigned& nx) {
    const unsigned G = gridDim.x * gridDim.y * gridDim.z;
    unsigned sum, cnt, mine, sp = 0u;
    for (;;) {
        sum = 0u; cnt = 0u; mine = 0u;
#pragma unroll
        for (unsigned j = 0; j < 16; ++j) { const unsigned c = xb_ld(&bar[XB_XCNT(j)]); sum += c; cnt += (c > 0u) ? 1u : 0u; mine = (j == x) ? c : mine; }
        if (sum == G) break;
        __builtin_amdgcn_s_sleep(1);
        if ((++sp & 255u) == 0u) { if (xb_ld(&bar[XB_TMO])) break; if (sp > XB_SPIN_CAP) { atomicAdd(&bar[XB_TMO], 1u); break; } }
    }
    nloc = mine > 0u ? mine : 1u; nx = cnt > 0u ? cnt : 1u;
}

__device__ __forceinline__ void xcd_barrier(const XcdBarrier& b) {
    asm volatile("s_waitcnt vmcnt(0)" ::: "memory");
    __syncthreads();
    if (threadIdx.x == 0) {
        unsigned* bar = b.bar;
        __builtin_amdgcn_s_waitcnt(0);
        unsigned nloc = b.st[0], nx = b.st[1];
        if (nloc == 0u) { xcd_barrier_complete(bar, b.x, nloc, nx); b.st[0] = nloc; b.st[1] = nx; }
        const unsigned old = xb_add(&bar[XB_XSUB(b.x)], 1u);
        const unsigned gen = old / nloc;
        if (old + 1u == (gen + 1u) * nloc) {
            __builtin_amdgcn_fence(__ATOMIC_RELEASE, "agent");
            asm volatile("s_waitcnt vmcnt(0)" ::: "memory");
            const unsigned og = xb_add(&bar[XB_TOP], 1u);
            const unsigned tg = og / nx;
            if (og + 1u == (tg + 1u) * nx) xb_add(&bar[XB_TOPGEN], 1u);
            else XB_SPIN(xb_ld(&bar[XB_TOPGEN]) == tg, bar);
            __builtin_amdgcn_fence(__ATOMIC_ACQUIRE, "agent");
            xb_add(&bar[XB_XGEN(b.x)], 1u);
            asm volatile("s_waitcnt vmcnt(0)" ::: "memory");
        } else {
            XB_SPIN(xb_ld(&bar[XB_XGEN(b.x)]) == gen, bar);
            __builtin_amdgcn_fence(__ATOMIC_ACQUIRE, "agent");
            asm volatile("s_waitcnt vmcnt(0)" ::: "memory");
        }
    }
    __syncthreads();
}

#ifndef REP_A
#define REP_A 0
#endif
#ifndef REP_B
#define REP_B 0
#endif
#ifndef REP_C
#define REP_C 0
#endif
#ifndef REP_D
#define REP_D 0
#endif
#ifndef MIX_A
#define MIX_A 1
#endif
#ifndef MIX_B
#define MIX_B 1
#endif
#ifndef MIX_C
#define MIX_C 1
#endif
#ifndef MIX_D
#define MIX_D 1
#endif
__global__ void __launch_bounds__(512, 2) hybrid_fwd(Params p) {
    extern __shared__ __attribute__((aligned(16))) unsigned char lds_raw[];
    LAS unsigned char* lds = (LAS unsigned char*)lds_raw;
    cg::grid_group grid = cg::this_grid();
    { volatile LAS unsigned* st0 = (volatile LAS unsigned*)(lds + LDS_BYTES - 64); if (threadIdx.x < 2) st0[threadIdx.x] = 0u; }
    __syncthreads();
    (void)xcd_barrier_post((unsigned*)(p.ws + WS_BAR), (volatile LAS unsigned*)(lds + LDS_BYTES - 64));
    const int G = gridDim.x, bid = blockIdx.x;
    unsigned char* ws = p.ws;
    bf16_t* XB = (bf16_t*)(ws + WS_XB); bf16_t* Zb = (bf16_t*)(ws + WS_Z); bf16_t* YC_ = (bf16_t*)(ws + WS_YCAT); bf16_t* HM = (bf16_t*)(ws + WS_HM);
    float* SSQP = (float*)(ws + WS_SSQP);

#define GRID_SYNC_() do { asm volatile("s_waitcnt vmcnt(0) lgkmcnt(0)" ::: "memory"); grid.sync(); if (threadIdx.x < 64) { __builtin_amdgcn_fence(__ATOMIC_ACQUIRE, "agent"); asm volatile("s_waitcnt vmcnt(0)" ::: "memory"); } __syncthreads(); } while (0)
#define XBAR_ONCE() do { XcdBarrier b_; b_.bar = (unsigned*)(p.ws + WS_BAR); b_.x = xb_xcc_id(); b_.st = (volatile LAS unsigned*)(lds + LDS_BYTES - 64); xcd_barrier(b_); } while (0)
#ifdef REP_SYNC
#define GRID_SYNC() do { XBAR_ONCE(); XBAR_ONCE(); } while (0)
#else
#define GRID_SYNC() XBAR_ONCE()
#endif
    prologue(p, lds, G);
#ifdef REP_PRO
    GRID_SYNC_(); prologue(p, lds, G);
#endif
#ifdef NANFILL
    { u32x4* q = (u32x4*)(ws + WS_S5H); const size_t n16 = (WS_END - WS_S5H) / 16; const u32x4 nanv = (u32x4){0xffffffffu, 0xffffffffu, 0xffffffffu, 0xffffffffu};
      for (size_t i = (size_t)bid * 512 + threadIdx.x; i < n16; i += (size_t)G * 512) q[i] = nanv;
      u32x4* q2 = (u32x4*)(ws + WS_LSE); const size_t m16 = (WS_S5K - WS_LSE) / 16;
      for (size_t i = (size_t)bid * 512 + threadIdx.x; i < m16; i += (size_t)G * 512) q2[i] = nanv; }
#endif
    if (gridDim.y == 0x7fffffffu) GRID_SYNC_();
    GRID_SYNC();

#ifndef NL_RUN
#define NL_RUN NL
#endif
#ifndef DUMP_LAYER
#define DUMP_LAYER 0
#endif
    for (int lrun = 0; lrun < NL_RUN; ++lrun) {
#ifdef SAME_LAYER
        const int l = 0; const bool firstl = (lrun == 0), lastl = (lrun == NL_RUN - 1);
#else
        const int l = lrun; const bool firstl = (lrun == 0), lastl = (lrun == NL_RUN - 1);
#endif
#define RS_TABLE(SSQ_, NUNITS_) \
          { pg8::Unit ua_, ub_; (void)S.next(0, ua_); (void)S.next((NUNITS_) - 1, ub_); \
              int tq_ = threadIdx.x; asm volatile("" : "+v"(tq_)); const int pm_ = (tq_ >> 8) ? ub_.pm : ua_.pm; \
              const f32x4* sq_ = (const f32x4*)((SSQ_) + ((size_t)pm_ * 256 + (tq_ & 255)) * 16); const f32x4 q0 = sq_[0], q1 = sq_[1], q2 = sq_[2], q3 = sq_[3]; \
              const float tot_ = (((q0[0] + q0[1]) + (q0[2] + q0[3])) + ((q1[0] + q1[1]) + (q1[2] + q1[3]))) + (((q2[0] + q2[1]) + (q2[2] + q2[3])) + ((q3[0] + q3[1]) + (q3[2] + q3[3]))); \
              ((LAS float*)(lds + 131072))[tq_] = rsqrtf(tot_ * (1.0f / 1024.0f) + EPS); __syncthreads(); }
        { pg8::Gemm g{XB, (const bf16_t*)(ws + WS_WIN) + (size_t)l * D * DIN, T, DIN, D, D}; pg8::StaticOrder S; S.init(T, DIN, G, bid);
          RS_TABLE(SSQP, (T / 256) * (DIN / 256) / 256)
          pg8::EpiScale E{Zb, DIN, 0, (const PG8_LAS float*)(lds + 131072)};
          pg8::gemm_phase<pg8::EpiScale, pg8::StaticOrder, true, true>(lds, g, S, E);
#ifdef REPEAT_GEMM
          GRID_SYNC(); pg8::gemm_phase<pg8::EpiScale, pg8::StaticOrder, true, true>(lds, g, S, E);
#endif
        }
        GRID_SYNC();
#ifndef SKIP_MIX
        if (!(MIX_A && MIX_B && MIX_C && MIX_D)) { int tq = threadIdx.x; asm volatile("" : "+v"(tq));
          for (int m = bid * 8 + (tq >> 6); m < T; m += G * 8) { u32x2* yp = (u32x2*)(YC_ + (size_t)m * D) + (tq & 63); const u32x2 z2 = (u32x2){0u, 0u};
              if (!MIX_A) yp[0] = z2; if (!MIX_B) yp[64] = z2; if (!MIX_C) yp[128] = z2; if (!MIX_D) yp[192] = z2; } }
#ifndef MIX_REPEAT
#define MIX_REPEAT 1
#endif
        for (int rep = 0; rep < MIX_REPEAT; ++rep) {
        for (int it = bid; it < 1664; it += G) {
            if (it < 512) { if (MIX_A) { hgrn_item<false>(p, lds, l, it); if (REP_A) hgrn_item<false>(p, lds, l, it); } }
            else if (it < 1024) { if (MIX_B) { conv_item(p, lds, l, it - 512); if (REP_B) conv_item(p, lds, l, it - 512); } }
            else if (it < 1152) { if (MIX_C) { s5_local_item(p, lds, l, it - 1024); if (REP_C) s5_local_item(p, lds, l, it - 1024); } }
            else { if (MIX_D) { attn_item(p, lds, l, 0, it - 1152); if (REP_D) attn_item(p, lds, l, 0, it - 1152); } }
        }
        GRID_SYNC();
        if (bid < 128) { if (MIX_A) hgrn_scan_item(p, bid); } else if (bid < 136) { if (MIX_C) s5_scan_item(p, l, bid - 128); }
        if (bid < 136) { if (MIX_D) { attn_item(p, lds, l, 1, 376 + bid); if (REP_D) attn_item(p, lds, l, 1, 376 + bid); } }
        else for (int it = bid - 136; it < 376; it += 120) { if (MIX_D) { attn_item(p, lds, l, 1, it); if (REP_D) attn_item(p, lds, l, 1, it); } }
        GRID_SYNC();
#ifdef REP_P3
        if (bid < 128) { if (MIX_A) hgrn_scan_item(p, bid); } else if (bid < 136) { if (MIX_C) s5_scan_item(p, l, bid - 128); }
        if (bid < 136) { if (MIX_D) { attn_item(p, lds, l, 1, 376 + bid); if (REP_D) attn_item(p, lds, l, 1, 376 + bid); } }
        else for (int it = bid - 136; it < 376; it += 120) { if (MIX_D) { attn_item(p, lds, l, 1, it); if (REP_D) attn_item(p, lds, l, 1, it); } }
        GRID_SYNC();
#endif
        for (int it = bid; it < 1536; it += G) {
            if (it < 512) { if (MIX_A) { hgrn_item<true>(p, lds, l, it); if (REP_A) hgrn_item<true>(p, lds, l, it); } }
            else if (it < 1024) { if (MIX_C) { s5_out_item(p, lds, l, it - 512); if (REP_C) s5_out_item(p, lds, l, it - 512); } }
            else { if (MIX_D) { attn_item(p, lds, l, 2, it - 1024); if (REP_D) attn_item(p, lds, l, 2, it - 1024); } }
        }
        GRID_SYNC();
        }
#ifndef NO_GLU
        { pg8::Gemm g{(const bf16_t*)(ws + WS_YPRE), (const bf16_t*)(ws + WS_WGLU) + (size_t)l * 65536, T, 256, 256, 256}; pg8::StaticOrder S; S.init(T, 256, G, bid);
          pg8::EpiGlu E{(const bf16_t*)(ws + WS_YPRE), 256, YC_ + YC};
          pg8::gemm_phase<pg8::EpiGlu, pg8::StaticOrder, false, true>(lds, g, S, E); }
#endif
        { int tq = threadIdx.x; asm volatile("" : "+v"(tq)); const int lane = tq & 63; const int gw = (bid - 128) * 8 + (tq >> 6), NGW = 128 * 8;
          if (bid >= 128) for (int m = gw; m < T; m += NGW) { u32x2* yp = (u32x2*)(YC_ + (size_t)m * D + YD) + lane; const u32x2 w = *((const u32x2*)(Zb + (size_t)m * DIN + ZOD) + lane);
              const float a0 = bflo(w.x), a1 = bfhi(w.x), a2 = bflo(w.y), a3 = bfhi(w.y);
              const float ss = wave_sum((a0 * a0 + a1 * a1) + (a2 * a2 + a3 * a3)); const float rs = rsqrtf(ss * (1.0f / 256.0f) + EPS);
              u32x2 o; o.x = pk2(a0 * rs, a1 * rs); o.y = pk2(a2 * rs, a3 * rs); *yp = o; } }
        GRID_SYNC();
#endif
#ifdef REP_P5
#ifndef NO_GLU
        { pg8::Gemm g{(const bf16_t*)(ws + WS_YPRE), (const bf16_t*)(ws + WS_WGLU) + (size_t)l * 65536, T, 256, 256, 256}; pg8::StaticOrder S; S.init(T, 256, G, bid);
          pg8::EpiGlu E{(const bf16_t*)(ws + WS_YPRE), 256, YC_ + YC};
          pg8::gemm_phase<pg8::EpiGlu, pg8::StaticOrder, false, true>(lds, g, S, E); }
#endif
        { int tq = threadIdx.x; asm volatile("" : "+v"(tq)); const int lane = tq & 63; const int gw = (bid - 128) * 8 + (tq >> 6), NGW = 128 * 8;
          if (bid >= 128) for (int m = gw; m < T; m += NGW) { u32x2* yp = (u32x2*)(YC_ + (size_t)m * D + YD) + lane; const u32x2 w = *((const u32x2*)(Zb + (size_t)m * DIN + ZOD) + lane);
              const float a0 = bflo(w.x), a1 = bfhi(w.x), a2 = bflo(w.y), a3 = bfhi(w.y);
              const float ss = wave_sum((a0 * a0 + a1 * a1) + (a2 * a2 + a3 * a3)); const float rs = rsqrtf(ss * (1.0f / 256.0f) + EPS);
              u32x2 o; o.x = pk2(a0 * rs, a1 * rs); o.y = pk2(a2 * rs, a3 * rs); *yp = o; } }
        GRID_SYNC();
#endif
#ifdef DUMP_SLICE
        if (lrun == DUMP_LAYER) { int tq = threadIdx.x; asm volatile("" : "+v"(tq));
          for (int m = bid * 8 + (tq >> 6); m < T; m += G * 8) { const int ln = tq & 63;
              for (int j = 0; j < 4; ++j) { const int col = j * 256 + ln * 4; const u32x2 w = *(const u32x2*)(YC_ + (size_t)m * D + col);
                  f32x4 o = (f32x4){0.f, 0.f, 0.f, 0.f}; if (j == DUMP_SLICE) o = (f32x4){bflo(w.x), bfhi(w.x), bflo(w.y), bfhi(w.y)};
                  *(f32x4*)(p.out + (size_t)m * D + col) = o; } }
          break; }
#endif
#ifdef SKIP_MIX
        { pg8::Gemm g{Zb, (const bf16_t*)(ws + WS_WOUT) + (size_t)l * D * D, T, D, D, DIN}; pg8::StaticOrder S; S.init(T, D, G, bid);
#else
        { pg8::Gemm g{YC_, (const bf16_t*)(ws + WS_WOUT) + (size_t)l * D * D, T, D, D, D}; pg8::StaticOrder S; S.init(T, D, G, bid);
#endif
          pg8::EpiRes E{firstl ? p.in[I_X] : p.out, p.out, XB, SSQP + (size_t)T * 16};
          pg8::gemm_phase<pg8::EpiRes, pg8::StaticOrder, true, true>(lds, g, S, E); }
        GRID_SYNC();
        { pg8::Gemm g{XB, (const bf16_t*)(ws + WS_WUP) + (size_t)l * D * FF, T, FF, D, D}; pg8::StaticOrder S; S.init(T, FF, G, bid);
          RS_TABLE(SSQP + (size_t)T * 16, (T / 256) * (FF / 256) / 256)
          pg8::EpiScale E{HM, FF, 1, (const PG8_LAS float*)(lds + 131072)};
          pg8::gemm_phase<pg8::EpiScale, pg8::StaticOrder, true, true>(lds, g, S, E);
#ifdef REPEAT_GEMM
          GRID_SYNC(); pg8::gemm_phase<pg8::EpiScale, pg8::StaticOrder, true, true>(lds, g, S, E);
#endif
        }
        GRID_SYNC();
        { pg8::Gemm g{HM, (const bf16_t*)(ws + WS_WDN) + (size_t)l * D * FF, T, D, FF, FF}; pg8::StaticOrder S; S.init(T, D, G, bid);
          pg8::EpiRes E{p.out, p.out, XB, !lastl ? SSQP : nullptr};
          pg8::gemm_phase<pg8::EpiRes, pg8::StaticOrder, true, true>(lds, g, S, E); }
        if (!lastl) GRID_SYNC();
    }
}

extern "C" void kernel_launch(void* const* d_in, const int* in_sizes, int n_in, void* d_out, int out_size, void* d_ws, size_t ws_size, hipStream_t stream) {
    static int grid = 0;
    if (grid == 0) {
        if (n_in != 26 || out_size != T * D || ws_size < WS_END) { fprintf(stderr, "kernel_launch: unexpected shapes (n_in %d, out %d, ws %zu); nothing launched\n", n_in, out_size, ws_size); grid = -1; return; }
        int dev = 0, cus = 0, per_cu = 0;
        (void)hipGetDevice(&dev); (void)hipDeviceGetAttribute(&cus, hipDeviceAttributeMultiprocessorCount, dev);
        if (hipFuncSetAttribute((const void*)hybrid_fwd, hipFuncAttributeMaxDynamicSharedMemorySize, LDS_BYTES) != hipSuccess) { fprintf(stderr, "kernel_launch: hipFuncSetAttribute failed\n"); grid = -1; return; }
        if (hipOccupancyMaxActiveBlocksPerMultiprocessor(&per_cu, (const void*)hybrid_fwd, 512, LDS_BYTES) != hipSuccess || per_cu < 1) { fprintf(stderr, "kernel_launch: occupancy query gave %d\n", per_cu); per_cu = 1; }
        (void)hipGetLastError();
        if (cus <= 0) cus = 256;
        grid = cus * per_cu;
    }
    if (grid < 0) return;
    if (hipMemsetAsync((char*)d_ws + WS_BAR, 0, XCD_BAR_WORDS * 4, stream) != hipSuccess) { fprintf(stderr, "kernel_launch: hipMemsetAsync of the barrier words failed\n"); return; }
    static int rs_ok = -1;
    if (rs_ok < 0) { rs_ok = (grid == 256) ? 1 : 0;
        const int ncol[2] = {DIN / 256, FF / 256};
        for (int ph = 0; ph < 2 && rs_ok; ++ph) { const int nun = (T / 256) * ncol[ph] / 256;
            for (int c = 0; c < grid && rs_ok; ++c) { pg8::StaticOrder S; S.init(T, ncol[ph] * 256, grid, c); pg8::Unit u0, u1, ui; if (!S.next(0, u0) || !S.next(nun - 1, u1) || S.next(nun, ui)) { rs_ok = 0; break; }
                if (((u0.pm >> 3) & 1) != 0 || ((u1.pm >> 3) & 1) != 1) { rs_ok = 0; break; }
                for (int i = 0; i < nun; ++i) { S.next(i, ui); if (ui.pm != (((ui.pm >> 3) & 1) ? u1.pm : u0.pm)) { rs_ok = 0; break; } } } } }
    Params a{};
    for (int i = 0; i < 26; ++i) a.in[i] = (const float*)d_in[i];
    if (!rs_ok) { fprintf(stderr, "kernel_launch: unit order does not keep a workgroup inside two row panels (grid %d); nothing launched\n", grid); return; }
    a.out = (float*)d_out; a.ws = (unsigned char*)d_ws; a.rs_lds = rs_ok; a.pad = 0;
    void* args[] = {&a};
    hipError_t e = hipLaunchCooperativeKernel((const void*)hybrid_fwd, dim3(grid), dim3(512), args, LDS_BYTES, stream);
    if (e != hipSuccess) fprintf(stderr, "cooperative launch failed: %s (grid %d)\n", hipGetErrorString(e), grid);
}
```

```cpp
#include <hip/hip_runtime.h>
#include <hip/hip_cooperative_groups.h>
#include <cstdio>
#include <cstdint>
namespace cg = cooperative_groups;

#define DI __device__ __forceinline__
#define LAS __attribute__((address_space(3)))
typedef unsigned short bf16_t;
typedef short bf16x8 __attribute__((ext_vector_type(8)));
typedef short s16x4 __attribute__((ext_vector_type(4)));
typedef float f32x4 __attribute__((ext_vector_type(4)));
typedef float f32x16 __attribute__((ext_vector_type(16)));
typedef unsigned u32x4 __attribute__((ext_vector_type(4)));
typedef unsigned u32x2 __attribute__((ext_vector_type(2)));

constexpr int NB = 4, SEQ = 8192, T = NB * SEQ, D = 1024, DIN = 2560, FF = 4096, NL = 4;
constexpr int ZQ = 0, ZF = 256, ZI = 512, ZG = 768, ZBV = 1024, ZBG = 1280, ZCU = 1536, ZDQ = 1792, ZDK = 2048, ZDV = 2304;
constexpr int YA = 0, YB = 256, YC = 512, YD = 768;
constexpr int ZOD = ZBG;
constexpr float EPS = 1e-6f;
constexpr size_t MiB = 1u << 20;
constexpr size_t WS_WIN = 0, WS_WOUT = 20 * MiB, WS_WUP = 28 * MiB, WS_WDN = 60 * MiB, WS_WGLU = 92 * MiB;
constexpr size_t WS_LB = 93 * MiB;
constexpr size_t WS_BIAS = WS_LB + 4096;
constexpr size_t WS_BAR = WS_LB + 32768;
constexpr size_t WS_SSQ = WS_LB + 65536;
constexpr size_t WS_LSE = WS_SSQ + 8 * (size_t)T * 4;
constexpr size_t WS_DEC = WS_LSE + (size_t)T * 16;
constexpr size_t WS_LSE1 = WS_DEC + 2048 * 64 * 4;
constexpr size_t WS_S5K = 96 * MiB;
constexpr size_t WS_S5WS = 98 * MiB;
constexpr size_t WS_S5WC = 114 * MiB;
constexpr size_t WS_XB = 130 * MiB;
constexpr size_t WS_S5H = 194 * MiB;
constexpr size_t WS_HM = 198 * MiB;
constexpr size_t WS_Z = 198 * MiB;
constexpr size_t WS_YCAT = 358 * MiB;
constexpr size_t WS_SL = 422 * MiB, WS_SL2 = 438 * MiB;
constexpr size_t WS_S5H2 = 454 * MiB;
constexpr size_t WS_O0 = 458 * MiB, WS_O1 = 474 * MiB;
constexpr size_t WS_YPRE = 490 * MiB;
constexpr size_t WS_SSQP = 506 * MiB;
constexpr size_t WS_END = 510 * MiB;
static_assert(WS_LSE1 + (size_t)T * 16 <= WS_S5K, "misc region");

constexpr int LDS_BYTES = 147456;

DI unsigned f2bf(float f) { unsigned u = __builtin_bit_cast(unsigned, f); return (u + 0x7fffu + ((u >> 16) & 1u)) >> 16; }
typedef float f32x2_t __attribute__((ext_vector_type(2))); typedef __bf16 bf16x2_t __attribute__((ext_vector_type(2)));
DI unsigned pk2(float lo, float hi) { const f32x2_t v = {lo, hi}; const bf16x2_t b = __builtin_convertvector(v, bf16x2_t); return __builtin_bit_cast(unsigned, b); }
DI float bf2f(bf16_t v) { return __builtin_bit_cast(float, (unsigned)v << 16); }
DI float bflo(unsigned w) { return __builtin_bit_cast(float, w << 16); }
DI float bfhi(unsigned w) { return __builtin_bit_cast(float, w & 0xffff0000u); }
DI float sigmoidf_(float x) { return 1.f / (1.f + __expf(-x)); }
DI float wave_sum(float v) {
#pragma unroll
    for (int o = 1; o < 64; o <<= 1) v += __shfl_xor(v, o);
    return v;
}
DI float half_sum(float v) {
#pragma unroll
    for (int o = 1; o < 32; o <<= 1) v += __shfl_xor(v, o);
    return v;
}
#define LDS_WAIT() asm volatile("s_waitcnt lgkmcnt(0)" ::: "memory")
DI int crow(int reg, int h) { return (reg & 3) + 8 * (reg >> 2) + 4 * h; }

template <int K>
DI f32x16 mma_lds(const LAS bf16_t* A, int lda, const LAS bf16_t* B, int ldb, f32x16 acc, int lane) {
    const int r = lane & 31, h = lane >> 5;
    const LAS bf16_t* ap = A + r * lda + 8 * h; const LAS bf16_t* bp = B + r * ldb + 8 * h;
#pragma unroll
    for (int k0 = 0; k0 < K; k0 += 16) {
        const bf16x8 a = *(const LAS bf16x8*)(ap + k0); const bf16x8 b = *(const LAS bf16x8*)(bp + k0);
        acc = __builtin_amdgcn_mfma_f32_32x32x16_bf16(a, b, acc, 0, 0, 0);
    }
    return acc;
}
DI f32x16 zero16() { f32x16 z;
#pragma unroll
    for (int i = 0; i < 16; ++i) z[i] = 0.f;
    return z; }

namespace pg8 {
#define PG8_LAS __attribute__((address_space(3)))
constexpr int BM = 256, BK = 64, HALF = 128, HTB = HALF * BK * 2, STAGE_BYTES = 8 * HTB, NXCD = 8, WGM = 8;
__host__ __device__ __forceinline__ int lds_byte(int r, int c) { const int st = (r >> 4) * 2 + (c >> 5), rr = r & 15, cc = c & 31, ob = rr * 64 + cc * 2; return st * 1024 + (ob ^ (((ob >> 9) & 1) << 5)); }
__host__ __device__ __forceinline__ void stage_rc(int b, int& R, int& C) { const int st = b / 1024, sb = b % 1024, swz = sb ^ (((sb >> 9) & 1) << 5); R = (st >> 1) * 16 + swz / 64; C = (st & 1) * 32 + (swz % 64) / 2; }
__host__ __device__ __forceinline__ int perm32(int rho) { const int n = rho >> 4, i = rho & 15; return 8 * (i >> 2) + 4 * n + (i & 3); }
struct Unit { int pm, pn; };
struct Gemm { const bf16_t* A; const bf16_t* Bt; int M, N, K, lda; };
struct StaticOrder {
    int nM, nN, nwg, G, c;
    __host__ __device__ __forceinline__ void init(int M, int N, int G_, int c_) { nM = M / BM; nN = N / BM; nwg = nM * nN; G = G_; c = c_; }
    __host__ __device__ __forceinline__ bool next(int i, Unit& u) const {
        const long L = (long)i * G + c; if (L >= nwg) return false;
        int wgid = (int)L; { const int q = nwg / NXCD, r = nwg % NXCD, xcd = wgid % NXCD, off = wgid / NXCD; wgid = (xcd < r ? xcd * (q + 1) : r * (q + 1) + (xcd - r) * q) + off; }
        const int nig = WGM * nN, gid = wgid / nig, fm = gid * WGM, gsz = (nM - fm) < WGM ? (nM - fm) : WGM;
        u.pm = fm + ((wgid % nig) % gsz); u.pn = (wgid % nig) / gsz; return true;
    }
    __device__ __forceinline__ void a_ready(const Unit&) const {}
    __device__ __forceinline__ void done(const Unit&) const {}
};
struct EpiScale {
    static constexpr bool PERM = true, AFTER_DRAIN = false;
    bf16_t* O; int ldc; int act; const PG8_LAS float* rsl;
    __device__ __forceinline__ void operator()(const f32x4 (&acc)[2][2][4][2], const Unit& u, int wr, int wc, int fr, int fq) const {
        const int row0 = u.pm * BM + wr * 64 + fr; const int col0 = u.pn * BM + wc * 32 + 8 * fq;
        const int slot = ((u.pm >> 3) & 1) * 256;
#pragma unroll
        for (int ai = 0; ai < 2; ++ai)
#pragma unroll
            for (int m = 0; m < 4; ++m) { const int r = row0 + ai * HALF + m * 16; float rs;
                rs = rsl[slot + ai * HALF + wr * 64 + m * 16 + fr];
                bf16_t* rowp = O + (size_t)r * ldc + col0;
#pragma unroll
                for (int bj = 0; bj < 2; ++bj) { f32x4 v0 = acc[ai][bj][m][0] * rs, v1 = acc[ai][bj][m][1] * rs;
                    if (act) {
#pragma unroll
                        for (int e = 0; e < 4; ++e) { const float a = fmaxf(v0[e], 0.f), b = fmaxf(v1[e], 0.f); v0[e] = a * a; v1[e] = b * b; } }
                    u32x4 w; w.x = pk2(v0[0], v0[1]); w.y = pk2(v0[2], v0[3]); w.z = pk2(v1[0], v1[1]); w.w = pk2(v1[2], v1[3]);
                    *(u32x4*)(rowp + bj * HALF) = w; } }
    }
};
struct EpiRes {
    static constexpr bool PERM = false, AFTER_DRAIN = false;
    const float* base; float* out; bf16_t* xb; float* ssq_out;
    __device__ __forceinline__ void operator()(const f32x4 (&acc)[2][2][4][2], const Unit& u, int wr, int wc, int fr, int fq) const {
        const int col0 = u.pn * BM + wc * 32 + 4 * fq;
#pragma unroll
        for (int ai = 0; ai < 2; ++ai)
#pragma unroll
            for (int m = 0; m < 4; ++m) { const int r = u.pm * BM + ai * HALF + wr * 64 + m * 16 + fr; const size_t off = (size_t)r * D + col0; float s = 0.f;
#pragma unroll
                for (int bj = 0; bj < 2; ++bj)
#pragma unroll
                    for (int n = 0; n < 2; ++n) { const size_t o2 = off + bj * HALF + n * 16; const f32x4 o = *(const f32x4*)(base + o2) + acc[ai][bj][m][n];
                        *(f32x4*)(out + o2) = o; u32x2 w; w.x = pk2(o[0], o[1]); w.y = pk2(o[2], o[3]); *(u32x2*)(xb + o2) = w;
                        s += (o[0] * o[0] + o[1] * o[1]) + (o[2] * o[2] + o[3] * o[3]); }
                s += __shfl_xor(s, 16); s += __shfl_xor(s, 32);
                if (fq == 0 && ssq_out) ssq_out[(size_t)r * 16 + u.pn * 4 + wc] = s; }
    }
};
struct EpiGlu {
    static constexpr bool PERM = false, AFTER_DRAIN = true;
    const bf16_t* Ysrc; int lds_; bf16_t* Y;
    __device__ __forceinline__ void fused(f32x4 (&acc)[2][2][4][2], const Unit& u, int wr, int wc, int fr, int fq, PG8_LAS unsigned char* lds, int wid, int lane) const {
        PG8_LAS float* Pp = (PG8_LAS float*)lds;
        const int col0 = wc * 32 + 4 * fq;
#pragma unroll
        for (int ai = 0; ai < 2; ++ai)
#pragma unroll
            for (int m = 0; m < 4; ++m) { const int rl = ai * HALF + wr * 64 + m * 16 + fr; const size_t off = (size_t)(u.pm * BM + rl) * lds_ + col0; float s = 0.f;
#pragma unroll
                for (int bj = 0; bj < 2; ++bj)
#pragma unroll
                    for (int n = 0; n < 2; ++n) { const u32x2 w = *(const u32x2*)(Ysrc + off + bj * HALF + n * 16); f32x4 a = acc[ai][bj][m][n];
                        const float y0 = bflo(w.x), y1 = bfhi(w.x), y2 = bflo(w.y), y3 = bfhi(w.y);
                        a[0] = y0 * sigmoidf_(a[0]); a[1] = y1 * sigmoidf_(a[1]); a[2] = y2 * sigmoidf_(a[2]); a[3] = y3 * sigmoidf_(a[3]);
                        acc[ai][bj][m][n] = a; s += (a[0] * a[0] + a[1] * a[1]) + (a[2] * a[2] + a[3] * a[3]); }
                s += __shfl_xor(s, 16); s += __shfl_xor(s, 32);
                if (fq == 0) Pp[rl * 4 + wc] = s; }
        __syncthreads();
#pragma unroll
        for (int ai = 0; ai < 2; ++ai)
#pragma unroll
            for (int m = 0; m < 4; ++m) { const int rl = ai * HALF + wr * 64 + m * 16 + fr; const size_t off = (size_t)(u.pm * BM + rl) * D + col0;
                const float tot = (Pp[rl * 4 + 0] + Pp[rl * 4 + 1]) + (Pp[rl * 4 + 2] + Pp[rl * 4 + 3]); const float rs = rsqrtf(tot * (1.0f / 256.0f) + EPS);
#pragma unroll
                for (int bj = 0; bj < 2; ++bj)
#pragma unroll
                    for (int n = 0; n < 2; ++n) { const f32x4 a = acc[ai][bj][m][n] * rs; u32x2 w; w.x = pk2(a[0], a[1]); w.y = pk2(a[2], a[3]); *(u32x2*)(Y + off + bj * HALF + n * 16) = w; } }
    }
};

template <class Epi, class Sched, bool ALIGN_EPI = false, bool SP2 = false>
__device__ __forceinline__ void gemm_phase(PG8_LAS unsigned char* lds, const Gemm g, const Sched& S, const Epi& E) {
    int tid_o = threadIdx.x; asm volatile("" : "+v"(tid_o));
    const int tid = tid_o, wid = __builtin_amdgcn_readfirstlane(tid >> 6), lane = tid & 63, wr = wid >> 2, wc = wid & 3, fr = lane & 15, fq = lane >> 4;
    const int K = g.K, nt = K / BK;
    unsigned voffA[2], voffB[2];
#pragma unroll
    for (int i = 0; i < 2; ++i) { int R, C; stage_rc(tid * 16 + i * 8192, R, C); const int Rb = Epi::PERM ? ((R & ~31) + perm32(R & 31)) : R;
        voffA[i] = (unsigned)(R * g.lda + C) * 2u; voffB[i] = (unsigned)(Rb * K + C) * 2u; }
    const size_t kstep = (size_t)(BK * 2);
    const size_t hstepA = (size_t)HALF * g.lda * 2, hstepB = (size_t)HALF * K * 2;
    const size_t tstepA = 2 * hstepA, tstepB = 2 * hstepB;
    const unsigned ldsw = (unsigned)wid * 1024u;
    const int aoff = lds_byte(wr * 64 + fr, fq * 8), boff = lds_byte(wc * 32 + fr, fq * 8);
#define PG8_SA(b, h) (((b) * 2 + (h)) * HTB)
#define PG8_SB(b, h) ((4 + (b) * 2 + (h)) * HTB)
#define PG8_STAGE(bufoff, gbase, voff) do { _Pragma("unroll") for (int _i = 0; _i < 2; ++_i) \
        __builtin_amdgcn_global_load_lds((const unsigned*)((const char*)(gbase) + (voff)[_i]), (PG8_LAS unsigned*)(lds + (bufoff) + ldsw + _i * 8192), 16, 0, 0); } while (0)
#define PG8_LDA(dst, b, h) do { _Pragma("unroll") for (int m = 0; m < 4; ++m) _Pragma("unroll") for (int k = 0; k < 2; ++k) dst[m][k] = *(const PG8_LAS bf16x8*)(lds + PG8_SA(b, h) + aoff + m * 2048 + k * 1024); } while (0)
#define PG8_LDB(dst, b, h) do { _Pragma("unroll") for (int n = 0; n < 2; ++n) _Pragma("unroll") for (int k = 0; k < 2; ++k) dst[n][k] = *(const PG8_LAS bf16x8*)(lds + PG8_SB(b, h) + boff + n * 2048 + k * 1024); } while (0)
#define PG8_MMA(ai, bj, At, Bt) do { __builtin_amdgcn_s_setprio(1); _Pragma("unroll") for (int m = 0; m < 4; ++m) _Pragma("unroll") for (int n = 0; n < 2; ++n) _Pragma("unroll") for (int k = 0; k < 2; ++k) \
        acc[ai][bj][m][n] = __builtin_amdgcn_mfma_f32_16x16x32_bf16(Bt[n][k], At[m][k], acc[ai][bj][m][n], 0, 0, 0); __builtin_amdgcn_s_setprio(0); } while (0)
#define PG8_WAIT_V(n) asm volatile("s_waitcnt vmcnt(" #n ")" ::: "memory")
#define PG8_WAIT_L(n) asm volatile("s_waitcnt lgkmcnt(" #n ")" ::: "memory")
#define PG8_BAR __builtin_amdgcn_s_barrier()
#define PG8_SCHED __builtin_amdgcn_sched_barrier(0)
    Unit cur, nxt; int ui = 0;
    if (!S.next(0, cur)) return;
    f32x4 acc[2][2][4][2];
#pragma unroll
    for (int a = 0; a < 2; ++a)
#pragma unroll
        for (int b = 0; b < 2; ++b)
#pragma unroll
            for (int m = 0; m < 4; ++m)
#pragma unroll
                for (int n = 0; n < 2; ++n) acc[a][b][m][n] = (f32x4){0.f, 0.f, 0.f, 0.f};
    bf16x8 At[4][2], B0[2][2], B1[2][2];
    const char* cA = (const char*)g.A + (size_t)cur.pm * tstepA; const char* cB = (const char*)g.Bt + (size_t)cur.pn * tstepB;
    S.a_ready(cur);
    if constexpr (SP2) {
        PG8_STAGE(PG8_SB(0, 0), cB, voffB); PG8_STAGE(PG8_SB(0, 1), cB + hstepB, voffB); PG8_STAGE(PG8_SA(0, 0), cA, voffA); PG8_STAGE(PG8_SA(0, 1), cA + hstepA, voffA);
        if (wr == 1) PG8_BAR;
        PG8_WAIT_V(2); PG8_BAR;
        PG8_STAGE(PG8_SB(1, 0), cB + kstep, voffB); PG8_STAGE(PG8_SA(1, 0), cA + kstep, voffA); PG8_STAGE(PG8_SB(1, 1), cB + hstepB + kstep, voffB);
        PG8_WAIT_V(6); PG8_BAR;
    } else {
        PG8_STAGE(PG8_SB(0, 0), cB, voffB); PG8_STAGE(PG8_SA(0, 0), cA, voffA); PG8_STAGE(PG8_SB(0, 1), cB + hstepB, voffB); PG8_STAGE(PG8_SA(0, 1), cA + hstepA, voffA);
        if (wr == 1) PG8_BAR;
        PG8_WAIT_V(4); PG8_BAR;
        PG8_STAGE(PG8_SB(1, 0), cB + kstep, voffB); PG8_STAGE(PG8_SA(1, 0), cA + kstep, voffA); PG8_STAGE(PG8_SB(1, 1), cB + hstepB + kstep, voffB);
        PG8_WAIT_V(6); PG8_BAR;
    }
    for (;;) {
        const bool has_next = S.next(ui + 1, nxt);
        const char* nA = has_next ? (const char*)g.A + (size_t)nxt.pm * tstepA : cA; const char* nB = has_next ? (const char*)g.Bt + (size_t)nxt.pn * tstepB : cB;
        for (int t = 0; t < nt; t += 2) {
            const bool last = (t == nt - 2);
            const char* a1 = cA + (size_t)(t + 1) * kstep;
            const char* a2 = last ? nA : cA + (size_t)(t + 2) * kstep; const char* b2 = last ? nB : cB + (size_t)(t + 2) * kstep;
            const char* a3 = a2 + kstep; const char* b3 = b2 + kstep;
            if (last && has_next) S.a_ready(nxt);
            if constexpr (SP2) {
            PG8_LDB(B0, 0, 0); PG8_LDB(B1, 0, 1); PG8_SCHED; PG8_LDA(At, 0, 0); PG8_STAGE(PG8_SA(1, 1), a1 + hstepA, voffA);
            PG8_WAIT_V(8); PG8_WAIT_L(0); PG8_BAR; PG8_MMA(0, 0, At, B0); PG8_MMA(0, 1, At, B1); PG8_BAR; PG8_SCHED;
            PG8_LDA(At, 0, 1); PG8_STAGE(PG8_SB(0, 0), b2, voffB); PG8_STAGE(PG8_SB(0, 1), b2 + hstepB, voffB); PG8_STAGE(PG8_SA(0, 0), a2, voffA);
            PG8_WAIT_V(8); PG8_WAIT_L(0); PG8_BAR; PG8_MMA(1, 0, At, B0); PG8_MMA(1, 1, At, B1); PG8_BAR; PG8_SCHED;
            PG8_LDB(B0, 1, 0); PG8_LDB(B1, 1, 1); PG8_SCHED; PG8_LDA(At, 1, 0); PG8_STAGE(PG8_SA(0, 1), a2 + hstepA, voffA);
            PG8_WAIT_V(8); PG8_WAIT_L(0); PG8_BAR; PG8_MMA(0, 0, At, B0); PG8_MMA(0, 1, At, B1); PG8_BAR; PG8_SCHED;
            PG8_LDA(At, 1, 1); PG8_STAGE(PG8_SB(1, 0), b3, voffB); PG8_STAGE(PG8_SB(1, 1), b3 + hstepB, voffB); PG8_STAGE(PG8_SA(1, 0), a3, voffA);
            PG8_WAIT_V(8); PG8_WAIT_L(0); PG8_BAR; PG8_MMA(1, 0, At, B0); PG8_MMA(1, 1, At, B1); PG8_BAR; PG8_SCHED;
            } else {
            PG8_LDB(B0, 0, 0); PG8_SCHED; PG8_LDA(At, 0, 0); PG8_STAGE(PG8_SA(1, 1), a1 + hstepA, voffA);
            PG8_WAIT_L(8); PG8_BAR; PG8_WAIT_L(0); PG8_MMA(0, 0, At, B0); PG8_BAR; PG8_SCHED;
            PG8_LDB(B1, 0, 1); PG8_STAGE(PG8_SB(0, 0), b2, voffB);
            PG8_BAR; PG8_WAIT_L(0); PG8_MMA(0, 1, At, B1); PG8_BAR;
            PG8_LDA(At, 0, 1); PG8_STAGE(PG8_SA(0, 0), a2, voffA);
            PG8_BAR; PG8_WAIT_L(0); PG8_MMA(1, 0, At, B0); PG8_BAR; PG8_SCHED;
            PG8_STAGE(PG8_SB(0, 1), b2 + hstepB, voffB);
            PG8_WAIT_V(6); PG8_BAR; PG8_MMA(1, 1, At, B1); PG8_BAR;
            PG8_LDB(B0, 1, 0); PG8_SCHED; PG8_LDA(At, 1, 0); PG8_STAGE(PG8_SA(0, 1), a2 + hstepA, voffA);
            PG8_WAIT_L(8); PG8_BAR; PG8_WAIT_L(0); PG8_MMA(0, 0, At, B0); PG8_BAR; PG8_SCHED;
            PG8_LDB(B1, 1, 1); PG8_STAGE(PG8_SB(1, 0), b3, voffB);
            PG8_BAR; PG8_WAIT_L(0); PG8_MMA(0, 1, At, B1); PG8_BAR;
            PG8_LDA(At, 1, 1); PG8_STAGE(PG8_SA(1, 0), a3, voffA);
            PG8_BAR; PG8_WAIT_L(0); PG8_MMA(1, 0, At, B0); PG8_BAR; PG8_SCHED;
            PG8_STAGE(PG8_SB(1, 1), b3 + hstepB, voffB);
            PG8_WAIT_V(6); PG8_BAR; PG8_MMA(1, 1, At, B1); PG8_BAR;
            }
        }
        if constexpr (ALIGN_EPI) { if (wr == 0) PG8_BAR; }
        if constexpr (!Epi::AFTER_DRAIN) { E(acc, cur, wr, wc, fr, fq); S.done(cur); }
        if (!has_next) break;
#pragma unroll
        for (int a = 0; a < 2; ++a)
#pragma unroll
            for (int b = 0; b < 2; ++b)
#pragma unroll
                for (int m = 0; m < 4; ++m)
#pragma unroll
                    for (int n = 0; n < 2; ++n) acc[a][b][m][n] = (f32x4){0.f, 0.f, 0.f, 0.f};
        cur = nxt; cA = nA; cB = nB; ++ui;
        if constexpr (ALIGN_EPI) { if (wr == 1) PG8_BAR; }
    }
    PG8_WAIT_V(0);
    if constexpr (!ALIGN_EPI) { if (wr == 0) PG8_BAR; }
    PG8_BAR;
    if constexpr (Epi::AFTER_DRAIN) { E.fused(acc, cur, wr, wc, fr, fq, lds, wid, lane); S.done(cur); }
#undef PG8_SA
#undef PG8_SB
#undef PG8_STAGE
#undef PG8_LDA
#undef PG8_LDB
#undef PG8_MMA
#undef PG8_WAIT_V
#undef PG8_WAIT_L
#undef PG8_BAR
#undef PG8_SCHED
}
}

struct Params { const float* in[26]; float* out; unsigned char* ws; int rs_lds; int pad; };
enum { I_X = 0, I_NMG, I_WIN, I_LBL, I_HNG, I_CW, I_CB, I_CLG, I_CLB, I_LRE, I_LIM, I_BRE, I_BIM, I_CRE, I_CIM, I_S5D, I_LDT, I_WGLU, I_QG, I_KG, I_RB, I_MONG, I_WOUT, I_NMLPG, I_WUP, I_WDN };

DI void p0_transpose_item(const float* W, int K, int N, bf16_t* WT, const float* gk, LAS float* scr, int item, int lane) {
    const int nblk = N / 32, kb = item / nblk, nb = item % nblk, k0 = 64 * kb, n0 = 32 * nb;
    float wv[32];
#pragma unroll
    for (int i = 0; i < 32; ++i) { const int kk = 2 * i + (lane >> 5); wv[i] = W[(size_t)(k0 + kk) * N + n0 + (lane & 31)]; }
#pragma unroll
    for (int i = 0; i < 32; ++i) { const int kk = 2 * i + (lane >> 5); const float s = gk ? gk[k0 + kk] : 1.f; scr[kk * 33 + (lane & 31)] = wv[i] * s; }
    LDS_WAIT();
    const int c = lane & 7;
#pragma unroll
    for (int j = 0; j < 4; ++j) { const int n = (lane >> 3) + 8 * j; const LAS float* s = scr + (8 * c) * 33 + n;
        u32x4 o; o.x = pk2(s[0 * 33], s[1 * 33]); o.y = pk2(s[2 * 33], s[3 * 33]); o.z = pk2(s[4 * 33], s[5 * 33]); o.w = pk2(s[6 * 33], s[7 * 33]);
        *(u32x4*)(WT + (size_t)(n0 + n) * K + k0 + 8 * c) = o; }
    LDS_WAIT();
}
DI void s5_params(const Params& p, int lg, int pp, float& lrdt, float& lidt, float& cr, float& ci) {
    const float dt = expf(p.in[I_LDT][lg]);
    const float lr = p.in[I_LRE][lg * 64 + pp], li = p.in[I_LIM][lg * 64 + pp];
    lrdt = lr * dt; lidt = li * dt;
    const float mag = expf(lrdt); const float ar = mag * cosf(lidt), ai = mag * sinf(lidt);
    const float den = lr * lr + li * li;
    cr = ((ar - 1.0f) * lr + ai * li) / den; ci = (ai * lr - (ar - 1.0f) * li) / den;
}
DI void s5_pow(float lrdt, float lidt, int n, float& er, float& ei) { const float m = expf((float)n * lrdt); const float a = (float)n * lidt; er = m * cosf(a); ei = m * sinf(a); }

DI void prologue(const Params& p, LAS unsigned char* lds, int G) {
    int tid_o = threadIdx.x; asm volatile("" : "+v"(tid_o));
    const int tid = tid_o, lane = tid & 63, wave = tid >> 6;
    const int gw = blockIdx.x * 8 + wave, NGW = G * 8;
    const int gt = blockIdx.x * 512 + tid, NGT = G * 512;
    unsigned char* ws = p.ws;
    LAS float* scr = (LAS float*)(lds + wave * 16384);
    {
        constexpr int I_IN = (D / 64) * (DIN / 32), I_OUT = (D / 64) * (D / 32), I_UP = (D / 64) * (FF / 32), I_DN = (FF / 64) * (D / 32), I_GL = (256 / 64) * (256 / 32);
        constexpr int PER_L = I_IN + I_OUT + I_UP + I_DN + I_GL;
        for (int it = gw; it < NL * PER_L; it += NGW) {
            const int l = it / PER_L; int r = it % PER_L;
            if (r < I_IN) { p0_transpose_item(p.in[I_WIN] + (size_t)l * D * DIN, D, DIN, (bf16_t*)(ws + WS_WIN) + (size_t)l * D * DIN, p.in[I_NMG] + l * D, scr, r, lane); continue; } r -= I_IN;
            if (r < I_OUT) { p0_transpose_item(p.in[I_WOUT] + (size_t)l * D * D, D, D, (bf16_t*)(ws + WS_WOUT) + (size_t)l * D * D, p.in[I_MONG] + l * D, scr, r, lane); continue; } r -= I_OUT;
            if (r < I_UP) { p0_transpose_item(p.in[I_WUP] + (size_t)l * D * FF, D, FF, (bf16_t*)(ws + WS_WUP) + (size_t)l * D * FF, p.in[I_NMLPG] + l * D, scr, r, lane); continue; } r -= I_UP;
            if (r < I_DN) { p0_transpose_item(p.in[I_WDN] + (size_t)l * D * FF, FF, D, (bf16_t*)(ws + WS_WDN) + (size_t)l * D * FF, nullptr, scr, r, lane); continue; } r -= I_DN;
            p0_transpose_item(p.in[I_WGLU] + (size_t)l * 65536, 256, 256, (bf16_t*)(ws + WS_WGLU) + (size_t)l * 65536, nullptr, scr, r, lane);
        }
    }
    {
        float* ssq0 = (float*)(ws + WS_SSQP); bf16_t* XB = (bf16_t*)(ws + WS_XB);
        for (int mb = gw * 16; mb < T; mb += NGW * 16) {
            float keep = 0.f;
#pragma unroll 4
            for (int i = 0; i < 16; ++i) { const int m = mb + i;
                const f32x4* xr = (const f32x4*)(p.in[I_X] + (size_t)m * D) + lane; f32x4 v[4]; float s = 0.f;
#pragma unroll
                for (int j = 0; j < 4; ++j) { v[j] = xr[64 * j]; s += (v[j][0] * v[j][0] + v[j][1] * v[j][1]) + (v[j][2] * v[j][2] + v[j][3] * v[j][3]); }
                s = wave_sum(s); if (lane == i) keep = s;
                u32x2* o8 = (u32x2*)(XB + (size_t)m * D) + lane;
#pragma unroll
                for (int j = 0; j < 4; ++j) { u32x2 w; w.x = pk2(v[j][0], v[j][1]); w.y = pk2(v[j][2], v[j][3]); o8[64 * j] = w; } }
#pragma unroll 1
            for (int i = 0; i < 16; ++i) { const float v = __shfl(keep, i); if (lane < 16) ssq0[(size_t)(mb + i) * 16 + lane] = lane == 0 ? v : 0.f; }
        }
    }
    {
        float* LB = (float*)(ws + WS_LB);
        for (int c = gt; c < 256; c += NGT) {
            const float a0 = p.in[I_LBL][c], a1 = p.in[I_LBL][256 + c], a2 = p.in[I_LBL][512 + c], a3 = p.in[I_LBL][768 + c];
            const float mx = fmaxf(fmaxf(a0, a1), fmaxf(a2, a3));
            const float e0 = expf(a0 - mx), e1 = expf(a1 - mx), e2 = expf(a2 - mx), e3 = expf(a3 - mx); const float inv = 1.f / (e0 + e1 + e2 + e3);
            const float s1 = e1 * inv, s2 = e2 * inv, s3 = e3 * inv; const float hi = 1.0f - 1e-6f;
            LB[c] = 0.f; LB[256 + c] = fminf(fmaxf(s1, 0.f), hi); LB[512 + c] = fminf(fmaxf(s1 + s2, 0.f), hi); LB[768 + c] = fminf(fmaxf(s1 + s2 + s3, 0.f), hi);
        }
        float* BT = (float*)(ws + WS_BIAS);
        for (int i = gt; i < 3 * 4 * 132; i += NGT) {
            const int pt = i / (4 * 132), hd = (i / 132) % 4, dl = i % 132; const int dil = pt == 0 ? 1 : (pt == 1 ? 4 : 16);
            float v = 0.f;
            if (dl <= 128) { const int dist = dl * dil; int bk;
                if (dist < 16) bk = dist; else { bk = 16 + (int)(logf((float)dist / 16.0f) / 4.852030263919617f * 16.0f); if (bk > 31) bk = 31; }
                v = p.in[I_RB][bk * 4 + hd]; }
            BT[i] = v;
        }
    }
    {
        bf16_t* KT = (bf16_t*)(ws + WS_S5K); bf16_t* WS_ = (bf16_t*)(ws + WS_S5WS); bf16_t* WC = (bf16_t*)(ws + WS_S5WC);
        LAS float* ebr = scr; LAS float* ebi = scr + 64 * 17;
        for (int it = gw; it < NL * 16 * 64; it += NGW) {
            const int lg = it >> 6, d = it & 63;
            float lrdt, lidt, cr, ci; s5_params(p, lg, lane, lrdt, lidt, cr, ci);
            float er, ei; s5_pow(lrdt, lidt, d, er, ei);
            const float fr_ = er * cr - ei * ci, fi_ = er * ci + ei * cr;
            const float* br = p.in[I_BRE] + ((size_t)lg * 64 + lane) * 16; const float* bi = p.in[I_BIM] + ((size_t)lg * 64 + lane) * 16;
#pragma unroll
            for (int c = 0; c < 16; ++c) { const float b0 = br[c], b1 = bi[c]; ebr[lane * 17 + c] = fr_ * b0 - fi_ * b1; ebi[lane * 17 + c] = fr_ * b1 + fi_ * b0; }
            LDS_WAIT();
            const int co = lane & 15, cb = (lane >> 4) * 4;
            const float* crp = p.in[I_CRE] + ((size_t)lg * 16 + co) * 64; const float* cip = p.in[I_CIM] + ((size_t)lg * 16 + co) * 64;
            float a0 = 0.f, a1 = 0.f, a2 = 0.f, a3 = 0.f;
            for (int q = 0; q < 64; ++q) { const float c0 = crp[q], c1 = cip[q];
                a0 += c0 * ebr[q * 17 + cb + 0] - c1 * ebi[q * 17 + cb + 0]; a1 += c0 * ebr[q * 17 + cb + 1] - c1 * ebi[q * 17 + cb + 1];
                a2 += c0 * ebr[q * 17 + cb + 2] - c1 * ebi[q * 17 + cb + 2]; a3 += c0 * ebr[q * 17 + cb + 3] - c1 * ebi[q * 17 + cb + 3]; }
            u32x2 w; w.x = pk2(a0, a1); w.y = pk2(a2, a3);
            *(u32x2*)(KT + ((size_t)it * 16 + co) * 16 + cb) = w;
            LDS_WAIT();
        }
        for (int it = gw; it < NL * 16 * 16; it += NGW) {
            const int lg = it >> 4, s4 = it & 15;
            float lrdt, lidt, cr, ci; s5_params(p, lg, lane, lrdt, lidt, cr, ci);
            const float* br = p.in[I_BRE] + ((size_t)lg * 64 + lane) * 16; const float* bi = p.in[I_BIM] + ((size_t)lg * 64 + lane) * 16;
            float b0[16], b1[16];
#pragma unroll
            for (int c = 0; c < 16; ++c) { b0[c] = br[c]; b1[c] = bi[c]; }
#pragma unroll 1
            for (int sq = 0; sq < 4; ++sq) { const int s = s4 * 4 + sq;
                float er, ei; s5_pow(lrdt, lidt, 63 - s, er, ei);
                const float fr_ = er * cr - ei * ci, fi_ = er * ci + ei * cr;
                float vr[16], vi[16];
#pragma unroll
                for (int c = 0; c < 16; ++c) { vr[c] = fr_ * b0[c] - fi_ * b1[c]; vi[c] = fr_ * b1[c] + fi_ * b0[c]; }
                bf16_t* o0 = WS_ + (((size_t)lg * 64 + s) * 128 + lane) * 16; bf16_t* o1 = WS_ + (((size_t)lg * 64 + s) * 128 + 64 + lane) * 16;
                u32x4 w;
                w.x = pk2(vr[0], vr[1]); w.y = pk2(vr[2], vr[3]); w.z = pk2(vr[4], vr[5]); w.w = pk2(vr[6], vr[7]); *(u32x4*)o0 = w;
                w.x = pk2(vr[8], vr[9]); w.y = pk2(vr[10], vr[11]); w.z = pk2(vr[12], vr[13]); w.w = pk2(vr[14], vr[15]); *(u32x4*)(o0 + 8) = w;
                w.x = pk2(vi[0], vi[1]); w.y = pk2(vi[2], vi[3]); w.z = pk2(vi[4], vi[5]); w.w = pk2(vi[6], vi[7]); *(u32x4*)o1 = w;
                w.x = pk2(vi[8], vi[9]); w.y = pk2(vi[10], vi[11]); w.z = pk2(vi[12], vi[13]); w.w = pk2(vi[14], vi[15]); *(u32x4*)(o1 + 8) = w; }
        }
        for (int it = gw; it < NL * 16 * 64; it += NGW) {
            const int lg = it >> 6, tl = it & 63;
            float lrdt, lidt, cr, ci; s5_params(p, lg, lane, lrdt, lidt, cr, ci);
            float er, ei; s5_pow(lrdt, lidt, tl + 1, er, ei);
#pragma unroll 4
            for (int co = 0; co < 16; ++co) { const float c0 = p.in[I_CRE][((size_t)lg * 16 + co) * 64 + lane], c1 = p.in[I_CIM][((size_t)lg * 16 + co) * 64 + lane];
                bf16_t* o = WC + (((size_t)lg * 64 + tl) * 16 + co) * 128;
                o[lane] = (bf16_t)f2bf(c0 * er - c1 * ei); o[64 + lane] = (bf16_t)f2bf(-(c0 * ei + c1 * er)); }
        }
    }
}

template <bool OUT>
DI void hgrn_item(const Params& p, LAS unsigned char* lds, int l, int cg) {
    int tid_o = threadIdx.x; asm volatile("" : "+v"(tid_o));
    const int tid = tid_o, lane = tid & 63, wave = tid >> 6, hd = wave >> 1, half = wave & 1;
    const bf16_t* Z = (const bf16_t*)(p.ws + WS_Z);
    LAS bf16_t* B0 = (LAS bf16_t*)(lds + hd * 27648); LAS bf16_t* B1 = B0 + 64 * 72; LAS bf16_t* B2 = B1 + 64 * 72;
    LAS float* GM = (LAS float*)(lds + 114688) + hd * 64; LAS float* GL = GM + 256; LAS float* SSA = (LAS float*)(lds + 114688) + 512;
    bf16_t* SL = (bf16_t*)(p.ws + WS_SL); const bf16_t* SL2 = (const bf16_t*)(p.ws + WS_SL2); float* DEC = (float*)(p.ws + WS_DEC);
    const int item = cg * 4 + hd;
#ifdef FORCE_LB0
    const float lb = 0.f, oml = 1.f;
#else
    const float lb = ((const float*)(p.ws + WS_LB))[l * 256 + hd * 64 + lane], oml = 1.f - lb;
#endif
    const int srow = tid >> 5, shd = (tid >> 3) & 3, spc = tid & 7;
    const bf16_t* zsrc = Z + (size_t)(cg * 64 + srow) * DIN + shd * 64 + spc * 8;
    const int sdst = shd * 27648 + (srow * 72 + spc * 8) * 2;
    __syncthreads();
    { u32x4 wf[4], wi[4], wq[4];
#pragma unroll
      for (int sub = 0; sub < 4; ++sub) { wf[sub] = *(const u32x4*)(zsrc + (size_t)(16 * sub) * DIN + ZF); wi[sub] = *(const u32x4*)(zsrc + (size_t)(16 * sub) * DIN + ZI);
          if (OUT) wq[sub] = *(const u32x4*)(zsrc + (size_t)(16 * sub) * DIN + ZQ); }
#pragma unroll
      for (int sub = 0; sub < 4; ++sub) { *(LAS u32x4*)(lds + sdst + 9216 + sub * 16 * 144) = wf[sub]; *(LAS u32x4*)(lds + sdst + 18432 + sub * 16 * 144) = wi[sub];
          if (OUT) *(LAS u32x4*)(lds + sdst + sub * 16 * 144) = wq[sub]; } }
    __syncthreads();
    float g[32]; float run = 0.f;
#pragma unroll
    for (int j = 0; j < 32; ++j) { const float fz = bf2f(B1[(half * 32 + j) * 72 + lane]); const float sg = sigmoidf_(fz); const float f = lb + oml * sg;
        run += __logf(fmaxf(f, 1e-30f)); g[j] = run; }
    if (half == 0) GM[lane] = run;
    __syncthreads();
    const float gm = GM[lane];
    if (half) {
#pragma unroll
        for (int j = 0; j < 32; ++j) g[j] += gm; }
    const int c0 = lane & 31, h = lane >> 5;
    if constexpr (!OUT) {
        if (half) GL[lane] = run + gm;
        __syncthreads();
        const float gl = GL[lane];
        bf16_t kv[32], ivr[32];
#pragma unroll
        for (int j = 0; j < 32; ++j) { const int t = half * 32 + j; const float e = __expf(gl - g[j]); const float kj = oml * (1.f - sigmoidf_(bf2f(B1[t * 72 + lane])));
            kv[j] = (bf16_t)f2bf(kj * e); ivr[j] = B2[t * 72 + lane]; }
        __syncthreads();
#pragma unroll
        for (int j = 0; j < 32; ++j) { const int t = half * 32 + j; B1[lane * 72 + t] = kv[j]; B2[lane * 72 + t] = ivr[j]; }
        __syncthreads();
#pragma unroll
        for (int kt = 0; kt < 2; ++kt) { const f32x16 a = mma_lds<64>(B2 + 32 * half * 72, 72, B1 + 32 * kt * 72, 72, zero16(), lane);
#pragma unroll
            for (int i = 0; i < 16; ++i) SL[(size_t)item * 4096 + (32 * half + crow(i, h)) * 64 + 32 * kt + c0] = (bf16_t)f2bf(a[i]); }
        if (half == 0) DEC[item * 64 + lane] = __expf(gl);
    } else {
        if (half == 0) GL[lane] = __expf(gm);
        bf16_t ivr[32];
#pragma unroll
        for (int j = 0; j < 32; ++j) { const int t = half * 32 + j; const float q = bf2f(B0[t * 72 + lane]); const float kj = oml * (1.f - sigmoidf_(bf2f(B1[t * 72 + lane])));
            const float e1 = __expf(fminf(g[j] - gm, 80.f)), e2 = __expf(fminf(gm - g[j], 80.f));
            ivr[j] = B2[t * 72 + lane];
            B0[t * 72 + lane] = (bf16_t)f2bf(q * e1); B1[t * 72 + lane] = (bf16_t)f2bf(kj * e2); }
        __syncthreads();
#pragma unroll
        for (int j = 0; j < 32; ++j) B2[lane * 72 + half * 32 + j] = ivr[j];
        __syncthreads();
        f32x16 s0 = mma_lds<64>(B0 + 32 * half * 72, 72, B1, 72, zero16(), lane);
        f32x16 s1 = zero16(); if (half) s1 = mma_lds<64>(B0 + 32 * half * 72, 72, B1 + 32 * 72, 72, zero16(), lane);
        __syncthreads();
#pragma unroll
        for (int i = 0; i < 16; ++i) { const int row = 32 * half + crow(i, h);
            B1[row * 72 + c0] = (bf16_t)f2bf(c0 <= row ? s0[i] : 0.f); B1[row * 72 + 32 + c0] = (bf16_t)f2bf(32 + c0 <= row ? s1[i] : 0.f); }
        __syncthreads();
        f32x16 o0 = mma_lds<64>(B1 + 32 * half * 72, 72, B2, 72, zero16(), lane);
        f32x16 o1 = mma_lds<64>(B1 + 32 * half * 72, 72, B2 + 32 * 72, 72, zero16(), lane);
        __syncthreads();
        {
          u32x4 wsl[4], wg[4];
          const bf16_t* sp = SL2 + (size_t)item * 4096 + (32 * half) * 64;
#pragma unroll
          for (int e = 0; e < 4; ++e) { const int pc = lane + 64 * e; wsl[e] = *(const u32x4*)(sp + pc * 8); wg[e] = *(const u32x4*)(zsrc + (size_t)(16 * e) * DIN + ZG); }
#pragma unroll
          for (int e = 0; e < 4; ++e) { const int pc = lane + 64 * e, row = pc >> 3, k0 = (pc & 7) * 8; const LAS float* eg = GL + k0;
              u32x4 o; o.x = pk2(bflo(wsl[e].x) * eg[0], bfhi(wsl[e].x) * eg[1]); o.y = pk2(bflo(wsl[e].y) * eg[2], bfhi(wsl[e].y) * eg[3]);
              o.z = pk2(bflo(wsl[e].z) * eg[4], bfhi(wsl[e].z) * eg[5]); o.w = pk2(bflo(wsl[e].w) * eg[6], bfhi(wsl[e].w) * eg[7]);
              *(LAS u32x4*)(B2 + (32 * half + row) * 72 + k0) = o;
              *(LAS u32x4*)(lds + sdst + 9216 + e * 16 * 144) = wg[e]; } }
        __syncthreads();
        o0 = mma_lds<64>(B0 + 32 * half * 72, 72, B2, 72, o0, lane);
        o1 = mma_lds<64>(B0 + 32 * half * 72, 72, B2 + 32 * 72, 72, o1, lane);
        const float* ng = p.in[I_HNG] + l * 256 + hd * 64; const float ng0 = ng[c0], ng1 = ng[32 + c0];
#pragma unroll
        for (int i = 0; i < 16; ++i) { const int row = 32 * half + crow(i, h);
            const float ss = half_sum(o0[i] * o0[i] + o1[i] * o1[i]); const float rs = rsqrtf(ss * (1.0f / 64.0f) + EPS);
            const float g0 = bf2f(B1[row * 72 + c0]), g1 = bf2f(B1[row * 72 + 32 + c0]);
            const float v0 = o0[i] * rs * ng0 * g0 * sigmoidf_(g0), v1 = o1[i] * rs * ng1 * g1 * sigmoidf_(g1);
            o0[i] = v0; o1[i] = v1; const float s2 = half_sum(v0 * v0 + v1 * v1); if (c0 == 0) SSA[hd * 64 + row] = s2; }
        __syncthreads();
        bf16_t* Y = (bf16_t*)(p.ws + WS_YCAT);
#pragma unroll
        for (int i = 0; i < 16; ++i) { const int row = 32 * half + crow(i, h); const size_t tok = (size_t)cg * 64 + row;
            const float tot = (SSA[row] + SSA[64 + row]) + (SSA[128 + row] + SSA[192 + row]); const float r2 = rsqrtf(tot * (1.0f / 256.0f) + EPS);
            Y[tok * D + YA + hd * 64 + c0] = (bf16_t)f2bf(o0[i] * r2); Y[tok * D + YA + hd * 64 + 32 + c0] = (bf16_t)f2bf(o1[i] * r2); }
    }
}
DI void hgrn_scan_item(const Params& p, int hb) {
    int tid_o = threadIdx.x; asm volatile("" : "+v"(tid_o));
    const int e = hb * 512 + tid_o, bh = e >> 12, b = bh >> 2, hd = bh & 3, vk = e & 4095, k = vk & 63;
    const bf16_t* SL = (const bf16_t*)(p.ws + WS_SL); bf16_t* SL2 = (bf16_t*)(p.ws + WS_SL2); const float* DEC = (const float*)(p.ws + WS_DEC);
    float st = 0.f;
    for (int c8 = 0; c8 < 128; c8 += 16) { float tmp[16], dc[16];
#pragma unroll
        for (int u = 0; u < 16; ++u) { const int item = (b * 128 + c8 + u) * 4 + hd; tmp[u] = bf2f(SL[(size_t)item * 4096 + vk]); dc[u] = DEC[item * 64 + k]; }
#pragma unroll
        for (int u = 0; u < 16; ++u) { const int item = (b * 128 + c8 + u) * 4 + hd; SL2[(size_t)item * 4096 + vk] = (bf16_t)f2bf(st); st = dc[u] * st + tmp[u]; } }
}

DI void conv_item(const Params& p, LAS unsigned char* lds, int l, int ti) {
    int tid_o = threadIdx.x; asm volatile("" : "+v"(tid_o));
    const int tid = tid_o, lane = tid & 63, wave = tid >> 6, c = tid & 255, hf = tid >> 8, wv = wave & 3;
    LAS float* Hs = (LAS float*)lds; LAS float* ST = (LAS float*)(lds + 98304); LAS float* ST2 = ST + 512;
    const bf16_t* Z = (const bf16_t*)(p.ws + WS_Z); bf16_t* Y = (bf16_t*)(p.ws + WS_YCAT);
    const int tok0 = ti * 64, pos0 = (ti & 127) * 64;
    __syncthreads();
    { u32x4 vw[6], gw_[6];
#pragma unroll
      for (int k = 0; k < 6; ++k) { const int pid = tid + 512 * k, row = pid >> 5, pc = pid & 31, pos = pos0 - 30 + row; const bool ok = (row < 94) && (pos >= 0);
          const size_t tok = ok ? (size_t)(tok0 - 30 + row) : (size_t)tok0; vw[k] = *(const u32x4*)(Z + tok * DIN + ZBV + pc * 8); gw_[k] = *(const u32x4*)(Z + tok * DIN + ZBG + pc * 8); }
#pragma unroll
      for (int k = 0; k < 6; ++k) { const int pid = tid + 512 * k, row = pid >> 5, pc = pid & 31, pos = pos0 - 30 + row; const bool ok = (row < 94) && (pos >= 0);
          if (row < 94) { f32x4 h0, h1;
              h0[0] = bflo(vw[k].x) * sigmoidf_(bflo(gw_[k].x)); h0[1] = bfhi(vw[k].x) * sigmoidf_(bfhi(gw_[k].x)); h0[2] = bflo(vw[k].y) * sigmoidf_(bflo(gw_[k].y)); h0[3] = bfhi(vw[k].y) * sigmoidf_(bfhi(gw_[k].y));
              h1[0] = bflo(vw[k].z) * sigmoidf_(bflo(gw_[k].z)); h1[1] = bfhi(vw[k].z) * sigmoidf_(bfhi(gw_[k].z)); h1[2] = bflo(vw[k].w) * sigmoidf_(bflo(gw_[k].w)); h1[3] = bfhi(vw[k].w) * sigmoidf_(bfhi(gw_[k].w));
              if (!ok) { h0 = (f32x4){0.f, 0.f, 0.f, 0.f}; h1 = h0; }
              *(LAS f32x4*)(Hs + row * 256 + pc * 8) = h0; *(LAS f32x4*)(Hs + row * 256 + pc * 8 + 4) = h1; } } }
    __syncthreads();
    const float* cw = p.in[I_CW] + (size_t)l * 31 * 256 + c; float w[31];
#pragma unroll
    for (int jj = 0; jj < 31; ++jj) w[jj] = cw[jj * 256];
    const float cb = p.in[I_CB][l * 256 + c];
    const float lng = p.in[I_CLG][l * 256 + c], lnb = p.in[I_CLB][l * 256 + c];
    LAS float* OT2 = (LAS float*)(lds + 98304);
    LAS float* STAT = (LAS float*)(lds + 131072); LAS float* STAT2 = STAT + 64;
    const int rtl = tid >> 4, rpart = tid & 15;
#pragma unroll 1
    for (int ps = 0; ps < 2; ++ps) { const int tb = hf * 32 + ps * 16;
        float o[16];
        { float hr[46];
#pragma unroll
          for (int r = 0; r < 46; ++r) hr[r] = Hs[(tb + r) * 256 + c];
#pragma unroll
          for (int j = 0; j < 16; ++j) { float a = cb;
#pragma unroll
            for (int jj = 0; jj < 31; ++jj) a += w[jj] * hr[j + jj];
            o[j] = a; } }
#pragma unroll
        for (int j = 0; j < 16; ++j) OT2[(hf * 16 + j) * 256 + c] = o[j];
        __syncthreads();
        { const LAS f32x4* q = (const LAS f32x4*)(OT2 + rtl * 256 + rpart * 16); float s1 = 0.f, s2 = 0.f;
#pragma unroll
          for (int e = 0; e < 4; ++e) { const f32x4 v = q[e]; s1 += (v[0] + v[1]) + (v[2] + v[3]); s2 += (v[0] * v[0] + v[1] * v[1]) + (v[2] * v[2] + v[3] * v[3]); }
#pragma unroll
          for (int off = 1; off < 16; off <<= 1) { s1 += __shfl_xor(s1, off); s2 += __shfl_xor(s2, off); }
          if (rpart == 0) { const float mu = s1 * (1.0f / 256.0f); const float var = fmaxf(s2 * (1.0f / 256.0f) - mu * mu, 0.f); STAT[rtl * 2] = mu; STAT[rtl * 2 + 1] = rsqrtf(var + EPS); } }
        __syncthreads();
#pragma unroll
        for (int j = 0; j < 16; ++j) { const float mu = STAT[(hf * 16 + j) * 2], rsd = STAT[(hf * 16 + j) * 2 + 1];
            const float y = (o[j] - mu) * rsd * lng + lnb; const float sv = y * sigmoidf_(y); o[j] = sv; OT2[(hf * 16 + j) * 256 + c] = sv; }
        __syncthreads();
        { const LAS f32x4* q = (const LAS f32x4*)(OT2 + rtl * 256 + rpart * 16); float s3 = 0.f;
#pragma unroll
          for (int e = 0; e < 4; ++e) { const f32x4 v = q[e]; s3 += (v[0] * v[0] + v[1] * v[1]) + (v[2] * v[2] + v[3] * v[3]); }
#pragma unroll
          for (int off = 1; off < 16; off <<= 1) s3 += __shfl_xor(s3, off);
          if (rpart == 0) STAT2[rtl] = rsqrtf(s3 * (1.0f / 256.0f) + EPS); }
        __syncthreads();
#pragma unroll
        for (int j = 0; j < 16; ++j) Y[(size_t)(tok0 + tb + j) * D + YB + c] = (bf16_t)f2bf(o[j] * STAT2[hf * 16 + j]);
    }
}

DI bf16x8 ldg8(const bf16_t* p) { return *(const bf16x8*)p; }
DI void s5_local_item(const Params& p, LAS unsigned char* lds, int l, int bi) {
    int tid_o = threadIdx.x; asm volatile("" : "+v"(tid_o));
    const int tid = tid_o, lane = tid & 63, wave = tid >> 6;
    const int gh = bi & 1, cb = (bi >> 1) & 15, pt = bi >> 5, g = gh * 8 + wave, c0 = lane & 31, h = lane >> 5, lg = l * 16 + g;
    LAS bf16_t* UT = (LAS bf16_t*)lds;
    const bf16_t* Z = (const bf16_t*)(p.ws + WS_Z);
    const int sm = tid >> 4, spc = tid & 15;
    const bf16_t* zst = Z + (size_t)((cb * 32 + sm) * 64) * DIN + ZCU + gh * 128 + spc * 8;
    const int ust = (sm * 136 + spc * 8) * 2;
    const bf16_t* wsp = (const bf16_t*)(p.ws + WS_S5WS) + ((size_t)lg * 64 * 128 + pt * 32 + c0) * 16 + 8 * h;
    u32x4 pf[8];
#pragma unroll
    for (int e = 0; e < 8; ++e) pf[e] = *(const u32x4*)(zst + (size_t)e * DIN);
    f32x16 acc = zero16();
    __syncthreads();
    for (int b = 0; b < 8; ++b) { const int s0 = 8 * b;
#pragma unroll
        for (int e = 0; e < 8; ++e) *(LAS u32x4*)(lds + ust + e * (32 * 136 * 2)) = pf[e];
        __syncthreads();
        if (b + 1 < 8) {
#pragma unroll
            for (int e = 0; e < 8; ++e) pf[e] = *(const u32x4*)(zst + (size_t)(s0 + 8 + e) * DIN); }
        bf16x8 bf[8];
#pragma unroll
        for (int e = 0; e < 8; ++e) bf[e] = ldg8(wsp + (size_t)(s0 + e) * 2048);
#pragma unroll
        for (int e = 0; e < 8; ++e) acc = __builtin_amdgcn_mfma_f32_32x32x16_bf16(*(const LAS bf16x8*)(UT + (e * 32 + c0) * 136 + wave * 16 + 8 * h), bf[e], acc, 0, 0, 0);
        __syncthreads();
    }
    float* HL = (float*)(p.ws + WS_S5H);
#pragma unroll
    for (int i = 0; i < 16; ++i) HL[((size_t)(cb * 32 + crow(i, h)) * 16 + g) * 128 + pt * 32 + c0] = acc[i];
}
DI void s5_scan_item(const Params& p, int l, int sb) {
    int tid_o = threadIdx.x; asm volatile("" : "+v"(tid_o));
    const int e = sb * 512 + tid_o, b = e >> 10, g = (e >> 6) & 15, pp = e & 63;
    float lrdt, lidt, cr, ci; s5_params(p, l * 16 + g, pp, lrdt, lidt, cr, ci);
    float ar, ai; s5_pow(lrdt, lidt, 64, ar, ai);
    const float* HL = (const float*)(p.ws + WS_S5H); float* HO = (float*)(p.ws + WS_S5H2); float hr = 0.f, hi = 0.f;
    for (int c8 = 0; c8 < 128; c8 += 16) { float tr[16], ti[16];
#pragma unroll
        for (int u = 0; u < 16; ++u) { const size_t idx = ((size_t)(b * 128 + c8 + u) * 16 + g) * 128; tr[u] = HL[idx + pp]; ti[u] = HL[idx + 64 + pp]; }
#pragma unroll
        for (int u = 0; u < 16; ++u) { const size_t idx = ((size_t)(b * 128 + c8 + u) * 16 + g) * 128; HO[idx + pp] = hr; HO[idx + 64 + pp] = hi;
            const float nr = ar * hr - ai * hi + tr[u], ni = ar * hi + ai * hr + ti[u]; hr = nr; hi = ni; } }
}
DI void s5_out_item(const Params& p, LAS unsigned char* lds, int l, int bi) {
    int tid_o = threadIdx.x; asm volatile("" : "+v"(tid_o));
    const int tid = tid_o, lane = tid & 63, wave = tid >> 6;
    const int gh = bi & 1, cb = (bi >> 1) & 15, pr = bi >> 5, g = gh * 8 + wave, c0 = lane & 31, h = lane >> 5, lg = l * 16 + g;
    LAS bf16_t* UT = (LAS bf16_t*)lds;
    LAS bf16_t* OT = (LAS bf16_t*)(lds + 69632);
    const bf16_t* Z = (const bf16_t*)(p.ws + WS_Z);
    const bf16_t* kt = (const bf16_t*)(p.ws + WS_S5K) + (size_t)lg * 64 * 256;
    const float* ha = (const float*)(p.ws + WS_S5H2) + ((size_t)(cb * 32 + c0) * 16 + g) * 128 + 8 * h;
    const int co = c0 & 15; const float dsk = p.in[I_S5D][l * 256 + g * 16 + co];
    const int jt0 = pr, jt1 = 31 - pr, tl0 = 2 * jt0 + (c0 >> 4), tl1 = 2 * jt1 + (c0 >> 4);
    const int sm = tid >> 4, spc = tid & 15;
    const bf16_t* zst = Z + (size_t)((cb * 32 + sm) * 64) * DIN + ZCU + gh * 128 + spc * 8;
    const int ust = (sm * 136 + spc * 8) * 2;
    const int nb = (2 * jt1 + 2 + 7) >> 3;
    u32x4 pf[8];
#pragma unroll
    for (int e = 0; e < 8; ++e) pf[e] = *(const u32x4*)(zst + (size_t)e * DIN);
    f32x16 acc0 = zero16(), acc1 = zero16();
    { const bf16_t* wc0 = (const bf16_t*)(p.ws + WS_S5WC) + (((size_t)lg * 64 + tl0) * 16 + co) * 128 + 8 * h;
      const bf16_t* wc1 = (const bf16_t*)(p.ws + WS_S5WC) + (((size_t)lg * 64 + tl1) * 16 + co) * 128 + 8 * h;
      f32x4 x0[8], x1[8];
#pragma unroll
      for (int ks = 0; ks < 8; ++ks) { x0[ks] = *(const f32x4*)(ha + ks * 16); x1[ks] = *(const f32x4*)(ha + ks * 16 + 4); }
#pragma unroll
      for (int ks = 0; ks < 8; ++ks) { u32x4 w; w.x = pk2(x0[ks][0], x0[ks][1]); w.y = pk2(x0[ks][2], x0[ks][3]); w.z = pk2(x1[ks][0], x1[ks][1]); w.w = pk2(x1[ks][2], x1[ks][3]);
        const bf16x8 af = __builtin_bit_cast(bf16x8, w);
        acc0 = __builtin_amdgcn_mfma_f32_32x32x16_bf16(af, ldg8(wc0 + ks * 16), acc0, 0, 0, 0);
        acc1 = __builtin_amdgcn_mfma_f32_32x32x16_bf16(af, ldg8(wc1 + ks * 16), acc1, 0, 0, 0); } }
    __syncthreads();
    for (int b = 0; b < nb; ++b) { const int s0 = 8 * b;
#pragma unroll
        for (int e = 0; e < 8; ++e) *(LAS u32x4*)(lds + ust + e * (32 * 136 * 2)) = pf[e];
        __syncthreads();
        if (b + 1 < nb) {
#pragma unroll
            for (int e = 0; e < 8; ++e) pf[e] = *(const u32x4*)(zst + (size_t)(s0 + 8 + e) * DIN); }
        const bool use0 = s0 <= 2 * jt0 + 1;
        bf16x8 b0[8], b1[8];
#pragma unroll
        for (int e = 0; e < 8; ++e) { const int d1 = tl1 - (s0 + e); b1[e] = ldg8(kt + ((size_t)(d1 < 0 ? 0 : d1) * 16 + co) * 16 + 8 * h);
            if (use0) { const int d0 = tl0 - (s0 + e); b0[e] = ldg8(kt + ((size_t)(d0 < 0 ? 0 : d0) * 16 + co) * 16 + 8 * h); } }
#pragma unroll
        for (int e = 0; e < 8; ++e) { const bf16x8 af = *(const LAS bf16x8*)(UT + (e * 32 + c0) * 136 + wave * 16 + 8 * h);
            const int d1 = tl1 - (s0 + e); bf16x8 bb = b1[e]; if (d1 < 0) bb = (bf16x8){0, 0, 0, 0, 0, 0, 0, 0};
            acc1 = __builtin_amdgcn_mfma_f32_32x32x16_bf16(af, bb, acc1, 0, 0, 0);
            if (use0) { const int d0 = tl0 - (s0 + e); bf16x8 ba = b0[e]; if (d0 < 0) ba = (bf16x8){0, 0, 0, 0, 0, 0, 0, 0};
                acc0 = __builtin_amdgcn_mfma_f32_32x32x16_bf16(af, ba, acc0, 0, 0, 0); } }
        __syncthreads();
    }
#pragma unroll
    for (int q = 0; q < 2; ++q) { const int tl = q ? tl1 : tl0;
#pragma unroll
        for (int i = 0; i < 16; ++i) { const int m = crow(i, h); const size_t tok = (size_t)(cb * 32 + m) * 64 + tl; const float u = bf2f(Z[tok * DIN + ZCU + g * 16 + co]);
            const float y = (q ? acc1[i] : acc0[i]) + dsk * u; const float ge = y * sigmoidf_(1.5957691216057308f * (y + 0.044715f * y * y * y));
            OT[(q * 64 + m * 2 + (c0 >> 4)) * 136 + wave * 16 + co] = (bf16_t)f2bf(ge); } }
    __syncthreads();
    { const int tau = tid >> 2, qq = tau >> 6, m = (tau >> 1) & 31, t2 = tau & 1, qt = tid & 3; const int jt = qq ? jt1 : jt0;
      const size_t tok = (size_t)(cb * 32 + m) * 64 + 2 * jt + t2;
      const LAS u32x4* src = (const LAS u32x4*)(OT + tau * 136 + qt * 32); u32x4* dst = (u32x4*)((bf16_t*)(p.ws + WS_YPRE) + tok * 256 + gh * 128 + qt * 32);
#pragma unroll
      for (int e = 0; e < 4; ++e) dst[e] = src[e]; }
}

DI void attn_item(const Params& p, LAS unsigned char* lds, int l, int pt, int id) {
    int tid_o = threadIdx.x; asm volatile("" : "+v"(tid_o));
    const int tid = tid_o, lane = tid & 63, wave = tid >> 6;
    const int dil = pt == 0 ? 1 : (pt == 1 ? 4 : 16), nblk = 32 / dil;
    const int b = id >> 7, hd = (id >> 5) & 3, rn = id & 31, r = rn / nblk, n = rn % nblk;
    LAS bf16_t* Ks = (LAS bf16_t*)lds;
    LAS bf16_t* Vt = (LAS bf16_t*)(lds + 55296);
    LAS float* BT = (LAS float*)(lds + 55296 + 50176);
    const bf16_t* Z = (const bf16_t*)(p.ws + WS_Z);
    const bf16_t* OP = (const bf16_t*)(p.ws + (pt == 1 ? WS_O0 : WS_O1)); const float* LP = (const float*)(p.ws + (pt == 1 ? WS_LSE : WS_LSE1));
    bf16_t* ON = pt == 2 ? (bf16_t*)(p.ws + WS_Z) + ZOD : (bf16_t*)(p.ws + (pt == 0 ? WS_O0 : WS_O1)); const int onp = pt == 2 ? DIN : 256;
    float* LN = (float*)(p.ws + (pt == 0 ? WS_LSE : WS_LSE1));
    const size_t tokb = (size_t)b * SEQ;
    const int c0 = lane & 31, h = lane >> 5;
    const int qi = 32 * wave + c0; const size_t tokq = tokb + (size_t)(n * 256 + qi) * dil + r;
    u32x4 qraw[4]; u32x2 oprev[2][4]; float mprev = 0.f;
#pragma unroll
    for (int ks = 0; ks < 4; ++ks) qraw[ks] = *(const u32x4*)(Z + tokq * DIN + ZDQ + hd * 64 + ks * 16 + 8 * h);
    if (pt > 0) { mprev = LP[tokq * 4 + hd];
#pragma unroll
        for (int vt = 0; vt < 2; ++vt)
#pragma unroll
            for (int g4 = 0; g4 < 4; ++g4) oprev[vt][g4] = *(const u32x2*)(OP + tokq * 256 + hd * 64 + 32 * vt + 8 * g4 + 4 * h); }
    __syncthreads();
    if (tid < 132) BT[tid] = ((const float*)(p.ws + WS_BIAS))[(pt * 4 + hd) * 132 + tid];
    { const float* kg = p.in[I_KG] + l * 64 + (tid & 7) * 8; float kgv[8];
#pragma unroll
      for (int e = 0; e < 8; ++e) kgv[e] = kg[e];
      u32x4 kwv[6], vwv[6];
#pragma unroll
      for (int it = 0; it < 6; ++it) { const int idx = tid + 512 * it, row = idx >> 3, c = idx & 7, si = n * 256 - 128 + row;
        const size_t tok = tokb + (size_t)(si < 0 ? 0 : si) * dil + r;
        kwv[it] = *(const u32x4*)(Z + tok * DIN + ZDK + hd * 64 + c * 8); vwv[it] = *(const u32x4*)(Z + tok * DIN + ZDV + hd * 64 + c * 8); }
#pragma unroll
      for (int it = 0; it < 6; ++it) { const int idx = tid + 512 * it, row = idx >> 3, c = idx & 7, si = n * 256 - 128 + row;
        u32x4 kw = kwv[it], vw = vwv[it];
        if (si < 0) { kw = (u32x4){0u, 0u, 0u, 0u}; vw = (u32x4){0u, 0u, 0u, 0u}; }
        float kf[8]; kf[0] = bflo(kw.x); kf[1] = bfhi(kw.x); kf[2] = bflo(kw.y); kf[3] = bfhi(kw.y); kf[4] = bflo(kw.z); kf[5] = bfhi(kw.z); kf[6] = bflo(kw.w); kf[7] = bfhi(kw.w);
        float ss = 0.f;
#pragma unroll
        for (int e = 0; e < 8; ++e) ss += kf[e] * kf[e];
        ss += __shfl_xor(ss, 1); ss += __shfl_xor(ss, 2); ss += __shfl_xor(ss, 4);
        const float rs = rsqrtf(ss * (1.0f / 64.0f) + EPS);
        u32x4 o; o.x = pk2(kf[0] * rs * kgv[0], kf[1] * rs * kgv[1]); o.y = pk2(kf[2] * rs * kgv[2], kf[3] * rs * kgv[3]); o.z = pk2(kf[4] * rs * kgv[4], kf[5] * rs * kgv[5]); o.w = pk2(kf[6] * rs * kgv[6], kf[7] * rs * kgv[7]);
        *(LAS u32x4*)(Ks + row * 72 + c * 8) = o;
        LAS bf16_t* vp = Vt + (c * 8) * 392 + row;
        vp[0 * 392] = (bf16_t)(vw.x & 0xffffu); vp[1 * 392] = (bf16_t)(vw.x >> 16); vp[2 * 392] = (bf16_t)(vw.y & 0xffffu); vp[3 * 392] = (bf16_t)(vw.y >> 16);
        vp[4 * 392] = (bf16_t)(vw.z & 0xffffu); vp[5 * 392] = (bf16_t)(vw.z >> 16); vp[6 * 392] = (bf16_t)(vw.w & 0xffffu); vp[7 * 392] = (bf16_t)(vw.w >> 16); } }
    __syncthreads();
    bf16x8 qf[4];
    { float qv[4][8]; float ss = 0.f;
#pragma unroll
      for (int ks = 0; ks < 4; ++ks) { const u32x4 w = qraw[ks];
        qv[ks][0] = bflo(w.x); qv[ks][1] = bfhi(w.x); qv[ks][2] = bflo(w.y); qv[ks][3] = bfhi(w.y); qv[ks][4] = bflo(w.z); qv[ks][5] = bfhi(w.z); qv[ks][6] = bflo(w.w); qv[ks][7] = bfhi(w.w);
#pragma unroll
        for (int e = 0; e < 8; ++e) ss += qv[ks][e] * qv[ks][e]; }
      ss += __shfl_xor(ss, 32);
      const float rs = rsqrtf(ss * (1.0f / 64.0f) + EPS) * 0.125f;
#pragma unroll
      for (int ks = 0; ks < 4; ++ks) { const float* qg = p.in[I_QG] + l * 64 + ks * 16 + 8 * h; const f32x4 g0 = *(const f32x4*)qg, g1 = *(const f32x4*)(qg + 4);
        u32x4 w; w.x = pk2(qv[ks][0] * rs * g0[0], qv[ks][1] * rs * g0[1]); w.y = pk2(qv[ks][2] * rs * g0[2], qv[ks][3] * rs * g0[3]);
        w.z = pk2(qv[ks][4] * rs * g1[0], qv[ks][5] * rs * g1[1]); w.w = pk2(qv[ks][6] * rs * g1[2], qv[ks][7] * rs * g1[3]);
        qf[ks] = __builtin_bit_cast(bf16x8, w); } }
    f32x16 acc[5];
#pragma unroll
    for (int c = 0; c < 5; ++c) { acc[c] = zero16(); const LAS bf16_t* kb = Ks + (32 * wave + 32 * c + c0) * 72 + 8 * h;
#pragma unroll
        for (int ks = 0; ks < 4; ++ks) acc[c] = __builtin_amdgcn_mfma_f32_32x32x16_bf16(*(const LAS bf16x8*)(kb + ks * 16), qf[ks], acc[c], 0, 0, 0); }
    float mx = -1e30f;
#pragma unroll
    for (int c = 0; c < 5; ++c)
#pragma unroll
        for (int i = 0; i < 16; ++i) { const int kr = crow(i, h); const int delta = 128 + c0 - 32 * c - kr; const int jl = 32 * wave + 32 * c + kr;
            const bool valid = (delta >= 0) && (delta <= 128) && (n * 256 - 128 + jl >= 0);
            const int dcl = delta < 0 ? 0 : (delta > 128 ? 128 : delta);
            const float lgt = valid ? acc[c][i] + BT[dcl] : -1e30f; acc[c][i] = lgt; mx = fmaxf(mx, lgt); }
    mx = fmaxf(mx, __shfl_xor(mx, 32));
    float mnew = mx;
    if (pt > 0) mnew = fmaxf(mx, mprev);
    float lsum = 0.f;
#pragma unroll
    for (int c = 0; c < 5; ++c)
#pragma unroll
        for (int i = 0; i < 16; ++i) { const float pv = __expf(acc[c][i] - mnew); acc[c][i] = pv; lsum += pv; }
    lsum += __shfl_xor(lsum, 32);
    f32x16 o[2]; o[0] = zero16(); o[1] = zero16();
#pragma unroll
    for (int c = 0; c < 5; ++c)
#pragma unroll
        for (int s = 0; s < 2; ++s) { u32x4 pw; pw.x = pk2(acc[c][8 * s + 0], acc[c][8 * s + 1]); pw.y = pk2(acc[c][8 * s + 2], acc[c][8 * s + 3]); pw.z = pk2(acc[c][8 * s + 4], acc[c][8 * s + 5]); pw.w = pk2(acc[c][8 * s + 6], acc[c][8 * s + 7]);
            const bf16x8 pf = __builtin_bit_cast(bf16x8, pw);
#pragma unroll
            for (int vt = 0; vt < 2; ++vt) { const LAS bf16_t* va = Vt + (32 * vt + c0) * 392 + 32 * wave + 32 * c + 16 * s + 4 * h;
                const s16x4 lo = *(const LAS s16x4*)va, hi = *(const LAS s16x4*)(va + 8);
                const bf16x8 vf = __builtin_shufflevector(lo, hi, 0, 1, 2, 3, 4, 5, 6, 7);
                o[vt] = __builtin_amdgcn_mfma_f32_32x32x16_bf16(vf, pf, o[vt], 0, 0, 0); } }
    float sp = 0.f; if (pt > 0) sp = __expf(mprev - mnew);
    const float ltot = lsum + sp, inv = 1.0f / ltot;
#pragma unroll
    for (int vt = 0; vt < 2; ++vt)
#pragma unroll
        for (int g4 = 0; g4 < 4; ++g4) { const int ch = hd * 64 + 32 * vt + 8 * g4 + 4 * h; bf16_t* yo = ON + tokq * onp + ch;
            float v0 = o[vt][4 * g4 + 0], v1 = o[vt][4 * g4 + 1], v2 = o[vt][4 * g4 + 2], v3 = o[vt][4 * g4 + 3];
            if (pt > 0) { const u32x2 w = oprev[vt][g4]; v0 += sp * bflo(w.x); v1 += sp * bfhi(w.x); v2 += sp * bflo(w.y); v3 += sp * bfhi(w.y); }
            u32x2 w; w.x = pk2(v0 * inv, v1 * inv); w.y = pk2(v2 * inv, v3 * inv); *(u32x2*)yo = w; }
    if (h == 0 && pt < 2) __hip_atomic_store(LN + tokq * 4 + hd, mnew + __logf(ltot), __ATOMIC_RELAXED, __HIP_MEMORY_SCOPE_AGENT);
}

#define RLX_AGENT __ATOMIC_RELAXED, __HIP_MEMORY_SCOPE_AGENT
#define XB_TMO      128
#define XB_XCNT(j)  (256  + 64 * (j))
#define XB_XSUB(j)  (1280 + 64 * (j))
#define XB_XGEN(j)  (2304 + 64 * (j))
#define XB_TOP      3328
#define XB_TOPGEN   3392
#define XCD_BAR_WORDS 3456
#define XB_SPIN_CAP (1u << 18)

__device__ __forceinline__ unsigned xb_ld(unsigned* p)              { return __hip_atomic_load(p, __ATOMIC_RELAXED, __HIP_MEMORY_SCOPE_AGENT); }
__device__ __forceinline__ unsigned xb_add(unsigned* p, unsigned v) { return __hip_atomic_fetch_add(p, v, __ATOMIC_RELAXED, __HIP_MEMORY_SCOPE_AGENT); }
__device__ __forceinline__ unsigned xb_xcc_id() { return (unsigned)__builtin_amdgcn_s_getreg((3 << 11) | 20) & 0xFu; }
#define XB_SPIN(cond, bar) do { unsigned _sp = 0; while (cond) { __builtin_amdgcn_s_sleep(1); \
    if ((++_sp & 255u) == 0u) { if (xb_ld(&(bar)[XB_TMO])) break; if (_sp > XB_SPIN_CAP) { atomicAdd(&(bar)[XB_TMO], 1u); break; } } } } while (0)

struct XcdBarrier {
    unsigned* bar; unsigned x;
    volatile LAS unsigned* st;
};

__device__ __forceinline__ XcdBarrier xcd_barrier_post(unsigned* bar, volatile LAS unsigned* st) {
    XcdBarrier b; b.bar = bar; b.x = xb_xcc_id(); b.st = st;
    if (threadIdx.x == 0) (void)xb_add(&bar[XB_XCNT(b.x)], 1u);
    return b;
}
__device__ __forceinline__ void xcd_barrier_complete(unsigned* bar, unsigned x, unsigned& nloc, unsigned& nx) {
    const unsigned G = gridDim.x * gridDim.y * gridDim.z;
    unsigned sum, cnt, mine, sp = 0u;
    for (;;) {
        sum = 0u; cnt = 0u; mine = 0u;
#pragma unroll
        for (unsigned j = 0; j < 16; ++j) { const unsigned c = xb_ld(&bar[XB_XCNT(j)]); sum += c; cnt += (c > 0u) ? 1u : 0u; mine = (j == x) ? c : mine; }
        if (sum == G) break;
        __builtin_amdgcn_s_sleep(1);
        if ((++sp & 255u) == 0u) { if (xb_ld(&bar[XB_TMO])) break; if (sp > XB_SPIN_CAP) { atomicAdd(&bar[XB_TMO], 1u); break; } }
    }
    nloc = mine > 0u ? mine : 1u; nx = cnt > 0u ? cnt : 1u;
}

__device__ __forceinline__ void xcd_barrier(const XcdBarrier& b) {
    asm volatile("s_waitcnt vmcnt(0)" ::: "memory");
    __syncthreads();
    if (threadIdx.x == 0) {
        unsigned* bar = b.bar;
        __builtin_amdgcn_s_waitcnt(0);
        unsigned nloc = b.st[0], nx = b.st[1];
        if (nloc == 0u) { xcd_barrier_complete(bar, b.x, nloc, nx); b.st[0] = nloc; b.st[1] = nx; }
        const unsigned old = xb_add(&bar[XB_XSUB(b.x)], 1u);
        const unsigned gen = old / nloc;
        if (old + 1u == (gen + 1u) * nloc) {
            __builtin_amdgcn_fence(__ATOMIC_RELEASE, "agent");
            asm volatile("s_waitcnt vmcnt(0)" ::: "memory");
            const unsigned og = xb_add(&bar[XB_TOP], 1u);
            const unsigned tg = og / nx;
            if (og + 1u == (tg + 1u) * nx) xb_add(&bar[XB_TOPGEN], 1u);
            else XB_SPIN(xb_ld(&bar[XB_TOPGEN]) == tg, bar);
            __builtin_amdgcn_fence(__ATOMIC_ACQUIRE, "agent");
            xb_add(&bar[XB_XGEN(b.x)], 1u);
            asm volatile("s_waitcnt vmcnt(0)" ::: "memory");
        } else {
            XB_SPIN(xb_ld(&bar[XB_XGEN(b.x)]) == gen, bar);
            __builtin_amdgcn_fence(__ATOMIC_ACQUIRE, "agent");
            asm volatile("s_waitcnt vmcnt(0)" ::: "memory");
        }
    }
    __syncthreads();
}

#ifndef REP_A
#define REP_A 0
#endif
#ifndef REP_B
#define REP_B 0
#endif
#ifndef REP_C
#define REP_C 0
#endif
#ifndef REP_D
#define REP_D 0
#endif
#ifndef MIX_A
#define MIX_A 1
#endif
#ifndef MIX_B
#define MIX_B 1
#endif
#ifndef MIX_C
#define MIX_C 1
#endif
#ifndef MIX_D
#define MIX_D 1
#endif
__global__ void __launch_bounds__(512, 2) hybrid_fwd(Params p) {
    extern __shared__ __attribute__((aligned(16))) unsigned char lds_raw[];
    LAS unsigned char* lds = (LAS unsigned char*)lds_raw;
    cg::grid_group grid = cg::this_grid();
    { volatile LAS unsigned* st0 = (volatile LAS unsigned*)(lds + LDS_BYTES - 64); if (threadIdx.x < 2) st0[threadIdx.x] = 0u; }
    __syncthreads();
    (void)xcd_barrier_post((unsigned*)(p.ws + WS_BAR), (volatile LAS unsigned*)(lds + LDS_BYTES - 64));
    const int G = gridDim.x, bid = blockIdx.x;
    unsigned char* ws = p.ws;
    bf16_t* XB = (bf16_t*)(ws + WS_XB); bf16_t* Zb = (bf16_t*)(ws + WS_Z); bf16_t* YC_ = (bf16_t*)(ws + WS_YCAT); bf16_t* HM = (bf16_t*)(ws + WS_HM);
    float* SSQP = (float*)(ws + WS_SSQP);

#define GRID_SYNC_() do { asm volatile("s_waitcnt vmcnt(0) lgkmcnt(0)" ::: "memory"); grid.sync(); if (threadIdx.x < 64) { __builtin_amdgcn_fence(__ATOMIC_ACQUIRE, "agent"); asm volatile("s_waitcnt vmcnt(0)" ::: "memory"); } __syncthreads(); } while (0)
#define XBAR_ONCE() do { XcdBarrier b_; b_.bar = (unsigned*)(p.ws + WS_BAR); b_.x = xb_xcc_id(); b_.st = (volatile LAS unsigned*)(lds + LDS_BYTES - 64); xcd_barrier(b_); } while (0)
#ifdef REP_SYNC
#define GRID_SYNC() do { XBAR_ONCE(); XBAR_ONCE(); } while (0)
#else
#define GRID_SYNC() XBAR_ONCE()
#endif
    prologue(p, lds, G);
#ifdef REP_PRO
    GRID_SYNC_(); prologue(p, lds, G);
#endif
#ifdef NANFILL
    { u32x4* q = (u32x4*)(ws + WS_S5H); const size_t n16 = (WS_END - WS_S5H) / 16; const u32x4 nanv = (u32x4){0xffffffffu, 0xffffffffu, 0xffffffffu, 0xffffffffu};
      for (size_t i = (size_t)bid * 512 + threadIdx.x; i < n16; i += (size_t)G * 512) q[i] = nanv;
      u32x4* q2 = (u32x4*)(ws + WS_LSE); const size_t m16 = (WS_S5K - WS_LSE) / 16;
      for (size_t i = (size_t)bid * 512 + threadIdx.x; i < m16; i += (size_t)G * 512) q2[i] = nanv; }
#endif
    if (gridDim.y == 0x7fffffffu) GRID_SYNC_();
    GRID_SYNC();

#ifndef NL_RUN
#define NL_RUN NL
#endif
#ifndef DUMP_LAYER
#define DUMP_LAYER 0
#endif
    for (int lrun = 0; lrun < NL_RUN; ++lrun) {
#ifdef SAME_LAYER
        const int l = 0; const bool firstl = (lrun == 0), lastl = (lrun == NL_RUN - 1);
#else
        const int l = lrun; const bool firstl = (lrun == 0), lastl = (lrun == NL_RUN - 1);
#endif
#define RS_TABLE(SSQ_, NUNITS_) \
          { pg8::Unit ua_, ub_; (void)S.next(0, ua_); (void)S.next((NUNITS_) - 1, ub_); \
              int tq_ = threadIdx.x; asm volatile("" : "+v"(tq_)); const int pm_ = (tq_ >> 8) ? ub_.pm : ua_.pm; \
              const f32x4* sq_ = (const f32x4*)((SSQ_) + ((size_t)pm_ * 256 + (tq_ & 255)) * 16); const f32x4 q0 = sq_[0], q1 = sq_[1], q2 = sq_[2], q3 = sq_[3]; \
              const float tot_ = (((q0[0] + q0[1]) + (q0[2] + q0[3])) + ((q1[0] + q1[1]) + (q1[2] + q1[3]))) + (((q2[0] + q2[1]) + (q2[2] + q2[3])) + ((q3[0] + q3[1]) + (q3[2] + q3[3]))); \
              ((LAS float*)(lds + 131072))[tq_] = rsqrtf(tot_ * (1.0f / 1024.0f) + EPS); __syncthreads(); }
        { pg8::Gemm g{XB, (const bf16_t*)(ws + WS_WIN) + (size_t)l * D * DIN, T, DIN, D, D}; pg8::StaticOrder S; S.init(T, DIN, G, bid);
          RS_TABLE(SSQP, (T / 256) * (DIN / 256) / 256)
          pg8::EpiScale E{Zb, DIN, 0, (const PG8_LAS float*)(lds + 131072)};
          pg8::gemm_phase<pg8::EpiScale, pg8::StaticOrder, true, true>(lds, g, S, E);
#ifdef REPEAT_GEMM
          GRID_SYNC(); pg8::gemm_phase<pg8::EpiScale, pg8::StaticOrder, true, true>(lds, g, S, E);
#endif
        }
        GRID_SYNC();
#ifndef SKIP_MIX
        if (!(MIX_A && MIX_B && MIX_C && MIX_D)) { int tq = threadIdx.x; asm volatile("" : "+v"(tq));
          for (int m = bid * 8 + (tq >> 6); m < T; m += G * 8) { u32x2* yp = (u32x2*)(YC_ + (size_t)m * D) + (tq & 63); const u32x2 z2 = (u32x2){0u, 0u};
              if (!MIX_A) yp[0] = z2; if (!MIX_B) yp[64] = z2; if (!MIX_C) yp[128] = z2; if (!MIX_D) yp[192] = z2; } }
#ifndef MIX_REPEAT
#define MIX_REPEAT 1
#endif
        for (int rep = 0; rep < MIX_REPEAT; ++rep) {
        for (int it = bid; it < 1664; it += G) {
            if (it < 512) { if (MIX_A) { hgrn_item<false>(p, lds, l, it); if (REP_A) hgrn_item<false>(p, lds, l, it); } }
            else if (it < 1024) { if (MIX_B) { conv_item(p, lds, l, it - 512); if (REP_B) conv_item(p, lds, l, it - 512); } }
            else if (it < 1152) { if (MIX_C) { s5_local_item(p, lds, l, it - 1024); if (REP_C) s5_local_item(p, lds, l, it - 1024); } }
            else { if (MIX_D) { attn_item(p, lds, l, 0, it - 1152); if (REP_D) attn_item(p, lds, l, 0, it - 1152); } }
        }
        GRID_SYNC();
        if (bid < 128) { if (MIX_A) hgrn_scan_item(p, bid); } else if (bid < 136) { if (MIX_C) s5_scan_item(p, l, bid - 128); }
        if (bid < 136) { if (MIX_D) { attn_item(p, lds, l, 1, 376 + bid); if (REP_D) attn_item(p, lds, l, 1, 376 + bid); } }
        else for (int it = bid - 136; it < 376; it += 120) { if (MIX_D) { attn_item(p, lds, l, 1, it); if (REP_D) attn_item(p, lds, l, 1, it); } }
        GRID_SYNC();
#ifdef REP_P3
        if (bid < 128) { if (MIX_A) hgrn_scan_item(p, bid); } else if (bid < 136) { if (MIX_C) s5_scan_item(p, l, bid - 128); }
        if (bid < 136) { if (MIX_D) { attn_item(p, lds, l, 1, 376 + bid); if (REP_D) attn_item(p, lds, l, 1, 376 + bid); } }
        else for (int it = bid - 136; it < 376; it += 120) { if (MIX_D) { attn_item(p, lds, l, 1, it); if (REP_D) attn_item(p, lds, l, 1, it); } }
        GRID_SYNC();
#endif
        for (int it = bid; it < 1536; it += G) {
            if (it < 512) { if (MIX_A) { hgrn_item<true>(p, lds, l, it); if (REP_A) hgrn_item<true>(p, lds, l, it); } }
            else if (it < 1024) { if (MIX_C) { s5_out_item(p, lds, l, it - 512); if (REP_C) s5_out_item(p, lds, l, it - 512); } }
            else { if (MIX_D) { attn_item(p, lds, l, 2, it - 1024); if (REP_D) attn_item(p, lds, l, 2, it - 1024); } }
        }
        GRID_SYNC();
        }
#ifndef NO_GLU
        { pg8::Gemm g{(const bf16_t*)(ws + WS_YPRE), (const bf16_t*)(ws + WS_WGLU) + (size_t)l * 65536, T, 256, 256, 256}; pg8::StaticOrder S; S.init(T, 256, G, bid);
          pg8::EpiGlu E{(const bf16_t*)(ws + WS_YPRE), 256, YC_ + YC};
          pg8::gemm_phase<pg8::EpiGlu, pg8::StaticOrder, false, true>(lds, g, S, E); }
#endif
        { int tq = threadIdx.x; asm volatile("" : "+v"(tq)); const int lane = tq & 63; const int gw = (bid - 128) * 8 + (tq >> 6), NGW = 128 * 8;
          if (bid >= 128) for (int m = gw; m < T; m += NGW) { u32x2* yp = (u32x2*)(YC_ + (size_t)m * D + YD) + lane; const u32x2 w = *((const u32x2*)(Zb + (size_t)m * DIN + ZOD) + lane);
              const float a0 = bflo(w.x), a1 = bfhi(w.x), a2 = bflo(w.y), a3 = bfhi(w.y);
              const float ss = wave_sum((a0 * a0 + a1 * a1) + (a2 * a2 + a3 * a3)); const float rs = rsqrtf(ss * (1.0f / 256.0f) + EPS);
              u32x2 o; o.x = pk2(a0 * rs, a1 * rs); o.y = pk2(a2 * rs, a3 * rs); *yp = o; } }
        GRID_SYNC();
#endif
#ifdef REP_P5
#ifndef NO_GLU
        { pg8::Gemm g{(const bf16_t*)(ws + WS_YPRE), (const bf16_t*)(ws + WS_WGLU) + (size_t)l * 65536, T, 256, 256, 256}; pg8::StaticOrder S; S.init(T, 256, G, bid);
          pg8::EpiGlu E{(const bf16_t*)(ws + WS_YPRE), 256, YC_ + YC};
          pg8::gemm_phase<pg8::EpiGlu, pg8::StaticOrder, false, true>(lds, g, S, E); }
#endif
        { int tq = threadIdx.x; asm volatile("" : "+v"(tq)); const int lane = tq & 63; const int gw = (bid - 128) * 8 + (tq >> 6), NGW = 128 * 8;
          if (bid >= 128) for (int m = gw; m < T; m += NGW) { u32x2* yp = (u32x2*)(YC_ + (size_t)m * D + YD) + lane; const u32x2 w = *((const u32x2*)(Zb + (size_t)m * DIN + ZOD) + lane);
              const float a0 = bflo(w.x), a1 = bfhi(w.x), a2 = bflo(w.y), a3 = bfhi(w.y);
              const float ss = wave_sum((a0 * a0 + a1 * a1) + (a2 * a2 + a3 * a3)); const float rs = rsqrtf(ss * (1.0f / 256.0f) + EPS);
              u32x2 o; o.x = pk2(a0 * rs, a1 * rs); o.y = pk2(a2 * rs, a3 * rs); *yp = o; } }
        GRID_SYNC();
#endif
#ifdef DUMP_SLICE
        if (lrun == DUMP_LAYER) { int tq = threadIdx.x; asm volatile("" : "+v"(tq));
          for (int m = bid * 8 + (tq >> 6); m < T; m += G * 8) { const int ln = tq & 63;
              for (int j = 0; j < 4; ++j) { const int col = j * 256 + ln * 4; const u32x2 w = *(const u32x2*)(YC_ + (size_t)m * D + col);
                  f32x4 o = (f32x4){0.f, 0.f, 0.f, 0.f}; if (j == DUMP_SLICE) o = (f32x4){bflo(w.x), bfhi(w.x), bflo(w.y), bfhi(w.y)};
                  *(f32x4*)(p.out + (size_t)m * D + col) = o; } }
          break; }
#endif
#ifdef SKIP_MIX
        { pg8::Gemm g{Zb, (const bf16_t*)(ws + WS_WOUT) + (size_t)l * D * D, T, D, D, DIN}; pg8::StaticOrder S; S.init(T, D, G, bid);
#else
        { pg8::Gemm g{YC_, (const bf16_t*)(ws + WS_WOUT) + (size_t)l * D * D, T, D, D, D}; pg8::StaticOrder S; S.init(T, D, G, bid);
#endif
          pg8::EpiRes E{firstl ? p.in[I_X] : p.out, p.out, XB, SSQP + (size_t)T * 16};
          pg8::gemm_phase<pg8::EpiRes, pg8::StaticOrder, true, true>(lds, g, S, E); }
        GRID_SYNC();
        { pg8::Gemm g{XB, (const bf16_t*)(ws + WS_WUP) + (size_t)l * D * FF, T, FF, D, D}; pg8::StaticOrder S; S.init(T, FF, G, bid);
          RS_TABLE(SSQP + (size_t)T * 16, (T / 256) * (FF / 256) / 256)
          pg8::EpiScale E{HM, FF, 1, (const PG8_LAS float*)(lds + 131072)};
          pg8::gemm_phase<pg8::EpiScale, pg8::StaticOrder, true, true>(lds, g, S, E);
#ifdef REPEAT_GEMM
          GRID_SYNC(); pg8::gemm_phase<pg8::EpiScale, pg8::StaticOrder, true, true>(lds, g, S, E);
#endif
        }
        GRID_SYNC();
        { pg8::Gemm g{HM, (const bf16_t*)(ws + WS_WDN) + (size_t)l * D * FF, T, D, FF, FF}; pg8::StaticOrder S; S.init(T, D, G, bid);
          pg8::EpiRes E{p.out, p.out, XB, !lastl ? SSQP : nullptr};
          pg8::gemm_phase<pg8::EpiRes, pg8::StaticOrder, true, true>(lds, g, S, E); }
        if (!lastl) GRID_SYNC();
    }
}

extern "C" void kernel_launch(void* const* d_in, const int* in_sizes, int n_in, void* d_out, int out_size, void* d_ws, size_t ws_size, hipStream_t stream) {
    static int grid = 0;
    if (grid == 0) {
        if (n_in != 26 || out_size != T * D || ws_size < WS_END) { fprintf(stderr, "kernel_launch: unexpected shapes (n_in %d, out %d, ws %zu); nothing launched\n", n_in, out_size, ws_size); grid = -1; return; }
        int dev = 0, cus = 0, per_cu = 0;
        (void)hipGetDevice(&dev); (void)hipDeviceGetAttribute(&cus, hipDeviceAttributeMultiprocessorCount, dev);
        if (hipFuncSetAttribute((const void*)hybrid_fwd, hipFuncAttributeMaxDynamicSharedMemorySize, LDS_BYTES) != hipSuccess) { fprintf(stderr, "kernel_launch: hipFuncSetAttribute failed\n"); grid = -1; return; }
        if (hipOccupancyMaxActiveBlocksPerMultiprocessor(&per_cu, (const void*)hybrid_fwd, 512, LDS_BYTES) != hipSuccess || per_cu < 1) { fprintf(stderr, "kernel_launch: occupancy query gave %d\n", per_cu); per_cu = 1; }
        (void)hipGetLastError();
        if (cus <= 0) cus = 256;
        grid = cus * per_cu;
    }
    if (grid < 0) return;
    if (hipMemsetAsync((char*)d_ws + WS_BAR, 0, XCD_BAR_WORDS * 4, stream) != hipSuccess) { fprintf(stderr, "kernel_launch: hipMemsetAsync of the barrier words failed\n"); return; }
    static int rs_ok = -1;
    if (rs_ok < 0) { rs_ok = (grid == 256) ? 1 : 0;
        const int ncol[2] = {DIN / 256, FF / 256};
        for (int ph = 0; ph < 2 && rs_ok; ++ph) { const int nun = (T / 256) * ncol[ph] / 256;
            for (int c = 0; c < grid && rs_ok; ++c) { pg8::StaticOrder S; S.init(T, ncol[ph] * 256, grid, c); pg8::Unit u0, u1, ui; if (!S.next(0, u0) || !S.next(nun - 1, u1) || S.next(nun, ui)) { rs_ok = 0; break; }
                if (((u0.pm >> 3) & 1) != 0 || ((u1.pm >> 3) & 1) != 1) { rs_ok = 0; break; }
                for (int i = 0; i < nun; ++i) { S.next(i, ui); if (ui.pm != (((ui.pm >> 3) & 1) ? u1.pm : u0.pm)) { rs_ok = 0; break; } } } } }
    Params a{};
    for (int i = 0; i < 26; ++i) a.in[i] = (const float*)d_in[i];
    if (!rs_ok) { fprintf(stderr, "kernel_launch: unit order does not keep a workgroup inside two row panels (grid %d); nothing launched\n", grid); return; }
    a.out = (float*)d_out; a.ws = (unsigned char*)d_ws; a.rs_lds = rs_ok; a.pad = 0;
    void* args[] = {&a};
    hipError_t e = hipLaunchCooperativeKernel((const void*)hybrid_fwd, dim3(grid), dim3(512), args, LDS_BYTES, stream);
    if (e != hipSuccess) fprintf(stderr, "cooperative launch failed: %s (grid %d)\n", hipGetErrorString(e), grid);
}
```

```cpp
#include <hip/hip_runtime.h>
#include <hip/hip_cooperative_groups.h>
#include <cstdio>
#include <cstdint>
namespace cg = cooperative_groups;

#define DI __device__ __forceinline__
#define LAS __attribute__((address_space(3)))
typedef unsigned short bf16_t;
typedef short bf16x8 __attribute__((ext_vector_type(8)));
typedef short s16x4 __attribute__((ext_vector_type(4)));
typedef float f32x4 __attribute__((ext_vector_type(4)));
typedef float f32x16 __attribute__((ext_vector_type(16)));
typedef unsigned u32x4 __attribute__((ext_vector_type(4)));
typedef unsigned u32x2 __attribute__((ext_vector_type(2)));

constexpr int NB = 4, SEQ = 8192, T = NB * SEQ, D = 1024, DIN = 2560, FF = 4096, NL = 4;
constexpr int ZQ = 0, ZF = 256, ZI = 512, ZG = 768, ZBV = 1024, ZBG = 1280, ZCU = 1536, ZDQ = 1792, ZDK = 2048, ZDV = 2304;
constexpr int YA = 0, YB = 256, YC = 512, YD = 768;
constexpr int ZOD = ZBG;
constexpr float EPS = 1e-6f;
constexpr size_t MiB = 1u << 20;
constexpr size_t WS_WIN = 0, WS_WOUT = 20 * MiB, WS_WUP = 28 * MiB, WS_WDN = 60 * MiB, WS_WGLU = 92 * MiB;
constexpr size_t WS_LB = 93 * MiB;
constexpr size_t WS_BIAS = WS_LB + 4096;
constexpr size_t WS_BAR = WS_LB + 32768;
constexpr size_t WS_SSQ = WS_LB + 65536;
constexpr size_t WS_LSE = WS_SSQ + 8 * (size_t)T * 4;
constexpr size_t WS_DEC = WS_LSE + (size_t)T * 16;
constexpr size_t WS_LSE1 = WS_DEC + 2048 * 64 * 4;
constexpr size_t WS_S5K = 96 * MiB;
constexpr size_t WS_S5WS = 98 * MiB;
constexpr size_t WS_S5WC = 114 * MiB;
constexpr size_t WS_XB = 130 * MiB;
constexpr size_t WS_S5H = 194 * MiB;
constexpr size_t WS_HM = 198 * MiB;
constexpr size_t WS_Z = 198 * MiB;
constexpr size_t WS_YCAT = 358 * MiB;
constexpr size_t WS_SL = 422 * MiB, WS_SL2 = 438 * MiB;
constexpr size_t WS_S5H2 = 454 * MiB;
constexpr size_t WS_O0 = 458 * MiB, WS_O1 = 474 * MiB;
constexpr size_t WS_YPRE = 490 * MiB;
constexpr size_t WS_SSQP = 506 * MiB;
constexpr size_t WS_END = 510 * MiB;
static_assert(WS_LSE1 + (size_t)T * 16 <= WS_S5K, "misc region");

constexpr int LDS_BYTES = 147456;

DI unsigned f2bf(float f) { unsigned u = __builtin_bit_cast(unsigned, f); return (u + 0x7fffu + ((u >> 16) & 1u)) >> 16; }
typedef float f32x2_t __attribute__((ext_vector_type(2))); typedef __bf16 bf16x2_t __attribute__((ext_vector_type(2)));
DI unsigned pk2(float lo, float hi) { const f32x2_t v = {lo, hi}; const bf16x2_t b = __builtin_convertvector(v, bf16x2_t); return __builtin_bit_cast(unsigned, b); }
DI float bf2f(bf16_t v) { return __builtin_bit_cast(float, (unsigned)v << 16); }
DI float bflo(unsigned w) { return __builtin_bit_cast(float, w << 16); }
DI float bfhi(unsigned w) { return __builtin_bit_cast(float, w & 0xffff0000u); }
DI float sigmoidf_(float x) { return 1.f / (1.f + __expf(-x)); }
DI float wave_sum(float v) {
#pragma unroll
    for (int o = 1; o < 64; o <<= 1) v += __shfl_xor(v, o);
    return v;
}
DI float half_sum(float v) {
#pragma unroll
    for (int o = 1; o < 32; o <<= 1) v += __shfl_xor(v, o);
    return v;
}
#define LDS_WAIT() asm volatile("s_waitcnt lgkmcnt(0)" ::: "memory")
DI int crow(int reg, int h) { return (reg & 3) + 8 * (reg >> 2) + 4 * h; }

template <int K>
DI f32x16 mma_lds(const LAS bf16_t* A, int lda, const LAS bf16_t* B, int ldb, f32x16 acc, int lane) {
    const int r = lane & 31, h = lane >> 5;
    const LAS bf16_t* ap = A + r * lda + 8 * h; const LAS bf16_t* bp = B + r * ldb + 8 * h;
#pragma unroll
    for (int k0 = 0; k0 < K; k0 += 16) {
        const bf16x8 a = *(const LAS bf16x8*)(ap + k0); const bf16x8 b = *(const LAS bf16x8*)(bp + k0);
        acc = __builtin_amdgcn_mfma_f32_32x32x16_bf16(a, b, acc, 0, 0, 0);
    }
    return acc;
}
DI f32x16 zero16() { f32x16 z;
#pragma unroll
    for (int i = 0; i < 16; ++i) z[i] = 0.f;
    return z; }

namespace pg8 {
#define PG8_LAS __attribute__((address_space(3)))
constexpr int BM = 256, BK = 64, HALF = 128, HTB = HALF * BK * 2, STAGE_BYTES = 8 * HTB, NXCD = 8, WGM = 8;
__host__ __device__ __forceinline__ int lds_byte(int r, int c) { const int st = (r >> 4) * 2 + (c >> 5), rr = r & 15, cc = c & 31, ob = rr * 64 + cc * 2; return st * 1024 + (ob ^ (((ob >> 9) & 1) << 5)); }
__host__ __device__ __forceinline__ void stage_rc(int b, int& R, int& C) { const int st = b / 1024, sb = b % 1024, swz = sb ^ (((sb >> 9) & 1) << 5); R = (st >> 1) * 16 + swz / 64; C = (st & 1) * 32 + (swz % 64) / 2; }
__host__ __device__ __forceinline__ int perm32(int rho) { const int n = rho >> 4, i = rho & 15; return 8 * (i >> 2) + 4 * n + (i & 3); }
struct Unit { int pm, pn; };
struct Gemm { const bf16_t* A; const bf16_t* Bt; int M, N, K, lda; };
struct StaticOrder {
    int nM, nN, nwg, G, c;
    __host__ __device__ __forceinline__ void init(int M, int N, int G_, int c_) { nM = M / BM; nN = N / BM; nwg = nM * nN; G = G_; c = c_; }
    __host__ __device__ __forceinline__ bool next(int i, Unit& u) const {
        const long L = (long)i * G + c; if (L >= nwg) return false;
        int wgid = (int)L; { const int q = nwg / NXCD, r = nwg % NXCD, xcd = wgid % NXCD, off = wgid / NXCD; wgid = (xcd < r ? xcd * (q + 1) : r * (q + 1) + (xcd - r) * q) + off; }
        const int nig = WGM * nN, gid = wgid / nig, fm = gid * WGM, gsz = (nM - fm) < WGM ? (nM - fm) : WGM;
        u.pm = fm + ((wgid % nig) % gsz); u.pn = (wgid % nig) / gsz; return true;
    }
    __device__ __forceinline__ void a_ready(const Unit&) const {}
    __device__ __forceinline__ void done(const Unit&) const {}
};
struct EpiScale {
    static constexpr bool PERM = true, AFTER_DRAIN = false;
    bf16_t* O; int ldc; int act; const PG8_LAS float* rsl;
    __device__ __forceinline__ void operator()(const f32x4 (&acc)[2][2][4][2], const Unit& u, int wr, int wc, int fr, int fq) const {
        const int row0 = u.pm * BM + wr * 64 + fr; const int col0 = u.pn * BM + wc * 32 + 8 * fq;
        const int slot = ((u.pm >> 3) & 1) * 256;
#pragma unroll
        for (int ai = 0; ai < 2; ++ai)
#pragma unroll
            for (int m = 0; m < 4; ++m) { const int r = row0 + ai * HALF + m * 16; float rs;
                rs = rsl[slot + ai * HALF + wr * 64 + m * 16 + fr];
                bf16_t* rowp = O + (size_t)r * ldc + col0;
#pragma unroll
                for (int bj = 0; bj < 2; ++bj) { f32x4 v0 = acc[ai][bj][m][0] * rs, v1 = acc[ai][bj][m][1] * rs;
                    if (act) {
#pragma unroll
                        for (int e = 0; e < 4; ++e) { const float a = fmaxf(v0[e], 0.f), b = fmaxf(v1[e], 0.f); v0[e] = a * a; v1[e] = b * b; } }
                    u32x4 w; w.x = pk2(v0[0], v0[1]); w.y = pk2(v0[2], v0[3]); w.z = pk2(v1[0], v1[1]); w.w = pk2(v1[2], v1[3]);
                    *(u32x4*)(rowp + bj * HALF) = w; } }
    }
};
struct EpiRes {
    static constexpr bool PERM = false, AFTER_DRAIN = false;
    const float* base; float* out; bf16_t* xb; float* ssq_out;
    __device__ __forceinline__ void operator()(const f32x4 (&acc)[2][2][4][2], const Unit& u, int wr, int wc, int fr, int fq) const {
        const int col0 = u.pn * BM + wc * 32 + 4 * fq;
#pragma unroll
        for (int ai = 0; ai < 2; ++ai) {
            f32x4 bv[4][2][2];
#pragma unroll
            for (int m = 0; m < 4; ++m) { const size_t off = (size_t)(u.pm * BM + ai * HALF + wr * 64 + m * 16 + fr) * D + col0;
#pragma unroll
                for (int bj = 0; bj < 2; ++bj)
#pragma unroll
                    for (int n = 0; n < 2; ++n) bv[m][bj][n] = *(const f32x4*)(base + off + bj * HALF + n * 16); }
#pragma unroll
            for (int m = 0; m < 4; ++m) { const int r = u.pm * BM + ai * HALF + wr * 64 + m * 16 + fr; const size_t off = (size_t)r * D + col0; float s = 0.f;
#pragma unroll
                for (int bj = 0; bj < 2; ++bj)
#pragma unroll
                    for (int n = 0; n < 2; ++n) { const size_t o2 = off + bj * HALF + n * 16; const f32x4 o = bv[m][bj][n] + acc[ai][bj][m][n];
                        *(f32x4*)(out + o2) = o; u32x2 w; w.x = pk2(o[0], o[1]); w.y = pk2(o[2], o[3]); *(u32x2*)(xb + o2) = w;
                        s += (o[0] * o[0] + o[1] * o[1]) + (o[2] * o[2] + o[3] * o[3]); }
                s += __shfl_xor(s, 16); s += __shfl_xor(s, 32);
                if (fq == 0 && ssq_out) ssq_out[(size_t)r * 16 + u.pn * 4 + wc] = s; } }
    }
};
struct EpiGlu {
    static constexpr bool PERM = false, AFTER_DRAIN = true;
    const bf16_t* Ysrc; int lds_; bf16_t* Y;
    __device__ __forceinline__ void fused(f32x4 (&acc)[2][2][4][2], const Unit& u, int wr, int wc, int fr, int fq, PG8_LAS unsigned char* lds, int wid, int lane) const {
        PG8_LAS float* Pp = (PG8_LAS float*)lds;
        const int col0 = wc * 32 + 4 * fq;
#pragma unroll
        for (int ai = 0; ai < 2; ++ai)
#pragma unroll
            for (int m = 0; m < 4; ++m) { const int rl = ai * HALF + wr * 64 + m * 16 + fr; const size_t off = (size_t)(u.pm * BM + rl) * lds_ + col0; float s = 0.f;
#pragma unroll
                for (int bj = 0; bj < 2; ++bj)
#pragma unroll
                    for (int n = 0; n < 2; ++n) { const u32x2 w = *(const u32x2*)(Ysrc + off + bj * HALF + n * 16); f32x4 a = acc[ai][bj][m][n];
                        const float y0 = bflo(w.x), y1 = bfhi(w.x), y2 = bflo(w.y), y3 = bfhi(w.y);
                        a[0] = y0 * sigmoidf_(a[0]); a[1] = y1 * sigmoidf_(a[1]); a[2] = y2 * sigmoidf_(a[2]); a[3] = y3 * sigmoidf_(a[3]);
                        acc[ai][bj][m][n] = a; s += (a[0] * a[0] + a[1] * a[1]) + (a[2] * a[2] + a[3] * a[3]); }
                s += __shfl_xor(s, 16); s += __shfl_xor(s, 32);
                if (fq == 0) Pp[rl * 4 + wc] = s; }
        __syncthreads();
#pragma unroll
        for (int ai = 0; ai < 2; ++ai)
#pragma unroll
            for (int m = 0; m < 4; ++m) { const int rl = ai * HALF + wr * 64 + m * 16 + fr; const size_t off = (size_t)(u.pm * BM + rl) * D + col0;
                const float tot = (Pp[rl * 4 + 0] + Pp[rl * 4 + 1]) + (Pp[rl * 4 + 2] + Pp[rl * 4 + 3]); const float rs = rsqrtf(tot * (1.0f / 256.0f) + EPS);
#pragma unroll
                for (int bj = 0; bj < 2; ++bj)
#pragma unroll
                    for (int n = 0; n < 2; ++n) { const f32x4 a = acc[ai][bj][m][n] * rs; u32x2 w; w.x = pk2(a[0], a[1]); w.y = pk2(a[2], a[3]); *(u32x2*)(Y + off + bj * HALF + n * 16) = w; } }
    }
};

template <class Epi, class Sched, bool ALIGN_EPI = false, bool SP2 = false>
__device__ __forceinline__ void gemm_phase(PG8_LAS unsigned char* lds, const Gemm g, const Sched& S, const Epi& E) {
    int tid_o = threadIdx.x; asm volatile("" : "+v"(tid_o));
    const int tid = tid_o, wid = __builtin_amdgcn_readfirstlane(tid >> 6), lane = tid & 63, wr = wid >> 2, wc = wid & 3, fr = lane & 15, fq = lane >> 4;
    const int K = g.K, nt = K / BK;
    unsigned voffA[2], voffB[2];
#pragma unroll
    for (int i = 0; i < 2; ++i) { int R, C; stage_rc(tid * 16 + i * 8192, R, C); const int Rb = Epi::PERM ? ((R & ~31) + perm32(R & 31)) : R;
        voffA[i] = (unsigned)(R * g.lda + C) * 2u; voffB[i] = (unsigned)(Rb * K + C) * 2u; }
    const size_t kstep = (size_t)(BK * 2);
    const size_t hstepA = (size_t)HALF * g.lda * 2, hstepB = (size_t)HALF * K * 2;
    const size_t tstepA = 2 * hstepA, tstepB = 2 * hstepB;
    const unsigned ldsw = (unsigned)wid * 1024u;
    const int aoff = lds_byte(wr * 64 + fr, fq * 8), boff = lds_byte(wc * 32 + fr, fq * 8);
#define PG8_SA(b, h) (((b) * 2 + (h)) * HTB)
#define PG8_SB(b, h) ((4 + (b) * 2 + (h)) * HTB)
#define PG8_STAGE(bufoff, gbase, voff) do { _Pragma("unroll") for (int _i = 0; _i < 2; ++_i) \
        __builtin_amdgcn_global_load_lds((const unsigned*)((const char*)(gbase) + (voff)[_i]), (PG8_LAS unsigned*)(lds + (bufoff) + ldsw + _i * 8192), 16, 0, 0); } while (0)
#define PG8_LDA(dst, b, h) do { _Pragma("unroll") for (int m = 0; m < 4; ++m) _Pragma("unroll") for (int k = 0; k < 2; ++k) dst[m][k] = *(const PG8_LAS bf16x8*)(lds + PG8_SA(b, h) + aoff + m * 2048 + k * 1024); } while (0)
#define PG8_LDB(dst, b, h) do { _Pragma("unroll") for (int n = 0; n < 2; ++n) _Pragma("unroll") for (int k = 0; k < 2; ++k) dst[n][k] = *(const PG8_LAS bf16x8*)(lds + PG8_SB(b, h) + boff + n * 2048 + k * 1024); } while (0)
#define PG8_MMA(ai, bj, At, Bt) do { __builtin_amdgcn_s_setprio(1); _Pragma("unroll") for (int m = 0; m < 4; ++m) _Pragma("unroll") for (int n = 0; n < 2; ++n) _Pragma("unroll") for (int k = 0; k < 2; ++k) \
        acc[ai][bj][m][n] = __builtin_amdgcn_mfma_f32_16x16x32_bf16(Bt[n][k], At[m][k], acc[ai][bj][m][n], 0, 0, 0); __builtin_amdgcn_s_setprio(0); } while (0)
#define PG8_WAIT_V(n) asm volatile("s_waitcnt vmcnt(" #n ")" ::: "memory")
#define PG8_WAIT_L(n) asm volatile("s_waitcnt lgkmcnt(" #n ")" ::: "memory")
#define PG8_BAR __builtin_amdgcn_s_barrier()
#define PG8_SCHED __builtin_amdgcn_sched_barrier(0)
    Unit cur, nxt; int ui = 0;
    if (!S.next(0, cur)) return;
    f32x4 acc[2][2][4][2];
#pragma unroll
    for (int a = 0; a < 2; ++a)
#pragma unroll
        for (int b = 0; b < 2; ++b)
#pragma unroll
            for (int m = 0; m < 4; ++m)
#pragma unroll
                for (int n = 0; n < 2; ++n) acc[a][b][m][n] = (f32x4){0.f, 0.f, 0.f, 0.f};
    bf16x8 At[4][2], B0[2][2], B1[2][2];
    const char* cA = (const char*)g.A + (size_t)cur.pm * tstepA; const char* cB = (const char*)g.Bt + (size_t)cur.pn * tstepB;
    S.a_ready(cur);
    if constexpr (SP2) {
        PG8_STAGE(PG8_SB(0, 0), cB, voffB); PG8_STAGE(PG8_SB(0, 1), cB + hstepB, voffB); PG8_STAGE(PG8_SA(0, 0), cA, voffA); PG8_STAGE(PG8_SA(0, 1), cA + hstepA, voffA);
        if (wr == 1) PG8_BAR;
        PG8_WAIT_V(2); PG8_BAR;
        PG8_STAGE(PG8_SB(1, 0), cB + kstep, voffB); PG8_STAGE(PG8_SA(1, 0), cA + kstep, voffA); PG8_STAGE(PG8_SB(1, 1), cB + hstepB + kstep, voffB);
        PG8_WAIT_V(6); PG8_BAR;
    } else {
        PG8_STAGE(PG8_SB(0, 0), cB, voffB); PG8_STAGE(PG8_SA(0, 0), cA, voffA); PG8_STAGE(PG8_SB(0, 1), cB + hstepB, voffB); PG8_STAGE(PG8_SA(0, 1), cA + hstepA, voffA);
        if (wr == 1) PG8_BAR;
        PG8_WAIT_V(4); PG8_BAR;
        PG8_STAGE(PG8_SB(1, 0), cB + kstep, voffB); PG8_STAGE(PG8_SA(1, 0), cA + kstep, voffA); PG8_STAGE(PG8_SB(1, 1), cB + hstepB + kstep, voffB);
        PG8_WAIT_V(6); PG8_BAR;
    }
    for (;;) {
        const bool has_next = S.next(ui + 1, nxt);
        const char* nA = has_next ? (const char*)g.A + (size_t)nxt.pm * tstepA : cA; const char* nB = has_next ? (const char*)g.Bt + (size_t)nxt.pn * tstepB : cB;
        for (int t = 0; t < nt; t += 2) {
            const bool last = (t == nt - 2);
            const char* a1 = cA + (size_t)(t + 1) * kstep;
            const char* a2 = last ? nA : cA + (size_t)(t + 2) * kstep; const char* b2 = last ? nB : cB + (size_t)(t + 2) * kstep;
            const char* a3 = a2 + kstep; const char* b3 = b2 + kstep;
            if (last && has_next) S.a_ready(nxt);
            if constexpr (SP2) {
            PG8_LDB(B0, 0, 0); PG8_LDB(B1, 0, 1); PG8_SCHED; PG8_LDA(At, 0, 0); PG8_STAGE(PG8_SA(1, 1), a1 + hstepA, voffA);
            PG8_WAIT_V(8); PG8_WAIT_L(0); PG8_BAR; PG8_MMA(0, 0, At, B0); PG8_MMA(0, 1, At, B1); PG8_BAR; PG8_SCHED;
            PG8_LDA(At, 0, 1); PG8_STAGE(PG8_SB(0, 0), b2, voffB); PG8_STAGE(PG8_SB(0, 1), b2 + hstepB, voffB); PG8_STAGE(PG8_SA(0, 0), a2, voffA);
            PG8_WAIT_V(8); PG8_WAIT_L(0); PG8_BAR; PG8_MMA(1, 0, At, B0); PG8_MMA(1, 1, At, B1); PG8_BAR; PG8_SCHED;
            PG8_LDB(B0, 1, 0); PG8_LDB(B1, 1, 1); PG8_SCHED; PG8_LDA(At, 1, 0); PG8_STAGE(PG8_SA(0, 1), a2 + hstepA, voffA);
            PG8_WAIT_V(8); PG8_WAIT_L(0); PG8_BAR; PG8_MMA(0, 0, At, B0); PG8_MMA(0, 1, At, B1); PG8_BAR; PG8_SCHED;
            PG8_LDA(At, 1, 1); PG8_STAGE(PG8_SB(1, 0), b3, voffB); PG8_STAGE(PG8_SB(1, 1), b3 + hstepB, voffB); PG8_STAGE(PG8_SA(1, 0), a3, voffA);
            PG8_WAIT_V(8); PG8_WAIT_L(0); PG8_BAR; PG8_MMA(1, 0, At, B0); PG8_MMA(1, 1, At, B1); PG8_BAR; PG8_SCHED;
            } else {
            PG8_LDB(B0, 0, 0); PG8_SCHED; PG8_LDA(At, 0, 0); PG8_STAGE(PG8_SA(1, 1), a1 + hstepA, voffA);
            PG8_WAIT_L(8); PG8_BAR; PG8_WAIT_L(0); PG8_MMA(0, 0, At, B0); PG8_BAR; PG8_SCHED;
            PG8_LDB(B1, 0, 1); PG8_STAGE(PG8_SB(0, 0), b2, voffB);
            PG8_BAR; PG8_WAIT_L(0); PG8_MMA(0, 1, At, B1); PG8_BAR;
            PG8_LDA(At, 0, 1); PG8_STAGE(PG8_SA(0, 0), a2, voffA);
            PG8_BAR; PG8_WAIT_L(0); PG8_MMA(1, 0, At, B0); PG8_BAR; PG8_SCHED;
            PG8_STAGE(PG8_SB(0, 1), b2 + hstepB, voffB);
            PG8_WAIT_V(6); PG8_BAR; PG8_MMA(1, 1, At, B1); PG8_BAR;
            PG8_LDB(B0, 1, 0); PG8_SCHED; PG8_LDA(At, 1, 0); PG8_STAGE(PG8_SA(0, 1), a2 + hstepA, voffA);
            PG8_WAIT_L(8); PG8_BAR; PG8_WAIT_L(0); PG8_MMA(0, 0, At, B0); PG8_BAR; PG8_SCHED;
            PG8_LDB(B1, 1, 1); PG8_STAGE(PG8_SB(1, 0), b3, voffB);
            PG8_BAR; PG8_WAIT_L(0); PG8_MMA(0, 1, At, B1); PG8_BAR;
            PG8_LDA(At, 1, 1); PG8_STAGE(PG8_SA(1, 0), a3, voffA);
            PG8_BAR; PG8_WAIT_L(0); PG8_MMA(1, 0, At, B0); PG8_BAR; PG8_SCHED;
            PG8_STAGE(PG8_SB(1, 1), b3 + hstepB, voffB);
            PG8_WAIT_V(6); PG8_BAR; PG8_MMA(1, 1, At, B1); PG8_BAR;
            }
        }
        if constexpr (ALIGN_EPI) { if (wr == 0) PG8_BAR; }
        if constexpr (!Epi::AFTER_DRAIN) { E(acc, cur, wr, wc, fr, fq); S.done(cur); }
        if (!has_next) break;
#pragma unroll
        for (int a = 0; a < 2; ++a)
#pragma unroll
            for (int b = 0; b < 2; ++b)
#pragma unroll
                for (int m = 0; m < 4; ++m)
#pragma unroll
                    for (int n = 0; n < 2; ++n) acc[a][b][m][n] = (f32x4){0.f, 0.f, 0.f, 0.f};
        cur = nxt; cA = nA; cB = nB; ++ui;
        if constexpr (ALIGN_EPI) { if (wr == 1) PG8_BAR; }
    }
    PG8_WAIT_V(0);
    if constexpr (!ALIGN_EPI) { if (wr == 0) PG8_BAR; }
    PG8_BAR;
    if constexpr (Epi::AFTER_DRAIN) { E.fused(acc, cur, wr, wc, fr, fq, lds, wid, lane); S.done(cur); }
#undef PG8_SA
#undef PG8_SB
#undef PG8_STAGE
#undef PG8_LDA
#undef PG8_LDB
#undef PG8_MMA
#undef PG8_WAIT_V
#undef PG8_WAIT_L
#undef PG8_BAR
#undef PG8_SCHED
}
}

struct Params { const float* in[26]; float* out; unsigned char* ws; int rs_lds; int pad; };
enum { I_X = 0, I_NMG, I_WIN, I_LBL, I_HNG, I_CW, I_CB, I_CLG, I_CLB, I_LRE, I_LIM, I_BRE, I_BIM, I_CRE, I_CIM, I_S5D, I_LDT, I_WGLU, I_QG, I_KG, I_RB, I_MONG, I_WOUT, I_NMLPG, I_WUP, I_WDN };

DI void p0_transpose_item(const float* W, int K, int N, bf16_t* WT, const float* gk, LAS float* scr, int item, int lane) {
    const int nblk = N / 32, kb = item / nblk, nb = item % nblk, k0 = 64 * kb, n0 = 32 * nb;
    float wv[32];
#pragma unroll
    for (int i = 0; i < 32; ++i) { const int kk = 2 * i + (lane >> 5); wv[i] = W[(size_t)(k0 + kk) * N + n0 + (lane & 31)]; }
#pragma unroll
    for (int i = 0; i < 32; ++i) { const int kk = 2 * i + (lane >> 5); const float s = gk ? gk[k0 + kk] : 1.f; scr[kk * 33 + (lane & 31)] = wv[i] * s; }
    LDS_WAIT();
    const int c = lane & 7;
#pragma unroll
    for (int j = 0; j < 4; ++j) { const int n = (lane >> 3) + 8 * j; const LAS float* s = scr + (8 * c) * 33 + n;
        u32x4 o; o.x = pk2(s[0 * 33], s[1 * 33]); o.y = pk2(s[2 * 33], s[3 * 33]); o.z = pk2(s[4 * 33], s[5 * 33]); o.w = pk2(s[6 * 33], s[7 * 33]);
        *(u32x4*)(WT + (size_t)(n0 + n) * K + k0 + 8 * c) = o; }
    LDS_WAIT();
}
DI void s5_params(const Params& p, int lg, int pp, float& lrdt, float& lidt, float& cr, float& ci) {
    const float dt = expf(p.in[I_LDT][lg]);
    const float lr = p.in[I_LRE][lg * 64 + pp], li = p.in[I_LIM][lg * 64 + pp];
    lrdt = lr * dt; lidt = li * dt;
    const float mag = expf(lrdt); const float ar = mag * cosf(lidt), ai = mag * sinf(lidt);
    const float den = lr * lr + li * li;
    cr = ((ar - 1.0f) * lr + ai * li) / den; ci = (ai * lr - (ar - 1.0f) * li) / den;
}
DI void s5_pow(float lrdt, float lidt, int n, float& er, float& ei) { const float m = expf((float)n * lrdt); const float a = (float)n * lidt; er = m * cosf(a); ei = m * sinf(a); }

DI void prologue(const Params& p, LAS unsigned char* lds, int G) {
    int tid_o = threadIdx.x; asm volatile("" : "+v"(tid_o));
    const int tid = tid_o, lane = tid & 63, wave = tid >> 6;
    const int gw = blockIdx.x * 8 + wave, NGW = G * 8;
    const int gt = blockIdx.x * 512 + tid, NGT = G * 512;
    unsigned char* ws = p.ws;
    LAS float* scr = (LAS float*)(lds + wave * 16384);
    {
        constexpr int I_IN = (D / 64) * (DIN / 32), I_OUT = (D / 64) * (D / 32), I_UP = (D / 64) * (FF / 32), I_DN = (FF / 64) * (D / 32), I_GL = (256 / 64) * (256 / 32);
        constexpr int PER_L = I_IN + I_OUT + I_UP + I_DN + I_GL;
        for (int it = gw; it < NL * PER_L; it += NGW) {
            const int l = it / PER_L; int r = it % PER_L;
            if (r < I_IN) { p0_transpose_item(p.in[I_WIN] + (size_t)l * D * DIN, D, DIN, (bf16_t*)(ws + WS_WIN) + (size_t)l * D * DIN, p.in[I_NMG] + l * D, scr, r, lane); continue; } r -= I_IN;
            if (r < I_OUT) { p0_transpose_item(p.in[I_WOUT] + (size_t)l * D * D, D, D, (bf16_t*)(ws + WS_WOUT) + (size_t)l * D * D, p.in[I_MONG] + l * D, scr, r, lane); continue; } r -= I_OUT;
            if (r < I_UP) { p0_transpose_item(p.in[I_WUP] + (size_t)l * D * FF, D, FF, (bf16_t*)(ws + WS_WUP) + (size_t)l * D * FF, p.in[I_NMLPG] + l * D, scr, r, lane); continue; } r -= I_UP;
            if (r < I_DN) { p0_transpose_item(p.in[I_WDN] + (size_t)l * D * FF, FF, D, (bf16_t*)(ws + WS_WDN) + (size_t)l * D * FF, nullptr, scr, r, lane); continue; } r -= I_DN;
            p0_transpose_item(p.in[I_WGLU] + (size_t)l * 65536, 256, 256, (bf16_t*)(ws + WS_WGLU) + (size_t)l * 65536, nullptr, scr, r, lane);
        }
    }
    {
        float* ssq0 = (float*)(ws + WS_SSQP); bf16_t* XB = (bf16_t*)(ws + WS_XB);
        for (int mb = gw * 16; mb < T; mb += NGW * 16) {
            float keep = 0.f;
#pragma unroll 4
            for (int i = 0; i < 16; ++i) { const int m = mb + i;
                const f32x4* xr = (const f32x4*)(p.in[I_X] + (size_t)m * D) + lane; f32x4 v[4]; float s = 0.f;
#pragma unroll
                for (int j = 0; j < 4; ++j) { v[j] = xr[64 * j]; s += (v[j][0] * v[j][0] + v[j][1] * v[j][1]) + (v[j][2] * v[j][2] + v[j][3] * v[j][3]); }
                s = wave_sum(s); if (lane == i) keep = s;
                u32x2* o8 = (u32x2*)(XB + (size_t)m * D) + lane;
#pragma unroll
                for (int j = 0; j < 4; ++j) { u32x2 w; w.x = pk2(v[j][0], v[j][1]); w.y = pk2(v[j][2], v[j][3]); o8[64 * j] = w; } }
#pragma unroll 1
            for (int i = 0; i < 16; ++i) { const float v = __shfl(keep, i); if (lane < 16) ssq0[(size_t)(mb + i) * 16 + lane] = lane == 0 ? v : 0.f; }
        }
    }
    {
        float* LB = (float*)(ws + WS_LB);
        for (int c = gt; c < 256; c += NGT) {
            const float a0 = p.in[I_LBL][c], a1 = p.in[I_LBL][256 + c], a2 = p.in[I_LBL][512 + c], a3 = p.in[I_LBL][768 + c];
            const float mx = fmaxf(fmaxf(a0, a1), fmaxf(a2, a3));
            const float e0 = expf(a0 - mx), e1 = expf(a1 - mx), e2 = expf(a2 - mx), e3 = expf(a3 - mx); const float inv = 1.f / (e0 + e1 + e2 + e3);
            const float s1 = e1 * inv, s2 = e2 * inv, s3 = e3 * inv; const float hi = 1.0f - 1e-6f;
            LB[c] = 0.f; LB[256 + c] = fminf(fmaxf(s1, 0.f), hi); LB[512 + c] = fminf(fmaxf(s1 + s2, 0.f), hi); LB[768 + c] = fminf(fmaxf(s1 + s2 + s3, 0.f), hi);
        }
        float* BT = (float*)(ws + WS_BIAS);
        for (int i = gt; i < 3 * 4 * 132; i += NGT) {
            const int pt = i / (4 * 132), hd = (i / 132) % 4, dl = i % 132; const int dil = pt == 0 ? 1 : (pt == 1 ? 4 : 16);
            float v = 0.f;
            if (dl <= 128) { const int dist = dl * dil; int bk;
                if (dist < 16) bk = dist; else { bk = 16 + (int)(logf((float)dist / 16.0f) / 4.852030263919617f * 16.0f); if (bk > 31) bk = 31; }
                v = p.in[I_RB][bk * 4 + hd]; }
            BT[i] = v;
        }
    }
    {
        bf16_t* KT = (bf16_t*)(ws + WS_S5K); bf16_t* WS_ = (bf16_t*)(ws + WS_S5WS); bf16_t* WC = (bf16_t*)(ws + WS_S5WC);
        LAS float* ebr = scr; LAS float* ebi = scr + 64 * 17;
        for (int it = gw; it < NL * 16 * 64; it += NGW) {
            const int lg = it >> 6, d = it & 63;
            float lrdt, lidt, cr, ci; s5_params(p, lg, lane, lrdt, lidt, cr, ci);
            float er, ei; s5_pow(lrdt, lidt, d, er, ei);
            const float fr_ = er * cr - ei * ci, fi_ = er * ci + ei * cr;
            const float* br = p.in[I_BRE] + ((size_t)lg * 64 + lane) * 16; const float* bi = p.in[I_BIM] + ((size_t)lg * 64 + lane) * 16;
#pragma unroll
            for (int c = 0; c < 16; ++c) { const float b0 = br[c], b1 = bi[c]; ebr[lane * 17 + c] = fr_ * b0 - fi_ * b1; ebi[lane * 17 + c] = fr_ * b1 + fi_ * b0; }
            LDS_WAIT();
            const int co = lane & 15, cb = (lane >> 4) * 4;
            const float* crp = p.in[I_CRE] + ((size_t)lg * 16 + co) * 64; const float* cip = p.in[I_CIM] + ((size_t)lg * 16 + co) * 64;
            float a0 = 0.f, a1 = 0.f, a2 = 0.f, a3 = 0.f;
            for (int q = 0; q < 64; ++q) { const float c0 = crp[q], c1 = cip[q];
                a0 += c0 * ebr[q * 17 + cb + 0] - c1 * ebi[q * 17 + cb + 0]; a1 += c0 * ebr[q * 17 + cb + 1] - c1 * ebi[q * 17 + cb + 1];
                a2 += c0 * ebr[q * 17 + cb + 2] - c1 * ebi[q * 17 + cb + 2]; a3 += c0 * ebr[q * 17 + cb + 3] - c1 * ebi[q * 17 + cb + 3]; }
            u32x2 w; w.x = pk2(a0, a1); w.y = pk2(a2, a3);
            *(u32x2*)(KT + ((size_t)it * 16 + co) * 16 + cb) = w;
            LDS_WAIT();
        }
        for (int it = gw; it < NL * 16 * 16; it += NGW) {
            const int lg = it >> 4, s4 = it & 15;
            float lrdt, lidt, cr, ci; s5_params(p, lg, lane, lrdt, lidt, cr, ci);
            const float* br = p.in[I_BRE] + ((size_t)lg * 64 + lane) * 16; const float* bi = p.in[I_BIM] + ((size_t)lg * 64 + lane) * 16;
            float b0[16], b1[16];
#pragma unroll
            for (int c = 0; c < 16; ++c) { b0[c] = br[c]; b1[c] = bi[c]; }
#pragma unroll 1
            for (int sq = 0; sq < 4; ++sq) { const int s = s4 * 4 + sq;
                float er, ei; s5_pow(lrdt, lidt, 63 - s, er, ei);
                const float fr_ = er * cr - ei * ci, fi_ = er * ci + ei * cr;
                float vr[16], vi[16];
#pragma unroll
                for (int c = 0; c < 16; ++c) { vr[c] = fr_ * b0[c] - fi_ * b1[c]; vi[c] = fr_ * b1[c] + fi_ * b0[c]; }
                bf16_t* o0 = WS_ + (((size_t)lg * 64 + s) * 128 + lane) * 16; bf16_t* o1 = WS_ + (((size_t)lg * 64 + s) * 128 + 64 + lane) * 16;
                u32x4 w;
                w.x = pk2(vr[0], vr[1]); w.y = pk2(vr[2], vr[3]); w.z = pk2(vr[4], vr[5]); w.w = pk2(vr[6], vr[7]); *(u32x4*)o0 = w;
                w.x = pk2(vr[8], vr[9]); w.y = pk2(vr[10], vr[11]); w.z = pk2(vr[12], vr[13]); w.w = pk2(vr[14], vr[15]); *(u32x4*)(o0 + 8) = w;
                w.x = pk2(vi[0], vi[1]); w.y = pk2(vi[2], vi[3]); w.z = pk2(vi[4], vi[5]); w.w = pk2(vi[6], vi[7]); *(u32x4*)o1 = w;
                w.x = pk2(vi[8], vi[9]); w.y = pk2(vi[10], vi[11]); w.z = pk2(vi[12], vi[13]); w.w = pk2(vi[14], vi[15]); *(u32x4*)(o1 + 8) = w; }
        }
        for (int it = gw; it < NL * 16 * 64; it += NGW) {
            const int lg = it >> 6, tl = it & 63;
            float lrdt, lidt, cr, ci; s5_params(p, lg, lane, lrdt, lidt, cr, ci);
            float er, ei; s5_pow(lrdt, lidt, tl + 1, er, ei);
#pragma unroll 4
            for (int co = 0; co < 16; ++co) { const float c0 = p.in[I_CRE][((size_t)lg * 16 + co) * 64 + lane], c1 = p.in[I_CIM][((size_t)lg * 16 + co) * 64 + lane];
                bf16_t* o = WC + (((size_t)lg * 64 + tl) * 16 + co) * 128;
                o[lane] = (bf16_t)f2bf(c0 * er - c1 * ei); o[64 + lane] = (bf16_t)f2bf(-(c0 * ei + c1 * er)); }
        }
    }
}

template <bool OUT>
DI void hgrn_item(const Params& p, LAS unsigned char* lds, int l, int cg) {
    int tid_o = threadIdx.x; asm volatile("" : "+v"(tid_o));
    const int tid = tid_o, lane = tid & 63, wave = tid >> 6, hd = wave >> 1, half = wave & 1;
    const bf16_t* Z = (const bf16_t*)(p.ws + WS_Z);
    LAS bf16_t* B0 = (LAS bf16_t*)(lds + hd * 27648); LAS bf16_t* B1 = B0 + 64 * 72; LAS bf16_t* B2 = B1 + 64 * 72;
    LAS float* GM = (LAS float*)(lds + 114688) + hd * 64; LAS float* GL = GM + 256; LAS float* SSA = (LAS float*)(lds + 114688) + 512;
    bf16_t* SL = (bf16_t*)(p.ws + WS_SL); const bf16_t* SL2 = (const bf16_t*)(p.ws + WS_SL2); float* DEC = (float*)(p.ws + WS_DEC);
    const int item = cg * 4 + hd;
#ifdef FORCE_LB0
    const float lb = 0.f, oml = 1.f;
#else
    const float lb = ((const float*)(p.ws + WS_LB))[l * 256 + hd * 64 + lane], oml = 1.f - lb;
#endif
    const int srow = tid >> 5, shd = (tid >> 3) & 3, spc = tid & 7;
    const bf16_t* zsrc = Z + (size_t)(cg * 64 + srow) * DIN + shd * 64 + spc * 8;
    const int sdst = shd * 27648 + (srow * 72 + spc * 8) * 2;
    __syncthreads();
    { u32x4 wf[4], wi[4], wq[4];
#pragma unroll
      for (int sub = 0; sub < 4; ++sub) { wf[sub] = *(const u32x4*)(zsrc + (size_t)(16 * sub) * DIN + ZF); wi[sub] = *(const u32x4*)(zsrc + (size_t)(16 * sub) * DIN + ZI);
          if (OUT) wq[sub] = *(const u32x4*)(zsrc + (size_t)(16 * sub) * DIN + ZQ); }
#pragma unroll
      for (int sub = 0; sub < 4; ++sub) { *(LAS u32x4*)(lds + sdst + 9216 + sub * 16 * 144) = wf[sub]; *(LAS u32x4*)(lds + sdst + 18432 + sub * 16 * 144) = wi[sub];
          if (OUT) *(LAS u32x4*)(lds + sdst + sub * 16 * 144) = wq[sub]; } }
    __syncthreads();
    float g[32]; float run = 0.f;
#pragma unroll
    for (int j = 0; j < 32; ++j) { const float fz = bf2f(B1[(half * 32 + j) * 72 + lane]); const float sg = sigmoidf_(fz); const float f = lb + oml * sg;
        run += __logf(fmaxf(f, 1e-30f)); g[j] = run; }
    if (half == 0) GM[lane] = run;
    __syncthreads();
    const float gm = GM[lane];
    if (half) {
#pragma unroll
        for (int j = 0; j < 32; ++j) g[j] += gm; }
    const int c0 = lane & 31, h = lane >> 5;
    if constexpr (!OUT) {
        if (half) GL[lane] = run + gm;
        __syncthreads();
        const float gl = GL[lane];
        bf16_t kv[32], ivr[32];
#pragma unroll
        for (int j = 0; j < 32; ++j) { const int t = half * 32 + j; const float e = __expf(gl - g[j]); const float kj = oml * (1.f - sigmoidf_(bf2f(B1[t * 72 + lane])));
            kv[j] = (bf16_t)f2bf(kj * e); ivr[j] = B2[t * 72 + lane]; }
        __syncthreads();
#pragma unroll
        for (int j = 0; j < 32; ++j) { const int t = half * 32 + j; B1[lane * 72 + t] = kv[j]; B2[lane * 72 + t] = ivr[j]; }
        __syncthreads();
#pragma unroll
        for (int kt = 0; kt < 2; ++kt) { const f32x16 a = mma_lds<64>(B2 + 32 * half * 72, 72, B1 + 32 * kt * 72, 72, zero16(), lane);
#pragma unroll
            for (int i = 0; i < 16; ++i) SL[(size_t)item * 4096 + (32 * half + crow(i, h)) * 64 + 32 * kt + c0] = (bf16_t)f2bf(a[i]); }
        if (half == 0) DEC[item * 64 + lane] = __expf(gl);
    } else {
        if (half == 0) GL[lane] = __expf(gm);
        bf16_t ivr[32];
#pragma unroll
        for (int j = 0; j < 32; ++j) { const int t = half * 32 + j; const float q = bf2f(B0[t * 72 + lane]); const float kj = oml * (1.f - sigmoidf_(bf2f(B1[t * 72 + lane])));
            const float e1 = __expf(fminf(g[j] - gm, 80.f)), e2 = __expf(fminf(gm - g[j], 80.f));
            ivr[j] = B2[t * 72 + lane];
            B0[t * 72 + lane] = (bf16_t)f2bf(q * e1); B1[t * 72 + lane] = (bf16_t)f2bf(kj * e2); }
        __syncthreads();
#pragma unroll
        for (int j = 0; j < 32; ++j) B2[lane * 72 + half * 32 + j] = ivr[j];
        __syncthreads();
        f32x16 s0 = mma_lds<64>(B0 + 32 * half * 72, 72, B1, 72, zero16(), lane);
        f32x16 s1 = zero16(); if (half) s1 = mma_lds<64>(B0 + 32 * half * 72, 72, B1 + 32 * 72, 72, zero16(), lane);
        __syncthreads();
#pragma unroll
        for (int i = 0; i < 16; ++i) { const int row = 32 * half + crow(i, h);
            B1[row * 72 + c0] = (bf16_t)f2bf(c0 <= row ? s0[i] : 0.f); B1[row * 72 + 32 + c0] = (bf16_t)f2bf(32 + c0 <= row ? s1[i] : 0.f); }
        __syncthreads();
        f32x16 o0 = mma_lds<64>(B1 + 32 * half * 72, 72, B2, 72, zero16(), lane);
        f32x16 o1 = mma_lds<64>(B1 + 32 * half * 72, 72, B2 + 32 * 72, 72, zero16(), lane);
        __syncthreads();
        {
          u32x4 wsl[4], wg[4];
          const bf16_t* sp = SL2 + (size_t)item * 4096 + (32 * half) * 64;
#pragma unroll
          for (int e = 0; e < 4; ++e) { const int pc = lane + 64 * e; wsl[e] = *(const u32x4*)(sp + pc * 8); wg[e] = *(const u32x4*)(zsrc + (size_t)(16 * e) * DIN + ZG); }
#pragma unroll
          for (int e = 0; e < 4; ++e) { const int pc = lane + 64 * e, row = pc >> 3, k0 = (pc & 7) * 8; const LAS float* eg = GL + k0;
              u32x4 o; o.x = pk2(bflo(wsl[e].x) * eg[0], bfhi(wsl[e].x) * eg[1]); o.y = pk2(bflo(wsl[e].y) * eg[2], bfhi(wsl[e].y) * eg[3]);
              o.z = pk2(bflo(wsl[e].z) * eg[4], bfhi(wsl[e].z) * eg[5]); o.w = pk2(bflo(wsl[e].w) * eg[6], bfhi(wsl[e].w) * eg[7]);
              *(LAS u32x4*)(B2 + (32 * half + row) * 72 + k0) = o;
              *(LAS u32x4*)(lds + sdst + 9216 + e * 16 * 144) = wg[e]; } }
        __syncthreads();
        o0 = mma_lds<64>(B0 + 32 * half * 72, 72, B2, 72, o0, lane);
        o1 = mma_lds<64>(B0 + 32 * half * 72, 72, B2 + 32 * 72, 72, o1, lane);
        const float* ng = p.in[I_HNG] + l * 256 + hd * 64; const float ng0 = ng[c0], ng1 = ng[32 + c0];
#pragma unroll
        for (int i = 0; i < 16; ++i) { const int row = 32 * half + crow(i, h);
            const float ss = half_sum(o0[i] * o0[i] + o1[i] * o1[i]); const float rs = rsqrtf(ss * (1.0f / 64.0f) + EPS);
            const float g0 = bf2f(B1[row * 72 + c0]), g1 = bf2f(B1[row * 72 + 32 + c0]);
            const float v0 = o0[i] * rs * ng0 * g0 * sigmoidf_(g0), v1 = o1[i] * rs * ng1 * g1 * sigmoidf_(g1);
            o0[i] = v0; o1[i] = v1; const float s2 = half_sum(v0 * v0 + v1 * v1); if (c0 == 0) SSA[hd * 64 + row] = s2; }
        __syncthreads();
        bf16_t* Y = (bf16_t*)(p.ws + WS_YCAT);
#pragma unroll
        for (int i = 0; i < 16; ++i) { const int row = 32 * half + crow(i, h); const size_t tok = (size_t)cg * 64 + row;
            const float tot = (SSA[row] + SSA[64 + row]) + (SSA[128 + row] + SSA[192 + row]); const float r2 = rsqrtf(tot * (1.0f / 256.0f) + EPS);
            Y[tok * D + YA + hd * 64 + c0] = (bf16_t)f2bf(o0[i] * r2); Y[tok * D + YA + hd * 64 + 32 + c0] = (bf16_t)f2bf(o1[i] * r2); }
    }
}
DI void hgrn_scan_item(const Params& p, int hb) {
    int tid_o = threadIdx.x; asm volatile("" : "+v"(tid_o));
    const int e = hb * 512 + tid_o, bh = e >> 12, b = bh >> 2, hd = bh & 3, vk = e & 4095, k = vk & 63;
    const bf16_t* SL = (const bf16_t*)(p.ws + WS_SL); bf16_t* SL2 = (bf16_t*)(p.ws + WS_SL2); const float* DEC = (const float*)(p.ws + WS_DEC);
    float st = 0.f;
    for (int c8 = 0; c8 < 128; c8 += 16) { float tmp[16], dc[16];
#pragma unroll
        for (int u = 0; u < 16; ++u) { const int item = (b * 128 + c8 + u) * 4 + hd; tmp[u] = bf2f(SL[(size_t)item * 4096 + vk]); dc[u] = DEC[item * 64 + k]; }
#pragma unroll
        for (int u = 0; u < 16; ++u) { const int item = (b * 128 + c8 + u) * 4 + hd; SL2[(size_t)item * 4096 + vk] = (bf16_t)f2bf(st); st = dc[u] * st + tmp[u]; } }
}

DI void conv_item(const Params& p, LAS unsigned char* lds, int l, int ti) {
    int tid_o = threadIdx.x; asm volatile("" : "+v"(tid_o));
    const int tid = tid_o, lane = tid & 63, wave = tid >> 6, c = tid & 255, hf = tid >> 8, wv = wave & 3;
    LAS float* Hs = (LAS float*)lds; LAS float* ST = (LAS float*)(lds + 98304); LAS float* ST2 = ST + 512;
    const bf16_t* Z = (const bf16_t*)(p.ws + WS_Z); bf16_t* Y = (bf16_t*)(p.ws + WS_YCAT);
    const int tok0 = ti * 64, pos0 = (ti & 127) * 64;
    __syncthreads();
    { u32x4 vw[6], gw_[6];
#pragma unroll
      for (int k = 0; k < 6; ++k) { const int pid = tid + 512 * k, row = pid >> 5, pc = pid & 31, pos = pos0 - 30 + row; const bool ok = (row < 94) && (pos >= 0);
          const size_t tok = ok ? (size_t)(tok0 - 30 + row) : (size_t)tok0; vw[k] = *(const u32x4*)(Z + tok * DIN + ZBV + pc * 8); gw_[k] = *(const u32x4*)(Z + tok * DIN + ZBG + pc * 8); }
#pragma unroll
      for (int k = 0; k < 6; ++k) { const int pid = tid + 512 * k, row = pid >> 5, pc = pid & 31, pos = pos0 - 30 + row; const bool ok = (row < 94) && (pos >= 0);
          if (row < 94) { f32x4 h0, h1;
              h0[0] = bflo(vw[k].x) * sigmoidf_(bflo(gw_[k].x)); h0[1] = bfhi(vw[k].x) * sigmoidf_(bfhi(gw_[k].x)); h0[2] = bflo(vw[k].y) * sigmoidf_(bflo(gw_[k].y)); h0[3] = bfhi(vw[k].y) * sigmoidf_(bfhi(gw_[k].y));
              h1[0] = bflo(vw[k].z) * sigmoidf_(bflo(gw_[k].z)); h1[1] = bfhi(vw[k].z) * sigmoidf_(bfhi(gw_[k].z)); h1[2] = bflo(vw[k].w) * sigmoidf_(bflo(gw_[k].w)); h1[3] = bfhi(vw[k].w) * sigmoidf_(bfhi(gw_[k].w));
              if (!ok) { h0 = (f32x4){0.f, 0.f, 0.f, 0.f}; h1 = h0; }
              *(LAS f32x4*)(Hs + row * 256 + pc * 8) = h0; *(LAS f32x4*)(Hs + row * 256 + pc * 8 + 4) = h1; } } }
    __syncthreads();
    const float* cw = p.in[I_CW] + (size_t)l * 31 * 256 + c; float w[31];
#pragma unroll
    for (int jj = 0; jj < 31; ++jj) w[jj] = cw[jj * 256];
    const float cb = p.in[I_CB][l * 256 + c];
    const float lng = p.in[I_CLG][l * 256 + c], lnb = p.in[I_CLB][l * 256 + c];
    LAS float* OT2 = (LAS float*)(lds + 98304);
    LAS float* STAT = (LAS float*)(lds + 131072); LAS float* STAT2 = STAT + 64;
    const int rtl = tid >> 4, rpart = tid & 15;
#pragma unroll 1
    for (int ps = 0; ps < 2; ++ps) { const int tb = hf * 32 + ps * 16;
        float o[16];
        { float hr[46];
#pragma unroll
          for (int r = 0; r < 46; ++r) hr[r] = Hs[(tb + r) * 256 + c];
#pragma unroll
          for (int j = 0; j < 16; ++j) { float a = cb;
#pragma unroll
            for (int jj = 0; jj < 31; ++jj) a += w[jj] * hr[j + jj];
            o[j] = a; } }
#pragma unroll
        for (int j = 0; j < 16; ++j) OT2[(hf * 16 + j) * 256 + c] = o[j];
        __syncthreads();
        { const LAS f32x4* q = (const LAS f32x4*)(OT2 + rtl * 256 + rpart * 16); float s1 = 0.f, s2 = 0.f;
#pragma unroll
          for (int e = 0; e < 4; ++e) { const f32x4 v = q[e]; s1 += (v[0] + v[1]) + (v[2] + v[3]); s2 += (v[0] * v[0] + v[1] * v[1]) + (v[2] * v[2] + v[3] * v[3]); }
#pragma unroll
          for (int off = 1; off < 16; off <<= 1) { s1 += __shfl_xor(s1, off); s2 += __shfl_xor(s2, off); }
          if (rpart == 0) { const float mu = s1 * (1.0f / 256.0f); const float var = fmaxf(s2 * (1.0f / 256.0f) - mu * mu, 0.f); STAT[rtl * 2] = mu; STAT[rtl * 2 + 1] = rsqrtf(var + EPS); } }
        __syncthreads();
#pragma unroll
        for (int j = 0; j < 16; ++j) { const float mu = STAT[(hf * 16 + j) * 2], rsd = STAT[(hf * 16 + j) * 2 + 1];
            const float y = (o[j] - mu) * rsd * lng + lnb; const float sv = y * sigmoidf_(y); o[j] = sv; OT2[(hf * 16 + j) * 256 + c] = sv; }
        __syncthreads();
        { const LAS f32x4* q = (const LAS f32x4*)(OT2 + rtl * 256 + rpart * 16); float s3 = 0.f;
#pragma unroll
          for (int e = 0; e < 4; ++e) { const f32x4 v = q[e]; s3 += (v[0] * v[0] + v[1] * v[1]) + (v[2] * v[2] + v[3] * v[3]); }
#pragma unroll
          for (int off = 1; off < 16; off <<= 1) s3 += __shfl_xor(s3, off);
          if (rpart == 0) STAT2[rtl] = rsqrtf(s3 * (1.0f / 256.0f) + EPS); }
        __syncthreads();
#pragma unroll
        for (int j = 0; j < 16; ++j) Y[(size_t)(tok0 + tb + j) * D + YB + c] = (bf16_t)f2bf(o[j] * STAT2[hf * 16 + j]);
    }
}

DI bf16x8 ldg8(const bf16_t* p) { return *(const bf16x8*)p; }
DI void s5_local_item(const Params& p, LAS unsigned char* lds, int l, int bi) {
    int tid_o = threadIdx.x; asm volatile("" : "+v"(tid_o));
    const int tid = tid_o, lane = tid & 63, wave = tid >> 6;
    const int gh = bi & 1, cb = (bi >> 1) & 15, pt = bi >> 5, g = gh * 8 + wave, c0 = lane & 31, h = lane >> 5, lg = l * 16 + g;
    LAS bf16_t* UT = (LAS bf16_t*)lds;
    const bf16_t* Z = (const bf16_t*)(p.ws + WS_Z);
    const int sm = tid >> 4, spc = tid & 15;
    const bf16_t* zst = Z + (size_t)((cb * 32 + sm) * 64) * DIN + ZCU + gh * 128 + spc * 8;
    const int ust = (sm * 136 + spc * 8) * 2;
    const bf16_t* wsp = (const bf16_t*)(p.ws + WS_S5WS) + ((size_t)lg * 64 * 128 + pt * 32 + c0) * 16 + 8 * h;
    u32x4 pf[8];
#pragma unroll
    for (int e = 0; e < 8; ++e) pf[e] = *(const u32x4*)(zst + (size_t)e * DIN);
    f32x16 acc = zero16();
    __syncthreads();
    for (int b = 0; b < 8; ++b) { const int s0 = 8 * b;
#pragma unroll
        for (int e = 0; e < 8; ++e) *(LAS u32x4*)(lds + ust + e * (32 * 136 * 2)) = pf[e];
        __syncthreads();
        if (b + 1 < 8) {
#pragma unroll
            for (int e = 0; e < 8; ++e) pf[e] = *(const u32x4*)(zst + (size_t)(s0 + 8 + e) * DIN); }
        bf16x8 bf[8];
#pragma unroll
        for (int e = 0; e < 8; ++e) bf[e] = ldg8(wsp + (size_t)(s0 + e) * 2048);
#pragma unroll
        for (int e = 0; e < 8; ++e) acc = __builtin_amdgcn_mfma_f32_32x32x16_bf16(*(const LAS bf16x8*)(UT + (e * 32 + c0) * 136 + wave * 16 + 8 * h), bf[e], acc, 0, 0, 0);
        __syncthreads();
    }
    float* HL = (float*)(p.ws + WS_S5H);
#pragma unroll
    for (int i = 0; i < 16; ++i) HL[((size_t)(cb * 32 + crow(i, h)) * 16 + g) * 128 + pt * 32 + c0] = acc[i];
}
DI void s5_scan_item(const Params& p, int l, int sb) {
    int tid_o = threadIdx.x; asm volatile("" : "+v"(tid_o));
    const int e = sb * 512 + tid_o, b = e >> 10, g = (e >> 6) & 15, pp = e & 63;
    float lrdt, lidt, cr, ci; s5_params(p, l * 16 + g, pp, lrdt, lidt, cr, ci);
    float ar, ai; s5_pow(lrdt, lidt, 64, ar, ai);
    const float* HL = (const float*)(p.ws + WS_S5H); float* HO = (float*)(p.ws + WS_S5H2); float hr = 0.f, hi = 0.f;
    for (int c8 = 0; c8 < 128; c8 += 16) { float tr[16], ti[16];
#pragma unroll
        for (int u = 0; u < 16; ++u) { const size_t idx = ((size_t)(b * 128 + c8 + u) * 16 + g) * 128; tr[u] = HL[idx + pp]; ti[u] = HL[idx + 64 + pp]; }
#pragma unroll
        for (int u = 0; u < 16; ++u) { const size_t idx = ((size_t)(b * 128 + c8 + u) * 16 + g) * 128; HO[idx + pp] = hr; HO[idx + 64 + pp] = hi;
            const float nr = ar * hr - ai * hi + tr[u], ni = ar * hi + ai * hr + ti[u]; hr = nr; hi = ni; } }
}
DI void s5_out_item(const Params& p, LAS unsigned char* lds, int l, int bi) {
    int tid_o = threadIdx.x; asm volatile("" : "+v"(tid_o));
    const int tid = tid_o, lane = tid & 63, wave = tid >> 6;
    const int gh = bi & 1, cb = (bi >> 1) & 15, pr = bi >> 5, g = gh * 8 + wave, c0 = lane & 31, h = lane >> 5, lg = l * 16 + g;
    LAS bf16_t* UT = (LAS bf16_t*)lds;
    LAS bf16_t* OT = (LAS bf16_t*)(lds + 69632);
    const bf16_t* Z = (const bf16_t*)(p.ws + WS_Z);
    const bf16_t* kt = (const bf16_t*)(p.ws + WS_S5K) + (size_t)lg * 64 * 256;
    const float* ha = (const float*)(p.ws + WS_S5H2) + ((size_t)(cb * 32 + c0) * 16 + g) * 128 + 8 * h;
    const int co = c0 & 15; const float dsk = p.in[I_S5D][l * 256 + g * 16 + co];
    const int jt0 = pr, jt1 = 31 - pr, tl0 = 2 * jt0 + (c0 >> 4), tl1 = 2 * jt1 + (c0 >> 4);
    const int sm = tid >> 4, spc = tid & 15;
    const bf16_t* zst = Z + (size_t)((cb * 32 + sm) * 64) * DIN + ZCU + gh * 128 + spc * 8;
    const int ust = (sm * 136 + spc * 8) * 2;
    const int nb = (2 * jt1 + 2 + 7) >> 3;
    u32x4 pf[8];
#pragma unroll
    for (int e = 0; e < 8; ++e) pf[e] = *(const u32x4*)(zst + (size_t)e * DIN);
    f32x16 acc0 = zero16(), acc1 = zero16();
    { const bf16_t* wc0 = (const bf16_t*)(p.ws + WS_S5WC) + (((size_t)lg * 64 + tl0) * 16 + co) * 128 + 8 * h;
      const bf16_t* wc1 = (const bf16_t*)(p.ws + WS_S5WC) + (((size_t)lg * 64 + tl1) * 16 + co) * 128 + 8 * h;
      f32x4 x0[8], x1[8];
#pragma unroll
      for (int ks = 0; ks < 8; ++ks) { x0[ks] = *(const f32x4*)(ha + ks * 16); x1[ks] = *(const f32x4*)(ha + ks * 16 + 4); }
#pragma unroll
      for (int ks = 0; ks < 8; ++ks) { u32x4 w; w.x = pk2(x0[ks][0], x0[ks][1]); w.y = pk2(x0[ks][2], x0[ks][3]); w.z = pk2(x1[ks][0], x1[ks][1]); w.w = pk2(x1[ks][2], x1[ks][3]);
        const bf16x8 af = __builtin_bit_cast(bf16x8, w);
        acc0 = __builtin_amdgcn_mfma_f32_32x32x16_bf16(af, ldg8(wc0 + ks * 16), acc0, 0, 0, 0);
        acc1 = __builtin_amdgcn_mfma_f32_32x32x16_bf16(af, ldg8(wc1 + ks * 16), acc1, 0, 0, 0); } }
    __syncthreads();
    for (int b = 0; b < nb; ++b) { const int s0 = 8 * b;
#pragma unroll
        for (int e = 0; e < 8; ++e) *(LAS u32x4*)(lds + ust + e * (32 * 136 * 2)) = pf[e];
        __syncthreads();
        if (b + 1 < nb) {
#pragma unroll
            for (int e = 0; e < 8; ++e) pf[e] = *(const u32x4*)(zst + (size_t)(s0 + 8 + e) * DIN); }
        const bool use0 = s0 <= 2 * jt0 + 1;
        bf16x8 b0[8], b1[8];
#pragma unroll
        for (int e = 0; e < 8; ++e) { const int d1 = tl1 - (s0 + e); b1[e] = ldg8(kt + ((size_t)(d1 < 0 ? 0 : d1) * 16 + co) * 16 + 8 * h);
            if (use0) { const int d0 = tl0 - (s0 + e); b0[e] = ldg8(kt + ((size_t)(d0 < 0 ? 0 : d0) * 16 + co) * 16 + 8 * h); } }
#pragma unroll
        for (int e = 0; e < 8; ++e) { const bf16x8 af = *(const LAS bf16x8*)(UT + (e * 32 + c0) * 136 + wave * 16 + 8 * h);
            const int d1 = tl1 - (s0 + e); bf16x8 bb = b1[e]; if (d1 < 0) bb = (bf16x8){0, 0, 0, 0, 0, 0, 0, 0};
            acc1 = __builtin_amdgcn_mfma_f32_32x32x16_bf16(af, bb, acc1, 0, 0, 0);
            if (use0) { const int d0 = tl0 - (s0 + e); bf16x8 ba = b0[e]; if (d0 < 0) ba = (bf16x8){0, 0, 0, 0, 0, 0, 0, 0};
                acc0 = __builtin_amdgcn_mfma_f32_32x32x16_bf16(af, ba, acc0, 0, 0, 0); } }
        __syncthreads();
    }
#pragma unroll
    for (int q = 0; q < 2; ++q) { const int tl = q ? tl1 : tl0;
#pragma unroll
        for (int i = 0; i < 16; ++i) { const int m = crow(i, h); const size_t tok = (size_t)(cb * 32 + m) * 64 + tl; const float u = bf2f(Z[tok * DIN + ZCU + g * 16 + co]);
            const float y = (q ? acc1[i] : acc0[i]) + dsk * u; const float ge = y * sigmoidf_(1.5957691216057308f * (y + 0.044715f * y * y * y));
            OT[(q * 64 + m * 2 + (c0 >> 4)) * 136 + wave * 16 + co] = (bf16_t)f2bf(ge); } }
    __syncthreads();
    { const int tau = tid >> 2, qq = tau >> 6, m = (tau >> 1) & 31, t2 = tau & 1, qt = tid & 3; const int jt = qq ? jt1 : jt0;
      const size_t tok = (size_t)(cb * 32 + m) * 64 + 2 * jt + t2;
      const LAS u32x4* src = (const LAS u32x4*)(OT + tau * 136 + qt * 32); u32x4* dst = (u32x4*)((bf16_t*)(p.ws + WS_YPRE) + tok * 256 + gh * 128 + qt * 32);
#pragma unroll
      for (int e = 0; e < 4; ++e) dst[e] = src[e]; }
}

DI void attn_item(const Params& p, LAS unsigned char* lds, int l, int pt, int id) {
    int tid_o = threadIdx.x; asm volatile("" : "+v"(tid_o));
    const int tid = tid_o, lane = tid & 63, wave = tid >> 6;
    const int dil = pt == 0 ? 1 : (pt == 1 ? 4 : 16), nblk = 32 / dil;
    const int b = id >> 7, hd = (id >> 5) & 3, rn = id & 31, r = rn / nblk, n = rn % nblk;
    LAS bf16_t* Ks = (LAS bf16_t*)lds;
    LAS bf16_t* Vt = (LAS bf16_t*)(lds + 55296);
    LAS float* BT = (LAS float*)(lds + 55296 + 50176);
    const bf16_t* Z = (const bf16_t*)(p.ws + WS_Z);
    const bf16_t* OP = (const bf16_t*)(p.ws + (pt == 1 ? WS_O0 : WS_O1)); const float* LP = (const float*)(p.ws + (pt == 1 ? WS_LSE : WS_LSE1));
    bf16_t* ON = pt == 2 ? (bf16_t*)(p.ws + WS_Z) + ZOD : (bf16_t*)(p.ws + (pt == 0 ? WS_O0 : WS_O1)); const int onp = pt == 2 ? DIN : 256;
    float* LN = (float*)(p.ws + (pt == 0 ? WS_LSE : WS_LSE1));
    const size_t tokb = (size_t)b * SEQ;
    const int c0 = lane & 31, h = lane >> 5;
    const int qi = 32 * wave + c0; const size_t tokq = tokb + (size_t)(n * 256 + qi) * dil + r;
    u32x4 qraw[4]; u32x2 oprev[2][4]; float mprev = 0.f;
#pragma unroll
    for (int ks = 0; ks < 4; ++ks) qraw[ks] = *(const u32x4*)(Z + tokq * DIN + ZDQ + hd * 64 + ks * 16 + 8 * h);
    if (pt > 0) { mprev = LP[tokq * 4 + hd];
#pragma unroll
        for (int vt = 0; vt < 2; ++vt)
#pragma unroll
            for (int g4 = 0; g4 < 4; ++g4) oprev[vt][g4] = *(const u32x2*)(OP + tokq * 256 + hd * 64 + 32 * vt + 8 * g4 + 4 * h); }
    __syncthreads();
    if (tid < 132) BT[tid] = ((const float*)(p.ws + WS_BIAS))[(pt * 4 + hd) * 132 + tid];
    { const float* kg = p.in[I_KG] + l * 64 + (tid & 7) * 8; float kgv[8];
#pragma unroll
      for (int e = 0; e < 8; ++e) kgv[e] = kg[e];
      u32x4 kwv[6], vwv[6];
#pragma unroll
      for (int it = 0; it < 6; ++it) { const int idx = tid + 512 * it, row = idx >> 3, c = idx & 7, si = n * 256 - 128 + row;
        const size_t tok = tokb + (size_t)(si < 0 ? 0 : si) * dil + r;
        kwv[it] = *(const u32x4*)(Z + tok * DIN + ZDK + hd * 64 + c * 8); vwv[it] = *(const u32x4*)(Z + tok * DIN + ZDV + hd * 64 + c * 8); }
#pragma unroll
      for (int it = 0; it < 6; ++it) { const int idx = tid + 512 * it, row = idx >> 3, c = idx & 7, si = n * 256 - 128 + row;
        u32x4 kw = kwv[it], vw = vwv[it];
        if (si < 0) { kw = (u32x4){0u, 0u, 0u, 0u}; vw = (u32x4){0u, 0u, 0u, 0u}; }
        float kf[8]; kf[0] = bflo(kw.x); kf[1] = bfhi(kw.x); kf[2] = bflo(kw.y); kf[3] = bfhi(kw.y); kf[4] = bflo(kw.z); kf[5] = bfhi(kw.z); kf[6] = bflo(kw.w); kf[7] = bfhi(kw.w);
        float ss = 0.f;
#pragma unroll
        for (int e = 0; e < 8; ++e) ss += kf[e] * kf[e];
        ss += __shfl_xor(ss, 1); ss += __shfl_xor(ss, 2); ss += __shfl_xor(ss, 4);
        const float rs = rsqrtf(ss * (1.0f / 64.0f) + EPS);
        u32x4 o; o.x = pk2(kf[0] * rs * kgv[0], kf[1] * rs * kgv[1]); o.y = pk2(kf[2] * rs * kgv[2], kf[3] * rs * kgv[3]); o.z = pk2(kf[4] * rs * kgv[4], kf[5] * rs * kgv[5]); o.w = pk2(kf[6] * rs * kgv[6], kf[7] * rs * kgv[7]);
        *(LAS u32x4*)(Ks + row * 72 + c * 8) = o;
        LAS bf16_t* vp = Vt + (c * 8) * 392 + row;
        vp[0 * 392] = (bf16_t)(vw.x & 0xffffu); vp[1 * 392] = (bf16_t)(vw.x >> 16); vp[2 * 392] = (bf16_t)(vw.y & 0xffffu); vp[3 * 392] = (bf16_t)(vw.y >> 16);
        vp[4 * 392] = (bf16_t)(vw.z & 0xffffu); vp[5 * 392] = (bf16_t)(vw.z >> 16); vp[6 * 392] = (bf16_t)(vw.w & 0xffffu); vp[7 * 392] = (bf16_t)(vw.w >> 16); } }
    __syncthreads();
    bf16x8 qf[4];
    { float qv[4][8]; float ss = 0.f;
#pragma unroll
      for (int ks = 0; ks < 4; ++ks) { const u32x4 w = qraw[ks];
        qv[ks][0] = bflo(w.x); qv[ks][1] = bfhi(w.x); qv[ks][2] = bflo(w.y); qv[ks][3] = bfhi(w.y); qv[ks][4] = bflo(w.z); qv[ks][5] = bfhi(w.z); qv[ks][6] = bflo(w.w); qv[ks][7] = bfhi(w.w);
#pragma unroll
        for (int e = 0; e < 8; ++e) ss += qv[ks][e] * qv[ks][e]; }
      ss += __shfl_xor(ss, 32);
      const float rs = rsqrtf(ss * (1.0f / 64.0f) + EPS) * 0.125f;
#pragma unroll
      for (int ks = 0; ks < 4; ++ks) { const float* qg = p.in[I_QG] + l * 64 + ks * 16 + 8 * h; const f32x4 g0 = *(const f32x4*)qg, g1 = *(const f32x4*)(qg + 4);
        u32x4 w; w.x = pk2(qv[ks][0] * rs * g0[0], qv[ks][1] * rs * g0[1]); w.y = pk2(qv[ks][2] * rs * g0[2], qv[ks][3] * rs * g0[3]);
        w.z = pk2(qv[ks][4] * rs * g1[0], qv[ks][5] * rs * g1[1]); w.w = pk2(qv[ks][6] * rs * g1[2], qv[ks][7] * rs * g1[3]);
        qf[ks] = __builtin_bit_cast(bf16x8, w); } }
    f32x16 acc[5];
#pragma unroll
    for (int c = 0; c < 5; ++c) { acc[c] = zero16(); const LAS bf16_t* kb = Ks + (32 * wave + 32 * c + c0) * 72 + 8 * h;
#pragma unroll
        for (int ks = 0; ks < 4; ++ks) acc[c] = __builtin_amdgcn_mfma_f32_32x32x16_bf16(*(const LAS bf16x8*)(kb + ks * 16), qf[ks], acc[c], 0, 0, 0); }
    float mx = -1e30f;
#pragma unroll
    for (int c = 0; c < 5; ++c)
#pragma unroll
        for (int i = 0; i < 16; ++i) { const int kr = crow(i, h); const int delta = 128 + c0 - 32 * c - kr; const int jl = 32 * wave + 32 * c + kr;
            const bool valid = (delta >= 0) && (delta <= 128) && (n * 256 - 128 + jl >= 0);
            const int dcl = delta < 0 ? 0 : (delta > 128 ? 128 : delta);
            const float lgt = valid ? acc[c][i] + BT[dcl] : -1e30f; acc[c][i] = lgt; mx = fmaxf(mx, lgt); }
    mx = fmaxf(mx, __shfl_xor(mx, 32));
    float mnew = mx;
    if (pt > 0) mnew = fmaxf(mx, mprev);
    float lsum = 0.f;
#pragma unroll
    for (int c = 0; c < 5; ++c)
#pragma unroll
        for (int i = 0; i < 16; ++i) { const float pv = __expf(acc[c][i] - mnew); acc[c][i] = pv; lsum += pv; }
    lsum += __shfl_xor(lsum, 32);
    f32x16 o[2]; o[0] = zero16(); o[1] = zero16();
#pragma unroll
    for (int c = 0; c < 5; ++c)
#pragma unroll
        for (int s = 0; s < 2; ++s) { u32x4 pw; pw.x = pk2(acc[c][8 * s + 0], acc[c][8 * s + 1]); pw.y = pk2(acc[c][8 * s + 2], acc[c][8 * s + 3]); pw.z = pk2(acc[c][8 * s + 4], acc[c][8 * s + 5]); pw.w = pk2(acc[c][8 * s + 6], acc[c][8 * s + 7]);
            const bf16x8 pf = __builtin_bit_cast(bf16x8, pw);
#pragma unroll
            for (int vt = 0; vt < 2; ++vt) { const LAS bf16_t* va = Vt + (32 * vt + c0) * 392 + 32 * wave + 32 * c + 16 * s + 4 * h;
                const s16x4 lo = *(const LAS s16x4*)va, hi = *(const LAS s16x4*)(va + 8);
                const bf16x8 vf = __builtin_shufflevector(lo, hi, 0, 1, 2, 3, 4, 5, 6, 7);
                o[vt] = __builtin_amdgcn_mfma_f32_32x32x16_bf16(vf, pf, o[vt], 0, 0, 0); } }
    float sp = 0.f; if (pt > 0) sp = __expf(mprev - mnew);
    const float ltot = lsum + sp, inv = 1.0f / ltot;
#pragma unroll
    for (int vt = 0; vt < 2; ++vt)
#pragma unroll
        for (int g4 = 0; g4 < 4; ++g4) { const int ch = hd * 64 + 32 * vt + 8 * g4 + 4 * h; bf16_t* yo = ON + tokq * onp + ch;
            float v0 = o[vt][4 * g4 + 0], v1 = o[vt][4 * g4 + 1], v2 = o[vt][4 * g4 + 2], v3 = o[vt][4 * g4 + 3];
            if (pt > 0) { const u32x2 w = oprev[vt][g4]; v0 += sp * bflo(w.x); v1 += sp * bfhi(w.x); v2 += sp * bflo(w.y); v3 += sp * bfhi(w.y); }
            u32x2 w; w.x = pk2(v0 * inv, v1 * inv); w.y = pk2(v2 * inv, v3 * inv); *(u32x2*)yo = w; }
    if (h == 0 && pt < 2) __hip_atomic_store(LN + tokq * 4 + hd, mnew + __logf(ltot), __ATOMIC_RELAXED, __HIP_MEMORY_SCOPE_AGENT);
}

#define RLX_AGENT __ATOMIC_RELAXED, __HIP_MEMORY_SCOPE_AGENT
#define XB_TMO      128
#define XB_XCNT(j)  (256  + 64 * (j))
#define XB_XSUB(j)  (1280 + 64 * (j))
#define XB_XGEN(j)  (2304 + 64 * (j))
#define XB_TOP      3328
#define XB_TOPGEN   3392
#define XCD_BAR_WORDS 3456
#define XB_SPIN_CAP (1u << 18)

__device__ __forceinline__ unsigned xb_ld(unsigned* p)              { return __hip_atomic_load(p, __ATOMIC_RELAXED, __HIP_MEMORY_SCOPE_AGENT); }
__device__ __forceinline__ unsigned xb_add(unsigned* p, unsigned v) { return __hip_atomic_fetch_add(p, v, __ATOMIC_RELAXED, __HIP_MEMORY_SCOPE_AGENT); }
__device__ __forceinline__ unsigned xb_xcc_id() { return (unsigned)__builtin_amdgcn_s_getreg((3 << 11) | 20) & 0xFu; }
#define XB_SPIN(cond, bar) do { unsigned _sp = 0; while (cond) { __builtin_amdgcn_s_sleep(1); \
    if ((++_sp & 255u) == 0u) { if (xb_ld(&(bar)[XB_TMO])) break; if (_sp > XB_SPIN_CAP) { atomicAdd(&(bar)[XB_TMO], 1u); break; } } } } while (0)

struct XcdBarrier {
    unsigned* bar; unsigned x;
    volatile LAS unsigned* st;
};

__device__ __forceinline__ XcdBarrier xcd_barrier_post(unsigned* bar, volatile LAS unsigned* st) {
    XcdBarrier b; b.bar = bar; b.x = xb_xcc_id(); b.st = st;
    if (threadIdx.x == 0) (void)xb_add(&bar[XB_XCNT(b.x)], 1u);
    return b;
}
__device__ __forceinline__ void xcd_barrier_complete(unsigned* bar, unsigned x, unsigned& nloc, unsigned& nx) {
    const unsigned G = gridDim.x * gridDim.y * gridDim.z;
    unsigned sum, cnt, mine, sp = 0u;
    for (;;) {
        sum = 0u; cnt = 0u; mine = 0u;
#pragma unroll
        for (unsigned j = 0; j < 16; ++j) { const unsigned c = xb_ld(&bar[XB_XCNT(j)]); sum += c; cnt += (c > 0u) ? 1u : 0u; mine = (j == x) ? c : mine; }
        if (sum == G) break;
        __builtin_amdgcn_s_sleep(1);
        if ((++sp & 255u) == 0u) { if (xb_ld(&bar[XB_TMO])) break; if (sp > XB_SPIN_CAP) { atomicAdd(&bar[XB_TMO], 1u); break; } }
    }
    nloc = mine > 0u ? mine : 1u; nx = cnt > 0u ? cnt : 1u;
}

__device__ __forceinline__ void xcd_barrier(const XcdBarrier& b) {
    asm volatile("s_waitcnt vmcnt(0)" ::: "memory");
    __syncthreads();
    if (threadIdx.x == 0) {
        unsigned* bar = b.bar;
        __builtin_amdgcn_s_waitcnt(0);
        unsigned nloc = b.st[0], nx = b.st[1];
        if (nloc == 0u) { xcd_barrier_complete(bar, b.x, nloc, nx); b.st[0] = nloc; b.st[1] = nx; }
        const unsigned old = xb_add(&bar[XB_XSUB(b.x)], 1u);
        const unsigned gen = old / nloc;
        if (old + 1u == (gen + 1u) * nloc) {
            __builtin_amdgcn_fence(__ATOMIC_RELEASE, "agent");
            asm volatile("s_waitcnt vmcnt(0)" ::: "memory");
            const unsigned og = xb_add(&bar[XB_TOP], 1u);
            const unsigned tg = og / nx;
            if (og + 1u == (tg + 1u) * nx) xb_add(&bar[XB_TOPGEN], 1u);
            else XB_SPIN(xb_ld(&bar[XB_TOPGEN]) == tg, bar);
            __builtin_amdgcn_fence(__ATOMIC_ACQUIRE, "agent");
            xb_add(&bar[XB_XGEN(b.x)], 1u);
            asm volatile("s_waitcnt vmcnt(0)" ::: "memory");
        } else {
            XB_SPIN(xb_ld(&bar[XB_XGEN(b.x)]) == gen, bar);
            __builtin_amdgcn_fence(__ATOMIC_ACQUIRE, "agent");
            asm volatile("s_waitcnt vmcnt(0)" ::: "memory");
        }
    }
    __syncthreads();
}

#ifndef REP_A
#define REP_A 0
#endif
#ifndef REP_B
#define REP_B 0
#endif
#ifndef REP_C
#define REP_C 0
#endif
#ifndef REP_D
#define REP_D 0
#endif
#ifndef MIX_A
#define MIX_A 1
#endif
#ifndef MIX_B
#define MIX_B 1
#endif
#ifndef MIX_C
#define MIX_C 1
#endif
#ifndef MIX_D
#define MIX_D 1
#endif
__global__ void __launch_bounds__(512, 2) hybrid_fwd(Params p) {
    extern __shared__ __attribute__((aligned(16))) unsigned char lds_raw[];
    LAS unsigned char* lds = (LAS unsigned char*)lds_raw;
    cg::grid_group grid = cg::this_grid();
    { volatile LAS unsigned* st0 = (volatile LAS unsigned*)(lds + LDS_BYTES - 64); if (threadIdx.x < 2) st0[threadIdx.x] = 0u; }
    __syncthreads();
    (void)xcd_barrier_post((unsigned*)(p.ws + WS_BAR), (volatile LAS unsigned*)(lds + LDS_BYTES - 64));
    const int G = gridDim.x, bid = blockIdx.x;
    unsigned char* ws = p.ws;
    bf16_t* XB = (bf16_t*)(ws + WS_XB); bf16_t* Zb = (bf16_t*)(ws + WS_Z); bf16_t* YC_ = (bf16_t*)(ws + WS_YCAT); bf16_t* HM = (bf16_t*)(ws + WS_HM);
    float* SSQP = (float*)(ws + WS_SSQP);

#define GRID_SYNC_() do { asm volatile("s_waitcnt vmcnt(0) lgkmcnt(0)" ::: "memory"); grid.sync(); if (threadIdx.x < 64) { __builtin_amdgcn_fence(__ATOMIC_ACQUIRE, "agent"); asm volatile("s_waitcnt vmcnt(0)" ::: "memory"); } __syncthreads(); } while (0)
#define XBAR_ONCE() do { XcdBarrier b_; b_.bar = (unsigned*)(p.ws + WS_BAR); b_.x = xb_xcc_id(); b_.st = (volatile LAS unsigned*)(lds + LDS_BYTES - 64); xcd_barrier(b_); } while (0)
#ifdef REP_SYNC
#define GRID_SYNC() do { XBAR_ONCE(); XBAR_ONCE(); } while (0)
#else
#define GRID_SYNC() XBAR_ONCE()
#endif
    prologue(p, lds, G);
#ifdef REP_PRO
    GRID_SYNC_(); prologue(p, lds, G);
#endif
#ifdef NANFILL
    { u32x4* q = (u32x4*)(ws + WS_S5H); const size_t n16 = (WS_END - WS_S5H) / 16; const u32x4 nanv = (u32x4){0xffffffffu, 0xffffffffu, 0xffffffffu, 0xffffffffu};
      for (size_t i = (size_t)bid * 512 + threadIdx.x; i < n16; i += (size_t)G * 512) q[i] = nanv;
      u32x4* q2 = (u32x4*)(ws + WS_LSE); const size_t m16 = (WS_S5K - WS_LSE) / 16;
      for (size_t i = (size_t)bid * 512 + threadIdx.x; i < m16; i += (size_t)G * 512) q2[i] = nanv; }
#endif
    if (gridDim.y == 0x7fffffffu) GRID_SYNC_();
    GRID_SYNC();

#ifndef NL_RUN
#define NL_RUN NL
#endif
#ifndef DUMP_LAYER
#define DUMP_LAYER 0
#endif
    for (int lrun = 0; lrun < NL_RUN; ++lrun) {
#ifdef SAME_LAYER
        const int l = 0; const bool firstl = (lrun == 0), lastl = (lrun == NL_RUN - 1);
#else
        const int l = lrun; const bool firstl = (lrun == 0), lastl = (lrun == NL_RUN - 1);
#endif
#define RS_TABLE(SSQ_, NUNITS_) \
          { pg8::Unit ua_, ub_; (void)S.next(0, ua_); (void)S.next((NUNITS_) - 1, ub_); \
              int tq_ = threadIdx.x; asm volatile("" : "+v"(tq_)); const int pm_ = (tq_ >> 8) ? ub_.pm : ua_.pm; \
              const f32x4* sq_ = (const f32x4*)((SSQ_) + ((size_t)pm_ * 256 + (tq_ & 255)) * 16); const f32x4 q0 = sq_[0], q1 = sq_[1], q2 = sq_[2], q3 = sq_[3]; \
              const float tot_ = (((q0[0] + q0[1]) + (q0[2] + q0[3])) + ((q1[0] + q1[1]) + (q1[2] + q1[3]))) + (((q2[0] + q2[1]) + (q2[2] + q2[3])) + ((q3[0] + q3[1]) + (q3[2] + q3[3]))); \
              ((LAS float*)(lds + 131072))[tq_] = rsqrtf(tot_ * (1.0f / 1024.0f) + EPS); __syncthreads(); }
        { pg8::Gemm g{XB, (const bf16_t*)(ws + WS_WIN) + (size_t)l * D * DIN, T, DIN, D, D}; pg8::StaticOrder S; S.init(T, DIN, G, bid);
          RS_TABLE(SSQP, (T / 256) * (DIN / 256) / 256)
          pg8::EpiScale E{Zb, DIN, 0, (const PG8_LAS float*)(lds + 131072)};
          pg8::gemm_phase<pg8::EpiScale, pg8::StaticOrder, true, true>(lds, g, S, E);
#ifdef REPEAT_GEMM
          GRID_SYNC(); pg8::gemm_phase<pg8::EpiScale, pg8::StaticOrder, true, true>(lds, g, S, E);
#endif
        }
        GRID_SYNC();
#ifndef SKIP_MIX
        if (!(MIX_A && MIX_B && MIX_C && MIX_D)) { int tq = threadIdx.x; asm volatile("" : "+v"(tq));
          for (int m = bid * 8 + (tq >> 6); m < T; m += G * 8) { u32x2* yp = (u32x2*)(YC_ + (size_t)m * D) + (tq & 63); const u32x2 z2 = (u32x2){0u, 0u};
              if (!MIX_A) yp[0] = z2; if (!MIX_B) yp[64] = z2; if (!MIX_C) yp[128] = z2; if (!MIX_D) yp[192] = z2; } }
#ifndef MIX_REPEAT
#define MIX_REPEAT 1
#endif
        for (int rep = 0; rep < MIX_REPEAT; ++rep) {
        for (int it = bid; it < 1664; it += G) {
            if (it < 512) { if (MIX_A) { hgrn_item<false>(p, lds, l, it); if (REP_A) hgrn_item<false>(p, lds, l, it); } }
            else if (it < 1024) { if (MIX_B) { conv_item(p, lds, l, it - 512); if (REP_B) conv_item(p, lds, l, it - 512); } }
            else if (it < 1152) { if (MIX_C) { s5_local_item(p, lds, l, it - 1024); if (REP_C) s5_local_item(p, lds, l, it - 1024); } }
            else { if (MIX_D) { attn_item(p, lds, l, 0, it - 1152); if (REP_D) attn_item(p, lds, l, 0, it - 1152); } }
        }
        GRID_SYNC();
        if (bid < 128) { if (MIX_A) hgrn_scan_item(p, bid); } else if (bid < 136) { if (MIX_C) s5_scan_item(p, l, bid - 128); }
        if (bid < 136) { if (MIX_D) { attn_item(p, lds, l, 1, 376 + bid); if (REP_D) attn_item(p, lds, l, 1, 376 + bid); } }
        else for (int it = bid - 136; it < 376; it += 120) { if (MIX_D) { attn_item(p, lds, l, 1, it); if (REP_D) attn_item(p, lds, l, 1, it); } }
        GRID_SYNC();
#ifdef REP_P3
        if (bid < 128) { if (MIX_A) hgrn_scan_item(p, bid); } else if (bid < 136) { if (MIX_C) s5_scan_item(p, l, bid - 128); }
        if (bid < 136) { if (MIX_D) { attn_item(p, lds, l, 1, 376 + bid); if (REP_D) attn_item(p, lds, l, 1, 376 + bid); } }
        else for (int it = bid - 136; it < 376; it += 120) { if (MIX_D) { attn_item(p, lds, l, 1, it); if (REP_D) attn_item(p, lds, l, 1, it); } }
        GRID_SYNC();
#endif
        for (int it = bid; it < 1536; it += G) {
            if (it < 512) { if (MIX_A) { hgrn_item<true>(p, lds, l, it); if (REP_A) hgrn_item<true>(p, lds, l, it); } }
            else if (it < 1024) { if (MIX_C) { s5_out_item(p, lds, l, it - 512); if (REP_C) s5_out_item(p, lds, l, it - 512); } }
            else { if (MIX_D) { attn_item(p, lds, l, 2, it - 1024); if (REP_D) attn_item(p, lds, l, 2, it - 1024); } }
        }
        GRID_SYNC();
        }
#ifndef NO_GLU
        { pg8::Gemm g{(const bf16_t*)(ws + WS_YPRE), (const bf16_t*)(ws + WS_WGLU) + (size_t)l * 65536, T, 256, 256, 256}; pg8::StaticOrder S; S.init(T, 256, G, bid);
          pg8::EpiGlu E{(const bf16_t*)(ws + WS_YPRE), 256, YC_ + YC};
          pg8::gemm_phase<pg8::EpiGlu, pg8::StaticOrder, false, true>(lds, g, S, E); }
#endif
        { int tq = threadIdx.x; asm volatile("" : "+v"(tq)); const int lane = tq & 63; const int gw = (bid - 128) * 8 + (tq >> 6), NGW = 128 * 8;
          if (bid >= 128) for (int m = gw; m < T; m += NGW) { u32x2* yp = (u32x2*)(YC_ + (size_t)m * D + YD) + lane; const u32x2 w = *((const u32x2*)(Zb + (size_t)m * DIN + ZOD) + lane);
              const float a0 = bflo(w.x), a1 = bfhi(w.x), a2 = bflo(w.y), a3 = bfhi(w.y);
              const float ss = wave_sum((a0 * a0 + a1 * a1) + (a2 * a2 + a3 * a3)); const float rs = rsqrtf(ss * (1.0f / 256.0f) + EPS);
              u32x2 o; o.x = pk2(a0 * rs, a1 * rs); o.y = pk2(a2 * rs, a3 * rs); *yp = o; } }
        GRID_SYNC();
#endif
#ifdef REP_P5
#ifndef NO_GLU
        { pg8::Gemm g{(const bf16_t*)(ws + WS_YPRE), (const bf16_t*)(ws + WS_WGLU) + (size_t)l * 65536, T, 256, 256, 256}; pg8::StaticOrder S; S.init(T, 256, G, bid);
          pg8::EpiGlu E{(const bf16_t*)(ws + WS_YPRE), 256, YC_ + YC};
          pg8::gemm_phase<pg8::EpiGlu, pg8::StaticOrder, false, true>(lds, g, S, E); }
#endif
        { int tq = threadIdx.x; asm volatile("" : "+v"(tq)); const int lane = tq & 63; const int gw = (bid - 128) * 8 + (tq >> 6), NGW = 128 * 8;
          if (bid >= 128) for (int m = gw; m < T; m += NGW) { u32x2* yp = (u32x2*)(YC_ + (size_t)m * D + YD) + lane; const u32x2 w = *((const u32x2*)(Zb + (size_t)m * DIN + ZOD) + lane);
              const float a0 = bflo(w.x), a1 = bfhi(w.x), a2 = bflo(w.y), a3 = bfhi(w.y);
              const float ss = wave_sum((a0 * a0 + a1 * a1) + (a2 * a2 + a3 * a3)); const float rs = rsqrtf(ss * (1.0f / 256.0f) + EPS);
              u32x2 o; o.x = pk2(a0 * rs, a1 * rs); o.y = pk2(a2 * rs, a3 * rs); *yp = o; } }
        GRID_SYNC();
#endif
#ifdef DUMP_SLICE
        if (lrun == DUMP_LAYER) { int tq = threadIdx.x; asm volatile("" : "+v"(tq));
          for (int m = bid * 8 + (tq >> 6); m < T; m += G * 8) { const int ln = tq & 63;
              for (int j = 0; j < 4; ++j) { const int col = j * 256 + ln * 4; const u32x2 w = *(const u32x2*)(YC_ + (size_t)m * D + col);
                  f32x4 o = (f32x4){0.f, 0.f, 0.f, 0.f}; if (j == DUMP_SLICE) o = (f32x4){bflo(w.x), bfhi(w.x), bflo(w.y), bfhi(w.y)};
                  *(f32x4*)(p.out + (size_t)m * D + col) = o; } }
          break; }
#endif
#ifdef SKIP_MIX
        { pg8::Gemm g{Zb, (const bf16_t*)(ws + WS_WOUT) + (size_t)l * D * D, T, D, D, DIN}; pg8::StaticOrder S; S.init(T, D, G, bid);
#else
        { pg8::Gemm g{YC_, (const bf16_t*)(ws + WS_WOUT) + (size_t)l * D * D, T, D, D, D}; pg8::StaticOrder S; S.init(T, D, G, bid);
#endif
          pg8::EpiRes E{firstl ? p.in[I_X] : p.out, p.out, XB, SSQP + (size_t)T * 16};
          pg8::gemm_phase<pg8::EpiRes, pg8::StaticOrder, true, true>(lds, g, S, E); }
        GRID_SYNC();
        { pg8::Gemm g{XB, (const bf16_t*)(ws + WS_WUP) + (size_t)l * D * FF, T, FF, D, D}; pg8::StaticOrder S; S.init(T, FF, G, bid);
          RS_TABLE(SSQP + (size_t)T * 16, (T / 256) * (FF / 256) / 256)
          pg8::EpiScale E{HM, FF, 1, (const PG8_LAS float*)(lds + 131072)};
          pg8::gemm_phase<pg8::EpiScale, pg8::StaticOrder, true, true>(lds, g, S, E);
#ifdef REPEAT_GEMM
          GRID_SYNC(); pg8::gemm_phase<pg8::EpiScale, pg8::StaticOrder, true, true>(lds, g, S, E);
#endif
        }
        GRID_SYNC();
        { pg8::Gemm g{HM, (const bf16_t*)(ws + WS_WDN) + (size_t)l * D * FF, T, D, FF, FF}; pg8::StaticOrder S; S.init(T, D, G, bid);
          pg8::EpiRes E{p.out, p.out, XB, !lastl ? SSQP : nullptr};
          pg8::gemm_phase<pg8::EpiRes, pg8::StaticOrder, true, true>(lds, g, S, E); }
        if (!lastl) GRID_SYNC();
    }
}

extern "C" void kernel_launch(void* const* d_in, const int* in_sizes, int n_in, void* d_out, int out_size, void* d_ws, size_t ws_size, hipStream_t stream) {
    static int grid = 0;
    if (grid == 0) {
        if (n_in != 26 || out_size != T * D || ws_size < WS_END) { fprintf(stderr, "kernel_launch: unexpected shapes (n_in %d, out %d, ws %zu); nothing launched\n", n_in, out_size, ws_size); grid = -1; return; }
        int dev = 0, cus = 0, per_cu = 0;
        (void)hipGetDevice(&dev); (void)hipDeviceGetAttribute(&cus, hipDeviceAttributeMultiprocessorCount, dev);
        if (hipFuncSetAttribute((const void*)hybrid_fwd, hipFuncAttributeMaxDynamicSharedMemorySize, LDS_BYTES) != hipSuccess) { fprintf(stderr, "kernel_launch: hipFuncSetAttribute failed\n"); grid = -1; return; }
        if (hipOccupancyMaxActiveBlocksPerMultiprocessor(&per_cu, (const void*)hybrid_fwd, 512, LDS_BYTES) != hipSuccess || per_cu < 1) { fprintf(stderr, "kernel_launch: occupancy query gave %d\n", per_cu); per_cu = 1; }
        (void)hipGetLastError();
        if (cus <= 0) cus = 256;
        grid = cus * per_cu;
    }
    if (grid < 0) return;
    if (hipMemsetAsync((char*)d_ws + WS_BAR, 0, XCD_BAR_WORDS * 4, stream) != hipSuccess) { fprintf(stderr, "kernel_launch: hipMemsetAsync of the barrier words failed\n"); return; }
    static int rs_ok = -1;
    if (rs_ok < 0) { rs_ok = (grid == 256) ? 1 : 0;
        const int ncol[2] = {DIN / 256, FF / 256};
        for (int ph = 0; ph < 2 && rs_ok; ++ph) { const int nun = (T / 256) * ncol[ph] / 256;
            for (int c = 0; c < grid && rs_ok; ++c) { pg8::StaticOrder S; S.init(T, ncol[ph] * 256, grid, c); pg8::Unit u0, u1, ui; if (!S.next(0, u0) || !S.next(nun - 1, u1) || S.next(nun, ui)) { rs_ok = 0; break; }
                if (((u0.pm >> 3) & 1) != 0 || ((u1.pm >> 3) & 1) != 1) { rs_ok = 0; break; }
                for (int i = 0; i < nun; ++i) { S.next(i, ui); if (ui.pm != (((ui.pm >> 3) & 1) ? u1.pm : u0.pm)) { rs_ok = 0; break; } } } } }
    Params a{};
    for (int i = 0; i < 26; ++i) a.in[i] = (const float*)d_in[i];
    if (!rs_ok) { fprintf(stderr, "kernel_launch: unit order does not keep a workgroup inside two row panels (grid %d); nothing launched\n", grid); return; }
    a.out = (float*)d_out; a.ws = (unsigned char*)d_ws; a.rs_lds = rs_ok; a.pad = 0;
    void* args[] = {&a};
    hipError_t e = hipLaunchCooperativeKernel((const void*)hybrid_fwd, dim3(grid), dim3(512), args, LDS_BYTES, stream);
    if (e != hipSuccess) fprintf(stderr, "cooperative launch failed: %s (grid %d)\n", hipGetErrorString(e), grid);
}
```

```cpp
#include <hip/hip_runtime.h>
#include <hip/hip_cooperative_groups.h>
#include <cstdio>
#include <cstdint>
namespace cg = cooperative_groups;

#define DI __device__ __forceinline__
#define LAS __attribute__((address_space(3)))
typedef unsigned short bf16_t;
typedef short bf16x8 __attribute__((ext_vector_type(8)));
typedef short s16x4 __attribute__((ext_vector_type(4)));
typedef float f32x4 __attribute__((ext_vector_type(4)));
typedef float f32x16 __attribute__((ext_vector_type(16)));
typedef unsigned u32x4 __attribute__((ext_vector_type(4)));
typedef unsigned u32x2 __attribute__((ext_vector_type(2)));

constexpr int NB = 4, SEQ = 8192, T = NB * SEQ, D = 1024, DIN = 2560, FF = 4096, NL = 4;
constexpr int ZQ = 0, ZF = 256, ZI = 512, ZG = 768, ZBV = 1024, ZBG = 1280, ZCU = 1536, ZDQ = 1792, ZDK = 2048, ZDV = 2304;
constexpr int YA = 0, YB = 256, YC = 512, YD = 768;
constexpr int ZOD = ZBG;
constexpr float EPS = 1e-6f;
constexpr size_t MiB = 1u << 20;
constexpr size_t WS_WIN = 0, WS_WOUT = 20 * MiB, WS_WUP = 28 * MiB, WS_WDN = 60 * MiB, WS_WGLU = 92 * MiB;
constexpr size_t WS_LB = 93 * MiB;
constexpr size_t WS_BIAS = WS_LB + 4096;
constexpr size_t WS_BAR = WS_LB + 32768;
constexpr size_t WS_SSQ = WS_LB + 65536;
constexpr size_t WS_LSE = WS_SSQ + 8 * (size_t)T * 4;
constexpr size_t WS_DEC = WS_LSE + (size_t)T * 16;
constexpr size_t WS_LSE1 = WS_DEC + 2048 * 64 * 4;
constexpr size_t WS_S5K = 96 * MiB;
constexpr size_t WS_S5WS = 98 * MiB;
constexpr size_t WS_S5WC = 114 * MiB;
constexpr size_t WS_XB = 130 * MiB;
constexpr size_t WS_S5H = 194 * MiB;
constexpr size_t WS_HM = 198 * MiB;
constexpr size_t WS_Z = 198 * MiB;
constexpr size_t WS_YCAT = 358 * MiB;
constexpr size_t WS_SL = 422 * MiB, WS_SL2 = 438 * MiB;
constexpr size_t WS_S5H2 = 454 * MiB;
constexpr size_t WS_O0 = 458 * MiB, WS_O1 = 474 * MiB;
constexpr size_t WS_YPRE = 490 * MiB;
constexpr size_t WS_SSQP = 506 * MiB;
constexpr size_t WS_END = 510 * MiB;
static_assert(WS_LSE1 + (size_t)T * 16 <= WS_S5K, "misc region");

constexpr int LDS_BYTES = 147456;

DI unsigned f2bf(float f) { unsigned u = __builtin_bit_cast(unsigned, f); return (u + 0x7fffu + ((u >> 16) & 1u)) >> 16; }
typedef float f32x2_t __attribute__((ext_vector_type(2))); typedef __bf16 bf16x2_t __attribute__((ext_vector_type(2)));
DI unsigned pk2(float lo, float hi) { const f32x2_t v = {lo, hi}; const bf16x2_t b = __builtin_convertvector(v, bf16x2_t); return __builtin_bit_cast(unsigned, b); }
DI float bf2f(bf16_t v) { return __builtin_bit_cast(float, (unsigned)v << 16); }
DI float bflo(unsigned w) { return __builtin_bit_cast(float, w << 16); }
DI float bfhi(unsigned w) { return __builtin_bit_cast(float, w & 0xffff0000u); }
DI float sigmoidf_(float x) { return __builtin_amdgcn_rcpf(1.f + __expf(-x)); }
DI float wave_sum(float v) {
#pragma unroll
    for (int o = 1; o < 64; o <<= 1) v += __shfl_xor(v, o);
    return v;
}
DI float half_sum(float v) {
#pragma unroll
    for (int o = 1; o < 32; o <<= 1) v += __shfl_xor(v, o);
    return v;
}
#define LDS_WAIT() asm volatile("s_waitcnt lgkmcnt(0)" ::: "memory")
DI int crow(int reg, int h) { return (reg & 3) + 8 * (reg >> 2) + 4 * h; }

template <int K>
DI f32x16 mma_lds(const LAS bf16_t* A, int lda, const LAS bf16_t* B, int ldb, f32x16 acc, int lane) {
    const int r = lane & 31, h = lane >> 5;
    const LAS bf16_t* ap = A + r * lda + 8 * h; const LAS bf16_t* bp = B + r * ldb + 8 * h;
#pragma unroll
    for (int k0 = 0; k0 < K; k0 += 16) {
        const bf16x8 a = *(const LAS bf16x8*)(ap + k0); const bf16x8 b = *(const LAS bf16x8*)(bp + k0);
        acc = __builtin_amdgcn_mfma_f32_32x32x16_bf16(a, b, acc, 0, 0, 0);
    }
    return acc;
}
DI f32x16 zero16() { f32x16 z;
#pragma unroll
    for (int i = 0; i < 16; ++i) z[i] = 0.f;
    return z; }

namespace pg8 {
#define PG8_LAS __attribute__((address_space(3)))
constexpr int BM = 256, BK = 64, HALF = 128, HTB = HALF * BK * 2, STAGE_BYTES = 8 * HTB, NXCD = 8, WGM = 8;
__host__ __device__ __forceinline__ int lds_byte(int r, int c) { const int st = (r >> 4) * 2 + (c >> 5), rr = r & 15, cc = c & 31, ob = rr * 64 + cc * 2; return st * 1024 + (ob ^ (((ob >> 9) & 1) << 5)); }
__host__ __device__ __forceinline__ void stage_rc(int b, int& R, int& C) { const int st = b / 1024, sb = b % 1024, swz = sb ^ (((sb >> 9) & 1) << 5); R = (st >> 1) * 16 + swz / 64; C = (st & 1) * 32 + (swz % 64) / 2; }
__host__ __device__ __forceinline__ int perm32(int rho) { const int n = rho >> 4, i = rho & 15; return 8 * (i >> 2) + 4 * n + (i & 3); }
struct Unit { int pm, pn; };
struct Gemm { const bf16_t* A; const bf16_t* Bt; int M, N, K, lda; };
struct StaticOrder {
    int nM, nN, nwg, G, c;
    __host__ __device__ __forceinline__ void init(int M, int N, int G_, int c_) { nM = M / BM; nN = N / BM; nwg = nM * nN; G = G_; c = c_; }
    __host__ __device__ __forceinline__ bool next(int i, Unit& u) const {
        const long L = (long)i * G + c; if (L >= nwg) return false;
        int wgid = (int)L; { const int q = nwg / NXCD, r = nwg % NXCD, xcd = wgid % NXCD, off = wgid / NXCD; wgid = (xcd < r ? xcd * (q + 1) : r * (q + 1) + (xcd - r) * q) + off; }
        const int nig = WGM * nN, gid = wgid / nig, fm = gid * WGM, gsz = (nM - fm) < WGM ? (nM - fm) : WGM;
        u.pm = fm + ((wgid % nig) % gsz); u.pn = (wgid % nig) / gsz; return true;
    }
    __device__ __forceinline__ void a_ready(const Unit&) const {}
    __device__ __forceinline__ void done(const Unit&) const {}
};
struct EpiScale {
    static constexpr bool PERM = true, AFTER_DRAIN = false;
    bf16_t* O; int ldc; int act; const PG8_LAS float* rsl;
    __device__ __forceinline__ void operator()(const f32x4 (&acc)[2][2][4][2], const Unit& u, int wr, int wc, int fr, int fq) const {
        const int row0 = u.pm * BM + wr * 64 + fr; const int col0 = u.pn * BM + wc * 32 + 8 * fq;
        const int slot = ((u.pm >> 3) & 1) * 256;
#pragma unroll
        for (int ai = 0; ai < 2; ++ai)
#pragma unroll
            for (int m = 0; m < 4; ++m) { const int r = row0 + ai * HALF + m * 16; float rs;
                rs = rsl[slot + ai * HALF + wr * 64 + m * 16 + fr];
                bf16_t* rowp = O + (size_t)r * ldc + col0;
#pragma unroll
                for (int bj = 0; bj < 2; ++bj) { f32x4 v0 = acc[ai][bj][m][0] * rs, v1 = acc[ai][bj][m][1] * rs;
                    if (act) {
#pragma unroll
                        for (int e = 0; e < 4; ++e) { const float a = fmaxf(v0[e], 0.f), b = fmaxf(v1[e], 0.f); v0[e] = a * a; v1[e] = b * b; } }
                    u32x4 w; w.x = pk2(v0[0], v0[1]); w.y = pk2(v0[2], v0[3]); w.z = pk2(v1[0], v1[1]); w.w = pk2(v1[2], v1[3]);
                    *(u32x4*)(rowp + bj * HALF) = w; } }
    }
};
struct EpiRes {
    static constexpr bool PERM = false, AFTER_DRAIN = false;
    const float* base; float* out; bf16_t* xb; float* ssq_out;
    __device__ __forceinline__ void operator()(const f32x4 (&acc)[2][2][4][2], const Unit& u, int wr, int wc, int fr, int fq) const {
        const int col0 = u.pn * BM + wc * 32 + 4 * fq;
#pragma unroll
        for (int ai = 0; ai < 2; ++ai) {
            f32x4 bv[4][2][2];
#pragma unroll
            for (int m = 0; m < 4; ++m) { const size_t off = (size_t)(u.pm * BM + ai * HALF + wr * 64 + m * 16 + fr) * D + col0;
#pragma unroll
                for (int bj = 0; bj < 2; ++bj)
#pragma unroll
                    for (int n = 0; n < 2; ++n) bv[m][bj][n] = *(const f32x4*)(base + off + bj * HALF + n * 16); }
#pragma unroll
            for (int m = 0; m < 4; ++m) { const int r = u.pm * BM + ai * HALF + wr * 64 + m * 16 + fr; const size_t off = (size_t)r * D + col0; float s = 0.f;
#pragma unroll
                for (int bj = 0; bj < 2; ++bj)
#pragma unroll
                    for (int n = 0; n < 2; ++n) { const size_t o2 = off + bj * HALF + n * 16; const f32x4 o = bv[m][bj][n] + acc[ai][bj][m][n];
                        *(f32x4*)(out + o2) = o; u32x2 w; w.x = pk2(o[0], o[1]); w.y = pk2(o[2], o[3]); *(u32x2*)(xb + o2) = w;
                        s += (o[0] * o[0] + o[1] * o[1]) + (o[2] * o[2] + o[3] * o[3]); }
                s += __shfl_xor(s, 16); s += __shfl_xor(s, 32);
                if (fq == 0 && ssq_out) ssq_out[(size_t)r * 16 + u.pn * 4 + wc] = s; } }
    }
};
struct EpiGlu {
    static constexpr bool PERM = false, AFTER_DRAIN = true;
    const bf16_t* Ysrc; int lds_; bf16_t* Y;
    __device__ __forceinline__ void fused(f32x4 (&acc)[2][2][4][2], const Unit& u, int wr, int wc, int fr, int fq, PG8_LAS unsigned char* lds, int wid, int lane) const {
        PG8_LAS float* Pp = (PG8_LAS float*)lds;
        const int col0 = wc * 32 + 4 * fq;
#pragma unroll
        for (int ai = 0; ai < 2; ++ai)
#pragma unroll
            for (int m = 0; m < 4; ++m) { const int rl = ai * HALF + wr * 64 + m * 16 + fr; const size_t off = (size_t)(u.pm * BM + rl) * lds_ + col0; float s = 0.f;
#pragma unroll
                for (int bj = 0; bj < 2; ++bj)
#pragma unroll
                    for (int n = 0; n < 2; ++n) { const u32x2 w = *(const u32x2*)(Ysrc + off + bj * HALF + n * 16); f32x4 a = acc[ai][bj][m][n];
                        const float y0 = bflo(w.x), y1 = bfhi(w.x), y2 = bflo(w.y), y3 = bfhi(w.y);
                        a[0] = y0 * sigmoidf_(a[0]); a[1] = y1 * sigmoidf_(a[1]); a[2] = y2 * sigmoidf_(a[2]); a[3] = y3 * sigmoidf_(a[3]);
                        acc[ai][bj][m][n] = a; s += (a[0] * a[0] + a[1] * a[1]) + (a[2] * a[2] + a[3] * a[3]); }
                s += __shfl_xor(s, 16); s += __shfl_xor(s, 32);
                if (fq == 0) Pp[rl * 4 + wc] = s; }
        __syncthreads();
#pragma unroll
        for (int ai = 0; ai < 2; ++ai)
#pragma unroll
            for (int m = 0; m < 4; ++m) { const int rl = ai * HALF + wr * 64 + m * 16 + fr; const size_t off = (size_t)(u.pm * BM + rl) * D + col0;
                const float tot = (Pp[rl * 4 + 0] + Pp[rl * 4 + 1]) + (Pp[rl * 4 + 2] + Pp[rl * 4 + 3]); const float rs = rsqrtf(tot * (1.0f / 256.0f) + EPS);
#pragma unroll
                for (int bj = 0; bj < 2; ++bj)
#pragma unroll
                    for (int n = 0; n < 2; ++n) { const f32x4 a = acc[ai][bj][m][n] * rs; u32x2 w; w.x = pk2(a[0], a[1]); w.y = pk2(a[2], a[3]); *(u32x2*)(Y + off + bj * HALF + n * 16) = w; } }
    }
};

template <class Epi, class Sched, bool ALIGN_EPI = false, bool SP2 = false>
__device__ __forceinline__ void gemm_phase(PG8_LAS unsigned char* lds, const Gemm g, const Sched& S, const Epi& E) {
    int tid_o = threadIdx.x; asm volatile("" : "+v"(tid_o));
    const int tid = tid_o, wid = __builtin_amdgcn_readfirstlane(tid >> 6), lane = tid & 63, wr = wid >> 2, wc = wid & 3, fr = lane & 15, fq = lane >> 4;
    const int K = g.K, nt = K / BK;
    unsigned voffA[2], voffB[2];
#pragma unroll
    for (int i = 0; i < 2; ++i) { int R, C; stage_rc(tid * 16 + i * 8192, R, C); const int Rb = Epi::PERM ? ((R & ~31) + perm32(R & 31)) : R;
        voffA[i] = (unsigned)(R * g.lda + C) * 2u; voffB[i] = (unsigned)(Rb * K + C) * 2u; }
    const size_t kstep = (size_t)(BK * 2);
    const size_t hstepA = (size_t)HALF * g.lda * 2, hstepB = (size_t)HALF * K * 2;
    const size_t tstepA = 2 * hstepA, tstepB = 2 * hstepB;
    const unsigned ldsw = (unsigned)wid * 1024u;
    const int aoff = lds_byte(wr * 64 + fr, fq * 8), boff = lds_byte(wc * 32 + fr, fq * 8);
#define PG8_SA(b, h) (((b) * 2 + (h)) * HTB)
#define PG8_SB(b, h) ((4 + (b) * 2 + (h)) * HTB)
#define PG8_STAGE(bufoff, gbase, voff) do { _Pragma("unroll") for (int _i = 0; _i < 2; ++_i) \
        __builtin_amdgcn_global_load_lds((const unsigned*)((const char*)(gbase) + (voff)[_i]), (PG8_LAS unsigned*)(lds + (bufoff) + ldsw + _i * 8192), 16, 0, 0); } while (0)
#define PG8_LDA(dst, b, h) do { _Pragma("unroll") for (int m = 0; m < 4; ++m) _Pragma("unroll") for (int k = 0; k < 2; ++k) dst[m][k] = *(const PG8_LAS bf16x8*)(lds + PG8_SA(b, h) + aoff + m * 2048 + k * 1024); } while (0)
#define PG8_LDB(dst, b, h) do { _Pragma("unroll") for (int n = 0; n < 2; ++n) _Pragma("unroll") for (int k = 0; k < 2; ++k) dst[n][k] = *(const PG8_LAS bf16x8*)(lds + PG8_SB(b, h) + boff + n * 2048 + k * 1024); } while (0)
#define PG8_MMA(ai, bj, At, Bt) do { __builtin_amdgcn_s_setprio(1); _Pragma("unroll") for (int m = 0; m < 4; ++m) _Pragma("unroll") for (int n = 0; n < 2; ++n) _Pragma("unroll") for (int k = 0; k < 2; ++k) \
        acc[ai][bj][m][n] = __builtin_amdgcn_mfma_f32_16x16x32_bf16(Bt[n][k], At[m][k], acc[ai][bj][m][n], 0, 0, 0); __builtin_amdgcn_s_setprio(0); } while (0)
#define PG8_WAIT_V(n) asm volatile("s_waitcnt vmcnt(" #n ")" ::: "memory")
#define PG8_WAIT_L(n) asm volatile("s_waitcnt lgkmcnt(" #n ")" ::: "memory")
#define PG8_BAR __builtin_amdgcn_s_barrier()
#define PG8_SCHED __builtin_amdgcn_sched_barrier(0)
    Unit cur, nxt; int ui = 0;
    if (!S.next(0, cur)) return;
    f32x4 acc[2][2][4][2];
#pragma unroll
    for (int a = 0; a < 2; ++a)
#pragma unroll
        for (int b = 0; b < 2; ++b)
#pragma unroll
            for (int m = 0; m < 4; ++m)
#pragma unroll
                for (int n = 0; n < 2; ++n) acc[a][b][m][n] = (f32x4){0.f, 0.f, 0.f, 0.f};
    bf16x8 At[4][2], B0[2][2], B1[2][2];
    const char* cA = (const char*)g.A + (size_t)cur.pm * tstepA; const char* cB = (const char*)g.Bt + (size_t)cur.pn * tstepB;
    S.a_ready(cur);
    if constexpr (SP2) {
        PG8_STAGE(PG8_SB(0, 0), cB, voffB); PG8_STAGE(PG8_SB(0, 1), cB + hstepB, voffB); PG8_STAGE(PG8_SA(0, 0), cA, voffA); PG8_STAGE(PG8_SA(0, 1), cA + hstepA, voffA);
        if (wr == 1) PG8_BAR;
        PG8_WAIT_V(2); PG8_BAR;
        PG8_STAGE(PG8_SB(1, 0), cB + kstep, voffB); PG8_STAGE(PG8_SA(1, 0), cA + kstep, voffA); PG8_STAGE(PG8_SB(1, 1), cB + hstepB + kstep, voffB);
        PG8_WAIT_V(6); PG8_BAR;
    } else {
        PG8_STAGE(PG8_SB(0, 0), cB, voffB); PG8_STAGE(PG8_SA(0, 0), cA, voffA); PG8_STAGE(PG8_SB(0, 1), cB + hstepB, voffB); PG8_STAGE(PG8_SA(0, 1), cA + hstepA, voffA);
        if (wr == 1) PG8_BAR;
        PG8_WAIT_V(4); PG8_BAR;
        PG8_STAGE(PG8_SB(1, 0), cB + kstep, voffB); PG8_STAGE(PG8_SA(1, 0), cA + kstep, voffA); PG8_STAGE(PG8_SB(1, 1), cB + hstepB + kstep, voffB);
        PG8_WAIT_V(6); PG8_BAR;
    }
    for (;;) {
        const bool has_next = S.next(ui + 1, nxt);
        const char* nA = has_next ? (const char*)g.A + (size_t)nxt.pm * tstepA : cA; const char* nB = has_next ? (const char*)g.Bt + (size_t)nxt.pn * tstepB : cB;
        for (int t = 0; t < nt; t += 2) {
            const bool last = (t == nt - 2);
            const char* a1 = cA + (size_t)(t + 1) * kstep;
            const char* a2 = last ? nA : cA + (size_t)(t + 2) * kstep; const char* b2 = last ? nB : cB + (size_t)(t + 2) * kstep;
            const char* a3 = a2 + kstep; const char* b3 = b2 + kstep;
            if (last && has_next) S.a_ready(nxt);
            if constexpr (SP2) {
            PG8_LDB(B0, 0, 0); PG8_LDB(B1, 0, 1); PG8_SCHED; PG8_LDA(At, 0, 0); PG8_STAGE(PG8_SA(1, 1), a1 + hstepA, voffA);
            PG8_WAIT_V(8); PG8_WAIT_L(0); PG8_BAR; PG8_MMA(0, 0, At, B0); PG8_MMA(0, 1, At, B1); PG8_BAR; PG8_SCHED;
            PG8_LDA(At, 0, 1); PG8_STAGE(PG8_SB(0, 0), b2, voffB); PG8_STAGE(PG8_SB(0, 1), b2 + hstepB, voffB); PG8_STAGE(PG8_SA(0, 0), a2, voffA);
            PG8_WAIT_V(8); PG8_WAIT_L(0); PG8_BAR; PG8_MMA(1, 0, At, B0); PG8_MMA(1, 1, At, B1); PG8_BAR; PG8_SCHED;
            PG8_LDB(B0, 1, 0); PG8_LDB(B1, 1, 1); PG8_SCHED; PG8_LDA(At, 1, 0); PG8_STAGE(PG8_SA(0, 1), a2 + hstepA, voffA);
            PG8_WAIT_V(8); PG8_WAIT_L(0); PG8_BAR; PG8_MMA(0, 0, At, B0); PG8_MMA(0, 1, At, B1); PG8_BAR; PG8_SCHED;
            PG8_LDA(At, 1, 1); PG8_STAGE(PG8_SB(1, 0), b3, voffB); PG8_STAGE(PG8_SB(1, 1), b3 + hstepB, voffB); PG8_STAGE(PG8_SA(1, 0), a3, voffA);
            PG8_WAIT_V(8); PG8_WAIT_L(0); PG8_BAR; PG8_MMA(1, 0, At, B0); PG8_MMA(1, 1, At, B1); PG8_BAR; PG8_SCHED;
            } else {
            PG8_LDB(B0, 0, 0); PG8_SCHED; PG8_LDA(At, 0, 0); PG8_STAGE(PG8_SA(1, 1), a1 + hstepA, voffA);
            PG8_WAIT_L(8); PG8_BAR; PG8_WAIT_L(0); PG8_MMA(0, 0, At, B0); PG8_BAR; PG8_SCHED;
            PG8_LDB(B1, 0, 1); PG8_STAGE(PG8_SB(0, 0), b2, voffB);
            PG8_BAR; PG8_WAIT_L(0); PG8_MMA(0, 1, At, B1); PG8_BAR;
            PG8_LDA(At, 0, 1); PG8_STAGE(PG8_SA(0, 0), a2, voffA);
            PG8_BAR; PG8_WAIT_L(0); PG8_MMA(1, 0, At, B0); PG8_BAR; PG8_SCHED;
            PG8_STAGE(PG8_SB(0, 1), b2 + hstepB, voffB);
            PG8_WAIT_V(6); PG8_BAR; PG8_MMA(1, 1, At, B1); PG8_BAR;
            PG8_LDB(B0, 1, 0); PG8_SCHED; PG8_LDA(At, 1, 0); PG8_STAGE(PG8_SA(0, 1), a2 + hstepA, voffA);
            PG8_WAIT_L(8); PG8_BAR; PG8_WAIT_L(0); PG8_MMA(0, 0, At, B0); PG8_BAR; PG8_SCHED;
            PG8_LDB(B1, 1, 1); PG8_STAGE(PG8_SB(1, 0), b3, voffB);
            PG8_BAR; PG8_WAIT_L(0); PG8_MMA(0, 1, At, B1); PG8_BAR;
            PG8_LDA(At, 1, 1); PG8_STAGE(PG8_SA(1, 0), a3, voffA);
            PG8_BAR; PG8_WAIT_L(0); PG8_MMA(1, 0, At, B0); PG8_BAR; PG8_SCHED;
            PG8_STAGE(PG8_SB(1, 1), b3 + hstepB, voffB);
            PG8_WAIT_V(6); PG8_BAR; PG8_MMA(1, 1, At, B1); PG8_BAR;
            }
        }
        if constexpr (ALIGN_EPI) { if (wr == 0) PG8_BAR; }
        if constexpr (!Epi::AFTER_DRAIN) { E(acc, cur, wr, wc, fr, fq); S.done(cur); }
        if (!has_next) break;
#pragma unroll
        for (int a = 0; a < 2; ++a)
#pragma unroll
            for (int b = 0; b < 2; ++b)
#pragma unroll
                for (int m = 0; m < 4; ++m)
#pragma unroll
                    for (int n = 0; n < 2; ++n) acc[a][b][m][n] = (f32x4){0.f, 0.f, 0.f, 0.f};
        cur = nxt; cA = nA; cB = nB; ++ui;
        if constexpr (ALIGN_EPI) { if (wr == 1) PG8_BAR; }
    }
    PG8_WAIT_V(0);
    if constexpr (!ALIGN_EPI) { if (wr == 0) PG8_BAR; }
    PG8_BAR;
    if constexpr (Epi::AFTER_DRAIN) { E.fused(acc, cur, wr, wc, fr, fq, lds, wid, lane); S.done(cur); }
#undef PG8_SA
#undef PG8_SB
#undef PG8_STAGE
#undef PG8_LDA
#undef PG8_LDB
#undef PG8_MMA
#undef PG8_WAIT_V
#undef PG8_WAIT_L
#undef PG8_BAR
#undef PG8_SCHED
}
}

struct Params { const float* in[26]; float* out; unsigned char* ws; int rs_lds; int pad; };
enum { I_X = 0, I_NMG, I_WIN, I_LBL, I_HNG, I_CW, I_CB, I_CLG, I_CLB, I_LRE, I_LIM, I_BRE, I_BIM, I_CRE, I_CIM, I_S5D, I_LDT, I_WGLU, I_QG, I_KG, I_RB, I_MONG, I_WOUT, I_NMLPG, I_WUP, I_WDN };

DI void p0_transpose_item(const float* W, int K, int N, bf16_t* WT, const float* gk, LAS float* scr, int item, int lane) {
    const int nblk = N / 32, kb = item / nblk, nb = item % nblk, k0 = 64 * kb, n0 = 32 * nb;
    float wv[32];
#pragma unroll
    for (int i = 0; i < 32; ++i) { const int kk = 2 * i + (lane >> 5); wv[i] = W[(size_t)(k0 + kk) * N + n0 + (lane & 31)]; }
#pragma unroll
    for (int i = 0; i < 32; ++i) { const int kk = 2 * i + (lane >> 5); const float s = gk ? gk[k0 + kk] : 1.f; scr[kk * 33 + (lane & 31)] = wv[i] * s; }
    LDS_WAIT();
    const int c = lane & 7;
#pragma unroll
    for (int j = 0; j < 4; ++j) { const int n = (lane >> 3) + 8 * j; const LAS float* s = scr + (8 * c) * 33 + n;
        u32x4 o; o.x = pk2(s[0 * 33], s[1 * 33]); o.y = pk2(s[2 * 33], s[3 * 33]); o.z = pk2(s[4 * 33], s[5 * 33]); o.w = pk2(s[6 * 33], s[7 * 33]);
        *(u32x4*)(WT + (size_t)(n0 + n) * K + k0 + 8 * c) = o; }
    LDS_WAIT();
}
DI void s5_params(const Params& p, int lg, int pp, float& lrdt, float& lidt, float& cr, float& ci) {
    const float dt = expf(p.in[I_LDT][lg]);
    const float lr = p.in[I_LRE][lg * 64 + pp], li = p.in[I_LIM][lg * 64 + pp];
    lrdt = lr * dt; lidt = li * dt;
    const float mag = expf(lrdt); const float ar = mag * cosf(lidt), ai = mag * sinf(lidt);
    const float den = lr * lr + li * li;
    cr = ((ar - 1.0f) * lr + ai * li) / den; ci = (ai * lr - (ar - 1.0f) * li) / den;
}
DI void s5_pow(float lrdt, float lidt, int n, float& er, float& ei) { const float m = expf((float)n * lrdt); const float a = (float)n * lidt; er = m * cosf(a); ei = m * sinf(a); }

DI void prologue(const Params& p, LAS unsigned char* lds, int G) {
    int tid_o = threadIdx.x; asm volatile("" : "+v"(tid_o));
    const int tid = tid_o, lane = tid & 63, wave = tid >> 6;
    const int gw = blockIdx.x * 8 + wave, NGW = G * 8;
    const int gt = blockIdx.x * 512 + tid, NGT = G * 512;
    unsigned char* ws = p.ws;
    LAS float* scr = (LAS float*)(lds + wave * 16384);
    {
        constexpr int I_IN = (D / 64) * (DIN / 32), I_OUT = (D / 64) * (D / 32), I_UP = (D / 64) * (FF / 32), I_DN = (FF / 64) * (D / 32), I_GL = (256 / 64) * (256 / 32);
        constexpr int PER_L = I_IN + I_OUT + I_UP + I_DN + I_GL;
        for (int it = gw; it < NL * PER_L; it += NGW) {
            const int l = it / PER_L; int r = it % PER_L;
            if (r < I_IN) { p0_transpose_item(p.in[I_WIN] + (size_t)l * D * DIN, D, DIN, (bf16_t*)(ws + WS_WIN) + (size_t)l * D * DIN, p.in[I_NMG] + l * D, scr, r, lane); continue; } r -= I_IN;
            if (r < I_OUT) { p0_transpose_item(p.in[I_WOUT] + (size_t)l * D * D, D, D, (bf16_t*)(ws + WS_WOUT) + (size_t)l * D * D, p.in[I_MONG] + l * D, scr, r, lane); continue; } r -= I_OUT;
            if (r < I_UP) { p0_transpose_item(p.in[I_WUP] + (size_t)l * D * FF, D, FF, (bf16_t*)(ws + WS_WUP) + (size_t)l * D * FF, p.in[I_NMLPG] + l * D, scr, r, lane); continue; } r -= I_UP;
            if (r < I_DN) { p0_transpose_item(p.in[I_WDN] + (size_t)l * D * FF, FF, D, (bf16_t*)(ws + WS_WDN) + (size_t)l * D * FF, nullptr, scr, r, lane); continue; } r -= I_DN;
            p0_transpose_item(p.in[I_WGLU] + (size_t)l * 65536, 256, 256, (bf16_t*)(ws + WS_WGLU) + (size_t)l * 65536, nullptr, scr, r, lane);
        }
    }
    {
        float* ssq0 = (float*)(ws + WS_SSQP); bf16_t* XB = (bf16_t*)(ws + WS_XB);
        for (int mb = gw * 16; mb < T; mb += NGW * 16) {
            float keep = 0.f;
#pragma unroll 4
            for (int i = 0; i < 16; ++i) { const int m = mb + i;
                const f32x4* xr = (const f32x4*)(p.in[I_X] + (size_t)m * D) + lane; f32x4 v[4]; float s = 0.f;
#pragma unroll
                for (int j = 0; j < 4; ++j) { v[j] = xr[64 * j]; s += (v[j][0] * v[j][0] + v[j][1] * v[j][1]) + (v[j][2] * v[j][2] + v[j][3] * v[j][3]); }
                s = wave_sum(s); if (lane == i) keep = s;
                u32x2* o8 = (u32x2*)(XB + (size_t)m * D) + lane;
#pragma unroll
                for (int j = 0; j < 4; ++j) { u32x2 w; w.x = pk2(v[j][0], v[j][1]); w.y = pk2(v[j][2], v[j][3]); o8[64 * j] = w; } }
#pragma unroll 1
            for (int i = 0; i < 16; ++i) { const float v = __shfl(keep, i); if (lane < 16) ssq0[(size_t)(mb + i) * 16 + lane] = lane == 0 ? v : 0.f; }
        }
    }
    {
        float* LB = (float*)(ws + WS_LB);
        for (int c = gt; c < 256; c += NGT) {
            const float a0 = p.in[I_LBL][c], a1 = p.in[I_LBL][256 + c], a2 = p.in[I_LBL][512 + c], a3 = p.in[I_LBL][768 + c];
            const float mx = fmaxf(fmaxf(a0, a1), fmaxf(a2, a3));
            const float e0 = expf(a0 - mx), e1 = expf(a1 - mx), e2 = expf(a2 - mx), e3 = expf(a3 - mx); const float inv = 1.f / (e0 + e1 + e2 + e3);
            const float s1 = e1 * inv, s2 = e2 * inv, s3 = e3 * inv; const float hi = 1.0f - 1e-6f;
            LB[c] = 0.f; LB[256 + c] = fminf(fmaxf(s1, 0.f), hi); LB[512 + c] = fminf(fmaxf(s1 + s2, 0.f), hi); LB[768 + c] = fminf(fmaxf(s1 + s2 + s3, 0.f), hi);
        }
        float* BT = (float*)(ws + WS_BIAS);
        for (int i = gt; i < 3 * 4 * 132; i += NGT) {
            const int pt = i / (4 * 132), hd = (i / 132) % 4, dl = i % 132; const int dil = pt == 0 ? 1 : (pt == 1 ? 4 : 16);
            float v = 0.f;
            if (dl <= 128) { const int dist = dl * dil; int bk;
                if (dist < 16) bk = dist; else { bk = 16 + (int)(logf((float)dist / 16.0f) / 4.852030263919617f * 16.0f); if (bk > 31) bk = 31; }
                v = p.in[I_RB][bk * 4 + hd]; }
            BT[i] = v;
        }
    }
    {
        bf16_t* KT = (bf16_t*)(ws + WS_S5K); bf16_t* WS_ = (bf16_t*)(ws + WS_S5WS); bf16_t* WC = (bf16_t*)(ws + WS_S5WC);
        LAS float* ebr = scr; LAS float* ebi = scr + 64 * 17;
        for (int it = gw; it < NL * 16 * 64; it += NGW) {
            const int lg = it >> 6, d = it & 63;
            float lrdt, lidt, cr, ci; s5_params(p, lg, lane, lrdt, lidt, cr, ci);
            float er, ei; s5_pow(lrdt, lidt, d, er, ei);
            const float fr_ = er * cr - ei * ci, fi_ = er * ci + ei * cr;
            const float* br = p.in[I_BRE] + ((size_t)lg * 64 + lane) * 16; const float* bi = p.in[I_BIM] + ((size_t)lg * 64 + lane) * 16;
#pragma unroll
            for (int c = 0; c < 16; ++c) { const float b0 = br[c], b1 = bi[c]; ebr[lane * 17 + c] = fr_ * b0 - fi_ * b1; ebi[lane * 17 + c] = fr_ * b1 + fi_ * b0; }
            LDS_WAIT();
            const int co = lane & 15, cb = (lane >> 4) * 4;
            const float* crp = p.in[I_CRE] + ((size_t)lg * 16 + co) * 64; const float* cip = p.in[I_CIM] + ((size_t)lg * 16 + co) * 64;
            float a0 = 0.f, a1 = 0.f, a2 = 0.f, a3 = 0.f;
            for (int q = 0; q < 64; ++q) { const float c0 = crp[q], c1 = cip[q];
                a0 += c0 * ebr[q * 17 + cb + 0] - c1 * ebi[q * 17 + cb + 0]; a1 += c0 * ebr[q * 17 + cb + 1] - c1 * ebi[q * 17 + cb + 1];
                a2 += c0 * ebr[q * 17 + cb + 2] - c1 * ebi[q * 17 + cb + 2]; a3 += c0 * ebr[q * 17 + cb + 3] - c1 * ebi[q * 17 + cb + 3]; }
            u32x2 w; w.x = pk2(a0, a1); w.y = pk2(a2, a3);
            *(u32x2*)(KT + ((size_t)it * 16 + co) * 16 + cb) = w;
            LDS_WAIT();
        }
        for (int it = gw; it < NL * 16 * 16; it += NGW) {
            const int lg = it >> 4, s4 = it & 15;
            float lrdt, lidt, cr, ci; s5_params(p, lg, lane, lrdt, lidt, cr, ci);
            const float* br = p.in[I_BRE] + ((size_t)lg * 64 + lane) * 16; const float* bi = p.in[I_BIM] + ((size_t)lg * 64 + lane) * 16;
            float b0[16], b1[16];
#pragma unroll
            for (int c = 0; c < 16; ++c) { b0[c] = br[c]; b1[c] = bi[c]; }
#pragma unroll 1
            for (int sq = 0; sq < 4; ++sq) { const int s = s4 * 4 + sq;
                float er, ei; s5_pow(lrdt, lidt, 63 - s, er, ei);
                const float fr_ = er * cr - ei * ci, fi_ = er * ci + ei * cr;
                float vr[16], vi[16];
#pragma unroll
                for (int c = 0; c < 16; ++c) { vr[c] = fr_ * b0[c] - fi_ * b1[c]; vi[c] = fr_ * b1[c] + fi_ * b0[c]; }
                bf16_t* o0 = WS_ + (((size_t)lg * 64 + s) * 128 + lane) * 16; bf16_t* o1 = WS_ + (((size_t)lg * 64 + s) * 128 + 64 + lane) * 16;
                u32x4 w;
                w.x = pk2(vr[0], vr[1]); w.y = pk2(vr[2], vr[3]); w.z = pk2(vr[4], vr[5]); w.w = pk2(vr[6], vr[7]); *(u32x4*)o0 = w;
                w.x = pk2(vr[8], vr[9]); w.y = pk2(vr[10], vr[11]); w.z = pk2(vr[12], vr[13]); w.w = pk2(vr[14], vr[15]); *(u32x4*)(o0 + 8) = w;
                w.x = pk2(vi[0], vi[1]); w.y = pk2(vi[2], vi[3]); w.z = pk2(vi[4], vi[5]); w.w = pk2(vi[6], vi[7]); *(u32x4*)o1 = w;
                w.x = pk2(vi[8], vi[9]); w.y = pk2(vi[10], vi[11]); w.z = pk2(vi[12], vi[13]); w.w = pk2(vi[14], vi[15]); *(u32x4*)(o1 + 8) = w; }
        }
        for (int it = gw; it < NL * 16 * 64; it += NGW) {
            const int lg = it >> 6, tl = it & 63;
            float lrdt, lidt, cr, ci; s5_params(p, lg, lane, lrdt, lidt, cr, ci);
            float er, ei; s5_pow(lrdt, lidt, tl + 1, er, ei);
#pragma unroll 4
            for (int co = 0; co < 16; ++co) { const float c0 = p.in[I_CRE][((size_t)lg * 16 + co) * 64 + lane], c1 = p.in[I_CIM][((size_t)lg * 16 + co) * 64 + lane];
                bf16_t* o = WC + (((size_t)lg * 64 + tl) * 16 + co) * 128;
                o[lane] = (bf16_t)f2bf(c0 * er - c1 * ei); o[64 + lane] = (bf16_t)f2bf(-(c0 * ei + c1 * er)); }
        }
    }
}

template <bool OUT>
DI void hgrn_item(const Params& p, LAS unsigned char* lds, int l, int cg) {
    int tid_o = threadIdx.x; asm volatile("" : "+v"(tid_o));
    const int tid = tid_o, lane = tid & 63, wave = tid >> 6, hd = wave >> 1, half = wave & 1;
    const bf16_t* Z = (const bf16_t*)(p.ws + WS_Z);
    LAS bf16_t* B0 = (LAS bf16_t*)(lds + hd * 27648); LAS bf16_t* B1 = B0 + 64 * 72; LAS bf16_t* B2 = B1 + 64 * 72;
    LAS float* GM = (LAS float*)(lds + 114688) + hd * 64; LAS float* GL = GM + 256; LAS float* SSA = (LAS float*)(lds + 114688) + 512;
    bf16_t* SL = (bf16_t*)(p.ws + WS_SL); const bf16_t* SL2 = (const bf16_t*)(p.ws + WS_SL2); float* DEC = (float*)(p.ws + WS_DEC);
    const int item = cg * 4 + hd;
#ifdef FORCE_LB0
    const float lb = 0.f, oml = 1.f;
#else
    const float lb = ((const float*)(p.ws + WS_LB))[l * 256 + hd * 64 + lane], oml = 1.f - lb;
#endif
    const int srow = tid >> 5, shd = (tid >> 3) & 3, spc = tid & 7;
    const bf16_t* zsrc = Z + (size_t)(cg * 64 + srow) * DIN + shd * 64 + spc * 8;
    const int sdst = shd * 27648 + (srow * 72 + spc * 8) * 2;
    u32x4 wsl[4], wg[4];
    if (OUT) { const bf16_t* sp = SL2 + (size_t)item * 4096 + (32 * half) * 64;
#pragma unroll
        for (int e = 0; e < 4; ++e) { wsl[e] = *(const u32x4*)(sp + (lane + 64 * e) * 8); wg[e] = *(const u32x4*)(zsrc + (size_t)(16 * e) * DIN + ZG); } }
    __syncthreads();
    { u32x4 wf[4], wi[4], wq[4];
#pragma unroll
      for (int sub = 0; sub < 4; ++sub) { wf[sub] = *(const u32x4*)(zsrc + (size_t)(16 * sub) * DIN + ZF); wi[sub] = *(const u32x4*)(zsrc + (size_t)(16 * sub) * DIN + ZI);
          if (OUT) wq[sub] = *(const u32x4*)(zsrc + (size_t)(16 * sub) * DIN + ZQ); }
#pragma unroll
      for (int sub = 0; sub < 4; ++sub) { *(LAS u32x4*)(lds + sdst + 9216 + sub * 16 * 144) = wf[sub]; *(LAS u32x4*)(lds + sdst + 18432 + sub * 16 * 144) = wi[sub];
          if (OUT) *(LAS u32x4*)(lds + sdst + sub * 16 * 144) = wq[sub]; } }
    __syncthreads();
    float g[32]; float run = 0.f;
#pragma unroll
    for (int j = 0; j < 32; ++j) { const float fz = bf2f(B1[(half * 32 + j) * 72 + lane]); const float sg = sigmoidf_(fz); const float f = lb + oml * sg;
        run += __logf(fmaxf(f, 1e-30f)); g[j] = run; }
    if (half == 0) GM[lane] = run;
    __syncthreads();
    const float gm = GM[lane];
    if (half) {
#pragma unroll
        for (int j = 0; j < 32; ++j) g[j] += gm; }
    const int c0 = lane & 31, h = lane >> 5;
    if constexpr (!OUT) {
        if (half) GL[lane] = run + gm;
        __syncthreads();
        const float gl = GL[lane];
        bf16_t kv[32], ivr[32];
#pragma unroll
        for (int j = 0; j < 32; ++j) { const int t = half * 32 + j; const float e = __expf(gl - g[j]); const float kj = oml * (1.f - sigmoidf_(bf2f(B1[t * 72 + lane])));
            kv[j] = (bf16_t)f2bf(kj * e); ivr[j] = B2[t * 72 + lane]; }
        __syncthreads();
#pragma unroll
        for (int j = 0; j < 32; ++j) { const int t = half * 32 + j; B1[lane * 72 + t] = kv[j]; B2[lane * 72 + t] = ivr[j]; }
        __syncthreads();
#pragma unroll
        for (int kt = 0; kt < 2; ++kt) { const f32x16 a = mma_lds<64>(B2 + 32 * half * 72, 72, B1 + 32 * kt * 72, 72, zero16(), lane);
#pragma unroll
            for (int i = 0; i < 16; ++i) SL[(size_t)item * 4096 + (32 * half + crow(i, h)) * 64 + 32 * kt + c0] = (bf16_t)f2bf(a[i]); }
        if (half == 0) DEC[item * 64 + lane] = __expf(gl);
    } else {
        if (half == 0) GL[lane] = __expf(gm);
        bf16_t ivr[32];
#pragma unroll
        for (int j = 0; j < 32; ++j) { const int t = half * 32 + j; const float q = bf2f(B0[t * 72 + lane]); const float kj = oml * (1.f - sigmoidf_(bf2f(B1[t * 72 + lane])));
            const float e1 = __expf(fminf(g[j] - gm, 80.f)), e2 = __expf(fminf(gm - g[j], 80.f));
            ivr[j] = B2[t * 72 + lane];
            B0[t * 72 + lane] = (bf16_t)f2bf(q * e1); B1[t * 72 + lane] = (bf16_t)f2bf(kj * e2); }
        __syncthreads();
#pragma unroll
        for (int j = 0; j < 32; ++j) B2[lane * 72 + half * 32 + j] = ivr[j];
        __syncthreads();
        f32x16 s0 = mma_lds<64>(B0 + 32 * half * 72, 72, B1, 72, zero16(), lane);
        f32x16 s1 = zero16(); if (half) s1 = mma_lds<64>(B0 + 32 * half * 72, 72, B1 + 32 * 72, 72, zero16(), lane);
        __syncthreads();
#pragma unroll
        for (int i = 0; i < 16; ++i) { const int row = 32 * half + crow(i, h);
            B1[row * 72 + c0] = (bf16_t)f2bf(c0 <= row ? s0[i] : 0.f); B1[row * 72 + 32 + c0] = (bf16_t)f2bf(32 + c0 <= row ? s1[i] : 0.f); }
        __syncthreads();
        f32x16 o0 = mma_lds<64>(B1 + 32 * half * 72, 72, B2, 72, zero16(), lane);
        f32x16 o1 = mma_lds<64>(B1 + 32 * half * 72, 72, B2 + 32 * 72, 72, zero16(), lane);
        __syncthreads();
        {
#pragma unroll
          for (int e = 0; e < 4; ++e) { const int pc = lane + 64 * e, row = pc >> 3, k0 = (pc & 7) * 8; const LAS float* eg = GL + k0;
              u32x4 o; o.x = pk2(bflo(wsl[e].x) * eg[0], bfhi(wsl[e].x) * eg[1]); o.y = pk2(bflo(wsl[e].y) * eg[2], bfhi(wsl[e].y) * eg[3]);
              o.z = pk2(bflo(wsl[e].z) * eg[4], bfhi(wsl[e].z) * eg[5]); o.w = pk2(bflo(wsl[e].w) * eg[6], bfhi(wsl[e].w) * eg[7]);
              *(LAS u32x4*)(B2 + (32 * half + row) * 72 + k0) = o;
              *(LAS u32x4*)(lds + sdst + 9216 + e * 16 * 144) = wg[e]; } }
        __syncthreads();
        o0 = mma_lds<64>(B0 + 32 * half * 72, 72, B2, 72, o0, lane);
        o1 = mma_lds<64>(B0 + 32 * half * 72, 72, B2 + 32 * 72, 72, o1, lane);
        const float* ng = p.in[I_HNG] + l * 256 + hd * 64; const float ng0 = ng[c0], ng1 = ng[32 + c0];
#pragma unroll
        for (int i = 0; i < 16; ++i) { const int row = 32 * half + crow(i, h);
            const float ss = half_sum(o0[i] * o0[i] + o1[i] * o1[i]); const float rs = rsqrtf(ss * (1.0f / 64.0f) + EPS);
            const float g0 = bf2f(B1[row * 72 + c0]), g1 = bf2f(B1[row * 72 + 32 + c0]);
            const float v0 = o0[i] * rs * ng0 * g0 * sigmoidf_(g0), v1 = o1[i] * rs * ng1 * g1 * sigmoidf_(g1);
            o0[i] = v0; o1[i] = v1; const float s2 = half_sum(v0 * v0 + v1 * v1); if (c0 == 0) SSA[hd * 64 + row] = s2; }
        __syncthreads();
        bf16_t* Y = (bf16_t*)(p.ws + WS_YCAT);
#pragma unroll
        for (int i = 0; i < 16; ++i) { const int row = 32 * half + crow(i, h); const size_t tok = (size_t)cg * 64 + row;
            const float tot = (SSA[row] + SSA[64 + row]) + (SSA[128 + row] + SSA[192 + row]); const float r2 = rsqrtf(tot * (1.0f / 256.0f) + EPS);
            Y[tok * D + YA + hd * 64 + c0] = (bf16_t)f2bf(o0[i] * r2); Y[tok * D + YA + hd * 64 + 32 + c0] = (bf16_t)f2bf(o1[i] * r2); }
    }
}
DI void hgrn_scan_item(const Params& p, int hb) {
    int tid_o = threadIdx.x; asm volatile("" : "+v"(tid_o));
    const int e = hb * 512 + tid_o, bh = e >> 12, b = bh >> 2, hd = bh & 3, vk = e & 4095, k = vk & 63;
    const bf16_t* SL = (const bf16_t*)(p.ws + WS_SL); bf16_t* SL2 = (bf16_t*)(p.ws + WS_SL2); const float* DEC = (const float*)(p.ws + WS_DEC);
    float st = 0.f;
    for (int c8 = 0; c8 < 128; c8 += 16) { float tmp[16], dc[16];
#pragma unroll
        for (int u = 0; u < 16; ++u) { const int item = (b * 128 + c8 + u) * 4 + hd; tmp[u] = bf2f(SL[(size_t)item * 4096 + vk]); dc[u] = DEC[item * 64 + k]; }
#pragma unroll
        for (int u = 0; u < 16; ++u) { const int item = (b * 128 + c8 + u) * 4 + hd; SL2[(size_t)item * 4096 + vk] = (bf16_t)f2bf(st); st = dc[u] * st + tmp[u]; } }
}

DI void conv_item(const Params& p, LAS unsigned char* lds, int l, int ti) {
    int tid_o = threadIdx.x; asm volatile("" : "+v"(tid_o));
    const int tid = tid_o, lane = tid & 63, wave = tid >> 6, c = tid & 255, hf = tid >> 8, wv = wave & 3;
    LAS float* Hs = (LAS float*)lds; LAS float* ST = (LAS float*)(lds + 98304); LAS float* ST2 = ST + 512;
    const bf16_t* Z = (const bf16_t*)(p.ws + WS_Z); bf16_t* Y = (bf16_t*)(p.ws + WS_YCAT);
    const int tok0 = ti * 64, pos0 = (ti & 127) * 64;
    const float* cw = p.in[I_CW] + (size_t)l * 31 * 256 + c; float w[31];
#pragma unroll
    for (int jj = 0; jj < 31; ++jj) w[jj] = cw[jj * 256];
    const float cb = p.in[I_CB][l * 256 + c];
    const float lng = p.in[I_CLG][l * 256 + c], lnb = p.in[I_CLB][l * 256 + c];
    __syncthreads();
    { u32x4 vw[6], gw_[6];
#pragma unroll
      for (int k = 0; k < 6; ++k) { const int pid = tid + 512 * k, row = pid >> 5, pc = pid & 31, pos = pos0 - 30 + row; const bool ok = (row < 94) && (pos >= 0);
          const size_t tok = ok ? (size_t)(tok0 - 30 + row) : (size_t)tok0; vw[k] = *(const u32x4*)(Z + tok * DIN + ZBV + pc * 8); gw_[k] = *(const u32x4*)(Z + tok * DIN + ZBG + pc * 8); }
#pragma unroll
      for (int k = 0; k < 6; ++k) { const int pid = tid + 512 * k, row = pid >> 5, pc = pid & 31, pos = pos0 - 30 + row; const bool ok = (row < 94) && (pos >= 0);
          if (row < 94) { f32x4 h0, h1;
              h0[0] = bflo(vw[k].x) * sigmoidf_(bflo(gw_[k].x)); h0[1] = bfhi(vw[k].x) * sigmoidf_(bfhi(gw_[k].x)); h0[2] = bflo(vw[k].y) * sigmoidf_(bflo(gw_[k].y)); h0[3] = bfhi(vw[k].y) * sigmoidf_(bfhi(gw_[k].y));
              h1[0] = bflo(vw[k].z) * sigmoidf_(bflo(gw_[k].z)); h1[1] = bfhi(vw[k].z) * sigmoidf_(bfhi(gw_[k].z)); h1[2] = bflo(vw[k].w) * sigmoidf_(bflo(gw_[k].w)); h1[3] = bfhi(vw[k].w) * sigmoidf_(bfhi(gw_[k].w));
              if (!ok) { h0 = (f32x4){0.f, 0.f, 0.f, 0.f}; h1 = h0; }
              *(LAS f32x4*)(Hs + row * 256 + pc * 8) = h0; *(LAS f32x4*)(Hs + row * 256 + pc * 8 + 4) = h1; } } }
    __syncthreads();
    LAS float* OT2 = (LAS float*)(lds + 98304);
    LAS float* STAT = (LAS float*)(lds + 131072); LAS float* STAT2 = STAT + 64;
    const int rtl = tid >> 4, rpart = tid & 15;
#pragma unroll 1
    for (int ps = 0; ps < 2; ++ps) { const int tb = hf * 32 + ps * 16;
        float o[16];
        { float hr[46];
#pragma unroll
          for (int r = 0; r < 46; ++r) hr[r] = Hs[(tb + r) * 256 + c];
#pragma unroll
          for (int j = 0; j < 16; ++j) { float a = cb;
#pragma unroll
            for (int jj = 0; jj < 31; ++jj) a += w[jj] * hr[j + jj];
            o[j] = a; } }
#pragma unroll
        for (int j = 0; j < 16; ++j) OT2[(hf * 16 + j) * 256 + c] = o[j];
        __syncthreads();
        { const LAS f32x4* q = (const LAS f32x4*)(OT2 + rtl * 256 + rpart * 16); float s1 = 0.f, s2 = 0.f;
#pragma unroll
          for (int e = 0; e < 4; ++e) { const f32x4 v = q[e]; s1 += (v[0] + v[1]) + (v[2] + v[3]); s2 += (v[0] * v[0] + v[1] * v[1]) + (v[2] * v[2] + v[3] * v[3]); }
#pragma unroll
          for (int off = 1; off < 16; off <<= 1) { s1 += __shfl_xor(s1, off); s2 += __shfl_xor(s2, off); }
          if (rpart == 0) { const float mu = s1 * (1.0f / 256.0f); const float var = fmaxf(s2 * (1.0f / 256.0f) - mu * mu, 0.f); STAT[rtl * 2] = mu; STAT[rtl * 2 + 1] = rsqrtf(var + EPS); } }
        __syncthreads();
#pragma unroll
        for (int j = 0; j < 16; ++j) { const float mu = STAT[(hf * 16 + j) * 2], rsd = STAT[(hf * 16 + j) * 2 + 1];
            const float y = (o[j] - mu) * rsd * lng + lnb; const float sv = y * sigmoidf_(y); o[j] = sv; OT2[(hf * 16 + j) * 256 + c] = sv; }
        __syncthreads();
        { const LAS f32x4* q = (const LAS f32x4*)(OT2 + rtl * 256 + rpart * 16); float s3 = 0.f;
#pragma unroll
          for (int e = 0; e < 4; ++e) { const f32x4 v = q[e]; s3 += (v[0] * v[0] + v[1] * v[1]) + (v[2] * v[2] + v[3] * v[3]); }
#pragma unroll
          for (int off = 1; off < 16; off <<= 1) s3 += __shfl_xor(s3, off);
          if (rpart == 0) STAT2[rtl] = rsqrtf(s3 * (1.0f / 256.0f) + EPS); }
        __syncthreads();
#pragma unroll
        for (int j = 0; j < 16; ++j) Y[(size_t)(tok0 + tb + j) * D + YB + c] = (bf16_t)f2bf(o[j] * STAT2[hf * 16 + j]);
    }
}

DI bf16x8 ldg8(const bf16_t* p) { return *(const bf16x8*)p; }
DI void s5_local_item(const Params& p, LAS unsigned char* lds, int l, int bi) {
    int tid_o = threadIdx.x; asm volatile("" : "+v"(tid_o));
    const int tid = tid_o, lane = tid & 63, wave = tid >> 6;
    const int gh = bi & 1, cb = (bi >> 1) & 15, pt = bi >> 5, g = gh * 8 + wave, c0 = lane & 31, h = lane >> 5, lg = l * 16 + g;
    LAS bf16_t* UT = (LAS bf16_t*)lds;
    const bf16_t* Z = (const bf16_t*)(p.ws + WS_Z);
    const int sm = tid >> 4, spc = tid & 15;
    const bf16_t* zst = Z + (size_t)((cb * 32 + sm) * 64) * DIN + ZCU + gh * 128 + spc * 8;
    const int ust = (sm * 136 + spc * 8) * 2;
    const bf16_t* wsp = (const bf16_t*)(p.ws + WS_S5WS) + ((size_t)lg * 64 * 128 + pt * 32 + c0) * 16 + 8 * h;
    u32x4 pf[8];
#pragma unroll
    for (int e = 0; e < 8; ++e) pf[e] = *(const u32x4*)(zst + (size_t)e * DIN);
    f32x16 acc = zero16();
    __syncthreads();
    for (int b = 0; b < 8; ++b) { const int s0 = 8 * b;
#pragma unroll
        for (int e = 0; e < 8; ++e) *(LAS u32x4*)(lds + ust + e * (32 * 136 * 2)) = pf[e];
        __syncthreads();
        if (b + 1 < 8) {
#pragma unroll
            for (int e = 0; e < 8; ++e) pf[e] = *(const u32x4*)(zst + (size_t)(s0 + 8 + e) * DIN); }
        bf16x8 bf[8];
#pragma unroll
        for (int e = 0; e < 8; ++e) bf[e] = ldg8(wsp + (size_t)(s0 + e) * 2048);
#pragma unroll
        for (int e = 0; e < 8; ++e) acc = __builtin_amdgcn_mfma_f32_32x32x16_bf16(*(const LAS bf16x8*)(UT + (e * 32 + c0) * 136 + wave * 16 + 8 * h), bf[e], acc, 0, 0, 0);
        __syncthreads();
    }
    float* HL = (float*)(p.ws + WS_S5H);
#pragma unroll
    for (int i = 0; i < 16; ++i) HL[((size_t)(cb * 32 + crow(i, h)) * 16 + g) * 128 + pt * 32 + c0] = acc[i];
}
DI void s5_scan_item(const Params& p, int l, int sb) {
    int tid_o = threadIdx.x; asm volatile("" : "+v"(tid_o));
    const int e = sb * 512 + tid_o, b = e >> 10, g = (e >> 6) & 15, pp = e & 63;
    float lrdt, lidt, cr, ci; s5_params(p, l * 16 + g, pp, lrdt, lidt, cr, ci);
    float ar, ai; s5_pow(lrdt, lidt, 64, ar, ai);
    const float* HL = (const float*)(p.ws + WS_S5H); float* HO = (float*)(p.ws + WS_S5H2); float hr = 0.f, hi = 0.f;
    for (int c8 = 0; c8 < 128; c8 += 16) { float tr[16], ti[16];
#pragma unroll
        for (int u = 0; u < 16; ++u) { const size_t idx = ((size_t)(b * 128 + c8 + u) * 16 + g) * 128; tr[u] = HL[idx + pp]; ti[u] = HL[idx + 64 + pp]; }
#pragma unroll
        for (int u = 0; u < 16; ++u) { const size_t idx = ((size_t)(b * 128 + c8 + u) * 16 + g) * 128; HO[idx + pp] = hr; HO[idx + 64 + pp] = hi;
            const float nr = ar * hr - ai * hi + tr[u], ni = ar * hi + ai * hr + ti[u]; hr = nr; hi = ni; } }
}
DI void s5_out_item(const Params& p, LAS unsigned char* lds, int l, int bi) {
    int tid_o = threadIdx.x; asm volatile("" : "+v"(tid_o));
    const int tid = tid_o, lane = tid & 63, wave = tid >> 6;
    const int gh = bi & 1, cb = (bi >> 1) & 15, pr = bi >> 5, g = gh * 8 + wave, c0 = lane & 31, h = lane >> 5, lg = l * 16 + g;
    LAS bf16_t* UT = (LAS bf16_t*)lds;
    LAS bf16_t* OT = (LAS bf16_t*)(lds + 69632);
    const bf16_t* Z = (const bf16_t*)(p.ws + WS_Z);
    const bf16_t* kt = (const bf16_t*)(p.ws + WS_S5K) + (size_t)lg * 64 * 256;
    const float* ha = (const float*)(p.ws + WS_S5H2) + ((size_t)(cb * 32 + c0) * 16 + g) * 128 + 8 * h;
    const int co = c0 & 15; const float dsk = p.in[I_S5D][l * 256 + g * 16 + co];
    const int jt0 = pr, jt1 = 31 - pr, tl0 = 2 * jt0 + (c0 >> 4), tl1 = 2 * jt1 + (c0 >> 4);
    const int sm = tid >> 4, spc = tid & 15;
    const bf16_t* zst = Z + (size_t)((cb * 32 + sm) * 64) * DIN + ZCU + gh * 128 + spc * 8;
    const int ust = (sm * 136 + spc * 8) * 2;
    const int nb = (2 * jt1 + 2 + 7) >> 3;
    u32x4 pf[8];
#pragma unroll
    for (int e = 0; e < 8; ++e) pf[e] = *(const u32x4*)(zst + (size_t)e * DIN);
    f32x16 acc0 = zero16(), acc1 = zero16();
    { const bf16_t* wc0 = (const bf16_t*)(p.ws + WS_S5WC) + (((size_t)lg * 64 + tl0) * 16 + co) * 128 + 8 * h;
      const bf16_t* wc1 = (const bf16_t*)(p.ws + WS_S5WC) + (((size_t)lg * 64 + tl1) * 16 + co) * 128 + 8 * h;
      f32x4 x0[8], x1[8];
#pragma unroll
      for (int ks = 0; ks < 8; ++ks) { x0[ks] = *(const f32x4*)(ha + ks * 16); x1[ks] = *(const f32x4*)(ha + ks * 16 + 4); }
#pragma unroll
      for (int ks = 0; ks < 8; ++ks) { u32x4 w; w.x = pk2(x0[ks][0], x0[ks][1]); w.y = pk2(x0[ks][2], x0[ks][3]); w.z = pk2(x1[ks][0], x1[ks][1]); w.w = pk2(x1[ks][2], x1[ks][3]);
        const bf16x8 af = __builtin_bit_cast(bf16x8, w);
        acc0 = __builtin_amdgcn_mfma_f32_32x32x16_bf16(af, ldg8(wc0 + ks * 16), acc0, 0, 0, 0);
        acc1 = __builtin_amdgcn_mfma_f32_32x32x16_bf16(af, ldg8(wc1 + ks * 16), acc1, 0, 0, 0); } }
    __syncthreads();
    for (int b = 0; b < nb; ++b) { const int s0 = 8 * b;
#pragma unroll
        for (int e = 0; e < 8; ++e) *(LAS u32x4*)(lds + ust + e * (32 * 136 * 2)) = pf[e];
        __syncthreads();
        if (b + 1 < nb) {
#pragma unroll
            for (int e = 0; e < 8; ++e) pf[e] = *(const u32x4*)(zst + (size_t)(s0 + 8 + e) * DIN); }
        const bool use0 = s0 <= 2 * jt0 + 1;
        bf16x8 b0[8], b1[8];
#pragma unroll
        for (int e = 0; e < 8; ++e) { const int d1 = tl1 - (s0 + e); b1[e] = ldg8(kt + ((size_t)(d1 < 0 ? 0 : d1) * 16 + co) * 16 + 8 * h);
            if (use0) { const int d0 = tl0 - (s0 + e); b0[e] = ldg8(kt + ((size_t)(d0 < 0 ? 0 : d0) * 16 + co) * 16 + 8 * h); } }
#pragma unroll
        for (int e = 0; e < 8; ++e) { const bf16x8 af = *(const LAS bf16x8*)(UT + (e * 32 + c0) * 136 + wave * 16 + 8 * h);
            const int d1 = tl1 - (s0 + e); bf16x8 bb = b1[e]; if (d1 < 0) bb = (bf16x8){0, 0, 0, 0, 0, 0, 0, 0};
            acc1 = __builtin_amdgcn_mfma_f32_32x32x16_bf16(af, bb, acc1, 0, 0, 0);
            if (use0) { const int d0 = tl0 - (s0 + e); bf16x8 ba = b0[e]; if (d0 < 0) ba = (bf16x8){0, 0, 0, 0, 0, 0, 0, 0};
                acc0 = __builtin_amdgcn_mfma_f32_32x32x16_bf16(af, ba, acc0, 0, 0, 0); } }
        __syncthreads();
    }
#pragma unroll
    for (int q = 0; q < 2; ++q) { const int tl = q ? tl1 : tl0;
#pragma unroll
        for (int i = 0; i < 16; ++i) { const int m = crow(i, h); const size_t tok = (size_t)(cb * 32 + m) * 64 + tl; const float u = bf2f(Z[tok * DIN + ZCU + g * 16 + co]);
            const float y = (q ? acc1[i] : acc0[i]) + dsk * u; const float ge = y * sigmoidf_(1.5957691216057308f * (y + 0.044715f * y * y * y));
            OT[(q * 64 + m * 2 + (c0 >> 4)) * 136 + wave * 16 + co] = (bf16_t)f2bf(ge); } }
    __syncthreads();
    { const int tau = tid >> 2, qq = tau >> 6, m = (tau >> 1) & 31, t2 = tau & 1, qt = tid & 3; const int jt = qq ? jt1 : jt0;
      const size_t tok = (size_t)(cb * 32 + m) * 64 + 2 * jt + t2;
      const LAS u32x4* src = (const LAS u32x4*)(OT + tau * 136 + qt * 32); u32x4* dst = (u32x4*)((bf16_t*)(p.ws + WS_YPRE) + tok * 256 + gh * 128 + qt * 32);
#pragma unroll
      for (int e = 0; e < 4; ++e) dst[e] = src[e]; }
}

DI void attn_item(const Params& p, LAS unsigned char* lds, int l, int pt, int id) {
    int tid_o = threadIdx.x; asm volatile("" : "+v"(tid_o));
    const int tid = tid_o, lane = tid & 63, wave = tid >> 6;
    const int dil = pt == 0 ? 1 : (pt == 1 ? 4 : 16), nblk = 32 / dil;
    const int b = id >> 7, hd = (id >> 5) & 3, rn = id & 31, r = rn / nblk, n = rn % nblk;
    LAS bf16_t* Ks = (LAS bf16_t*)lds;
    LAS bf16_t* Vt = (LAS bf16_t*)(lds + 55296);
    LAS float* BT = (LAS float*)(lds + 55296 + 50176);
    const bf16_t* Z = (const bf16_t*)(p.ws + WS_Z);
    const bf16_t* OP = (const bf16_t*)(p.ws + (pt == 1 ? WS_O0 : WS_O1)); const float* LP = (const float*)(p.ws + (pt == 1 ? WS_LSE : WS_LSE1));
    bf16_t* ON = pt == 2 ? (bf16_t*)(p.ws + WS_Z) + ZOD : (bf16_t*)(p.ws + (pt == 0 ? WS_O0 : WS_O1)); const int onp = pt == 2 ? DIN : 256;
    float* LN = (float*)(p.ws + (pt == 0 ? WS_LSE : WS_LSE1));
    const size_t tokb = (size_t)b * SEQ;
    const int c0 = lane & 31, h = lane >> 5;
    const int qi = 32 * wave + c0; const size_t tokq = tokb + (size_t)(n * 256 + qi) * dil + r;
    u32x4 qraw[4]; u32x2 oprev[2][4]; float mprev = 0.f;
#pragma unroll
    for (int ks = 0; ks < 4; ++ks) qraw[ks] = *(const u32x4*)(Z + tokq * DIN + ZDQ + hd * 64 + ks * 16 + 8 * h);
    if (pt > 0) { mprev = LP[tokq * 4 + hd];
#pragma unroll
        for (int vt = 0; vt < 2; ++vt)
#pragma unroll
            for (int g4 = 0; g4 < 4; ++g4) oprev[vt][g4] = *(const u32x2*)(OP + tokq * 256 + hd * 64 + 32 * vt + 8 * g4 + 4 * h); }
    __syncthreads();
    if (tid < 132) BT[tid] = ((const float*)(p.ws + WS_BIAS))[(pt * 4 + hd) * 132 + tid];
    { const float* kg = p.in[I_KG] + l * 64 + (tid & 7) * 8; float kgv[8];
#pragma unroll
      for (int e = 0; e < 8; ++e) kgv[e] = kg[e];
      u32x4 kwv[6], vwv[6];
#pragma unroll
      for (int it = 0; it < 6; ++it) { const int idx = tid + 512 * it, row = idx >> 3, c = idx & 7, si = n * 256 - 128 + row;
        const size_t tok = tokb + (size_t)(si < 0 ? 0 : si) * dil + r;
        kwv[it] = *(const u32x4*)(Z + tok * DIN + ZDK + hd * 64 + c * 8); vwv[it] = *(const u32x4*)(Z + tok * DIN + ZDV + hd * 64 + c * 8); }
#pragma unroll
      for (int it = 0; it < 6; ++it) { const int idx = tid + 512 * it, row = idx >> 3, c = idx & 7, si = n * 256 - 128 + row;
        u32x4 kw = kwv[it], vw = vwv[it];
        if (si < 0) { kw = (u32x4){0u, 0u, 0u, 0u}; vw = (u32x4){0u, 0u, 0u, 0u}; }
        float kf[8]; kf[0] = bflo(kw.x); kf[1] = bfhi(kw.x); kf[2] = bflo(kw.y); kf[3] = bfhi(kw.y); kf[4] = bflo(kw.z); kf[5] = bfhi(kw.z); kf[6] = bflo(kw.w); kf[7] = bfhi(kw.w);
        float ss = 0.f;
#pragma unroll
        for (int e = 0; e < 8; ++e) ss += kf[e] * kf[e];
        ss += __shfl_xor(ss, 1); ss += __shfl_xor(ss, 2); ss += __shfl_xor(ss, 4);
        const float rs = rsqrtf(ss * (1.0f / 64.0f) + EPS);
        u32x4 o; o.x = pk2(kf[0] * rs * kgv[0], kf[1] * rs * kgv[1]); o.y = pk2(kf[2] * rs * kgv[2], kf[3] * rs * kgv[3]); o.z = pk2(kf[4] * rs * kgv[4], kf[5] * rs * kgv[5]); o.w = pk2(kf[6] * rs * kgv[6], kf[7] * rs * kgv[7]);
        *(LAS u32x4*)(Ks + row * 72 + c * 8) = o;
        LAS bf16_t* vp = Vt + (c * 8) * 392 + row;
        vp[0 * 392] = (bf16_t)(vw.x & 0xffffu); vp[1 * 392] = (bf16_t)(vw.x >> 16); vp[2 * 392] = (bf16_t)(vw.y & 0xffffu); vp[3 * 392] = (bf16_t)(vw.y >> 16);
        vp[4 * 392] = (bf16_t)(vw.z & 0xffffu); vp[5 * 392] = (bf16_t)(vw.z >> 16); vp[6 * 392] = (bf16_t)(vw.w & 0xffffu); vp[7 * 392] = (bf16_t)(vw.w >> 16); } }
    __syncthreads();
    bf16x8 qf[4];
    { float qv[4][8]; float ss = 0.f;
#pragma unroll
      for (int ks = 0; ks < 4; ++ks) { const u32x4 w = qraw[ks];
        qv[ks][0] = bflo(w.x); qv[ks][1] = bfhi(w.x); qv[ks][2] = bflo(w.y); qv[ks][3] = bfhi(w.y); qv[ks][4] = bflo(w.z); qv[ks][5] = bfhi(w.z); qv[ks][6] = bflo(w.w); qv[ks][7] = bfhi(w.w);
#pragma unroll
        for (int e = 0; e < 8; ++e) ss += qv[ks][e] * qv[ks][e]; }
      ss += __shfl_xor(ss, 32);
      const float rs = rsqrtf(ss * (1.0f / 64.0f) + EPS) * 0.125f;
#pragma unroll
      for (int ks = 0; ks < 4; ++ks) { const float* qg = p.in[I_QG] + l * 64 + ks * 16 + 8 * h; const f32x4 g0 = *(const f32x4*)qg, g1 = *(const f32x4*)(qg + 4);
        u32x4 w; w.x = pk2(qv[ks][0] * rs * g0[0], qv[ks][1] * rs * g0[1]); w.y = pk2(qv[ks][2] * rs * g0[2], qv[ks][3] * rs * g0[3]);
        w.z = pk2(qv[ks][4] * rs * g1[0], qv[ks][5] * rs * g1[1]); w.w = pk2(qv[ks][6] * rs * g1[2], qv[ks][7] * rs * g1[3]);
        qf[ks] = __builtin_bit_cast(bf16x8, w); } }
    f32x16 acc[5];
#pragma unroll
    for (int c = 0; c < 5; ++c) { acc[c] = zero16(); const LAS bf16_t* kb = Ks + (32 * wave + 32 * c + c0) * 72 + 8 * h;
#pragma unroll
        for (int ks = 0; ks < 4; ++ks) acc[c] = __builtin_amdgcn_mfma_f32_32x32x16_bf16(*(const LAS bf16x8*)(kb + ks * 16), qf[ks], acc[c], 0, 0, 0); }
    float mx = -1e30f;
#pragma unroll
    for (int c = 0; c < 5; ++c)
#pragma unroll
        for (int i = 0; i < 16; ++i) { const int kr = crow(i, h); const int delta = 128 + c0 - 32 * c - kr; const int jl = 32 * wave + 32 * c + kr;
            const bool valid = (delta >= 0) && (delta <= 128) && (n * 256 - 128 + jl >= 0);
            const int dcl = delta < 0 ? 0 : (delta > 128 ? 128 : delta);
            const float lgt = valid ? acc[c][i] + BT[dcl] : -1e30f; acc[c][i] = lgt; mx = fmaxf(mx, lgt); }
    mx = fmaxf(mx, __shfl_xor(mx, 32));
    float mnew = mx;
    if (pt > 0) mnew = fmaxf(mx, mprev);
    float lsum = 0.f;
#pragma unroll
    for (int c = 0; c < 5; ++c)
#pragma unroll
        for (int i = 0; i < 16; ++i) { const float pv = __expf(acc[c][i] - mnew); acc[c][i] = pv; lsum += pv; }
    lsum += __shfl_xor(lsum, 32);
    f32x16 o[2]; o[0] = zero16(); o[1] = zero16();
#pragma unroll
    for (int c = 0; c < 5; ++c)
#pragma unroll
        for (int s = 0; s < 2; ++s) { u32x4 pw; pw.x = pk2(acc[c][8 * s + 0], acc[c][8 * s + 1]); pw.y = pk2(acc[c][8 * s + 2], acc[c][8 * s + 3]); pw.z = pk2(acc[c][8 * s + 4], acc[c][8 * s + 5]); pw.w = pk2(acc[c][8 * s + 6], acc[c][8 * s + 7]);
            const bf16x8 pf = __builtin_bit_cast(bf16x8, pw);
#pragma unroll
            for (int vt = 0; vt < 2; ++vt) { const LAS bf16_t* va = Vt + (32 * vt + c0) * 392 + 32 * wave + 32 * c + 16 * s + 4 * h;
                const s16x4 lo = *(const LAS s16x4*)va, hi = *(const LAS s16x4*)(va + 8);
                const bf16x8 vf = __builtin_shufflevector(lo, hi, 0, 1, 2, 3, 4, 5, 6, 7);
                o[vt] = __builtin_amdgcn_mfma_f32_32x32x16_bf16(vf, pf, o[vt], 0, 0, 0); } }
    float sp = 0.f; if (pt > 0) sp = __expf(mprev - mnew);
    const float ltot = lsum + sp, inv = __builtin_amdgcn_rcpf(ltot);
#pragma unroll
    for (int vt = 0; vt < 2; ++vt)
#pragma unroll
        for (int g4 = 0; g4 < 4; ++g4) { const int ch = hd * 64 + 32 * vt + 8 * g4 + 4 * h; bf16_t* yo = ON + tokq * onp + ch;
            float v0 = o[vt][4 * g4 + 0], v1 = o[vt][4 * g4 + 1], v2 = o[vt][4 * g4 + 2], v3 = o[vt][4 * g4 + 3];
            if (pt > 0) { const u32x2 w = oprev[vt][g4]; v0 += sp * bflo(w.x); v1 += sp * bfhi(w.x); v2 += sp * bflo(w.y); v3 += sp * bfhi(w.y); }
            u32x2 w; w.x = pk2(v0 * inv, v1 * inv); w.y = pk2(v2 * inv, v3 * inv); *(u32x2*)yo = w; }
    if (h == 0 && pt < 2) __hip_atomic_store(LN + tokq * 4 + hd, mnew + __logf(ltot), __ATOMIC_RELAXED, __HIP_MEMORY_SCOPE_AGENT);
}

#define RLX_AGENT __ATOMIC_RELAXED, __HIP_MEMORY_SCOPE_AGENT
#define XB_TMO      128
#define XB_XCNT(j)  (256  + 64 * (j))
#define XB_XSUB(j)  (1280 + 64 * (j))
#define XB_XGEN(j)  (2304 + 64 * (j))
#define XB_TOP      3328
#define XB_TOPGEN   3392
#define XCD_BAR_WORDS 3456
#define XB_SPIN_CAP (1u << 18)

__device__ __forceinline__ unsigned xb_ld(unsigned* p)              { return __hip_atomic_load(p, __ATOMIC_RELAXED, __HIP_MEMORY_SCOPE_AGENT); }
__device__ __forceinline__ unsigned xb_add(unsigned* p, unsigned v) { return __hip_atomic_fetch_add(p, v, __ATOMIC_RELAXED, __HIP_MEMORY_SCOPE_AGENT); }
__device__ __forceinline__ unsigned xb_xcc_id() { return (unsigned)__builtin_amdgcn_s_getreg((3 << 11) | 20) & 0xFu; }
#define XB_SPIN(cond, bar) do { unsigned _sp = 0; while (cond) { __builtin_amdgcn_s_sleep(1); \
    if ((++_sp & 255u) == 0u) { if (xb_ld(&(bar)[XB_TMO])) break; if (_sp > XB_SPIN_CAP) { atomicAdd(&(bar)[XB_TMO], 1u); break; } } } } while (0)

struct XcdBarrier {
    unsigned* bar; unsigned x;
    volatile LAS unsigned* st;
};

__device__ __forceinline__ XcdBarrier xcd_barrier_post(unsigned* bar, volatile LAS unsigned* st) {
    XcdBarrier b; b.bar = bar; b.x = xb_xcc_id(); b.st = st;
    if (threadIdx.x == 0) (void)xb_add(&bar[XB_XCNT(b.x)], 1u);
    return b;
}
__device__ __forceinline__ void xcd_barrier_complete(unsigned* bar, unsigned x, unsigned& nloc, unsigned& nx) {
    const unsigned G = gridDim.x * gridDim.y * gridDim.z;
    unsigned sum, cnt, mine, sp = 0u;
    for (;;) {
        sum = 0u; cnt = 0u; mine = 0u;
#pragma unroll
        for (unsigned j = 0; j < 16; ++j) { const unsigned c = xb_ld(&bar[XB_XCNT(j)]); sum += c; cnt += (c > 0u) ? 1u : 0u; mine = (j == x) ? c : mine; }
        if (sum == G) break;
        __builtin_amdgcn_s_sleep(1);
        if ((++sp & 255u) == 0u) { if (xb_ld(&bar[XB_TMO])) break; if (sp > XB_SPIN_CAP) { atomicAdd(&bar[XB_TMO], 1u); break; } }
    }
    nloc = mine > 0u ? mine : 1u; nx = cnt > 0u ? cnt : 1u;
}

__device__ __forceinline__ void xcd_barrier(const XcdBarrier& b) {
    asm volatile("s_waitcnt vmcnt(0)" ::: "memory");
    __syncthreads();
    if (threadIdx.x == 0) {
        unsigned* bar = b.bar;
        __builtin_amdgcn_s_waitcnt(0);
        unsigned nloc = b.st[0], nx = b.st[1];
        if (nloc == 0u) { xcd_barrier_complete(bar, b.x, nloc, nx); b.st[0] = nloc; b.st[1] = nx; }
        const unsigned old = xb_add(&bar[XB_XSUB(b.x)], 1u);
        const unsigned gen = old / nloc;
        if (old + 1u == (gen + 1u) * nloc) {
            __builtin_amdgcn_fence(__ATOMIC_RELEASE, "agent");
            asm volatile("s_waitcnt vmcnt(0)" ::: "memory");
            const unsigned og = xb_add(&bar[XB_TOP], 1u);
            const unsigned tg = og / nx;
            if (og + 1u == (tg + 1u) * nx) xb_add(&bar[XB_TOPGEN], 1u);
            else XB_SPIN(xb_ld(&bar[XB_TOPGEN]) == tg, bar);
            __builtin_amdgcn_fence(__ATOMIC_ACQUIRE, "agent");
            xb_add(&bar[XB_XGEN(b.x)], 1u);
            asm volatile("s_waitcnt vmcnt(0)" ::: "memory");
        } else {
            XB_SPIN(xb_ld(&bar[XB_XGEN(b.x)]) == gen, bar);
            __builtin_amdgcn_fence(__ATOMIC_ACQUIRE, "agent");
            asm volatile("s_waitcnt vmcnt(0)" ::: "memory");
        }
    }
    __syncthreads();
}

#ifndef REP_A
#define REP_A 0
#endif
#ifndef REP_B
#define REP_B 0
#endif
#ifndef REP_C
#define REP_C 0
#endif
#ifndef REP_D
#define REP_D 0
#endif
#ifndef MIX_A
#define MIX_A 1
#endif
#ifndef MIX_B
#define MIX_B 1
#endif
#ifndef MIX_C
#define MIX_C 1
#endif
#ifndef MIX_D
#define MIX_D 1
#endif
__global__ void __launch_bounds__(512, 2) hybrid_fwd(Params p) {
    extern __shared__ __attribute__((aligned(16))) unsigned char lds_raw[];
    LAS unsigned char* lds = (LAS unsigned char*)lds_raw;
    cg::grid_group grid = cg::this_grid();
    { volatile LAS unsigned* st0 = (volatile LAS unsigned*)(lds + LDS_BYTES - 64); if (threadIdx.x < 2) st0[threadIdx.x] = 0u; }
    __syncthreads();
    (void)xcd_barrier_post((unsigned*)(p.ws + WS_BAR), (volatile LAS unsigned*)(lds + LDS_BYTES - 64));
    const int G = gridDim.x, bid = blockIdx.x;
    unsigned char* ws = p.ws;
    bf16_t* XB = (bf16_t*)(ws + WS_XB); bf16_t* Zb = (bf16_t*)(ws + WS_Z); bf16_t* YC_ = (bf16_t*)(ws + WS_YCAT); bf16_t* HM = (bf16_t*)(ws + WS_HM);
    float* SSQP = (float*)(ws + WS_SSQP);

#define GRID_SYNC_() do { asm volatile("s_waitcnt vmcnt(0) lgkmcnt(0)" ::: "memory"); grid.sync(); if (threadIdx.x < 64) { __builtin_amdgcn_fence(__ATOMIC_ACQUIRE, "agent"); asm volatile("s_waitcnt vmcnt(0)" ::: "memory"); } __syncthreads(); } while (0)
#define XBAR_ONCE() do { XcdBarrier b_; b_.bar = (unsigned*)(p.ws + WS_BAR); b_.x = xb_xcc_id(); b_.st = (volatile LAS unsigned*)(lds + LDS_BYTES - 64); xcd_barrier(b_); } while (0)
#ifdef REP_SYNC
#define GRID_SYNC() do { XBAR_ONCE(); XBAR_ONCE(); } while (0)
#else
#define GRID_SYNC() XBAR_ONCE()
#endif
    prologue(p, lds, G);
#ifdef REP_PRO
    GRID_SYNC_(); prologue(p, lds, G);
#endif
#ifdef NANFILL
    { u32x4* q = (u32x4*)(ws + WS_S5H); const size_t n16 = (WS_END - WS_S5H) / 16; const u32x4 nanv = (u32x4){0xffffffffu, 0xffffffffu, 0xffffffffu, 0xffffffffu};
      for (size_t i = (size_t)bid * 512 + threadIdx.x; i < n16; i += (size_t)G * 512) q[i] = nanv;
      u32x4* q2 = (u32x4*)(ws + WS_LSE); const size_t m16 = (WS_S5K - WS_LSE) / 16;
      for (size_t i = (size_t)bid * 512 + threadIdx.x; i < m16; i += (size_t)G * 512) q2[i] = nanv; }
#endif
    if (gridDim.y == 0x7fffffffu) GRID_SYNC_();
    GRID_SYNC();

#ifndef NL_RUN
#define NL_RUN NL
#endif
#ifndef DUMP_LAYER
#define DUMP_LAYER 0
#endif
    for (int lrun = 0; lrun < NL_RUN; ++lrun) {
#ifdef SAME_LAYER
        const int l = 0; const bool firstl = (lrun == 0), lastl = (lrun == NL_RUN - 1);
#else
        const int l = lrun; const bool firstl = (lrun == 0), lastl = (lrun == NL_RUN - 1);
#endif
#define RS_TABLE(SSQ_, NUNITS_) \
          { pg8::Unit ua_, ub_; (void)S.next(0, ua_); (void)S.next((NUNITS_) - 1, ub_); \
              int tq_ = threadIdx.x; asm volatile("" : "+v"(tq_)); const int pm_ = (tq_ >> 8) ? ub_.pm : ua_.pm; \
              const f32x4* sq_ = (const f32x4*)((SSQ_) + ((size_t)pm_ * 256 + (tq_ & 255)) * 16); const f32x4 q0 = sq_[0], q1 = sq_[1], q2 = sq_[2], q3 = sq_[3]; \
              const float tot_ = (((q0[0] + q0[1]) + (q0[2] + q0[3])) + ((q1[0] + q1[1]) + (q1[2] + q1[3]))) + (((q2[0] + q2[1]) + (q2[2] + q2[3])) + ((q3[0] + q3[1]) + (q3[2] + q3[3]))); \
              ((LAS float*)(lds + 131072))[tq_] = rsqrtf(tot_ * (1.0f / 1024.0f) + EPS); __syncthreads(); }
        { pg8::Gemm g{XB, (const bf16_t*)(ws + WS_WIN) + (size_t)l * D * DIN, T, DIN, D, D}; pg8::StaticOrder S; S.init(T, DIN, G, bid);
          RS_TABLE(SSQP, (T / 256) * (DIN / 256) / 256)
          pg8::EpiScale E{Zb, DIN, 0, (const PG8_LAS float*)(lds + 131072)};
          pg8::gemm_phase<pg8::EpiScale, pg8::StaticOrder, true, true>(lds, g, S, E);
#ifdef REPEAT_GEMM
          GRID_SYNC(); pg8::gemm_phase<pg8::EpiScale, pg8::StaticOrder, true, true>(lds, g, S, E);
#endif
        }
        GRID_SYNC();
#ifndef SKIP_MIX
        if (!(MIX_A && MIX_B && MIX_C && MIX_D)) { int tq = threadIdx.x; asm volatile("" : "+v"(tq));
          for (int m = bid * 8 + (tq >> 6); m < T; m += G * 8) { u32x2* yp = (u32x2*)(YC_ + (size_t)m * D) + (tq & 63); const u32x2 z2 = (u32x2){0u, 0u};
              if (!MIX_A) yp[0] = z2; if (!MIX_B) yp[64] = z2; if (!MIX_C) yp[128] = z2; if (!MIX_D) yp[192] = z2; } }
#ifndef MIX_REPEAT
#define MIX_REPEAT 1
#endif
        for (int rep = 0; rep < MIX_REPEAT; ++rep) {
        for (int it = bid; it < 1664; it += G) {
            if (it < 512) { if (MIX_A) { hgrn_item<false>(p, lds, l, it); if (REP_A) hgrn_item<false>(p, lds, l, it); } }
            else if (it < 1024) { if (MIX_B) { conv_item(p, lds, l, it - 512); if (REP_B) conv_item(p, lds, l, it - 512); } }
            else if (it < 1152) { if (MIX_C) { s5_local_item(p, lds, l, it - 1024); if (REP_C) s5_local_item(p, lds, l, it - 1024); } }
            else { if (MIX_D) { attn_item(p, lds, l, 0, it - 1152); if (REP_D) attn_item(p, lds, l, 0, it - 1152); } }
        }
        GRID_SYNC();
        if (bid < 128) { if (MIX_A) hgrn_scan_item(p, bid); } else if (bid < 136) { if (MIX_C) s5_scan_item(p, l, bid - 128); }
        if (bid < 136) { if (MIX_D) { attn_item(p, lds, l, 1, 376 + bid); if (REP_D) attn_item(p, lds, l, 1, 376 + bid); } }
        else for (int it = bid - 136; it < 376; it += 120) { if (MIX_D) { attn_item(p, lds, l, 1, it); if (REP_D) attn_item(p, lds, l, 1, it); } }
        GRID_SYNC();
#ifdef REP_P3
        if (bid < 128) { if (MIX_A) hgrn_scan_item(p, bid); } else if (bid < 136) { if (MIX_C) s5_scan_item(p, l, bid - 128); }
        if (bid < 136) { if (MIX_D) { attn_item(p, lds, l, 1, 376 + bid); if (REP_D) attn_item(p, lds, l, 1, 376 + bid); } }
        else for (int it = bid - 136; it < 376; it += 120) { if (MIX_D) { attn_item(p, lds, l, 1, it); if (REP_D) attn_item(p, lds, l, 1, it); } }
        GRID_SYNC();
#endif
        for (int it = bid; it < 1536; it += G) {
            if (it < 512) { if (MIX_A) { hgrn_item<true>(p, lds, l, it); if (REP_A) hgrn_item<true>(p, lds, l, it); } }
            else if (it < 1024) { if (MIX_C) { s5_out_item(p, lds, l, it - 512); if (REP_C) s5_out_item(p, lds, l, it - 512); } }
            else { if (MIX_D) { attn_item(p, lds, l, 2, it - 1024); if (REP_D) attn_item(p, lds, l, 2, it - 1024); } }
        }
        GRID_SYNC();
        }
#ifndef NO_GLU
        { pg8::Gemm g{(const bf16_t*)(ws + WS_YPRE), (const bf16_t*)(ws + WS_WGLU) + (size_t)l * 65536, T, 256, 256, 256}; pg8::StaticOrder S; S.init(T, 256, G, bid);
          pg8::EpiGlu E{(const bf16_t*)(ws + WS_YPRE), 256, YC_ + YC};
          pg8::gemm_phase<pg8::EpiGlu, pg8::StaticOrder, false, true>(lds, g, S, E); }
#endif
        { int tq = threadIdx.x; asm volatile("" : "+v"(tq)); const int lane = tq & 63; const int gw = (bid - 128) * 8 + (tq >> 6), NGW = 128 * 8;
          if (bid >= 128) for (int m = gw; m < T; m += NGW) { u32x2* yp = (u32x2*)(YC_ + (size_t)m * D + YD) + lane; const u32x2 w = *((const u32x2*)(Zb + (size_t)m * DIN + ZOD) + lane);
              const float a0 = bflo(w.x), a1 = bfhi(w.x), a2 = bflo(w.y), a3 = bfhi(w.y);
              const float ss = wave_sum((a0 * a0 + a1 * a1) + (a2 * a2 + a3 * a3)); const float rs = rsqrtf(ss * (1.0f / 256.0f) + EPS);
              u32x2 o; o.x = pk2(a0 * rs, a1 * rs); o.y = pk2(a2 * rs, a3 * rs); *yp = o; } }
        GRID_SYNC();
#endif
#ifdef REP_P5
#ifndef NO_GLU
        { pg8::Gemm g{(const bf16_t*)(ws + WS_YPRE), (const bf16_t*)(ws + WS_WGLU) + (size_t)l * 65536, T, 256, 256, 256}; pg8::StaticOrder S; S.init(T, 256, G, bid);
          pg8::EpiGlu E{(const bf16_t*)(ws + WS_YPRE), 256, YC_ + YC};
          pg8::gemm_phase<pg8::EpiGlu, pg8::StaticOrder, false, true>(lds, g, S, E); }
#endif
        { int tq = threadIdx.x; asm volatile("" : "+v"(tq)); const int lane = tq & 63; const int gw = (bid - 128) * 8 + (tq >> 6), NGW = 128 * 8;
          if (bid >= 128) for (int m = gw; m < T; m += NGW) { u32x2* yp = (u32x2*)(YC_ + (size_t)m * D + YD) + lane; const u32x2 w = *((const u32x2*)(Zb + (size_t)m * DIN + ZOD) + lane);
              const float a0 = bflo(w.x), a1 = bfhi(w.x), a2 = bflo(w.y), a3 = bfhi(w.y);
              const float ss = wave_sum((a0 * a0 + a1 * a1) + (a2 * a2 + a3 * a3)); const float rs = rsqrtf(ss * (1.0f / 256.0f) + EPS);
              u32x2 o; o.x = pk2(a0 * rs, a1 * rs); o.y = pk2(a2 * rs, a3 * rs); *yp = o; } }
        GRID_SYNC();
#endif
#ifdef DUMP_SLICE
        if (lrun == DUMP_LAYER) { int tq = threadIdx.x; asm volatile("" : "+v"(tq));
          for (int m = bid * 8 + (tq >> 6); m < T; m += G * 8) { const int ln = tq & 63;
              for (int j = 0; j < 4; ++j) { const int col = j * 256 + ln * 4; const u32x2 w = *(const u32x2*)(YC_ + (size_t)m * D + col);
                  f32x4 o = (f32x4){0.f, 0.f, 0.f, 0.f}; if (j == DUMP_SLICE) o = (f32x4){bflo(w.x), bfhi(w.x), bflo(w.y), bfhi(w.y)};
                  *(f32x4*)(p.out + (size_t)m * D + col) = o; } }
          break; }
#endif
#ifdef SKIP_MIX
        { pg8::Gemm g{Zb, (const bf16_t*)(ws + WS_WOUT) + (size_t)l * D * D, T, D, D, DIN}; pg8::StaticOrder S; S.init(T, D, G, bid);
#else
        { pg8::Gemm g{YC_, (const bf16_t*)(ws + WS_WOUT) + (size_t)l * D * D, T, D, D, D}; pg8::StaticOrder S; S.init(T, D, G, bid);
#endif
          pg8::EpiRes E{firstl ? p.in[I_X] : p.out, p.out, XB, SSQP + (size_t)T * 16};
          pg8::gemm_phase<pg8::EpiRes, pg8::StaticOrder, true, true>(lds, g, S, E); }
        GRID_SYNC();
        { pg8::Gemm g{XB, (const bf16_t*)(ws + WS_WUP) + (size_t)l * D * FF, T, FF, D, D}; pg8::StaticOrder S; S.init(T, FF, G, bid);
          RS_TABLE(SSQP + (size_t)T * 16, (T / 256) * (FF / 256) / 256)
          pg8::EpiScale E{HM, FF, 1, (const PG8_LAS float*)(lds + 131072)};
          pg8::gemm_phase<pg8::EpiScale, pg8::StaticOrder, true, true>(lds, g, S, E);
#ifdef REPEAT_GEMM
          GRID_SYNC(); pg8::gemm_phase<pg8::EpiScale, pg8::StaticOrder, true, true>(lds, g, S, E);
#endif
        }
        GRID_SYNC();
        { pg8::Gemm g{HM, (const bf16_t*)(ws + WS_WDN) + (size_t)l * D * FF, T, D, FF, FF}; pg8::StaticOrder S; S.init(T, D, G, bid);
          pg8::EpiRes E{p.out, p.out, XB, !lastl ? SSQP : nullptr};
          pg8::gemm_phase<pg8::EpiRes, pg8::StaticOrder, true, true>(lds, g, S, E); }
        if (!lastl) GRID_SYNC();
    }
}

extern "C" void kernel_launch(void* const* d_in, const int* in_sizes, int n_in, void* d_out, int out_size, void* d_ws, size_t ws_size, hipStream_t stream) {
    static int grid = 0;
    if (grid == 0) {
        if (n_in != 26 || out_size != T * D || ws_size < WS_END) { fprintf(stderr, "kernel_launch: unexpected shapes (n_in %d, out %d, ws %zu); nothing launched\n", n_in, out_size, ws_size); grid = -1; return; }
        int dev = 0, cus = 0, per_cu = 0;
        (void)hipGetDevice(&dev); (void)hipDeviceGetAttribute(&cus, hipDeviceAttributeMultiprocessorCount, dev);
        if (hipFuncSetAttribute((const void*)hybrid_fwd, hipFuncAttributeMaxDynamicSharedMemorySize, LDS_BYTES) != hipSuccess) { fprintf(stderr, "kernel_launch: hipFuncSetAttribute failed\n"); grid = -1; return; }
        if (hipOccupancyMaxActiveBlocksPerMultiprocessor(&per_cu, (const void*)hybrid_fwd, 512, LDS_BYTES) != hipSuccess || per_cu < 1) { fprintf(stderr, "kernel_launch: occupancy query gave %d\n", per_cu); per_cu = 1; }
        (void)hipGetLastError();
        if (cus <= 0) cus = 256;
        grid = cus * per_cu;
    }
    if (grid < 0) return;
    if (hipMemsetAsync((char*)d_ws + WS_BAR, 0, XCD_BAR_WORDS * 4, stream) != hipSuccess) { fprintf(stderr, "kernel_launch: hipMemsetAsync of the barrier words failed\n"); return; }
    static int rs_ok = -1;
    if (rs_ok < 0) { rs_ok = (grid == 256) ? 1 : 0;
        const int ncol[2] = {DIN / 256, FF / 256};
        for (int ph = 0; ph < 2 && rs_ok; ++ph) { const int nun = (T / 256) * ncol[ph] / 256;
            for (int c = 0; c < grid && rs_ok; ++c) { pg8::StaticOrder S; S.init(T, ncol[ph] * 256, grid, c); pg8::Unit u0, u1, ui; if (!S.next(0, u0) || !S.next(nun - 1, u1) || S.next(nun, ui)) { rs_ok = 0; break; }
                if (((u0.pm >> 3) & 1) != 0 || ((u1.pm >> 3) & 1) != 1) { rs_ok = 0; break; }
                for (int i = 0; i < nun; ++i) { S.next(i, ui); if (ui.pm != (((ui.pm >> 3) & 1) ? u1.pm : u0.pm)) { rs_ok = 0; break; } } } } }
    Params a{};
    for (int i = 0; i < 26; ++i) a.in[i] = (const float*)d_in[i];
    if (!rs_ok) { fprintf(stderr, "kernel_launch: unit order does not keep a workgroup inside two row panels (grid %d); nothing launched\n", grid); return; }
    a.out = (float*)d_out; a.ws = (unsigned char*)d_ws; a.rs_lds = rs_ok; a.pad = 0;
    void* args[] = {&a};
    hipError_t e = hipLaunchCooperativeKernel((const void*)hybrid_fwd, dim3(grid), dim3(512), args, LDS_BYTES, stream);
    if (e != hipSuccess) fprintf(stderr, "cooperative launch failed: %s (grid %d)\n", hipGetErrorString(e), grid);
}
```

```cpp
#include <hip/hip_runtime.h>
#include <hip/hip_cooperative_groups.h>
#include <cstdio>
#include <cstdint>
namespace cg = cooperative_groups;

#define DI __device__ __forceinline__
#define LAS __attribute__((address_space(3)))
typedef unsigned short bf16_t;
typedef short bf16x8 __attribute__((ext_vector_type(8)));
typedef short s16x4 __attribute__((ext_vector_type(4)));
typedef float f32x4 __attribute__((ext_vector_type(4)));
typedef float f32x16 __attribute__((ext_vector_type(16)));
typedef unsigned u32x4 __attribute__((ext_vector_type(4)));
typedef unsigned u32x2 __attribute__((ext_vector_type(2)));

constexpr int NB = 4, SEQ = 8192, T = NB * SEQ, D = 1024, DIN = 2560, FF = 4096, NL = 4;
constexpr int ZQ = 0, ZF = 256, ZI = 512, ZG = 768, ZBV = 1024, ZBG = 1280, ZCU = 1536, ZDQ = 1792, ZDK = 2048, ZDV = 2304;
constexpr int YA = 0, YB = 256, YC = 512, YD = 768;
constexpr int ZOD = ZBG;
constexpr float EPS = 1e-6f;
constexpr size_t MiB = 1u << 20;
constexpr size_t WS_WIN = 0, WS_WOUT = 20 * MiB, WS_WUP = 28 * MiB, WS_WDN = 60 * MiB, WS_WGLU = 92 * MiB;
constexpr size_t WS_LB = 93 * MiB;
constexpr size_t WS_BIAS = WS_LB + 4096;
constexpr size_t WS_BAR = WS_LB + 32768;
constexpr size_t WS_SSQ = WS_LB + 65536;
constexpr size_t WS_LSE = WS_SSQ + 8 * (size_t)T * 4;
constexpr size_t WS_DEC = WS_LSE + (size_t)T * 16;
constexpr size_t WS_LSE1 = WS_DEC + 2048 * 64 * 4;
constexpr size_t WS_S5K = 96 * MiB;
constexpr size_t WS_S5WS = 98 * MiB;
constexpr size_t WS_S5WC = 114 * MiB;
constexpr size_t WS_XB = 130 * MiB;
constexpr size_t WS_S5H = 194 * MiB;
constexpr size_t WS_HM = 198 * MiB;
constexpr size_t WS_Z = 198 * MiB;
constexpr size_t WS_YCAT = 358 * MiB;
constexpr size_t WS_SL = 422 * MiB, WS_SL2 = 438 * MiB;
constexpr size_t WS_S5H2 = 454 * MiB;
constexpr size_t WS_O0 = 458 * MiB, WS_O1 = 474 * MiB;
constexpr size_t WS_YPRE = 490 * MiB;
constexpr size_t WS_SSQP = 506 * MiB;
constexpr size_t WS_END = 510 * MiB;
static_assert(WS_LSE1 + (size_t)T * 16 <= WS_S5K, "misc region");

constexpr int LDS_BYTES = 147456;

typedef float f32x2_t __attribute__((ext_vector_type(2))); typedef __bf16 bf16x2_t __attribute__((ext_vector_type(2)));
DI unsigned f2bf(float f) { const f32x2_t v = {f, 0.f}; const bf16x2_t b = __builtin_convertvector(v, bf16x2_t); return __builtin_bit_cast(unsigned, b) & 0xffffu; }
DI unsigned pk2(float lo, float hi) { const f32x2_t v = {lo, hi}; const bf16x2_t b = __builtin_convertvector(v, bf16x2_t); return __builtin_bit_cast(unsigned, b); }
DI float bf2f(bf16_t v) { return __builtin_bit_cast(float, (unsigned)v << 16); }
DI float bflo(unsigned w) { return __builtin_bit_cast(float, w << 16); }
DI float bfhi(unsigned w) { return __builtin_bit_cast(float, w & 0xffff0000u); }
DI float sigmoidf_(float x) { return __builtin_amdgcn_rcpf(1.f + __expf(-x)); }
DI float wave_sum(float v) {
#pragma unroll
    for (int o = 1; o < 64; o <<= 1) v += __shfl_xor(v, o);
    return v;
}
DI float half_sum(float v) {
#pragma unroll
    for (int o = 1; o < 32; o <<= 1) v += __shfl_xor(v, o);
    return v;
}
#define LDS_WAIT() asm volatile("s_waitcnt lgkmcnt(0)" ::: "memory")
DI int crow(int reg, int h) { return (reg & 3) + 8 * (reg >> 2) + 4 * h; }

template <int K>
DI f32x16 mma_lds(const LAS bf16_t* A, int lda, const LAS bf16_t* B, int ldb, f32x16 acc, int lane) {
    const int r = lane & 31, h = lane >> 5;
    const LAS bf16_t* ap = A + r * lda + 8 * h; const LAS bf16_t* bp = B + r * ldb + 8 * h;
#pragma unroll
    for (int k0 = 0; k0 < K; k0 += 16) {
        const bf16x8 a = *(const LAS bf16x8*)(ap + k0); const bf16x8 b = *(const LAS bf16x8*)(bp + k0);
        acc = __builtin_amdgcn_mfma_f32_32x32x16_bf16(a, b, acc, 0, 0, 0);
    }
    return acc;
}
DI f32x16 zero16() { f32x16 z;
#pragma unroll
    for (int i = 0; i < 16; ++i) z[i] = 0.f;
    return z; }

namespace pg8 {
#define PG8_LAS __attribute__((address_space(3)))
constexpr int BM = 256, BK = 64, HALF = 128, HTB = HALF * BK * 2, STAGE_BYTES = 8 * HTB, NXCD = 8, WGM = 8;
__host__ __device__ __forceinline__ int lds_byte(int r, int c) { const int st = (r >> 4) * 2 + (c >> 5), rr = r & 15, cc = c & 31, ob = rr * 64 + cc * 2; return st * 1024 + (ob ^ (((ob >> 9) & 1) << 5)); }
__host__ __device__ __forceinline__ void stage_rc(int b, int& R, int& C) { const int st = b / 1024, sb = b % 1024, swz = sb ^ (((sb >> 9) & 1) << 5); R = (st >> 1) * 16 + swz / 64; C = (st & 1) * 32 + (swz % 64) / 2; }
__host__ __device__ __forceinline__ int perm32(int rho) { const int n = rho >> 4, i = rho & 15; return 8 * (i >> 2) + 4 * n + (i & 3); }
struct Unit { int pm, pn; };
struct Gemm { const bf16_t* A; const bf16_t* Bt; int M, N, K, lda; };
struct StaticOrder {
    int nM, nN, nwg, G, c;
    __host__ __device__ __forceinline__ void init(int M, int N, int G_, int c_) { nM = M / BM; nN = N / BM; nwg = nM * nN; G = G_; c = c_; }
    __host__ __device__ __forceinline__ bool next(int i, Unit& u) const {
        const long L = (long)i * G + c; if (L >= nwg) return false;
        int wgid = (int)L; { const int q = nwg / NXCD, r = nwg % NXCD, xcd = wgid % NXCD, off = wgid / NXCD; wgid = (xcd < r ? xcd * (q + 1) : r * (q + 1) + (xcd - r) * q) + off; }
        const int nig = WGM * nN, gid = wgid / nig, fm = gid * WGM, gsz = (nM - fm) < WGM ? (nM - fm) : WGM;
        u.pm = fm + ((wgid % nig) % gsz); u.pn = (wgid % nig) / gsz; return true;
    }
    __device__ __forceinline__ void a_ready(const Unit&) const {}
    __device__ __forceinline__ void done(const Unit&) const {}
};
struct EpiScale {
    static constexpr bool PERM = true, AFTER_DRAIN = false;
    bf16_t* O; int ldc; int act; const PG8_LAS float* rsl;
    __device__ __forceinline__ void operator()(const f32x4 (&acc)[2][2][4][2], const Unit& u, int wr, int wc, int fr, int fq) const {
        const int row0 = u.pm * BM + wr * 64 + fr; const int col0 = u.pn * BM + wc * 32 + 8 * fq;
        const int slot = ((u.pm >> 3) & 1) * 256;
#pragma unroll
        for (int ai = 0; ai < 2; ++ai)
#pragma unroll
            for (int m = 0; m < 4; ++m) { const int r = row0 + ai * HALF + m * 16; float rs;
                rs = rsl[slot + ai * HALF + wr * 64 + m * 16 + fr];
                bf16_t* rowp = O + (size_t)r * ldc + col0;
#pragma unroll
                for (int bj = 0; bj < 2; ++bj) { f32x4 v0 = acc[ai][bj][m][0] * rs, v1 = acc[ai][bj][m][1] * rs;
                    if (act) {
#pragma unroll
                        for (int e = 0; e < 4; ++e) { const float a = fmaxf(v0[e], 0.f), b = fmaxf(v1[e], 0.f); v0[e] = a * a; v1[e] = b * b; } }
                    u32x4 w; w.x = pk2(v0[0], v0[1]); w.y = pk2(v0[2], v0[3]); w.z = pk2(v1[0], v1[1]); w.w = pk2(v1[2], v1[3]);
                    *(u32x4*)(rowp + bj * HALF) = w; } }
    }
};
struct EpiRes {
    static constexpr bool PERM = false, AFTER_DRAIN = false;
    const float* base; float* out; bf16_t* xb; float* ssq_out;
    __device__ __forceinline__ void operator()(const f32x4 (&acc)[2][2][4][2], const Unit& u, int wr, int wc, int fr, int fq) const {
        const int col0 = u.pn * BM + wc * 32 + 4 * fq;
#pragma unroll
        for (int ai = 0; ai < 2; ++ai) {
            f32x4 bv[4][2][2];
#pragma unroll
            for (int m = 0; m < 4; ++m) { const size_t off = (size_t)(u.pm * BM + ai * HALF + wr * 64 + m * 16 + fr) * D + col0;
#pragma unroll
                for (int bj = 0; bj < 2; ++bj)
#pragma unroll
                    for (int n = 0; n < 2; ++n) bv[m][bj][n] = *(const f32x4*)(base + off + bj * HALF + n * 16); }
#pragma unroll
            for (int m = 0; m < 4; ++m) { const int r = u.pm * BM + ai * HALF + wr * 64 + m * 16 + fr; const size_t off = (size_t)r * D + col0; float s = 0.f;
#pragma unroll
                for (int bj = 0; bj < 2; ++bj)
#pragma unroll
                    for (int n = 0; n < 2; ++n) { const size_t o2 = off + bj * HALF + n * 16; const f32x4 o = bv[m][bj][n] + acc[ai][bj][m][n];
                        *(f32x4*)(out + o2) = o; u32x2 w; w.x = pk2(o[0], o[1]); w.y = pk2(o[2], o[3]); *(u32x2*)(xb + o2) = w;
                        s += (o[0] * o[0] + o[1] * o[1]) + (o[2] * o[2] + o[3] * o[3]); }
                s += __shfl_xor(s, 16); s += __shfl_xor(s, 32);
                if (fq == 0 && ssq_out) ssq_out[(size_t)r * 16 + u.pn * 4 + wc] = s; } }
    }
};
struct EpiGlu {
    static constexpr bool PERM = false, AFTER_DRAIN = true;
    const bf16_t* Ysrc; int lds_; bf16_t* Y;
    __device__ __forceinline__ void fused(f32x4 (&acc)[2][2][4][2], const Unit& u, int wr, int wc, int fr, int fq, PG8_LAS unsigned char* lds, int wid, int lane) const {
        PG8_LAS float* Pp = (PG8_LAS float*)lds;
        const int col0 = wc * 32 + 4 * fq;
#pragma unroll
        for (int ai = 0; ai < 2; ++ai)
#pragma unroll
            for (int m = 0; m < 4; ++m) { const int rl = ai * HALF + wr * 64 + m * 16 + fr; const size_t off = (size_t)(u.pm * BM + rl) * lds_ + col0; float s = 0.f;
#pragma unroll
                for (int bj = 0; bj < 2; ++bj)
#pragma unroll
                    for (int n = 0; n < 2; ++n) { const u32x2 w = *(const u32x2*)(Ysrc + off + bj * HALF + n * 16); f32x4 a = acc[ai][bj][m][n];
                        const float y0 = bflo(w.x), y1 = bfhi(w.x), y2 = bflo(w.y), y3 = bfhi(w.y);
                        a[0] = y0 * sigmoidf_(a[0]); a[1] = y1 * sigmoidf_(a[1]); a[2] = y2 * sigmoidf_(a[2]); a[3] = y3 * sigmoidf_(a[3]);
                        acc[ai][bj][m][n] = a; s += (a[0] * a[0] + a[1] * a[1]) + (a[2] * a[2] + a[3] * a[3]); }
                s += __shfl_xor(s, 16); s += __shfl_xor(s, 32);
                if (fq == 0) Pp[rl * 4 + wc] = s; }
        __syncthreads();
#pragma unroll
        for (int ai = 0; ai < 2; ++ai)
#pragma unroll
            for (int m = 0; m < 4; ++m) { const int rl = ai * HALF + wr * 64 + m * 16 + fr; const size_t off = (size_t)(u.pm * BM + rl) * D + col0;
                const float tot = (Pp[rl * 4 + 0] + Pp[rl * 4 + 1]) + (Pp[rl * 4 + 2] + Pp[rl * 4 + 3]); const float rs = rsqrtf(tot * (1.0f / 256.0f) + EPS);
#pragma unroll
                for (int bj = 0; bj < 2; ++bj)
#pragma unroll
                    for (int n = 0; n < 2; ++n) { const f32x4 a = acc[ai][bj][m][n] * rs; u32x2 w; w.x = pk2(a[0], a[1]); w.y = pk2(a[2], a[3]); *(u32x2*)(Y + off + bj * HALF + n * 16) = w; } }
    }
};

template <class Epi, class Sched, bool ALIGN_EPI = false, bool SP2 = false>
__device__ __forceinline__ void gemm_phase(PG8_LAS unsigned char* lds, const Gemm g, const Sched& S, const Epi& E) {
    int tid_o = threadIdx.x; asm volatile("" : "+v"(tid_o));
    const int tid = tid_o, wid = __builtin_amdgcn_readfirstlane(tid >> 6), lane = tid & 63, wr = wid >> 2, wc = wid & 3, fr = lane & 15, fq = lane >> 4;
    const int K = g.K, nt = K / BK;
    unsigned voffA[2], voffB[2];
#pragma unroll
    for (int i = 0; i < 2; ++i) { int R, C; stage_rc(tid * 16 + i * 8192, R, C); const int Rb = Epi::PERM ? ((R & ~31) + perm32(R & 31)) : R;
        voffA[i] = (unsigned)(R * g.lda + C) * 2u; voffB[i] = (unsigned)(Rb * K + C) * 2u; }
    const size_t kstep = (size_t)(BK * 2);
    const size_t hstepA = (size_t)HALF * g.lda * 2, hstepB = (size_t)HALF * K * 2;
    const size_t tstepA = 2 * hstepA, tstepB = 2 * hstepB;
    const unsigned ldsw = (unsigned)wid * 1024u;
    const int aoff = lds_byte(wr * 64 + fr, fq * 8), boff = lds_byte(wc * 32 + fr, fq * 8);
#define PG8_SA(b, h) (((b) * 2 + (h)) * HTB)
#define PG8_SB(b, h) ((4 + (b) * 2 + (h)) * HTB)
#define PG8_STAGE(bufoff, gbase, voff) do { _Pragma("unroll") for (int _i = 0; _i < 2; ++_i) \
        __builtin_amdgcn_global_load_lds((const unsigned*)((const char*)(gbase) + (voff)[_i]), (PG8_LAS unsigned*)(lds + (bufoff) + ldsw + _i * 8192), 16, 0, 0); } while (0)
#define PG8_LDA(dst, b, h) do { _Pragma("unroll") for (int m = 0; m < 4; ++m) _Pragma("unroll") for (int k = 0; k < 2; ++k) dst[m][k] = *(const PG8_LAS bf16x8*)(lds + PG8_SA(b, h) + aoff + m * 2048 + k * 1024); } while (0)
#define PG8_LDB(dst, b, h) do { _Pragma("unroll") for (int n = 0; n < 2; ++n) _Pragma("unroll") for (int k = 0; k < 2; ++k) dst[n][k] = *(const PG8_LAS bf16x8*)(lds + PG8_SB(b, h) + boff + n * 2048 + k * 1024); } while (0)
#define PG8_MMA(ai, bj, At, Bt) do { __builtin_amdgcn_s_setprio(1); _Pragma("unroll") for (int m = 0; m < 4; ++m) _Pragma("unroll") for (int n = 0; n < 2; ++n) _Pragma("unroll") for (int k = 0; k < 2; ++k) \
        acc[ai][bj][m][n] = __builtin_amdgcn_mfma_f32_16x16x32_bf16(Bt[n][k], At[m][k], acc[ai][bj][m][n], 0, 0, 0); __builtin_amdgcn_s_setprio(0); } while (0)
#define PG8_WAIT_V(n) asm volatile("s_waitcnt vmcnt(" #n ")" ::: "memory")
#define PG8_WAIT_L(n) asm volatile("s_waitcnt lgkmcnt(" #n ")" ::: "memory")
#define PG8_BAR __builtin_amdgcn_s_barrier()
#define PG8_SCHED __builtin_amdgcn_sched_barrier(0)
    Unit cur, nxt; int ui = 0;
    if (!S.next(0, cur)) return;
    f32x4 acc[2][2][4][2];
#pragma unroll
    for (int a = 0; a < 2; ++a)
#pragma unroll
        for (int b = 0; b < 2; ++b)
#pragma unroll
            for (int m = 0; m < 4; ++m)
#pragma unroll
                for (int n = 0; n < 2; ++n) acc[a][b][m][n] = (f32x4){0.f, 0.f, 0.f, 0.f};
    bf16x8 At[4][2], B0[2][2], B1[2][2];
    const char* cA = (const char*)g.A + (size_t)cur.pm * tstepA; const char* cB = (const char*)g.Bt + (size_t)cur.pn * tstepB;
    S.a_ready(cur);
    if constexpr (SP2) {
        PG8_STAGE(PG8_SB(0, 0), cB, voffB); PG8_STAGE(PG8_SB(0, 1), cB + hstepB, voffB); PG8_STAGE(PG8_SA(0, 0), cA, voffA); PG8_STAGE(PG8_SA(0, 1), cA + hstepA, voffA);
        if (wr == 1) PG8_BAR;
        PG8_WAIT_V(2); PG8_BAR;
        PG8_STAGE(PG8_SB(1, 0), cB + kstep, voffB); PG8_STAGE(PG8_SA(1, 0), cA + kstep, voffA); PG8_STAGE(PG8_SB(1, 1), cB + hstepB + kstep, voffB);
        PG8_WAIT_V(6); PG8_BAR;
    } else {
        PG8_STAGE(PG8_SB(0, 0), cB, voffB); PG8_STAGE(PG8_SA(0, 0), cA, voffA); PG8_STAGE(PG8_SB(0, 1), cB + hstepB, voffB); PG8_STAGE(PG8_SA(0, 1), cA + hstepA, voffA);
        if (wr == 1) PG8_BAR;
        PG8_WAIT_V(4); PG8_BAR;
        PG8_STAGE(PG8_SB(1, 0), cB + kstep, voffB); PG8_STAGE(PG8_SA(1, 0), cA + kstep, voffA); PG8_STAGE(PG8_SB(1, 1), cB + hstepB + kstep, voffB);
        PG8_WAIT_V(6); PG8_BAR;
    }
    for (;;) {
        const bool has_next = S.next(ui + 1, nxt);
        const char* nA = has_next ? (const char*)g.A + (size_t)nxt.pm * tstepA : cA; const char* nB = has_next ? (const char*)g.Bt + (size_t)nxt.pn * tstepB : cB;
        for (int t = 0; t < nt; t += 2) {
            const bool last = (t == nt - 2);
            const char* a1 = cA + (size_t)(t + 1) * kstep;
            const char* a2 = last ? nA : cA + (size_t)(t + 2) * kstep; const char* b2 = last ? nB : cB + (size_t)(t + 2) * kstep;
            const char* a3 = a2 + kstep; const char* b3 = b2 + kstep;
            if (last && has_next) S.a_ready(nxt);
            if constexpr (SP2) {
            PG8_LDB(B0, 0, 0); PG8_LDB(B1, 0, 1); PG8_SCHED; PG8_LDA(At, 0, 0); PG8_STAGE(PG8_SA(1, 1), a1 + hstepA, voffA);
            PG8_WAIT_V(8); PG8_WAIT_L(0); PG8_BAR; PG8_MMA(0, 0, At, B0); PG8_MMA(0, 1, At, B1); PG8_BAR; PG8_SCHED;
            PG8_LDA(At, 0, 1); PG8_STAGE(PG8_SB(0, 0), b2, voffB); PG8_STAGE(PG8_SB(0, 1), b2 + hstepB, voffB); PG8_STAGE(PG8_SA(0, 0), a2, voffA);
            PG8_WAIT_V(8); PG8_WAIT_L(0); PG8_BAR; PG8_MMA(1, 0, At, B0); PG8_MMA(1, 1, At, B1); PG8_BAR; PG8_SCHED;
            PG8_LDB(B0, 1, 0); PG8_LDB(B1, 1, 1); PG8_SCHED; PG8_LDA(At, 1, 0); PG8_STAGE(PG8_SA(0, 1), a2 + hstepA, voffA);
            PG8_WAIT_V(8); PG8_WAIT_L(0); PG8_BAR; PG8_MMA(0, 0, At, B0); PG8_MMA(0, 1, At, B1); PG8_BAR; PG8_SCHED;
            PG8_LDA(At, 1, 1); PG8_STAGE(PG8_SB(1, 0), b3, voffB); PG8_STAGE(PG8_SB(1, 1), b3 + hstepB, voffB); PG8_STAGE(PG8_SA(1, 0), a3, voffA);
            PG8_WAIT_V(8); PG8_WAIT_L(0); PG8_BAR; PG8_MMA(1, 0, At, B0); PG8_MMA(1, 1, At, B1); PG8_BAR; PG8_SCHED;
            } else {
            PG8_LDB(B0, 0, 0); PG8_SCHED; PG8_LDA(At, 0, 0); PG8_STAGE(PG8_SA(1, 1), a1 + hstepA, voffA);
            PG8_WAIT_L(8); PG8_BAR; PG8_WAIT_L(0); PG8_MMA(0, 0, At, B0); PG8_BAR; PG8_SCHED;
            PG8_LDB(B1, 0, 1); PG8_STAGE(PG8_SB(0, 0), b2, voffB);
            PG8_BAR; PG8_WAIT_L(0); PG8_MMA(0, 1, At, B1); PG8_BAR;
            PG8_LDA(At, 0, 1); PG8_STAGE(PG8_SA(0, 0), a2, voffA);
            PG8_BAR; PG8_WAIT_L(0); PG8_MMA(1, 0, At, B0); PG8_BAR; PG8_SCHED;
            PG8_STAGE(PG8_SB(0, 1), b2 + hstepB, voffB);
            PG8_WAIT_V(6); PG8_BAR; PG8_MMA(1, 1, At, B1); PG8_BAR;
            PG8_LDB(B0, 1, 0); PG8_SCHED; PG8_LDA(At, 1, 0); PG8_STAGE(PG8_SA(0, 1), a2 + hstepA, voffA);
            PG8_WAIT_L(8); PG8_BAR; PG8_WAIT_L(0); PG8_MMA(0, 0, At, B0); PG8_BAR; PG8_SCHED;
            PG8_LDB(B1, 1, 1); PG8_STAGE(PG8_SB(1, 0), b3, voffB);
            PG8_BAR; PG8_WAIT_L(0); PG8_MMA(0, 1, At, B1); PG8_BAR;
            PG8_LDA(At, 1, 1); PG8_STAGE(PG8_SA(1, 0), a3, voffA);
            PG8_BAR; PG8_WAIT_L(0); PG8_MMA(1, 0, At, B0); PG8_BAR; PG8_SCHED;
            PG8_STAGE(PG8_SB(1, 1), b3 + hstepB, voffB);
            PG8_WAIT_V(6); PG8_BAR; PG8_MMA(1, 1, At, B1); PG8_BAR;
            }
        }
        if constexpr (ALIGN_EPI) { if (wr == 0) PG8_BAR; }
        if constexpr (!Epi::AFTER_DRAIN) { E(acc, cur, wr, wc, fr, fq); S.done(cur); }
        if (!has_next) break;
#pragma unroll
        for (int a = 0; a < 2; ++a)
#pragma unroll
            for (int b = 0; b < 2; ++b)
#pragma unroll
                for (int m = 0; m < 4; ++m)
#pragma unroll
                    for (int n = 0; n < 2; ++n) acc[a][b][m][n] = (f32x4){0.f, 0.f, 0.f, 0.f};
        cur = nxt; cA = nA; cB = nB; ++ui;
        if constexpr (ALIGN_EPI) { if (wr == 1) PG8_BAR; }
    }
    PG8_WAIT_V(0);
    if constexpr (!ALIGN_EPI) { if (wr == 0) PG8_BAR; }
    PG8_BAR;
    if constexpr (Epi::AFTER_DRAIN) { E.fused(acc, cur, wr, wc, fr, fq, lds, wid, lane); S.done(cur); }
#undef PG8_SA
#undef PG8_SB
#undef PG8_STAGE
#undef PG8_LDA
#undef PG8_LDB
#undef PG8_MMA
#undef PG8_WAIT_V
#undef PG8_WAIT_L
#undef PG8_BAR
#undef PG8_SCHED
}
}

struct Params { const float* in[26]; float* out; unsigned char* ws; int rs_lds; int pad; };
enum { I_X = 0, I_NMG, I_WIN, I_LBL, I_HNG, I_CW, I_CB, I_CLG, I_CLB, I_LRE, I_LIM, I_BRE, I_BIM, I_CRE, I_CIM, I_S5D, I_LDT, I_WGLU, I_QG, I_KG, I_RB, I_MONG, I_WOUT, I_NMLPG, I_WUP, I_WDN };

DI void p0_transpose_item(const float* W, int K, int N, bf16_t* WT, const float* gk, LAS float* scr, int item, int lane) {
    const int nblk = N / 32, kb = item / nblk, nb = item % nblk, k0 = 64 * kb, n0 = 32 * nb;
    float wv[32];
#pragma unroll
    for (int i = 0; i < 32; ++i) { const int kk = 2 * i + (lane >> 5); wv[i] = W[(size_t)(k0 + kk) * N + n0 + (lane & 31)]; }
#pragma unroll
    for (int i = 0; i < 32; ++i) { const int kk = 2 * i + (lane >> 5); const float s = gk ? gk[k0 + kk] : 1.f; scr[kk * 33 + (lane & 31)] = wv[i] * s; }
    LDS_WAIT();
    const int c = lane & 7;
#pragma unroll
    for (int j = 0; j < 4; ++j) { const int n = (lane >> 3) + 8 * j; const LAS float* s = scr + (8 * c) * 33 + n;
        u32x4 o; o.x = pk2(s[0 * 33], s[1 * 33]); o.y = pk2(s[2 * 33], s[3 * 33]); o.z = pk2(s[4 * 33], s[5 * 33]); o.w = pk2(s[6 * 33], s[7 * 33]);
        *(u32x4*)(WT + (size_t)(n0 + n) * K + k0 + 8 * c) = o; }
    LDS_WAIT();
}
DI void s5_params(const Params& p, int lg, int pp, float& lrdt, float& lidt, float& cr, float& ci) {
    const float dt = expf(p.in[I_LDT][lg]);
    const float lr = p.in[I_LRE][lg * 64 + pp], li = p.in[I_LIM][lg * 64 + pp];
    lrdt = lr * dt; lidt = li * dt;
    const float mag = expf(lrdt); const float ar = mag * cosf(lidt), ai = mag * sinf(lidt);
    const float den = lr * lr + li * li;
    cr = ((ar - 1.0f) * lr + ai * li) / den; ci = (ai * lr - (ar - 1.0f) * li) / den;
}
DI void s5_pow(float lrdt, float lidt, int n, float& er, float& ei) { const float m = expf((float)n * lrdt); const float a = (float)n * lidt; er = m * cosf(a); ei = m * sinf(a); }

DI void prologue(const Params& p, LAS unsigned char* lds, int G) {
    int tid_o = threadIdx.x; asm volatile("" : "+v"(tid_o));
    const int tid = tid_o, lane = tid & 63, wave = tid >> 6;
    const int gw = blockIdx.x * 8 + wave, NGW = G * 8;
    const int gt = blockIdx.x * 512 + tid, NGT = G * 512;
    unsigned char* ws = p.ws;
    LAS float* scr = (LAS float*)(lds + wave * 16384);
    {
        constexpr int I_IN = (D / 64) * (DIN / 32), I_OUT = (D / 64) * (D / 32), I_UP = (D / 64) * (FF / 32), I_DN = (FF / 64) * (D / 32), I_GL = (256 / 64) * (256 / 32);
        constexpr int PER_L = I_IN + I_OUT + I_UP + I_DN + I_GL;
        for (int it = gw; it < NL * PER_L; it += NGW) {
            const int l = it / PER_L; int r = it % PER_L;
            if (r < I_IN) { p0_transpose_item(p.in[I_WIN] + (size_t)l * D * DIN, D, DIN, (bf16_t*)(ws + WS_WIN) + (size_t)l * D * DIN, p.in[I_NMG] + l * D, scr, r, lane); continue; } r -= I_IN;
            if (r < I_OUT) { p0_transpose_item(p.in[I_WOUT] + (size_t)l * D * D, D, D, (bf16_t*)(ws + WS_WOUT) + (size_t)l * D * D, p.in[I_MONG] + l * D, scr, r, lane); continue; } r -= I_OUT;
            if (r < I_UP) { p0_transpose_item(p.in[I_WUP] + (size_t)l * D * FF, D, FF, (bf16_t*)(ws + WS_WUP) + (size_t)l * D * FF, p.in[I_NMLPG] + l * D, scr, r, lane); continue; } r -= I_UP;
            if (r < I_DN) { p0_transpose_item(p.in[I_WDN] + (size_t)l * D * FF, FF, D, (bf16_t*)(ws + WS_WDN) + (size_t)l * D * FF, nullptr, scr, r, lane); continue; } r -= I_DN;
            p0_transpose_item(p.in[I_WGLU] + (size_t)l * 65536, 256, 256, (bf16_t*)(ws + WS_WGLU) + (size_t)l * 65536, nullptr, scr, r, lane);
        }
    }
    {
        float* ssq0 = (float*)(ws + WS_SSQP); bf16_t* XB = (bf16_t*)(ws + WS_XB);
        for (int mb = gw * 16; mb < T; mb += NGW * 16) {
            float keep = 0.f;
#pragma unroll 4
            for (int i = 0; i < 16; ++i) { const int m = mb + i;
                const f32x4* xr = (const f32x4*)(p.in[I_X] + (size_t)m * D) + lane; f32x4 v[4]; float s = 0.f;
#pragma unroll
                for (int j = 0; j < 4; ++j) { v[j] = xr[64 * j]; s += (v[j][0] * v[j][0] + v[j][1] * v[j][1]) + (v[j][2] * v[j][2] + v[j][3] * v[j][3]); }
                s = wave_sum(s); if (lane == i) keep = s;
                u32x2* o8 = (u32x2*)(XB + (size_t)m * D) + lane;
#pragma unroll
                for (int j = 0; j < 4; ++j) { u32x2 w; w.x = pk2(v[j][0], v[j][1]); w.y = pk2(v[j][2], v[j][3]); o8[64 * j] = w; } }
#pragma unroll 1
            for (int i = 0; i < 16; ++i) { const float v = __shfl(keep, i); if (lane < 16) ssq0[(size_t)(mb + i) * 16 + lane] = lane == 0 ? v : 0.f; }
        }
    }
    {
        float* LB = (float*)(ws + WS_LB);
        for (int c = gt; c < 256; c += NGT) {
            const float a0 = p.in[I_LBL][c], a1 = p.in[I_LBL][256 + c], a2 = p.in[I_LBL][512 + c], a3 = p.in[I_LBL][768 + c];
            const float mx = fmaxf(fmaxf(a0, a1), fmaxf(a2, a3));
            const float e0 = expf(a0 - mx), e1 = expf(a1 - mx), e2 = expf(a2 - mx), e3 = expf(a3 - mx); const float inv = 1.f / (e0 + e1 + e2 + e3);
            const float s1 = e1 * inv, s2 = e2 * inv, s3 = e3 * inv; const float hi = 1.0f - 1e-6f;
            LB[c] = 0.f; LB[256 + c] = fminf(fmaxf(s1, 0.f), hi); LB[512 + c] = fminf(fmaxf(s1 + s2, 0.f), hi); LB[768 + c] = fminf(fmaxf(s1 + s2 + s3, 0.f), hi);
        }
        float* BT = (float*)(ws + WS_BIAS);
        for (int i = gt; i < 3 * 4 * 132; i += NGT) {
            const int pt = i / (4 * 132), hd = (i / 132) % 4, dl = i % 132; const int dil = pt == 0 ? 1 : (pt == 1 ? 4 : 16);
            float v = 0.f;
            if (dl <= 128) { const int dist = dl * dil; int bk;
                if (dist < 16) bk = dist; else { bk = 16 + (int)(logf((float)dist / 16.0f) / 4.852030263919617f * 16.0f); if (bk > 31) bk = 31; }
                v = p.in[I_RB][bk * 4 + hd]; }
            BT[i] = v;
        }
    }
    {
        bf16_t* KT = (bf16_t*)(ws + WS_S5K); bf16_t* WS_ = (bf16_t*)(ws + WS_S5WS); bf16_t* WC = (bf16_t*)(ws + WS_S5WC);
        LAS float* ebr = scr; LAS float* ebi = scr + 64 * 17;
        for (int it = gw; it < NL * 16 * 64; it += NGW) {
            const int lg = it >> 6, d = it & 63;
            float lrdt, lidt, cr, ci; s5_params(p, lg, lane, lrdt, lidt, cr, ci);
            float er, ei; s5_pow(lrdt, lidt, d, er, ei);
            const float fr_ = er * cr - ei * ci, fi_ = er * ci + ei * cr;
            const float* br = p.in[I_BRE] + ((size_t)lg * 64 + lane) * 16; const float* bi = p.in[I_BIM] + ((size_t)lg * 64 + lane) * 16;
#pragma unroll
            for (int c = 0; c < 16; ++c) { const float b0 = br[c], b1 = bi[c]; ebr[lane * 17 + c] = fr_ * b0 - fi_ * b1; ebi[lane * 17 + c] = fr_ * b1 + fi_ * b0; }
            LDS_WAIT();
            const int co = lane & 15, cb = (lane >> 4) * 4;
            const float* crp = p.in[I_CRE] + ((size_t)lg * 16 + co) * 64; const float* cip = p.in[I_CIM] + ((size_t)lg * 16 + co) * 64;
            float a0 = 0.f, a1 = 0.f, a2 = 0.f, a3 = 0.f;
            for (int q = 0; q < 64; ++q) { const float c0 = crp[q], c1 = cip[q];
                a0 += c0 * ebr[q * 17 + cb + 0] - c1 * ebi[q * 17 + cb + 0]; a1 += c0 * ebr[q * 17 + cb + 1] - c1 * ebi[q * 17 + cb + 1];
                a2 += c0 * ebr[q * 17 + cb + 2] - c1 * ebi[q * 17 + cb + 2]; a3 += c0 * ebr[q * 17 + cb + 3] - c1 * ebi[q * 17 + cb + 3]; }
            u32x2 w; w.x = pk2(a0, a1); w.y = pk2(a2, a3);
            *(u32x2*)(KT + ((size_t)it * 16 + co) * 16 + cb) = w;
            LDS_WAIT();
        }
        for (int it = gw; it < NL * 16 * 16; it += NGW) {
            const int lg = it >> 4, s4 = it & 15;
            float lrdt, lidt, cr, ci; s5_params(p, lg, lane, lrdt, lidt, cr, ci);
            const float* br = p.in[I_BRE] + ((size_t)lg * 64 + lane) * 16; const float* bi = p.in[I_BIM] + ((size_t)lg * 64 + lane) * 16;
            float b0[16], b1[16];
#pragma unroll
            for (int c = 0; c < 16; ++c) { b0[c] = br[c]; b1[c] = bi[c]; }
#pragma unroll 1
            for (int sq = 0; sq < 4; ++sq) { const int s = s4 * 4 + sq;
                float er, ei; s5_pow(lrdt, lidt, 63 - s, er, ei);
                const float fr_ = er * cr - ei * ci, fi_ = er * ci + ei * cr;
                float vr[16], vi[16];
#pragma unroll
                for (int c = 0; c < 16; ++c) { vr[c] = fr_ * b0[c] - fi_ * b1[c]; vi[c] = fr_ * b1[c] + fi_ * b0[c]; }
                bf16_t* o0 = WS_ + (((size_t)lg * 64 + s) * 128 + lane) * 16; bf16_t* o1 = WS_ + (((size_t)lg * 64 + s) * 128 + 64 + lane) * 16;
                u32x4 w;
                w.x = pk2(vr[0], vr[1]); w.y = pk2(vr[2], vr[3]); w.z = pk2(vr[4], vr[5]); w.w = pk2(vr[6], vr[7]); *(u32x4*)o0 = w;
                w.x = pk2(vr[8], vr[9]); w.y = pk2(vr[10], vr[11]); w.z = pk2(vr[12], vr[13]); w.w = pk2(vr[14], vr[15]); *(u32x4*)(o0 + 8) = w;
                w.x = pk2(vi[0], vi[1]); w.y = pk2(vi[2], vi[3]); w.z = pk2(vi[4], vi[5]); w.w = pk2(vi[6], vi[7]); *(u32x4*)o1 = w;
                w.x = pk2(vi[8], vi[9]); w.y = pk2(vi[10], vi[11]); w.z = pk2(vi[12], vi[13]); w.w = pk2(vi[14], vi[15]); *(u32x4*)(o1 + 8) = w; }
        }
        for (int it = gw; it < NL * 16 * 64; it += NGW) {
            const int lg = it >> 6, tl = it & 63;
            float lrdt, lidt, cr, ci; s5_params(p, lg, lane, lrdt, lidt, cr, ci);
            float er, ei; s5_pow(lrdt, lidt, tl + 1, er, ei);
#pragma unroll 4
            for (int co = 0; co < 16; ++co) { const float c0 = p.in[I_CRE][((size_t)lg * 16 + co) * 64 + lane], c1 = p.in[I_CIM][((size_t)lg * 16 + co) * 64 + lane];
                bf16_t* o = WC + (((size_t)lg * 64 + tl) * 16 + co) * 128;
                o[lane] = (bf16_t)f2bf(c0 * er - c1 * ei); o[64 + lane] = (bf16_t)f2bf(-(c0 * ei + c1 * er)); }
        }
    }
}

template <bool OUT>
DI void hgrn_item(const Params& p, LAS unsigned char* lds, int l, int cg) {
    int tid_o = threadIdx.x; asm volatile("" : "+v"(tid_o));
    const int tid = tid_o, lane = tid & 63, wave = tid >> 6, hd = wave >> 1, half = wave & 1;
    const bf16_t* Z = (const bf16_t*)(p.ws + WS_Z);
    LAS bf16_t* B0 = (LAS bf16_t*)(lds + hd * 27648); LAS bf16_t* B1 = B0 + 64 * 72; LAS bf16_t* B2 = B1 + 64 * 72;
    LAS float* GM = (LAS float*)(lds + 114688) + hd * 64; LAS float* GL = GM + 256; LAS float* SSA = (LAS float*)(lds + 114688) + 512;
    bf16_t* SL = (bf16_t*)(p.ws + WS_SL); const bf16_t* SL2 = (const bf16_t*)(p.ws + WS_SL2); float* DEC = (float*)(p.ws + WS_DEC);
    const int item = cg * 4 + hd;
#ifdef FORCE_LB0
    const float lb = 0.f, oml = 1.f;
#else
    const float lb = ((const float*)(p.ws + WS_LB))[l * 256 + hd * 64 + lane], oml = 1.f - lb;
#endif
    const int srow = tid >> 5, shd = (tid >> 3) & 3, spc = tid & 7;
    const bf16_t* zsrc = Z + (size_t)(cg * 64 + srow) * DIN + shd * 64 + spc * 8;
    const int sdst = shd * 27648 + (srow * 72 + spc * 8) * 2;
    u32x4 wsl[4], wg[4];
    if (OUT) { const bf16_t* sp = SL2 + (size_t)item * 4096 + (32 * half) * 64;
#pragma unroll
        for (int e = 0; e < 4; ++e) { wsl[e] = *(const u32x4*)(sp + (lane + 64 * e) * 8); wg[e] = *(const u32x4*)(zsrc + (size_t)(16 * e) * DIN + ZG); } }
    __syncthreads();
    { u32x4 wf[4], wi[4], wq[4];
#pragma unroll
      for (int sub = 0; sub < 4; ++sub) { wf[sub] = *(const u32x4*)(zsrc + (size_t)(16 * sub) * DIN + ZF); wi[sub] = *(const u32x4*)(zsrc + (size_t)(16 * sub) * DIN + ZI);
          if (OUT) wq[sub] = *(const u32x4*)(zsrc + (size_t)(16 * sub) * DIN + ZQ); }
#pragma unroll
      for (int sub = 0; sub < 4; ++sub) { *(LAS u32x4*)(lds + sdst + 9216 + sub * 16 * 144) = wf[sub]; *(LAS u32x4*)(lds + sdst + 18432 + sub * 16 * 144) = wi[sub];
          if (OUT) *(LAS u32x4*)(lds + sdst + sub * 16 * 144) = wq[sub]; } }
    __syncthreads();
    float g[32]; float run = 0.f;
#pragma unroll
    for (int j = 0; j < 32; ++j) { const float fz = bf2f(B1[(half * 32 + j) * 72 + lane]); const float sg = sigmoidf_(fz); const float f = lb + oml * sg;
        run += __logf(fmaxf(f, 1e-30f)); g[j] = run; }
    if (half == 0) GM[lane] = run;
    __syncthreads();
    const float gm = GM[lane];
    if (half) {
#pragma unroll
        for (int j = 0; j < 32; ++j) g[j] += gm; }
    const int c0 = lane & 31, h = lane >> 5;
    if constexpr (!OUT) {
        if (half) GL[lane] = run + gm;
        __syncthreads();
        const float gl = GL[lane];
        bf16_t kv[32], ivr[32];
#pragma unroll
        for (int j = 0; j < 32; ++j) { const int t = half * 32 + j; const float e = __expf(gl - g[j]); const float kj = oml * (1.f - sigmoidf_(bf2f(B1[t * 72 + lane])));
            kv[j] = (bf16_t)f2bf(kj * e); ivr[j] = B2[t * 72 + lane]; }
        __syncthreads();
#pragma unroll
        for (int j = 0; j < 32; ++j) { const int t = half * 32 + j; B1[lane * 72 + t] = kv[j]; B2[lane * 72 + t] = ivr[j]; }
        __syncthreads();
#pragma unroll
        for (int kt = 0; kt < 2; ++kt) { const f32x16 a = mma_lds<64>(B2 + 32 * half * 72, 72, B1 + 32 * kt * 72, 72, zero16(), lane);
#pragma unroll
            for (int i = 0; i < 16; ++i) SL[(size_t)item * 4096 + (32 * half + crow(i, h)) * 64 + 32 * kt + c0] = (bf16_t)f2bf(a[i]); }
        if (half == 0) DEC[item * 64 + lane] = __expf(gl);
    } else {
        if (half == 0) GL[lane] = __expf(gm);
        bf16_t ivr[32];
#pragma unroll
        for (int j = 0; j < 32; ++j) { const int t = half * 32 + j; const float q = bf2f(B0[t * 72 + lane]); const float kj = oml * (1.f - sigmoidf_(bf2f(B1[t * 72 + lane])));
            const float e1 = __expf(fminf(g[j] - gm, 80.f)), e2 = __expf(fminf(gm - g[j], 80.f));
            ivr[j] = B2[t * 72 + lane];
            B0[t * 72 + lane] = (bf16_t)f2bf(q * e1); B1[t * 72 + lane] = (bf16_t)f2bf(kj * e2); }
        __syncthreads();
#pragma unroll
        for (int j = 0; j < 32; ++j) B2[lane * 72 + half * 32 + j] = ivr[j];
        __syncthreads();
        f32x16 s0 = mma_lds<64>(B0 + 32 * half * 72, 72, B1, 72, zero16(), lane);
        f32x16 s1 = zero16(); if (half) s1 = mma_lds<64>(B0 + 32 * half * 72, 72, B1 + 32 * 72, 72, zero16(), lane);
        __syncthreads();
#pragma unroll
        for (int i = 0; i < 16; ++i) { const int row = 32 * half + crow(i, h);
            B1[row * 72 + c0] = (bf16_t)f2bf(c0 <= row ? s0[i] : 0.f); B1[row * 72 + 32 + c0] = (bf16_t)f2bf(32 + c0 <= row ? s1[i] : 0.f); }
        __syncthreads();
        f32x16 o0 = mma_lds<64>(B1 + 32 * half * 72, 72, B2, 72, zero16(), lane);
        f32x16 o1 = mma_lds<64>(B1 + 32 * half * 72, 72, B2 + 32 * 72, 72, zero16(), lane);
        __syncthreads();
        {
#pragma unroll
          for (int e = 0; e < 4; ++e) { const int pc = lane + 64 * e, row = pc >> 3, k0 = (pc & 7) * 8; const LAS float* eg = GL + k0;
              u32x4 o; o.x = pk2(bflo(wsl[e].x) * eg[0], bfhi(wsl[e].x) * eg[1]); o.y = pk2(bflo(wsl[e].y) * eg[2], bfhi(wsl[e].y) * eg[3]);
              o.z = pk2(bflo(wsl[e].z) * eg[4], bfhi(wsl[e].z) * eg[5]); o.w = pk2(bflo(wsl[e].w) * eg[6], bfhi(wsl[e].w) * eg[7]);
              *(LAS u32x4*)(B2 + (32 * half + row) * 72 + k0) = o;
              *(LAS u32x4*)(lds + sdst + 9216 + e * 16 * 144) = wg[e]; } }
        __syncthreads();
        o0 = mma_lds<64>(B0 + 32 * half * 72, 72, B2, 72, o0, lane);
        o1 = mma_lds<64>(B0 + 32 * half * 72, 72, B2 + 32 * 72, 72, o1, lane);
        const float* ng = p.in[I_HNG] + l * 256 + hd * 64; const float ng0 = ng[c0], ng1 = ng[32 + c0];
#pragma unroll
        for (int i = 0; i < 16; ++i) { const int row = 32 * half + crow(i, h);
            const float ss = half_sum(o0[i] * o0[i] + o1[i] * o1[i]); const float rs = rsqrtf(ss * (1.0f / 64.0f) + EPS);
            const float g0 = bf2f(B1[row * 72 + c0]), g1 = bf2f(B1[row * 72 + 32 + c0]);
            const float v0 = o0[i] * rs * ng0 * g0 * sigmoidf_(g0), v1 = o1[i] * rs * ng1 * g1 * sigmoidf_(g1);
            o0[i] = v0; o1[i] = v1; const float s2 = half_sum(v0 * v0 + v1 * v1); if (c0 == 0) SSA[hd * 64 + row] = s2; }
        __syncthreads();
        bf16_t* Y = (bf16_t*)(p.ws + WS_YCAT);
#pragma unroll
        for (int i = 0; i < 16; ++i) { const int row = 32 * half + crow(i, h); const size_t tok = (size_t)cg * 64 + row;
            const float tot = (SSA[row] + SSA[64 + row]) + (SSA[128 + row] + SSA[192 + row]); const float r2 = rsqrtf(tot * (1.0f / 256.0f) + EPS);
            Y[tok * D + YA + hd * 64 + c0] = (bf16_t)f2bf(o0[i] * r2); Y[tok * D + YA + hd * 64 + 32 + c0] = (bf16_t)f2bf(o1[i] * r2); }
    }
}
DI void hgrn_scan_item(const Params& p, int hb) {
    int tid_o = threadIdx.x; asm volatile("" : "+v"(tid_o));
    const int e = hb * 512 + tid_o, bh = e >> 12, b = bh >> 2, hd = bh & 3, vk = e & 4095, k = vk & 63;
    const bf16_t* SL = (const bf16_t*)(p.ws + WS_SL); bf16_t* SL2 = (bf16_t*)(p.ws + WS_SL2); const float* DEC = (const float*)(p.ws + WS_DEC);
    float st = 0.f;
    for (int c8 = 0; c8 < 128; c8 += 16) { float tmp[16], dc[16];
#pragma unroll
        for (int u = 0; u < 16; ++u) { const int item = (b * 128 + c8 + u) * 4 + hd; tmp[u] = bf2f(SL[(size_t)item * 4096 + vk]); dc[u] = DEC[item * 64 + k]; }
#pragma unroll
        for (int u = 0; u < 16; ++u) { const int item = (b * 128 + c8 + u) * 4 + hd; SL2[(size_t)item * 4096 + vk] = (bf16_t)f2bf(st); st = dc[u] * st + tmp[u]; } }
}

DI void conv_item(const Params& p, LAS unsigned char* lds, int l, int ti) {
    int tid_o = threadIdx.x; asm volatile("" : "+v"(tid_o));
    const int tid = tid_o, lane = tid & 63, wave = tid >> 6, c = tid & 255, hf = tid >> 8, wv = wave & 3;
    LAS float* Hs = (LAS float*)lds; LAS float* ST = (LAS float*)(lds + 98304); LAS float* ST2 = ST + 512;
    const bf16_t* Z = (const bf16_t*)(p.ws + WS_Z); bf16_t* Y = (bf16_t*)(p.ws + WS_YCAT);
    const int tok0 = ti * 64, pos0 = (ti & 127) * 64;
    const float* cw = p.in[I_CW] + (size_t)l * 31 * 256 + c; float w[31];
#pragma unroll
    for (int jj = 0; jj < 31; ++jj) w[jj] = cw[jj * 256];
    const float cb = p.in[I_CB][l * 256 + c];
    const float lng = p.in[I_CLG][l * 256 + c], lnb = p.in[I_CLB][l * 256 + c];
    __syncthreads();
    { u32x4 vw[6], gw_[6];
#pragma unroll
      for (int k = 0; k < 6; ++k) { const int pid = tid + 512 * k, row = pid >> 5, pc = pid & 31, pos = pos0 - 30 + row; const bool ok = (row < 94) && (pos >= 0);
          const size_t tok = ok ? (size_t)(tok0 - 30 + row) : (size_t)tok0; vw[k] = *(const u32x4*)(Z + tok * DIN + ZBV + pc * 8); gw_[k] = *(const u32x4*)(Z + tok * DIN + ZBG + pc * 8); }
#pragma unroll
      for (int k = 0; k < 6; ++k) { const int pid = tid + 512 * k, row = pid >> 5, pc = pid & 31, pos = pos0 - 30 + row; const bool ok = (row < 94) && (pos >= 0);
          if (row < 94) { f32x4 h0, h1;
              h0[0] = bflo(vw[k].x) * sigmoidf_(bflo(gw_[k].x)); h0[1] = bfhi(vw[k].x) * sigmoidf_(bfhi(gw_[k].x)); h0[2] = bflo(vw[k].y) * sigmoidf_(bflo(gw_[k].y)); h0[3] = bfhi(vw[k].y) * sigmoidf_(bfhi(gw_[k].y));
              h1[0] = bflo(vw[k].z) * sigmoidf_(bflo(gw_[k].z)); h1[1] = bfhi(vw[k].z) * sigmoidf_(bfhi(gw_[k].z)); h1[2] = bflo(vw[k].w) * sigmoidf_(bflo(gw_[k].w)); h1[3] = bfhi(vw[k].w) * sigmoidf_(bfhi(gw_[k].w));
              if (!ok) { h0 = (f32x4){0.f, 0.f, 0.f, 0.f}; h1 = h0; }
              *(LAS f32x4*)(Hs + row * 256 + pc * 8) = h0; *(LAS f32x4*)(Hs + row * 256 + pc * 8 + 4) = h1; } } }
    __syncthreads();
    LAS float* OT2 = (LAS float*)(lds + 98304);
    LAS float* STAT = (LAS float*)(lds + 131072); LAS float* STAT2 = STAT + 64;
    const int rtl = tid >> 4, rpart = tid & 15;
#pragma unroll 1
    for (int ps = 0; ps < 2; ++ps) { const int tb = hf * 32 + ps * 16;
        float o[16];
        { float hr[46];
#pragma unroll
          for (int r = 0; r < 46; ++r) hr[r] = Hs[(tb + r) * 256 + c];
#pragma unroll
          for (int j = 0; j < 16; ++j) { float a = cb;
#pragma unroll
            for (int jj = 0; jj < 31; ++jj) a += w[jj] * hr[j + jj];
            o[j] = a; } }
#pragma unroll
        for (int j = 0; j < 16; ++j) OT2[(hf * 16 + j) * 256 + c] = o[j];
        __syncthreads();
        { const LAS f32x4* q = (const LAS f32x4*)(OT2 + rtl * 256 + rpart * 16); float s1 = 0.f, s2 = 0.f;
#pragma unroll
          for (int e = 0; e < 4; ++e) { const f32x4 v = q[e]; s1 += (v[0] + v[1]) + (v[2] + v[3]); s2 += (v[0] * v[0] + v[1] * v[1]) + (v[2] * v[2] + v[3] * v[3]); }
#pragma unroll
          for (int off = 1; off < 16; off <<= 1) { s1 += __shfl_xor(s1, off); s2 += __shfl_xor(s2, off); }
          if (rpart == 0) { const float mu = s1 * (1.0f / 256.0f); const float var = fmaxf(s2 * (1.0f / 256.0f) - mu * mu, 0.f); STAT[rtl * 2] = mu; STAT[rtl * 2 + 1] = rsqrtf(var + EPS); } }
        __syncthreads();
#pragma unroll
        for (int j = 0; j < 16; ++j) { const float mu = STAT[(hf * 16 + j) * 2], rsd = STAT[(hf * 16 + j) * 2 + 1];
            const float y = (o[j] - mu) * rsd * lng + lnb; const float sv = y * sigmoidf_(y); o[j] = sv; OT2[(hf * 16 + j) * 256 + c] = sv; }
        __syncthreads();
        { const LAS f32x4* q = (const LAS f32x4*)(OT2 + rtl * 256 + rpart * 16); float s3 = 0.f;
#pragma unroll
          for (int e = 0; e < 4; ++e) { const f32x4 v = q[e]; s3 += (v[0] * v[0] + v[1] * v[1]) + (v[2] * v[2] + v[3] * v[3]); }
#pragma unroll
          for (int off = 1; off < 16; off <<= 1) s3 += __shfl_xor(s3, off);
          if (rpart == 0) STAT2[rtl] = rsqrtf(s3 * (1.0f / 256.0f) + EPS); }
        __syncthreads();
#pragma unroll
        for (int j = 0; j < 16; ++j) Y[(size_t)(tok0 + tb + j) * D + YB + c] = (bf16_t)f2bf(o[j] * STAT2[hf * 16 + j]);
    }
}

DI bf16x8 ldg8(const bf16_t* p) { return *(const bf16x8*)p; }
DI void s5_local_item(const Params& p, LAS unsigned char* lds, int l, int bi) {
    int tid_o = threadIdx.x; asm volatile("" : "+v"(tid_o));
    const int tid = tid_o, lane = tid & 63, wave = tid >> 6;
    const int gh = bi & 1, cb = (bi >> 1) & 15, pt = bi >> 5, g = gh * 8 + wave, c0 = lane & 31, h = lane >> 5, lg = l * 16 + g;
    LAS bf16_t* UT = (LAS bf16_t*)lds;
    const bf16_t* Z = (const bf16_t*)(p.ws + WS_Z);
    const int sm = tid >> 4, spc = tid & 15;
    const bf16_t* zst = Z + (size_t)((cb * 32 + sm) * 64) * DIN + ZCU + gh * 128 + spc * 8;
    const int ust = (sm * 136 + spc * 8) * 2;
    const bf16_t* wsp = (const bf16_t*)(p.ws + WS_S5WS) + ((size_t)lg * 64 * 128 + pt * 32 + c0) * 16 + 8 * h;
    u32x4 pf[8];
#pragma unroll
    for (int e = 0; e < 8; ++e) pf[e] = *(const u32x4*)(zst + (size_t)e * DIN);
    f32x16 acc = zero16();
    __syncthreads();
    for (int b = 0; b < 8; ++b) { const int s0 = 8 * b;
#pragma unroll
        for (int e = 0; e < 8; ++e) *(LAS u32x4*)(lds + ust + e * (32 * 136 * 2)) = pf[e];
        __syncthreads();
        if (b + 1 < 8) {
#pragma unroll
            for (int e = 0; e < 8; ++e) pf[e] = *(const u32x4*)(zst + (size_t)(s0 + 8 + e) * DIN); }
        bf16x8 bf[8];
#pragma unroll
        for (int e = 0; e < 8; ++e) bf[e] = ldg8(wsp + (size_t)(s0 + e) * 2048);
#pragma unroll
        for (int e = 0; e < 8; ++e) acc = __builtin_amdgcn_mfma_f32_32x32x16_bf16(*(const LAS bf16x8*)(UT + (e * 32 + c0) * 136 + wave * 16 + 8 * h), bf[e], acc, 0, 0, 0);
        __syncthreads();
    }
    float* HL = (float*)(p.ws + WS_S5H);
#pragma unroll
    for (int i = 0; i < 16; ++i) HL[((size_t)(cb * 32 + crow(i, h)) * 16 + g) * 128 + pt * 32 + c0] = acc[i];
}
DI void s5_scan_item(const Params& p, int l, int sb) {
    int tid_o = threadIdx.x; asm volatile("" : "+v"(tid_o));
    const int e = sb * 512 + tid_o, b = e >> 10, g = (e >> 6) & 15, pp = e & 63;
    float lrdt, lidt, cr, ci; s5_params(p, l * 16 + g, pp, lrdt, lidt, cr, ci);
    float ar, ai; s5_pow(lrdt, lidt, 64, ar, ai);
    const float* HL = (const float*)(p.ws + WS_S5H); float* HO = (float*)(p.ws + WS_S5H2); float hr = 0.f, hi = 0.f;
    for (int c8 = 0; c8 < 128; c8 += 16) { float tr[16], ti[16];
#pragma unroll
        for (int u = 0; u < 16; ++u) { const size_t idx = ((size_t)(b * 128 + c8 + u) * 16 + g) * 128; tr[u] = HL[idx + pp]; ti[u] = HL[idx + 64 + pp]; }
#pragma unroll
        for (int u = 0; u < 16; ++u) { const size_t idx = ((size_t)(b * 128 + c8 + u) * 16 + g) * 128; HO[idx + pp] = hr; HO[idx + 64 + pp] = hi;
            const float nr = ar * hr - ai * hi + tr[u], ni = ar * hi + ai * hr + ti[u]; hr = nr; hi = ni; } }
}
DI void s5_out_item(const Params& p, LAS unsigned char* lds, int l, int bi) {
    int tid_o = threadIdx.x; asm volatile("" : "+v"(tid_o));
    const int tid = tid_o, lane = tid & 63, wave = tid >> 6;
    const int gh = bi & 1, cb = (bi >> 1) & 15, pr = bi >> 5, g = gh * 8 + wave, c0 = lane & 31, h = lane >> 5, lg = l * 16 + g;
    LAS bf16_t* UT = (LAS bf16_t*)lds;
    LAS bf16_t* OT = (LAS bf16_t*)(lds + 69632);
    const bf16_t* Z = (const bf16_t*)(p.ws + WS_Z);
    const bf16_t* kt = (const bf16_t*)(p.ws + WS_S5K) + (size_t)lg * 64 * 256;
    const float* ha = (const float*)(p.ws + WS_S5H2) + ((size_t)(cb * 32 + c0) * 16 + g) * 128 + 8 * h;
    const int co = c0 & 15; const float dsk = p.in[I_S5D][l * 256 + g * 16 + co];
    const int jt0 = pr, jt1 = 31 - pr, tl0 = 2 * jt0 + (c0 >> 4), tl1 = 2 * jt1 + (c0 >> 4);
    const int sm = tid >> 4, spc = tid & 15;
    const bf16_t* zst = Z + (size_t)((cb * 32 + sm) * 64) * DIN + ZCU + gh * 128 + spc * 8;
    const int ust = (sm * 136 + spc * 8) * 2;
    const int nb = (2 * jt1 + 2 + 7) >> 3;
    u32x4 pf[8];
#pragma unroll
    for (int e = 0; e < 8; ++e) pf[e] = *(const u32x4*)(zst + (size_t)e * DIN);
    f32x16 acc0 = zero16(), acc1 = zero16();
    { const bf16_t* wc0 = (const bf16_t*)(p.ws + WS_S5WC) + (((size_t)lg * 64 + tl0) * 16 + co) * 128 + 8 * h;
      const bf16_t* wc1 = (const bf16_t*)(p.ws + WS_S5WC) + (((size_t)lg * 64 + tl1) * 16 + co) * 128 + 8 * h;
      f32x4 x0[8], x1[8];
#pragma unroll
      for (int ks = 0; ks < 8; ++ks) { x0[ks] = *(const f32x4*)(ha + ks * 16); x1[ks] = *(const f32x4*)(ha + ks * 16 + 4); }
#pragma unroll
      for (int ks = 0; ks < 8; ++ks) { u32x4 w; w.x = pk2(x0[ks][0], x0[ks][1]); w.y = pk2(x0[ks][2], x0[ks][3]); w.z = pk2(x1[ks][0], x1[ks][1]); w.w = pk2(x1[ks][2], x1[ks][3]);
        const bf16x8 af = __builtin_bit_cast(bf16x8, w);
        acc0 = __builtin_amdgcn_mfma_f32_32x32x16_bf16(af, ldg8(wc0 + ks * 16), acc0, 0, 0, 0);
        acc1 = __builtin_amdgcn_mfma_f32_32x32x16_bf16(af, ldg8(wc1 + ks * 16), acc1, 0, 0, 0); } }
    __syncthreads();
    for (int b = 0; b < nb; ++b) { const int s0 = 8 * b;
#pragma unroll
        for (int e = 0; e < 8; ++e) *(LAS u32x4*)(lds + ust + e * (32 * 136 * 2)) = pf[e];
        __syncthreads();
        if (b + 1 < nb) {
#pragma unroll
            for (int e = 0; e < 8; ++e) pf[e] = *(const u32x4*)(zst + (size_t)(s0 + 8 + e) * DIN); }
        const bool use0 = s0 <= 2 * jt0 + 1;
        bf16x8 b0[8], b1[8];
#pragma unroll
        for (int e = 0; e < 8; ++e) { const int d1 = tl1 - (s0 + e); b1[e] = ldg8(kt + ((size_t)(d1 < 0 ? 0 : d1) * 16 + co) * 16 + 8 * h);
            if (use0) { const int d0 = tl0 - (s0 + e); b0[e] = ldg8(kt + ((size_t)(d0 < 0 ? 0 : d0) * 16 + co) * 16 + 8 * h); } }
#pragma unroll
        for (int e = 0; e < 8; ++e) { const bf16x8 af = *(const LAS bf16x8*)(UT + (e * 32 + c0) * 136 + wave * 16 + 8 * h);
            const int d1 = tl1 - (s0 + e); bf16x8 bb = b1[e]; if (d1 < 0) bb = (bf16x8){0, 0, 0, 0, 0, 0, 0, 0};
            acc1 = __builtin_amdgcn_mfma_f32_32x32x16_bf16(af, bb, acc1, 0, 0, 0);
            if (use0) { const int d0 = tl0 - (s0 + e); bf16x8 ba = b0[e]; if (d0 < 0) ba = (bf16x8){0, 0, 0, 0, 0, 0, 0, 0};
                acc0 = __builtin_amdgcn_mfma_f32_32x32x16_bf16(af, ba, acc0, 0, 0, 0); } }
        __syncthreads();
    }
#pragma unroll
    for (int q = 0; q < 2; ++q) { const int tl = q ? tl1 : tl0;
#pragma unroll
        for (int i = 0; i < 16; ++i) { const int m = crow(i, h); const size_t tok = (size_t)(cb * 32 + m) * 64 + tl; const float u = bf2f(Z[tok * DIN + ZCU + g * 16 + co]);
            const float y = (q ? acc1[i] : acc0[i]) + dsk * u; const float ge = y * sigmoidf_(1.5957691216057308f * (y + 0.044715f * y * y * y));
            OT[(q * 64 + m * 2 + (c0 >> 4)) * 136 + wave * 16 + co] = (bf16_t)f2bf(ge); } }
    __syncthreads();
    { const int tau = tid >> 2, qq = tau >> 6, m = (tau >> 1) & 31, t2 = tau & 1, qt = tid & 3; const int jt = qq ? jt1 : jt0;
      const size_t tok = (size_t)(cb * 32 + m) * 64 + 2 * jt + t2;
      const LAS u32x4* src = (const LAS u32x4*)(OT + tau * 136 + qt * 32); u32x4* dst = (u32x4*)((bf16_t*)(p.ws + WS_YPRE) + tok * 256 + gh * 128 + qt * 32);
#pragma unroll
      for (int e = 0; e < 4; ++e) dst[e] = src[e]; }
}

DI void attn_item(const Params& p, LAS unsigned char* lds, int l, int pt, int id) {
    int tid_o = threadIdx.x; asm volatile("" : "+v"(tid_o));
    const int tid = tid_o, lane = tid & 63, wave = tid >> 6;
    const int dil = pt == 0 ? 1 : (pt == 1 ? 4 : 16), nblk = 32 / dil;
    const int b = id >> 7, hd = (id >> 5) & 3, rn = id & 31, r = rn / nblk, n = rn % nblk;
    LAS bf16_t* Ks = (LAS bf16_t*)lds;
    LAS bf16_t* Vt = (LAS bf16_t*)(lds + 55296);
    LAS float* BT = (LAS float*)(lds + 55296 + 50176);
    const bf16_t* Z = (const bf16_t*)(p.ws + WS_Z);
    const bf16_t* OP = (const bf16_t*)(p.ws + (pt == 1 ? WS_O0 : WS_O1)); const float* LP = (const float*)(p.ws + (pt == 1 ? WS_LSE : WS_LSE1));
    bf16_t* ON = pt == 2 ? (bf16_t*)(p.ws + WS_Z) + ZOD : (bf16_t*)(p.ws + (pt == 0 ? WS_O0 : WS_O1)); const int onp = pt == 2 ? DIN : 256;
    float* LN = (float*)(p.ws + (pt == 0 ? WS_LSE : WS_LSE1));
    const size_t tokb = (size_t)b * SEQ;
    const int c0 = lane & 31, h = lane >> 5;
    const int qi = 32 * wave + c0; const size_t tokq = tokb + (size_t)(n * 256 + qi) * dil + r;
    u32x4 qraw[4]; u32x2 oprev[2][4]; float mprev = 0.f;
#pragma unroll
    for (int ks = 0; ks < 4; ++ks) qraw[ks] = *(const u32x4*)(Z + tokq * DIN + ZDQ + hd * 64 + ks * 16 + 8 * h);
    if (pt > 0) { mprev = LP[tokq * 4 + hd];
#pragma unroll
        for (int vt = 0; vt < 2; ++vt)
#pragma unroll
            for (int g4 = 0; g4 < 4; ++g4) oprev[vt][g4] = *(const u32x2*)(OP + tokq * 256 + hd * 64 + 32 * vt + 8 * g4 + 4 * h); }
    __syncthreads();
    if (tid < 132) BT[tid] = ((const float*)(p.ws + WS_BIAS))[(pt * 4 + hd) * 132 + tid];
    { const float* kg = p.in[I_KG] + l * 64 + (tid & 7) * 8; float kgv[8];
#pragma unroll
      for (int e = 0; e < 8; ++e) kgv[e] = kg[e];
      u32x4 kwv[6], vwv[6];
#pragma unroll
      for (int it = 0; it < 6; ++it) { const int idx = tid + 512 * it, row = idx >> 3, c = idx & 7, si = n * 256 - 128 + row;
        const size_t tok = tokb + (size_t)(si < 0 ? 0 : si) * dil + r;
        kwv[it] = *(const u32x4*)(Z + tok * DIN + ZDK + hd * 64 + c * 8); vwv[it] = *(const u32x4*)(Z + tok * DIN + ZDV + hd * 64 + c * 8); }
#pragma unroll
      for (int it = 0; it < 6; ++it) { const int idx = tid + 512 * it, row = idx >> 3, c = idx & 7, si = n * 256 - 128 + row;
        u32x4 kw = kwv[it], vw = vwv[it];
        if (si < 0) { kw = (u32x4){0u, 0u, 0u, 0u}; vw = (u32x4){0u, 0u, 0u, 0u}; }
        float kf[8]; kf[0] = bflo(kw.x); kf[1] = bfhi(kw.x); kf[2] = bflo(kw.y); kf[3] = bfhi(kw.y); kf[4] = bflo(kw.z); kf[5] = bfhi(kw.z); kf[6] = bflo(kw.w); kf[7] = bfhi(kw.w);
        float ss = 0.f;
#pragma unroll
        for (int e = 0; e < 8; ++e) ss += kf[e] * kf[e];
        ss += __shfl_xor(ss, 1); ss += __shfl_xor(ss, 2); ss += __shfl_xor(ss, 4);
        const float rs = rsqrtf(ss * (1.0f / 64.0f) + EPS);
        u32x4 o; o.x = pk2(kf[0] * rs * kgv[0], kf[1] * rs * kgv[1]); o.y = pk2(kf[2] * rs * kgv[2], kf[3] * rs * kgv[3]); o.z = pk2(kf[4] * rs * kgv[4], kf[5] * rs * kgv[5]); o.w = pk2(kf[6] * rs * kgv[6], kf[7] * rs * kgv[7]);
        *(LAS u32x4*)(Ks + row * 72 + c * 8) = o;
        LAS bf16_t* vp = Vt + (c * 8) * 392 + row;
        vp[0 * 392] = (bf16_t)(vw.x & 0xffffu); vp[1 * 392] = (bf16_t)(vw.x >> 16); vp[2 * 392] = (bf16_t)(vw.y & 0xffffu); vp[3 * 392] = (bf16_t)(vw.y >> 16);
        vp[4 * 392] = (bf16_t)(vw.z & 0xffffu); vp[5 * 392] = (bf16_t)(vw.z >> 16); vp[6 * 392] = (bf16_t)(vw.w & 0xffffu); vp[7 * 392] = (bf16_t)(vw.w >> 16); } }
    __syncthreads();
    bf16x8 qf[4];
    { float qv[4][8]; float ss = 0.f;
#pragma unroll
      for (int ks = 0; ks < 4; ++ks) { const u32x4 w = qraw[ks];
        qv[ks][0] = bflo(w.x); qv[ks][1] = bfhi(w.x); qv[ks][2] = bflo(w.y); qv[ks][3] = bfhi(w.y); qv[ks][4] = bflo(w.z); qv[ks][5] = bfhi(w.z); qv[ks][6] = bflo(w.w); qv[ks][7] = bfhi(w.w);
#pragma unroll
        for (int e = 0; e < 8; ++e) ss += qv[ks][e] * qv[ks][e]; }
      ss += __shfl_xor(ss, 32);
      const float rs = rsqrtf(ss * (1.0f / 64.0f) + EPS) * 0.125f;
#pragma unroll
      for (int ks = 0; ks < 4; ++ks) { const float* qg = p.in[I_QG] + l * 64 + ks * 16 + 8 * h; const f32x4 g0 = *(const f32x4*)qg, g1 = *(const f32x4*)(qg + 4);
        u32x4 w; w.x = pk2(qv[ks][0] * rs * g0[0], qv[ks][1] * rs * g0[1]); w.y = pk2(qv[ks][2] * rs * g0[2], qv[ks][3] * rs * g0[3]);
        w.z = pk2(qv[ks][4] * rs * g1[0], qv[ks][5] * rs * g1[1]); w.w = pk2(qv[ks][6] * rs * g1[2], qv[ks][7] * rs * g1[3]);
        qf[ks] = __builtin_bit_cast(bf16x8, w); } }
    f32x16 acc[5];
#pragma unroll
    for (int c = 0; c < 5; ++c) { acc[c] = zero16(); const LAS bf16_t* kb = Ks + (32 * wave + 32 * c + c0) * 72 + 8 * h;
#pragma unroll
        for (int ks = 0; ks < 4; ++ks) acc[c] = __builtin_amdgcn_mfma_f32_32x32x16_bf16(*(const LAS bf16x8*)(kb + ks * 16), qf[ks], acc[c], 0, 0, 0); }
    float mx = -1e30f;
    { const int tq = c0 - 4 * h, kmin = 128 - n * 256; const LAS float* pb = BT + tq - 32;
#pragma unroll
      for (int c = 0; c < 5; ++c) { const int th = kmin - (32 * wave + 32 * c) - 4 * h;
#pragma unroll
        for (int i = 0; i < 16; ++i) { const int ci = (i & 3) + 8 * (i >> 2);
            bool valid = ci >= th;
            if (c == 0) valid = valid && (tq <= ci);
            if (c == 4) valid = valid && (tq >= ci);
            const float lgt = valid ? acc[c][i] + pb[160 - 32 * c - ci] : -1e30f; acc[c][i] = lgt; mx = fmaxf(mx, lgt); } } }
    mx = fmaxf(mx, __shfl_xor(mx, 32));
    float mnew = mx;
    if (pt > 0) mnew = fmaxf(mx, mprev);
    float lsum = 0.f;
#pragma unroll
    for (int c = 0; c < 5; ++c)
#pragma unroll
        for (int i = 0; i < 16; ++i) { const float pv = __expf(acc[c][i] - mnew); acc[c][i] = pv; lsum += pv; }
    lsum += __shfl_xor(lsum, 32);
    f32x16 o[2]; o[0] = zero16(); o[1] = zero16();
#pragma unroll
    for (int c = 0; c < 5; ++c)
#pragma unroll
        for (int s = 0; s < 2; ++s) { u32x4 pw; pw.x = pk2(acc[c][8 * s + 0], acc[c][8 * s + 1]); pw.y = pk2(acc[c][8 * s + 2], acc[c][8 * s + 3]); pw.z = pk2(acc[c][8 * s + 4], acc[c][8 * s + 5]); pw.w = pk2(acc[c][8 * s + 6], acc[c][8 * s + 7]);
            const bf16x8 pf = __builtin_bit_cast(bf16x8, pw);
#pragma unroll
            for (int vt = 0; vt < 2; ++vt) { const LAS bf16_t* va = Vt + (32 * vt + c0) * 392 + 32 * wave + 32 * c + 16 * s + 4 * h;
                const s16x4 lo = *(const LAS s16x4*)va, hi = *(const LAS s16x4*)(va + 8);
                const bf16x8 vf = __builtin_shufflevector(lo, hi, 0, 1, 2, 3, 4, 5, 6, 7);
                o[vt] = __builtin_amdgcn_mfma_f32_32x32x16_bf16(vf, pf, o[vt], 0, 0, 0); } }
    float sp = 0.f; if (pt > 0) sp = __expf(mprev - mnew);
    const float ltot = lsum + sp, inv = __builtin_amdgcn_rcpf(ltot);
#pragma unroll
    for (int vt = 0; vt < 2; ++vt)
#pragma unroll
        for (int g4 = 0; g4 < 4; ++g4) { const int ch = hd * 64 + 32 * vt + 8 * g4 + 4 * h; bf16_t* yo = ON + tokq * onp + ch;
            float v0 = o[vt][4 * g4 + 0], v1 = o[vt][4 * g4 + 1], v2 = o[vt][4 * g4 + 2], v3 = o[vt][4 * g4 + 3];
            if (pt > 0) { const u32x2 w = oprev[vt][g4]; v0 += sp * bflo(w.x); v1 += sp * bfhi(w.x); v2 += sp * bflo(w.y); v3 += sp * bfhi(w.y); }
            u32x2 w; w.x = pk2(v0 * inv, v1 * inv); w.y = pk2(v2 * inv, v3 * inv); *(u32x2*)yo = w; }
    if (h == 0 && pt < 2) __hip_atomic_store(LN + tokq * 4 + hd, mnew + __logf(ltot), __ATOMIC_RELAXED, __HIP_MEMORY_SCOPE_AGENT);
}

#define RLX_AGENT __ATOMIC_RELAXED, __HIP_MEMORY_SCOPE_AGENT
#define XB_TMO      128
#define XB_XCNT(j)  (256  + 64 * (j))
#define XB_XSUB(j)  (1280 + 64 * (j))
#define XB_XGEN(j)  (2304 + 64 * (j))
#define XB_TOP      3328
#define XB_TOPGEN   3392
#define XCD_BAR_WORDS 3456
#define XB_SPIN_CAP (1u << 18)

__device__ __forceinline__ unsigned xb_ld(unsigned* p)              { return __hip_atomic_load(p, __ATOMIC_RELAXED, __HIP_MEMORY_SCOPE_AGENT); }
__device__ __forceinline__ unsigned xb_add(unsigned* p, unsigned v) { return __hip_atomic_fetch_add(p, v, __ATOMIC_RELAXED, __HIP_MEMORY_SCOPE_AGENT); }
__device__ __forceinline__ unsigned xb_xcc_id() { return (unsigned)__builtin_amdgcn_s_getreg((3 << 11) | 20) & 0xFu; }
#define XB_SPIN(cond, bar) do { unsigned _sp = 0; while (cond) { __builtin_amdgcn_s_sleep(1); \
    if ((++_sp & 255u) == 0u) { if (xb_ld(&(bar)[XB_TMO])) break; if (_sp > XB_SPIN_CAP) { atomicAdd(&(bar)[XB_TMO], 1u); break; } } } } while (0)

struct XcdBarrier {
    unsigned* bar; unsigned x;
    volatile LAS unsigned* st;
};

__device__ __forceinline__ XcdBarrier xcd_barrier_post(unsigned* bar, volatile LAS unsigned* st) {
    XcdBarrier b; b.bar = bar; b.x = xb_xcc_id(); b.st = st;
    if (threadIdx.x == 0) (void)xb_add(&bar[XB_XCNT(b.x)], 1u);
    return b;
}
__device__ __forceinline__ void xcd_barrier_complete(unsigned* bar, unsigned x, unsigned& nloc, unsigned& nx) {
    const unsigned G = gridDim.x * gridDim.y * gridDim.z;
    unsigned sum, cnt, mine, sp = 0u;
    for (;;) {
        sum = 0u; cnt = 0u; mine = 0u;
#pragma unroll
        for (unsigned j = 0; j < 16; ++j) { const unsigned c = xb_ld(&bar[XB_XCNT(j)]); sum += c; cnt += (c > 0u) ? 1u : 0u; mine = (j == x) ? c : mine; }
        if (sum == G) break;
        __builtin_amdgcn_s_sleep(1);
        if ((++sp & 255u) == 0u) { if (xb_ld(&bar[XB_TMO])) break; if (sp > XB_SPIN_CAP) { atomicAdd(&bar[XB_TMO], 1u); break; } }
    }
    nloc = mine > 0u ? mine : 1u; nx = cnt > 0u ? cnt : 1u;
}

__device__ __forceinline__ void xcd_barrier(const XcdBarrier& b) {
    asm volatile("s_waitcnt vmcnt(0)" ::: "memory");
    __syncthreads();
    if (threadIdx.x == 0) {
        unsigned* bar = b.bar;
        __builtin_amdgcn_s_waitcnt(0);
        unsigned nloc = b.st[0], nx = b.st[1];
        if (nloc == 0u) { xcd_barrier_complete(bar, b.x, nloc, nx); b.st[0] = nloc; b.st[1] = nx; }
        const unsigned old = xb_add(&bar[XB_XSUB(b.x)], 1u);
        const unsigned gen = old / nloc;
        if (old + 1u == (gen + 1u) * nloc) {
            __builtin_amdgcn_fence(__ATOMIC_RELEASE, "agent");
            asm volatile("s_waitcnt vmcnt(0)" ::: "memory");
            const unsigned og = xb_add(&bar[XB_TOP], 1u);
            const unsigned tg = og / nx;
            if (og + 1u == (tg + 1u) * nx) xb_add(&bar[XB_TOPGEN], 1u);
            else XB_SPIN(xb_ld(&bar[XB_TOPGEN]) == tg, bar);
            __builtin_amdgcn_fence(__ATOMIC_ACQUIRE, "agent");
            xb_add(&bar[XB_XGEN(b.x)], 1u);
            asm volatile("s_waitcnt vmcnt(0)" ::: "memory");
        } else {
            XB_SPIN(xb_ld(&bar[XB_XGEN(b.x)]) == gen, bar);
            __builtin_amdgcn_fence(__ATOMIC_ACQUIRE, "agent");
            asm volatile("s_waitcnt vmcnt(0)" ::: "memory");
        }
    }
    __syncthreads();
}

#ifndef REP_A
#define REP_A 0
#endif
#ifndef REP_B
#define REP_B 0
#endif
#ifndef REP_C
#define REP_C 0
#endif
#ifndef REP_D
#define REP_D 0
#endif
#ifndef MIX_A
#define MIX_A 1
#endif
#ifndef MIX_B
#define MIX_B 1
#endif
#ifndef MIX_C
#define MIX_C 1
#endif
#ifndef MIX_D
#define MIX_D 1
#endif
__global__ void __launch_bounds__(512, 2) hybrid_fwd(Params p) {
    extern __shared__ __attribute__((aligned(16))) unsigned char lds_raw[];
    LAS unsigned char* lds = (LAS unsigned char*)lds_raw;
    cg::grid_group grid = cg::this_grid();
    { volatile LAS unsigned* st0 = (volatile LAS unsigned*)(lds + LDS_BYTES - 64); if (threadIdx.x < 2) st0[threadIdx.x] = 0u; }
    __syncthreads();
    (void)xcd_barrier_post((unsigned*)(p.ws + WS_BAR), (volatile LAS unsigned*)(lds + LDS_BYTES - 64));
    const int G = gridDim.x, bid = blockIdx.x;
    unsigned char* ws = p.ws;
    bf16_t* XB = (bf16_t*)(ws + WS_XB); bf16_t* Zb = (bf16_t*)(ws + WS_Z); bf16_t* YC_ = (bf16_t*)(ws + WS_YCAT); bf16_t* HM = (bf16_t*)(ws + WS_HM);
    float* SSQP = (float*)(ws + WS_SSQP);

#define GRID_SYNC_() do { asm volatile("s_waitcnt vmcnt(0) lgkmcnt(0)" ::: "memory"); grid.sync(); if (threadIdx.x < 64) { __builtin_amdgcn_fence(__ATOMIC_ACQUIRE, "agent"); asm volatile("s_waitcnt vmcnt(0)" ::: "memory"); } __syncthreads(); } while (0)
#define XBAR_ONCE() do { XcdBarrier b_; b_.bar = (unsigned*)(p.ws + WS_BAR); b_.x = xb_xcc_id(); b_.st = (volatile LAS unsigned*)(lds + LDS_BYTES - 64); xcd_barrier(b_); } while (0)
#ifdef REP_SYNC
#define GRID_SYNC() do { XBAR_ONCE(); XBAR_ONCE(); } while (0)
#else
#define GRID_SYNC() XBAR_ONCE()
#endif
    prologue(p, lds, G);
#ifdef REP_PRO
    GRID_SYNC_(); prologue(p, lds, G);
#endif
#ifdef NANFILL
    { u32x4* q = (u32x4*)(ws + WS_S5H); const size_t n16 = (WS_END - WS_S5H) / 16; const u32x4 nanv = (u32x4){0xffffffffu, 0xffffffffu, 0xffffffffu, 0xffffffffu};
      for (size_t i = (size_t)bid * 512 + threadIdx.x; i < n16; i += (size_t)G * 512) q[i] = nanv;
      u32x4* q2 = (u32x4*)(ws + WS_LSE); const size_t m16 = (WS_S5K - WS_LSE) / 16;
      for (size_t i = (size_t)bid * 512 + threadIdx.x; i < m16; i += (size_t)G * 512) q2[i] = nanv; }
#endif
    if (gridDim.y == 0x7fffffffu) GRID_SYNC_();
    GRID_SYNC();

#ifndef NL_RUN
#define NL_RUN NL
#endif
#ifndef DUMP_LAYER
#define DUMP_LAYER 0
#endif
    for (int lrun = 0; lrun < NL_RUN; ++lrun) {
#ifdef SAME_LAYER
        const int l = 0; const bool firstl = (lrun == 0), lastl = (lrun == NL_RUN - 1);
#else
        const int l = lrun; const bool firstl = (lrun == 0), lastl = (lrun == NL_RUN - 1);
#endif
#define RS_TABLE(SSQ_, NUNITS_) \
          { pg8::Unit ua_, ub_; (void)S.next(0, ua_); (void)S.next((NUNITS_) - 1, ub_); \
              int tq_ = threadIdx.x; asm volatile("" : "+v"(tq_)); const int pm_ = (tq_ >> 8) ? ub_.pm : ua_.pm; \
              const f32x4* sq_ = (const f32x4*)((SSQ_) + ((size_t)pm_ * 256 + (tq_ & 255)) * 16); const f32x4 q0 = sq_[0], q1 = sq_[1], q2 = sq_[2], q3 = sq_[3]; \
              const float tot_ = (((q0[0] + q0[1]) + (q0[2] + q0[3])) + ((q1[0] + q1[1]) + (q1[2] + q1[3]))) + (((q2[0] + q2[1]) + (q2[2] + q2[3])) + ((q3[0] + q3[1]) + (q3[2] + q3[3]))); \
              ((LAS float*)(lds + 131072))[tq_] = rsqrtf(tot_ * (1.0f / 1024.0f) + EPS); __syncthreads(); }
        { pg8::Gemm g{XB, (const bf16_t*)(ws + WS_WIN) + (size_t)l * D * DIN, T, DIN, D, D}; pg8::StaticOrder S; S.init(T, DIN, G, bid);
          RS_TABLE(SSQP, (T / 256) * (DIN / 256) / 256)
          pg8::EpiScale E{Zb, DIN, 0, (const PG8_LAS float*)(lds + 131072)};
          pg8::gemm_phase<pg8::EpiScale, pg8::StaticOrder, true, true>(lds, g, S, E);
#ifdef REPEAT_GEMM
          GRID_SYNC(); pg8::gemm_phase<pg8::EpiScale, pg8::StaticOrder, true, true>(lds, g, S, E);
#endif
        }
        GRID_SYNC();
#ifndef SKIP_MIX
        if (!(MIX_A && MIX_B && MIX_C && MIX_D)) { int tq = threadIdx.x; asm volatile("" : "+v"(tq));
          for (int m = bid * 8 + (tq >> 6); m < T; m += G * 8) { u32x2* yp = (u32x2*)(YC_ + (size_t)m * D) + (tq & 63); const u32x2 z2 = (u32x2){0u, 0u};
              if (!MIX_A) yp[0] = z2; if (!MIX_B) yp[64] = z2; if (!MIX_C) yp[128] = z2; if (!MIX_D) yp[192] = z2; } }
#ifndef MIX_REPEAT
#define MIX_REPEAT 1
#endif
        for (int rep = 0; rep < MIX_REPEAT; ++rep) {
        for (int it = bid; it < 1664; it += G) {
            if (it < 512) { if (MIX_A) { hgrn_item<false>(p, lds, l, it); if (REP_A) hgrn_item<false>(p, lds, l, it); } }
            else if (it < 1024) { if (MIX_B) { conv_item(p, lds, l, it - 512); if (REP_B) conv_item(p, lds, l, it - 512); } }
            else if (it < 1152) { if (MIX_C) { s5_local_item(p, lds, l, it - 1024); if (REP_C) s5_local_item(p, lds, l, it - 1024); } }
            else { if (MIX_D) { attn_item(p, lds, l, 0, it - 1152); if (REP_D) attn_item(p, lds, l, 0, it - 1152); } }
        }
        GRID_SYNC();
        if (bid < 128) { if (MIX_A) hgrn_scan_item(p, bid); } else if (bid < 136) { if (MIX_C) s5_scan_item(p, l, bid - 128); }
        if (bid < 136) { if (MIX_D) { attn_item(p, lds, l, 1, 376 + bid); if (REP_D) attn_item(p, lds, l, 1, 376 + bid); } }
        else for (int it = bid - 136; it < 376; it += 120) { if (MIX_D) { attn_item(p, lds, l, 1, it); if (REP_D) attn_item(p, lds, l, 1, it); } }
        GRID_SYNC();
#ifdef REP_P3
        if (bid < 128) { if (MIX_A) hgrn_scan_item(p, bid); } else if (bid < 136) { if (MIX_C) s5_scan_item(p, l, bid - 128); }
        if (bid < 136) { if (MIX_D) { attn_item(p, lds, l, 1, 376 + bid); if (REP_D) attn_item(p, lds, l, 1, 376 + bid); } }
        else for (int it = bid - 136; it < 376; it += 120) { if (MIX_D) { attn_item(p, lds, l, 1, it); if (REP_D) attn_item(p, lds, l, 1, it); } }
        GRID_SYNC();
#endif
        for (int it = bid; it < 1536; it += G) {
            if (it < 512) { if (MIX_A) { hgrn_item<true>(p, lds, l, it); if (REP_A) hgrn_item<true>(p, lds, l, it); } }
            else if (it < 1024) { if (MIX_C) { s5_out_item(p, lds, l, it - 512); if (REP_C) s5_out_item(p, lds, l, it - 512); } }
            else { if (MIX_D) { attn_item(p, lds, l, 2, it - 1024); if (REP_D) attn_item(p, lds, l, 2, it - 1024); } }
        }
        GRID_SYNC();
        }
#ifndef NO_GLU
        { pg8::Gemm g{(const bf16_t*)(ws + WS_YPRE), (const bf16_t*)(ws + WS_WGLU) + (size_t)l * 65536, T, 256, 256, 256}; pg8::StaticOrder S; S.init(T, 256, G, bid);
          pg8::EpiGlu E{(const bf16_t*)(ws + WS_YPRE), 256, YC_ + YC};
          pg8::gemm_phase<pg8::EpiGlu, pg8::StaticOrder, false, true>(lds, g, S, E); }
#endif
        { int tq = threadIdx.x; asm volatile("" : "+v"(tq)); const int lane = tq & 63; const int gw = (bid - 128) * 8 + (tq >> 6), NGW = 128 * 8;
          if (bid >= 128) for (int m = gw; m < T; m += NGW) { u32x2* yp = (u32x2*)(YC_ + (size_t)m * D + YD) + lane; const u32x2 w = *((const u32x2*)(Zb + (size_t)m * DIN + ZOD) + lane);
              const float a0 = bflo(w.x), a1 = bfhi(w.x), a2 = bflo(w.y), a3 = bfhi(w.y);
              const float ss = wave_sum((a0 * a0 + a1 * a1) + (a2 * a2 + a3 * a3)); const float rs = rsqrtf(ss * (1.0f / 256.0f) + EPS);
              u32x2 o; o.x = pk2(a0 * rs, a1 * rs); o.y = pk2(a2 * rs, a3 * rs); *yp = o; } }
        GRID_SYNC();
#endif
#ifdef REP_P5
#ifndef NO_GLU
        { pg8::Gemm g{(const bf16_t*)(ws + WS_YPRE), (const bf16_t*)(ws + WS_WGLU) + (size_t)l * 65536, T, 256, 256, 256}; pg8::StaticOrder S; S.init(T, 256, G, bid);
          pg8::EpiGlu E{(const bf16_t*)(ws + WS_YPRE), 256, YC_ + YC};
          pg8::gemm_phase<pg8::EpiGlu, pg8::StaticOrder, false, true>(lds, g, S, E); }
#endif
        { int tq = threadIdx.x; asm volatile("" : "+v"(tq)); const int lane = tq & 63; const int gw = (bid - 128) * 8 + (tq >> 6), NGW = 128 * 8;
          if (bid >= 128) for (int m = gw; m < T; m += NGW) { u32x2* yp = (u32x2*)(YC_ + (size_t)m * D + YD) + lane; const u32x2 w = *((const u32x2*)(Zb + (size_t)m * DIN + ZOD) + lane);
              const float a0 = bflo(w.x), a1 = bfhi(w.x), a2 = bflo(w.y), a3 = bfhi(w.y);
              const float ss = wave_sum((a0 * a0 + a1 * a1) + (a2 * a2 + a3 * a3)); const float rs = rsqrtf(ss * (1.0f / 256.0f) + EPS);
              u32x2 o; o.x = pk2(a0 * rs, a1 * rs); o.y = pk2(a2 * rs, a3 * rs); *yp = o; } }
        GRID_SYNC();
#endif
#ifdef DUMP_SLICE
        if (lrun == DUMP_LAYER) { int tq = threadIdx.x; asm volatile("" : "+v"(tq));
          for (int m = bid * 8 + (tq >> 6); m < T; m += G * 8) { const int ln = tq & 63;
              for (int j = 0; j < 4; ++j) { const int col = j * 256 + ln * 4; const u32x2 w = *(const u32x2*)(YC_ + (size_t)m * D + col);
                  f32x4 o = (f32x4){0.f, 0.f, 0.f, 0.f}; if (j == DUMP_SLICE) o = (f32x4){bflo(w.x), bfhi(w.x), bflo(w.y), bfhi(w.y)};
                  *(f32x4*)(p.out + (size_t)m * D + col) = o; } }
          break; }
#endif
#ifdef SKIP_MIX
        { pg8::Gemm g{Zb, (const bf16_t*)(ws + WS_WOUT) + (size_t)l * D * D, T, D, D, DIN}; pg8::StaticOrder S; S.init(T, D, G, bid);
#else
        { pg8::Gemm g{YC_, (const bf16_t*)(ws + WS_WOUT) + (size_t)l * D * D, T, D, D, D}; pg8::StaticOrder S; S.init(T, D, G, bid);
#endif
          pg8::EpiRes E{firstl ? p.in[I_X] : p.out, p.out, XB, SSQP + (size_t)T * 16};
          pg8::gemm_phase<pg8::EpiRes, pg8::StaticOrder, true, true>(lds, g, S, E); }
        GRID_SYNC();
        { pg8::Gemm g{XB, (const bf16_t*)(ws + WS_WUP) + (size_t)l * D * FF, T, FF, D, D}; pg8::StaticOrder S; S.init(T, FF, G, bid);
          RS_TABLE(SSQP + (size_t)T * 16, (T / 256) * (FF / 256) / 256)
          pg8::EpiScale E{HM, FF, 1, (const PG8_LAS float*)(lds + 131072)};
          pg8::gemm_phase<pg8::EpiScale, pg8::StaticOrder, true, true>(lds, g, S, E);
#ifdef REPEAT_GEMM
          GRID_SYNC(); pg8::gemm_phase<pg8::EpiScale, pg8::StaticOrder, true, true>(lds, g, S, E);
#endif
        }
        GRID_SYNC();
        { pg8::Gemm g{HM, (const bf16_t*)(ws + WS_WDN) + (size_t)l * D * FF, T, D, FF, FF}; pg8::StaticOrder S; S.init(T, D, G, bid);
          pg8::EpiRes E{p.out, p.out, XB, !lastl ? SSQP : nullptr};
          pg8::gemm_phase<pg8::EpiRes, pg8::StaticOrder, true, true>(lds, g, S, E); }
        if (!lastl) GRID_SYNC();
    }
}

extern "C" void kernel_launch(void* const* d_in, const int* in_sizes, int n_in, void* d_out, int out_size, void* d_ws, size_t ws_size, hipStream_t stream) {
    static int grid = 0;
    if (grid == 0) {
        if (n_in != 26 || out_size != T * D || ws_size < WS_END) { fprintf(stderr, "kernel_launch: unexpected shapes (n_in %d, out %d, ws %zu); nothing launched\n", n_in, out_size, ws_size); grid = -1; return; }
        int dev = 0, cus = 0, per_cu = 0;
        (void)hipGetDevice(&dev); (void)hipDeviceGetAttribute(&cus, hipDeviceAttributeMultiprocessorCount, dev);
        if (hipFuncSetAttribute((const void*)hybrid_fwd, hipFuncAttributeMaxDynamicSharedMemorySize, LDS_BYTES) != hipSuccess) { fprintf(stderr, "kernel_launch: hipFuncSetAttribute failed\n"); grid = -1; return; }
        if (hipOccupancyMaxActiveBlocksPerMultiprocessor(&per_cu, (const void*)hybrid_fwd, 512, LDS_BYTES) != hipSuccess || per_cu < 1) { fprintf(stderr, "kernel_launch: occupancy query gave %d\n", per_cu); per_cu = 1; }
        (void)hipGetLastError();
        if (cus <= 0) cus = 256;
        grid = cus * per_cu;
    }
    if (grid < 0) return;
    if (hipMemsetAsync((char*)d_ws + WS_BAR, 0, XCD_BAR_WORDS * 4, stream) != hipSuccess) { fprintf(stderr, "kernel_launch: hipMemsetAsync of the barrier words failed\n"); return; }
    static int rs_ok = -1;
    if (rs_ok < 0) { rs_ok = (grid == 256) ? 1 : 0;
        const int ncol[2] = {DIN / 256, FF / 256};
        for (int ph = 0; ph < 2 && rs_ok; ++ph) { const int nun = (T / 256) * ncol[ph] / 256;
            for (int c = 0; c < grid && rs_ok; ++c) { pg8::StaticOrder S; S.init(T, ncol[ph] * 256, grid, c); pg8::Unit u0, u1, ui; if (!S.next(0, u0) || !S.next(nun - 1, u1) || S.next(nun, ui)) { rs_ok = 0; break; }
                if (((u0.pm >> 3) & 1) != 0 || ((u1.pm >> 3) & 1) != 1) { rs_ok = 0; break; }
                for (int i = 0; i < nun; ++i) { S.next(i, ui); if (ui.pm != (((ui.pm >> 3) & 1) ? u1.pm : u0.pm)) { rs_ok = 0; break; } } } } }
    Params a{};
    for (int i = 0; i < 26; ++i) a.in[i] = (const float*)d_in[i];
    if (!rs_ok) { fprintf(stderr, "kernel_launch: unit order does not keep a workgroup inside two row panels (grid %d); nothing launched\n", grid); return; }
    a.out = (float*)d_out; a.ws = (unsigned char*)d_ws; a.rs_lds = rs_ok; a.pad = 0;
    void* args[] = {&a};
    hipError_t e = hipLaunchCooperativeKernel((const void*)hybrid_fwd, dim3(grid), dim3(512), args, LDS_BYTES, stream);
    if (e != hipSuccess) fprintf(stderr, "cooperative launch failed: %s (grid %d)\n", hipGetErrorString(e), grid);
}
```

```cpp
#include <hip/hip_runtime.h>
#include <hip/hip_cooperative_groups.h>
#include <cstdio>
#include <cstdint>
namespace cg = cooperative_groups;

#define DI __device__ __forceinline__
#define LAS __attribute__((address_space(3)))
typedef unsigned short bf16_t;
typedef short bf16x8 __attribute__((ext_vector_type(8)));
typedef short s16x4 __attribute__((ext_vector_type(4)));
typedef float f32x4 __attribute__((ext_vector_type(4)));
typedef float f32x16 __attribute__((ext_vector_type(16)));
typedef unsigned u32x4 __attribute__((ext_vector_type(4)));
typedef unsigned u32x2 __attribute__((ext_vector_type(2)));

constexpr int NB = 4, SEQ = 8192, T = NB * SEQ, D = 1024, DIN = 2560, FF = 4096, NL = 4;
constexpr int ZQ = 0, ZF = 256, ZI = 512, ZG = 768, ZBV = 1024, ZBG = 1280, ZCU = 1536, ZDQ = 1792, ZDK = 2048, ZDV = 2304;
constexpr int YA = 0, YB = 256, YC = 512, YD = 768;
constexpr int ZOD = ZBG;
constexpr float EPS = 1e-6f;
constexpr size_t MiB = 1u << 20;
constexpr size_t WS_WIN = 0, WS_WOUT = 20 * MiB, WS_WUP = 28 * MiB, WS_WDN = 60 * MiB, WS_WGLU = 92 * MiB;
constexpr size_t WS_LB = 93 * MiB;
constexpr size_t WS_BIAS = WS_LB + 4096;
constexpr size_t WS_BAR = WS_LB + 32768;
constexpr size_t WS_SSQ = WS_LB + 65536;
constexpr size_t WS_LSE = WS_SSQ + 8 * (size_t)T * 4;
constexpr size_t WS_DEC = WS_LSE + (size_t)T * 16;
constexpr size_t WS_LSE1 = WS_DEC + 2048 * 64 * 4;
constexpr size_t WS_S5K = 96 * MiB;
constexpr size_t WS_S5WS = 98 * MiB;
constexpr size_t WS_S5WC = 114 * MiB;
constexpr size_t WS_XB = 130 * MiB;
constexpr size_t WS_S5H = 194 * MiB;
constexpr size_t WS_HM = 198 * MiB;
constexpr size_t WS_Z = 198 * MiB;
constexpr size_t WS_YCAT = 358 * MiB;
constexpr size_t WS_SL = 422 * MiB, WS_SL2 = 438 * MiB;
constexpr size_t WS_S5H2 = 454 * MiB;
constexpr size_t WS_O0 = 458 * MiB, WS_O1 = 474 * MiB;
constexpr size_t WS_YPRE = 490 * MiB;
constexpr size_t WS_SSQP = 506 * MiB;
constexpr size_t WS_END = 510 * MiB;
static_assert(WS_LSE1 + (size_t)T * 16 <= WS_S5K, "misc region");

constexpr int LDS_BYTES = 147456;

typedef float f32x2_t __attribute__((ext_vector_type(2))); typedef __bf16 bf16x2_t __attribute__((ext_vector_type(2)));
DI unsigned f2bf(float f) { const f32x2_t v = {f, 0.f}; const bf16x2_t b = __builtin_convertvector(v, bf16x2_t); return __builtin_bit_cast(unsigned, b) & 0xffffu; }
DI unsigned pk2(float lo, float hi) { const f32x2_t v = {lo, hi}; const bf16x2_t b = __builtin_convertvector(v, bf16x2_t); return __builtin_bit_cast(unsigned, b); }
DI float bf2f(bf16_t v) { return __builtin_bit_cast(float, (unsigned)v << 16); }
DI float bflo(unsigned w) { return __builtin_bit_cast(float, w << 16); }
DI float bfhi(unsigned w) { return __builtin_bit_cast(float, w & 0xffff0000u); }
DI float sigmoidf_(float x) { return __builtin_amdgcn_rcpf(1.f + __expf(-x)); }
template <int CTRL> DI float dpp_(float v) { return __builtin_bit_cast(float, __builtin_amdgcn_update_dpp(0, __builtin_bit_cast(int, v), CTRL, 0xF, 0xF, false)); }
DI float sum8_(float v) { v += dpp_<0xB1>(v); v += dpp_<0x4E>(v); v += dpp_<0x141>(v); return v; }
DI float sum16_(float v) { v = sum8_(v); v += dpp_<0x140>(v); return v; }
DI float half_sum(float v) { v = sum16_(v); v += __shfl_xor(v, 16); return v; }
DI float wave_sum(float v) { v = half_sum(v); v += __shfl_xor(v, 32); return v; }
#define LDS_WAIT() asm volatile("s_waitcnt lgkmcnt(0)" ::: "memory")
DI int crow(int reg, int h) { return (reg & 3) + 8 * (reg >> 2) + 4 * h; }

template <int K>
DI f32x16 mma_lds(const LAS bf16_t* A, int lda, const LAS bf16_t* B, int ldb, f32x16 acc, int lane) {
    const int r = lane & 31, h = lane >> 5;
    const LAS bf16_t* ap = A + r * lda + 8 * h; const LAS bf16_t* bp = B + r * ldb + 8 * h;
#pragma unroll
    for (int k0 = 0; k0 < K; k0 += 16) {
        const bf16x8 a = *(const LAS bf16x8*)(ap + k0); const bf16x8 b = *(const LAS bf16x8*)(bp + k0);
        acc = __builtin_amdgcn_mfma_f32_32x32x16_bf16(a, b, acc, 0, 0, 0);
    }
    return acc;
}
DI f32x16 zero16() { f32x16 z;
#pragma unroll
    for (int i = 0; i < 16; ++i) z[i] = 0.f;
    return z; }

namespace pg8 {
#define PG8_LAS __attribute__((address_space(3)))
constexpr int BM = 256, BK = 64, HALF = 128, HTB = HALF * BK * 2, STAGE_BYTES = 8 * HTB, NXCD = 8, WGM = 8;
__host__ __device__ __forceinline__ int lds_byte(int r, int c) { const int st = (r >> 4) * 2 + (c >> 5), rr = r & 15, cc = c & 31, ob = rr * 64 + cc * 2; return st * 1024 + (ob ^ (((ob >> 9) & 1) << 5)); }
__host__ __device__ __forceinline__ void stage_rc(int b, int& R, int& C) { const int st = b / 1024, sb = b % 1024, swz = sb ^ (((sb >> 9) & 1) << 5); R = (st >> 1) * 16 + swz / 64; C = (st & 1) * 32 + (swz % 64) / 2; }
__host__ __device__ __forceinline__ int perm32(int rho) { const int n = rho >> 4, i = rho & 15; return 8 * (i >> 2) + 4 * n + (i & 3); }
struct Unit { int pm, pn; };
struct Gemm { const bf16_t* A; const bf16_t* Bt; int M, N, K, lda; };
struct StaticOrder {
    int nM, nN, nwg, G, c;
    __host__ __device__ __forceinline__ void init(int M, int N, int G_, int c_) { nM = M / BM; nN = N / BM; nwg = nM * nN; G = G_; c = c_; }
    __host__ __device__ __forceinline__ bool next(int i, Unit& u) const {
        const long L = (long)i * G + c; if (L >= nwg) return false;
        int wgid = (int)L; { const int q = nwg / NXCD, r = nwg % NXCD, xcd = wgid % NXCD, off = wgid / NXCD; wgid = (xcd < r ? xcd * (q + 1) : r * (q + 1) + (xcd - r) * q) + off; }
        const int nig = WGM * nN, gid = wgid / nig, fm = gid * WGM, gsz = (nM - fm) < WGM ? (nM - fm) : WGM;
        u.pm = fm + ((wgid % nig) % gsz); u.pn = (wgid % nig) / gsz; return true;
    }
    __device__ __forceinline__ void a_ready(const Unit&) const {}
    __device__ __forceinline__ void done(const Unit&) const {}
};
struct EpiScale {
    static constexpr bool PERM = true, AFTER_DRAIN = false;
    bf16_t* O; int ldc; int act; const PG8_LAS float* rsl;
    __device__ __forceinline__ void operator()(const f32x4 (&acc)[2][2][4][2], const Unit& u, int wr, int wc, int fr, int fq) const {
        const int row0 = u.pm * BM + wr * 64 + fr; const int col0 = u.pn * BM + wc * 32 + 8 * fq;
        const int slot = ((u.pm >> 3) & 1) * 256;
#pragma unroll
        for (int ai = 0; ai < 2; ++ai)
#pragma unroll
            for (int m = 0; m < 4; ++m) { const int r = row0 + ai * HALF + m * 16; float rs;
                rs = rsl[slot + ai * HALF + wr * 64 + m * 16 + fr];
                bf16_t* rowp = O + (size_t)r * ldc + col0;
#pragma unroll
                for (int bj = 0; bj < 2; ++bj) { f32x4 v0 = acc[ai][bj][m][0] * rs, v1 = acc[ai][bj][m][1] * rs;
                    if (act) {
#pragma unroll
                        for (int e = 0; e < 4; ++e) { const float a = fmaxf(v0[e], 0.f), b = fmaxf(v1[e], 0.f); v0[e] = a * a; v1[e] = b * b; } }
                    u32x4 w; w.x = pk2(v0[0], v0[1]); w.y = pk2(v0[2], v0[3]); w.z = pk2(v1[0], v1[1]); w.w = pk2(v1[2], v1[3]);
                    *(u32x4*)(rowp + bj * HALF) = w; } }
    }
};
struct EpiRes {
    static constexpr bool PERM = false, AFTER_DRAIN = false;
    const float* base; float* out; bf16_t* xb; float* ssq_out;
    __device__ __forceinline__ void operator()(const f32x4 (&acc)[2][2][4][2], const Unit& u, int wr, int wc, int fr, int fq) const {
        const int col0 = u.pn * BM + wc * 32 + 4 * fq;
#pragma unroll
        for (int ai = 0; ai < 2; ++ai) {
            f32x4 bv[4][2][2];
#pragma unroll
            for (int m = 0; m < 4; ++m) { const size_t off = (size_t)(u.pm * BM + ai * HALF + wr * 64 + m * 16 + fr) * D + col0;
#pragma unroll
                for (int bj = 0; bj < 2; ++bj)
#pragma unroll
                    for (int n = 0; n < 2; ++n) bv[m][bj][n] = *(const f32x4*)(base + off + bj * HALF + n * 16); }
#pragma unroll
            for (int m = 0; m < 4; ++m) { const int r = u.pm * BM + ai * HALF + wr * 64 + m * 16 + fr; const size_t off = (size_t)r * D + col0; float s = 0.f;
#pragma unroll
                for (int bj = 0; bj < 2; ++bj)
#pragma unroll
                    for (int n = 0; n < 2; ++n) { const size_t o2 = off + bj * HALF + n * 16; const f32x4 o = bv[m][bj][n] + acc[ai][bj][m][n];
                        *(f32x4*)(out + o2) = o; u32x2 w; w.x = pk2(o[0], o[1]); w.y = pk2(o[2], o[3]); *(u32x2*)(xb + o2) = w;
                        s += (o[0] * o[0] + o[1] * o[1]) + (o[2] * o[2] + o[3] * o[3]); }
                s += __shfl_xor(s, 16); s += __shfl_xor(s, 32);
                if (fq == 0 && ssq_out) ssq_out[(size_t)r * 16 + u.pn * 4 + wc] = s; } }
    }
};
struct EpiGlu {
    static constexpr bool PERM = false, AFTER_DRAIN = true;
    const bf16_t* Ysrc; int lds_; bf16_t* Y;
    __device__ __forceinline__ void fused(f32x4 (&acc)[2][2][4][2], const Unit& u, int wr, int wc, int fr, int fq, PG8_LAS unsigned char* lds, int wid, int lane) const {
        PG8_LAS float* Pp = (PG8_LAS float*)lds;
        const int col0 = wc * 32 + 4 * fq;
#pragma unroll
        for (int ai = 0; ai < 2; ++ai)
#pragma unroll
            for (int m = 0; m < 4; ++m) { const int rl = ai * HALF + wr * 64 + m * 16 + fr; const size_t off = (size_t)(u.pm * BM + rl) * lds_ + col0; float s = 0.f;
#pragma unroll
                for (int bj = 0; bj < 2; ++bj)
#pragma unroll
                    for (int n = 0; n < 2; ++n) { const u32x2 w = *(const u32x2*)(Ysrc + off + bj * HALF + n * 16); f32x4 a = acc[ai][bj][m][n];
                        const float y0 = bflo(w.x), y1 = bfhi(w.x), y2 = bflo(w.y), y3 = bfhi(w.y);
                        a[0] = y0 * sigmoidf_(a[0]); a[1] = y1 * sigmoidf_(a[1]); a[2] = y2 * sigmoidf_(a[2]); a[3] = y3 * sigmoidf_(a[3]);
                        acc[ai][bj][m][n] = a; s += (a[0] * a[0] + a[1] * a[1]) + (a[2] * a[2] + a[3] * a[3]); }
                s += __shfl_xor(s, 16); s += __shfl_xor(s, 32);
                if (fq == 0) Pp[rl * 4 + wc] = s; }
        __syncthreads();
#pragma unroll
        for (int ai = 0; ai < 2; ++ai)
#pragma unroll
            for (int m = 0; m < 4; ++m) { const int rl = ai * HALF + wr * 64 + m * 16 + fr; const size_t off = (size_t)(u.pm * BM + rl) * D + col0;
                const float tot = (Pp[rl * 4 + 0] + Pp[rl * 4 + 1]) + (Pp[rl * 4 + 2] + Pp[rl * 4 + 3]); const float rs = rsqrtf(tot * (1.0f / 256.0f) + EPS);
#pragma unroll
                for (int bj = 0; bj < 2; ++bj)
#pragma unroll
                    for (int n = 0; n < 2; ++n) { const f32x4 a = acc[ai][bj][m][n] * rs; u32x2 w; w.x = pk2(a[0], a[1]); w.y = pk2(a[2], a[3]); *(u32x2*)(Y + off + bj * HALF + n * 16) = w; } }
    }
};

template <class Epi, class Sched, bool ALIGN_EPI = false, bool SP2 = false>
__device__ __forceinline__ void gemm_phase(PG8_LAS unsigned char* lds, const Gemm g, const Sched& S, const Epi& E) {
    int tid_o = threadIdx.x; asm volatile("" : "+v"(tid_o));
    const int tid = tid_o, wid = __builtin_amdgcn_readfirstlane(tid >> 6), lane = tid & 63, wr = wid >> 2, wc = wid & 3, fr = lane & 15, fq = lane >> 4;
    const int K = g.K, nt = K / BK;
    unsigned voffA[2], voffB[2];
#pragma unroll
    for (int i = 0; i < 2; ++i) { int R, C; stage_rc(tid * 16 + i * 8192, R, C); const int Rb = Epi::PERM ? ((R & ~31) + perm32(R & 31)) : R;
        voffA[i] = (unsigned)(R * g.lda + C) * 2u; voffB[i] = (unsigned)(Rb * K + C) * 2u; }
    const size_t kstep = (size_t)(BK * 2);
    const size_t hstepA = (size_t)HALF * g.lda * 2, hstepB = (size_t)HALF * K * 2;
    const size_t tstepA = 2 * hstepA, tstepB = 2 * hstepB;
    const unsigned ldsw = (unsigned)wid * 1024u;
    const int aoff = lds_byte(wr * 64 + fr, fq * 8), boff = lds_byte(wc * 32 + fr, fq * 8);
#define PG8_SA(b, h) (((b) * 2 + (h)) * HTB)
#define PG8_SB(b, h) ((4 + (b) * 2 + (h)) * HTB)
#define PG8_STAGE(bufoff, gbase, voff) do { _Pragma("unroll") for (int _i = 0; _i < 2; ++_i) \
        __builtin_amdgcn_global_load_lds((const unsigned*)((const char*)(gbase) + (voff)[_i]), (PG8_LAS unsigned*)(lds + (bufoff) + ldsw + _i * 8192), 16, 0, 0); } while (0)
#define PG8_LDA(dst, b, h) do { _Pragma("unroll") for (int m = 0; m < 4; ++m) _Pragma("unroll") for (int k = 0; k < 2; ++k) dst[m][k] = *(const PG8_LAS bf16x8*)(lds + PG8_SA(b, h) + aoff + m * 2048 + k * 1024); } while (0)
#define PG8_LDB(dst, b, h) do { _Pragma("unroll") for (int n = 0; n < 2; ++n) _Pragma("unroll") for (int k = 0; k < 2; ++k) dst[n][k] = *(const PG8_LAS bf16x8*)(lds + PG8_SB(b, h) + boff + n * 2048 + k * 1024); } while (0)
#define PG8_MMA(ai, bj, At, Bt) do { __builtin_amdgcn_s_setprio(1); _Pragma("unroll") for (int m = 0; m < 4; ++m) _Pragma("unroll") for (int n = 0; n < 2; ++n) _Pragma("unroll") for (int k = 0; k < 2; ++k) \
        acc[ai][bj][m][n] = __builtin_amdgcn_mfma_f32_16x16x32_bf16(Bt[n][k], At[m][k], acc[ai][bj][m][n], 0, 0, 0); __builtin_amdgcn_s_setprio(0); } while (0)
#define PG8_WAIT_V(n) asm volatile("s_waitcnt vmcnt(" #n ")" ::: "memory")
#define PG8_WAIT_L(n) asm volatile("s_waitcnt lgkmcnt(" #n ")" ::: "memory")
#define PG8_BAR __builtin_amdgcn_s_barrier()
#define PG8_SCHED __builtin_amdgcn_sched_barrier(0)
    Unit cur, nxt; int ui = 0;
    if (!S.next(0, cur)) return;
    f32x4 acc[2][2][4][2];
#pragma unroll
    for (int a = 0; a < 2; ++a)
#pragma unroll
        for (int b = 0; b < 2; ++b)
#pragma unroll
            for (int m = 0; m < 4; ++m)
#pragma unroll
                for (int n = 0; n < 2; ++n) acc[a][b][m][n] = (f32x4){0.f, 0.f, 0.f, 0.f};
    bf16x8 At[4][2], B0[2][2], B1[2][2];
    const char* cA = (const char*)g.A + (size_t)cur.pm * tstepA; const char* cB = (const char*)g.Bt + (size_t)cur.pn * tstepB;
    S.a_ready(cur);
    if constexpr (SP2) {
        PG8_STAGE(PG8_SB(0, 0), cB, voffB); PG8_STAGE(PG8_SB(0, 1), cB + hstepB, voffB); PG8_STAGE(PG8_SA(0, 0), cA, voffA); PG8_STAGE(PG8_SA(0, 1), cA + hstepA, voffA);
        if (wr == 1) PG8_BAR;
        PG8_WAIT_V(2); PG8_BAR;
        PG8_STAGE(PG8_SB(1, 0), cB + kstep, voffB); PG8_STAGE(PG8_SA(1, 0), cA + kstep, voffA); PG8_STAGE(PG8_SB(1, 1), cB + hstepB + kstep, voffB);
        PG8_WAIT_V(6); PG8_BAR;
    } else {
        PG8_STAGE(PG8_SB(0, 0), cB, voffB); PG8_STAGE(PG8_SA(0, 0), cA, voffA); PG8_STAGE(PG8_SB(0, 1), cB + hstepB, voffB); PG8_STAGE(PG8_SA(0, 1), cA + hstepA, voffA);
        if (wr == 1) PG8_BAR;
        PG8_WAIT_V(4); PG8_BAR;
        PG8_STAGE(PG8_SB(1, 0), cB + kstep, voffB); PG8_STAGE(PG8_SA(1, 0), cA + kstep, voffA); PG8_STAGE(PG8_SB(1, 1), cB + hstepB + kstep, voffB);
        PG8_WAIT_V(6); PG8_BAR;
    }
    for (;;) {
        const bool has_next = S.next(ui + 1, nxt);
        const char* nA = has_next ? (const char*)g.A + (size_t)nxt.pm * tstepA : cA; const char* nB = has_next ? (const char*)g.Bt + (size_t)nxt.pn * tstepB : cB;
        for (int t = 0; t < nt; t += 2) {
            const bool last = (t == nt - 2);
            const char* a1 = cA + (size_t)(t + 1) * kstep;
            const char* a2 = last ? nA : cA + (size_t)(t + 2) * kstep; const char* b2 = last ? nB : cB + (size_t)(t + 2) * kstep;
            const char* a3 = a2 + kstep; const char* b3 = b2 + kstep;
            if (last && has_next) S.a_ready(nxt);
            if constexpr (SP2) {
            PG8_LDB(B0, 0, 0); PG8_LDB(B1, 0, 1); PG8_SCHED; PG8_LDA(At, 0, 0); PG8_STAGE(PG8_SA(1, 1), a1 + hstepA, voffA);
            PG8_WAIT_V(8); PG8_WAIT_L(0); PG8_BAR; PG8_MMA(0, 0, At, B0); PG8_MMA(0, 1, At, B1); PG8_BAR; PG8_SCHED;
            PG8_LDA(At, 0, 1); PG8_STAGE(PG8_SB(0, 0), b2, voffB); PG8_STAGE(PG8_SB(0, 1), b2 + hstepB, voffB); PG8_STAGE(PG8_SA(0, 0), a2, voffA);
            PG8_WAIT_V(8); PG8_WAIT_L(0); PG8_BAR; PG8_MMA(1, 0, At, B0); PG8_MMA(1, 1, At, B1); PG8_BAR; PG8_SCHED;
            PG8_LDB(B0, 1, 0); PG8_LDB(B1, 1, 1); PG8_SCHED; PG8_LDA(At, 1, 0); PG8_STAGE(PG8_SA(0, 1), a2 + hstepA, voffA);
            PG8_WAIT_V(8); PG8_WAIT_L(0); PG8_BAR; PG8_MMA(0, 0, At, B0); PG8_MMA(0, 1, At, B1); PG8_BAR; PG8_SCHED;
            PG8_LDA(At, 1, 1); PG8_STAGE(PG8_SB(1, 0), b3, voffB); PG8_STAGE(PG8_SB(1, 1), b3 + hstepB, voffB); PG8_STAGE(PG8_SA(1, 0), a3, voffA);
            PG8_WAIT_V(8); PG8_WAIT_L(0); PG8_BAR; PG8_MMA(1, 0, At, B0); PG8_MMA(1, 1, At, B1); PG8_BAR; PG8_SCHED;
            } else {
            PG8_LDB(B0, 0, 0); PG8_SCHED; PG8_LDA(At, 0, 0); PG8_STAGE(PG8_SA(1, 1), a1 + hstepA, voffA);
            PG8_WAIT_L(8); PG8_BAR; PG8_WAIT_L(0); PG8_MMA(0, 0, At, B0); PG8_BAR; PG8_SCHED;
            PG8_LDB(B1, 0, 1); PG8_STAGE(PG8_SB(0, 0), b2, voffB);
            PG8_BAR; PG8_WAIT_L(0); PG8_MMA(0, 1, At, B1); PG8_BAR;
            PG8_LDA(At, 0, 1); PG8_STAGE(PG8_SA(0, 0), a2, voffA);
            PG8_BAR; PG8_WAIT_L(0); PG8_MMA(1, 0, At, B0); PG8_BAR; PG8_SCHED;
            PG8_STAGE(PG8_SB(0, 1), b2 + hstepB, voffB);
            PG8_WAIT_V(6); PG8_BAR; PG8_MMA(1, 1, At, B1); PG8_BAR;
            PG8_LDB(B0, 1, 0); PG8_SCHED; PG8_LDA(At, 1, 0); PG8_STAGE(PG8_SA(0, 1), a2 + hstepA, voffA);
            PG8_WAIT_L(8); PG8_BAR; PG8_WAIT_L(0); PG8_MMA(0, 0, At, B0); PG8_BAR; PG8_SCHED;
            PG8_LDB(B1, 1, 1); PG8_STAGE(PG8_SB(1, 0), b3, voffB);
            PG8_BAR; PG8_WAIT_L(0); PG8_MMA(0, 1, At, B1); PG8_BAR;
            PG8_LDA(At, 1, 1); PG8_STAGE(PG8_SA(1, 0), a3, voffA);
            PG8_BAR; PG8_WAIT_L(0); PG8_MMA(1, 0, At, B0); PG8_BAR; PG8_SCHED;
            PG8_STAGE(PG8_SB(1, 1), b3 + hstepB, voffB);
            PG8_WAIT_V(6); PG8_BAR; PG8_MMA(1, 1, At, B1); PG8_BAR;
            }
        }
        if constexpr (ALIGN_EPI) { if (wr == 0) PG8_BAR; }
        if constexpr (!Epi::AFTER_DRAIN) { E(acc, cur, wr, wc, fr, fq); S.done(cur); }
        if (!has_next) break;
#pragma unroll
        for (int a = 0; a < 2; ++a)
#pragma unroll
            for (int b = 0; b < 2; ++b)
#pragma unroll
                for (int m = 0; m < 4; ++m)
#pragma unroll
                    for (int n = 0; n < 2; ++n) acc[a][b][m][n] = (f32x4){0.f, 0.f, 0.f, 0.f};
        cur = nxt; cA = nA; cB = nB; ++ui;
        if constexpr (ALIGN_EPI) { if (wr == 1) PG8_BAR; }
    }
    PG8_WAIT_V(0);
    if constexpr (!ALIGN_EPI) { if (wr == 0) PG8_BAR; }
    PG8_BAR;
    if constexpr (Epi::AFTER_DRAIN) { E.fused(acc, cur, wr, wc, fr, fq, lds, wid, lane); S.done(cur); }
#undef PG8_SA
#undef PG8_SB
#undef PG8_STAGE
#undef PG8_LDA
#undef PG8_LDB
#undef PG8_MMA
#undef PG8_WAIT_V
#undef PG8_WAIT_L
#undef PG8_BAR
#undef PG8_SCHED
}
}

struct Params { const float* in[26]; float* out; unsigned char* ws; int rs_lds; int pad; };
enum { I_X = 0, I_NMG, I_WIN, I_LBL, I_HNG, I_CW, I_CB, I_CLG, I_CLB, I_LRE, I_LIM, I_BRE, I_BIM, I_CRE, I_CIM, I_S5D, I_LDT, I_WGLU, I_QG, I_KG, I_RB, I_MONG, I_WOUT, I_NMLPG, I_WUP, I_WDN };

DI void p0_transpose_item(const float* W, int K, int N, bf16_t* WT, const float* gk, LAS float* scr, int item, int lane) {
    const int nblk = N / 32, kb = item / nblk, nb = item % nblk, k0 = 64 * kb, n0 = 32 * nb;
    float wv[32];
#pragma unroll
    for (int i = 0; i < 32; ++i) { const int kk = 2 * i + (lane >> 5); wv[i] = W[(size_t)(k0 + kk) * N + n0 + (lane & 31)]; }
#pragma unroll
    for (int i = 0; i < 32; ++i) { const int kk = 2 * i + (lane >> 5); const float s = gk ? gk[k0 + kk] : 1.f; scr[kk * 33 + (lane & 31)] = wv[i] * s; }
    LDS_WAIT();
    const int c = lane & 7;
#pragma unroll
    for (int j = 0; j < 4; ++j) { const int n = (lane >> 3) + 8 * j; const LAS float* s = scr + (8 * c) * 33 + n;
        u32x4 o; o.x = pk2(s[0 * 33], s[1 * 33]); o.y = pk2(s[2 * 33], s[3 * 33]); o.z = pk2(s[4 * 33], s[5 * 33]); o.w = pk2(s[6 * 33], s[7 * 33]);
        *(u32x4*)(WT + (size_t)(n0 + n) * K + k0 + 8 * c) = o; }
    LDS_WAIT();
}
DI void s5_params(const Params& p, int lg, int pp, float& lrdt, float& lidt, float& cr, float& ci) {
    const float dt = expf(p.in[I_LDT][lg]);
    const float lr = p.in[I_LRE][lg * 64 + pp], li = p.in[I_LIM][lg * 64 + pp];
    lrdt = lr * dt; lidt = li * dt;
    const float mag = expf(lrdt); const float ar = mag * cosf(lidt), ai = mag * sinf(lidt);
    const float den = lr * lr + li * li;
    cr = ((ar - 1.0f) * lr + ai * li) / den; ci = (ai * lr - (ar - 1.0f) * li) / den;
}
DI void s5_pow(float lrdt, float lidt, int n, float& er, float& ei) { const float m = expf((float)n * lrdt); const float a = (float)n * lidt; er = m * cosf(a); ei = m * sinf(a); }

DI void prologue(const Params& p, LAS unsigned char* lds, int G) {
    int tid_o = threadIdx.x; asm volatile("" : "+v"(tid_o));
    const int tid = tid_o, lane = tid & 63, wave = tid >> 6;
    const int gw = blockIdx.x * 8 + wave, NGW = G * 8;
    const int gt = blockIdx.x * 512 + tid, NGT = G * 512;
    unsigned char* ws = p.ws;
    LAS float* scr = (LAS float*)(lds + wave * 16384);
    {
        constexpr int I_IN = (D / 64) * (DIN / 32), I_OUT = (D / 64) * (D / 32), I_UP = (D / 64) * (FF / 32), I_DN = (FF / 64) * (D / 32), I_GL = (256 / 64) * (256 / 32);
        constexpr int PER_L = I_IN + I_OUT + I_UP + I_DN + I_GL;
        for (int it = gw; it < NL * PER_L; it += NGW) {
            const int l = it / PER_L; int r = it % PER_L;
            if (r < I_IN) { p0_transpose_item(p.in[I_WIN] + (size_t)l * D * DIN, D, DIN, (bf16_t*)(ws + WS_WIN) + (size_t)l * D * DIN, p.in[I_NMG] + l * D, scr, r, lane); continue; } r -= I_IN;
            if (r < I_OUT) { p0_transpose_item(p.in[I_WOUT] + (size_t)l * D * D, D, D, (bf16_t*)(ws + WS_WOUT) + (size_t)l * D * D, p.in[I_MONG] + l * D, scr, r, lane); continue; } r -= I_OUT;
            if (r < I_UP) { p0_transpose_item(p.in[I_WUP] + (size_t)l * D * FF, D, FF, (bf16_t*)(ws + WS_WUP) + (size_t)l * D * FF, p.in[I_NMLPG] + l * D, scr, r, lane); continue; } r -= I_UP;
            if (r < I_DN) { p0_transpose_item(p.in[I_WDN] + (size_t)l * D * FF, FF, D, (bf16_t*)(ws + WS_WDN) + (size_t)l * D * FF, nullptr, scr, r, lane); continue; } r -= I_DN;
            p0_transpose_item(p.in[I_WGLU] + (size_t)l * 65536, 256, 256, (bf16_t*)(ws + WS_WGLU) + (size_t)l * 65536, nullptr, scr, r, lane);
        }
    }
    {
        float* ssq0 = (float*)(ws + WS_SSQP); bf16_t* XB = (bf16_t*)(ws + WS_XB);
        for (int mb = gw * 16; mb < T; mb += NGW * 16) {
            float keep = 0.f;
#pragma unroll 4
            for (int i = 0; i < 16; ++i) { const int m = mb + i;
                const f32x4* xr = (const f32x4*)(p.in[I_X] + (size_t)m * D) + lane; f32x4 v[4]; float s = 0.f;
#pragma unroll
                for (int j = 0; j < 4; ++j) { v[j] = xr[64 * j]; s += (v[j][0] * v[j][0] + v[j][1] * v[j][1]) + (v[j][2] * v[j][2] + v[j][3] * v[j][3]); }
                s = wave_sum(s); if (lane == i) keep = s;
                u32x2* o8 = (u32x2*)(XB + (size_t)m * D) + lane;
#pragma unroll
                for (int j = 0; j < 4; ++j) { u32x2 w; w.x = pk2(v[j][0], v[j][1]); w.y = pk2(v[j][2], v[j][3]); o8[64 * j] = w; } }
#pragma unroll 1
            for (int i = 0; i < 16; ++i) { const float v = __shfl(keep, i); if (lane < 16) ssq0[(size_t)(mb + i) * 16 + lane] = lane == 0 ? v : 0.f; }
        }
    }
    {
        float* LB = (float*)(ws + WS_LB);
        for (int c = gt; c < 256; c += NGT) {
            const float a0 = p.in[I_LBL][c], a1 = p.in[I_LBL][256 + c], a2 = p.in[I_LBL][512 + c], a3 = p.in[I_LBL][768 + c];
            const float mx = fmaxf(fmaxf(a0, a1), fmaxf(a2, a3));
            const float e0 = expf(a0 - mx), e1 = expf(a1 - mx), e2 = expf(a2 - mx), e3 = expf(a3 - mx); const float inv = 1.f / (e0 + e1 + e2 + e3);
            const float s1 = e1 * inv, s2 = e2 * inv, s3 = e3 * inv; const float hi = 1.0f - 1e-6f;
            LB[c] = 0.f; LB[256 + c] = fminf(fmaxf(s1, 0.f), hi); LB[512 + c] = fminf(fmaxf(s1 + s2, 0.f), hi); LB[768 + c] = fminf(fmaxf(s1 + s2 + s3, 0.f), hi);
        }
        float* BT = (float*)(ws + WS_BIAS);
        for (int i = gt; i < 3 * 4 * 132; i += NGT) {
            const int pt = i / (4 * 132), hd = (i / 132) % 4, dl = i % 132; const int dil = pt == 0 ? 1 : (pt == 1 ? 4 : 16);
            float v = 0.f;
            if (dl <= 128) { const int dist = dl * dil; int bk;
                if (dist < 16) bk = dist; else { bk = 16 + (int)(logf((float)dist / 16.0f) / 4.852030263919617f * 16.0f); if (bk > 31) bk = 31; }
                v = p.in[I_RB][bk * 4 + hd]; }
            BT[i] = v;
        }
    }
    {
        bf16_t* KT = (bf16_t*)(ws + WS_S5K); bf16_t* WS_ = (bf16_t*)(ws + WS_S5WS); bf16_t* WC = (bf16_t*)(ws + WS_S5WC);
        LAS float* ebr = scr; LAS float* ebi = scr + 64 * 17;
        for (int it = gw; it < NL * 16 * 64; it += NGW) {
            const int lg = it >> 6, d = it & 63;
            float lrdt, lidt, cr, ci; s5_params(p, lg, lane, lrdt, lidt, cr, ci);
            float er, ei; s5_pow(lrdt, lidt, d, er, ei);
            const float fr_ = er * cr - ei * ci, fi_ = er * ci + ei * cr;
            const float* br = p.in[I_BRE] + ((size_t)lg * 64 + lane) * 16; const float* bi = p.in[I_BIM] + ((size_t)lg * 64 + lane) * 16;
#pragma unroll
            for (int c = 0; c < 16; ++c) { const float b0 = br[c], b1 = bi[c]; ebr[lane * 17 + c] = fr_ * b0 - fi_ * b1; ebi[lane * 17 + c] = fr_ * b1 + fi_ * b0; }
            LDS_WAIT();
            const int co = lane & 15, cb = (lane >> 4) * 4;
            const float* crp = p.in[I_CRE] + ((size_t)lg * 16 + co) * 64; const float* cip = p.in[I_CIM] + ((size_t)lg * 16 + co) * 64;
            float a0 = 0.f, a1 = 0.f, a2 = 0.f, a3 = 0.f;
            for (int q = 0; q < 64; ++q) { const float c0 = crp[q], c1 = cip[q];
                a0 += c0 * ebr[q * 17 + cb + 0] - c1 * ebi[q * 17 + cb + 0]; a1 += c0 * ebr[q * 17 + cb + 1] - c1 * ebi[q * 17 + cb + 1];
                a2 += c0 * ebr[q * 17 + cb + 2] - c1 * ebi[q * 17 + cb + 2]; a3 += c0 * ebr[q * 17 + cb + 3] - c1 * ebi[q * 17 + cb + 3]; }
            u32x2 w; w.x = pk2(a0, a1); w.y = pk2(a2, a3);
            *(u32x2*)(KT + ((size_t)it * 16 + co) * 16 + cb) = w;
            LDS_WAIT();
        }
        for (int it = gw; it < NL * 16 * 16; it += NGW) {
            const int lg = it >> 4, s4 = it & 15;
            float lrdt, lidt, cr, ci; s5_params(p, lg, lane, lrdt, lidt, cr, ci);
            const float* br = p.in[I_BRE] + ((size_t)lg * 64 + lane) * 16; const float* bi = p.in[I_BIM] + ((size_t)lg * 64 + lane) * 16;
            float b0[16], b1[16];
#pragma unroll
            for (int c = 0; c < 16; ++c) { b0[c] = br[c]; b1[c] = bi[c]; }
#pragma unroll 1
            for (int sq = 0; sq < 4; ++sq) { const int s = s4 * 4 + sq;
                float er, ei; s5_pow(lrdt, lidt, 63 - s, er, ei);
                const float fr_ = er * cr - ei * ci, fi_ = er * ci + ei * cr;
                float vr[16], vi[16];
#pragma unroll
                for (int c = 0; c < 16; ++c) { vr[c] = fr_ * b0[c] - fi_ * b1[c]; vi[c] = fr_ * b1[c] + fi_ * b0[c]; }
                bf16_t* o0 = WS_ + (((size_t)lg * 64 + s) * 128 + lane) * 16; bf16_t* o1 = WS_ + (((size_t)lg * 64 + s) * 128 + 64 + lane) * 16;
                u32x4 w;
                w.x = pk2(vr[0], vr[1]); w.y = pk2(vr[2], vr[3]); w.z = pk2(vr[4], vr[5]); w.w = pk2(vr[6], vr[7]); *(u32x4*)o0 = w;
                w.x = pk2(vr[8], vr[9]); w.y = pk2(vr[10], vr[11]); w.z = pk2(vr[12], vr[13]); w.w = pk2(vr[14], vr[15]); *(u32x4*)(o0 + 8) = w;
                w.x = pk2(vi[0], vi[1]); w.y = pk2(vi[2], vi[3]); w.z = pk2(vi[4], vi[5]); w.w = pk2(vi[6], vi[7]); *(u32x4*)o1 = w;
                w.x = pk2(vi[8], vi[9]); w.y = pk2(vi[10], vi[11]); w.z = pk2(vi[12], vi[13]); w.w = pk2(vi[14], vi[15]); *(u32x4*)(o1 + 8) = w; }
        }
        for (int it = gw; it < NL * 16 * 64; it += NGW) {
            const int lg = it >> 6, tl = it & 63;
            float lrdt, lidt, cr, ci; s5_params(p, lg, lane, lrdt, lidt, cr, ci);
            float er, ei; s5_pow(lrdt, lidt, tl + 1, er, ei);
#pragma unroll 4
            for (int co = 0; co < 16; ++co) { const float c0 = p.in[I_CRE][((size_t)lg * 16 + co) * 64 + lane], c1 = p.in[I_CIM][((size_t)lg * 16 + co) * 64 + lane];
                bf16_t* o = WC + (((size_t)lg * 64 + tl) * 16 + co) * 128;
                o[lane] = (bf16_t)f2bf(c0 * er - c1 * ei); o[64 + lane] = (bf16_t)f2bf(-(c0 * ei + c1 * er)); }
        }
    }
}

template <bool OUT>
DI void hgrn_item(const Params& p, LAS unsigned char* lds, int l, int cg) {
    int tid_o = threadIdx.x; asm volatile("" : "+v"(tid_o));
    const int tid = tid_o, lane = tid & 63, wave = tid >> 6, hd = wave >> 1, half = wave & 1;
    const bf16_t* Z = (const bf16_t*)(p.ws + WS_Z);
    LAS bf16_t* B0 = (LAS bf16_t*)(lds + hd * 27648); LAS bf16_t* B1 = B0 + 64 * 72; LAS bf16_t* B2 = B1 + 64 * 72;
    LAS float* GM = (LAS float*)(lds + 114688) + hd * 64; LAS float* GL = GM + 256; LAS float* SSA = (LAS float*)(lds + 114688) + 512;
    bf16_t* SL = (bf16_t*)(p.ws + WS_SL); const bf16_t* SL2 = (const bf16_t*)(p.ws + WS_SL2); float* DEC = (float*)(p.ws + WS_DEC);
    const int item = cg * 4 + hd;
#ifdef FORCE_LB0
    const float lb = 0.f, oml = 1.f;
#else
    const float lb = ((const float*)(p.ws + WS_LB))[l * 256 + hd * 64 + lane], oml = 1.f - lb;
#endif
    const int srow = tid >> 5, shd = (tid >> 3) & 3, spc = tid & 7;
    const bf16_t* zsrc = Z + (size_t)(cg * 64 + srow) * DIN + shd * 64 + spc * 8;
    const int sdst = shd * 27648 + (srow * 72 + spc * 8) * 2;
    u32x4 wsl[4], wg[4];
    if (OUT) { const bf16_t* sp = SL2 + (size_t)item * 4096 + (32 * half) * 64;
#pragma unroll
        for (int e = 0; e < 4; ++e) { wsl[e] = *(const u32x4*)(sp + (lane + 64 * e) * 8); wg[e] = *(const u32x4*)(zsrc + (size_t)(16 * e) * DIN + ZG); } }
    __syncthreads();
    { u32x4 wf[4], wi[4], wq[4];
#pragma unroll
      for (int sub = 0; sub < 4; ++sub) { wf[sub] = *(const u32x4*)(zsrc + (size_t)(16 * sub) * DIN + ZF); wi[sub] = *(const u32x4*)(zsrc + (size_t)(16 * sub) * DIN + ZI);
          if (OUT) wq[sub] = *(const u32x4*)(zsrc + (size_t)(16 * sub) * DIN + ZQ); }
#pragma unroll
      for (int sub = 0; sub < 4; ++sub) { *(LAS u32x4*)(lds + sdst + 9216 + sub * 16 * 144) = wf[sub]; *(LAS u32x4*)(lds + sdst + 18432 + sub * 16 * 144) = wi[sub];
          if (OUT) *(LAS u32x4*)(lds + sdst + sub * 16 * 144) = wq[sub]; } }
    __syncthreads();
    float g[32]; float run = 0.f;
#pragma unroll
    for (int j = 0; j < 32; ++j) { const float fz = bf2f(B1[(half * 32 + j) * 72 + lane]); const float sg = sigmoidf_(fz); const float f = lb + oml * sg;
        run += __logf(fmaxf(f, 1e-30f)); g[j] = run; }
    if (half == 0) GM[lane] = run;
    __syncthreads();
    const float gm = GM[lane];
    if (half) {
#pragma unroll
        for (int j = 0; j < 32; ++j) g[j] += gm; }
    const int c0 = lane & 31, h = lane >> 5;
    if constexpr (!OUT) {
        if (half) GL[lane] = run + gm;
        __syncthreads();
        const float gl = GL[lane];
        bf16_t kv[32], ivr[32];
#pragma unroll
        for (int j = 0; j < 32; ++j) { const int t = half * 32 + j; const float e = __expf(gl - g[j]); const float kj = oml * (1.f - sigmoidf_(bf2f(B1[t * 72 + lane])));
            kv[j] = (bf16_t)f2bf(kj * e); ivr[j] = B2[t * 72 + lane]; }
        __syncthreads();
#pragma unroll
        for (int j = 0; j < 32; ++j) { const int t = half * 32 + j; B1[lane * 72 + t] = kv[j]; B2[lane * 72 + t] = ivr[j]; }
        __syncthreads();
#pragma unroll
        for (int kt = 0; kt < 2; ++kt) { const f32x16 a = mma_lds<64>(B2 + 32 * half * 72, 72, B1 + 32 * kt * 72, 72, zero16(), lane);
#pragma unroll
            for (int i = 0; i < 16; ++i) SL[(size_t)item * 4096 + (32 * half + crow(i, h)) * 64 + 32 * kt + c0] = (bf16_t)f2bf(a[i]); }
        if (half == 0) DEC[item * 64 + lane] = __expf(gl);
    } else {
        if (half == 0) GL[lane] = __expf(gm);
        bf16_t ivr[32];
#pragma unroll
        for (int j = 0; j < 32; ++j) { const int t = half * 32 + j; const float q = bf2f(B0[t * 72 + lane]); const float kj = oml * (1.f - sigmoidf_(bf2f(B1[t * 72 + lane])));
            const float e1 = __expf(fminf(g[j] - gm, 80.f)), e2 = __expf(fminf(gm - g[j], 80.f));
            ivr[j] = B2[t * 72 + lane];
            B0[t * 72 + lane] = (bf16_t)f2bf(q * e1); B1[t * 72 + lane] = (bf16_t)f2bf(kj * e2); }
        __syncthreads();
#pragma unroll
        for (int j = 0; j < 32; ++j) B2[lane * 72 + half * 32 + j] = ivr[j];
        __syncthreads();
        f32x16 s0 = mma_lds<64>(B0 + 32 * half * 72, 72, B1, 72, zero16(), lane);
        f32x16 s1 = zero16(); if (half) s1 = mma_lds<64>(B0 + 32 * half * 72, 72, B1 + 32 * 72, 72, zero16(), lane);
        __syncthreads();
#pragma unroll
        for (int i = 0; i < 16; ++i) { const int row = 32 * half + crow(i, h);
            B1[row * 72 + c0] = (bf16_t)f2bf(c0 <= row ? s0[i] : 0.f); B1[row * 72 + 32 + c0] = (bf16_t)f2bf(32 + c0 <= row ? s1[i] : 0.f); }
        __syncthreads();
        f32x16 o0 = mma_lds<64>(B1 + 32 * half * 72, 72, B2, 72, zero16(), lane);
        f32x16 o1 = mma_lds<64>(B1 + 32 * half * 72, 72, B2 + 32 * 72, 72, zero16(), lane);
        __syncthreads();
        {
#pragma unroll
          for (int e = 0; e < 4; ++e) { const int pc = lane + 64 * e, row = pc >> 3, k0 = (pc & 7) * 8; const LAS float* eg = GL + k0;
              u32x4 o; o.x = pk2(bflo(wsl[e].x) * eg[0], bfhi(wsl[e].x) * eg[1]); o.y = pk2(bflo(wsl[e].y) * eg[2], bfhi(wsl[e].y) * eg[3]);
              o.z = pk2(bflo(wsl[e].z) * eg[4], bfhi(wsl[e].z) * eg[5]); o.w = pk2(bflo(wsl[e].w) * eg[6], bfhi(wsl[e].w) * eg[7]);
              *(LAS u32x4*)(B2 + (32 * half + row) * 72 + k0) = o;
              *(LAS u32x4*)(lds + sdst + 9216 + e * 16 * 144) = wg[e]; } }
        __syncthreads();
        o0 = mma_lds<64>(B0 + 32 * half * 72, 72, B2, 72, o0, lane);
        o1 = mma_lds<64>(B0 + 32 * half * 72, 72, B2 + 32 * 72, 72, o1, lane);
        const float* ng = p.in[I_HNG] + l * 256 + hd * 64; const float ng0 = ng[c0], ng1 = ng[32 + c0];
#pragma unroll
        for (int i = 0; i < 16; ++i) { const int row = 32 * half + crow(i, h);
            const float ss = half_sum(o0[i] * o0[i] + o1[i] * o1[i]); const float rs = rsqrtf(ss * (1.0f / 64.0f) + EPS);
            const float g0 = bf2f(B1[row * 72 + c0]), g1 = bf2f(B1[row * 72 + 32 + c0]);
            const float v0 = o0[i] * rs * ng0 * g0 * sigmoidf_(g0), v1 = o1[i] * rs * ng1 * g1 * sigmoidf_(g1);
            o0[i] = v0; o1[i] = v1; const float s2 = half_sum(v0 * v0 + v1 * v1); if (c0 == 0) SSA[hd * 64 + row] = s2; }
        __syncthreads();
        bf16_t* Y = (bf16_t*)(p.ws + WS_YCAT);
#pragma unroll
        for (int i = 0; i < 16; ++i) { const int row = 32 * half + crow(i, h); const size_t tok = (size_t)cg * 64 + row;
            const float tot = (SSA[row] + SSA[64 + row]) + (SSA[128 + row] + SSA[192 + row]); const float r2 = rsqrtf(tot * (1.0f / 256.0f) + EPS);
            Y[tok * D + YA + hd * 64 + c0] = (bf16_t)f2bf(o0[i] * r2); Y[tok * D + YA + hd * 64 + 32 + c0] = (bf16_t)f2bf(o1[i] * r2); }
    }
}
DI void hgrn_scan_item(const Params& p, int hb) {
    int tid_o = threadIdx.x; asm volatile("" : "+v"(tid_o));
    const int e = hb * 512 + tid_o, bh = e >> 12, b = bh >> 2, hd = bh & 3, vk = e & 4095, k = vk & 63;
    const bf16_t* SL = (const bf16_t*)(p.ws + WS_SL); bf16_t* SL2 = (bf16_t*)(p.ws + WS_SL2); const float* DEC = (const float*)(p.ws + WS_DEC);
    float st = 0.f;
    for (int c8 = 0; c8 < 128; c8 += 16) { float tmp[16], dc[16];
#pragma unroll
        for (int u = 0; u < 16; ++u) { const int item = (b * 128 + c8 + u) * 4 + hd; tmp[u] = bf2f(SL[(size_t)item * 4096 + vk]); dc[u] = DEC[item * 64 + k]; }
#pragma unroll
        for (int u = 0; u < 16; ++u) { const int item = (b * 128 + c8 + u) * 4 + hd; SL2[(size_t)item * 4096 + vk] = (bf16_t)f2bf(st); st = dc[u] * st + tmp[u]; } }
}

DI void conv_item(const Params& p, LAS unsigned char* lds, int l, int ti) {
    int tid_o = threadIdx.x; asm volatile("" : "+v"(tid_o));
    const int tid = tid_o, lane = tid & 63, wave = tid >> 6, c = tid & 255, hf = tid >> 8, wv = wave & 3;
    LAS float* Hs = (LAS float*)lds; LAS float* ST = (LAS float*)(lds + 98304); LAS float* ST2 = ST + 512;
    const bf16_t* Z = (const bf16_t*)(p.ws + WS_Z); bf16_t* Y = (bf16_t*)(p.ws + WS_YCAT);
    const int tok0 = ti * 64, pos0 = (ti & 127) * 64;
    const float* cw = p.in[I_CW] + (size_t)l * 31 * 256 + c; float w[31];
#pragma unroll
    for (int jj = 0; jj < 31; ++jj) w[jj] = cw[jj * 256];
    const float cb = p.in[I_CB][l * 256 + c];
    const float lng = p.in[I_CLG][l * 256 + c], lnb = p.in[I_CLB][l * 256 + c];
    __syncthreads();
    { u32x4 vw[6], gw_[6];
#pragma unroll
      for (int k = 0; k < 6; ++k) { const int pid = tid + 512 * k, row = pid >> 5, pc = pid & 31, pos = pos0 - 30 + row; const bool ok = (row < 94) && (pos >= 0);
          const size_t tok = ok ? (size_t)(tok0 - 30 + row) : (size_t)tok0; vw[k] = *(const u32x4*)(Z + tok * DIN + ZBV + pc * 8); gw_[k] = *(const u32x4*)(Z + tok * DIN + ZBG + pc * 8); }
#pragma unroll
      for (int k = 0; k < 6; ++k) { const int pid = tid + 512 * k, row = pid >> 5, pc = pid & 31, pos = pos0 - 30 + row; const bool ok = (row < 94) && (pos >= 0);
          if (row < 94) { f32x4 h0, h1;
              h0[0] = bflo(vw[k].x) * sigmoidf_(bflo(gw_[k].x)); h0[1] = bfhi(vw[k].x) * sigmoidf_(bfhi(gw_[k].x)); h0[2] = bflo(vw[k].y) * sigmoidf_(bflo(gw_[k].y)); h0[3] = bfhi(vw[k].y) * sigmoidf_(bfhi(gw_[k].y));
              h1[0] = bflo(vw[k].z) * sigmoidf_(bflo(gw_[k].z)); h1[1] = bfhi(vw[k].z) * sigmoidf_(bfhi(gw_[k].z)); h1[2] = bflo(vw[k].w) * sigmoidf_(bflo(gw_[k].w)); h1[3] = bfhi(vw[k].w) * sigmoidf_(bfhi(gw_[k].w));
              if (!ok) { h0 = (f32x4){0.f, 0.f, 0.f, 0.f}; h1 = h0; }
              *(LAS f32x4*)(Hs + row * 256 + pc * 8) = h0; *(LAS f32x4*)(Hs + row * 256 + pc * 8 + 4) = h1; } } }
    __syncthreads();
    LAS float* OT2 = (LAS float*)(lds + 98304);
    LAS float* STAT = (LAS float*)(lds + 131072); LAS float* STAT2 = STAT + 64;
    const int rtl = tid >> 4, rpart = tid & 15;
#pragma unroll 1
    for (int ps = 0; ps < 2; ++ps) { const int tb = hf * 32 + ps * 16;
        float o[16];
        { float hr[46];
#pragma unroll
          for (int r = 0; r < 46; ++r) hr[r] = Hs[(tb + r) * 256 + c];
#pragma unroll
          for (int j = 0; j < 16; ++j) { float a = cb;
#pragma unroll
            for (int jj = 0; jj < 31; ++jj) a += w[jj] * hr[j + jj];
            o[j] = a; } }
#pragma unroll
        for (int j = 0; j < 16; ++j) OT2[(hf * 16 + j) * 256 + c] = o[j];
        __syncthreads();
        { const LAS f32x4* q = (const LAS f32x4*)(OT2 + rtl * 256 + rpart * 16); float s1 = 0.f, s2 = 0.f;
#pragma unroll
          for (int e = 0; e < 4; ++e) { const f32x4 v = q[e]; s1 += (v[0] + v[1]) + (v[2] + v[3]); s2 += (v[0] * v[0] + v[1] * v[1]) + (v[2] * v[2] + v[3] * v[3]); }
          s1 = sum16_(s1); s2 = sum16_(s2);
          if (rpart == 0) { const float mu = s1 * (1.0f / 256.0f); const float var = fmaxf(s2 * (1.0f / 256.0f) - mu * mu, 0.f); STAT[rtl * 2] = mu; STAT[rtl * 2 + 1] = rsqrtf(var + EPS); } }
        __syncthreads();
#pragma unroll
        for (int j = 0; j < 16; ++j) { const float mu = STAT[(hf * 16 + j) * 2], rsd = STAT[(hf * 16 + j) * 2 + 1];
            const float y = (o[j] - mu) * rsd * lng + lnb; const float sv = y * sigmoidf_(y); o[j] = sv; OT2[(hf * 16 + j) * 256 + c] = sv; }
        __syncthreads();
        { const LAS f32x4* q = (const LAS f32x4*)(OT2 + rtl * 256 + rpart * 16); float s3 = 0.f;
#pragma unroll
          for (int e = 0; e < 4; ++e) { const f32x4 v = q[e]; s3 += (v[0] * v[0] + v[1] * v[1]) + (v[2] * v[2] + v[3] * v[3]); }
          s3 = sum16_(s3);
          if (rpart == 0) STAT2[rtl] = rsqrtf(s3 * (1.0f / 256.0f) + EPS); }
        __syncthreads();
#pragma unroll
        for (int j = 0; j < 16; ++j) Y[(size_t)(tok0 + tb + j) * D + YB + c] = (bf16_t)f2bf(o[j] * STAT2[hf * 16 + j]);
    }
}

DI bf16x8 ldg8(const bf16_t* p) { return *(const bf16x8*)p; }
DI void s5_local_item(const Params& p, LAS unsigned char* lds, int l, int bi) {
    int tid_o = threadIdx.x; asm volatile("" : "+v"(tid_o));
    const int tid = tid_o, lane = tid & 63, wave = tid >> 6;
    const int gh = bi & 1, cb = (bi >> 1) & 15, pt = bi >> 5, g = gh * 8 + wave, c0 = lane & 31, h = lane >> 5, lg = l * 16 + g;
    LAS bf16_t* UT = (LAS bf16_t*)lds;
    const bf16_t* Z = (const bf16_t*)(p.ws + WS_Z);
    const int sm = tid >> 4, spc = tid & 15;
    const bf16_t* zst = Z + (size_t)((cb * 32 + sm) * 64) * DIN + ZCU + gh * 128 + spc * 8;
    const int ust = (sm * 136 + spc * 8) * 2;
    const bf16_t* wsp = (const bf16_t*)(p.ws + WS_S5WS) + ((size_t)lg * 64 * 128 + pt * 32 + c0) * 16 + 8 * h;
    u32x4 pf[8];
#pragma unroll
    for (int e = 0; e < 8; ++e) pf[e] = *(const u32x4*)(zst + (size_t)e * DIN);
    f32x16 acc = zero16();
    __syncthreads();
    for (int b = 0; b < 8; ++b) { const int s0 = 8 * b;
#pragma unroll
        for (int e = 0; e < 8; ++e) *(LAS u32x4*)(lds + ust + e * (32 * 136 * 2)) = pf[e];
        __syncthreads();
        if (b + 1 < 8) {
#pragma unroll
            for (int e = 0; e < 8; ++e) pf[e] = *(const u32x4*)(zst + (size_t)(s0 + 8 + e) * DIN); }
        bf16x8 bf[8];
#pragma unroll
        for (int e = 0; e < 8; ++e) bf[e] = ldg8(wsp + (size_t)(s0 + e) * 2048);
#pragma unroll
        for (int e = 0; e < 8; ++e) acc = __builtin_amdgcn_mfma_f32_32x32x16_bf16(*(const LAS bf16x8*)(UT + (e * 32 + c0) * 136 + wave * 16 + 8 * h), bf[e], acc, 0, 0, 0);
        __syncthreads();
    }
    float* HL = (float*)(p.ws + WS_S5H);
#pragma unroll
    for (int i = 0; i < 16; ++i) HL[((size_t)(cb * 32 + crow(i, h)) * 16 + g) * 128 + pt * 32 + c0] = acc[i];
}
DI void s5_scan_item(const Params& p, int l, int sb) {
    int tid_o = threadIdx.x; asm volatile("" : "+v"(tid_o));
    const int e = sb * 512 + tid_o, b = e >> 10, g = (e >> 6) & 15, pp = e & 63;
    float lrdt, lidt, cr, ci; s5_params(p, l * 16 + g, pp, lrdt, lidt, cr, ci);
    float ar, ai; s5_pow(lrdt, lidt, 64, ar, ai);
    const float* HL = (const float*)(p.ws + WS_S5H); float* HO = (float*)(p.ws + WS_S5H2); float hr = 0.f, hi = 0.f;
    for (int c8 = 0; c8 < 128; c8 += 16) { float tr[16], ti[16];
#pragma unroll
        for (int u = 0; u < 16; ++u) { const size_t idx = ((size_t)(b * 128 + c8 + u) * 16 + g) * 128; tr[u] = HL[idx + pp]; ti[u] = HL[idx + 64 + pp]; }
#pragma unroll
        for (int u = 0; u < 16; ++u) { const size_t idx = ((size_t)(b * 128 + c8 + u) * 16 + g) * 128; HO[idx + pp] = hr; HO[idx + 64 + pp] = hi;
            const float nr = ar * hr - ai * hi + tr[u], ni = ar * hi + ai * hr + ti[u]; hr = nr; hi = ni; } }
}
DI void s5_out_item(const Params& p, LAS unsigned char* lds, int l, int bi) {
    int tid_o = threadIdx.x; asm volatile("" : "+v"(tid_o));
    const int tid = tid_o, lane = tid & 63, wave = tid >> 6;
    const int gh = bi & 1, cb = (bi >> 1) & 15, pr = bi >> 5, g = gh * 8 + wave, c0 = lane & 31, h = lane >> 5, lg = l * 16 + g;
    LAS bf16_t* UT = (LAS bf16_t*)lds;
    LAS bf16_t* OT = (LAS bf16_t*)(lds + 69632);
    const bf16_t* Z = (const bf16_t*)(p.ws + WS_Z);
    const bf16_t* kt = (const bf16_t*)(p.ws + WS_S5K) + (size_t)lg * 64 * 256;
    const float* ha = (const float*)(p.ws + WS_S5H2) + ((size_t)(cb * 32 + c0) * 16 + g) * 128 + 8 * h;
    const int co = c0 & 15; const float dsk = p.in[I_S5D][l * 256 + g * 16 + co];
    const int jt0 = pr, jt1 = 31 - pr, tl0 = 2 * jt0 + (c0 >> 4), tl1 = 2 * jt1 + (c0 >> 4);
    const int sm = tid >> 4, spc = tid & 15;
    const bf16_t* zst = Z + (size_t)((cb * 32 + sm) * 64) * DIN + ZCU + gh * 128 + spc * 8;
    const int ust = (sm * 136 + spc * 8) * 2;
    const int nb = (2 * jt1 + 2 + 7) >> 3;
    u32x4 pf[8];
#pragma unroll
    for (int e = 0; e < 8; ++e) pf[e] = *(const u32x4*)(zst + (size_t)e * DIN);
    f32x16 acc0 = zero16(), acc1 = zero16();
    { const bf16_t* wc0 = (const bf16_t*)(p.ws + WS_S5WC) + (((size_t)lg * 64 + tl0) * 16 + co) * 128 + 8 * h;
      const bf16_t* wc1 = (const bf16_t*)(p.ws + WS_S5WC) + (((size_t)lg * 64 + tl1) * 16 + co) * 128 + 8 * h;
      f32x4 x0[8], x1[8];
#pragma unroll
      for (int ks = 0; ks < 8; ++ks) { x0[ks] = *(const f32x4*)(ha + ks * 16); x1[ks] = *(const f32x4*)(ha + ks * 16 + 4); }
#pragma unroll
      for (int ks = 0; ks < 8; ++ks) { u32x4 w; w.x = pk2(x0[ks][0], x0[ks][1]); w.y = pk2(x0[ks][2], x0[ks][3]); w.z = pk2(x1[ks][0], x1[ks][1]); w.w = pk2(x1[ks][2], x1[ks][3]);
        const bf16x8 af = __builtin_bit_cast(bf16x8, w);
        acc0 = __builtin_amdgcn_mfma_f32_32x32x16_bf16(af, ldg8(wc0 + ks * 16), acc0, 0, 0, 0);
        acc1 = __builtin_amdgcn_mfma_f32_32x32x16_bf16(af, ldg8(wc1 + ks * 16), acc1, 0, 0, 0); } }
    __syncthreads();
    for (int b = 0; b < nb; ++b) { const int s0 = 8 * b;
#pragma unroll
        for (int e = 0; e < 8; ++e) *(LAS u32x4*)(lds + ust + e * (32 * 136 * 2)) = pf[e];
        __syncthreads();
        if (b + 1 < nb) {
#pragma unroll
            for (int e = 0; e < 8; ++e) pf[e] = *(const u32x4*)(zst + (size_t)(s0 + 8 + e) * DIN); }
        const bool use0 = s0 <= 2 * jt0 + 1;
        bf16x8 b0[8], b1[8];
#pragma unroll
        for (int e = 0; e < 8; ++e) { const int d1 = tl1 - (s0 + e); b1[e] = ldg8(kt + ((size_t)(d1 < 0 ? 0 : d1) * 16 + co) * 16 + 8 * h);
            if (use0) { const int d0 = tl0 - (s0 + e); b0[e] = ldg8(kt + ((size_t)(d0 < 0 ? 0 : d0) * 16 + co) * 16 + 8 * h); } }
#pragma unroll
        for (int e = 0; e < 8; ++e) { const bf16x8 af = *(const LAS bf16x8*)(UT + (e * 32 + c0) * 136 + wave * 16 + 8 * h);
            const int d1 = tl1 - (s0 + e); bf16x8 bb = b1[e]; if (d1 < 0) bb = (bf16x8){0, 0, 0, 0, 0, 0, 0, 0};
            acc1 = __builtin_amdgcn_mfma_f32_32x32x16_bf16(af, bb, acc1, 0, 0, 0);
            if (use0) { const int d0 = tl0 - (s0 + e); bf16x8 ba = b0[e]; if (d0 < 0) ba = (bf16x8){0, 0, 0, 0, 0, 0, 0, 0};
                acc0 = __builtin_amdgcn_mfma_f32_32x32x16_bf16(af, ba, acc0, 0, 0, 0); } }
        __syncthreads();
    }
#pragma unroll
    for (int q = 0; q < 2; ++q) { const int tl = q ? tl1 : tl0;
#pragma unroll
        for (int i = 0; i < 16; ++i) { const int m = crow(i, h); const size_t tok = (size_t)(cb * 32 + m) * 64 + tl; const float u = bf2f(Z[tok * DIN + ZCU + g * 16 + co]);
            const float y = (q ? acc1[i] : acc0[i]) + dsk * u; const float ge = y * sigmoidf_(1.5957691216057308f * (y + 0.044715f * y * y * y));
            OT[(q * 64 + m * 2 + (c0 >> 4)) * 136 + wave * 16 + co] = (bf16_t)f2bf(ge); } }
    __syncthreads();
    { const int tau = tid >> 2, qq = tau >> 6, m = (tau >> 1) & 31, t2 = tau & 1, qt = tid & 3; const int jt = qq ? jt1 : jt0;
      const size_t tok = (size_t)(cb * 32 + m) * 64 + 2 * jt + t2;
      const LAS u32x4* src = (const LAS u32x4*)(OT + tau * 136 + qt * 32); u32x4* dst = (u32x4*)((bf16_t*)(p.ws + WS_YPRE) + tok * 256 + gh * 128 + qt * 32);
#pragma unroll
      for (int e = 0; e < 4; ++e) dst[e] = src[e]; }
}

DI void attn_item(const Params& p, LAS unsigned char* lds, int l, int pt, int id) {
    int tid_o = threadIdx.x; asm volatile("" : "+v"(tid_o));
    const int tid = tid_o, lane = tid & 63, wave = tid >> 6;
    const int dil = pt == 0 ? 1 : (pt == 1 ? 4 : 16), nblk = 32 / dil;
    const int b = id >> 7, hd = (id >> 5) & 3, rn = id & 31, r = rn / nblk, n = rn % nblk;
    LAS bf16_t* Ks = (LAS bf16_t*)lds;
    LAS bf16_t* Vt = (LAS bf16_t*)(lds + 55296);
    LAS float* BT = (LAS float*)(lds + 55296 + 50176);
    const bf16_t* Z = (const bf16_t*)(p.ws + WS_Z);
    const bf16_t* OP = (const bf16_t*)(p.ws + (pt == 1 ? WS_O0 : WS_O1)); const float* LP = (const float*)(p.ws + (pt == 1 ? WS_LSE : WS_LSE1));
    bf16_t* ON = pt == 2 ? (bf16_t*)(p.ws + WS_Z) + ZOD : (bf16_t*)(p.ws + (pt == 0 ? WS_O0 : WS_O1)); const int onp = pt == 2 ? DIN : 256;
    float* LN = (float*)(p.ws + (pt == 0 ? WS_LSE : WS_LSE1));
    const size_t tokb = (size_t)b * SEQ;
    const int c0 = lane & 31, h = lane >> 5;
    const int qi = 32 * wave + c0; const size_t tokq = tokb + (size_t)(n * 256 + qi) * dil + r;
    u32x4 qraw[4]; u32x2 oprev[2][4]; float mprev = 0.f;
#pragma unroll
    for (int ks = 0; ks < 4; ++ks) qraw[ks] = *(const u32x4*)(Z + tokq * DIN + ZDQ + hd * 64 + ks * 16 + 8 * h);
    if (pt > 0) { mprev = LP[tokq * 4 + hd];
#pragma unroll
        for (int vt = 0; vt < 2; ++vt)
#pragma unroll
            for (int g4 = 0; g4 < 4; ++g4) oprev[vt][g4] = *(const u32x2*)(OP + tokq * 256 + hd * 64 + 32 * vt + 8 * g4 + 4 * h); }
    __syncthreads();
    if (tid < 132) BT[tid] = ((const float*)(p.ws + WS_BIAS))[(pt * 4 + hd) * 132 + tid];
    { const float* kg = p.in[I_KG] + l * 64 + (tid & 7) * 8; float kgv[8];
#pragma unroll
      for (int e = 0; e < 8; ++e) kgv[e] = kg[e];
      u32x4 kwv[6], vwv[6];
#pragma unroll
      for (int it = 0; it < 6; ++it) { const int idx = tid + 512 * it, row = idx >> 3, c = idx & 7, si = n * 256 - 128 + row;
        const size_t tok = tokb + (size_t)(si < 0 ? 0 : si) * dil + r;
        kwv[it] = *(const u32x4*)(Z + tok * DIN + ZDK + hd * 64 + c * 8); vwv[it] = *(const u32x4*)(Z + tok * DIN + ZDV + hd * 64 + c * 8); }
#pragma unroll
      for (int it = 0; it < 6; ++it) { const int idx = tid + 512 * it, row = idx >> 3, c = idx & 7, si = n * 256 - 128 + row;
        u32x4 kw = kwv[it], vw = vwv[it];
        if (si < 0) { kw = (u32x4){0u, 0u, 0u, 0u}; vw = (u32x4){0u, 0u, 0u, 0u}; }
        float kf[8]; kf[0] = bflo(kw.x); kf[1] = bfhi(kw.x); kf[2] = bflo(kw.y); kf[3] = bfhi(kw.y); kf[4] = bflo(kw.z); kf[5] = bfhi(kw.z); kf[6] = bflo(kw.w); kf[7] = bfhi(kw.w);
        float ss = 0.f;
#pragma unroll
        for (int e = 0; e < 8; ++e) ss += kf[e] * kf[e];
        ss = sum8_(ss);
        const float rs = rsqrtf(ss * (1.0f / 64.0f) + EPS);
        u32x4 o; o.x = pk2(kf[0] * rs * kgv[0], kf[1] * rs * kgv[1]); o.y = pk2(kf[2] * rs * kgv[2], kf[3] * rs * kgv[3]); o.z = pk2(kf[4] * rs * kgv[4], kf[5] * rs * kgv[5]); o.w = pk2(kf[6] * rs * kgv[6], kf[7] * rs * kgv[7]);
        *(LAS u32x4*)(Ks + row * 72 + c * 8) = o;
        LAS bf16_t* vp = Vt + (c * 8) * 392 + row;
        vp[0 * 392] = (bf16_t)(vw.x & 0xffffu); vp[1 * 392] = (bf16_t)(vw.x >> 16); vp[2 * 392] = (bf16_t)(vw.y & 0xffffu); vp[3 * 392] = (bf16_t)(vw.y >> 16);
        vp[4 * 392] = (bf16_t)(vw.z & 0xffffu); vp[5 * 392] = (bf16_t)(vw.z >> 16); vp[6 * 392] = (bf16_t)(vw.w & 0xffffu); vp[7 * 392] = (bf16_t)(vw.w >> 16); } }
    __syncthreads();
    bf16x8 qf[4];
    { float qv[4][8]; float ss = 0.f;
#pragma unroll
      for (int ks = 0; ks < 4; ++ks) { const u32x4 w = qraw[ks];
        qv[ks][0] = bflo(w.x); qv[ks][1] = bfhi(w.x); qv[ks][2] = bflo(w.y); qv[ks][3] = bfhi(w.y); qv[ks][4] = bflo(w.z); qv[ks][5] = bfhi(w.z); qv[ks][6] = bflo(w.w); qv[ks][7] = bfhi(w.w);
#pragma unroll
        for (int e = 0; e < 8; ++e) ss += qv[ks][e] * qv[ks][e]; }
      ss += __shfl_xor(ss, 32);
      const float rs = rsqrtf(ss * (1.0f / 64.0f) + EPS) * 0.125f;
#pragma unroll
      for (int ks = 0; ks < 4; ++ks) { const float* qg = p.in[I_QG] + l * 64 + ks * 16 + 8 * h; const f32x4 g0 = *(const f32x4*)qg, g1 = *(const f32x4*)(qg + 4);
        u32x4 w; w.x = pk2(qv[ks][0] * rs * g0[0], qv[ks][1] * rs * g0[1]); w.y = pk2(qv[ks][2] * rs * g0[2], qv[ks][3] * rs * g0[3]);
        w.z = pk2(qv[ks][4] * rs * g1[0], qv[ks][5] * rs * g1[1]); w.w = pk2(qv[ks][6] * rs * g1[2], qv[ks][7] * rs * g1[3]);
        qf[ks] = __builtin_bit_cast(bf16x8, w); } }
    f32x16 acc[5];
#pragma unroll
    for (int c = 0; c < 5; ++c) { acc[c] = zero16(); const LAS bf16_t* kb = Ks + (32 * wave + 32 * c + c0) * 72 + 8 * h;
#pragma unroll
        for (int ks = 0; ks < 4; ++ks) acc[c] = __builtin_amdgcn_mfma_f32_32x32x16_bf16(*(const LAS bf16x8*)(kb + ks * 16), qf[ks], acc[c], 0, 0, 0); }
    float mx = -1e30f;
    { const int tq = c0 - 4 * h, kmin = 128 - n * 256; const LAS float* pb = BT + tq - 32;
#pragma unroll
      for (int c = 0; c < 5; ++c) { const int th = kmin - (32 * wave + 32 * c) - 4 * h;
#pragma unroll
        for (int i = 0; i < 16; ++i) { const int ci = (i & 3) + 8 * (i >> 2);
            bool valid = ci >= th;
            if (c == 0) valid = valid && (tq <= ci);
            if (c == 4) valid = valid && (tq >= ci);
            const float lgt = valid ? acc[c][i] + pb[160 - 32 * c - ci] : -1e30f; acc[c][i] = lgt; mx = fmaxf(mx, lgt); } } }
    mx = fmaxf(mx, __shfl_xor(mx, 32));
    float mnew = mx;
    if (pt > 0) mnew = fmaxf(mx, mprev);
    float lsum = 0.f;
#pragma unroll
    for (int c = 0; c < 5; ++c)
#pragma unroll
        for (int i = 0; i < 16; ++i) { const float pv = __expf(acc[c][i] - mnew); acc[c][i] = pv; lsum += pv; }
    lsum += __shfl_xor(lsum, 32);
    f32x16 o[2]; o[0] = zero16(); o[1] = zero16();
#pragma unroll
    for (int c = 0; c < 5; ++c)
#pragma unroll
        for (int s = 0; s < 2; ++s) { u32x4 pw; pw.x = pk2(acc[c][8 * s + 0], acc[c][8 * s + 1]); pw.y = pk2(acc[c][8 * s + 2], acc[c][8 * s + 3]); pw.z = pk2(acc[c][8 * s + 4], acc[c][8 * s + 5]); pw.w = pk2(acc[c][8 * s + 6], acc[c][8 * s + 7]);
            const bf16x8 pf = __builtin_bit_cast(bf16x8, pw);
#pragma unroll
            for (int vt = 0; vt < 2; ++vt) { const LAS bf16_t* va = Vt + (32 * vt + c0) * 392 + 32 * wave + 32 * c + 16 * s + 4 * h;
                const s16x4 lo = *(const LAS s16x4*)va, hi = *(const LAS s16x4*)(va + 8);
                const bf16x8 vf = __builtin_shufflevector(lo, hi, 0, 1, 2, 3, 4, 5, 6, 7);
                o[vt] = __builtin_amdgcn_mfma_f32_32x32x16_bf16(vf, pf, o[vt], 0, 0, 0); } }
    float sp = 0.f; if (pt > 0) sp = __expf(mprev - mnew);
    const float ltot = lsum + sp, inv = __builtin_amdgcn_rcpf(ltot);
#pragma unroll
    for (int vt = 0; vt < 2; ++vt)
#pragma unroll
        for (int g4 = 0; g4 < 4; ++g4) { const int ch = hd * 64 + 32 * vt + 8 * g4 + 4 * h; bf16_t* yo = ON + tokq * onp + ch;
            float v0 = o[vt][4 * g4 + 0], v1 = o[vt][4 * g4 + 1], v2 = o[vt][4 * g4 + 2], v3 = o[vt][4 * g4 + 3];
            if (pt > 0) { const u32x2 w = oprev[vt][g4]; v0 += sp * bflo(w.x); v1 += sp * bfhi(w.x); v2 += sp * bflo(w.y); v3 += sp * bfhi(w.y); }
            u32x2 w; w.x = pk2(v0 * inv, v1 * inv); w.y = pk2(v2 * inv, v3 * inv); *(u32x2*)yo = w; }
    if (h == 0 && pt < 2) __hip_atomic_store(LN + tokq * 4 + hd, mnew + __logf(ltot), __ATOMIC_RELAXED, __HIP_MEMORY_SCOPE_AGENT);
}

#define RLX_AGENT __ATOMIC_RELAXED, __HIP_MEMORY_SCOPE_AGENT
#define XB_TMO      128
#define XB_XCNT(j)  (256  + 64 * (j))
#define XB_XSUB(j)  (1280 + 64 * (j))
#define XB_XGEN(j)  (2304 + 64 * (j))
#define XB_TOP      3328
#define XB_TOPGEN   3392
#define XCD_BAR_WORDS 3456
#define XB_SPIN_CAP (1u << 18)

__device__ __forceinline__ unsigned xb_ld(unsigned* p)              { return __hip_atomic_load(p, __ATOMIC_RELAXED, __HIP_MEMORY_SCOPE_AGENT); }
__device__ __forceinline__ unsigned xb_add(unsigned* p, unsigned v) { return __hip_atomic_fetch_add(p, v, __ATOMIC_RELAXED, __HIP_MEMORY_SCOPE_AGENT); }
__device__ __forceinline__ unsigned xb_xcc_id() { return (unsigned)__builtin_amdgcn_s_getreg((3 << 11) | 20) & 0xFu; }
#define XB_SPIN(cond, bar) do { unsigned _sp = 0; while (cond) { __builtin_amdgcn_s_sleep(1); \
    if ((++_sp & 255u) == 0u) { if (xb_ld(&(bar)[XB_TMO])) break; if (_sp > XB_SPIN_CAP) { atomicAdd(&(bar)[XB_TMO], 1u); break; } } } } while (0)

struct XcdBarrier {
    unsigned* bar; unsigned x;
    volatile LAS unsigned* st;
};

__device__ __forceinline__ XcdBarrier xcd_barrier_post(unsigned* bar, volatile LAS unsigned* st) {
    XcdBarrier b; b.bar = bar; b.x = xb_xcc_id(); b.st = st;
    if (threadIdx.x == 0) (void)xb_add(&bar[XB_XCNT(b.x)], 1u);
    return b;
}
__device__ __forceinline__ void xcd_barrier_complete(unsigned* bar, unsigned x, unsigned& nloc, unsigned& nx) {
    const unsigned G = gridDim.x * gridDim.y * gridDim.z;
    unsigned sum, cnt, mine, sp = 0u;
    for (;;) {
        sum = 0u; cnt = 0u; mine = 0u;
#pragma unroll
        for (unsigned j = 0; j < 16; ++j) { const unsigned c = xb_ld(&bar[XB_XCNT(j)]); sum += c; cnt += (c > 0u) ? 1u : 0u; mine = (j == x) ? c : mine; }
        if (sum == G) break;
        __builtin_amdgcn_s_sleep(1);
        if ((++sp & 255u) == 0u) { if (xb_ld(&bar[XB_TMO])) break; if (sp > XB_SPIN_CAP) { atomicAdd(&bar[XB_TMO], 1u); break; } }
    }
    nloc = mine > 0u ? mine : 1u; nx = cnt > 0u ? cnt : 1u;
}

__device__ __forceinline__ void xcd_barrier(const XcdBarrier& b) {
    asm volatile("s_waitcnt vmcnt(0)" ::: "memory");
    __syncthreads();
    if (threadIdx.x == 0) {
        unsigned* bar = b.bar;
        __builtin_amdgcn_s_waitcnt(0);
        unsigned nloc = b.st[0], nx = b.st[1];
        if (nloc == 0u) { xcd_barrier_complete(bar, b.x, nloc, nx); b.st[0] = nloc; b.st[1] = nx; }
        const unsigned old = xb_add(&bar[XB_XSUB(b.x)], 1u);
        const unsigned gen = old / nloc;
        if (old + 1u == (gen + 1u) * nloc) {
            __builtin_amdgcn_fence(__ATOMIC_RELEASE, "agent");
            asm volatile("s_waitcnt vmcnt(0)" ::: "memory");
            const unsigned og = xb_add(&bar[XB_TOP], 1u);
            const unsigned tg = og / nx;
            if (og + 1u == (tg + 1u) * nx) xb_add(&bar[XB_TOPGEN], 1u);
            else XB_SPIN(xb_ld(&bar[XB_TOPGEN]) == tg, bar);
            __builtin_amdgcn_fence(__ATOMIC_ACQUIRE, "agent");
            xb_add(&bar[XB_XGEN(b.x)], 1u);
            asm volatile("s_waitcnt vmcnt(0)" ::: "memory");
        } else {
            XB_SPIN(xb_ld(&bar[XB_XGEN(b.x)]) == gen, bar);
            __builtin_amdgcn_fence(__ATOMIC_ACQUIRE, "agent");
            asm volatile("s_waitcnt vmcnt(0)" ::: "memory");
        }
    }
    __syncthreads();
}

#ifndef REP_A
#define REP_A 0
#endif
#ifndef REP_B
#define REP_B 0
#endif
#ifndef REP_C
#define REP_C 0
#endif
#ifndef REP_D
#define REP_D 0
#endif
#ifndef MIX_A
#define MIX_A 1
#endif
#ifndef MIX_B
#define MIX_B 1
#endif
#ifndef MIX_C
#define MIX_C 1
#endif
#ifndef MIX_D
#define MIX_D 1
#endif
__global__ void __launch_bounds__(512, 2) hybrid_fwd(Params p) {
    extern __shared__ __attribute__((aligned(16))) unsigned char lds_raw[];
    LAS unsigned char* lds = (LAS unsigned char*)lds_raw;
    cg::grid_group grid = cg::this_grid();
    { volatile LAS unsigned* st0 = (volatile LAS unsigned*)(lds + LDS_BYTES - 64); if (threadIdx.x < 2) st0[threadIdx.x] = 0u; }
    __syncthreads();
    (void)xcd_barrier_post((unsigned*)(p.ws + WS_BAR), (volatile LAS unsigned*)(lds + LDS_BYTES - 64));
    const int G = gridDim.x, bid = blockIdx.x;
    unsigned char* ws = p.ws;
    bf16_t* XB = (bf16_t*)(ws + WS_XB); bf16_t* Zb = (bf16_t*)(ws + WS_Z); bf16_t* YC_ = (bf16_t*)(ws + WS_YCAT); bf16_t* HM = (bf16_t*)(ws + WS_HM);
    float* SSQP = (float*)(ws + WS_SSQP);

#define GRID_SYNC_() do { asm volatile("s_waitcnt vmcnt(0) lgkmcnt(0)" ::: "memory"); grid.sync(); if (threadIdx.x < 64) { __builtin_amdgcn_fence(__ATOMIC_ACQUIRE, "agent"); asm volatile("s_waitcnt vmcnt(0)" ::: "memory"); } __syncthreads(); } while (0)
#define XBAR_ONCE() do { XcdBarrier b_; b_.bar = (unsigned*)(p.ws + WS_BAR); b_.x = xb_xcc_id(); b_.st = (volatile LAS unsigned*)(lds + LDS_BYTES - 64); xcd_barrier(b_); } while (0)
#ifdef REP_SYNC
#define GRID_SYNC() do { XBAR_ONCE(); XBAR_ONCE(); } while (0)
#else
#define GRID_SYNC() XBAR_ONCE()
#endif
    prologue(p, lds, G);
#ifdef REP_PRO
    GRID_SYNC_(); prologue(p, lds, G);
#endif
#ifdef NANFILL
    { u32x4* q = (u32x4*)(ws + WS_S5H); const size_t n16 = (WS_END - WS_S5H) / 16; const u32x4 nanv = (u32x4){0xffffffffu, 0xffffffffu, 0xffffffffu, 0xffffffffu};
      for (size_t i = (size_t)bid * 512 + threadIdx.x; i < n16; i += (size_t)G * 512) q[i] = nanv;
      u32x4* q2 = (u32x4*)(ws + WS_LSE); const size_t m16 = (WS_S5K - WS_LSE) / 16;
      for (size_t i = (size_t)bid * 512 + threadIdx.x; i < m16; i += (size_t)G * 512) q2[i] = nanv; }
#endif
    if (gridDim.y == 0x7fffffffu) GRID_SYNC_();
    GRID_SYNC();

#ifndef NL_RUN
#define NL_RUN NL
#endif
#ifndef DUMP_LAYER
#define DUMP_LAYER 0
#endif
    for (int lrun = 0; lrun < NL_RUN; ++lrun) {
#ifdef SAME_LAYER
        const int l = 0; const bool firstl = (lrun == 0), lastl = (lrun == NL_RUN - 1);
#else
        const int l = lrun; const bool firstl = (lrun == 0), lastl = (lrun == NL_RUN - 1);
#endif
#define RS_TABLE(SSQ_, NUNITS_) \
          { pg8::Unit ua_, ub_; (void)S.next(0, ua_); (void)S.next((NUNITS_) - 1, ub_); \
              int tq_ = threadIdx.x; asm volatile("" : "+v"(tq_)); const int pm_ = (tq_ >> 8) ? ub_.pm : ua_.pm; \
              const f32x4* sq_ = (const f32x4*)((SSQ_) + ((size_t)pm_ * 256 + (tq_ & 255)) * 16); const f32x4 q0 = sq_[0], q1 = sq_[1], q2 = sq_[2], q3 = sq_[3]; \
              const float tot_ = (((q0[0] + q0[1]) + (q0[2] + q0[3])) + ((q1[0] + q1[1]) + (q1[2] + q1[3]))) + (((q2[0] + q2[1]) + (q2[2] + q2[3])) + ((q3[0] + q3[1]) + (q3[2] + q3[3]))); \
              ((LAS float*)(lds + 131072))[tq_] = rsqrtf(tot_ * (1.0f / 1024.0f) + EPS); __syncthreads(); }
        { pg8::Gemm g{XB, (const bf16_t*)(ws + WS_WIN) + (size_t)l * D * DIN, T, DIN, D, D}; pg8::StaticOrder S; S.init(T, DIN, G, bid);
          RS_TABLE(SSQP, (T / 256) * (DIN / 256) / 256)
          pg8::EpiScale E{Zb, DIN, 0, (const PG8_LAS float*)(lds + 131072)};
          pg8::gemm_phase<pg8::EpiScale, pg8::StaticOrder, true, true>(lds, g, S, E);
#ifdef REPEAT_GEMM
          GRID_SYNC(); pg8::gemm_phase<pg8::EpiScale, pg8::StaticOrder, true, true>(lds, g, S, E);
#endif
        }
        GRID_SYNC();
#ifndef SKIP_MIX
        if (!(MIX_A && MIX_B && MIX_C && MIX_D)) { int tq = threadIdx.x; asm volatile("" : "+v"(tq));
          for (int m = bid * 8 + (tq >> 6); m < T; m += G * 8) { u32x2* yp = (u32x2*)(YC_ + (size_t)m * D) + (tq & 63); const u32x2 z2 = (u32x2){0u, 0u};
              if (!MIX_A) yp[0] = z2; if (!MIX_B) yp[64] = z2; if (!MIX_C) yp[128] = z2; if (!MIX_D) yp[192] = z2; } }
#ifndef MIX_REPEAT
#define MIX_REPEAT 1
#endif
        for (int rep = 0; rep < MIX_REPEAT; ++rep) {
        for (int it = bid; it < 1664; it += G) {
            if (it < 512) { if (MIX_A) { hgrn_item<false>(p, lds, l, it); if (REP_A) hgrn_item<false>(p, lds, l, it); } }
            else if (it < 1024) { if (MIX_B) { conv_item(p, lds, l, it - 512); if (REP_B) conv_item(p, lds, l, it - 512); } }
            else if (it < 1152) { if (MIX_C) { s5_local_item(p, lds, l, it - 1024); if (REP_C) s5_local_item(p, lds, l, it - 1024); } }
            else { if (MIX_D) { attn_item(p, lds, l, 0, it - 1152); if (REP_D) attn_item(p, lds, l, 0, it - 1152); } }
        }
        GRID_SYNC();
        if (bid < 128) { if (MIX_A) hgrn_scan_item(p, bid); } else if (bid < 136) { if (MIX_C) s5_scan_item(p, l, bid - 128); }
        if (bid < 136) { if (MIX_D) { attn_item(p, lds, l, 1, 376 + bid); if (REP_D) attn_item(p, lds, l, 1, 376 + bid); } }
        else for (int it = bid - 136; it < 376; it += 120) { if (MIX_D) { attn_item(p, lds, l, 1, it); if (REP_D) attn_item(p, lds, l, 1, it); } }
        GRID_SYNC();
#ifdef REP_P3
        if (bid < 128) { if (MIX_A) hgrn_scan_item(p, bid); } else if (bid < 136) { if (MIX_C) s5_scan_item(p, l, bid - 128); }
        if (bid < 136) { if (MIX_D) { attn_item(p, lds, l, 1, 376 + bid); if (REP_D) attn_item(p, lds, l, 1, 376 + bid); } }
        else for (int it = bid - 136; it < 376; it += 120) { if (MIX_D) { attn_item(p, lds, l, 1, it); if (REP_D) attn_item(p, lds, l, 1, it); } }
        GRID_SYNC();
#endif
        for (int it = bid; it < 1536; it += G) {
            if (it < 512) { if (MIX_A) { hgrn_item<true>(p, lds, l, it); if (REP_A) hgrn_item<true>(p, lds, l, it); } }
            else if (it < 1024) { if (MIX_C) { s5_out_item(p, lds, l, it - 512); if (REP_C) s5_out_item(p, lds, l, it - 512); } }
            else { if (MIX_D) { attn_item(p, lds, l, 2, it - 1024); if (REP_D) attn_item(p, lds, l, 2, it - 1024); } }
        }
        GRID_SYNC();
        }
#ifndef NO_GLU
        { pg8::Gemm g{(const bf16_t*)(ws + WS_YPRE), (const bf16_t*)(ws + WS_WGLU) + (size_t)l * 65536, T, 256, 256, 256}; pg8::StaticOrder S; S.init(T, 256, G, bid);
          pg8::EpiGlu E{(const bf16_t*)(ws + WS_YPRE), 256, YC_ + YC};
          pg8::gemm_phase<pg8::EpiGlu, pg8::StaticOrder, false, true>(lds, g, S, E); }
#endif
        { int tq = threadIdx.x; asm volatile("" : "+v"(tq)); const int lane = tq & 63; const int gw = (bid - 128) * 8 + (tq >> 6), NGW = 128 * 8;
          if (bid >= 128) for (int m = gw; m < T; m += NGW) { u32x2* yp = (u32x2*)(YC_ + (size_t)m * D + YD) + lane; const u32x2 w = *((const u32x2*)(Zb + (size_t)m * DIN + ZOD) + lane);
              const float a0 = bflo(w.x), a1 = bfhi(w.x), a2 = bflo(w.y), a3 = bfhi(w.y);
              const float ss = wave_sum((a0 * a0 + a1 * a1) + (a2 * a2 + a3 * a3)); const float rs = rsqrtf(ss * (1.0f / 256.0f) + EPS);
              u32x2 o; o.x = pk2(a0 * rs, a1 * rs); o.y = pk2(a2 * rs, a3 * rs); *yp = o; } }
        GRID_SYNC();
#endif
#ifdef REP_P5
#ifndef NO_GLU
        { pg8::Gemm g{(const bf16_t*)(ws + WS_YPRE), (const bf16_t*)(ws + WS_WGLU) + (size_t)l * 65536, T, 256, 256, 256}; pg8::StaticOrder S; S.init(T, 256, G, bid);
          pg8::EpiGlu E{(const bf16_t*)(ws + WS_YPRE), 256, YC_ + YC};
          pg8::gemm_phase<pg8::EpiGlu, pg8::StaticOrder, false, true>(lds, g, S, E); }
#endif
        { int tq = threadIdx.x; asm volatile("" : "+v"(tq)); const int lane = tq & 63; const int gw = (bid - 128) * 8 + (tq >> 6), NGW = 128 * 8;
          if (bid >= 128) for (int m = gw; m < T; m += NGW) { u32x2* yp = (u32x2*)(YC_ + (size_t)m * D + YD) + lane; const u32x2 w = *((const u32x2*)(Zb + (size_t)m * DIN + ZOD) + lane);
              const float a0 = bflo(w.x), a1 = bfhi(w.x), a2 = bflo(w.y), a3 = bfhi(w.y);
              const float ss = wave_sum((a0 * a0 + a1 * a1) + (a2 * a2 + a3 * a3)); const float rs = rsqrtf(ss * (1.0f / 256.0f) + EPS);
              u32x2 o; o.x = pk2(a0 * rs, a1 * rs); o.y = pk2(a2 * rs, a3 * rs); *yp = o; } }
        GRID_SYNC();
#endif
#ifdef DUMP_SLICE
        if (lrun == DUMP_LAYER) { int tq = threadIdx.x; asm volatile("" : "+v"(tq));
          for (int m = bid * 8 + (tq >> 6); m < T; m += G * 8) { const int ln = tq & 63;
              for (int j = 0; j < 4; ++j) { const int col = j * 256 + ln * 4; const u32x2 w = *(const u32x2*)(YC_ + (size_t)m * D + col);
                  f32x4 o = (f32x4){0.f, 0.f, 0.f, 0.f}; if (j == DUMP_SLICE) o = (f32x4){bflo(w.x), bfhi(w.x), bflo(w.y), bfhi(w.y)};
                  *(f32x4*)(p.out + (size_t)m * D + col) = o; } }
          break; }
#endif
#ifdef SKIP_MIX
        { pg8::Gemm g{Zb, (const bf16_t*)(ws + WS_WOUT) + (size_t)l * D * D, T, D, D, DIN}; pg8::StaticOrder S; S.init(T, D, G, bid);
#else
        { pg8::Gemm g{YC_, (const bf16_t*)(ws + WS_WOUT) + (size_t)l * D * D, T, D, D, D}; pg8::StaticOrder S; S.init(T, D, G, bid);
#endif
          pg8::EpiRes E{firstl ? p.in[I_X] : p.out, p.out, XB, SSQP + (size_t)T * 16};
          pg8::gemm_phase<pg8::EpiRes, pg8::StaticOrder, true, true>(lds, g, S, E); }
        GRID_SYNC();
        { pg8::Gemm g{XB, (const bf16_t*)(ws + WS_WUP) + (size_t)l * D * FF, T, FF, D, D}; pg8::StaticOrder S; S.init(T, FF, G, bid);
          RS_TABLE(SSQP + (size_t)T * 16, (T / 256) * (FF / 256) / 256)
          pg8::EpiScale E{HM, FF, 1, (const PG8_LAS float*)(lds + 131072)};
          pg8::gemm_phase<pg8::EpiScale, pg8::StaticOrder, true, true>(lds, g, S, E);
#ifdef REPEAT_GEMM
          GRID_SYNC(); pg8::gemm_phase<pg8::EpiScale, pg8::StaticOrder, true, true>(lds, g, S, E);
#endif
        }
        GRID_SYNC();
        { pg8::Gemm g{HM, (const bf16_t*)(ws + WS_WDN) + (size_t)l * D * FF, T, D, FF, FF}; pg8::StaticOrder S; S.init(T, D, G, bid);
          pg8::EpiRes E{p.out, p.out, XB, !lastl ? SSQP : nullptr};
          pg8::gemm_phase<pg8::EpiRes, pg8::StaticOrder, true, true>(lds, g, S, E); }
        if (!lastl) GRID_SYNC();
    }
}

extern "C" void kernel_launch(void* const* d_in, const int* in_sizes, int n_in, void* d_out, int out_size, void* d_ws, size_t ws_size, hipStream_t stream) {
    static int grid = 0;
    if (grid == 0) {
        if (n_in != 26 || out_size != T * D || ws_size < WS_END) { fprintf(stderr, "kernel_launch: unexpected shapes (n_in %d, out %d, ws %zu); nothing launched\n", n_in, out_size, ws_size); grid = -1; return; }
        int dev = 0, cus = 0, per_cu = 0;
        (void)hipGetDevice(&dev); (void)hipDeviceGetAttribute(&cus, hipDeviceAttributeMultiprocessorCount, dev);
        if (hipFuncSetAttribute((const void*)hybrid_fwd, hipFuncAttributeMaxDynamicSharedMemorySize, LDS_BYTES) != hipSuccess) { fprintf(stderr, "kernel_launch: hipFuncSetAttribute failed\n"); grid = -1; return; }
        if (hipOccupancyMaxActiveBlocksPerMultiprocessor(&per_cu, (const void*)hybrid_fwd, 512, LDS_BYTES) != hipSuccess || per_cu < 1) { fprintf(stderr, "kernel_launch: occupancy query gave %d\n", per_cu); per_cu = 1; }
        (void)hipGetLastError();
        if (cus <= 0) cus = 256;
        grid = cus * per_cu;
    }
    if (grid < 0) return;
    if (hipMemsetAsync((char*)d_ws + WS_BAR, 0, XCD_BAR_WORDS * 4, stream) != hipSuccess) { fprintf(stderr, "kernel_launch: hipMemsetAsync of the barrier words failed\n"); return; }
    static int rs_ok = -1;
    if (rs_ok < 0) { rs_ok = (grid == 256) ? 1 : 0;
        const int ncol[2] = {DIN / 256, FF / 256};
        for (int ph = 0; ph < 2 && rs_ok; ++ph) { const int nun = (T / 256) * ncol[ph] / 256;
            for (int c = 0; c < grid && rs_ok; ++c) { pg8::StaticOrder S; S.init(T, ncol[ph] * 256, grid, c); pg8::Unit u0, u1, ui; if (!S.next(0, u0) || !S.next(nun - 1, u1) || S.next(nun, ui)) { rs_ok = 0; break; }
                if (((u0.pm >> 3) & 1) != 0 || ((u1.pm >> 3) & 1) != 1) { rs_ok = 0; break; }
                for (int i = 0; i < nun; ++i) { S.next(i, ui); if (ui.pm != (((ui.pm >> 3) & 1) ? u1.pm : u0.pm)) { rs_ok = 0; break; } } } } }
    Params a{};
    for (int i = 0; i < 26; ++i) a.in[i] = (const float*)d_in[i];
    if (!rs_ok) { fprintf(stderr, "kernel_launch: unit order does not keep a workgroup inside two row panels (grid %d); nothing launched\n", grid); return; }
    a.out = (float*)d_out; a.ws = (unsigned char*)d_ws; a.rs_lds = rs_ok; a.pad = 0;
    void* args[] = {&a};
    hipError_t e = hipLaunchCooperativeKernel((const void*)hybrid_fwd, dim3(grid), dim3(512), args, LDS_BYTES, stream);
    if (e != hipSuccess) fprintf(stderr, "cooperative launch failed: %s (grid %d)\n", hipGetErrorString(e), grid);
}
```

```cpp
#include <hip/hip_runtime.h>
#include <hip/hip_cooperative_groups.h>
#include <cstdio>
#include <cstdint>
namespace cg = cooperative_groups;

#define DI __device__ __forceinline__
#define LAS __attribute__((address_space(3)))
typedef unsigned short bf16_t;
typedef short bf16x8 __attribute__((ext_vector_type(8)));
typedef short s16x4 __attribute__((ext_vector_type(4)));
typedef float f32x4 __attribute__((ext_vector_type(4)));
typedef float f32x16 __attribute__((ext_vector_type(16)));
typedef unsigned u32x4 __attribute__((ext_vector_type(4)));
typedef unsigned u32x2 __attribute__((ext_vector_type(2)));

constexpr int NB = 4, SEQ = 8192, T = NB * SEQ, D = 1024, DIN = 2560, FF = 4096, NL = 4;
constexpr int ZQ = 0, ZF = 256, ZI = 512, ZG = 768, ZBV = 1024, ZBG = 1280, ZCU = 1536, ZDQ = 1792, ZDK = 2048, ZDV = 2304;
constexpr int YA = 0, YB = 256, YC = 512, YD = 768;
constexpr int ZOD = ZBG;
constexpr float EPS = 1e-6f;
constexpr size_t MiB = 1u << 20;
constexpr size_t WS_WIN = 0, WS_WOUT = 20 * MiB, WS_WUP = 28 * MiB, WS_WDN = 60 * MiB, WS_WGLU = 92 * MiB;
constexpr size_t WS_LB = 93 * MiB;
constexpr size_t WS_BIAS = WS_LB + 4096;
constexpr size_t WS_BAR = WS_LB + 32768;
constexpr size_t WS_SSQ = WS_LB + 65536;
constexpr size_t WS_LSE = WS_SSQ + 8 * (size_t)T * 4;
constexpr size_t WS_DEC = WS_LSE + (size_t)T * 16;
constexpr size_t WS_LSE1 = WS_DEC + 2048 * 64 * 4;
constexpr size_t WS_S5K = 96 * MiB;
constexpr size_t WS_S5WS = 98 * MiB;
constexpr size_t WS_S5WC = 114 * MiB;
constexpr size_t WS_XB = 130 * MiB;
constexpr size_t WS_S5H = 194 * MiB;
constexpr size_t WS_HM = 198 * MiB;
constexpr size_t WS_Z = 198 * MiB;
constexpr size_t WS_YCAT = 358 * MiB;
constexpr size_t WS_SL = 422 * MiB, WS_SL2 = 438 * MiB;
constexpr size_t WS_S5H2 = 454 * MiB;
constexpr size_t WS_O0 = 458 * MiB, WS_O1 = 474 * MiB;
constexpr size_t WS_YPRE = 490 * MiB;
constexpr size_t WS_SSQP = 506 * MiB;
constexpr size_t WS_END = 510 * MiB;
static_assert(WS_LSE1 + (size_t)T * 16 <= WS_S5K, "misc region");

constexpr int LDS_BYTES = 147456;

typedef float f32x2_t __attribute__((ext_vector_type(2))); typedef __bf16 bf16x2_t __attribute__((ext_vector_type(2)));
DI unsigned f2bf(float f) { const f32x2_t v = {f, 0.f}; const bf16x2_t b = __builtin_convertvector(v, bf16x2_t); return __builtin_bit_cast(unsigned, b) & 0xffffu; }
DI unsigned pk2(float lo, float hi) { const f32x2_t v = {lo, hi}; const bf16x2_t b = __builtin_convertvector(v, bf16x2_t); return __builtin_bit_cast(unsigned, b); }
DI float bf2f(bf16_t v) { return __builtin_bit_cast(float, (unsigned)v << 16); }
DI float bflo(unsigned w) { return __builtin_bit_cast(float, w << 16); }
DI float bfhi(unsigned w) { return __builtin_bit_cast(float, w & 0xffff0000u); }
DI float sigmoidf_(float x) { return __builtin_amdgcn_rcpf(1.f + __expf(-x)); }
template <int CTRL> DI float dpp_(float v) { return __builtin_bit_cast(float, __builtin_amdgcn_update_dpp(0, __builtin_bit_cast(int, v), CTRL, 0xF, 0xF, false)); }
DI float sum8_(float v) { v += dpp_<0xB1>(v); v += dpp_<0x4E>(v); v += dpp_<0x141>(v); return v; }
DI float sum16_(float v) { v = sum8_(v); v += dpp_<0x140>(v); return v; }
DI float half_sum(float v) { v = sum16_(v); v += __shfl_xor(v, 16); return v; }
DI float wave_sum(float v) { v = half_sum(v); v += __shfl_xor(v, 32); return v; }
#define LDS_WAIT() asm volatile("s_waitcnt lgkmcnt(0)" ::: "memory")
DI int crow(int reg, int h) { return (reg & 3) + 8 * (reg >> 2) + 4 * h; }

template <int K>
DI f32x16 mma_lds(const LAS bf16_t* A, int lda, const LAS bf16_t* B, int ldb, f32x16 acc, int lane) {
    const int r = lane & 31, h = lane >> 5;
    const LAS bf16_t* ap = A + r * lda + 8 * h; const LAS bf16_t* bp = B + r * ldb + 8 * h;
#pragma unroll
    for (int k0 = 0; k0 < K; k0 += 16) {
        const bf16x8 a = *(const LAS bf16x8*)(ap + k0); const bf16x8 b = *(const LAS bf16x8*)(bp + k0);
        acc = __builtin_amdgcn_mfma_f32_32x32x16_bf16(a, b, acc, 0, 0, 0);
    }
    return acc;
}
DI f32x16 zero16() { f32x16 z;
#pragma unroll
    for (int i = 0; i < 16; ++i) z[i] = 0.f;
    return z; }

namespace pg8 {
#define PG8_LAS __attribute__((address_space(3)))
constexpr int BM = 256, BK = 64, HALF = 128, HTB = HALF * BK * 2, STAGE_BYTES = 8 * HTB, NXCD = 8, WGM = 8;
__host__ __device__ __forceinline__ int lds_byte(int r, int c) { const int st = (r >> 4) * 2 + (c >> 5), rr = r & 15, cc = c & 31, ob = rr * 64 + cc * 2; return st * 1024 + (ob ^ (((ob >> 9) & 1) << 5)); }
__host__ __device__ __forceinline__ void stage_rc(int b, int& R, int& C) { const int st = b / 1024, sb = b % 1024, swz = sb ^ (((sb >> 9) & 1) << 5); R = (st >> 1) * 16 + swz / 64; C = (st & 1) * 32 + (swz % 64) / 2; }
__host__ __device__ __forceinline__ int perm32(int rho) { const int n = rho >> 4, i = rho & 15; return 8 * (i >> 2) + 4 * n + (i & 3); }
struct Unit { int pm, pn; };
struct Gemm { const bf16_t* A; const bf16_t* Bt; int M, N, K, lda; };
struct StaticOrder {
    int nM, nN, nwg, G, c;
    __host__ __device__ __forceinline__ void init(int M, int N, int G_, int c_) { nM = M / BM; nN = N / BM; nwg = nM * nN; G = G_; c = c_; }
    __host__ __device__ __forceinline__ bool next(int i, Unit& u) const {
        const long L = (long)i * G + c; if (L >= nwg) return false;
        int wgid = (int)L; { const int q = nwg / NXCD, r = nwg % NXCD, xcd = wgid % NXCD, off = wgid / NXCD; wgid = (xcd < r ? xcd * (q + 1) : r * (q + 1) + (xcd - r) * q) + off; }
        const int nig = WGM * nN, gid = wgid / nig, fm = gid * WGM, gsz = (nM - fm) < WGM ? (nM - fm) : WGM;
        u.pm = fm + ((wgid % nig) % gsz); u.pn = (wgid % nig) / gsz; return true;
    }
    __device__ __forceinline__ void a_ready(const Unit&) const {}
    __device__ __forceinline__ void done(const Unit&) const {}
};
struct EpiScale {
    static constexpr bool PERM = true, AFTER_DRAIN = false;
    bf16_t* O; int ldc; int act; const PG8_LAS float* rsl;
    __device__ __forceinline__ void operator()(const f32x4 (&acc)[2][2][4][2], const Unit& u, int wr, int wc, int fr, int fq) const {
        const int row0 = u.pm * BM + wr * 64 + fr; const int col0 = u.pn * BM + wc * 32 + 8 * fq;
        const int slot = ((u.pm >> 3) & 1) * 256;
#pragma unroll
        for (int ai = 0; ai < 2; ++ai)
#pragma unroll
            for (int m = 0; m < 4; ++m) { const int r = row0 + ai * HALF + m * 16; float rs;
                rs = rsl[slot + ai * HALF + wr * 64 + m * 16 + fr];
                bf16_t* rowp = O + (size_t)r * ldc + col0;
#pragma unroll
                for (int bj = 0; bj < 2; ++bj) { f32x4 v0 = acc[ai][bj][m][0] * rs, v1 = acc[ai][bj][m][1] * rs;
                    if (act) {
#pragma unroll
                        for (int e = 0; e < 4; ++e) { const float a = fmaxf(v0[e], 0.f), b = fmaxf(v1[e], 0.f); v0[e] = a * a; v1[e] = b * b; } }
                    u32x4 w; w.x = pk2(v0[0], v0[1]); w.y = pk2(v0[2], v0[3]); w.z = pk2(v1[0], v1[1]); w.w = pk2(v1[2], v1[3]);
                    *(u32x4*)(rowp + bj * HALF) = w; } }
    }
};
struct EpiRes {
    static constexpr bool PERM = false, AFTER_DRAIN = false;
    const float* base; float* out; bf16_t* xb; float* ssq_out;
    __device__ __forceinline__ void operator()(const f32x4 (&acc)[2][2][4][2], const Unit& u, int wr, int wc, int fr, int fq) const {
        const int col0 = u.pn * BM + wc * 32 + 4 * fq;
#pragma unroll
        for (int ai = 0; ai < 2; ++ai) {
            f32x4 bv[4][2][2];
#pragma unroll
            for (int m = 0; m < 4; ++m) { const size_t off = (size_t)(u.pm * BM + ai * HALF + wr * 64 + m * 16 + fr) * D + col0;
#pragma unroll
                for (int bj = 0; bj < 2; ++bj)
#pragma unroll
                    for (int n = 0; n < 2; ++n) bv[m][bj][n] = *(const f32x4*)(base + off + bj * HALF + n * 16); }
#pragma unroll
            for (int m = 0; m < 4; ++m) { const int r = u.pm * BM + ai * HALF + wr * 64 + m * 16 + fr; const size_t off = (size_t)r * D + col0; float s = 0.f;
#pragma unroll
                for (int bj = 0; bj < 2; ++bj)
#pragma unroll
                    for (int n = 0; n < 2; ++n) { const size_t o2 = off + bj * HALF + n * 16; const f32x4 o = bv[m][bj][n] + acc[ai][bj][m][n];
                        *(f32x4*)(out + o2) = o; u32x2 w; w.x = pk2(o[0], o[1]); w.y = pk2(o[2], o[3]); *(u32x2*)(xb + o2) = w;
                        s += (o[0] * o[0] + o[1] * o[1]) + (o[2] * o[2] + o[3] * o[3]); }
                s += __shfl_xor(s, 16); s += __shfl_xor(s, 32);
                if (fq == 0 && ssq_out) ssq_out[(size_t)r * 16 + u.pn * 4 + wc] = s; } }
    }
};
struct EpiGlu {
    static constexpr bool PERM = false, AFTER_DRAIN = true;
    const bf16_t* Ysrc; int lds_; bf16_t* Y;
    __device__ __forceinline__ void fused(f32x4 (&acc)[2][2][4][2], const Unit& u, int wr, int wc, int fr, int fq, PG8_LAS unsigned char* lds, int wid, int lane) const {
        PG8_LAS float* Pp = (PG8_LAS float*)lds;
        const int col0 = wc * 32 + 4 * fq;
#pragma unroll
        for (int ai = 0; ai < 2; ++ai)
#pragma unroll
            for (int m = 0; m < 4; ++m) { const int rl = ai * HALF + wr * 64 + m * 16 + fr; const size_t off = (size_t)(u.pm * BM + rl) * lds_ + col0; float s = 0.f;
#pragma unroll
                for (int bj = 0; bj < 2; ++bj)
#pragma unroll
                    for (int n = 0; n < 2; ++n) { const u32x2 w = *(const u32x2*)(Ysrc + off + bj * HALF + n * 16); f32x4 a = acc[ai][bj][m][n];
                        const float y0 = bflo(w.x), y1 = bfhi(w.x), y2 = bflo(w.y), y3 = bfhi(w.y);
                        a[0] = y0 * sigmoidf_(a[0]); a[1] = y1 * sigmoidf_(a[1]); a[2] = y2 * sigmoidf_(a[2]); a[3] = y3 * sigmoidf_(a[3]);
                        acc[ai][bj][m][n] = a; s += (a[0] * a[0] + a[1] * a[1]) + (a[2] * a[2] + a[3] * a[3]); }
                s += __shfl_xor(s, 16); s += __shfl_xor(s, 32);
                if (fq == 0) Pp[rl * 4 + wc] = s; }
        __syncthreads();
#pragma unroll
        for (int ai = 0; ai < 2; ++ai)
#pragma unroll
            for (int m = 0; m < 4; ++m) { const int rl = ai * HALF + wr * 64 + m * 16 + fr; const size_t off = (size_t)(u.pm * BM + rl) * D + col0;
                const float tot = (Pp[rl * 4 + 0] + Pp[rl * 4 + 1]) + (Pp[rl * 4 + 2] + Pp[rl * 4 + 3]); const float rs = rsqrtf(tot * (1.0f / 256.0f) + EPS);
#pragma unroll
                for (int bj = 0; bj < 2; ++bj)
#pragma unroll
                    for (int n = 0; n < 2; ++n) { const f32x4 a = acc[ai][bj][m][n] * rs; u32x2 w; w.x = pk2(a[0], a[1]); w.y = pk2(a[2], a[3]); *(u32x2*)(Y + off + bj * HALF + n * 16) = w; } }
    }
};

template <class Epi, class Sched, bool ALIGN_EPI = false, bool SP2 = false>
__device__ __forceinline__ void gemm_phase(PG8_LAS unsigned char* lds, const Gemm g, const Sched& S, const Epi& E) {
    int tid_o = threadIdx.x; asm volatile("" : "+v"(tid_o));
    const int tid = tid_o, wid = __builtin_amdgcn_readfirstlane(tid >> 6), lane = tid & 63, wr = wid >> 2, wc = wid & 3, fr = lane & 15, fq = lane >> 4;
    const int K = g.K, nt = K / BK;
    unsigned voffA[2], voffB[2];
#pragma unroll
    for (int i = 0; i < 2; ++i) { int R, C; stage_rc(tid * 16 + i * 8192, R, C); const int Rb = Epi::PERM ? ((R & ~31) + perm32(R & 31)) : R;
        voffA[i] = (unsigned)(R * g.lda + C) * 2u; voffB[i] = (unsigned)(Rb * K + C) * 2u; }
    const size_t kstep = (size_t)(BK * 2);
    const size_t hstepA = (size_t)HALF * g.lda * 2, hstepB = (size_t)HALF * K * 2;
    const size_t tstepA = 2 * hstepA, tstepB = 2 * hstepB;
    const unsigned ldsw = (unsigned)wid * 1024u;
    const int aoff = lds_byte(wr * 64 + fr, fq * 8), boff = lds_byte(wc * 32 + fr, fq * 8);
#define PG8_SA(b, h) (((b) * 2 + (h)) * HTB)
#define PG8_SB(b, h) ((4 + (b) * 2 + (h)) * HTB)
#define PG8_STAGE(bufoff, gbase, voff) do { _Pragma("unroll") for (int _i = 0; _i < 2; ++_i) \
        __builtin_amdgcn_global_load_lds((const unsigned*)((const char*)(gbase) + (voff)[_i]), (PG8_LAS unsigned*)(lds + (bufoff) + ldsw + _i * 8192), 16, 0, 0); } while (0)
#define PG8_LDA(dst, b, h) do { _Pragma("unroll") for (int m = 0; m < 4; ++m) _Pragma("unroll") for (int k = 0; k < 2; ++k) dst[m][k] = *(const PG8_LAS bf16x8*)(lds + PG8_SA(b, h) + aoff + m * 2048 + k * 1024); } while (0)
#define PG8_LDB(dst, b, h) do { _Pragma("unroll") for (int n = 0; n < 2; ++n) _Pragma("unroll") for (int k = 0; k < 2; ++k) dst[n][k] = *(const PG8_LAS bf16x8*)(lds + PG8_SB(b, h) + boff + n * 2048 + k * 1024); } while (0)
#define PG8_MMA(ai, bj, At, Bt) do { __builtin_amdgcn_s_setprio(1); _Pragma("unroll") for (int m = 0; m < 4; ++m) _Pragma("unroll") for (int n = 0; n < 2; ++n) _Pragma("unroll") for (int k = 0; k < 2; ++k) \
        acc[ai][bj][m][n] = __builtin_amdgcn_mfma_f32_16x16x32_bf16(Bt[n][k], At[m][k], acc[ai][bj][m][n], 0, 0, 0); __builtin_amdgcn_s_setprio(0); } while (0)
#define PG8_WAIT_V(n) asm volatile("s_waitcnt vmcnt(" #n ")" ::: "memory")
#define PG8_WAIT_L(n) asm volatile("s_waitcnt lgkmcnt(" #n ")" ::: "memory")
#define PG8_BAR __builtin_amdgcn_s_barrier()
#define PG8_SCHED __builtin_amdgcn_sched_barrier(0)
    Unit cur, nxt; int ui = 0;
    if (!S.next(0, cur)) return;
    f32x4 acc[2][2][4][2];
#pragma unroll
    for (int a = 0; a < 2; ++a)
#pragma unroll
        for (int b = 0; b < 2; ++b)
#pragma unroll
            for (int m = 0; m < 4; ++m)
#pragma unroll
                for (int n = 0; n < 2; ++n) acc[a][b][m][n] = (f32x4){0.f, 0.f, 0.f, 0.f};
    bf16x8 At[4][2], B0[2][2], B1[2][2];
    const char* cA = (const char*)g.A + (size_t)cur.pm * tstepA; const char* cB = (const char*)g.Bt + (size_t)cur.pn * tstepB;
    S.a_ready(cur);
    if constexpr (SP2) {
        PG8_STAGE(PG8_SB(0, 0), cB, voffB); PG8_STAGE(PG8_SB(0, 1), cB + hstepB, voffB); PG8_STAGE(PG8_SA(0, 0), cA, voffA); PG8_STAGE(PG8_SA(0, 1), cA + hstepA, voffA);
        if (wr == 1) PG8_BAR;
        PG8_WAIT_V(2); PG8_BAR;
        PG8_STAGE(PG8_SB(1, 0), cB + kstep, voffB); PG8_STAGE(PG8_SA(1, 0), cA + kstep, voffA); PG8_STAGE(PG8_SB(1, 1), cB + hstepB + kstep, voffB);
        PG8_WAIT_V(6); PG8_BAR;
    } else {
        PG8_STAGE(PG8_SB(0, 0), cB, voffB); PG8_STAGE(PG8_SA(0, 0), cA, voffA); PG8_STAGE(PG8_SB(0, 1), cB + hstepB, voffB); PG8_STAGE(PG8_SA(0, 1), cA + hstepA, voffA);
        if (wr == 1) PG8_BAR;
        PG8_WAIT_V(4); PG8_BAR;
        PG8_STAGE(PG8_SB(1, 0), cB + kstep, voffB); PG8_STAGE(PG8_SA(1, 0), cA + kstep, voffA); PG8_STAGE(PG8_SB(1, 1), cB + hstepB + kstep, voffB);
        PG8_WAIT_V(6); PG8_BAR;
    }
    for (;;) {
        const bool has_next = S.next(ui + 1, nxt);
        const char* nA = has_next ? (const char*)g.A + (size_t)nxt.pm * tstepA : cA; const char* nB = has_next ? (const char*)g.Bt + (size_t)nxt.pn * tstepB : cB;
        for (int t = 0; t < nt; t += 2) {
            const bool last = (t == nt - 2);
            const char* a1 = cA + (size_t)(t + 1) * kstep;
            const char* a2 = last ? nA : cA + (size_t)(t + 2) * kstep; const char* b2 = last ? nB : cB + (size_t)(t + 2) * kstep;
            const char* a3 = a2 + kstep; const char* b3 = b2 + kstep;
            if (last && has_next) S.a_ready(nxt);
            if constexpr (SP2) {
            PG8_LDB(B0, 0, 0); PG8_LDB(B1, 0, 1); PG8_SCHED; PG8_LDA(At, 0, 0); PG8_STAGE(PG8_SA(1, 1), a1 + hstepA, voffA);
            PG8_WAIT_V(8); PG8_WAIT_L(0); PG8_BAR; PG8_MMA(0, 0, At, B0); PG8_MMA(0, 1, At, B1); PG8_BAR; PG8_SCHED;
            PG8_LDA(At, 0, 1); PG8_STAGE(PG8_SB(0, 0), b2, voffB); PG8_STAGE(PG8_SB(0, 1), b2 + hstepB, voffB); PG8_STAGE(PG8_SA(0, 0), a2, voffA);
            PG8_WAIT_V(8); PG8_WAIT_L(0); PG8_BAR; PG8_MMA(1, 0, At, B0); PG8_MMA(1, 1, At, B1); PG8_BAR; PG8_SCHED;
            PG8_LDB(B0, 1, 0); PG8_LDB(B1, 1, 1); PG8_SCHED; PG8_LDA(At, 1, 0); PG8_STAGE(PG8_SA(0, 1), a2 + hstepA, voffA);
            PG8_WAIT_V(8); PG8_WAIT_L(0); PG8_BAR; PG8_MMA(0, 0, At, B0); PG8_MMA(0, 1, At, B1); PG8_BAR; PG8_SCHED;
            PG8_LDA(At, 1, 1); PG8_STAGE(PG8_SB(1, 0), b3, voffB); PG8_STAGE(PG8_SB(1, 1), b3 + hstepB, voffB); PG8_STAGE(PG8_SA(1, 0), a3, voffA);
            PG8_WAIT_V(8); PG8_WAIT_L(0); PG8_BAR; PG8_MMA(1, 0, At, B0); PG8_MMA(1, 1, At, B1); PG8_BAR; PG8_SCHED;
            } else {
            PG8_LDB(B0, 0, 0); PG8_SCHED; PG8_LDA(At, 0, 0); PG8_STAGE(PG8_SA(1, 1), a1 + hstepA, voffA);
            PG8_WAIT_L(8); PG8_BAR; PG8_WAIT_L(0); PG8_MMA(0, 0, At, B0); PG8_BAR; PG8_SCHED;
            PG8_LDB(B1, 0, 1); PG8_STAGE(PG8_SB(0, 0), b2, voffB);
            PG8_BAR; PG8_WAIT_L(0); PG8_MMA(0, 1, At, B1); PG8_BAR;
            PG8_LDA(At, 0, 1); PG8_STAGE(PG8_SA(0, 0), a2, voffA);
            PG8_BAR; PG8_WAIT_L(0); PG8_MMA(1, 0, At, B0); PG8_BAR; PG8_SCHED;
            PG8_STAGE(PG8_SB(0, 1), b2 + hstepB, voffB);
            PG8_WAIT_V(6); PG8_BAR; PG8_MMA(1, 1, At, B1); PG8_BAR;
            PG8_LDB(B0, 1, 0); PG8_SCHED; PG8_LDA(At, 1, 0); PG8_STAGE(PG8_SA(0, 1), a2 + hstepA, voffA);
            PG8_WAIT_L(8); PG8_BAR; PG8_WAIT_L(0); PG8_MMA(0, 0, At, B0); PG8_BAR; PG8_SCHED;
            PG8_LDB(B1, 1, 1); PG8_STAGE(PG8_SB(1, 0), b3, voffB);
            PG8_BAR; PG8_WAIT_L(0); PG8_MMA(0, 1, At, B1); PG8_BAR;
            PG8_LDA(At, 1, 1); PG8_STAGE(PG8_SA(1, 0), a3, voffA);
            PG8_BAR; PG8_WAIT_L(0); PG8_MMA(1, 0, At, B0); PG8_BAR; PG8_SCHED;
            PG8_STAGE(PG8_SB(1, 1), b3 + hstepB, voffB);
            PG8_WAIT_V(6); PG8_BAR; PG8_MMA(1, 1, At, B1); PG8_BAR;
            }
        }
        if constexpr (ALIGN_EPI) { if (wr == 0) PG8_BAR; }
        if constexpr (!Epi::AFTER_DRAIN) { E(acc, cur, wr, wc, fr, fq); S.done(cur); }
        if (!has_next) break;
#pragma unroll
        for (int a = 0; a < 2; ++a)
#pragma unroll
            for (int b = 0; b < 2; ++b)
#pragma unroll
                for (int m = 0; m < 4; ++m)
#pragma unroll
                    for (int n = 0; n < 2; ++n) acc[a][b][m][n] = (f32x4){0.f, 0.f, 0.f, 0.f};
        cur = nxt; cA = nA; cB = nB; ++ui;
        if constexpr (ALIGN_EPI) { if (wr == 1) PG8_BAR; }
    }
    PG8_WAIT_V(0);
    if constexpr (!ALIGN_EPI) { if (wr == 0) PG8_BAR; }
    PG8_BAR;
    if constexpr (Epi::AFTER_DRAIN) { E.fused(acc, cur, wr, wc, fr, fq, lds, wid, lane); S.done(cur); }
#undef PG8_SA
#undef PG8_SB
#undef PG8_STAGE
#undef PG8_LDA
#undef PG8_LDB
#undef PG8_MMA
#undef PG8_WAIT_V
#undef PG8_WAIT_L
#undef PG8_BAR
#undef PG8_SCHED
}
}

struct Params { const float* in[26]; float* out; unsigned char* ws; int rs_lds; int pad; };
enum { I_X = 0, I_NMG, I_WIN, I_LBL, I_HNG, I_CW, I_CB, I_CLG, I_CLB, I_LRE, I_LIM, I_BRE, I_BIM, I_CRE, I_CIM, I_S5D, I_LDT, I_WGLU, I_QG, I_KG, I_RB, I_MONG, I_WOUT, I_NMLPG, I_WUP, I_WDN };

DI void p0_transpose_item(const float* W, int K, int N, bf16_t* WT, const float* gk, LAS float* scr, int item, int lane) {
    const int nblk = N / 32, kb = item / nblk, nb = item % nblk, k0 = 64 * kb, n0 = 32 * nb;
    float wv[32];
#pragma unroll
    for (int i = 0; i < 32; ++i) { const int kk = 2 * i + (lane >> 5); wv[i] = W[(size_t)(k0 + kk) * N + n0 + (lane & 31)]; }
#pragma unroll
    for (int i = 0; i < 32; ++i) { const int kk = 2 * i + (lane >> 5); const float s = gk ? gk[k0 + kk] : 1.f; scr[kk * 33 + (lane & 31)] = wv[i] * s; }
    LDS_WAIT();
    const int c = lane & 7;
#pragma unroll
    for (int j = 0; j < 4; ++j) { const int n = (lane >> 3) + 8 * j; const LAS float* s = scr + (8 * c) * 33 + n;
        u32x4 o; o.x = pk2(s[0 * 33], s[1 * 33]); o.y = pk2(s[2 * 33], s[3 * 33]); o.z = pk2(s[4 * 33], s[5 * 33]); o.w = pk2(s[6 * 33], s[7 * 33]);
        *(u32x4*)(WT + (size_t)(n0 + n) * K + k0 + 8 * c) = o; }
    LDS_WAIT();
}
DI void s5_params(const Params& p, int lg, int pp, float& lrdt, float& lidt, float& cr, float& ci) {
    const float dt = expf(p.in[I_LDT][lg]);
    const float lr = p.in[I_LRE][lg * 64 + pp], li = p.in[I_LIM][lg * 64 + pp];
    lrdt = lr * dt; lidt = li * dt;
    const float mag = expf(lrdt); const float ar = mag * cosf(lidt), ai = mag * sinf(lidt);
    const float den = lr * lr + li * li;
    cr = ((ar - 1.0f) * lr + ai * li) / den; ci = (ai * lr - (ar - 1.0f) * li) / den;
}
DI void s5_pow(float lrdt, float lidt, int n, float& er, float& ei) { const float m = expf((float)n * lrdt); const float a = (float)n * lidt; er = m * cosf(a); ei = m * sinf(a); }

DI void prologue(const Params& p, LAS unsigned char* lds, int G) {
    int tid_o = threadIdx.x; asm volatile("" : "+v"(tid_o));
    const int tid = tid_o, lane = tid & 63, wave = tid >> 6;
    const int gw = blockIdx.x * 8 + wave, NGW = G * 8;
    const int gt = blockIdx.x * 512 + tid, NGT = G * 512;
    unsigned char* ws = p.ws;
    LAS float* scr = (LAS float*)(lds + wave * 16384);
    {
        constexpr int I_IN = (D / 64) * (DIN / 32), I_OUT = (D / 64) * (D / 32), I_UP = (D / 64) * (FF / 32), I_DN = (FF / 64) * (D / 32), I_GL = (256 / 64) * (256 / 32);
        constexpr int PER_L = I_IN + I_OUT + I_UP + I_DN + I_GL;
        for (int it = gw; it < NL * PER_L; it += NGW) {
            const int l = it / PER_L; int r = it % PER_L;
            if (r < I_IN) { p0_transpose_item(p.in[I_WIN] + (size_t)l * D * DIN, D, DIN, (bf16_t*)(ws + WS_WIN) + (size_t)l * D * DIN, p.in[I_NMG] + l * D, scr, r, lane); continue; } r -= I_IN;
            if (r < I_OUT) { p0_transpose_item(p.in[I_WOUT] + (size_t)l * D * D, D, D, (bf16_t*)(ws + WS_WOUT) + (size_t)l * D * D, p.in[I_MONG] + l * D, scr, r, lane); continue; } r -= I_OUT;
            if (r < I_UP) { p0_transpose_item(p.in[I_WUP] + (size_t)l * D * FF, D, FF, (bf16_t*)(ws + WS_WUP) + (size_t)l * D * FF, p.in[I_NMLPG] + l * D, scr, r, lane); continue; } r -= I_UP;
            if (r < I_DN) { p0_transpose_item(p.in[I_WDN] + (size_t)l * D * FF, FF, D, (bf16_t*)(ws + WS_WDN) + (size_t)l * D * FF, nullptr, scr, r, lane); continue; } r -= I_DN;
            p0_transpose_item(p.in[I_WGLU] + (size_t)l * 65536, 256, 256, (bf16_t*)(ws + WS_WGLU) + (size_t)l * 65536, nullptr, scr, r, lane);
        }
    }
    {
        float* ssq0 = (float*)(ws + WS_SSQP); bf16_t* XB = (bf16_t*)(ws + WS_XB);
        for (int mb = gw * 16; mb < T; mb += NGW * 16) {
            float keep = 0.f;
#pragma unroll 4
            for (int i = 0; i < 16; ++i) { const int m = mb + i;
                const f32x4* xr = (const f32x4*)(p.in[I_X] + (size_t)m * D) + lane; f32x4 v[4]; float s = 0.f;
#pragma unroll
                for (int j = 0; j < 4; ++j) { v[j] = xr[64 * j]; s += (v[j][0] * v[j][0] + v[j][1] * v[j][1]) + (v[j][2] * v[j][2] + v[j][3] * v[j][3]); }
                s = wave_sum(s); if (lane == i) keep = s;
                u32x2* o8 = (u32x2*)(XB + (size_t)m * D) + lane;
#pragma unroll
                for (int j = 0; j < 4; ++j) { u32x2 w; w.x = pk2(v[j][0], v[j][1]); w.y = pk2(v[j][2], v[j][3]); o8[64 * j] = w; } }
#pragma unroll 1
            for (int i = 0; i < 16; ++i) { const float v = __shfl(keep, i); if (lane < 16) ssq0[(size_t)(mb + i) * 16 + lane] = lane == 0 ? v : 0.f; }
        }
    }
    {
        float* LB = (float*)(ws + WS_LB);
        for (int c = gt; c < 256; c += NGT) {
            const float a0 = p.in[I_LBL][c], a1 = p.in[I_LBL][256 + c], a2 = p.in[I_LBL][512 + c], a3 = p.in[I_LBL][768 + c];
            const float mx = fmaxf(fmaxf(a0, a1), fmaxf(a2, a3));
            const float e0 = expf(a0 - mx), e1 = expf(a1 - mx), e2 = expf(a2 - mx), e3 = expf(a3 - mx); const float inv = 1.f / (e0 + e1 + e2 + e3);
            const float s1 = e1 * inv, s2 = e2 * inv, s3 = e3 * inv; const float hi = 1.0f - 1e-6f;
            LB[c] = 0.f; LB[256 + c] = fminf(fmaxf(s1, 0.f), hi); LB[512 + c] = fminf(fmaxf(s1 + s2, 0.f), hi); LB[768 + c] = fminf(fmaxf(s1 + s2 + s3, 0.f), hi);
        }
        float* BT = (float*)(ws + WS_BIAS);
        for (int i = gt; i < 3 * 4 * 132; i += NGT) {
            const int pt = i / (4 * 132), hd = (i / 132) % 4, dl = i % 132; const int dil = pt == 0 ? 1 : (pt == 1 ? 4 : 16);
            float v = 0.f;
            if (dl <= 128) { const int dist = dl * dil; int bk;
                if (dist < 16) bk = dist; else { bk = 16 + (int)(logf((float)dist / 16.0f) / 4.852030263919617f * 16.0f); if (bk > 31) bk = 31; }
                v = p.in[I_RB][bk * 4 + hd]; }
            BT[i] = v;
        }
    }
    {
        bf16_t* KT = (bf16_t*)(ws + WS_S5K); bf16_t* WS_ = (bf16_t*)(ws + WS_S5WS); bf16_t* WC = (bf16_t*)(ws + WS_S5WC);
        LAS float* ebr = scr; LAS float* ebi = scr + 64 * 17;
        for (int it = gw; it < NL * 16 * 64; it += NGW) {
            const int lg = it >> 6, d = it & 63;
            float lrdt, lidt, cr, ci; s5_params(p, lg, lane, lrdt, lidt, cr, ci);
            float er, ei; s5_pow(lrdt, lidt, d, er, ei);
            const float fr_ = er * cr - ei * ci, fi_ = er * ci + ei * cr;
            const float* br = p.in[I_BRE] + ((size_t)lg * 64 + lane) * 16; const float* bi = p.in[I_BIM] + ((size_t)lg * 64 + lane) * 16;
#pragma unroll
            for (int c = 0; c < 16; ++c) { const float b0 = br[c], b1 = bi[c]; ebr[lane * 17 + c] = fr_ * b0 - fi_ * b1; ebi[lane * 17 + c] = fr_ * b1 + fi_ * b0; }
            LDS_WAIT();
            const int co = lane & 15, cb = (lane >> 4) * 4;
            const float* crp = p.in[I_CRE] + ((size_t)lg * 16 + co) * 64; const float* cip = p.in[I_CIM] + ((size_t)lg * 16 + co) * 64;
            float a0 = 0.f, a1 = 0.f, a2 = 0.f, a3 = 0.f;
            for (int q = 0; q < 64; ++q) { const float c0 = crp[q], c1 = cip[q];
                a0 += c0 * ebr[q * 17 + cb + 0] - c1 * ebi[q * 17 + cb + 0]; a1 += c0 * ebr[q * 17 + cb + 1] - c1 * ebi[q * 17 + cb + 1];
                a2 += c0 * ebr[q * 17 + cb + 2] - c1 * ebi[q * 17 + cb + 2]; a3 += c0 * ebr[q * 17 + cb + 3] - c1 * ebi[q * 17 + cb + 3]; }
            u32x2 w; w.x = pk2(a0, a1); w.y = pk2(a2, a3);
            *(u32x2*)(KT + ((size_t)it * 16 + co) * 16 + cb) = w;
            LDS_WAIT();
        }
        for (int it = gw; it < NL * 16 * 16; it += NGW) {
            const int lg = it >> 4, s4 = it & 15;
            float lrdt, lidt, cr, ci; s5_params(p, lg, lane, lrdt, lidt, cr, ci);
            const float* br = p.in[I_BRE] + ((size_t)lg * 64 + lane) * 16; const float* bi = p.in[I_BIM] + ((size_t)lg * 64 + lane) * 16;
            float b0[16], b1[16];
#pragma unroll
            for (int c = 0; c < 16; ++c) { b0[c] = br[c]; b1[c] = bi[c]; }
#pragma unroll 1
            for (int sq = 0; sq < 4; ++sq) { const int s = s4 * 4 + sq;
                float er, ei; s5_pow(lrdt, lidt, 63 - s, er, ei);
                const float fr_ = er * cr - ei * ci, fi_ = er * ci + ei * cr;
                float vr[16], vi[16];
#pragma unroll
                for (int c = 0; c < 16; ++c) { vr[c] = fr_ * b0[c] - fi_ * b1[c]; vi[c] = fr_ * b1[c] + fi_ * b0[c]; }
                bf16_t* o0 = WS_ + (((size_t)lg * 64 + s) * 128 + lane) * 16; bf16_t* o1 = WS_ + (((size_t)lg * 64 + s) * 128 + 64 + lane) * 16;
                u32x4 w;
                w.x = pk2(vr[0], vr[1]); w.y = pk2(vr[2], vr[3]); w.z = pk2(vr[4], vr[5]); w.w = pk2(vr[6], vr[7]); *(u32x4*)o0 = w;
                w.x = pk2(vr[8], vr[9]); w.y = pk2(vr[10], vr[11]); w.z = pk2(vr[12], vr[13]); w.w = pk2(vr[14], vr[15]); *(u32x4*)(o0 + 8) = w;
                w.x = pk2(vi[0], vi[1]); w.y = pk2(vi[2], vi[3]); w.z = pk2(vi[4], vi[5]); w.w = pk2(vi[6], vi[7]); *(u32x4*)o1 = w;
                w.x = pk2(vi[8], vi[9]); w.y = pk2(vi[10], vi[11]); w.z = pk2(vi[12], vi[13]); w.w = pk2(vi[14], vi[15]); *(u32x4*)(o1 + 8) = w; }
        }
        for (int it = gw; it < NL * 16 * 64; it += NGW) {
            const int lg = it >> 6, tl = it & 63;
            float lrdt, lidt, cr, ci; s5_params(p, lg, lane, lrdt, lidt, cr, ci);
            float er, ei; s5_pow(lrdt, lidt, tl + 1, er, ei);
#pragma unroll 4
            for (int co = 0; co < 16; ++co) { const float c0 = p.in[I_CRE][((size_t)lg * 16 + co) * 64 + lane], c1 = p.in[I_CIM][((size_t)lg * 16 + co) * 64 + lane];
                bf16_t* o = WC + (((size_t)lg * 64 + tl) * 16 + co) * 128;
                o[lane] = (bf16_t)f2bf(c0 * er - c1 * ei); o[64 + lane] = (bf16_t)f2bf(-(c0 * ei + c1 * er)); }
        }
    }
}

template <bool OUT>
DI void hgrn_item(const Params& p, LAS unsigned char* lds, int l, int cg) {
    int tid_o = threadIdx.x; asm volatile("" : "+v"(tid_o));
    const int tid = tid_o, lane = tid & 63, wave = tid >> 6, hd = wave >> 1, half = wave & 1;
    const bf16_t* Z = (const bf16_t*)(p.ws + WS_Z);
    LAS bf16_t* B0 = (LAS bf16_t*)(lds + hd * 27648); LAS bf16_t* B1 = B0 + 64 * 72; LAS bf16_t* B2 = B1 + 64 * 72;
    LAS float* GM = (LAS float*)(lds + 114688) + hd * 64; LAS float* GL = GM + 256; LAS float* SSA = (LAS float*)(lds + 114688) + 512;
    bf16_t* SL = (bf16_t*)(p.ws + WS_SL); const bf16_t* SL2 = (const bf16_t*)(p.ws + WS_SL2); float* DEC = (float*)(p.ws + WS_DEC);
    const int item = cg * 4 + hd;
#ifdef FORCE_LB0
    const float lb = 0.f, oml = 1.f;
#else
    const float lb = ((const float*)(p.ws + WS_LB))[l * 256 + hd * 64 + lane], oml = 1.f - lb;
#endif
    const int srow = tid >> 5, shd = (tid >> 3) & 3, spc = tid & 7;
    const bf16_t* zsrc = Z + (size_t)(cg * 64 + srow) * DIN + shd * 64 + spc * 8;
    const int sdst = shd * 27648 + (srow * 72 + spc * 8) * 2;
    u32x4 wsl[4], wg[4];
    if (OUT) { const bf16_t* sp = SL2 + (size_t)item * 4096 + (32 * half) * 64;
#pragma unroll
        for (int e = 0; e < 4; ++e) { wsl[e] = *(const u32x4*)(sp + (lane + 64 * e) * 8); wg[e] = *(const u32x4*)(zsrc + (size_t)(16 * e) * DIN + ZG); } }
    __syncthreads();
    { u32x4 wf[4], wi[4], wq[4];
#pragma unroll
      for (int sub = 0; sub < 4; ++sub) { wf[sub] = *(const u32x4*)(zsrc + (size_t)(16 * sub) * DIN + ZF); wi[sub] = *(const u32x4*)(zsrc + (size_t)(16 * sub) * DIN + ZI);
          if (OUT) wq[sub] = *(const u32x4*)(zsrc + (size_t)(16 * sub) * DIN + ZQ); }
#pragma unroll
      for (int sub = 0; sub < 4; ++sub) { *(LAS u32x4*)(lds + sdst + 9216 + sub * 16 * 144) = wf[sub]; *(LAS u32x4*)(lds + sdst + 18432 + sub * 16 * 144) = wi[sub];
          if (OUT) *(LAS u32x4*)(lds + sdst + sub * 16 * 144) = wq[sub]; } }
    __syncthreads();
    float g[32]; float run = 0.f;
#pragma unroll
    for (int j = 0; j < 32; ++j) { const float fz = bf2f(B1[(half * 32 + j) * 72 + lane]); const float sg = sigmoidf_(fz); const float f = lb + oml * sg;
        run += __logf(fmaxf(f, 1e-30f)); g[j] = run; }
    if (half == 0) GM[lane] = run;
    __syncthreads();
    const float gm = GM[lane];
    if (half) {
#pragma unroll
        for (int j = 0; j < 32; ++j) g[j] += gm; }
    const int c0 = lane & 31, h = lane >> 5;
    if constexpr (!OUT) {
        if (half) GL[lane] = run + gm;
        __syncthreads();
        const float gl = GL[lane];
        bf16_t kv[32], ivr[32];
#pragma unroll
        for (int j = 0; j < 32; ++j) { const int t = half * 32 + j; const float e = __expf(gl - g[j]); const float kj = oml * (1.f - sigmoidf_(bf2f(B1[t * 72 + lane])));
            kv[j] = (bf16_t)f2bf(kj * e); ivr[j] = B2[t * 72 + lane]; }
        __syncthreads();
#pragma unroll
        for (int j = 0; j < 32; ++j) { const int t = half * 32 + j; B1[lane * 72 + t] = kv[j]; B2[lane * 72 + t] = ivr[j]; }
        __syncthreads();
#pragma unroll
        for (int kt = 0; kt < 2; ++kt) { const f32x16 a = mma_lds<64>(B2 + 32 * half * 72, 72, B1 + 32 * kt * 72, 72, zero16(), lane);
#pragma unroll
            for (int i = 0; i < 16; ++i) SL[(size_t)item * 4096 + (32 * half + crow(i, h)) * 64 + 32 * kt + c0] = (bf16_t)f2bf(a[i]); }
        if (half == 0) DEC[item * 64 + lane] = __expf(gl);
    } else {
        if (half == 0) GL[lane] = __expf(gm);
        bf16_t ivr[32];
#pragma unroll
        for (int j = 0; j < 32; ++j) { const int t = half * 32 + j; const float q = bf2f(B0[t * 72 + lane]); const float kj = oml * (1.f - sigmoidf_(bf2f(B1[t * 72 + lane])));
            const float e1 = __expf(fminf(g[j] - gm, 80.f)), e2 = __expf(fminf(gm - g[j], 80.f));
            ivr[j] = B2[t * 72 + lane];
            B0[t * 72 + lane] = (bf16_t)f2bf(q * e1); B1[t * 72 + lane] = (bf16_t)f2bf(kj * e2); }
        __syncthreads();
#pragma unroll
        for (int j = 0; j < 32; ++j) B2[lane * 72 + half * 32 + j] = ivr[j];
        __syncthreads();
        f32x16 s0 = mma_lds<64>(B0 + 32 * half * 72, 72, B1, 72, zero16(), lane);
        f32x16 s1 = zero16(); if (half) s1 = mma_lds<64>(B0 + 32 * half * 72, 72, B1 + 32 * 72, 72, zero16(), lane);
        __syncthreads();
#pragma unroll
        for (int i = 0; i < 16; ++i) { const int row = 32 * half + crow(i, h);
            B1[row * 72 + c0] = (bf16_t)f2bf(c0 <= row ? s0[i] : 0.f); B1[row * 72 + 32 + c0] = (bf16_t)f2bf(32 + c0 <= row ? s1[i] : 0.f); }
        __syncthreads();
        f32x16 o0 = mma_lds<64>(B1 + 32 * half * 72, 72, B2, 72, zero16(), lane);
        f32x16 o1 = mma_lds<64>(B1 + 32 * half * 72, 72, B2 + 32 * 72, 72, zero16(), lane);
        __syncthreads();
        {
#pragma unroll
          for (int e = 0; e < 4; ++e) { const int pc = lane + 64 * e, row = pc >> 3, k0 = (pc & 7) * 8; const LAS float* eg = GL + k0;
              u32x4 o; o.x = pk2(bflo(wsl[e].x) * eg[0], bfhi(wsl[e].x) * eg[1]); o.y = pk2(bflo(wsl[e].y) * eg[2], bfhi(wsl[e].y) * eg[3]);
              o.z = pk2(bflo(wsl[e].z) * eg[4], bfhi(wsl[e].z) * eg[5]); o.w = pk2(bflo(wsl[e].w) * eg[6], bfhi(wsl[e].w) * eg[7]);
              *(LAS u32x4*)(B2 + (32 * half + row) * 72 + k0) = o;
              *(LAS u32x4*)(lds + sdst + 9216 + e * 16 * 144) = wg[e]; } }
        __syncthreads();
        o0 = mma_lds<64>(B0 + 32 * half * 72, 72, B2, 72, o0, lane);
        o1 = mma_lds<64>(B0 + 32 * half * 72, 72, B2 + 32 * 72, 72, o1, lane);
        const float* ng = p.in[I_HNG] + l * 256 + hd * 64; const float ng0 = ng[c0], ng1 = ng[32 + c0];
#pragma unroll
        for (int i = 0; i < 16; ++i) { const int row = 32 * half + crow(i, h);
            const float ss = half_sum(o0[i] * o0[i] + o1[i] * o1[i]); const float rs = rsqrtf(ss * (1.0f / 64.0f) + EPS);
            const float g0 = bf2f(B1[row * 72 + c0]), g1 = bf2f(B1[row * 72 + 32 + c0]);
            const float v0 = o0[i] * rs * ng0 * g0 * sigmoidf_(g0), v1 = o1[i] * rs * ng1 * g1 * sigmoidf_(g1);
            o0[i] = v0; o1[i] = v1; const float s2 = half_sum(v0 * v0 + v1 * v1); if (c0 == 0) SSA[hd * 64 + row] = s2; }
        __syncthreads();
        bf16_t* Y = (bf16_t*)(p.ws + WS_YCAT);
#pragma unroll
        for (int i = 0; i < 16; ++i) { const int row = 32 * half + crow(i, h); const size_t tok = (size_t)cg * 64 + row;
            const float tot = (SSA[row] + SSA[64 + row]) + (SSA[128 + row] + SSA[192 + row]); const float r2 = rsqrtf(tot * (1.0f / 256.0f) + EPS);
            Y[tok * D + YA + hd * 64 + c0] = (bf16_t)f2bf(o0[i] * r2); Y[tok * D + YA + hd * 64 + 32 + c0] = (bf16_t)f2bf(o1[i] * r2); }
    }
}
DI void hgrn_scan_item(const Params& p, int hb) {
    int tid_o = threadIdx.x; asm volatile("" : "+v"(tid_o));
    const int e = hb * 512 + tid_o, bh = e >> 12, b = bh >> 2, hd = bh & 3, vk = e & 4095, k = vk & 63;
    const bf16_t* SL = (const bf16_t*)(p.ws + WS_SL); bf16_t* SL2 = (bf16_t*)(p.ws + WS_SL2); const float* DEC = (const float*)(p.ws + WS_DEC);
    float st = 0.f;
    for (int c8 = 0; c8 < 128; c8 += 16) { float tmp[16], dc[16];
#pragma unroll
        for (int u = 0; u < 16; ++u) { const int item = (b * 128 + c8 + u) * 4 + hd; tmp[u] = bf2f(SL[(size_t)item * 4096 + vk]); dc[u] = DEC[item * 64 + k]; }
#pragma unroll
        for (int u = 0; u < 16; ++u) { const int item = (b * 128 + c8 + u) * 4 + hd; SL2[(size_t)item * 4096 + vk] = (bf16_t)f2bf(st); st = dc[u] * st + tmp[u]; } }
}

DI void conv_item(const Params& p, LAS unsigned char* lds, int l, int ti) {
    int tid_o = threadIdx.x; asm volatile("" : "+v"(tid_o));
    const int tid = tid_o, lane = tid & 63, wave = tid >> 6, c = tid & 255, hf = tid >> 8, wv = wave & 3;
    LAS float* Hs = (LAS float*)lds; LAS float* ST = (LAS float*)(lds + 98304); LAS float* ST2 = ST + 512;
    const bf16_t* Z = (const bf16_t*)(p.ws + WS_Z); bf16_t* Y = (bf16_t*)(p.ws + WS_YCAT);
    const int tok0 = ti * 64, pos0 = (ti & 127) * 64;
    const float* cw = p.in[I_CW] + (size_t)l * 31 * 256 + c; float w[31];
#pragma unroll
    for (int jj = 0; jj < 31; ++jj) w[jj] = cw[jj * 256];
    const float cb = p.in[I_CB][l * 256 + c];
    const float lng = p.in[I_CLG][l * 256 + c], lnb = p.in[I_CLB][l * 256 + c];
    __syncthreads();
    { u32x4 vw[6], gw_[6];
#pragma unroll
      for (int k = 0; k < 6; ++k) { const int pid = tid + 512 * k, row = pid >> 5, pc = pid & 31, pos = pos0 - 30 + row; const bool ok = (row < 94) && (pos >= 0);
          const size_t tok = ok ? (size_t)(tok0 - 30 + row) : (size_t)tok0; vw[k] = *(const u32x4*)(Z + tok * DIN + ZBV + pc * 8); gw_[k] = *(const u32x4*)(Z + tok * DIN + ZBG + pc * 8); }
#pragma unroll
      for (int k = 0; k < 6; ++k) { const int pid = tid + 512 * k, row = pid >> 5, pc = pid & 31, pos = pos0 - 30 + row; const bool ok = (row < 94) && (pos >= 0);
          if (row < 94) { f32x4 h0, h1;
              h0[0] = bflo(vw[k].x) * sigmoidf_(bflo(gw_[k].x)); h0[1] = bfhi(vw[k].x) * sigmoidf_(bfhi(gw_[k].x)); h0[2] = bflo(vw[k].y) * sigmoidf_(bflo(gw_[k].y)); h0[3] = bfhi(vw[k].y) * sigmoidf_(bfhi(gw_[k].y));
              h1[0] = bflo(vw[k].z) * sigmoidf_(bflo(gw_[k].z)); h1[1] = bfhi(vw[k].z) * sigmoidf_(bfhi(gw_[k].z)); h1[2] = bflo(vw[k].w) * sigmoidf_(bflo(gw_[k].w)); h1[3] = bfhi(vw[k].w) * sigmoidf_(bfhi(gw_[k].w));
              if (!ok) { h0 = (f32x4){0.f, 0.f, 0.f, 0.f}; h1 = h0; }
              *(LAS f32x4*)(Hs + row * 256 + pc * 8) = h0; *(LAS f32x4*)(Hs + row * 256 + pc * 8 + 4) = h1; } } }
    __syncthreads();
    LAS float* OT2 = (LAS float*)(lds + 98304);
    LAS float* STAT = (LAS float*)(lds + 131072); LAS float* STAT2 = STAT + 64;
    const int rtl = tid >> 4, rpart = tid & 15;
#pragma unroll 1
    for (int ps = 0; ps < 2; ++ps) { const int tb = hf * 32 + ps * 16;
        float o[16];
        { float hr[46];
#pragma unroll
          for (int r = 0; r < 46; ++r) hr[r] = Hs[(tb + r) * 256 + c];
#pragma unroll
          for (int j = 0; j < 16; ++j) { float a = cb;
#pragma unroll
            for (int jj = 0; jj < 31; ++jj) a += w[jj] * hr[j + jj];
            o[j] = a; } }
#pragma unroll
        for (int j = 0; j < 16; ++j) OT2[(hf * 16 + j) * 256 + c] = o[j];
        __syncthreads();
        { const LAS f32x4* q = (const LAS f32x4*)(OT2 + rtl * 256 + rpart * 16); float s1 = 0.f, s2 = 0.f;
#pragma unroll
          for (int e = 0; e < 4; ++e) { const f32x4 v = q[e]; s1 += (v[0] + v[1]) + (v[2] + v[3]); s2 += (v[0] * v[0] + v[1] * v[1]) + (v[2] * v[2] + v[3] * v[3]); }
          s1 = sum16_(s1); s2 = sum16_(s2);
          if (rpart == 0) { const float mu = s1 * (1.0f / 256.0f); const float var = fmaxf(s2 * (1.0f / 256.0f) - mu * mu, 0.f); STAT[rtl * 2] = mu; STAT[rtl * 2 + 1] = rsqrtf(var + EPS); } }
        __syncthreads();
#pragma unroll
        for (int j = 0; j < 16; ++j) { const float mu = STAT[(hf * 16 + j) * 2], rsd = STAT[(hf * 16 + j) * 2 + 1];
            const float y = (o[j] - mu) * rsd * lng + lnb; const float sv = y * sigmoidf_(y); o[j] = sv; OT2[(hf * 16 + j) * 256 + c] = sv; }
        __syncthreads();
        { const LAS f32x4* q = (const LAS f32x4*)(OT2 + rtl * 256 + rpart * 16); float s3 = 0.f;
#pragma unroll
          for (int e = 0; e < 4; ++e) { const f32x4 v = q[e]; s3 += (v[0] * v[0] + v[1] * v[1]) + (v[2] * v[2] + v[3] * v[3]); }
          s3 = sum16_(s3);
          if (rpart == 0) STAT2[rtl] = rsqrtf(s3 * (1.0f / 256.0f) + EPS); }
        __syncthreads();
#pragma unroll
        for (int j = 0; j < 16; ++j) Y[(size_t)(tok0 + tb + j) * D + YB + c] = (bf16_t)f2bf(o[j] * STAT2[hf * 16 + j]);
    }
}

DI bf16x8 ldg8(const bf16_t* p) { return *(const bf16x8*)p; }
DI void s5_local_item(const Params& p, LAS unsigned char* lds, int l, int bi) {
    int tid_o = threadIdx.x; asm volatile("" : "+v"(tid_o));
    const int tid = tid_o, lane = tid & 63, wave = tid >> 6;
    const int gh = bi & 1, cb = (bi >> 1) & 15, pt = bi >> 5, g = gh * 8 + wave, c0 = lane & 31, h = lane >> 5, lg = l * 16 + g;
    LAS bf16_t* UT = (LAS bf16_t*)lds;
    const bf16_t* Z = (const bf16_t*)(p.ws + WS_Z);
    const int sm = tid >> 4, spc = tid & 15;
    const bf16_t* zst = Z + (size_t)((cb * 32 + sm) * 64) * DIN + ZCU + gh * 128 + spc * 8;
    const int ust = (sm * 136 + spc * 8) * 2;
    const bf16_t* wsp = (const bf16_t*)(p.ws + WS_S5WS) + ((size_t)lg * 64 * 128 + pt * 32 + c0) * 16 + 8 * h;
    u32x4 pf[8];
#pragma unroll
    for (int e = 0; e < 8; ++e) pf[e] = *(const u32x4*)(zst + (size_t)e * DIN);
    f32x16 acc = zero16();
    __syncthreads();
    for (int b = 0; b < 8; ++b) { const int s0 = 8 * b;
#pragma unroll
        for (int e = 0; e < 8; ++e) *(LAS u32x4*)(lds + ust + e * (32 * 136 * 2)) = pf[e];
        __syncthreads();
        if (b + 1 < 8) {
#pragma unroll
            for (int e = 0; e < 8; ++e) pf[e] = *(const u32x4*)(zst + (size_t)(s0 + 8 + e) * DIN); }
        bf16x8 bf[8];
#pragma unroll
        for (int e = 0; e < 8; ++e) bf[e] = ldg8(wsp + (size_t)(s0 + e) * 2048);
#pragma unroll
        for (int e = 0; e < 8; ++e) acc = __builtin_amdgcn_mfma_f32_32x32x16_bf16(*(const LAS bf16x8*)(UT + (e * 32 + c0) * 136 + wave * 16 + 8 * h), bf[e], acc, 0, 0, 0);
        __syncthreads();
    }
    float* HL = (float*)(p.ws + WS_S5H);
#pragma unroll
    for (int i = 0; i < 16; ++i) HL[((size_t)(cb * 32 + crow(i, h)) * 16 + g) * 128 + pt * 32 + c0] = acc[i];
}
DI void s5_scan_item(const Params& p, int l, int sb) {
    int tid_o = threadIdx.x; asm volatile("" : "+v"(tid_o));
    const int e = sb * 512 + tid_o, b = e >> 10, g = (e >> 6) & 15, pp = e & 63;
    float lrdt, lidt, cr, ci; s5_params(p, l * 16 + g, pp, lrdt, lidt, cr, ci);
    float ar, ai; s5_pow(lrdt, lidt, 64, ar, ai);
    const float* HL = (const float*)(p.ws + WS_S5H); float* HO = (float*)(p.ws + WS_S5H2); float hr = 0.f, hi = 0.f;
    for (int c8 = 0; c8 < 128; c8 += 16) { float tr[16], ti[16];
#pragma unroll
        for (int u = 0; u < 16; ++u) { const size_t idx = ((size_t)(b * 128 + c8 + u) * 16 + g) * 128; tr[u] = HL[idx + pp]; ti[u] = HL[idx + 64 + pp]; }
#pragma unroll
        for (int u = 0; u < 16; ++u) { const size_t idx = ((size_t)(b * 128 + c8 + u) * 16 + g) * 128; HO[idx + pp] = hr; HO[idx + 64 + pp] = hi;
            const float nr = ar * hr - ai * hi + tr[u], ni = ar * hi + ai * hr + ti[u]; hr = nr; hi = ni; } }
}
DI void s5_out_item(const Params& p, LAS unsigned char* lds, int l, int bi) {
    int tid_o = threadIdx.x; asm volatile("" : "+v"(tid_o));
    const int tid = tid_o, lane = tid & 63, wave = tid >> 6;
    const int gh = bi & 1, cb = (bi >> 1) & 15, pr = bi >> 5, g = gh * 8 + wave, c0 = lane & 31, h = lane >> 5, lg = l * 16 + g;
    LAS bf16_t* UT = (LAS bf16_t*)lds;
    LAS bf16_t* OT = (LAS bf16_t*)(lds + 69632);
    const bf16_t* Z = (const bf16_t*)(p.ws + WS_Z);
    const bf16_t* kt = (const bf16_t*)(p.ws + WS_S5K) + (size_t)lg * 64 * 256;
    const float* ha = (const float*)(p.ws + WS_S5H2) + ((size_t)(cb * 32 + c0) * 16 + g) * 128 + 8 * h;
    const int co = c0 & 15; const float dsk = p.in[I_S5D][l * 256 + g * 16 + co];
    const int jt0 = pr, jt1 = 31 - pr, tl0 = 2 * jt0 + (c0 >> 4), tl1 = 2 * jt1 + (c0 >> 4);
    const int sm = tid >> 4, spc = tid & 15;
    const bf16_t* zst = Z + (size_t)((cb * 32 + sm) * 64) * DIN + ZCU + gh * 128 + spc * 8;
    const int ust = (sm * 136 + spc * 8) * 2;
    const int nb = (2 * jt1 + 2 + 7) >> 3;
    u32x4 pf[8];
#pragma unroll
    for (int e = 0; e < 8; ++e) pf[e] = *(const u32x4*)(zst + (size_t)e * DIN);
    f32x16 acc0 = zero16(), acc1 = zero16();
    { const bf16_t* wc0 = (const bf16_t*)(p.ws + WS_S5WC) + (((size_t)lg * 64 + tl0) * 16 + co) * 128 + 8 * h;
      const bf16_t* wc1 = (const bf16_t*)(p.ws + WS_S5WC) + (((size_t)lg * 64 + tl1) * 16 + co) * 128 + 8 * h;
      f32x4 x0[8], x1[8];
#pragma unroll
      for (int ks = 0; ks < 8; ++ks) { x0[ks] = *(const f32x4*)(ha + ks * 16); x1[ks] = *(const f32x4*)(ha + ks * 16 + 4); }
#pragma unroll
      for (int ks = 0; ks < 8; ++ks) { u32x4 w; w.x = pk2(x0[ks][0], x0[ks][1]); w.y = pk2(x0[ks][2], x0[ks][3]); w.z = pk2(x1[ks][0], x1[ks][1]); w.w = pk2(x1[ks][2], x1[ks][3]);
        const bf16x8 af = __builtin_bit_cast(bf16x8, w);
        acc0 = __builtin_amdgcn_mfma_f32_32x32x16_bf16(af, ldg8(wc0 + ks * 16), acc0, 0, 0, 0);
        acc1 = __builtin_amdgcn_mfma_f32_32x32x16_bf16(af, ldg8(wc1 + ks * 16), acc1, 0, 0, 0); } }
    __syncthreads();
    for (int b = 0; b < nb; ++b) { const int s0 = 8 * b;
#pragma unroll
        for (int e = 0; e < 8; ++e) *(LAS u32x4*)(lds + ust + e * (32 * 136 * 2)) = pf[e];
        __syncthreads();
        if (b + 1 < nb) {
#pragma unroll
            for (int e = 0; e < 8; ++e) pf[e] = *(const u32x4*)(zst + (size_t)(s0 + 8 + e) * DIN); }
        const bool use0 = s0 <= 2 * jt0 + 1;
        bf16x8 b0[8], b1[8];
#pragma unroll
        for (int e = 0; e < 8; ++e) { const int d1 = tl1 - (s0 + e); b1[e] = ldg8(kt + ((size_t)(d1 < 0 ? 0 : d1) * 16 + co) * 16 + 8 * h);
            if (use0) { const int d0 = tl0 - (s0 + e); b0[e] = ldg8(kt + ((size_t)(d0 < 0 ? 0 : d0) * 16 + co) * 16 + 8 * h); } }
#pragma unroll
        for (int e = 0; e < 8; ++e) { const bf16x8 af = *(const LAS bf16x8*)(UT + (e * 32 + c0) * 136 + wave * 16 + 8 * h);
            const int d1 = tl1 - (s0 + e); bf16x8 bb = b1[e]; if (d1 < 0) bb = (bf16x8){0, 0, 0, 0, 0, 0, 0, 0};
            acc1 = __builtin_amdgcn_mfma_f32_32x32x16_bf16(af, bb, acc1, 0, 0, 0);
            if (use0) { const int d0 = tl0 - (s0 + e); bf16x8 ba = b0[e]; if (d0 < 0) ba = (bf16x8){0, 0, 0, 0, 0, 0, 0, 0};
                acc0 = __builtin_amdgcn_mfma_f32_32x32x16_bf16(af, ba, acc0, 0, 0, 0); } }
        __syncthreads();
    }
#pragma unroll
    for (int q = 0; q < 2; ++q) { const int tl = q ? tl1 : tl0;
#pragma unroll
        for (int i = 0; i < 16; ++i) { const int m = crow(i, h); const size_t tok = (size_t)(cb * 32 + m) * 64 + tl; const float u = bf2f(Z[tok * DIN + ZCU + g * 16 + co]);
            const float y = (q ? acc1[i] : acc0[i]) + dsk * u; const float ge = y * sigmoidf_(1.5957691216057308f * (y + 0.044715f * y * y * y));
            OT[(q * 64 + m * 2 + (c0 >> 4)) * 136 + wave * 16 + co] = (bf16_t)f2bf(ge); } }
    __syncthreads();
    { const int tau = tid >> 2, qq = tau >> 6, m = (tau >> 1) & 31, t2 = tau & 1, qt = tid & 3; const int jt = qq ? jt1 : jt0;
      const size_t tok = (size_t)(cb * 32 + m) * 64 + 2 * jt + t2;
      const LAS u32x4* src = (const LAS u32x4*)(OT + tau * 136 + qt * 32); u32x4* dst = (u32x4*)((bf16_t*)(p.ws + WS_YPRE) + tok * 256 + gh * 128 + qt * 32);
#pragma unroll
      for (int e = 0; e < 4; ++e) dst[e] = src[e]; }
}

DI void attn_item(const Params& p, LAS unsigned char* lds, int l, int pt, int id) {
    int tid_o = threadIdx.x; asm volatile("" : "+v"(tid_o));
    const int tid = tid_o, lane = tid & 63, wave = tid >> 6;
    const int dil = pt == 0 ? 1 : (pt == 1 ? 4 : 16), nblk = 32 / dil;
    const int b = id >> 7, hd = (id >> 5) & 3, rn = id & 31, r = rn / nblk, n = rn % nblk;
    LAS bf16_t* Ks = (LAS bf16_t*)lds;
    LAS bf16_t* Vt = (LAS bf16_t*)(lds + 55296);
    LAS float* BT = (LAS float*)(lds + 55296 + 50176);
    const bf16_t* Z = (const bf16_t*)(p.ws + WS_Z);
    const bf16_t* OP = (const bf16_t*)(p.ws + (pt == 1 ? WS_O0 : WS_O1)); const float* LP = (const float*)(p.ws + (pt == 1 ? WS_LSE : WS_LSE1));
    bf16_t* ON = pt == 2 ? (bf16_t*)(p.ws + WS_Z) + ZOD : (bf16_t*)(p.ws + (pt == 0 ? WS_O0 : WS_O1)); const int onp = pt == 2 ? DIN : 256;
    float* LN = (float*)(p.ws + (pt == 0 ? WS_LSE : WS_LSE1));
    const size_t tokb = (size_t)b * SEQ;
    const int c0 = lane & 31, h = lane >> 5;
    const int qi = 32 * wave + c0; const size_t tokq = tokb + (size_t)(n * 256 + qi) * dil + r;
    u32x4 qraw[4]; u32x2 oprev[2][4]; float mprev = 0.f;
#pragma unroll
    for (int ks = 0; ks < 4; ++ks) qraw[ks] = *(const u32x4*)(Z + tokq * DIN + ZDQ + hd * 64 + ks * 16 + 8 * h);
    if (pt > 0) { mprev = LP[tokq * 4 + hd];
#pragma unroll
        for (int vt = 0; vt < 2; ++vt)
#pragma unroll
            for (int g4 = 0; g4 < 4; ++g4) oprev[vt][g4] = *(const u32x2*)(OP + tokq * 256 + hd * 64 + 32 * vt + 8 * g4 + 4 * h); }
    __syncthreads();
    if (tid < 132) BT[tid] = ((const float*)(p.ws + WS_BIAS))[(pt * 4 + hd) * 132 + tid];
    { const float* kg = p.in[I_KG] + l * 64 + (tid & 7) * 8; float kgv[8];
#pragma unroll
      for (int e = 0; e < 8; ++e) kgv[e] = kg[e];
      u32x4 kwv[6], vwv[6];
#pragma unroll
      for (int it = 0; it < 6; ++it) { const int idx = tid + 512 * it, row = idx >> 3, c = idx & 7, si = n * 256 - 128 + row;
        const size_t tok = tokb + (size_t)(si < 0 ? 0 : si) * dil + r;
        kwv[it] = *(const u32x4*)(Z + tok * DIN + ZDK + hd * 64 + c * 8); vwv[it] = *(const u32x4*)(Z + tok * DIN + ZDV + hd * 64 + c * 8); }
#pragma unroll
      for (int it = 0; it < 6; ++it) { const int idx = tid + 512 * it, row = idx >> 3, c = idx & 7, si = n * 256 - 128 + row;
        u32x4 kw = kwv[it], vw = vwv[it];
        if (si < 0) { kw = (u32x4){0u, 0u, 0u, 0u}; vw = (u32x4){0u, 0u, 0u, 0u}; }
        float kf[8]; kf[0] = bflo(kw.x); kf[1] = bfhi(kw.x); kf[2] = bflo(kw.y); kf[3] = bfhi(kw.y); kf[4] = bflo(kw.z); kf[5] = bfhi(kw.z); kf[6] = bflo(kw.w); kf[7] = bfhi(kw.w);
        float ss = 0.f;
#pragma unroll
        for (int e = 0; e < 8; ++e) ss += kf[e] * kf[e];
        ss = sum8_(ss);
        const float rs = rsqrtf(ss * (1.0f / 64.0f) + EPS);
        u32x4 o; o.x = pk2(kf[0] * rs * kgv[0], kf[1] * rs * kgv[1]); o.y = pk2(kf[2] * rs * kgv[2], kf[3] * rs * kgv[3]); o.z = pk2(kf[4] * rs * kgv[4], kf[5] * rs * kgv[5]); o.w = pk2(kf[6] * rs * kgv[6], kf[7] * rs * kgv[7]);
        *(LAS u32x4*)(Ks + row * 72 + c * 8) = o;
        LAS bf16_t* vp = Vt + (c * 8) * 392 + row;
        vp[0 * 392] = (bf16_t)(vw.x & 0xffffu); vp[1 * 392] = (bf16_t)(vw.x >> 16); vp[2 * 392] = (bf16_t)(vw.y & 0xffffu); vp[3 * 392] = (bf16_t)(vw.y >> 16);
        vp[4 * 392] = (bf16_t)(vw.z & 0xffffu); vp[5 * 392] = (bf16_t)(vw.z >> 16); vp[6 * 392] = (bf16_t)(vw.w & 0xffffu); vp[7 * 392] = (bf16_t)(vw.w >> 16); } }
    __syncthreads();
    bf16x8 qf[4];
    { float qv[4][8]; float ss = 0.f;
#pragma unroll
      for (int ks = 0; ks < 4; ++ks) { const u32x4 w = qraw[ks];
        qv[ks][0] = bflo(w.x); qv[ks][1] = bfhi(w.x); qv[ks][2] = bflo(w.y); qv[ks][3] = bfhi(w.y); qv[ks][4] = bflo(w.z); qv[ks][5] = bfhi(w.z); qv[ks][6] = bflo(w.w); qv[ks][7] = bfhi(w.w);
#pragma unroll
        for (int e = 0; e < 8; ++e) ss += qv[ks][e] * qv[ks][e]; }
      ss += __shfl_xor(ss, 32);
      const float rs = rsqrtf(ss * (1.0f / 64.0f) + EPS) * 0.125f;
#pragma unroll
      for (int ks = 0; ks < 4; ++ks) { const float* qg = p.in[I_QG] + l * 64 + ks * 16 + 8 * h; const f32x4 g0 = *(const f32x4*)qg, g1 = *(const f32x4*)(qg + 4);
        u32x4 w; w.x = pk2(qv[ks][0] * rs * g0[0], qv[ks][1] * rs * g0[1]); w.y = pk2(qv[ks][2] * rs * g0[2], qv[ks][3] * rs * g0[3]);
        w.z = pk2(qv[ks][4] * rs * g1[0], qv[ks][5] * rs * g1[1]); w.w = pk2(qv[ks][6] * rs * g1[2], qv[ks][7] * rs * g1[3]);
        qf[ks] = __builtin_bit_cast(bf16x8, w); } }
    f32x16 acc[5];
#pragma unroll
    for (int c = 0; c < 5; ++c) { acc[c] = zero16(); const LAS bf16_t* kb = Ks + (32 * wave + 32 * c + c0) * 72 + 8 * h;
#pragma unroll
        for (int ks = 0; ks < 4; ++ks) acc[c] = __builtin_amdgcn_mfma_f32_32x32x16_bf16(*(const LAS bf16x8*)(kb + ks * 16), qf[ks], acc[c], 0, 0, 0); }
    float mx = -1e30f;
    { const int tq = c0 - 4 * h, kmin = 128 - n * 256; const LAS float* pb = BT + tq - 32;
#pragma unroll
      for (int c = 0; c < 5; ++c) { const int th = kmin - (32 * wave + 32 * c) - 4 * h;
#pragma unroll
        for (int i = 0; i < 16; ++i) { const int ci = (i & 3) + 8 * (i >> 2);
            bool valid = ci >= th;
            if (c == 0) valid = valid && (tq <= ci);
            if (c == 4) valid = valid && (tq >= ci);
            const float lgt = valid ? acc[c][i] + pb[160 - 32 * c - ci] : -1e30f; acc[c][i] = lgt; mx = fmaxf(mx, lgt); } } }
    mx = fmaxf(mx, __shfl_xor(mx, 32));
    float mnew = mx;
    if (pt > 0) mnew = fmaxf(mx, mprev);
    float lsum = 0.f;
#pragma unroll
    for (int c = 0; c < 5; ++c)
#pragma unroll
        for (int i = 0; i < 16; ++i) { const float pv = __expf(acc[c][i] - mnew); acc[c][i] = pv; lsum += pv; }
    lsum += __shfl_xor(lsum, 32);
    f32x16 o[2]; o[0] = zero16(); o[1] = zero16();
#pragma unroll
    for (int c = 0; c < 5; ++c)
#pragma unroll
        for (int s = 0; s < 2; ++s) { u32x4 pw; pw.x = pk2(acc[c][8 * s + 0], acc[c][8 * s + 1]); pw.y = pk2(acc[c][8 * s + 2], acc[c][8 * s + 3]); pw.z = pk2(acc[c][8 * s + 4], acc[c][8 * s + 5]); pw.w = pk2(acc[c][8 * s + 6], acc[c][8 * s + 7]);
            const bf16x8 pf = __builtin_bit_cast(bf16x8, pw);
#pragma unroll
            for (int vt = 0; vt < 2; ++vt) { const LAS bf16_t* va = Vt + (32 * vt + c0) * 392 + 32 * wave + 32 * c + 16 * s + 4 * h;
                const s16x4 lo = *(const LAS s16x4*)va, hi = *(const LAS s16x4*)(va + 8);
                const bf16x8 vf = __builtin_shufflevector(lo, hi, 0, 1, 2, 3, 4, 5, 6, 7);
                o[vt] = __builtin_amdgcn_mfma_f32_32x32x16_bf16(vf, pf, o[vt], 0, 0, 0); } }
    float sp = 0.f; if (pt > 0) sp = __expf(mprev - mnew);
    const float ltot = lsum + sp, inv = __builtin_amdgcn_rcpf(ltot);
#pragma unroll
    for (int vt = 0; vt < 2; ++vt)
#pragma unroll
        for (int g4 = 0; g4 < 4; ++g4) { const int ch = hd * 64 + 32 * vt + 8 * g4 + 4 * h; bf16_t* yo = ON + tokq * onp + ch;
            float v0 = o[vt][4 * g4 + 0], v1 = o[vt][4 * g4 + 1], v2 = o[vt][4 * g4 + 2], v3 = o[vt][4 * g4 + 3];
            if (pt > 0) { const u32x2 w = oprev[vt][g4]; v0 += sp * bflo(w.x); v1 += sp * bfhi(w.x); v2 += sp * bflo(w.y); v3 += sp * bfhi(w.y); }
            u32x2 w; w.x = pk2(v0 * inv, v1 * inv); w.y = pk2(v2 * inv, v3 * inv); *(u32x2*)yo = w; }
    if (h == 0 && pt < 2) __hip_atomic_store(LN + tokq * 4 + hd, mnew + __logf(ltot), __ATOMIC_RELAXED, __HIP_MEMORY_SCOPE_AGENT);
}

#define RLX_AGENT __ATOMIC_RELAXED, __HIP_MEMORY_SCOPE_AGENT
#define XB_TMO      128
#define XB_XCNT(j)  (256  + 64 * (j))
#define XB_XSUB(j)  (1280 + 64 * (j))
#define XB_XGEN(j)  (2304 + 64 * (j))
#define XB_TOP      3328
#define XB_TOPGEN   3392
#define XCD_BAR_WORDS 3456
#define XB_SPIN_CAP (1u << 18)

__device__ __forceinline__ unsigned xb_ld(unsigned* p)              { return __hip_atomic_load(p, __ATOMIC_RELAXED, __HIP_MEMORY_SCOPE_AGENT); }
__device__ __forceinline__ unsigned xb_add(unsigned* p, unsigned v) { return __hip_atomic_fetch_add(p, v, __ATOMIC_RELAXED, __HIP_MEMORY_SCOPE_AGENT); }
__device__ __forceinline__ unsigned xb_xcc_id() { return (unsigned)__builtin_amdgcn_s_getreg((3 << 11) | 20) & 0xFu; }
#define XB_SPIN(cond, bar) do { unsigned _sp = 0; while (cond) { __builtin_amdgcn_s_sleep(1); \
    if ((++_sp & 255u) == 0u) { if (xb_ld(&(bar)[XB_TMO])) break; if (_sp > XB_SPIN_CAP) { atomicAdd(&(bar)[XB_TMO], 1u); break; } } } } while (0)

struct XcdBarrier {
    unsigned* bar; unsigned x;
    volatile LAS unsigned* st;
};

__device__ __forceinline__ XcdBarrier xcd_barrier_post(unsigned* bar, volatile LAS unsigned* st) {
    XcdBarrier b; b.bar = bar; b.x = xb_xcc_id(); b.st = st;
    if (threadIdx.x == 0) (void)xb_add(&bar[XB_XCNT(b.x)], 1u);
    return b;
}
__device__ __forceinline__ void xcd_barrier_complete(unsigned* bar, unsigned x, unsigned& nloc, unsigned& nx) {
    const unsigned G = gridDim.x * gridDim.y * gridDim.z;
    unsigned sum, cnt, mine, sp = 0u;
    for (;;) {
        sum = 0u; cnt = 0u; mine = 0u;
#pragma unroll
        for (unsigned j = 0; j < 16; ++j) { const unsigned c = xb_ld(&bar[XB_XCNT(j)]); sum += c; cnt += (c > 0u) ? 1u : 0u; mine = (j == x) ? c : mine; }
        if (sum == G) break;
        __builtin_amdgcn_s_sleep(1);
        if ((++sp & 255u) == 0u) { if (xb_ld(&bar[XB_TMO])) break; if (sp > XB_SPIN_CAP) { atomicAdd(&bar[XB_TMO], 1u); break; } }
    }
    nloc = mine > 0u ? mine : 1u; nx = cnt > 0u ? cnt : 1u;
}

__device__ __forceinline__ void xcd_barrier(const XcdBarrier& b) {
    asm volatile("s_waitcnt vmcnt(0)" ::: "memory");
    __syncthreads();
    if (threadIdx.x == 0) {
        unsigned* bar = b.bar;
        __builtin_amdgcn_s_waitcnt(0);
        unsigned nloc = b.st[0], nx = b.st[1];
        if (nloc == 0u) { xcd_barrier_complete(bar, b.x, nloc, nx); b.st[0] = nloc; b.st[1] = nx; }
        const unsigned old = xb_add(&bar[XB_XSUB(b.x)], 1u);
        const unsigned gen = old / nloc;
        if (old + 1u == (gen + 1u) * nloc) {
            __builtin_amdgcn_fence(__ATOMIC_RELEASE, "agent");
            asm volatile("s_waitcnt vmcnt(0)" ::: "memory");
            const unsigned og = xb_add(&bar[XB_TOP], 1u);
            const unsigned tg = og / nx;
            if (og + 1u == (tg + 1u) * nx) xb_add(&bar[XB_TOPGEN], 1u);
            else XB_SPIN(xb_ld(&bar[XB_TOPGEN]) == tg, bar);
            __builtin_amdgcn_fence(__ATOMIC_ACQUIRE, "agent");
            xb_add(&bar[XB_XGEN(b.x)], 1u);
            asm volatile("s_waitcnt vmcnt(0)" ::: "memory");
        } else {
            XB_SPIN(xb_ld(&bar[XB_XGEN(b.x)]) == gen, bar);
            __builtin_amdgcn_fence(__ATOMIC_ACQUIRE, "agent");
            asm volatile("s_waitcnt vmcnt(0)" ::: "memory");
        }
    }
    __syncthreads();
}

#ifndef REP_A
#define REP_A 0
#endif
#ifndef REP_B
#define REP_B 0
#endif
#ifndef REP_C
#define REP_C 0
#endif
#ifndef REP_D
#define REP_D 0
#endif
#ifndef MIX_A
#define MIX_A 1
#endif
#ifndef MIX_B
#define MIX_B 1
#endif
#ifndef MIX_C
#define MIX_C 1
#endif
#ifndef MIX_D
#define MIX_D 1
#endif
__global__ void __launch_bounds__(512, 2) hybrid_fwd(Params p) {
    extern __shared__ __attribute__((aligned(16))) unsigned char lds_raw[];
    LAS unsigned char* lds = (LAS unsigned char*)lds_raw;
    cg::grid_group grid = cg::this_grid();
    { volatile LAS unsigned* st0 = (volatile LAS unsigned*)(lds + LDS_BYTES - 64); if (threadIdx.x < 2) st0[threadIdx.x] = 0u; }
    __syncthreads();
    (void)xcd_barrier_post((unsigned*)(p.ws + WS_BAR), (volatile LAS unsigned*)(lds + LDS_BYTES - 64));
    const int G = gridDim.x, bid = blockIdx.x;
    unsigned char* ws = p.ws;
    bf16_t* XB = (bf16_t*)(ws + WS_XB); bf16_t* Zb = (bf16_t*)(ws + WS_Z); bf16_t* YC_ = (bf16_t*)(ws + WS_YCAT); bf16_t* HM = (bf16_t*)(ws + WS_HM);
    float* SSQP = (float*)(ws + WS_SSQP);

#define GRID_SYNC_() do { asm volatile("s_waitcnt vmcnt(0) lgkmcnt(0)" ::: "memory"); grid.sync(); if (threadIdx.x < 64) { __builtin_amdgcn_fence(__ATOMIC_ACQUIRE, "agent"); asm volatile("s_waitcnt vmcnt(0)" ::: "memory"); } __syncthreads(); } while (0)
#define XBAR_ONCE() do { XcdBarrier b_; b_.bar = (unsigned*)(p.ws + WS_BAR); b_.x = xb_xcc_id(); b_.st = (volatile LAS unsigned*)(lds + LDS_BYTES - 64); xcd_barrier(b_); } while (0)
#ifdef REP_SYNC
#define GRID_SYNC() do { XBAR_ONCE(); XBAR_ONCE(); } while (0)
#else
#define GRID_SYNC() XBAR_ONCE()
#endif
    prologue(p, lds, G);
#ifdef REP_PRO
    GRID_SYNC_(); prologue(p, lds, G);
#endif
#ifdef NANFILL
    { u32x4* q = (u32x4*)(ws + WS_S5H); const size_t n16 = (WS_END - WS_S5H) / 16; const u32x4 nanv = (u32x4){0xffffffffu, 0xffffffffu, 0xffffffffu, 0xffffffffu};
      for (size_t i = (size_t)bid * 512 + threadIdx.x; i < n16; i += (size_t)G * 512) q[i] = nanv;
      u32x4* q2 = (u32x4*)(ws + WS_LSE); const size_t m16 = (WS_S5K - WS_LSE) / 16;
      for (size_t i = (size_t)bid * 512 + threadIdx.x; i < m16; i += (size_t)G * 512) q2[i] = nanv; }
#endif
    if (gridDim.y == 0x7fffffffu) GRID_SYNC_();
    GRID_SYNC();

#ifndef NL_RUN
#define NL_RUN NL
#endif
#ifndef DUMP_LAYER
#define DUMP_LAYER 0
#endif
    for (int lrun = 0; lrun < NL_RUN; ++lrun) {
#ifdef SAME_LAYER
        const int l = 0; const bool firstl = (lrun == 0), lastl = (lrun == NL_RUN - 1);
#else
        const int l = lrun; const bool firstl = (lrun == 0), lastl = (lrun == NL_RUN - 1);
#endif
#define RS_TABLE(SSQ_, NUNITS_) \
          { pg8::Unit ua_, ub_; (void)S.next(0, ua_); (void)S.next((NUNITS_) - 1, ub_); \
              int tq_ = threadIdx.x; asm volatile("" : "+v"(tq_)); const int pm_ = (tq_ >> 8) ? ub_.pm : ua_.pm; \
              const f32x4* sq_ = (const f32x4*)((SSQ_) + ((size_t)pm_ * 256 + (tq_ & 255)) * 16); const f32x4 q0 = sq_[0], q1 = sq_[1], q2 = sq_[2], q3 = sq_[3]; \
              const float tot_ = (((q0[0] + q0[1]) + (q0[2] + q0[3])) + ((q1[0] + q1[1]) + (q1[2] + q1[3]))) + (((q2[0] + q2[1]) + (q2[2] + q2[3])) + ((q3[0] + q3[1]) + (q3[2] + q3[3]))); \
              ((LAS float*)(lds + 131072))[tq_] = rsqrtf(tot_ * (1.0f / 1024.0f) + EPS); __syncthreads(); }
        { pg8::Gemm g{XB, (const bf16_t*)(ws + WS_WIN) + (size_t)l * D * DIN, T, DIN, D, D}; pg8::StaticOrder S; S.init(T, DIN, G, bid);
          RS_TABLE(SSQP, (T / 256) * (DIN / 256) / 256)
          pg8::EpiScale E{Zb, DIN, 0, (const PG8_LAS float*)(lds + 131072)};
          pg8::gemm_phase<pg8::EpiScale, pg8::StaticOrder, true, true>(lds, g, S, E);
#ifdef REPEAT_GEMM
          GRID_SYNC(); pg8::gemm_phase<pg8::EpiScale, pg8::StaticOrder, true, true>(lds, g, S, E);
#endif
        }
        GRID_SYNC();
#ifndef SKIP_MIX
        if (!(MIX_A && MIX_B && MIX_C && MIX_D)) { int tq = threadIdx.x; asm volatile("" : "+v"(tq));
          for (int m = bid * 8 + (tq >> 6); m < T; m += G * 8) { u32x2* yp = (u32x2*)(YC_ + (size_t)m * D) + (tq & 63); const u32x2 z2 = (u32x2){0u, 0u};
              if (!MIX_A) yp[0] = z2; if (!MIX_B) yp[64] = z2; if (!MIX_C) yp[128] = z2; if (!MIX_D) yp[192] = z2; } }
#ifndef MIX_REPEAT
#define MIX_REPEAT 1
#endif
        for (int rep = 0; rep < MIX_REPEAT; ++rep) {
        for (int it = bid; it < 1664; it += G) {
            if (it < 512) { if (MIX_A) { hgrn_item<false>(p, lds, l, it); if (REP_A) hgrn_item<false>(p, lds, l, it); } }
            else if (it < 1024) { if (MIX_B) { conv_item(p, lds, l, it - 512); if (REP_B) conv_item(p, lds, l, it - 512); } }
            else if (it < 1152) { if (MIX_C) { s5_local_item(p, lds, l, it - 1024); if (REP_C) s5_local_item(p, lds, l, it - 1024); } }
            else { if (MIX_D) { attn_item(p, lds, l, 0, it - 1152); if (REP_D) attn_item(p, lds, l, 0, it - 1152); } }
        }
        GRID_SYNC();
        if (bid < 128) { if (MIX_A) hgrn_scan_item(p, bid); } else if (bid < 136) { if (MIX_C) s5_scan_item(p, l, bid - 128); }
        if (bid < 136) { if (MIX_D) { attn_item(p, lds, l, 1, 360 + bid); if (REP_D) attn_item(p, lds, l, 1, 360 + bid); if (bid < 16) attn_item(p, lds, l, 1, 496 + bid); } }
        else for (int it = bid - 136; it < 360; it += 120) { if (MIX_D) { attn_item(p, lds, l, 1, it); if (REP_D) attn_item(p, lds, l, 1, it); } }
        GRID_SYNC();
#ifdef REP_P3
        if (bid < 128) { if (MIX_A) hgrn_scan_item(p, bid); } else if (bid < 136) { if (MIX_C) s5_scan_item(p, l, bid - 128); }
        if (bid < 136) { if (MIX_D) { attn_item(p, lds, l, 1, 360 + bid); if (REP_D) attn_item(p, lds, l, 1, 360 + bid); if (bid < 16) attn_item(p, lds, l, 1, 496 + bid); } }
        else for (int it = bid - 136; it < 360; it += 120) { if (MIX_D) { attn_item(p, lds, l, 1, it); if (REP_D) attn_item(p, lds, l, 1, it); } }
        GRID_SYNC();
#endif
        for (int it = bid; it < 1536; it += G) {
            if (it < 512) { if (MIX_A) { hgrn_item<true>(p, lds, l, it); if (REP_A) hgrn_item<true>(p, lds, l, it); } }
            else if (it < 1024) { if (MIX_C) { s5_out_item(p, lds, l, it - 512); if (REP_C) s5_out_item(p, lds, l, it - 512); } }
            else { if (MIX_D) { attn_item(p, lds, l, 2, it - 1024); if (REP_D) attn_item(p, lds, l, 2, it - 1024); } }
        }
        GRID_SYNC();
        }
#ifndef NO_GLU
        { pg8::Gemm g{(const bf16_t*)(ws + WS_YPRE), (const bf16_t*)(ws + WS_WGLU) + (size_t)l * 65536, T, 256, 256, 256}; pg8::StaticOrder S; S.init(T, 256, G, bid);
          pg8::EpiGlu E{(const bf16_t*)(ws + WS_YPRE), 256, YC_ + YC};
          pg8::gemm_phase<pg8::EpiGlu, pg8::StaticOrder, false, true>(lds, g, S, E); }
#endif
        { int tq = threadIdx.x; asm volatile("" : "+v"(tq)); const int lane = tq & 63; const int gw = (bid - 128) * 8 + (tq >> 6), NGW = 128 * 8;
          if (bid >= 128) for (int m = gw; m < T; m += NGW) { u32x2* yp = (u32x2*)(YC_ + (size_t)m * D + YD) + lane; const u32x2 w = *((const u32x2*)(Zb + (size_t)m * DIN + ZOD) + lane);
              const float a0 = bflo(w.x), a1 = bfhi(w.x), a2 = bflo(w.y), a3 = bfhi(w.y);
              const float ss = wave_sum((a0 * a0 + a1 * a1) + (a2 * a2 + a3 * a3)); const float rs = rsqrtf(ss * (1.0f / 256.0f) + EPS);
              u32x2 o; o.x = pk2(a0 * rs, a1 * rs); o.y = pk2(a2 * rs, a3 * rs); *yp = o; } }
        GRID_SYNC();
#endif
#ifdef REP_P5
#ifndef NO_GLU
        { pg8::Gemm g{(const bf16_t*)(ws + WS_YPRE), (const bf16_t*)(ws + WS_WGLU) + (size_t)l * 65536, T, 256, 256, 256}; pg8::StaticOrder S; S.init(T, 256, G, bid);
          pg8::EpiGlu E{(const bf16_t*)(ws + WS_YPRE), 256, YC_ + YC};
          pg8::gemm_phase<pg8::EpiGlu, pg8::StaticOrder, false, true>(lds, g, S, E); }
#endif
        { int tq = threadIdx.x; asm volatile("" : "+v"(tq)); const int lane = tq & 63; const int gw = (bid - 128) * 8 + (tq >> 6), NGW = 128 * 8;
          if (bid >= 128) for (int m = gw; m < T; m += NGW) { u32x2* yp = (u32x2*)(YC_ + (size_t)m * D + YD) + lane; const u32x2 w = *((const u32x2*)(Zb + (size_t)m * DIN + ZOD) + lane);
              const float a0 = bflo(w.x), a1 = bfhi(w.x), a2 = bflo(w.y), a3 = bfhi(w.y);
              const float ss = wave_sum((a0 * a0 + a1 * a1) + (a2 * a2 + a3 * a3)); const float rs = rsqrtf(ss * (1.0f / 256.0f) + EPS);
              u32x2 o; o.x = pk2(a0 * rs, a1 * rs); o.y = pk2(a2 * rs, a3 * rs); *yp = o; } }
        GRID_SYNC();
#endif
#ifdef DUMP_SLICE
        if (lrun == DUMP_LAYER) { int tq = threadIdx.x; asm volatile("" : "+v"(tq));
          for (int m = bid * 8 + (tq >> 6); m < T; m += G * 8) { const int ln = tq & 63;
              for (int j = 0; j < 4; ++j) { const int col = j * 256 + ln * 4; const u32x2 w = *(const u32x2*)(YC_ + (size_t)m * D + col);
                  f32x4 o = (f32x4){0.f, 0.f, 0.f, 0.f}; if (j == DUMP_SLICE) o = (f32x4){bflo(w.x), bfhi(w.x), bflo(w.y), bfhi(w.y)};
                  *(f32x4*)(p.out + (size_t)m * D + col) = o; } }
          break; }
#endif
#ifdef SKIP_MIX
        { pg8::Gemm g{Zb, (const bf16_t*)(ws + WS_WOUT) + (size_t)l * D * D, T, D, D, DIN}; pg8::StaticOrder S; S.init(T, D, G, bid);
#else
        { pg8::Gemm g{YC_, (const bf16_t*)(ws + WS_WOUT) + (size_t)l * D * D, T, D, D, D}; pg8::StaticOrder S; S.init(T, D, G, bid);
#endif
          pg8::EpiRes E{firstl ? p.in[I_X] : p.out, p.out, XB, SSQP + (size_t)T * 16};
          pg8::gemm_phase<pg8::EpiRes, pg8::StaticOrder, true, true>(lds, g, S, E); }
        GRID_SYNC();
        { pg8::Gemm g{XB, (const bf16_t*)(ws + WS_WUP) + (size_t)l * D * FF, T, FF, D, D}; pg8::StaticOrder S; S.init(T, FF, G, bid);
          RS_TABLE(SSQP + (size_t)T * 16, (T / 256) * (FF / 256) / 256)
          pg8::EpiScale E{HM, FF, 1, (const PG8_LAS float*)(lds + 131072)};
          pg8::gemm_phase<pg8::EpiScale, pg8::StaticOrder, true, true>(lds, g, S, E);
#ifdef REPEAT_GEMM
          GRID_SYNC(); pg8::gemm_phase<pg8::EpiScale, pg8::StaticOrder, true, true>(lds, g, S, E);
#endif
        }
        GRID_SYNC();
        { pg8::Gemm g{HM, (const bf16_t*)(ws + WS_WDN) + (size_t)l * D * FF, T, D, FF, FF}; pg8::StaticOrder S; S.init(T, D, G, bid);
          pg8::EpiRes E{p.out, p.out, XB, !lastl ? SSQP : nullptr};
          pg8::gemm_phase<pg8::EpiRes, pg8::StaticOrder, true, true>(lds, g, S, E); }
        if (!lastl) GRID_SYNC();
    }
}

extern "C" void kernel_launch(void* const* d_in, const int* in_sizes, int n_in, void* d_out, int out_size, void* d_ws, size_t ws_size, hipStream_t stream) {
    static int grid = 0;
    if (grid == 0) {
        if (n_in != 26 || out_size != T * D || ws_size < WS_END) { fprintf(stderr, "kernel_launch: unexpected shapes (n_in %d, out %d, ws %zu); nothing launched\n", n_in, out_size, ws_size); grid = -1; return; }
        int dev = 0, cus = 0, per_cu = 0;
        (void)hipGetDevice(&dev); (void)hipDeviceGetAttribute(&cus, hipDeviceAttributeMultiprocessorCount, dev);
        if (hipFuncSetAttribute((const void*)hybrid_fwd, hipFuncAttributeMaxDynamicSharedMemorySize, LDS_BYTES) != hipSuccess) { fprintf(stderr, "kernel_launch: hipFuncSetAttribute failed\n"); grid = -1; return; }
        if (hipOccupancyMaxActiveBlocksPerMultiprocessor(&per_cu, (const void*)hybrid_fwd, 512, LDS_BYTES) != hipSuccess || per_cu < 1) { fprintf(stderr, "kernel_launch: occupancy query gave %d\n", per_cu); per_cu = 1; }
        (void)hipGetLastError();
        if (cus <= 0) cus = 256;
        grid = cus * per_cu;
    }
    if (grid < 0) return;
    if (hipMemsetAsync((char*)d_ws + WS_BAR, 0, XCD_BAR_WORDS * 4, stream) != hipSuccess) { fprintf(stderr, "kernel_launch: hipMemsetAsync of the barrier words failed\n"); return; }
    static int rs_ok = -1;
    if (rs_ok < 0) { rs_ok = (grid == 256) ? 1 : 0;
        const int ncol[2] = {DIN / 256, FF / 256};
        for (int ph = 0; ph < 2 && rs_ok; ++ph) { const int nun = (T / 256) * ncol[ph] / 256;
            for (int c = 0; c < grid && rs_ok; ++c) { pg8::StaticOrder S; S.init(T, ncol[ph] * 256, grid, c); pg8::Unit u0, u1, ui; if (!S.next(0, u0) || !S.next(nun - 1, u1) || S.next(nun, ui)) { rs_ok = 0; break; }
                if (((u0.pm >> 3) & 1) != 0 || ((u1.pm >> 3) & 1) != 1) { rs_ok = 0; break; }
                for (int i = 0; i < nun; ++i) { S.next(i, ui); if (ui.pm != (((ui.pm >> 3) & 1) ? u1.pm : u0.pm)) { rs_ok = 0; break; } } } } }
    Params a{};
    for (int i = 0; i < 26; ++i) a.in[i] = (const float*)d_in[i];
    if (!rs_ok) { fprintf(stderr, "kernel_launch: unit order does not keep a workgroup inside two row panels (grid %d); nothing launched\n", grid); return; }
    a.out = (float*)d_out; a.ws = (unsigned char*)d_ws; a.rs_lds = rs_ok; a.pad = 0;
    void* args[] = {&a};
    hipError_t e = hipLaunchCooperativeKernel((const void*)hybrid_fwd, dim3(grid), dim3(512), args, LDS_BYTES, stream);
    if (e != hipSuccess) fprintf(stderr, "cooperative launch failed: %s (grid %d)\n", hipGetErrorString(e), grid);
}
```

```cpp
#include <hip/hip_runtime.h>
#include <hip/hip_cooperative_groups.h>
#include <cstdio>
#include <cstdint>
namespace cg = cooperative_groups;

#define DI __device__ __forceinline__
#define LAS __attribute__((address_space(3)))
typedef unsigned short bf16_t;
typedef short bf16x8 __attribute__((ext_vector_type(8)));
typedef short s16x4 __attribute__((ext_vector_type(4)));
typedef float f32x4 __attribute__((ext_vector_type(4)));
typedef float f32x16 __attribute__((ext_vector_type(16)));
typedef unsigned u32x4 __attribute__((ext_vector_type(4)));
typedef unsigned u32x2 __attribute__((ext_vector_type(2)));

constexpr int NB = 4, SEQ = 8192, T = NB * SEQ, D = 1024, DIN = 2560, FF = 4096, NL = 4;
constexpr int ZQ = 0, ZF = 256, ZI = 512, ZG = 768, ZBV = 1024, ZBG = 1280, ZCU = 1536, ZDQ = 1792, ZDK = 2048, ZDV = 2304;
constexpr int YA = 0, YB = 256, YC = 512, YD = 768;
constexpr int ZOD = ZBG;
constexpr float EPS = 1e-6f;
constexpr size_t MiB = 1u << 20;
constexpr size_t WS_WIN = 0, WS_WOUT = 20 * MiB, WS_WUP = 28 * MiB, WS_WDN = 60 * MiB, WS_WGLU = 92 * MiB;
constexpr size_t WS_LB = 93 * MiB;
constexpr size_t WS_BIAS = WS_LB + 4096;
constexpr size_t WS_BAR = WS_LB + 32768;
constexpr size_t WS_SSQ = WS_LB + 65536;
constexpr size_t WS_LSE = WS_SSQ + 8 * (size_t)T * 4;
constexpr size_t WS_DEC = WS_LSE + (size_t)T * 16;
constexpr size_t WS_LSE1 = WS_DEC + 2048 * 64 * 4;
constexpr size_t WS_S5K = 96 * MiB;
constexpr size_t WS_S5WS = 98 * MiB;
constexpr size_t WS_S5WC = 114 * MiB;
constexpr size_t WS_XB = 130 * MiB;
constexpr size_t WS_S5H = 194 * MiB;
constexpr size_t WS_HM = 198 * MiB;
constexpr size_t WS_Z = 198 * MiB;
constexpr size_t WS_YCAT = 358 * MiB;
constexpr size_t WS_SL = 422 * MiB, WS_SL2 = 438 * MiB;
constexpr size_t WS_S5H2 = 454 * MiB;
constexpr size_t WS_O0 = 458 * MiB, WS_O1 = 474 * MiB;
constexpr size_t WS_YPRE = 490 * MiB;
constexpr size_t WS_SSQP = 506 * MiB;
constexpr size_t WS_END = 510 * MiB;
static_assert(WS_LSE1 + (size_t)T * 16 <= WS_S5K, "misc region");

constexpr int LDS_BYTES = 147456;

typedef float f32x2_t __attribute__((ext_vector_type(2))); typedef __bf16 bf16x2_t __attribute__((ext_vector_type(2)));
DI unsigned f2bf(float f) { const f32x2_t v = {f, 0.f}; const bf16x2_t b = __builtin_convertvector(v, bf16x2_t); return __builtin_bit_cast(unsigned, b) & 0xffffu; }
DI unsigned pk2(float lo, float hi) { const f32x2_t v = {lo, hi}; const bf16x2_t b = __builtin_convertvector(v, bf16x2_t); return __builtin_bit_cast(unsigned, b); }
DI float bf2f(bf16_t v) { return __builtin_bit_cast(float, (unsigned)v << 16); }
DI float bflo(unsigned w) { return __builtin_bit_cast(float, w << 16); }
DI float bfhi(unsigned w) { return __builtin_bit_cast(float, w & 0xffff0000u); }
DI float sigmoidf_(float x) { return __builtin_amdgcn_rcpf(1.f + __expf(-x)); }
template <int CTRL> DI float dpp_(float v) { return __builtin_bit_cast(float, __builtin_amdgcn_update_dpp(0, __builtin_bit_cast(int, v), CTRL, 0xF, 0xF, false)); }
DI float sum8_(float v) { v += dpp_<0xB1>(v); v += dpp_<0x4E>(v); v += dpp_<0x141>(v); return v; }
DI float sum16_(float v) { v = sum8_(v); v += dpp_<0x140>(v); return v; }
DI float half_sum(float v) { v = sum16_(v); v += __shfl_xor(v, 16); return v; }
DI float wave_sum(float v) { v = half_sum(v); v += __shfl_xor(v, 32); return v; }
#define LDS_WAIT() asm volatile("s_waitcnt lgkmcnt(0)" ::: "memory")
DI int crow(int reg, int h) { return (reg & 3) + 8 * (reg >> 2) + 4 * h; }

template <int K>
DI f32x16 mma_lds(const LAS bf16_t* A, int lda, const LAS bf16_t* B, int ldb, f32x16 acc, int lane) {
    const int r = lane & 31, h = lane >> 5;
    const LAS bf16_t* ap = A + r * lda + 8 * h; const LAS bf16_t* bp = B + r * ldb + 8 * h;
#pragma unroll
    for (int k0 = 0; k0 < K; k0 += 16) {
        const bf16x8 a = *(const LAS bf16x8*)(ap + k0); const bf16x8 b = *(const LAS bf16x8*)(bp + k0);
        acc = __builtin_amdgcn_mfma_f32_32x32x16_bf16(a, b, acc, 0, 0, 0);
    }
    return acc;
}
DI f32x16 zero16() { f32x16 z;
#pragma unroll
    for (int i = 0; i < 16; ++i) z[i] = 0.f;
    return z; }

namespace pg8 {
#define PG8_LAS __attribute__((address_space(3)))
constexpr int BM = 256, BK = 64, HALF = 128, HTB = HALF * BK * 2, STAGE_BYTES = 8 * HTB, NXCD = 8, WGM = 8;
__host__ __device__ __forceinline__ int lds_byte(int r, int c) { const int st = (r >> 4) * 2 + (c >> 5), rr = r & 15, cc = c & 31, ob = rr * 64 + cc * 2; return st * 1024 + (ob ^ (((ob >> 9) & 1) << 5)); }
__host__ __device__ __forceinline__ void stage_rc(int b, int& R, int& C) { const int st = b / 1024, sb = b % 1024, swz = sb ^ (((sb >> 9) & 1) << 5); R = (st >> 1) * 16 + swz / 64; C = (st & 1) * 32 + (swz % 64) / 2; }
__host__ __device__ __forceinline__ int perm32(int rho) { const int n = rho >> 4, i = rho & 15; return 8 * (i >> 2) + 4 * n + (i & 3); }
struct Unit { int pm, pn; };
struct Gemm { const bf16_t* A; const bf16_t* Bt; int M, N, K, lda; };
struct StaticOrder {
    int nM, nN, nwg, G, c;
    __host__ __device__ __forceinline__ void init(int M, int N, int G_, int c_) { nM = M / BM; nN = N / BM; nwg = nM * nN; G = G_; c = c_; }
    __host__ __device__ __forceinline__ bool next(int i, Unit& u) const {
        const long L = (long)i * G + c; if (L >= nwg) return false;
        int wgid = (int)L; { const int q = nwg / NXCD, r = nwg % NXCD, xcd = wgid % NXCD, off = wgid / NXCD; wgid = (xcd < r ? xcd * (q + 1) : r * (q + 1) + (xcd - r) * q) + off; }
        const int nig = WGM * nN, gid = wgid / nig, fm = gid * WGM, gsz = (nM - fm) < WGM ? (nM - fm) : WGM;
        u.pm = fm + ((wgid % nig) % gsz); u.pn = (wgid % nig) / gsz; return true;
    }
    __device__ __forceinline__ void a_ready(const Unit&) const {}
    __device__ __forceinline__ void done(const Unit&) const {}
};
struct EpiScale {
    static constexpr bool PERM = true, AFTER_DRAIN = false;
    bf16_t* O; int ldc; int act; const PG8_LAS float* rsl;
    __device__ __forceinline__ void operator()(const f32x4 (&acc)[2][2][4][2], const Unit& u, int wr, int wc, int fr, int fq) const {
        const int row0 = u.pm * BM + wr * 64 + fr; const int col0 = u.pn * BM + wc * 32 + 8 * fq;
        const int slot = ((u.pm >> 3) & 1) * 256;
#pragma unroll
        for (int ai = 0; ai < 2; ++ai)
#pragma unroll
            for (int m = 0; m < 4; ++m) { const int r = row0 + ai * HALF + m * 16; float rs;
                rs = rsl[slot + ai * HALF + wr * 64 + m * 16 + fr];
                bf16_t* rowp = O + (size_t)r * ldc + col0;
#pragma unroll
                for (int bj = 0; bj < 2; ++bj) { f32x4 v0 = acc[ai][bj][m][0] * rs, v1 = acc[ai][bj][m][1] * rs;
                    if (act) {
#pragma unroll
                        for (int e = 0; e < 4; ++e) { const float a = fmaxf(v0[e], 0.f), b = fmaxf(v1[e], 0.f); v0[e] = a * a; v1[e] = b * b; } }
                    u32x4 w; w.x = pk2(v0[0], v0[1]); w.y = pk2(v0[2], v0[3]); w.z = pk2(v1[0], v1[1]); w.w = pk2(v1[2], v1[3]);
                    *(u32x4*)(rowp + bj * HALF) = w; } }
    }
};
struct EpiRes {
    static constexpr bool PERM = false, AFTER_DRAIN = false;
    const float* base; float* out; bf16_t* xb; float* ssq_out;
    __device__ __forceinline__ void operator()(const f32x4 (&acc)[2][2][4][2], const Unit& u, int wr, int wc, int fr, int fq) const {
        const int col0 = u.pn * BM + wc * 32 + 4 * fq;
#pragma unroll
        for (int ai = 0; ai < 2; ++ai) {
            f32x4 bv[4][2][2];
#pragma unroll
            for (int m = 0; m < 4; ++m) { const size_t off = (size_t)(u.pm * BM + ai * HALF + wr * 64 + m * 16 + fr) * D + col0;
#pragma unroll
                for (int bj = 0; bj < 2; ++bj)
#pragma unroll
                    for (int n = 0; n < 2; ++n) bv[m][bj][n] = *(const f32x4*)(base + off + bj * HALF + n * 16); }
#pragma unroll
            for (int m = 0; m < 4; ++m) { const int r = u.pm * BM + ai * HALF + wr * 64 + m * 16 + fr; const size_t off = (size_t)r * D + col0; float s = 0.f;
#pragma unroll
                for (int bj = 0; bj < 2; ++bj)
#pragma unroll
                    for (int n = 0; n < 2; ++n) { const size_t o2 = off + bj * HALF + n * 16; const f32x4 o = bv[m][bj][n] + acc[ai][bj][m][n];
                        *(f32x4*)(out + o2) = o; u32x2 w; w.x = pk2(o[0], o[1]); w.y = pk2(o[2], o[3]); *(u32x2*)(xb + o2) = w;
                        s += (o[0] * o[0] + o[1] * o[1]) + (o[2] * o[2] + o[3] * o[3]); }
                s += __shfl_xor(s, 16); s += __shfl_xor(s, 32);
                if (fq == 0 && ssq_out) ssq_out[(size_t)r * 16 + u.pn * 4 + wc] = s; } }
    }
};
struct EpiGlu {
    static constexpr bool PERM = false, AFTER_DRAIN = true;
    const bf16_t* Ysrc; int lds_; bf16_t* Y;
    __device__ __forceinline__ void fused(f32x4 (&acc)[2][2][4][2], const Unit& u, int wr, int wc, int fr, int fq, PG8_LAS unsigned char* lds, int wid, int lane) const {
        PG8_LAS float* Pp = (PG8_LAS float*)lds;
        const int col0 = wc * 32 + 4 * fq;
#pragma unroll
        for (int ai = 0; ai < 2; ++ai)
#pragma unroll
            for (int m = 0; m < 4; ++m) { const int rl = ai * HALF + wr * 64 + m * 16 + fr; const size_t off = (size_t)(u.pm * BM + rl) * lds_ + col0; float s = 0.f;
#pragma unroll
                for (int bj = 0; bj < 2; ++bj)
#pragma unroll
                    for (int n = 0; n < 2; ++n) { const u32x2 w = *(const u32x2*)(Ysrc + off + bj * HALF + n * 16); f32x4 a = acc[ai][bj][m][n];
                        const float y0 = bflo(w.x), y1 = bfhi(w.x), y2 = bflo(w.y), y3 = bfhi(w.y);
                        a[0] = y0 * sigmoidf_(a[0]); a[1] = y1 * sigmoidf_(a[1]); a[2] = y2 * sigmoidf_(a[2]); a[3] = y3 * sigmoidf_(a[3]);
                        acc[ai][bj][m][n] = a; s += (a[0] * a[0] + a[1] * a[1]) + (a[2] * a[2] + a[3] * a[3]); }
                s += __shfl_xor(s, 16); s += __shfl_xor(s, 32);
                if (fq == 0) Pp[rl * 4 + wc] = s; }
        __syncthreads();
#pragma unroll
        for (int ai = 0; ai < 2; ++ai)
#pragma unroll
            for (int m = 0; m < 4; ++m) { const int rl = ai * HALF + wr * 64 + m * 16 + fr; const size_t off = (size_t)(u.pm * BM + rl) * D + col0;
                const float tot = (Pp[rl * 4 + 0] + Pp[rl * 4 + 1]) + (Pp[rl * 4 + 2] + Pp[rl * 4 + 3]); const float rs = rsqrtf(tot * (1.0f / 256.0f) + EPS);
#pragma unroll
                for (int bj = 0; bj < 2; ++bj)
#pragma unroll
                    for (int n = 0; n < 2; ++n) { const f32x4 a = acc[ai][bj][m][n] * rs; u32x2 w; w.x = pk2(a[0], a[1]); w.y = pk2(a[2], a[3]); *(u32x2*)(Y + off + bj * HALF + n * 16) = w; } }
    }
};

template <class Epi, class Sched, bool ALIGN_EPI = false, bool SP2 = false>
__device__ __forceinline__ void gemm_phase(PG8_LAS unsigned char* lds, const Gemm g, const Sched& S, const Epi& E) {
    int tid_o = threadIdx.x; asm volatile("" : "+v"(tid_o));
    const int tid = tid_o, wid = __builtin_amdgcn_readfirstlane(tid >> 6), lane = tid & 63, wr = wid >> 2, wc = wid & 3, fr = lane & 15, fq = lane >> 4;
    const int K = g.K, nt = K / BK;
    unsigned voffA[2], voffB[2];
#pragma unroll
    for (int i = 0; i < 2; ++i) { int R, C; stage_rc(tid * 16 + i * 8192, R, C); const int Rb = Epi::PERM ? ((R & ~31) + perm32(R & 31)) : R;
        voffA[i] = (unsigned)(R * g.lda + C) * 2u; voffB[i] = (unsigned)(Rb * K + C) * 2u; }
    const size_t kstep = (size_t)(BK * 2);
    const size_t hstepA = (size_t)HALF * g.lda * 2, hstepB = (size_t)HALF * K * 2;
    const size_t tstepA = 2 * hstepA, tstepB = 2 * hstepB;
    const unsigned ldsw = (unsigned)wid * 1024u;
    const int aoff = lds_byte(wr * 64 + fr, fq * 8), boff = lds_byte(wc * 32 + fr, fq * 8);
#define PG8_SA(b, h) (((b) * 2 + (h)) * HTB)
#define PG8_SB(b, h) ((4 + (b) * 2 + (h)) * HTB)
#define PG8_STAGE(bufoff, gbase, voff) do { _Pragma("unroll") for (int _i = 0; _i < 2; ++_i) \
        __builtin_amdgcn_global_load_lds((const unsigned*)((const char*)(gbase) + (voff)[_i]), (PG8_LAS unsigned*)(lds + (bufoff) + ldsw + _i * 8192), 16, 0, 0); } while (0)
#define PG8_LDA(dst, b, h) do { _Pragma("unroll") for (int m = 0; m < 4; ++m) _Pragma("unroll") for (int k = 0; k < 2; ++k) dst[m][k] = *(const PG8_LAS bf16x8*)(lds + PG8_SA(b, h) + aoff + m * 2048 + k * 1024); } while (0)
#define PG8_LDB(dst, b, h) do { _Pragma("unroll") for (int n = 0; n < 2; ++n) _Pragma("unroll") for (int k = 0; k < 2; ++k) dst[n][k] = *(const PG8_LAS bf16x8*)(lds + PG8_SB(b, h) + boff + n * 2048 + k * 1024); } while (0)
#define PG8_MMA(ai, bj, At, Bt) do { __builtin_amdgcn_s_setprio(1); _Pragma("unroll") for (int m = 0; m < 4; ++m) _Pragma("unroll") for (int n = 0; n < 2; ++n) _Pragma("unroll") for (int k = 0; k < 2; ++k) \
        acc[ai][bj][m][n] = __builtin_amdgcn_mfma_f32_16x16x32_bf16(Bt[n][k], At[m][k], acc[ai][bj][m][n], 0, 0, 0); __builtin_amdgcn_s_setprio(0); } while (0)
#define PG8_WAIT_V(n) asm volatile("s_waitcnt vmcnt(" #n ")" ::: "memory")
#define PG8_WAIT_L(n) asm volatile("s_waitcnt lgkmcnt(" #n ")" ::: "memory")
#define PG8_BAR __builtin_amdgcn_s_barrier()
#define PG8_SCHED __builtin_amdgcn_sched_barrier(0)
    Unit cur, nxt; int ui = 0;
    if (!S.next(0, cur)) return;
    f32x4 acc[2][2][4][2];
#pragma unroll
    for (int a = 0; a < 2; ++a)
#pragma unroll
        for (int b = 0; b < 2; ++b)
#pragma unroll
            for (int m = 0; m < 4; ++m)
#pragma unroll
                for (int n = 0; n < 2; ++n) acc[a][b][m][n] = (f32x4){0.f, 0.f, 0.f, 0.f};
    bf16x8 At[4][2], B0[2][2], B1[2][2];
    const char* cA = (const char*)g.A + (size_t)cur.pm * tstepA; const char* cB = (const char*)g.Bt + (size_t)cur.pn * tstepB;
    S.a_ready(cur);
    if constexpr (SP2) {
        PG8_STAGE(PG8_SB(0, 0), cB, voffB); PG8_STAGE(PG8_SB(0, 1), cB + hstepB, voffB); PG8_STAGE(PG8_SA(0, 0), cA, voffA); PG8_STAGE(PG8_SA(0, 1), cA + hstepA, voffA);
        if (wr == 1) PG8_BAR;
        PG8_WAIT_V(2); PG8_BAR;
        PG8_STAGE(PG8_SB(1, 0), cB + kstep, voffB); PG8_STAGE(PG8_SA(1, 0), cA + kstep, voffA); PG8_STAGE(PG8_SB(1, 1), cB + hstepB + kstep, voffB);
        PG8_WAIT_V(6); PG8_BAR;
    } else {
        PG8_STAGE(PG8_SB(0, 0), cB, voffB); PG8_STAGE(PG8_SA(0, 0), cA, voffA); PG8_STAGE(PG8_SB(0, 1), cB + hstepB, voffB); PG8_STAGE(PG8_SA(0, 1), cA + hstepA, voffA);
        if (wr == 1) PG8_BAR;
        PG8_WAIT_V(4); PG8_BAR;
        PG8_STAGE(PG8_SB(1, 0), cB + kstep, voffB); PG8_STAGE(PG8_SA(1, 0), cA + kstep, voffA); PG8_STAGE(PG8_SB(1, 1), cB + hstepB + kstep, voffB);
        PG8_WAIT_V(6); PG8_BAR;
    }
    for (;;) {
        const bool has_next = S.next(ui + 1, nxt);
        const char* nA = has_next ? (const char*)g.A + (size_t)nxt.pm * tstepA : cA; const char* nB = has_next ? (const char*)g.Bt + (size_t)nxt.pn * tstepB : cB;
        for (int t = 0; t < nt; t += 2) {
            const bool last = (t == nt - 2);
            const char* a1 = cA + (size_t)(t + 1) * kstep;
            const char* a2 = last ? nA : cA + (size_t)(t + 2) * kstep; const char* b2 = last ? nB : cB + (size_t)(t + 2) * kstep;
            const char* a3 = a2 + kstep; const char* b3 = b2 + kstep;
            if (last && has_next) S.a_ready(nxt);
            if constexpr (SP2) {
            PG8_LDB(B0, 0, 0); PG8_LDB(B1, 0, 1); PG8_SCHED; PG8_LDA(At, 0, 0); PG8_STAGE(PG8_SA(1, 1), a1 + hstepA, voffA);
            PG8_WAIT_V(8); PG8_WAIT_L(0); PG8_BAR; PG8_MMA(0, 0, At, B0); PG8_MMA(0, 1, At, B1); PG8_BAR; PG8_SCHED;
            PG8_LDA(At, 0, 1); PG8_STAGE(PG8_SB(0, 0), b2, voffB); PG8_STAGE(PG8_SB(0, 1), b2 + hstepB, voffB); PG8_STAGE(PG8_SA(0, 0), a2, voffA);
            PG8_WAIT_V(8); PG8_WAIT_L(0); PG8_BAR; PG8_MMA(1, 0, At, B0); PG8_MMA(1, 1, At, B1); PG8_BAR; PG8_SCHED;
            PG8_LDB(B0, 1, 0); PG8_LDB(B1, 1, 1); PG8_SCHED; PG8_LDA(At, 1, 0); PG8_STAGE(PG8_SA(0, 1), a2 + hstepA, voffA);
            PG8_WAIT_V(8); PG8_WAIT_L(0); PG8_BAR; PG8_MMA(0, 0, At, B0); PG8_MMA(0, 1, At, B1); PG8_BAR; PG8_SCHED;
            PG8_LDA(At, 1, 1); PG8_STAGE(PG8_SB(1, 0), b3, voffB); PG8_STAGE(PG8_SB(1, 1), b3 + hstepB, voffB); PG8_STAGE(PG8_SA(1, 0), a3, voffA);
            PG8_WAIT_V(8); PG8_WAIT_L(0); PG8_BAR; PG8_MMA(1, 0, At, B0); PG8_MMA(1, 1, At, B1); PG8_BAR; PG8_SCHED;
            } else {
            PG8_LDB(B0, 0, 0); PG8_SCHED; PG8_LDA(At, 0, 0); PG8_STAGE(PG8_SA(1, 1), a1 + hstepA, voffA);
            PG8_WAIT_L(8); PG8_BAR; PG8_WAIT_L(0); PG8_MMA(0, 0, At, B0); PG8_BAR; PG8_SCHED;
            PG8_LDB(B1, 0, 1); PG8_STAGE(PG8_SB(0, 0), b2, voffB);
            PG8_BAR; PG8_WAIT_L(0); PG8_MMA(0, 1, At, B1); PG8_BAR;
            PG8_LDA(At, 0, 1); PG8_STAGE(PG8_SA(0, 0), a2, voffA);
            PG8_BAR; PG8_WAIT_L(0); PG8_MMA(1, 0, At, B0); PG8_BAR; PG8_SCHED;
            PG8_STAGE(PG8_SB(0, 1), b2 + hstepB, voffB);
            PG8_WAIT_V(6); PG8_BAR; PG8_MMA(1, 1, At, B1); PG8_BAR;
            PG8_LDB(B0, 1, 0); PG8_SCHED; PG8_LDA(At, 1, 0); PG8_STAGE(PG8_SA(0, 1), a2 + hstepA, voffA);
            PG8_WAIT_L(8); PG8_BAR; PG8_WAIT_L(0); PG8_MMA(0, 0, At, B0); PG8_BAR; PG8_SCHED;
            PG8_LDB(B1, 1, 1); PG8_STAGE(PG8_SB(1, 0), b3, voffB);
            PG8_BAR; PG8_WAIT_L(0); PG8_MMA(0, 1, At, B1); PG8_BAR;
            PG8_LDA(At, 1, 1); PG8_STAGE(PG8_SA(1, 0), a3, voffA);
            PG8_BAR; PG8_WAIT_L(0); PG8_MMA(1, 0, At, B0); PG8_BAR; PG8_SCHED;
            PG8_STAGE(PG8_SB(1, 1), b3 + hstepB, voffB);
            PG8_WAIT_V(6); PG8_BAR; PG8_MMA(1, 1, At, B1); PG8_BAR;
            }
        }
        if constexpr (ALIGN_EPI) { if (wr == 0) PG8_BAR; }
        if constexpr (!Epi::AFTER_DRAIN) { E(acc, cur, wr, wc, fr, fq); S.done(cur); }
        if (!has_next) break;
#pragma unroll
        for (int a = 0; a < 2; ++a)
#pragma unroll
            for (int b = 0; b < 2; ++b)
#pragma unroll
                for (int m = 0; m < 4; ++m)
#pragma unroll
                    for (int n = 0; n < 2; ++n) acc[a][b][m][n] = (f32x4){0.f, 0.f, 0.f, 0.f};
        cur = nxt; cA = nA; cB = nB; ++ui;
        if constexpr (ALIGN_EPI) { if (wr == 1) PG8_BAR; }
    }
    PG8_WAIT_V(0);
    if constexpr (!ALIGN_EPI) { if (wr == 0) PG8_BAR; }
    PG8_BAR;
    if constexpr (Epi::AFTER_DRAIN) { E.fused(acc, cur, wr, wc, fr, fq, lds, wid, lane); S.done(cur); }
#undef PG8_SA
#undef PG8_SB
#undef PG8_STAGE
#undef PG8_LDA
#undef PG8_LDB
#undef PG8_MMA
#undef PG8_WAIT_V
#undef PG8_WAIT_L
#undef PG8_BAR
#undef PG8_SCHED
}
}

struct Params { const float* in[26]; float* out; unsigned char* ws; int rs_lds; int pad; };
enum { I_X = 0, I_NMG, I_WIN, I_LBL, I_HNG, I_CW, I_CB, I_CLG, I_CLB, I_LRE, I_LIM, I_BRE, I_BIM, I_CRE, I_CIM, I_S5D, I_LDT, I_WGLU, I_QG, I_KG, I_RB, I_MONG, I_WOUT, I_NMLPG, I_WUP, I_WDN };

DI void p0_transpose_item(const float* W, int K, int N, bf16_t* WT, const float* gk, LAS float* scr, int item, int lane) {
    const int nblk = N / 32, kb = item / nblk, nb = item % nblk, k0 = 64 * kb, n0 = 32 * nb;
    float wv[32];
#pragma unroll
    for (int i = 0; i < 32; ++i) { const int kk = 2 * i + (lane >> 5); wv[i] = W[(size_t)(k0 + kk) * N + n0 + (lane & 31)]; }
#pragma unroll
    for (int i = 0; i < 32; ++i) { const int kk = 2 * i + (lane >> 5); const float s = gk ? gk[k0 + kk] : 1.f; scr[kk * 33 + (lane & 31)] = wv[i] * s; }
    LDS_WAIT();
    const int c = lane & 7;
#pragma unroll
    for (int j = 0; j < 4; ++j) { const int n = (lane >> 3) + 8 * j; const LAS float* s = scr + (8 * c) * 33 + n;
        u32x4 o; o.x = pk2(s[0 * 33], s[1 * 33]); o.y = pk2(s[2 * 33], s[3 * 33]); o.z = pk2(s[4 * 33], s[5 * 33]); o.w = pk2(s[6 * 33], s[7 * 33]);
        *(u32x4*)(WT + (size_t)(n0 + n) * K + k0 + 8 * c) = o; }
    LDS_WAIT();
}
DI void s5_params(const Params& p, int lg, int pp, float& lrdt, float& lidt, float& cr, float& ci) {
    const float dt = expf(p.in[I_LDT][lg]);
    const float lr = p.in[I_LRE][lg * 64 + pp], li = p.in[I_LIM][lg * 64 + pp];
    lrdt = lr * dt; lidt = li * dt;
    const float mag = expf(lrdt); const float ar = mag * cosf(lidt), ai = mag * sinf(lidt);
    const float den = lr * lr + li * li;
    cr = ((ar - 1.0f) * lr + ai * li) / den; ci = (ai * lr - (ar - 1.0f) * li) / den;
}
DI void s5_pow(float lrdt, float lidt, int n, float& er, float& ei) { const float m = expf((float)n * lrdt); const float a = (float)n * lidt; er = m * cosf(a); ei = m * sinf(a); }

DI void prologue(const Params& p, LAS unsigned char* lds, int G) {
    int tid_o = threadIdx.x; asm volatile("" : "+v"(tid_o));
    const int tid = tid_o, lane = tid & 63, wave = tid >> 6;
    const int gw = blockIdx.x * 8 + wave, NGW = G * 8;
    const int gt = blockIdx.x * 512 + tid, NGT = G * 512;
    unsigned char* ws = p.ws;
    LAS float* scr = (LAS float*)(lds + wave * 16384);
    {
        constexpr int I_IN = (D / 64) * (DIN / 32), I_OUT = (D / 64) * (D / 32), I_UP = (D / 64) * (FF / 32), I_DN = (FF / 64) * (D / 32), I_GL = (256 / 64) * (256 / 32);
        constexpr int PER_L = I_IN + I_OUT + I_UP + I_DN + I_GL;
        for (int it = gw; it < NL * PER_L; it += NGW) {
            const int l = it / PER_L; int r = it % PER_L;
            if (r < I_IN) { p0_transpose_item(p.in[I_WIN] + (size_t)l * D * DIN, D, DIN, (bf16_t*)(ws + WS_WIN) + (size_t)l * D * DIN, p.in[I_NMG] + l * D, scr, r, lane); continue; } r -= I_IN;
            if (r < I_OUT) { p0_transpose_item(p.in[I_WOUT] + (size_t)l * D * D, D, D, (bf16_t*)(ws + WS_WOUT) + (size_t)l * D * D, p.in[I_MONG] + l * D, scr, r, lane); continue; } r -= I_OUT;
            if (r < I_UP) { p0_transpose_item(p.in[I_WUP] + (size_t)l * D * FF, D, FF, (bf16_t*)(ws + WS_WUP) + (size_t)l * D * FF, p.in[I_NMLPG] + l * D, scr, r, lane); continue; } r -= I_UP;
            if (r < I_DN) { p0_transpose_item(p.in[I_WDN] + (size_t)l * D * FF, FF, D, (bf16_t*)(ws + WS_WDN) + (size_t)l * D * FF, nullptr, scr, r, lane); continue; } r -= I_DN;
            p0_transpose_item(p.in[I_WGLU] + (size_t)l * 65536, 256, 256, (bf16_t*)(ws + WS_WGLU) + (size_t)l * 65536, nullptr, scr, r, lane);
        }
    }
    {
        float* ssq0 = (float*)(ws + WS_SSQP); bf16_t* XB = (bf16_t*)(ws + WS_XB);
        for (int mb = gw * 16; mb < T; mb += NGW * 16) {
            float keep = 0.f;
#pragma unroll 4
            for (int i = 0; i < 16; ++i) { const int m = mb + i;
                const f32x4* xr = (const f32x4*)(p.in[I_X] + (size_t)m * D) + lane; f32x4 v[4]; float s = 0.f;
#pragma unroll
                for (int j = 0; j < 4; ++j) { v[j] = xr[64 * j]; s += (v[j][0] * v[j][0] + v[j][1] * v[j][1]) + (v[j][2] * v[j][2] + v[j][3] * v[j][3]); }
                s = wave_sum(s); if (lane == i) keep = s;
                u32x2* o8 = (u32x2*)(XB + (size_t)m * D) + lane;
#pragma unroll
                for (int j = 0; j < 4; ++j) { u32x2 w; w.x = pk2(v[j][0], v[j][1]); w.y = pk2(v[j][2], v[j][3]); o8[64 * j] = w; } }
#pragma unroll 1
            for (int i = 0; i < 16; ++i) { const float v = __shfl(keep, i); if (lane < 16) ssq0[(size_t)(mb + i) * 16 + lane] = lane == 0 ? v : 0.f; }
        }
    }
    {
        float* LB = (float*)(ws + WS_LB);
        for (int c = gt; c < 256; c += NGT) {
            const float a0 = p.in[I_LBL][c], a1 = p.in[I_LBL][256 + c], a2 = p.in[I_LBL][512 + c], a3 = p.in[I_LBL][768 + c];
            const float mx = fmaxf(fmaxf(a0, a1), fmaxf(a2, a3));
            const float e0 = expf(a0 - mx), e1 = expf(a1 - mx), e2 = expf(a2 - mx), e3 = expf(a3 - mx); const float inv = 1.f / (e0 + e1 + e2 + e3);
            const float s1 = e1 * inv, s2 = e2 * inv, s3 = e3 * inv; const float hi = 1.0f - 1e-6f;
            LB[c] = 0.f; LB[256 + c] = fminf(fmaxf(s1, 0.f), hi); LB[512 + c] = fminf(fmaxf(s1 + s2, 0.f), hi); LB[768 + c] = fminf(fmaxf(s1 + s2 + s3, 0.f), hi);
        }
        float* BT = (float*)(ws + WS_BIAS);
        for (int i = gt; i < 3 * 4 * 132; i += NGT) {
            const int pt = i / (4 * 132), hd = (i / 132) % 4, dl = i % 132; const int dil = pt == 0 ? 1 : (pt == 1 ? 4 : 16);
            float v = 0.f;
            if (dl <= 128) { const int dist = dl * dil; int bk;
                if (dist < 16) bk = dist; else { bk = 16 + (int)(logf((float)dist / 16.0f) / 4.852030263919617f * 16.0f); if (bk > 31) bk = 31; }
                v = p.in[I_RB][bk * 4 + hd]; }
            BT[i] = v;
        }
    }
    {
        bf16_t* KT = (bf16_t*)(ws + WS_S5K); bf16_t* WS_ = (bf16_t*)(ws + WS_S5WS); bf16_t* WC = (bf16_t*)(ws + WS_S5WC);
        LAS float* ebr = scr; LAS float* ebi = scr + 64 * 17;
        for (int it = gw; it < NL * 16 * 64; it += NGW) {
            const int lg = it >> 6, d = it & 63;
            float lrdt, lidt, cr, ci; s5_params(p, lg, lane, lrdt, lidt, cr, ci);
            float er, ei; s5_pow(lrdt, lidt, d, er, ei);
            const float fr_ = er * cr - ei * ci, fi_ = er * ci + ei * cr;
            const float* br = p.in[I_BRE] + ((size_t)lg * 64 + lane) * 16; const float* bi = p.in[I_BIM] + ((size_t)lg * 64 + lane) * 16;
#pragma unroll
            for (int c = 0; c < 16; ++c) { const float b0 = br[c], b1 = bi[c]; ebr[lane * 17 + c] = fr_ * b0 - fi_ * b1; ebi[lane * 17 + c] = fr_ * b1 + fi_ * b0; }
            LDS_WAIT();
            const int co = lane & 15, cb = (lane >> 4) * 4;
            const float* crp = p.in[I_CRE] + ((size_t)lg * 16 + co) * 64; const float* cip = p.in[I_CIM] + ((size_t)lg * 16 + co) * 64;
            float a0 = 0.f, a1 = 0.f, a2 = 0.f, a3 = 0.f;
            for (int q = 0; q < 64; ++q) { const float c0 = crp[q], c1 = cip[q];
                a0 += c0 * ebr[q * 17 + cb + 0] - c1 * ebi[q * 17 + cb + 0]; a1 += c0 * ebr[q * 17 + cb + 1] - c1 * ebi[q * 17 + cb + 1];
                a2 += c0 * ebr[q * 17 + cb + 2] - c1 * ebi[q * 17 + cb + 2]; a3 += c0 * ebr[q * 17 + cb + 3] - c1 * ebi[q * 17 + cb + 3]; }
            u32x2 w; w.x = pk2(a0, a1); w.y = pk2(a2, a3);
            *(u32x2*)(KT + ((size_t)it * 16 + co) * 16 + cb) = w;
            LDS_WAIT();
        }
        for (int it = gw; it < NL * 16 * 16; it += NGW) {
            const int lg = it >> 4, s4 = it & 15;
            float lrdt, lidt, cr, ci; s5_params(p, lg, lane, lrdt, lidt, cr, ci);
            const float* br = p.in[I_BRE] + ((size_t)lg * 64 + lane) * 16; const float* bi = p.in[I_BIM] + ((size_t)lg * 64 + lane) * 16;
            float b0[16], b1[16];
#pragma unroll
            for (int c = 0; c < 16; ++c) { b0[c] = br[c]; b1[c] = bi[c]; }
#pragma unroll 1
            for (int sq = 0; sq < 4; ++sq) { const int s = s4 * 4 + sq;
                float er, ei; s5_pow(lrdt, lidt, 63 - s, er, ei);
                const float fr_ = er * cr - ei * ci, fi_ = er * ci + ei * cr;
                float vr[16], vi[16];
#pragma unroll
                for (int c = 0; c < 16; ++c) { vr[c] = fr_ * b0[c] - fi_ * b1[c]; vi[c] = fr_ * b1[c] + fi_ * b0[c]; }
                bf16_t* o0 = WS_ + (((size_t)lg * 64 + s) * 128 + lane) * 16; bf16_t* o1 = WS_ + (((size_t)lg * 64 + s) * 128 + 64 + lane) * 16;
                u32x4 w;
                w.x = pk2(vr[0], vr[1]); w.y = pk2(vr[2], vr[3]); w.z = pk2(vr[4], vr[5]); w.w = pk2(vr[6], vr[7]); *(u32x4*)o0 = w;
                w.x = pk2(vr[8], vr[9]); w.y = pk2(vr[10], vr[11]); w.z = pk2(vr[12], vr[13]); w.w = pk2(vr[14], vr[15]); *(u32x4*)(o0 + 8) = w;
                w.x = pk2(vi[0], vi[1]); w.y = pk2(vi[2], vi[3]); w.z = pk2(vi[4], vi[5]); w.w = pk2(vi[6], vi[7]); *(u32x4*)o1 = w;
                w.x = pk2(vi[8], vi[9]); w.y = pk2(vi[10], vi[11]); w.z = pk2(vi[12], vi[13]); w.w = pk2(vi[14], vi[15]); *(u32x4*)(o1 + 8) = w; }
        }
        for (int it = gw; it < NL * 16 * 64; it += NGW) {
            const int lg = it >> 6, tl = it & 63;
            float lrdt, lidt, cr, ci; s5_params(p, lg, lane, lrdt, lidt, cr, ci);
            float er, ei; s5_pow(lrdt, lidt, tl + 1, er, ei);
#pragma unroll 4
            for (int co = 0; co < 16; ++co) { const float c0 = p.in[I_CRE][((size_t)lg * 16 + co) * 64 + lane], c1 = p.in[I_CIM][((size_t)lg * 16 + co) * 64 + lane];
                bf16_t* o = WC + (((size_t)lg * 64 + tl) * 16 + co) * 128;
                o[lane] = (bf16_t)f2bf(c0 * er - c1 * ei); o[64 + lane] = (bf16_t)f2bf(-(c0 * ei + c1 * er)); }
        }
    }
}

template <bool OUT>
DI void hgrn_item(const Params& p, LAS unsigned char* lds, int l, int cg) {
    int tid_o = threadIdx.x; asm volatile("" : "+v"(tid_o));
    const int tid = tid_o, lane = tid & 63, wave = tid >> 6, hd = wave >> 1, half = wave & 1;
    const bf16_t* Z = (const bf16_t*)(p.ws + WS_Z);
    LAS bf16_t* B0 = (LAS bf16_t*)(lds + hd * 27648); LAS bf16_t* B1 = B0 + 64 * 72; LAS bf16_t* B2 = B1 + 64 * 72;
    LAS float* GM = (LAS float*)(lds + 114688) + hd * 64; LAS float* GL = GM + 256; LAS float* SSA = (LAS float*)(lds + 114688) + 512;
    bf16_t* SL = (bf16_t*)(p.ws + WS_SL); const bf16_t* SL2 = (const bf16_t*)(p.ws + WS_SL2); float* DEC = (float*)(p.ws + WS_DEC);
    const int item = cg * 4 + hd;
#ifdef FORCE_LB0
    const float lb = 0.f, oml = 1.f;
#else
    const float lb = ((const float*)(p.ws + WS_LB))[l * 256 + hd * 64 + lane], oml = 1.f - lb;
#endif
    const int srow = tid >> 5, shd = (tid >> 3) & 3, spc = tid & 7;
    const bf16_t* zsrc = Z + (size_t)(cg * 64 + srow) * DIN + shd * 64 + spc * 8;
    const int sdst = shd * 27648 + (srow * 72 + spc * 8) * 2;
    u32x4 wsl[4], wg[4];
    if (OUT) { const bf16_t* sp = SL2 + (size_t)item * 4096 + (32 * half) * 64;
#pragma unroll
        for (int e = 0; e < 4; ++e) { wsl[e] = *(const u32x4*)(sp + (lane + 64 * e) * 8); wg[e] = *(const u32x4*)(zsrc + (size_t)(16 * e) * DIN + ZG); } }
    __syncthreads();
    { u32x4 wf[4], wi[4], wq[4];
#pragma unroll
      for (int sub = 0; sub < 4; ++sub) { wf[sub] = *(const u32x4*)(zsrc + (size_t)(16 * sub) * DIN + ZF); wi[sub] = *(const u32x4*)(zsrc + (size_t)(16 * sub) * DIN + ZI);
          if (OUT) wq[sub] = *(const u32x4*)(zsrc + (size_t)(16 * sub) * DIN + ZQ); }
#pragma unroll
      for (int sub = 0; sub < 4; ++sub) { *(LAS u32x4*)(lds + sdst + 9216 + sub * 16 * 144) = wf[sub]; *(LAS u32x4*)(lds + sdst + 18432 + sub * 16 * 144) = wi[sub];
          if (OUT) *(LAS u32x4*)(lds + sdst + sub * 16 * 144) = wq[sub]; } }
    __syncthreads();
    float g[32]; float run = 0.f;
#pragma unroll
    for (int j = 0; j < 32; ++j) { const float fz = bf2f(B1[(half * 32 + j) * 72 + lane]); const float sg = sigmoidf_(fz); const float f = lb + oml * sg;
        run += __logf(fmaxf(f, 1e-30f)); g[j] = run; }
    if (half == 0) GM[lane] = run;
    __syncthreads();
    const float gm = GM[lane];
    if (half) {
#pragma unroll
        for (int j = 0; j < 32; ++j) g[j] += gm; }
    const int c0 = lane & 31, h = lane >> 5;
    if constexpr (!OUT) {
        if (half) GL[lane] = run + gm;
        __syncthreads();
        const float gl = GL[lane];
        bf16_t kv[32], ivr[32];
#pragma unroll
        for (int j = 0; j < 32; ++j) { const int t = half * 32 + j; const float e = __expf(gl - g[j]); const float kj = oml * (1.f - sigmoidf_(bf2f(B1[t * 72 + lane])));
            kv[j] = (bf16_t)f2bf(kj * e); ivr[j] = B2[t * 72 + lane]; }
        __syncthreads();
#pragma unroll
        for (int j = 0; j < 32; ++j) { const int t = half * 32 + j; B1[lane * 72 + t] = kv[j]; B2[lane * 72 + t] = ivr[j]; }
        __syncthreads();
#pragma unroll
        for (int kt = 0; kt < 2; ++kt) { const f32x16 a = mma_lds<64>(B2 + 32 * half * 72, 72, B1 + 32 * kt * 72, 72, zero16(), lane);
#pragma unroll
            for (int i = 0; i < 16; ++i) SL[(size_t)item * 4096 + (32 * half + crow(i, h)) * 64 + 32 * kt + c0] = (bf16_t)f2bf(a[i]); }
        if (half == 0) DEC[item * 64 + lane] = __expf(gl);
    } else {
        if (half == 0) GL[lane] = __expf(gm);
        bf16_t ivr[32];
#pragma unroll
        for (int j = 0; j < 32; ++j) { const int t = half * 32 + j; const float q = bf2f(B0[t * 72 + lane]); const float kj = oml * (1.f - sigmoidf_(bf2f(B1[t * 72 + lane])));
            const float e1 = __expf(fminf(g[j] - gm, 80.f)), e2 = __expf(fminf(gm - g[j], 80.f));
            ivr[j] = B2[t * 72 + lane];
            B0[t * 72 + lane] = (bf16_t)f2bf(q * e1); B1[t * 72 + lane] = (bf16_t)f2bf(kj * e2); }
        __syncthreads();
#pragma unroll
        for (int j = 0; j < 32; ++j) B2[lane * 72 + half * 32 + j] = ivr[j];
        __syncthreads();
        f32x16 s0 = mma_lds<64>(B0 + 32 * half * 72, 72, B1, 72, zero16(), lane);
        f32x16 s1 = zero16(); if (half) s1 = mma_lds<64>(B0 + 32 * half * 72, 72, B1 + 32 * 72, 72, zero16(), lane);
        __syncthreads();
#pragma unroll
        for (int i = 0; i < 16; ++i) { const int row = 32 * half + crow(i, h);
            B1[row * 72 + c0] = (bf16_t)f2bf(c0 <= row ? s0[i] : 0.f); B1[row * 72 + 32 + c0] = (bf16_t)f2bf(32 + c0 <= row ? s1[i] : 0.f); }
        __syncthreads();
        f32x16 o0 = mma_lds<64>(B1 + 32 * half * 72, 72, B2, 72, zero16(), lane);
        f32x16 o1 = mma_lds<64>(B1 + 32 * half * 72, 72, B2 + 32 * 72, 72, zero16(), lane);
        __syncthreads();
        {
#pragma unroll
          for (int e = 0; e < 4; ++e) { const int pc = lane + 64 * e, row = pc >> 3, k0 = (pc & 7) * 8; const LAS float* eg = GL + k0;
              u32x4 o; o.x = pk2(bflo(wsl[e].x) * eg[0], bfhi(wsl[e].x) * eg[1]); o.y = pk2(bflo(wsl[e].y) * eg[2], bfhi(wsl[e].y) * eg[3]);
              o.z = pk2(bflo(wsl[e].z) * eg[4], bfhi(wsl[e].z) * eg[5]); o.w = pk2(bflo(wsl[e].w) * eg[6], bfhi(wsl[e].w) * eg[7]);
              *(LAS u32x4*)(B2 + (32 * half + row) * 72 + k0) = o;
              *(LAS u32x4*)(lds + sdst + 9216 + e * 16 * 144) = wg[e]; } }
        __syncthreads();
        o0 = mma_lds<64>(B0 + 32 * half * 72, 72, B2, 72, o0, lane);
        o1 = mma_lds<64>(B0 + 32 * half * 72, 72, B2 + 32 * 72, 72, o1, lane);
        const float* ng = p.in[I_HNG] + l * 256 + hd * 64; const float ng0 = ng[c0], ng1 = ng[32 + c0];
#pragma unroll
        for (int i = 0; i < 16; ++i) { const int row = 32 * half + crow(i, h);
            const float ss = half_sum(o0[i] * o0[i] + o1[i] * o1[i]); const float rs = rsqrtf(ss * (1.0f / 64.0f) + EPS);
            const float g0 = bf2f(B1[row * 72 + c0]), g1 = bf2f(B1[row * 72 + 32 + c0]);
            const float v0 = o0[i] * rs * ng0 * g0 * sigmoidf_(g0), v1 = o1[i] * rs * ng1 * g1 * sigmoidf_(g1);
            o0[i] = v0; o1[i] = v1; const float s2 = half_sum(v0 * v0 + v1 * v1); if (c0 == 0) SSA[hd * 64 + row] = s2; }
        __syncthreads();
        bf16_t* Y = (bf16_t*)(p.ws + WS_YCAT);
#pragma unroll
        for (int i = 0; i < 16; ++i) { const int row = 32 * half + crow(i, h); const size_t tok = (size_t)cg * 64 + row;
            const float tot = (SSA[row] + SSA[64 + row]) + (SSA[128 + row] + SSA[192 + row]); const float r2 = rsqrtf(tot * (1.0f / 256.0f) + EPS);
            Y[tok * D + YA + hd * 64 + c0] = (bf16_t)f2bf(o0[i] * r2); Y[tok * D + YA + hd * 64 + 32 + c0] = (bf16_t)f2bf(o1[i] * r2); }
    }
}
DI void hgrn_scan_item(const Params& p, int hb) {
    int tid_o = threadIdx.x; asm volatile("" : "+v"(tid_o));
    const int e = hb * 512 + tid_o, bh = e >> 12, b = bh >> 2, hd = bh & 3, vk = e & 4095, k = vk & 63;
    const bf16_t* SL = (const bf16_t*)(p.ws + WS_SL); bf16_t* SL2 = (bf16_t*)(p.ws + WS_SL2); const float* DEC = (const float*)(p.ws + WS_DEC);
    float st = 0.f;
    for (int c8 = 0; c8 < 128; c8 += 32) { float tmp[32], dc[32];
#pragma unroll
        for (int u = 0; u < 32; ++u) { const int item = (b * 128 + c8 + u) * 4 + hd; tmp[u] = bf2f(SL[(size_t)item * 4096 + vk]); dc[u] = DEC[item * 64 + k]; }
#pragma unroll
        for (int u = 0; u < 32; ++u) { const int item = (b * 128 + c8 + u) * 4 + hd; SL2[(size_t)item * 4096 + vk] = (bf16_t)f2bf(st); st = dc[u] * st + tmp[u]; } }
}

DI void conv_item(const Params& p, LAS unsigned char* lds, int l, int ti) {
    int tid_o = threadIdx.x; asm volatile("" : "+v"(tid_o));
    const int tid = tid_o, lane = tid & 63, wave = tid >> 6, c = tid & 255, hf = tid >> 8, wv = wave & 3;
    LAS float* Hs = (LAS float*)lds; LAS float* ST = (LAS float*)(lds + 98304); LAS float* ST2 = ST + 512;
    const bf16_t* Z = (const bf16_t*)(p.ws + WS_Z); bf16_t* Y = (bf16_t*)(p.ws + WS_YCAT);
    const int tok0 = ti * 64, pos0 = (ti & 127) * 64;
    const float* cw = p.in[I_CW] + (size_t)l * 31 * 256 + c; float w[31];
#pragma unroll
    for (int jj = 0; jj < 31; ++jj) w[jj] = cw[jj * 256];
    const float cb = p.in[I_CB][l * 256 + c];
    const float lng = p.in[I_CLG][l * 256 + c], lnb = p.in[I_CLB][l * 256 + c];
    __syncthreads();
    { u32x4 vw[6], gw_[6];
#pragma unroll
      for (int k = 0; k < 6; ++k) { const int pid = tid + 512 * k, row = pid >> 5, pc = pid & 31, pos = pos0 - 30 + row; const bool ok = (row < 94) && (pos >= 0);
          const size_t tok = ok ? (size_t)(tok0 - 30 + row) : (size_t)tok0; vw[k] = *(const u32x4*)(Z + tok * DIN + ZBV + pc * 8); gw_[k] = *(const u32x4*)(Z + tok * DIN + ZBG + pc * 8); }
#pragma unroll
      for (int k = 0; k < 6; ++k) { const int pid = tid + 512 * k, row = pid >> 5, pc = pid & 31, pos = pos0 - 30 + row; const bool ok = (row < 94) && (pos >= 0);
          if (row < 94) { f32x4 h0, h1;
              h0[0] = bflo(vw[k].x) * sigmoidf_(bflo(gw_[k].x)); h0[1] = bfhi(vw[k].x) * sigmoidf_(bfhi(gw_[k].x)); h0[2] = bflo(vw[k].y) * sigmoidf_(bflo(gw_[k].y)); h0[3] = bfhi(vw[k].y) * sigmoidf_(bfhi(gw_[k].y));
              h1[0] = bflo(vw[k].z) * sigmoidf_(bflo(gw_[k].z)); h1[1] = bfhi(vw[k].z) * sigmoidf_(bfhi(gw_[k].z)); h1[2] = bflo(vw[k].w) * sigmoidf_(bflo(gw_[k].w)); h1[3] = bfhi(vw[k].w) * sigmoidf_(bfhi(gw_[k].w));
              if (!ok) { h0 = (f32x4){0.f, 0.f, 0.f, 0.f}; h1 = h0; }
              *(LAS f32x4*)(Hs + row * 256 + pc * 8) = h0; *(LAS f32x4*)(Hs + row * 256 + pc * 8 + 4) = h1; } } }
    __syncthreads();
    LAS float* OT2 = (LAS float*)(lds + 98304);
    LAS float* STAT = (LAS float*)(lds + 131072); LAS float* STAT2 = STAT + 64;
    const int rtl = tid >> 4, rpart = tid & 15;
#pragma unroll 1
    for (int ps = 0; ps < 2; ++ps) { const int tb = hf * 32 + ps * 16;
        float o[16];
        { float hr[46];
#pragma unroll
          for (int r = 0; r < 46; ++r) hr[r] = Hs[(tb + r) * 256 + c];
#pragma unroll
          for (int j = 0; j < 16; ++j) { float a = cb;
#pragma unroll
            for (int jj = 0; jj < 31; ++jj) a += w[jj] * hr[j + jj];
            o[j] = a; } }
#pragma unroll
        for (int j = 0; j < 16; ++j) OT2[(hf * 16 + j) * 256 + c] = o[j];
        __syncthreads();
        { const LAS f32x4* q = (const LAS f32x4*)(OT2 + rtl * 256 + rpart * 16); float s1 = 0.f, s2 = 0.f;
#pragma unroll
          for (int e = 0; e < 4; ++e) { const f32x4 v = q[e]; s1 += (v[0] + v[1]) + (v[2] + v[3]); s2 += (v[0] * v[0] + v[1] * v[1]) + (v[2] * v[2] + v[3] * v[3]); }
          s1 = sum16_(s1); s2 = sum16_(s2);
          if (rpart == 0) { const float mu = s1 * (1.0f / 256.0f); const float var = fmaxf(s2 * (1.0f / 256.0f) - mu * mu, 0.f); STAT[rtl * 2] = mu; STAT[rtl * 2 + 1] = rsqrtf(var + EPS); } }
        __syncthreads();
#pragma unroll
        for (int j = 0; j < 16; ++j) { const float mu = STAT[(hf * 16 + j) * 2], rsd = STAT[(hf * 16 + j) * 2 + 1];
            const float y = (o[j] - mu) * rsd * lng + lnb; const float sv = y * sigmoidf_(y); o[j] = sv; OT2[(hf * 16 + j) * 256 + c] = sv; }
        __syncthreads();
        { const LAS f32x4* q = (const LAS f32x4*)(OT2 + rtl * 256 + rpart * 16); float s3 = 0.f;
#pragma unroll
          for (int e = 0; e < 4; ++e) { const f32x4 v = q[e]; s3 += (v[0] * v[0] + v[1] * v[1]) + (v[2] * v[2] + v[3] * v[3]); }
          s3 = sum16_(s3);
          if (rpart == 0) STAT2[rtl] = rsqrtf(s3 * (1.0f / 256.0f) + EPS); }
        __syncthreads();
#pragma unroll
        for (int j = 0; j < 16; ++j) Y[(size_t)(tok0 + tb + j) * D + YB + c] = (bf16_t)f2bf(o[j] * STAT2[hf * 16 + j]);
    }
}

DI bf16x8 ldg8(const bf16_t* p) { return *(const bf16x8*)p; }
DI void s5_local_item(const Params& p, LAS unsigned char* lds, int l, int bi) {
    int tid_o = threadIdx.x; asm volatile("" : "+v"(tid_o));
    const int tid = tid_o, lane = tid & 63, wave = tid >> 6;
    const int gh = bi & 1, cb = (bi >> 1) & 15, pt = bi >> 5, g = gh * 8 + wave, c0 = lane & 31, h = lane >> 5, lg = l * 16 + g;
    LAS bf16_t* UT = (LAS bf16_t*)lds;
    const bf16_t* Z = (const bf16_t*)(p.ws + WS_Z);
    const int sm = tid >> 4, spc = tid & 15;
    const bf16_t* zst = Z + (size_t)((cb * 32 + sm) * 64) * DIN + ZCU + gh * 128 + spc * 8;
    const int ust = (sm * 136 + spc * 8) * 2;
    const bf16_t* wsp = (const bf16_t*)(p.ws + WS_S5WS) + ((size_t)lg * 64 * 128 + pt * 32 + c0) * 16 + 8 * h;
    u32x4 pf[8];
#pragma unroll
    for (int e = 0; e < 8; ++e) pf[e] = *(const u32x4*)(zst + (size_t)e * DIN);
    f32x16 acc = zero16();
    __syncthreads();
    for (int b = 0; b < 8; ++b) { const int s0 = 8 * b;
#pragma unroll
        for (int e = 0; e < 8; ++e) *(LAS u32x4*)(lds + ust + e * (32 * 136 * 2)) = pf[e];
        __syncthreads();
        if (b + 1 < 8) {
#pragma unroll
            for (int e = 0; e < 8; ++e) pf[e] = *(const u32x4*)(zst + (size_t)(s0 + 8 + e) * DIN); }
        bf16x8 bf[8];
#pragma unroll
        for (int e = 0; e < 8; ++e) bf[e] = ldg8(wsp + (size_t)(s0 + e) * 2048);
#pragma unroll
        for (int e = 0; e < 8; ++e) acc = __builtin_amdgcn_mfma_f32_32x32x16_bf16(*(const LAS bf16x8*)(UT + (e * 32 + c0) * 136 + wave * 16 + 8 * h), bf[e], acc, 0, 0, 0);
        __syncthreads();
    }
    float* HL = (float*)(p.ws + WS_S5H);
#pragma unroll
    for (int i = 0; i < 16; ++i) HL[((size_t)(cb * 32 + crow(i, h)) * 16 + g) * 128 + pt * 32 + c0] = acc[i];
}
DI void s5_scan_item(const Params& p, int l, int sb) {
    int tid_o = threadIdx.x; asm volatile("" : "+v"(tid_o));
    const int e = sb * 512 + tid_o, b = e >> 10, g = (e >> 6) & 15, pp = e & 63;
    float lrdt, lidt, cr, ci; s5_params(p, l * 16 + g, pp, lrdt, lidt, cr, ci);
    float ar, ai; s5_pow(lrdt, lidt, 64, ar, ai);
    const float* HL = (const float*)(p.ws + WS_S5H); float* HO = (float*)(p.ws + WS_S5H2); float hr = 0.f, hi = 0.f;
    for (int c8 = 0; c8 < 128; c8 += 32) { float tr[32], ti[32];
#pragma unroll
        for (int u = 0; u < 32; ++u) { const size_t idx = ((size_t)(b * 128 + c8 + u) * 16 + g) * 128; tr[u] = HL[idx + pp]; ti[u] = HL[idx + 64 + pp]; }
#pragma unroll
        for (int u = 0; u < 32; ++u) { const size_t idx = ((size_t)(b * 128 + c8 + u) * 16 + g) * 128; HO[idx + pp] = hr; HO[idx + 64 + pp] = hi;
            const float nr = ar * hr - ai * hi + tr[u], ni = ar * hi + ai * hr + ti[u]; hr = nr; hi = ni; } }
}
DI void s5_out_item(const Params& p, LAS unsigned char* lds, int l, int bi) {
    int tid_o = threadIdx.x; asm volatile("" : "+v"(tid_o));
    const int tid = tid_o, lane = tid & 63, wave = tid >> 6;
    const int gh = bi & 1, cb = (bi >> 1) & 15, pr = bi >> 5, g = gh * 8 + wave, c0 = lane & 31, h = lane >> 5, lg = l * 16 + g;
    LAS bf16_t* UT = (LAS bf16_t*)lds;
    LAS bf16_t* OT = (LAS bf16_t*)(lds + 69632);
    const bf16_t* Z = (const bf16_t*)(p.ws + WS_Z);
    const bf16_t* kt = (const bf16_t*)(p.ws + WS_S5K) + (size_t)lg * 64 * 256;
    const float* ha = (const float*)(p.ws + WS_S5H2) + ((size_t)(cb * 32 + c0) * 16 + g) * 128 + 8 * h;
    const int co = c0 & 15; const float dsk = p.in[I_S5D][l * 256 + g * 16 + co];
    const int jt0 = pr, jt1 = 31 - pr, tl0 = 2 * jt0 + (c0 >> 4), tl1 = 2 * jt1 + (c0 >> 4);
    const int sm = tid >> 4, spc = tid & 15;
    const bf16_t* zst = Z + (size_t)((cb * 32 + sm) * 64) * DIN + ZCU + gh * 128 + spc * 8;
    const int ust = (sm * 136 + spc * 8) * 2;
    const int nb = (2 * jt1 + 2 + 7) >> 3;
    u32x4 pf[8];
#pragma unroll
    for (int e = 0; e < 8; ++e) pf[e] = *(const u32x4*)(zst + (size_t)e * DIN);
    f32x16 acc0 = zero16(), acc1 = zero16();
    { const bf16_t* wc0 = (const bf16_t*)(p.ws + WS_S5WC) + (((size_t)lg * 64 + tl0) * 16 + co) * 128 + 8 * h;
      const bf16_t* wc1 = (const bf16_t*)(p.ws + WS_S5WC) + (((size_t)lg * 64 + tl1) * 16 + co) * 128 + 8 * h;
      f32x4 x0[8], x1[8];
#pragma unroll
      for (int ks = 0; ks < 8; ++ks) { x0[ks] = *(const f32x4*)(ha + ks * 16); x1[ks] = *(const f32x4*)(ha + ks * 16 + 4); }
#pragma unroll
      for (int ks = 0; ks < 8; ++ks) { u32x4 w; w.x = pk2(x0[ks][0], x0[ks][1]); w.y = pk2(x0[ks][2], x0[ks][3]); w.z = pk2(x1[ks][0], x1[ks][1]); w.w = pk2(x1[ks][2], x1[ks][3]);
        const bf16x8 af = __builtin_bit_cast(bf16x8, w);
        acc0 = __builtin_amdgcn_mfma_f32_32x32x16_bf16(af, ldg8(wc0 + ks * 16), acc0, 0, 0, 0);
        acc1 = __builtin_amdgcn_mfma_f32_32x32x16_bf16(af, ldg8(wc1 + ks * 16), acc1, 0, 0, 0); } }
    __syncthreads();
    for (int b = 0; b < nb; ++b) { const int s0 = 8 * b;
#pragma unroll
        for (int e = 0; e < 8; ++e) *(LAS u32x4*)(lds + ust + e * (32 * 136 * 2)) = pf[e];
        __syncthreads();
        if (b + 1 < nb) {
#pragma unroll
            for (int e = 0; e < 8; ++e) pf[e] = *(const u32x4*)(zst + (size_t)(s0 + 8 + e) * DIN); }
        const bool use0 = s0 <= 2 * jt0 + 1;
        bf16x8 b0[8], b1[8];
#pragma unroll
        for (int e = 0; e < 8; ++e) { const int d1 = tl1 - (s0 + e); b1[e] = ldg8(kt + ((size_t)(d1 < 0 ? 0 : d1) * 16 + co) * 16 + 8 * h);
            if (use0) { const int d0 = tl0 - (s0 + e); b0[e] = ldg8(kt + ((size_t)(d0 < 0 ? 0 : d0) * 16 + co) * 16 + 8 * h); } }
#pragma unroll
        for (int e = 0; e < 8; ++e) { const bf16x8 af = *(const LAS bf16x8*)(UT + (e * 32 + c0) * 136 + wave * 16 + 8 * h);
            const int d1 = tl1 - (s0 + e); bf16x8 bb = b1[e]; if (d1 < 0) bb = (bf16x8){0, 0, 0, 0, 0, 0, 0, 0};
            acc1 = __builtin_amdgcn_mfma_f32_32x32x16_bf16(af, bb, acc1, 0, 0, 0);
            if (use0) { const int d0 = tl0 - (s0 + e); bf16x8 ba = b0[e]; if (d0 < 0) ba = (bf16x8){0, 0, 0, 0, 0, 0, 0, 0};
                acc0 = __builtin_amdgcn_mfma_f32_32x32x16_bf16(af, ba, acc0, 0, 0, 0); } }
        __syncthreads();
    }
#pragma unroll
    for (int q = 0; q < 2; ++q) { const int tl = q ? tl1 : tl0;
#pragma unroll
        for (int i = 0; i < 16; ++i) { const int m = crow(i, h); const size_t tok = (size_t)(cb * 32 + m) * 64 + tl; const float u = bf2f(Z[tok * DIN + ZCU + g * 16 + co]);
            const float y = (q ? acc1[i] : acc0[i]) + dsk * u; const float ge = y * sigmoidf_(1.5957691216057308f * (y + 0.044715f * y * y * y));
            OT[(q * 64 + m * 2 + (c0 >> 4)) * 136 + wave * 16 + co] = (bf16_t)f2bf(ge); } }
    __syncthreads();
    { const int tau = tid >> 2, qq = tau >> 6, m = (tau >> 1) & 31, t2 = tau & 1, qt = tid & 3; const int jt = qq ? jt1 : jt0;
      const size_t tok = (size_t)(cb * 32 + m) * 64 + 2 * jt + t2;
      const LAS u32x4* src = (const LAS u32x4*)(OT + tau * 136 + qt * 32); u32x4* dst = (u32x4*)((bf16_t*)(p.ws + WS_YPRE) + tok * 256 + gh * 128 + qt * 32);
#pragma unroll
      for (int e = 0; e < 4; ++e) dst[e] = src[e]; }
}

DI void attn_item(const Params& p, LAS unsigned char* lds, int l, int pt, int id) {
    int tid_o = threadIdx.x; asm volatile("" : "+v"(tid_o));
    const int tid = tid_o, lane = tid & 63, wave = tid >> 6;
    const int dil = pt == 0 ? 1 : (pt == 1 ? 4 : 16), nblk = 32 / dil;
    const int b = id >> 7, hd = (id >> 5) & 3, rn = id & 31, r = rn / nblk, n = rn % nblk;
    LAS bf16_t* Ks = (LAS bf16_t*)lds;
    LAS bf16_t* Vt = (LAS bf16_t*)(lds + 55296);
    LAS float* BT = (LAS float*)(lds + 55296 + 50176);
    const bf16_t* Z = (const bf16_t*)(p.ws + WS_Z);
    const bf16_t* OP = (const bf16_t*)(p.ws + (pt == 1 ? WS_O0 : WS_O1)); const float* LP = (const float*)(p.ws + (pt == 1 ? WS_LSE : WS_LSE1));
    bf16_t* ON = pt == 2 ? (bf16_t*)(p.ws + WS_Z) + ZOD : (bf16_t*)(p.ws + (pt == 0 ? WS_O0 : WS_O1)); const int onp = pt == 2 ? DIN : 256;
    float* LN = (float*)(p.ws + (pt == 0 ? WS_LSE : WS_LSE1));
    const size_t tokb = (size_t)b * SEQ;
    const int c0 = lane & 31, h = lane >> 5;
    const int qi = 32 * wave + c0; const size_t tokq = tokb + (size_t)(n * 256 + qi) * dil + r;
    u32x4 qraw[4]; u32x2 oprev[2][4]; float mprev = 0.f;
#pragma unroll
    for (int ks = 0; ks < 4; ++ks) qraw[ks] = *(const u32x4*)(Z + tokq * DIN + ZDQ + hd * 64 + ks * 16 + 8 * h);
    if (pt > 0) { mprev = LP[tokq * 4 + hd];
#pragma unroll
        for (int vt = 0; vt < 2; ++vt)
#pragma unroll
            for (int g4 = 0; g4 < 4; ++g4) oprev[vt][g4] = *(const u32x2*)(OP + tokq * 256 + hd * 64 + 32 * vt + 8 * g4 + 4 * h); }
    __syncthreads();
    if (tid < 132) BT[tid] = ((const float*)(p.ws + WS_BIAS))[(pt * 4 + hd) * 132 + tid];
    { const float* kg = p.in[I_KG] + l * 64 + (tid & 7) * 8; float kgv[8];
#pragma unroll
      for (int e = 0; e < 8; ++e) kgv[e] = kg[e];
      u32x4 kwv[6], vwv[6];
#pragma unroll
      for (int it = 0; it < 6; ++it) { const int idx = tid + 512 * it, row = idx >> 3, c = idx & 7, si = n * 256 - 128 + row;
        const size_t tok = tokb + (size_t)(si < 0 ? 0 : si) * dil + r;
        kwv[it] = *(const u32x4*)(Z + tok * DIN + ZDK + hd * 64 + c * 8); vwv[it] = *(const u32x4*)(Z + tok * DIN + ZDV + hd * 64 + c * 8); }
#pragma unroll
      for (int it = 0; it < 6; ++it) { const int idx = tid + 512 * it, row = idx >> 3, c = idx & 7, si = n * 256 - 128 + row;
        u32x4 kw = kwv[it], vw = vwv[it];
        if (si < 0) { kw = (u32x4){0u, 0u, 0u, 0u}; vw = (u32x4){0u, 0u, 0u, 0u}; }
        float kf[8]; kf[0] = bflo(kw.x); kf[1] = bfhi(kw.x); kf[2] = bflo(kw.y); kf[3] = bfhi(kw.y); kf[4] = bflo(kw.z); kf[5] = bfhi(kw.z); kf[6] = bflo(kw.w); kf[7] = bfhi(kw.w);
        float ss = 0.f;
#pragma unroll
        for (int e = 0; e < 8; ++e) ss += kf[e] * kf[e];
        ss = sum8_(ss);
        const float rs = rsqrtf(ss * (1.0f / 64.0f) + EPS);
        u32x4 o; o.x = pk2(kf[0] * rs * kgv[0], kf[1] * rs * kgv[1]); o.y = pk2(kf[2] * rs * kgv[2], kf[3] * rs * kgv[3]); o.z = pk2(kf[4] * rs * kgv[4], kf[5] * rs * kgv[5]); o.w = pk2(kf[6] * rs * kgv[6], kf[7] * rs * kgv[7]);
        *(LAS u32x4*)(Ks + row * 72 + c * 8) = o;
        LAS bf16_t* vp = Vt + (c * 8) * 392 + row;
        vp[0 * 392] = (bf16_t)(vw.x & 0xffffu); vp[1 * 392] = (bf16_t)(vw.x >> 16); vp[2 * 392] = (bf16_t)(vw.y & 0xffffu); vp[3 * 392] = (bf16_t)(vw.y >> 16);
        vp[4 * 392] = (bf16_t)(vw.z & 0xffffu); vp[5 * 392] = (bf16_t)(vw.z >> 16); vp[6 * 392] = (bf16_t)(vw.w & 0xffffu); vp[7 * 392] = (bf16_t)(vw.w >> 16); } }
    __syncthreads();
    bf16x8 qf[4];
    { float qv[4][8]; float ss = 0.f;
#pragma unroll
      for (int ks = 0; ks < 4; ++ks) { const u32x4 w = qraw[ks];
        qv[ks][0] = bflo(w.x); qv[ks][1] = bfhi(w.x); qv[ks][2] = bflo(w.y); qv[ks][3] = bfhi(w.y); qv[ks][4] = bflo(w.z); qv[ks][5] = bfhi(w.z); qv[ks][6] = bflo(w.w); qv[ks][7] = bfhi(w.w);
#pragma unroll
        for (int e = 0; e < 8; ++e) ss += qv[ks][e] * qv[ks][e]; }
      ss += __shfl_xor(ss, 32);
      const float rs = rsqrtf(ss * (1.0f / 64.0f) + EPS) * 0.125f;
#pragma unroll
      for (int ks = 0; ks < 4; ++ks) { const float* qg = p.in[I_QG] + l * 64 + ks * 16 + 8 * h; const f32x4 g0 = *(const f32x4*)qg, g1 = *(const f32x4*)(qg + 4);
        u32x4 w; w.x = pk2(qv[ks][0] * rs * g0[0], qv[ks][1] * rs * g0[1]); w.y = pk2(qv[ks][2] * rs * g0[2], qv[ks][3] * rs * g0[3]);
        w.z = pk2(qv[ks][4] * rs * g1[0], qv[ks][5] * rs * g1[1]); w.w = pk2(qv[ks][6] * rs * g1[2], qv[ks][7] * rs * g1[3]);
        qf[ks] = __builtin_bit_cast(bf16x8, w); } }
    f32x16 acc[5];
#pragma unroll
    for (int c = 0; c < 5; ++c) { acc[c] = zero16(); const LAS bf16_t* kb = Ks + (32 * wave + 32 * c + c0) * 72 + 8 * h;
#pragma unroll
        for (int ks = 0; ks < 4; ++ks) acc[c] = __builtin_amdgcn_mfma_f32_32x32x16_bf16(*(const LAS bf16x8*)(kb + ks * 16), qf[ks], acc[c], 0, 0, 0); }
    float mx = -1e30f;
    { const int tq = c0 - 4 * h, kmin = 128 - n * 256; const LAS float* pb = BT + tq - 32;
#pragma unroll
      for (int c = 0; c < 5; ++c) { const int th = kmin - (32 * wave + 32 * c) - 4 * h;
#pragma unroll
        for (int i = 0; i < 16; ++i) { const int ci = (i & 3) + 8 * (i >> 2);
            bool valid = ci >= th;
            if (c == 0) valid = valid && (tq <= ci);
            if (c == 4) valid = valid && (tq >= ci);
            const float lgt = valid ? acc[c][i] + pb[160 - 32 * c - ci] : -1e30f; acc[c][i] = lgt; mx = fmaxf(mx, lgt); } } }
    mx = fmaxf(mx, __shfl_xor(mx, 32));
    float mnew = mx;
    if (pt > 0) mnew = fmaxf(mx, mprev);
    float lsum = 0.f;
#pragma unroll
    for (int c = 0; c < 5; ++c)
#pragma unroll
        for (int i = 0; i < 16; ++i) { const float pv = __expf(acc[c][i] - mnew); acc[c][i] = pv; lsum += pv; }
    lsum += __shfl_xor(lsum, 32);
    f32x16 o[2]; o[0] = zero16(); o[1] = zero16();
#pragma unroll
    for (int c = 0; c < 5; ++c)
#pragma unroll
        for (int s = 0; s < 2; ++s) { u32x4 pw; pw.x = pk2(acc[c][8 * s + 0], acc[c][8 * s + 1]); pw.y = pk2(acc[c][8 * s + 2], acc[c][8 * s + 3]); pw.z = pk2(acc[c][8 * s + 4], acc[c][8 * s + 5]); pw.w = pk2(acc[c][8 * s + 6], acc[c][8 * s + 7]);
            const bf16x8 pf = __builtin_bit_cast(bf16x8, pw);
#pragma unroll
            for (int vt = 0; vt < 2; ++vt) { const LAS bf16_t* va = Vt + (32 * vt + c0) * 392 + 32 * wave + 32 * c + 16 * s + 4 * h;
                const s16x4 lo = *(const LAS s16x4*)va, hi = *(const LAS s16x4*)(va + 8);
                const bf16x8 vf = __builtin_shufflevector(lo, hi, 0, 1, 2, 3, 4, 5, 6, 7);
                o[vt] = __builtin_amdgcn_mfma_f32_32x32x16_bf16(vf, pf, o[vt], 0, 0, 0); } }
    float sp = 0.f; if (pt > 0) sp = __expf(mprev - mnew);
    const float ltot = lsum + sp, inv = __builtin_amdgcn_rcpf(ltot);
#pragma unroll
    for (int vt = 0; vt < 2; ++vt)
#pragma unroll
        for (int g4 = 0; g4 < 4; ++g4) { const int ch = hd * 64 + 32 * vt + 8 * g4 + 4 * h; bf16_t* yo = ON + tokq * onp + ch;
            float v0 = o[vt][4 * g4 + 0], v1 = o[vt][4 * g4 + 1], v2 = o[vt][4 * g4 + 2], v3 = o[vt][4 * g4 + 3];
            if (pt > 0) { const u32x2 w = oprev[vt][g4]; v0 += sp * bflo(w.x); v1 += sp * bfhi(w.x); v2 += sp * bflo(w.y); v3 += sp * bfhi(w.y); }
            u32x2 w; w.x = pk2(v0 * inv, v1 * inv); w.y = pk2(v2 * inv, v3 * inv); *(u32x2*)yo = w; }
    if (h == 0 && pt < 2) __hip_atomic_store(LN + tokq * 4 + hd, mnew + __logf(ltot), __ATOMIC_RELAXED, __HIP_MEMORY_SCOPE_AGENT);
}

#define RLX_AGENT __ATOMIC_RELAXED, __HIP_MEMORY_SCOPE_AGENT
#define XB_TMO      128
#define XB_XCNT(j)  (256  + 64 * (j))
#define XB_XSUB(j)  (1280 + 64 * (j))
#define XB_XGEN(j)  (2304 + 64 * (j))
#define XB_TOP      3328
#define XB_TOPGEN   3392
#define XCD_BAR_WORDS 3456
#define XB_SPIN_CAP (1u << 18)

__device__ __forceinline__ unsigned xb_ld(unsigned* p)              { return __hip_atomic_load(p, __ATOMIC_RELAXED, __HIP_MEMORY_SCOPE_AGENT); }
__device__ __forceinline__ unsigned xb_add(unsigned* p, unsigned v) { return __hip_atomic_fetch_add(p, v, __ATOMIC_RELAXED, __HIP_MEMORY_SCOPE_AGENT); }
__device__ __forceinline__ unsigned xb_xcc_id() { return (unsigned)__builtin_amdgcn_s_getreg((3 << 11) | 20) & 0xFu; }
#define XB_SPIN(cond, bar) do { unsigned _sp = 0; while (cond) { __builtin_amdgcn_s_sleep(1); \
    if ((++_sp & 255u) == 0u) { if (xb_ld(&(bar)[XB_TMO])) break; if (_sp > XB_SPIN_CAP) { atomicAdd(&(bar)[XB_TMO], 1u); break; } } } } while (0)

struct XcdBarrier {
    unsigned* bar; unsigned x;
    volatile LAS unsigned* st;
};

__device__ __forceinline__ XcdBarrier xcd_barrier_post(unsigned* bar, volatile LAS unsigned* st) {
    XcdBarrier b; b.bar = bar; b.x = xb_xcc_id(); b.st = st;
    if (threadIdx.x == 0) (void)xb_add(&bar[XB_XCNT(b.x)], 1u);
    return b;
}
__device__ __forceinline__ void xcd_barrier_complete(unsigned* bar, unsigned x, unsigned& nloc, unsigned& nx) {
    const unsigned G = gridDim.x * gridDim.y * gridDim.z;
    unsigned sum, cnt, mine, sp = 0u;
    for (;;) {
        sum = 0u; cnt = 0u; mine = 0u;
#pragma unroll
        for (unsigned j = 0; j < 16; ++j) { const unsigned c = xb_ld(&bar[XB_XCNT(j)]); sum += c; cnt += (c > 0u) ? 1u : 0u; mine = (j == x) ? c : mine; }
        if (sum == G) break;
        __builtin_amdgcn_s_sleep(1);
        if ((++sp & 255u) == 0u) { if (xb_ld(&bar[XB_TMO])) break; if (sp > XB_SPIN_CAP) { atomicAdd(&bar[XB_TMO], 1u); break; } }
    }
    nloc = mine > 0u ? mine : 1u; nx = cnt > 0u ? cnt : 1u;
}

__device__ __forceinline__ void xcd_barrier(const XcdBarrier& b) {
    asm volatile("s_waitcnt vmcnt(0)" ::: "memory");
    __syncthreads();
    if (threadIdx.x == 0) {
        unsigned* bar = b.bar;
        __builtin_amdgcn_s_waitcnt(0);
        unsigned nloc = b.st[0], nx = b.st[1];
        if (nloc == 0u) { xcd_barrier_complete(bar, b.x, nloc, nx); b.st[0] = nloc; b.st[1] = nx; }
        const unsigned old = xb_add(&bar[XB_XSUB(b.x)], 1u);
        const unsigned gen = old / nloc;
        if (old + 1u == (gen + 1u) * nloc) {
            __builtin_amdgcn_fence(__ATOMIC_RELEASE, "agent");
            asm volatile("s_waitcnt vmcnt(0)" ::: "memory");
            const unsigned og = xb_add(&bar[XB_TOP], 1u);
            const unsigned tg = og / nx;
            if (og + 1u == (tg + 1u) * nx) xb_add(&bar[XB_TOPGEN], 1u);
            else XB_SPIN(xb_ld(&bar[XB_TOPGEN]) == tg, bar);
            __builtin_amdgcn_fence(__ATOMIC_ACQUIRE, "agent");
            xb_add(&bar[XB_XGEN(b.x)], 1u);
            asm volatile("s_waitcnt vmcnt(0)" ::: "memory");
        } else {
            XB_SPIN(xb_ld(&bar[XB_XGEN(b.x)]) == gen, bar);
            __builtin_amdgcn_fence(__ATOMIC_ACQUIRE, "agent");
            asm volatile("s_waitcnt vmcnt(0)" ::: "memory");
        }
    }
    __syncthreads();
}

#ifndef REP_A
#define REP_A 0
#endif
#ifndef REP_B
#define REP_B 0
#endif
#ifndef REP_C
#define REP_C 0
#endif
#ifndef REP_D
#define REP_D 0
#endif
#ifndef MIX_A
#define MIX_A 1
#endif
#ifndef MIX_B
#define MIX_B 1
#endif
#ifndef MIX_C
#define MIX_C 1
#endif
#ifndef MIX_D
#define MIX_D 1
#endif
__global__ void __launch_bounds__(512, 2) hybrid_fwd(Params p) {
    extern __shared__ __attribute__((aligned(16))) unsigned char lds_raw[];
    LAS unsigned char* lds = (LAS unsigned char*)lds_raw;
    cg::grid_group grid = cg::this_grid();
    { volatile LAS unsigned* st0 = (volatile LAS unsigned*)(lds + LDS_BYTES - 64); if (threadIdx.x < 2) st0[threadIdx.x] = 0u; }
    __syncthreads();
    (void)xcd_barrier_post((unsigned*)(p.ws + WS_BAR), (volatile LAS unsigned*)(lds + LDS_BYTES - 64));
    const int G = gridDim.x, bid = blockIdx.x;
    unsigned char* ws = p.ws;
    bf16_t* XB = (bf16_t*)(ws + WS_XB); bf16_t* Zb = (bf16_t*)(ws + WS_Z); bf16_t* YC_ = (bf16_t*)(ws + WS_YCAT); bf16_t* HM = (bf16_t*)(ws + WS_HM);
    float* SSQP = (float*)(ws + WS_SSQP);

#define GRID_SYNC_() do { asm volatile("s_waitcnt vmcnt(0) lgkmcnt(0)" ::: "memory"); grid.sync(); if (threadIdx.x < 64) { __builtin_amdgcn_fence(__ATOMIC_ACQUIRE, "agent"); asm volatile("s_waitcnt vmcnt(0)" ::: "memory"); } __syncthreads(); } while (0)
#define XBAR_ONCE() do { XcdBarrier b_; b_.bar = (unsigned*)(p.ws + WS_BAR); b_.x = xb_xcc_id(); b_.st = (volatile LAS unsigned*)(lds + LDS_BYTES - 64); xcd_barrier(b_); } while (0)
#ifdef REP_SYNC
#define GRID_SYNC() do { XBAR_ONCE(); XBAR_ONCE(); } while (0)
#else
#define GRID_SYNC() XBAR_ONCE()
#endif
    prologue(p, lds, G);
#ifdef REP_PRO
    GRID_SYNC_(); prologue(p, lds, G);
#endif
#ifdef NANFILL
    { u32x4* q = (u32x4*)(ws + WS_S5H); const size_t n16 = (WS_END - WS_S5H) / 16; const u32x4 nanv = (u32x4){0xffffffffu, 0xffffffffu, 0xffffffffu, 0xffffffffu};
      for (size_t i = (size_t)bid * 512 + threadIdx.x; i < n16; i += (size_t)G * 512) q[i] = nanv;
      u32x4* q2 = (u32x4*)(ws + WS_LSE); const size_t m16 = (WS_S5K - WS_LSE) / 16;
      for (size_t i = (size_t)bid * 512 + threadIdx.x; i < m16; i += (size_t)G * 512) q2[i] = nanv; }
#endif
    if (gridDim.y == 0x7fffffffu) GRID_SYNC_();
    GRID_SYNC();

#ifndef NL_RUN
#define NL_RUN NL
#endif
#ifndef DUMP_LAYER
#define DUMP_LAYER 0
#endif
    for (int lrun = 0; lrun < NL_RUN; ++lrun) {
#ifdef SAME_LAYER
        const int l = 0; const bool firstl = (lrun == 0), lastl = (lrun == NL_RUN - 1);
#else
        const int l = lrun; const bool firstl = (lrun == 0), lastl = (lrun == NL_RUN - 1);
#endif
#define RS_TABLE(SSQ_, NUNITS_) \
          { pg8::Unit ua_, ub_; (void)S.next(0, ua_); (void)S.next((NUNITS_) - 1, ub_); \
              int tq_ = threadIdx.x; asm volatile("" : "+v"(tq_)); const int pm_ = (tq_ >> 8) ? ub_.pm : ua_.pm; \
              const f32x4* sq_ = (const f32x4*)((SSQ_) + ((size_t)pm_ * 256 + (tq_ & 255)) * 16); const f32x4 q0 = sq_[0], q1 = sq_[1], q2 = sq_[2], q3 = sq_[3]; \
              const float tot_ = (((q0[0] + q0[1]) + (q0[2] + q0[3])) + ((q1[0] + q1[1]) + (q1[2] + q1[3]))) + (((q2[0] + q2[1]) + (q2[2] + q2[3])) + ((q3[0] + q3[1]) + (q3[2] + q3[3]))); \
              ((LAS float*)(lds + 131072))[tq_] = rsqrtf(tot_ * (1.0f / 1024.0f) + EPS); __syncthreads(); }
        { pg8::Gemm g{XB, (const bf16_t*)(ws + WS_WIN) + (size_t)l * D * DIN, T, DIN, D, D}; pg8::StaticOrder S; S.init(T, DIN, G, bid);
          RS_TABLE(SSQP, (T / 256) * (DIN / 256) / 256)
          pg8::EpiScale E{Zb, DIN, 0, (const PG8_LAS float*)(lds + 131072)};
          pg8::gemm_phase<pg8::EpiScale, pg8::StaticOrder, true, true>(lds, g, S, E);
#ifdef REPEAT_GEMM
          GRID_SYNC(); pg8::gemm_phase<pg8::EpiScale, pg8::StaticOrder, true, true>(lds, g, S, E);
#endif
        }
        GRID_SYNC();
#ifndef SKIP_MIX
        if (!(MIX_A && MIX_B && MIX_C && MIX_D)) { int tq = threadIdx.x; asm volatile("" : "+v"(tq));
          for (int m = bid * 8 + (tq >> 6); m < T; m += G * 8) { u32x2* yp = (u32x2*)(YC_ + (size_t)m * D) + (tq & 63); const u32x2 z2 = (u32x2){0u, 0u};
              if (!MIX_A) yp[0] = z2; if (!MIX_B) yp[64] = z2; if (!MIX_C) yp[128] = z2; if (!MIX_D) yp[192] = z2; } }
#ifndef MIX_REPEAT
#define MIX_REPEAT 1
#endif
        for (int rep = 0; rep < MIX_REPEAT; ++rep) {
        for (int it = bid; it < 1664; it += G) {
            if (it < 512) { if (MIX_A) { hgrn_item<false>(p, lds, l, it); if (REP_A) hgrn_item<false>(p, lds, l, it); } }
            else if (it < 1024) { if (MIX_B) { conv_item(p, lds, l, it - 512); if (REP_B) conv_item(p, lds, l, it - 512); } }
            else if (it < 1152) { if (MIX_C) { s5_local_item(p, lds, l, it - 1024); if (REP_C) s5_local_item(p, lds, l, it - 1024); } }
            else { if (MIX_D) { attn_item(p, lds, l, 0, it - 1152); if (REP_D) attn_item(p, lds, l, 0, it - 1152); } }
        }
        GRID_SYNC();
        if (bid < 128) { if (MIX_A) hgrn_scan_item(p, bid); } else if (bid < 136) { if (MIX_C) s5_scan_item(p, l, bid - 128); }
        if (bid < 136) { if (MIX_D) { attn_item(p, lds, l, 1, 360 + bid); if (REP_D) attn_item(p, lds, l, 1, 360 + bid); if (bid < 16) attn_item(p, lds, l, 1, 496 + bid); } }
        else for (int it = bid - 136; it < 360; it += 120) { if (MIX_D) { attn_item(p, lds, l, 1, it); if (REP_D) attn_item(p, lds, l, 1, it); } }
        GRID_SYNC();
#ifdef REP_P3
        if (bid < 128) { if (MIX_A) hgrn_scan_item(p, bid); } else if (bid < 136) { if (MIX_C) s5_scan_item(p, l, bid - 128); }
        if (bid < 136) { if (MIX_D) { attn_item(p, lds, l, 1, 360 + bid); if (REP_D) attn_item(p, lds, l, 1, 360 + bid); if (bid < 16) attn_item(p, lds, l, 1, 496 + bid); } }
        else for (int it = bid - 136; it < 360; it += 120) { if (MIX_D) { attn_item(p, lds, l, 1, it); if (REP_D) attn_item(p, lds, l, 1, it); } }
        GRID_SYNC();
#endif
        for (int it = bid; it < 1536; it += G) {
            if (it < 512) { if (MIX_A) { hgrn_item<true>(p, lds, l, it); if (REP_A) hgrn_item<true>(p, lds, l, it); } }
            else if (it < 1024) { if (MIX_C) { s5_out_item(p, lds, l, it - 512); if (REP_C) s5_out_item(p, lds, l, it - 512); } }
            else { if (MIX_D) { attn_item(p, lds, l, 2, it - 1024); if (REP_D) attn_item(p, lds, l, 2, it - 1024); } }
        }
        GRID_SYNC();
        }
#ifndef NO_GLU
        { pg8::Gemm g{(const bf16_t*)(ws + WS_YPRE), (const bf16_t*)(ws + WS_WGLU) + (size_t)l * 65536, T, 256, 256, 256}; pg8::StaticOrder S; S.init(T, 256, G, bid);
          pg8::EpiGlu E{(const bf16_t*)(ws + WS_YPRE), 256, YC_ + YC};
          pg8::gemm_phase<pg8::EpiGlu, pg8::StaticOrder, false, true>(lds, g, S, E); }
#endif
        { int tq = threadIdx.x; asm volatile("" : "+v"(tq)); const int lane = tq & 63; const int gw = (bid - 128) * 8 + (tq >> 6), NGW = 128 * 8;
          if (bid >= 128) for (int m = gw; m < T; m += NGW) { u32x2* yp = (u32x2*)(YC_ + (size_t)m * D + YD) + lane; const u32x2 w = *((const u32x2*)(Zb + (size_t)m * DIN + ZOD) + lane);
              const float a0 = bflo(w.x), a1 = bfhi(w.x), a2 = bflo(w.y), a3 = bfhi(w.y);
              const float ss = wave_sum((a0 * a0 + a1 * a1) + (a2 * a2 + a3 * a3)); const float rs = rsqrtf(ss * (1.0f / 256.0f) + EPS);
              u32x2 o; o.x = pk2(a0 * rs, a1 * rs); o.y = pk2(a2 * rs, a3 * rs); *yp = o; } }
        GRID_SYNC();
#endif
#ifdef REP_P5
#ifndef NO_GLU
        { pg8::Gemm g{(const bf16_t*)(ws + WS_YPRE), (const bf16_t*)(ws + WS_WGLU) + (size_t)l * 65536, T, 256, 256, 256}; pg8::StaticOrder S; S.init(T, 256, G, bid);
          pg8::EpiGlu E{(const bf16_t*)(ws + WS_YPRE), 256, YC_ + YC};
          pg8::gemm_phase<pg8::EpiGlu, pg8::StaticOrder, false, true>(lds, g, S, E); }
#endif
        { int tq = threadIdx.x; asm volatile("" : "+v"(tq)); const int lane = tq & 63; const int gw = (bid - 128) * 8 + (tq >> 6), NGW = 128 * 8;
          if (bid >= 128) for (int m = gw; m < T; m += NGW) { u32x2* yp = (u32x2*)(YC_ + (size_t)m * D + YD) + lane; const u32x2 w = *((const u32x2*)(Zb + (size_t)m * DIN + ZOD) + lane);
              const float a0 = bflo(w.x), a1 = bfhi(w.x), a2 = bflo(w.y), a3 = bfhi(w.y);
              const float ss = wave_sum((a0 * a0 + a1 * a1) + (a2 * a2 + a3 * a3)); const float rs = rsqrtf(ss * (1.0f / 256.0f) + EPS);
              u32x2 o; o.x = pk2(a0 * rs, a1 * rs); o.y = pk2(a2 * rs, a3 * rs); *yp = o; } }
        GRID_SYNC();
#endif
#ifdef DUMP_SLICE
        if (lrun == DUMP_LAYER) { int tq = threadIdx.x; asm volatile("" : "+v"(tq));
          for (int m = bid * 8 + (tq >> 6); m < T; m += G * 8) { const int ln = tq & 63;
              for (int j = 0; j < 4; ++j) { const int col = j * 256 + ln * 4; const u32x2 w = *(const u32x2*)(YC_ + (size_t)m * D + col);
                  f32x4 o = (f32x4){0.f, 0.f, 0.f, 0.f}; if (j == DUMP_SLICE) o = (f32x4){bflo(w.x), bfhi(w.x), bflo(w.y), bfhi(w.y)};
                  *(f32x4*)(p.out + (size_t)m * D + col) = o; } }
          break; }
#endif
#ifdef SKIP_MIX
        { pg8::Gemm g{Zb, (const bf16_t*)(ws + WS_WOUT) + (size_t)l * D * D, T, D, D, DIN}; pg8::StaticOrder S; S.init(T, D, G, bid);
#else
        { pg8::Gemm g{YC_, (const bf16_t*)(ws + WS_WOUT) + (size_t)l * D * D, T, D, D, D}; pg8::StaticOrder S; S.init(T, D, G, bid);
#endif
          pg8::EpiRes E{firstl ? p.in[I_X] : p.out, p.out, XB, SSQP + (size_t)T * 16};
          pg8::gemm_phase<pg8::EpiRes, pg8::StaticOrder, true, true>(lds, g, S, E); }
        GRID_SYNC();
        { pg8::Gemm g{XB, (const bf16_t*)(ws + WS_WUP) + (size_t)l * D * FF, T, FF, D, D}; pg8::StaticOrder S; S.init(T, FF, G, bid);
          RS_TABLE(SSQP + (size_t)T * 16, (T / 256) * (FF / 256) / 256)
          pg8::EpiScale E{HM, FF, 1, (const PG8_LAS float*)(lds + 131072)};
          pg8::gemm_phase<pg8::EpiScale, pg8::StaticOrder, true, true>(lds, g, S, E);
#ifdef REPEAT_GEMM
          GRID_SYNC(); pg8::gemm_phase<pg8::EpiScale, pg8::StaticOrder, true, true>(lds, g, S, E);
#endif
        }
        GRID_SYNC();
        { pg8::Gemm g{HM, (const bf16_t*)(ws + WS_WDN) + (size_t)l * D * FF, T, D, FF, FF}; pg8::StaticOrder S; S.init(T, D, G, bid);
          pg8::EpiRes E{p.out, p.out, XB, !lastl ? SSQP : nullptr};
          pg8::gemm_phase<pg8::EpiRes, pg8::StaticOrder, true, true>(lds, g, S, E); }
        if (!lastl) GRID_SYNC();
    }
}

extern "C" void kernel_launch(void* const* d_in, const int* in_sizes, int n_in, void* d_out, int out_size, void* d_ws, size_t ws_size, hipStream_t stream) {
    static int grid = 0;
    if (grid == 0) {
        if (n_in != 26 || out_size != T * D || ws_size < WS_END) { fprintf(stderr, "kernel_launch: unexpected shapes (n_in %d, out %d, ws %zu); nothing launched\n", n_in, out_size, ws_size); grid = -1; return; }
        int dev = 0, cus = 0, per_cu = 0;
        (void)hipGetDevice(&dev); (void)hipDeviceGetAttribute(&cus, hipDeviceAttributeMultiprocessorCount, dev);
        if (hipFuncSetAttribute((const void*)hybrid_fwd, hipFuncAttributeMaxDynamicSharedMemorySize, LDS_BYTES) != hipSuccess) { fprintf(stderr, "kernel_launch: hipFuncSetAttribute failed\n"); grid = -1; return; }
        if (hipOccupancyMaxActiveBlocksPerMultiprocessor(&per_cu, (const void*)hybrid_fwd, 512, LDS_BYTES) != hipSuccess || per_cu < 1) { fprintf(stderr, "kernel_launch: occupancy query gave %d\n", per_cu); per_cu = 1; }
        (void)hipGetLastError();
        if (cus <= 0) cus = 256;
        grid = cus * per_cu;
    }
    if (grid < 0) return;
    if (hipMemsetAsync((char*)d_ws + WS_BAR, 0, XCD_BAR_WORDS * 4, stream) != hipSuccess) { fprintf(stderr, "kernel_launch: hipMemsetAsync of the barrier words failed\n"); return; }
    static int rs_ok = -1;
    if (rs_ok < 0) { rs_ok = (grid == 256) ? 1 : 0;
        const int ncol[2] = {DIN / 256, FF / 256};
        for (int ph = 0; ph < 2 && rs_ok; ++ph) { const int nun = (T / 256) * ncol[ph] / 256;
            for (int c = 0; c < grid && rs_ok; ++c) { pg8::StaticOrder S; S.init(T, ncol[ph] * 256, grid, c); pg8::Unit u0, u1, ui; if (!S.next(0, u0) || !S.next(nun - 1, u1) || S.next(nun, ui)) { rs_ok = 0; break; }
                if (((u0.pm >> 3) & 1) != 0 || ((u1.pm >> 3) & 1) != 1) { rs_ok = 0; break; }
                for (int i = 0; i < nun; ++i) { S.next(i, ui); if (ui.pm != (((ui.pm >> 3) & 1) ? u1.pm : u0.pm)) { rs_ok = 0; break; } } } } }
    Params a{};
    for (int i = 0; i < 26; ++i) a.in[i] = (const float*)d_in[i];
    if (!rs_ok) { fprintf(stderr, "kernel_launch: unit order does not keep a workgroup inside two row panels (grid %d); nothing launched\n", grid); return; }
    a.out = (float*)d_out; a.ws = (unsigned char*)d_ws; a.rs_lds = rs_ok; a.pad = 0;
    void* args[] = {&a};
    hipError_t e = hipLaunchCooperativeKernel((const void*)hybrid_fwd, dim3(grid), dim3(512), args, LDS_BYTES, stream);
    if (e != hipSuccess) fprintf(stderr, "cooperative launch failed: %s (grid %d)\n", hipGetErrorString(e), grid);
}
```

```cpp
#include <hip/hip_runtime.h>
#include <hip/hip_cooperative_groups.h>
#include <cstdio>
#include <cstdint>
namespace cg = cooperative_groups;

#define DI __device__ __forceinline__
#define LAS __attribute__((address_space(3)))
typedef unsigned short bf16_t;
typedef short bf16x8 __attribute__((ext_vector_type(8)));
typedef short s16x4 __attribute__((ext_vector_type(4)));
typedef float f32x4 __attribute__((ext_vector_type(4)));
typedef float f32x16 __attribute__((ext_vector_type(16)));
typedef unsigned u32x4 __attribute__((ext_vector_type(4)));
typedef unsigned u32x2 __attribute__((ext_vector_type(2)));

constexpr int NB = 4, SEQ = 8192, T = NB * SEQ, D = 1024, DIN = 2560, FF = 4096, NL = 4;
constexpr int ZQ = 0, ZF = 256, ZI = 512, ZG = 768, ZBV = 1024, ZBG = 1280, ZCU = 1536, ZDQ = 1792, ZDK = 2048, ZDV = 2304;
constexpr int YA = 0, YB = 256, YC = 512, YD = 768;
constexpr int ZOD = ZBG;
constexpr float EPS = 1e-6f;
constexpr size_t MiB = 1u << 20;
constexpr size_t WS_WIN = 0, WS_WOUT = 20 * MiB, WS_WUP = 28 * MiB, WS_WDN = 60 * MiB, WS_WGLU = 92 * MiB;
constexpr size_t WS_LB = 93 * MiB;
constexpr size_t WS_BIAS = WS_LB + 4096;
constexpr size_t WS_BAR = WS_LB + 32768;
constexpr size_t WS_SSQ = WS_LB + 65536;
constexpr size_t WS_LSE = WS_SSQ + 8 * (size_t)T * 4;
constexpr size_t WS_DEC = WS_LSE + (size_t)T * 16;
constexpr size_t WS_LSE1 = WS_DEC + 2048 * 64 * 4;
constexpr size_t WS_S5K = 96 * MiB;
constexpr size_t WS_S5WS = 98 * MiB;
constexpr size_t WS_S5WC = 114 * MiB;
constexpr size_t WS_XB = 130 * MiB;
constexpr size_t WS_S5H = 194 * MiB;
constexpr size_t WS_HM = 198 * MiB;
constexpr size_t WS_Z = 198 * MiB;
constexpr size_t WS_YCAT = 358 * MiB;
constexpr size_t WS_SL = 422 * MiB, WS_SL2 = 438 * MiB;
constexpr size_t WS_S5H2 = 454 * MiB;
constexpr size_t WS_O0 = 458 * MiB, WS_O1 = 474 * MiB;
constexpr size_t WS_YPRE = 490 * MiB;
constexpr size_t WS_SSQP = 506 * MiB;
constexpr size_t WS_END = 510 * MiB;
static_assert(WS_LSE1 + (size_t)T * 16 <= WS_S5K, "misc region");

constexpr int LDS_BYTES = 147456;

typedef float f32x2_t __attribute__((ext_vector_type(2))); typedef __bf16 bf16x2_t __attribute__((ext_vector_type(2)));
DI unsigned f2bf(float f) { const f32x2_t v = {f, 0.f}; const bf16x2_t b = __builtin_convertvector(v, bf16x2_t); return __builtin_bit_cast(unsigned, b) & 0xffffu; }
DI unsigned pk2(float lo, float hi) { const f32x2_t v = {lo, hi}; const bf16x2_t b = __builtin_convertvector(v, bf16x2_t); return __builtin_bit_cast(unsigned, b); }
DI float bf2f(bf16_t v) { return __builtin_bit_cast(float, (unsigned)v << 16); }
DI float bflo(unsigned w) { return __builtin_bit_cast(float, w << 16); }
DI float bfhi(unsigned w) { return __builtin_bit_cast(float, w & 0xffff0000u); }
DI float sigmoidf_(float x) { return __builtin_amdgcn_rcpf(1.f + __expf(-x)); }
template <int CTRL> DI float dpp_(float v) { return __builtin_bit_cast(float, __builtin_amdgcn_update_dpp(0, __builtin_bit_cast(int, v), CTRL, 0xF, 0xF, false)); }
DI float sum8_(float v) { v += dpp_<0xB1>(v); v += dpp_<0x4E>(v); v += dpp_<0x141>(v); return v; }
DI float sum16_(float v) { v = sum8_(v); v += dpp_<0x140>(v); return v; }
DI float half_sum(float v) { v = sum16_(v); v += __shfl_xor(v, 16); return v; }
DI float wave_sum(float v) { v = half_sum(v); v += __shfl_xor(v, 32); return v; }
#define LDS_WAIT() asm volatile("s_waitcnt lgkmcnt(0)" ::: "memory")
DI int crow(int reg, int h) { return (reg & 3) + 8 * (reg >> 2) + 4 * h; }

template <int K>
DI f32x16 mma_lds(const LAS bf16_t* A, int lda, const LAS bf16_t* B, int ldb, f32x16 acc, int lane) {
    const int r = lane & 31, h = lane >> 5;
    const LAS bf16_t* ap = A + r * lda + 8 * h; const LAS bf16_t* bp = B + r * ldb + 8 * h;
#pragma unroll
    for (int k0 = 0; k0 < K; k0 += 16) {
        const bf16x8 a = *(const LAS bf16x8*)(ap + k0); const bf16x8 b = *(const LAS bf16x8*)(bp + k0);
        acc = __builtin_amdgcn_mfma_f32_32x32x16_bf16(a, b, acc, 0, 0, 0);
    }
    return acc;
}
DI f32x16 zero16() { f32x16 z;
#pragma unroll
    for (int i = 0; i < 16; ++i) z[i] = 0.f;
    return z; }

namespace pg8 {
#define PG8_LAS __attribute__((address_space(3)))
constexpr int BM = 256, BK = 64, HALF = 128, HTB = HALF * BK * 2, STAGE_BYTES = 8 * HTB, NXCD = 8, WGM = 8;
__host__ __device__ __forceinline__ int lds_byte(int r, int c) { const int st = (r >> 4) * 2 + (c >> 5), rr = r & 15, cc = c & 31, ob = rr * 64 + cc * 2; return st * 1024 + (ob ^ (((ob >> 9) & 1) << 5)); }
__host__ __device__ __forceinline__ void stage_rc(int b, int& R, int& C) { const int st = b / 1024, sb = b % 1024, swz = sb ^ (((sb >> 9) & 1) << 5); R = (st >> 1) * 16 + swz / 64; C = (st & 1) * 32 + (swz % 64) / 2; }
__host__ __device__ __forceinline__ int perm32(int rho) { const int n = rho >> 4, i = rho & 15; return 8 * (i >> 2) + 4 * n + (i & 3); }
struct Unit { int pm, pn; };
struct Gemm { const bf16_t* A; const bf16_t* Bt; int M, N, K, lda; };
struct StaticOrder {
    int nM, nN, nwg, G, c;
    __host__ __device__ __forceinline__ void init(int M, int N, int G_, int c_) { nM = M / BM; nN = N / BM; nwg = nM * nN; G = G_; c = c_; }
    __host__ __device__ __forceinline__ bool next(int i, Unit& u) const {
        const long L = (long)i * G + c; if (L >= nwg) return false;
        int wgid = (int)L; { const int q = nwg / NXCD, r = nwg % NXCD, xcd = wgid % NXCD, off = wgid / NXCD; wgid = (xcd < r ? xcd * (q + 1) : r * (q + 1) + (xcd - r) * q) + off; }
        const int nig = WGM * nN, gid = wgid / nig, fm = gid * WGM, gsz = (nM - fm) < WGM ? (nM - fm) : WGM;
        u.pm = fm + ((wgid % nig) % gsz); u.pn = (wgid % nig) / gsz; return true;
    }
    __device__ __forceinline__ void a_ready(const Unit&) const {}
    __device__ __forceinline__ void done(const Unit&) const {}
};
struct EpiScale {
    static constexpr bool PERM = true, AFTER_DRAIN = false;
    bf16_t* O; int ldc; int act; const PG8_LAS float* rsl;
    __device__ __forceinline__ void operator()(const f32x4 (&acc)[2][2][4][2], const Unit& u, int wr, int wc, int fr, int fq) const {
        const int row0 = u.pm * BM + wr * 64 + fr; const int col0 = u.pn * BM + wc * 32 + 8 * fq;
        const int slot = ((u.pm >> 3) & 1) * 256;
#pragma unroll
        for (int ai = 0; ai < 2; ++ai)
#pragma unroll
            for (int m = 0; m < 4; ++m) { const int r = row0 + ai * HALF + m * 16; float rs;
                rs = rsl[slot + ai * HALF + wr * 64 + m * 16 + fr];
                bf16_t* rowp = O + (size_t)r * ldc + col0;
#pragma unroll
                for (int bj = 0; bj < 2; ++bj) { f32x4 v0 = acc[ai][bj][m][0] * rs, v1 = acc[ai][bj][m][1] * rs;
                    if (act) {
#pragma unroll
                        for (int e = 0; e < 4; ++e) { const float a = fmaxf(v0[e], 0.f), b = fmaxf(v1[e], 0.f); v0[e] = a * a; v1[e] = b * b; } }
                    u32x4 w; w.x = pk2(v0[0], v0[1]); w.y = pk2(v0[2], v0[3]); w.z = pk2(v1[0], v1[1]); w.w = pk2(v1[2], v1[3]);
                    *(u32x4*)(rowp + bj * HALF) = w; } }
    }
};
struct EpiRes {
    static constexpr bool PERM = false, AFTER_DRAIN = false;
    const float* base; float* out; bf16_t* xb; float* ssq_out;
    __device__ __forceinline__ void operator()(const f32x4 (&acc)[2][2][4][2], const Unit& u, int wr, int wc, int fr, int fq) const {
        const int col0 = u.pn * BM + wc * 32 + 4 * fq;
#pragma unroll
        for (int ai = 0; ai < 2; ++ai) {
            f32x4 bv[4][2][2];
#pragma unroll
            for (int m = 0; m < 4; ++m) { const size_t off = (size_t)(u.pm * BM + ai * HALF + wr * 64 + m * 16 + fr) * D + col0;
#pragma unroll
                for (int bj = 0; bj < 2; ++bj)
#pragma unroll
                    for (int n = 0; n < 2; ++n) bv[m][bj][n] = *(const f32x4*)(base + off + bj * HALF + n * 16); }
#pragma unroll
            for (int m = 0; m < 4; ++m) { const int r = u.pm * BM + ai * HALF + wr * 64 + m * 16 + fr; const size_t off = (size_t)r * D + col0; float s = 0.f;
#pragma unroll
                for (int bj = 0; bj < 2; ++bj)
#pragma unroll
                    for (int n = 0; n < 2; ++n) { const size_t o2 = off + bj * HALF + n * 16; const f32x4 o = bv[m][bj][n] + acc[ai][bj][m][n];
                        *(f32x4*)(out + o2) = o; u32x2 w; w.x = pk2(o[0], o[1]); w.y = pk2(o[2], o[3]); *(u32x2*)(xb + o2) = w;
                        s += (o[0] * o[0] + o[1] * o[1]) + (o[2] * o[2] + o[3] * o[3]); }
                s += __shfl_xor(s, 16); s += __shfl_xor(s, 32);
                if (fq == 0 && ssq_out) ssq_out[(size_t)r * 16 + u.pn * 4 + wc] = s; } }
    }
};
struct EpiGlu {
    static constexpr bool PERM = false, AFTER_DRAIN = true;
    const bf16_t* Ysrc; int lds_; bf16_t* Y;
    __device__ __forceinline__ void fused(f32x4 (&acc)[2][2][4][2], const Unit& u, int wr, int wc, int fr, int fq, PG8_LAS unsigned char* lds, int wid, int lane) const {
        PG8_LAS float* Pp = (PG8_LAS float*)lds;
        const int col0 = wc * 32 + 4 * fq;
#pragma unroll
        for (int ai = 0; ai < 2; ++ai)
#pragma unroll
            for (int m = 0; m < 4; ++m) { const int rl = ai * HALF + wr * 64 + m * 16 + fr; const size_t off = (size_t)(u.pm * BM + rl) * lds_ + col0; float s = 0.f;
#pragma unroll
                for (int bj = 0; bj < 2; ++bj)
#pragma unroll
                    for (int n = 0; n < 2; ++n) { const u32x2 w = *(const u32x2*)(Ysrc + off + bj * HALF + n * 16); f32x4 a = acc[ai][bj][m][n];
                        const float y0 = bflo(w.x), y1 = bfhi(w.x), y2 = bflo(w.y), y3 = bfhi(w.y);
                        a[0] = y0 * sigmoidf_(a[0]); a[1] = y1 * sigmoidf_(a[1]); a[2] = y2 * sigmoidf_(a[2]); a[3] = y3 * sigmoidf_(a[3]);
                        acc[ai][bj][m][n] = a; s += (a[0] * a[0] + a[1] * a[1]) + (a[2] * a[2] + a[3] * a[3]); }
                s += __shfl_xor(s, 16); s += __shfl_xor(s, 32);
                if (fq == 0) Pp[rl * 4 + wc] = s; }
        __syncthreads();
#pragma unroll
        for (int ai = 0; ai < 2; ++ai)
#pragma unroll
            for (int m = 0; m < 4; ++m) { const int rl = ai * HALF + wr * 64 + m * 16 + fr; const size_t off = (size_t)(u.pm * BM + rl) * D + col0;
                const float tot = (Pp[rl * 4 + 0] + Pp[rl * 4 + 1]) + (Pp[rl * 4 + 2] + Pp[rl * 4 + 3]); const float rs = rsqrtf(tot * (1.0f / 256.0f) + EPS);
#pragma unroll
                for (int bj = 0; bj < 2; ++bj)
#pragma unroll
                    for (int n = 0; n < 2; ++n) { const f32x4 a = acc[ai][bj][m][n] * rs; u32x2 w; w.x = pk2(a[0], a[1]); w.y = pk2(a[2], a[3]); *(u32x2*)(Y + off + bj * HALF + n * 16) = w; } }
    }
};

template <class Epi, class Sched, bool ALIGN_EPI = false, bool SP2 = false>
__device__ __forceinline__ void gemm_phase(PG8_LAS unsigned char* lds, const Gemm g, const Sched& S, const Epi& E) {
    int tid_o = threadIdx.x; asm volatile("" : "+v"(tid_o));
    const int tid = tid_o, wid = __builtin_amdgcn_readfirstlane(tid >> 6), lane = tid & 63, wr = wid >> 2, wc = wid & 3, fr = lane & 15, fq = lane >> 4;
    const int K = g.K, nt = K / BK;
    unsigned voffA[2], voffB[2];
#pragma unroll
    for (int i = 0; i < 2; ++i) { int R, C; stage_rc(tid * 16 + i * 8192, R, C); const int Rb = Epi::PERM ? ((R & ~31) + perm32(R & 31)) : R;
        voffA[i] = (unsigned)(R * g.lda + C) * 2u; voffB[i] = (unsigned)(Rb * K + C) * 2u; }
    const size_t kstep = (size_t)(BK * 2);
    const size_t hstepA = (size_t)HALF * g.lda * 2, hstepB = (size_t)HALF * K * 2;
    const size_t tstepA = 2 * hstepA, tstepB = 2 * hstepB;
    const unsigned ldsw = (unsigned)wid * 1024u;
    const int aoff = lds_byte(wr * 64 + fr, fq * 8), boff = lds_byte(wc * 32 + fr, fq * 8);
#define PG8_SA(b, h) (((b) * 2 + (h)) * HTB)
#define PG8_SB(b, h) ((4 + (b) * 2 + (h)) * HTB)
#define PG8_STAGE(bufoff, gbase, voff) do { _Pragma("unroll") for (int _i = 0; _i < 2; ++_i) \
        __builtin_amdgcn_global_load_lds((const unsigned*)((const char*)(gbase) + (voff)[_i]), (PG8_LAS unsigned*)(lds + (bufoff) + ldsw + _i * 8192), 16, 0, 0); } while (0)
#define PG8_LDA(dst, b, h) do { _Pragma("unroll") for (int m = 0; m < 4; ++m) _Pragma("unroll") for (int k = 0; k < 2; ++k) dst[m][k] = *(const PG8_LAS bf16x8*)(lds + PG8_SA(b, h) + aoff + m * 2048 + k * 1024); } while (0)
#define PG8_LDB(dst, b, h) do { _Pragma("unroll") for (int n = 0; n < 2; ++n) _Pragma("unroll") for (int k = 0; k < 2; ++k) dst[n][k] = *(const PG8_LAS bf16x8*)(lds + PG8_SB(b, h) + boff + n * 2048 + k * 1024); } while (0)
#define PG8_MMA(ai, bj, At, Bt) do { __builtin_amdgcn_s_setprio(1); _Pragma("unroll") for (int m = 0; m < 4; ++m) _Pragma("unroll") for (int n = 0; n < 2; ++n) _Pragma("unroll") for (int k = 0; k < 2; ++k) \
        acc[ai][bj][m][n] = __builtin_amdgcn_mfma_f32_16x16x32_bf16(Bt[n][k], At[m][k], acc[ai][bj][m][n], 0, 0, 0); __builtin_amdgcn_s_setprio(0); } while (0)
#define PG8_WAIT_V(n) asm volatile("s_waitcnt vmcnt(" #n ")" ::: "memory")
#define PG8_WAIT_L(n) asm volatile("s_waitcnt lgkmcnt(" #n ")" ::: "memory")
#define PG8_BAR __builtin_amdgcn_s_barrier()
#define PG8_SCHED __builtin_amdgcn_sched_barrier(0)
    Unit cur, nxt; int ui = 0;
    if (!S.next(0, cur)) return;
    f32x4 acc[2][2][4][2];
#pragma unroll
    for (int a = 0; a < 2; ++a)
#pragma unroll
        for (int b = 0; b < 2; ++b)
#pragma unroll
            for (int m = 0; m < 4; ++m)
#pragma unroll
                for (int n = 0; n < 2; ++n) acc[a][b][m][n] = (f32x4){0.f, 0.f, 0.f, 0.f};
    bf16x8 At[4][2], B0[2][2], B1[2][2];
    const char* cA = (const char*)g.A + (size_t)cur.pm * tstepA; const char* cB = (const char*)g.Bt + (size_t)cur.pn * tstepB;
    S.a_ready(cur);
    if constexpr (SP2) {
        PG8_STAGE(PG8_SB(0, 0), cB, voffB); PG8_STAGE(PG8_SB(0, 1), cB + hstepB, voffB); PG8_STAGE(PG8_SA(0, 0), cA, voffA); PG8_STAGE(PG8_SA(0, 1), cA + hstepA, voffA);
        if (wr == 1) PG8_BAR;
        PG8_WAIT_V(2); PG8_BAR;
        PG8_STAGE(PG8_SB(1, 0), cB + kstep, voffB); PG8_STAGE(PG8_SA(1, 0), cA + kstep, voffA); PG8_STAGE(PG8_SB(1, 1), cB + hstepB + kstep, voffB);
        PG8_WAIT_V(6); PG8_BAR;
    } else {
        PG8_STAGE(PG8_SB(0, 0), cB, voffB); PG8_STAGE(PG8_SA(0, 0), cA, voffA); PG8_STAGE(PG8_SB(0, 1), cB + hstepB, voffB); PG8_STAGE(PG8_SA(0, 1), cA + hstepA, voffA);
        if (wr == 1) PG8_BAR;
        PG8_WAIT_V(4); PG8_BAR;
        PG8_STAGE(PG8_SB(1, 0), cB + kstep, voffB); PG8_STAGE(PG8_SA(1, 0), cA + kstep, voffA); PG8_STAGE(PG8_SB(1, 1), cB + hstepB + kstep, voffB);
        PG8_WAIT_V(6); PG8_BAR;
    }
    for (;;) {
        const bool has_next = S.next(ui + 1, nxt);
        const char* nA = has_next ? (const char*)g.A + (size_t)nxt.pm * tstepA : cA; const char* nB = has_next ? (const char*)g.Bt + (size_t)nxt.pn * tstepB : cB;
        for (int t = 0; t < nt; t += 2) {
            const bool last = (t == nt - 2);
            const char* a1 = cA + (size_t)(t + 1) * kstep;
            const char* a2 = last ? nA : cA + (size_t)(t + 2) * kstep; const char* b2 = last ? nB : cB + (size_t)(t + 2) * kstep;
            const char* a3 = a2 + kstep; const char* b3 = b2 + kstep;
            if (last && has_next) S.a_ready(nxt);
            if constexpr (SP2) {
            PG8_LDB(B0, 0, 0); PG8_LDB(B1, 0, 1); PG8_SCHED; PG8_LDA(At, 0, 0); PG8_STAGE(PG8_SA(1, 1), a1 + hstepA, voffA);
            PG8_WAIT_V(8); PG8_WAIT_L(0); PG8_BAR; PG8_MMA(0, 0, At, B0); PG8_MMA(0, 1, At, B1); PG8_BAR; PG8_SCHED;
            PG8_LDA(At, 0, 1); PG8_STAGE(PG8_SB(0, 0), b2, voffB); PG8_STAGE(PG8_SB(0, 1), b2 + hstepB, voffB); PG8_STAGE(PG8_SA(0, 0), a2, voffA);
            PG8_WAIT_V(8); PG8_WAIT_L(0); PG8_BAR; PG8_MMA(1, 0, At, B0); PG8_MMA(1, 1, At, B1); PG8_BAR; PG8_SCHED;
            PG8_LDB(B0, 1, 0); PG8_LDB(B1, 1, 1); PG8_SCHED; PG8_LDA(At, 1, 0); PG8_STAGE(PG8_SA(0, 1), a2 + hstepA, voffA);
            PG8_WAIT_V(8); PG8_WAIT_L(0); PG8_BAR; PG8_MMA(0, 0, At, B0); PG8_MMA(0, 1, At, B1); PG8_BAR; PG8_SCHED;
            PG8_LDA(At, 1, 1); PG8_STAGE(PG8_SB(1, 0), b3, voffB); PG8_STAGE(PG8_SB(1, 1), b3 + hstepB, voffB); PG8_STAGE(PG8_SA(1, 0), a3, voffA);
            PG8_WAIT_V(8); PG8_WAIT_L(0); PG8_BAR; PG8_MMA(1, 0, At, B0); PG8_MMA(1, 1, At, B1); PG8_BAR; PG8_SCHED;
            } else {
            PG8_LDB(B0, 0, 0); PG8_SCHED; PG8_LDA(At, 0, 0); PG8_STAGE(PG8_SA(1, 1), a1 + hstepA, voffA);
            PG8_WAIT_L(8); PG8_BAR; PG8_WAIT_L(0); PG8_MMA(0, 0, At, B0); PG8_BAR; PG8_SCHED;
            PG8_LDB(B1, 0, 1); PG8_STAGE(PG8_SB(0, 0), b2, voffB);
            PG8_BAR; PG8_WAIT_L(0); PG8_MMA(0, 1, At, B1); PG8_BAR;
            PG8_LDA(At, 0, 1); PG8_STAGE(PG8_SA(0, 0), a2, voffA);
            PG8_BAR; PG8_WAIT_L(0); PG8_MMA(1, 0, At, B0); PG8_BAR; PG8_SCHED;
            PG8_STAGE(PG8_SB(0, 1), b2 + hstepB, voffB);
            PG8_WAIT_V(6); PG8_BAR; PG8_MMA(1, 1, At, B1); PG8_BAR;
            PG8_LDB(B0, 1, 0); PG8_SCHED; PG8_LDA(At, 1, 0); PG8_STAGE(PG8_SA(0, 1), a2 + hstepA, voffA);
            PG8_WAIT_L(8); PG8_BAR; PG8_WAIT_L(0); PG8_MMA(0, 0, At, B0); PG8_BAR; PG8_SCHED;
            PG8_LDB(B1, 1, 1); PG8_STAGE(PG8_SB(1, 0), b3, voffB);
            PG8_BAR; PG8_WAIT_L(0); PG8_MMA(0, 1, At, B1); PG8_BAR;
            PG8_LDA(At, 1, 1); PG8_STAGE(PG8_SA(1, 0), a3, voffA);
            PG8_BAR; PG8_WAIT_L(0); PG8_MMA(1, 0, At, B0); PG8_BAR; PG8_SCHED;
            PG8_STAGE(PG8_SB(1, 1), b3 + hstepB, voffB);
            PG8_WAIT_V(6); PG8_BAR; PG8_MMA(1, 1, At, B1); PG8_BAR;
            }
        }
        if constexpr (ALIGN_EPI) { if (wr == 0) PG8_BAR; }
        if constexpr (!Epi::AFTER_DRAIN) { E(acc, cur, wr, wc, fr, fq); S.done(cur); }
        if (!has_next) break;
#pragma unroll
        for (int a = 0; a < 2; ++a)
#pragma unroll
            for (int b = 0; b < 2; ++b)
#pragma unroll
                for (int m = 0; m < 4; ++m)
#pragma unroll
                    for (int n = 0; n < 2; ++n) acc[a][b][m][n] = (f32x4){0.f, 0.f, 0.f, 0.f};
        cur = nxt; cA = nA; cB = nB; ++ui;
        if constexpr (ALIGN_EPI) { if (wr == 1) PG8_BAR; }
    }
    PG8_WAIT_V(0);
    if constexpr (!ALIGN_EPI) { if (wr == 0) PG8_BAR; }
    PG8_BAR;
    if constexpr (Epi::AFTER_DRAIN) { E.fused(acc, cur, wr, wc, fr, fq, lds, wid, lane); S.done(cur); }
#undef PG8_SA
#undef PG8_SB
#undef PG8_STAGE
#undef PG8_LDA
#undef PG8_LDB
#undef PG8_MMA
#undef PG8_WAIT_V
#undef PG8_WAIT_L
#undef PG8_BAR
#undef PG8_SCHED
}
}

struct Params { const float* in[26]; float* out; unsigned char* ws; int rs_lds; int pad; };
enum { I_X = 0, I_NMG, I_WIN, I_LBL, I_HNG, I_CW, I_CB, I_CLG, I_CLB, I_LRE, I_LIM, I_BRE, I_BIM, I_CRE, I_CIM, I_S5D, I_LDT, I_WGLU, I_QG, I_KG, I_RB, I_MONG, I_WOUT, I_NMLPG, I_WUP, I_WDN };

DI void p0_transpose_item(const float* W, int K, int N, bf16_t* WT, const float* gk, LAS float* scr, int item, int lane) {
    const int nblk = N / 32, kb = item / nblk, nb = item % nblk, k0 = 64 * kb, n0 = 32 * nb;
    float wv[32];
#pragma unroll
    for (int i = 0; i < 32; ++i) { const int kk = 2 * i + (lane >> 5); wv[i] = W[(size_t)(k0 + kk) * N + n0 + (lane & 31)]; }
#pragma unroll
    for (int i = 0; i < 32; ++i) { const int kk = 2 * i + (lane >> 5); const float s = gk ? gk[k0 + kk] : 1.f; scr[kk * 33 + (lane & 31)] = wv[i] * s; }
    LDS_WAIT();
    const int c = lane & 7;
#pragma unroll
    for (int j = 0; j < 4; ++j) { const int n = (lane >> 3) + 8 * j; const LAS float* s = scr + (8 * c) * 33 + n;
        u32x4 o; o.x = pk2(s[0 * 33], s[1 * 33]); o.y = pk2(s[2 * 33], s[3 * 33]); o.z = pk2(s[4 * 33], s[5 * 33]); o.w = pk2(s[6 * 33], s[7 * 33]);
        *(u32x4*)(WT + (size_t)(n0 + n) * K + k0 + 8 * c) = o; }
    LDS_WAIT();
}
DI void s5_params(const Params& p, int lg, int pp, float& lrdt, float& lidt, float& cr, float& ci) {
    const float dt = expf(p.in[I_LDT][lg]);
    const float lr = p.in[I_LRE][lg * 64 + pp], li = p.in[I_LIM][lg * 64 + pp];
    lrdt = lr * dt; lidt = li * dt;
    const float mag = expf(lrdt); const float ar = mag * cosf(lidt), ai = mag * sinf(lidt);
    const float den = lr * lr + li * li;
    cr = ((ar - 1.0f) * lr + ai * li) / den; ci = (ai * lr - (ar - 1.0f) * li) / den;
}
DI void s5_pow(float lrdt, float lidt, int n, float& er, float& ei) { const float m = expf((float)n * lrdt); const float a = (float)n * lidt; er = m * cosf(a); ei = m * sinf(a); }

DI void prologue(const Params& p, LAS unsigned char* lds, int G) {
    int tid_o = threadIdx.x; asm volatile("" : "+v"(tid_o));
    const int tid = tid_o, lane = tid & 63, wave = tid >> 6;
    const int gw = blockIdx.x * 8 + wave, NGW = G * 8;
    const int gt = blockIdx.x * 512 + tid, NGT = G * 512;
    unsigned char* ws = p.ws;
    LAS float* scr = (LAS float*)(lds + wave * 16384);
    {
        constexpr int I_IN = (D / 64) * (DIN / 32), I_OUT = (D / 64) * (D / 32), I_UP = (D / 64) * (FF / 32), I_DN = (FF / 64) * (D / 32), I_GL = (256 / 64) * (256 / 32);
        constexpr int PER_L = I_IN + I_OUT + I_UP + I_DN + I_GL;
        for (int it = gw; it < NL * PER_L; it += NGW) {
            const int l = it / PER_L; int r = it % PER_L;
            if (r < I_IN) { p0_transpose_item(p.in[I_WIN] + (size_t)l * D * DIN, D, DIN, (bf16_t*)(ws + WS_WIN) + (size_t)l * D * DIN, p.in[I_NMG] + l * D, scr, r, lane); continue; } r -= I_IN;
            if (r < I_OUT) { p0_transpose_item(p.in[I_WOUT] + (size_t)l * D * D, D, D, (bf16_t*)(ws + WS_WOUT) + (size_t)l * D * D, p.in[I_MONG] + l * D, scr, r, lane); continue; } r -= I_OUT;
            if (r < I_UP) { p0_transpose_item(p.in[I_WUP] + (size_t)l * D * FF, D, FF, (bf16_t*)(ws + WS_WUP) + (size_t)l * D * FF, p.in[I_NMLPG] + l * D, scr, r, lane); continue; } r -= I_UP;
            if (r < I_DN) { p0_transpose_item(p.in[I_WDN] + (size_t)l * D * FF, FF, D, (bf16_t*)(ws + WS_WDN) + (size_t)l * D * FF, nullptr, scr, r, lane); continue; } r -= I_DN;
            p0_transpose_item(p.in[I_WGLU] + (size_t)l * 65536, 256, 256, (bf16_t*)(ws + WS_WGLU) + (size_t)l * 65536, nullptr, scr, r, lane);
        }
    }
    {
        float* ssq0 = (float*)(ws + WS_SSQP); bf16_t* XB = (bf16_t*)(ws + WS_XB);
        for (int mb = gw * 16; mb < T; mb += NGW * 16) {
            float keep = 0.f;
#pragma unroll 4
            for (int i = 0; i < 16; ++i) { const int m = mb + i;
                const f32x4* xr = (const f32x4*)(p.in[I_X] + (size_t)m * D) + lane; f32x4 v[4]; float s = 0.f;
#pragma unroll
                for (int j = 0; j < 4; ++j) { v[j] = xr[64 * j]; s += (v[j][0] * v[j][0] + v[j][1] * v[j][1]) + (v[j][2] * v[j][2] + v[j][3] * v[j][3]); }
                s = wave_sum(s); if (lane == i) keep = s;
                u32x2* o8 = (u32x2*)(XB + (size_t)m * D) + lane;
#pragma unroll
                for (int j = 0; j < 4; ++j) { u32x2 w; w.x = pk2(v[j][0], v[j][1]); w.y = pk2(v[j][2], v[j][3]); o8[64 * j] = w; } }
#pragma unroll 1
            for (int i = 0; i < 16; ++i) { const float v = __shfl(keep, i); if (lane < 16) ssq0[(size_t)(mb + i) * 16 + lane] = lane == 0 ? v : 0.f; }
        }
    }
    {
        float* LB = (float*)(ws + WS_LB);
        for (int c = gt; c < 256; c += NGT) {
            const float a0 = p.in[I_LBL][c], a1 = p.in[I_LBL][256 + c], a2 = p.in[I_LBL][512 + c], a3 = p.in[I_LBL][768 + c];
            const float mx = fmaxf(fmaxf(a0, a1), fmaxf(a2, a3));
            const float e0 = expf(a0 - mx), e1 = expf(a1 - mx), e2 = expf(a2 - mx), e3 = expf(a3 - mx); const float inv = 1.f / (e0 + e1 + e2 + e3);
            const float s1 = e1 * inv, s2 = e2 * inv, s3 = e3 * inv; const float hi = 1.0f - 1e-6f;
            LB[c] = 0.f; LB[256 + c] = fminf(fmaxf(s1, 0.f), hi); LB[512 + c] = fminf(fmaxf(s1 + s2, 0.f), hi); LB[768 + c] = fminf(fmaxf(s1 + s2 + s3, 0.f), hi);
        }
        float* BT = (float*)(ws + WS_BIAS);
        for (int i = gt; i < 3 * 4 * 132; i += NGT) {
            const int pt = i / (4 * 132), hd = (i / 132) % 4, dl = i % 132; const int dil = pt == 0 ? 1 : (pt == 1 ? 4 : 16);
            float v = 0.f;
            if (dl <= 128) { const int dist = dl * dil; int bk;
                if (dist < 16) bk = dist; else { bk = 16 + (int)(logf((float)dist / 16.0f) / 4.852030263919617f * 16.0f); if (bk > 31) bk = 31; }
                v = p.in[I_RB][bk * 4 + hd]; }
            BT[i] = v;
        }
    }
    {
        bf16_t* KT = (bf16_t*)(ws + WS_S5K); bf16_t* WS_ = (bf16_t*)(ws + WS_S5WS); bf16_t* WC = (bf16_t*)(ws + WS_S5WC);
        LAS float* ebr = scr; LAS float* ebi = scr + 64 * 17;
        for (int it = gw; it < NL * 16 * 64; it += NGW) {
            const int lg = it >> 6, d = it & 63;
            float lrdt, lidt, cr, ci; s5_params(p, lg, lane, lrdt, lidt, cr, ci);
            float er, ei; s5_pow(lrdt, lidt, d, er, ei);
            const float fr_ = er * cr - ei * ci, fi_ = er * ci + ei * cr;
            const float* br = p.in[I_BRE] + ((size_t)lg * 64 + lane) * 16; const float* bi = p.in[I_BIM] + ((size_t)lg * 64 + lane) * 16;
#pragma unroll
            for (int c = 0; c < 16; ++c) { const float b0 = br[c], b1 = bi[c]; ebr[lane * 17 + c] = fr_ * b0 - fi_ * b1; ebi[lane * 17 + c] = fr_ * b1 + fi_ * b0; }
            LDS_WAIT();
            const int co = lane & 15, cb = (lane >> 4) * 4;
            const float* crp = p.in[I_CRE] + ((size_t)lg * 16 + co) * 64; const float* cip = p.in[I_CIM] + ((size_t)lg * 16 + co) * 64;
            float a0 = 0.f, a1 = 0.f, a2 = 0.f, a3 = 0.f;
            for (int q = 0; q < 64; ++q) { const float c0 = crp[q], c1 = cip[q];
                a0 += c0 * ebr[q * 17 + cb + 0] - c1 * ebi[q * 17 + cb + 0]; a1 += c0 * ebr[q * 17 + cb + 1] - c1 * ebi[q * 17 + cb + 1];
                a2 += c0 * ebr[q * 17 + cb + 2] - c1 * ebi[q * 17 + cb + 2]; a3 += c0 * ebr[q * 17 + cb + 3] - c1 * ebi[q * 17 + cb + 3]; }
            u32x2 w; w.x = pk2(a0, a1); w.y = pk2(a2, a3);
            *(u32x2*)(KT + ((size_t)it * 16 + co) * 16 + cb) = w;
            LDS_WAIT();
        }
        for (int it = gw; it < NL * 16 * 16; it += NGW) {
            const int lg = it >> 4, s4 = it & 15;
            float lrdt, lidt, cr, ci; s5_params(p, lg, lane, lrdt, lidt, cr, ci);
            const float* br = p.in[I_BRE] + ((size_t)lg * 64 + lane) * 16; const float* bi = p.in[I_BIM] + ((size_t)lg * 64 + lane) * 16;
            float b0[16], b1[16];
#pragma unroll
            for (int c = 0; c < 16; ++c) { b0[c] = br[c]; b1[c] = bi[c]; }
#pragma unroll 1
            for (int sq = 0; sq < 4; ++sq) { const int s = s4 * 4 + sq;
                float er, ei; s5_pow(lrdt, lidt, 63 - s, er, ei);
                const float fr_ = er * cr - ei * ci, fi_ = er * ci + ei * cr;
                float vr[16], vi[16];
#pragma unroll
                for (int c = 0; c < 16; ++c) { vr[c] = fr_ * b0[c] - fi_ * b1[c]; vi[c] = fr_ * b1[c] + fi_ * b0[c]; }
                bf16_t* o0 = WS_ + (((size_t)lg * 64 + s) * 128 + lane) * 16; bf16_t* o1 = WS_ + (((size_t)lg * 64 + s) * 128 + 64 + lane) * 16;
                u32x4 w;
                w.x = pk2(vr[0], vr[1]); w.y = pk2(vr[2], vr[3]); w.z = pk2(vr[4], vr[5]); w.w = pk2(vr[6], vr[7]); *(u32x4*)o0 = w;
                w.x = pk2(vr[8], vr[9]); w.y = pk2(vr[10], vr[11]); w.z = pk2(vr[12], vr[13]); w.w = pk2(vr[14], vr[15]); *(u32x4*)(o0 + 8) = w;
                w.x = pk2(vi[0], vi[1]); w.y = pk2(vi[2], vi[3]); w.z = pk2(vi[4], vi[5]); w.w = pk2(vi[6], vi[7]); *(u32x4*)o1 = w;
                w.x = pk2(vi[8], vi[9]); w.y = pk2(vi[10], vi[11]); w.z = pk2(vi[12], vi[13]); w.w = pk2(vi[14], vi[15]); *(u32x4*)(o1 + 8) = w; }
        }
        for (int it = gw; it < NL * 16 * 64; it += NGW) {
            const int lg = it >> 6, tl = it & 63;
            float lrdt, lidt, cr, ci; s5_params(p, lg, lane, lrdt, lidt, cr, ci);
            float er, ei; s5_pow(lrdt, lidt, tl + 1, er, ei);
#pragma unroll 4
            for (int co = 0; co < 16; ++co) { const float c0 = p.in[I_CRE][((size_t)lg * 16 + co) * 64 + lane], c1 = p.in[I_CIM][((size_t)lg * 16 + co) * 64 + lane];
                bf16_t* o = WC + (((size_t)lg * 64 + tl) * 16 + co) * 128;
                o[lane] = (bf16_t)f2bf(c0 * er - c1 * ei); o[64 + lane] = (bf16_t)f2bf(-(c0 * ei + c1 * er)); }
        }
    }
}

template <bool OUT>
DI void hgrn_item(const Params& p, LAS unsigned char* lds, int l, int cg) {
    int tid_o = threadIdx.x; asm volatile("" : "+v"(tid_o));
    const int tid = tid_o, lane = tid & 63, wave = tid >> 6, hd = wave >> 1, half = wave & 1;
    const bf16_t* Z = (const bf16_t*)(p.ws + WS_Z);
    LAS bf16_t* B0 = (LAS bf16_t*)(lds + hd * 27648); LAS bf16_t* B1 = B0 + 64 * 72; LAS bf16_t* B2 = B1 + 64 * 72;
    LAS float* GM = (LAS float*)(lds + 114688) + hd * 64; LAS float* GL = GM + 256; LAS float* SSA = (LAS float*)(lds + 114688) + 512;
    bf16_t* SL = (bf16_t*)(p.ws + WS_SL); const bf16_t* SL2 = (const bf16_t*)(p.ws + WS_SL2); float* DEC = (float*)(p.ws + WS_DEC);
    const int item = cg * 4 + hd;
#ifdef FORCE_LB0
    const float lb = 0.f, oml = 1.f;
#else
    const float lb = ((const float*)(p.ws + WS_LB))[l * 256 + hd * 64 + lane], oml = 1.f - lb;
#endif
    const int srow = tid >> 5, shd = (tid >> 3) & 3, spc = tid & 7;
    const bf16_t* zsrc = Z + (size_t)(cg * 64 + srow) * DIN + shd * 64 + spc * 8;
    const int sdst = shd * 27648 + (srow * 72 + spc * 8) * 2;
    u32x4 wsl[4], wg[4];
    if (OUT) { const bf16_t* sp = SL2 + (size_t)item * 4096 + (32 * half) * 64;
#pragma unroll
        for (int e = 0; e < 4; ++e) { wsl[e] = *(const u32x4*)(sp + (lane + 64 * e) * 8); wg[e] = *(const u32x4*)(zsrc + (size_t)(16 * e) * DIN + ZG); } }
    __syncthreads();
    { u32x4 wf[4], wi[4], wq[4];
#pragma unroll
      for (int sub = 0; sub < 4; ++sub) { wf[sub] = *(const u32x4*)(zsrc + (size_t)(16 * sub) * DIN + ZF); wi[sub] = *(const u32x4*)(zsrc + (size_t)(16 * sub) * DIN + ZI);
          if (OUT) wq[sub] = *(const u32x4*)(zsrc + (size_t)(16 * sub) * DIN + ZQ); }
#pragma unroll
      for (int sub = 0; sub < 4; ++sub) { *(LAS u32x4*)(lds + sdst + 9216 + sub * 16 * 144) = wf[sub]; *(LAS u32x4*)(lds + sdst + 18432 + sub * 16 * 144) = wi[sub];
          if (OUT) *(LAS u32x4*)(lds + sdst + sub * 16 * 144) = wq[sub]; } }
    __syncthreads();
    float g[32], km[32]; float run = 0.f;
#pragma unroll
    for (int j = 0; j < 32; ++j) { const float fz = bf2f(B1[(half * 32 + j) * 72 + lane]); const float sg = sigmoidf_(fz); const float f = lb + oml * sg;
        run += __logf(fmaxf(f, 1e-30f)); g[j] = run; km[j] = oml * (1.f - sg); }
    if (half == 0) GM[lane] = run;
    __syncthreads();
    const float gm = GM[lane];
    if (half) {
#pragma unroll
        for (int j = 0; j < 32; ++j) g[j] += gm; }
    const int c0 = lane & 31, h = lane >> 5;
    if constexpr (!OUT) {
        if (half) GL[lane] = run + gm;
        __syncthreads();
        const float gl = GL[lane];
        bf16_t kv[32], ivr[32];
#pragma unroll
        for (int j = 0; j < 32; ++j) { const int t = half * 32 + j; const float e = __expf(gl - g[j]); const float kj = km[j];
            kv[j] = (bf16_t)f2bf(kj * e); ivr[j] = B2[t * 72 + lane]; }
        __syncthreads();
#pragma unroll
        for (int j = 0; j < 32; ++j) { const int t = half * 32 + j; B1[lane * 72 + t] = kv[j]; B2[lane * 72 + t] = ivr[j]; }
        __syncthreads();
#pragma unroll
        for (int kt = 0; kt < 2; ++kt) { const f32x16 a = mma_lds<64>(B2 + 32 * half * 72, 72, B1 + 32 * kt * 72, 72, zero16(), lane);
#pragma unroll
            for (int i = 0; i < 16; ++i) SL[(size_t)item * 4096 + (32 * half + crow(i, h)) * 64 + 32 * kt + c0] = (bf16_t)f2bf(a[i]); }
        if (half == 0) DEC[item * 64 + lane] = __expf(gl);
    } else {
        if (half == 0) GL[lane] = __expf(gm);
        bf16_t ivr[32];
#pragma unroll
        for (int j = 0; j < 32; ++j) { const int t = half * 32 + j; const float q = bf2f(B0[t * 72 + lane]); const float kj = km[j];
            const float e1 = __expf(fminf(fmaxf(g[j] - gm, -80.f), 80.f)), e2 = __builtin_amdgcn_rcpf(e1);
            ivr[j] = B2[t * 72 + lane];
            B0[t * 72 + lane] = (bf16_t)f2bf(q * e1); B1[t * 72 + lane] = (bf16_t)f2bf(kj * e2); }
        __syncthreads();
#pragma unroll
        for (int j = 0; j < 32; ++j) B2[lane * 72 + half * 32 + j] = ivr[j];
        __syncthreads();
        f32x16 s0 = mma_lds<64>(B0 + 32 * half * 72, 72, B1, 72, zero16(), lane);
        f32x16 s1 = zero16(); if (half) s1 = mma_lds<64>(B0 + 32 * half * 72, 72, B1 + 32 * 72, 72, zero16(), lane);
        __syncthreads();
#pragma unroll
        for (int i = 0; i < 16; ++i) { const int row = 32 * half + crow(i, h);
            B1[row * 72 + c0] = (bf16_t)f2bf(c0 <= row ? s0[i] : 0.f); B1[row * 72 + 32 + c0] = (bf16_t)f2bf(32 + c0 <= row ? s1[i] : 0.f); }
        __syncthreads();
        f32x16 o0 = mma_lds<64>(B1 + 32 * half * 72, 72, B2, 72, zero16(), lane);
        f32x16 o1 = mma_lds<64>(B1 + 32 * half * 72, 72, B2 + 32 * 72, 72, zero16(), lane);
        __syncthreads();
        {
#pragma unroll
          for (int e = 0; e < 4; ++e) { const int pc = lane + 64 * e, row = pc >> 3, k0 = (pc & 7) * 8; const LAS float* eg = GL + k0;
              u32x4 o; o.x = pk2(bflo(wsl[e].x) * eg[0], bfhi(wsl[e].x) * eg[1]); o.y = pk2(bflo(wsl[e].y) * eg[2], bfhi(wsl[e].y) * eg[3]);
              o.z = pk2(bflo(wsl[e].z) * eg[4], bfhi(wsl[e].z) * eg[5]); o.w = pk2(bflo(wsl[e].w) * eg[6], bfhi(wsl[e].w) * eg[7]);
              *(LAS u32x4*)(B2 + (32 * half + row) * 72 + k0) = o;
              *(LAS u32x4*)(lds + sdst + 9216 + e * 16 * 144) = wg[e]; } }
        __syncthreads();
        o0 = mma_lds<64>(B0 + 32 * half * 72, 72, B2, 72, o0, lane);
        o1 = mma_lds<64>(B0 + 32 * half * 72, 72, B2 + 32 * 72, 72, o1, lane);
        const float* ng = p.in[I_HNG] + l * 256 + hd * 64; const float ng0 = ng[c0], ng1 = ng[32 + c0];
#pragma unroll
        for (int i = 0; i < 16; ++i) { const int row = 32 * half + crow(i, h);
            const float ss = half_sum(o0[i] * o0[i] + o1[i] * o1[i]); const float rs = rsqrtf(ss * (1.0f / 64.0f) + EPS);
            const float g0 = bf2f(B1[row * 72 + c0]), g1 = bf2f(B1[row * 72 + 32 + c0]);
            const float v0 = o0[i] * rs * ng0 * g0 * sigmoidf_(g0), v1 = o1[i] * rs * ng1 * g1 * sigmoidf_(g1);
            o0[i] = v0; o1[i] = v1; const float s2 = half_sum(v0 * v0 + v1 * v1); if (c0 == 0) SSA[hd * 64 + row] = s2; }
        __syncthreads();
        bf16_t* Y = (bf16_t*)(p.ws + WS_YCAT);
#pragma unroll
        for (int i = 0; i < 16; ++i) { const int row = 32 * half + crow(i, h); const size_t tok = (size_t)cg * 64 + row;
            const float tot = (SSA[row] + SSA[64 + row]) + (SSA[128 + row] + SSA[192 + row]); const float r2 = rsqrtf(tot * (1.0f / 256.0f) + EPS);
            Y[tok * D + YA + hd * 64 + c0] = (bf16_t)f2bf(o0[i] * r2); Y[tok * D + YA + hd * 64 + 32 + c0] = (bf16_t)f2bf(o1[i] * r2); }
    }
}
DI void hgrn_scan_item(const Params& p, int hb) {
    int tid_o = threadIdx.x; asm volatile("" : "+v"(tid_o));
    const int e = hb * 512 + tid_o, bh = e >> 12, b = bh >> 2, hd = bh & 3, vk = e & 4095, k = vk & 63;
    const bf16_t* SL = (const bf16_t*)(p.ws + WS_SL); bf16_t* SL2 = (bf16_t*)(p.ws + WS_SL2); const float* DEC = (const float*)(p.ws + WS_DEC);
    float st = 0.f;
    for (int c8 = 0; c8 < 128; c8 += 32) { float tmp[32], dc[32];
#pragma unroll
        for (int u = 0; u < 32; ++u) { const int item = (b * 128 + c8 + u) * 4 + hd; tmp[u] = bf2f(SL[(size_t)item * 4096 + vk]); dc[u] = DEC[item * 64 + k]; }
#pragma unroll
        for (int u = 0; u < 32; ++u) { const int item = (b * 128 + c8 + u) * 4 + hd; SL2[(size_t)item * 4096 + vk] = (bf16_t)f2bf(st); st = dc[u] * st + tmp[u]; } }
}

DI void conv_item(const Params& p, LAS unsigned char* lds, int l, int ti) {
    int tid_o = threadIdx.x; asm volatile("" : "+v"(tid_o));
    const int tid = tid_o, lane = tid & 63, wave = tid >> 6, c = tid & 255, hf = tid >> 8, wv = wave & 3;
    LAS float* Hs = (LAS float*)lds; LAS float* ST = (LAS float*)(lds + 98304); LAS float* ST2 = ST + 512;
    const bf16_t* Z = (const bf16_t*)(p.ws + WS_Z); bf16_t* Y = (bf16_t*)(p.ws + WS_YCAT);
    const int tok0 = ti * 64, pos0 = (ti & 127) * 64;
    const float* cw = p.in[I_CW] + (size_t)l * 31 * 256 + c; float w[31];
#pragma unroll
    for (int jj = 0; jj < 31; ++jj) w[jj] = cw[jj * 256];
    const float cb = p.in[I_CB][l * 256 + c];
    const float lng = p.in[I_CLG][l * 256 + c], lnb = p.in[I_CLB][l * 256 + c];
    __syncthreads();
    { u32x4 vw[6], gw_[6];
#pragma unroll
      for (int k = 0; k < 6; ++k) { const int pid = tid + 512 * k, row = pid >> 5, pc = pid & 31, pos = pos0 - 30 + row; const bool ok = (row < 94) && (pos >= 0);
          const size_t tok = ok ? (size_t)(tok0 - 30 + row) : (size_t)tok0; vw[k] = *(const u32x4*)(Z + tok * DIN + ZBV + pc * 8); gw_[k] = *(const u32x4*)(Z + tok * DIN + ZBG + pc * 8); }
#pragma unroll
      for (int k = 0; k < 6; ++k) { const int pid = tid + 512 * k, row = pid >> 5, pc = pid & 31, pos = pos0 - 30 + row; const bool ok = (row < 94) && (pos >= 0);
          if (row < 94) { f32x4 h0, h1;
              h0[0] = bflo(vw[k].x) * sigmoidf_(bflo(gw_[k].x)); h0[1] = bfhi(vw[k].x) * sigmoidf_(bfhi(gw_[k].x)); h0[2] = bflo(vw[k].y) * sigmoidf_(bflo(gw_[k].y)); h0[3] = bfhi(vw[k].y) * sigmoidf_(bfhi(gw_[k].y));
              h1[0] = bflo(vw[k].z) * sigmoidf_(bflo(gw_[k].z)); h1[1] = bfhi(vw[k].z) * sigmoidf_(bfhi(gw_[k].z)); h1[2] = bflo(vw[k].w) * sigmoidf_(bflo(gw_[k].w)); h1[3] = bfhi(vw[k].w) * sigmoidf_(bfhi(gw_[k].w));
              if (!ok) { h0 = (f32x4){0.f, 0.f, 0.f, 0.f}; h1 = h0; }
              *(LAS f32x4*)(Hs + row * 256 + pc * 8) = h0; *(LAS f32x4*)(Hs + row * 256 + pc * 8 + 4) = h1; } } }
    __syncthreads();
    LAS float* OT2 = (LAS float*)(lds + 98304);
    LAS float* STAT = (LAS float*)(lds + 131072); LAS float* STAT2 = STAT + 64;
    const int rtl = tid >> 4, rpart = tid & 15;
#pragma unroll 1
    for (int ps = 0; ps < 2; ++ps) { const int tb = hf * 32 + ps * 16;
        float o[16];
        { float hr[46];
#pragma unroll
          for (int r = 0; r < 46; ++r) hr[r] = Hs[(tb + r) * 256 + c];
#pragma unroll
          for (int j = 0; j < 16; ++j) { float a = cb;
#pragma unroll
            for (int jj = 0; jj < 31; ++jj) a += w[jj] * hr[j + jj];
            o[j] = a; } }
#pragma unroll
        for (int j = 0; j < 16; ++j) OT2[(hf * 16 + j) * 256 + c] = o[j];
        __syncthreads();
        { const LAS f32x4* q = (const LAS f32x4*)(OT2 + rtl * 256 + rpart * 16); float s1 = 0.f, s2 = 0.f;
#pragma unroll
          for (int e = 0; e < 4; ++e) { const f32x4 v = q[e]; s1 += (v[0] + v[1]) + (v[2] + v[3]); s2 += (v[0] * v[0] + v[1] * v[1]) + (v[2] * v[2] + v[3] * v[3]); }
          s1 = sum16_(s1); s2 = sum16_(s2);
          if (rpart == 0) { const float mu = s1 * (1.0f / 256.0f); const float var = fmaxf(s2 * (1.0f / 256.0f) - mu * mu, 0.f); STAT[rtl * 2] = mu; STAT[rtl * 2 + 1] = rsqrtf(var + EPS); } }
        __syncthreads();
#pragma unroll
        for (int j = 0; j < 16; ++j) { const float mu = STAT[(hf * 16 + j) * 2], rsd = STAT[(hf * 16 + j) * 2 + 1];
            const float y = (o[j] - mu) * rsd * lng + lnb; const float sv = y * sigmoidf_(y); o[j] = sv; OT2[(hf * 16 + j) * 256 + c] = sv; }
        __syncthreads();
        { const LAS f32x4* q = (const LAS f32x4*)(OT2 + rtl * 256 + rpart * 16); float s3 = 0.f;
#pragma unroll
          for (int e = 0; e < 4; ++e) { const f32x4 v = q[e]; s3 += (v[0] * v[0] + v[1] * v[1]) + (v[2] * v[2] + v[3] * v[3]); }
          s3 = sum16_(s3);
          if (rpart == 0) STAT2[rtl] = rsqrtf(s3 * (1.0f / 256.0f) + EPS); }
        __syncthreads();
#pragma unroll
        for (int j = 0; j < 16; ++j) Y[(size_t)(tok0 + tb + j) * D + YB + c] = (bf16_t)f2bf(o[j] * STAT2[hf * 16 + j]);
    }
}

DI bf16x8 ldg8(const bf16_t* p) { return *(const bf16x8*)p; }
DI void s5_local_item(const Params& p, LAS unsigned char* lds, int l, int bi) {
    int tid_o = threadIdx.x; asm volatile("" : "+v"(tid_o));
    const int tid = tid_o, lane = tid & 63, wave = tid >> 6;
    const int gh = bi & 1, cb = (bi >> 1) & 15, pt = bi >> 5, g = gh * 8 + wave, c0 = lane & 31, h = lane >> 5, lg = l * 16 + g;
    LAS bf16_t* UT = (LAS bf16_t*)lds;
    const bf16_t* Z = (const bf16_t*)(p.ws + WS_Z);
    const int sm = tid >> 4, spc = tid & 15;
    const bf16_t* zst = Z + (size_t)((cb * 32 + sm) * 64) * DIN + ZCU + gh * 128 + spc * 8;
    const int ust = (sm * 136 + spc * 8) * 2;
    const bf16_t* wsp = (const bf16_t*)(p.ws + WS_S5WS) + ((size_t)lg * 64 * 128 + pt * 32 + c0) * 16 + 8 * h;
    u32x4 pf[8];
#pragma unroll
    for (int e = 0; e < 8; ++e) pf[e] = *(const u32x4*)(zst + (size_t)e * DIN);
    f32x16 acc = zero16();
    __syncthreads();
    for (int b = 0; b < 8; ++b) { const int s0 = 8 * b;
#pragma unroll
        for (int e = 0; e < 8; ++e) *(LAS u32x4*)(lds + ust + e * (32 * 136 * 2)) = pf[e];
        __syncthreads();
        if (b + 1 < 8) {
#pragma unroll
            for (int e = 0; e < 8; ++e) pf[e] = *(const u32x4*)(zst + (size_t)(s0 + 8 + e) * DIN); }
        bf16x8 bf[8];
#pragma unroll
        for (int e = 0; e < 8; ++e) bf[e] = ldg8(wsp + (size_t)(s0 + e) * 2048);
#pragma unroll
        for (int e = 0; e < 8; ++e) acc = __builtin_amdgcn_mfma_f32_32x32x16_bf16(*(const LAS bf16x8*)(UT + (e * 32 + c0) * 136 + wave * 16 + 8 * h), bf[e], acc, 0, 0, 0);
        __syncthreads();
    }
    float* HL = (float*)(p.ws + WS_S5H);
#pragma unroll
    for (int i = 0; i < 16; ++i) HL[((size_t)(cb * 32 + crow(i, h)) * 16 + g) * 128 + pt * 32 + c0] = acc[i];
}
DI void s5_scan_item(const Params& p, int l, int sb) {
    int tid_o = threadIdx.x; asm volatile("" : "+v"(tid_o));
    const int e = sb * 512 + tid_o, b = e >> 10, g = (e >> 6) & 15, pp = e & 63;
    float lrdt, lidt, cr, ci; s5_params(p, l * 16 + g, pp, lrdt, lidt, cr, ci);
    float ar, ai; s5_pow(lrdt, lidt, 64, ar, ai);
    const float* HL = (const float*)(p.ws + WS_S5H); float* HO = (float*)(p.ws + WS_S5H2); float hr = 0.f, hi = 0.f;
    for (int c8 = 0; c8 < 128; c8 += 32) { float tr[32], ti[32];
#pragma unroll
        for (int u = 0; u < 32; ++u) { const size_t idx = ((size_t)(b * 128 + c8 + u) * 16 + g) * 128; tr[u] = HL[idx + pp]; ti[u] = HL[idx + 64 + pp]; }
#pragma unroll
        for (int u = 0; u < 32; ++u) { const size_t idx = ((size_t)(b * 128 + c8 + u) * 16 + g) * 128; HO[idx + pp] = hr; HO[idx + 64 + pp] = hi;
            const float nr = ar * hr - ai * hi + tr[u], ni = ar * hi + ai * hr + ti[u]; hr = nr; hi = ni; } }
}
DI void s5_out_item(const Params& p, LAS unsigned char* lds, int l, int bi) {
    int tid_o = threadIdx.x; asm volatile("" : "+v"(tid_o));
    const int tid = tid_o, lane = tid & 63, wave = tid >> 6;
    const int gh = bi & 1, cb = (bi >> 1) & 15, pr = bi >> 5, g = gh * 8 + wave, c0 = lane & 31, h = lane >> 5, lg = l * 16 + g;
    LAS bf16_t* UT = (LAS bf16_t*)lds;
    LAS bf16_t* OT = (LAS bf16_t*)(lds + 69632);
    const bf16_t* Z = (const bf16_t*)(p.ws + WS_Z);
    const bf16_t* kt = (const bf16_t*)(p.ws + WS_S5K) + (size_t)lg * 64 * 256;
    const float* ha = (const float*)(p.ws + WS_S5H2) + ((size_t)(cb * 32 + c0) * 16 + g) * 128 + 8 * h;
    const int co = c0 & 15; const float dsk = p.in[I_S5D][l * 256 + g * 16 + co];
    const int jt0 = pr, jt1 = 31 - pr, tl0 = 2 * jt0 + (c0 >> 4), tl1 = 2 * jt1 + (c0 >> 4);
    const int sm = tid >> 4, spc = tid & 15;
    const bf16_t* zst = Z + (size_t)((cb * 32 + sm) * 64) * DIN + ZCU + gh * 128 + spc * 8;
    const int ust = (sm * 136 + spc * 8) * 2;
    const int nb = (2 * jt1 + 2 + 7) >> 3;
    u32x4 pf[8];
#pragma unroll
    for (int e = 0; e < 8; ++e) pf[e] = *(const u32x4*)(zst + (size_t)e * DIN);
    f32x16 acc0 = zero16(), acc1 = zero16();
    { const bf16_t* wc0 = (const bf16_t*)(p.ws + WS_S5WC) + (((size_t)lg * 64 + tl0) * 16 + co) * 128 + 8 * h;
      const bf16_t* wc1 = (const bf16_t*)(p.ws + WS_S5WC) + (((size_t)lg * 64 + tl1) * 16 + co) * 128 + 8 * h;
      f32x4 x0[8], x1[8];
#pragma unroll
      for (int ks = 0; ks < 8; ++ks) { x0[ks] = *(const f32x4*)(ha + ks * 16); x1[ks] = *(const f32x4*)(ha + ks * 16 + 4); }
#pragma unroll
      for (int ks = 0; ks < 8; ++ks) { u32x4 w; w.x = pk2(x0[ks][0], x0[ks][1]); w.y = pk2(x0[ks][2], x0[ks][3]); w.z = pk2(x1[ks][0], x1[ks][1]); w.w = pk2(x1[ks][2], x1[ks][3]);
        const bf16x8 af = __builtin_bit_cast(bf16x8, w);
        acc0 = __builtin_amdgcn_mfma_f32_32x32x16_bf16(af, ldg8(wc0 + ks * 16), acc0, 0, 0, 0);
        acc1 = __builtin_amdgcn_mfma_f32_32x32x16_bf16(af, ldg8(wc1 + ks * 16), acc1, 0, 0, 0); } }
    __syncthreads();
    for (int b = 0; b < nb; ++b) { const int s0 = 8 * b;
#pragma unroll
        for (int e = 0; e < 8; ++e) *(LAS u32x4*)(lds + ust + e * (32 * 136 * 2)) = pf[e];
        __syncthreads();
        if (b + 1 < nb) {
#pragma unroll
            for (int e = 0; e < 8; ++e) pf[e] = *(const u32x4*)(zst + (size_t)(s0 + 8 + e) * DIN); }
        const bool use0 = s0 <= 2 * jt0 + 1;
        bf16x8 b0[8], b1[8];
#pragma unroll
        for (int e = 0; e < 8; ++e) { const int d1 = tl1 - (s0 + e); b1[e] = ldg8(kt + ((size_t)(d1 < 0 ? 0 : d1) * 16 + co) * 16 + 8 * h);
            if (use0) { const int d0 = tl0 - (s0 + e); b0[e] = ldg8(kt + ((size_t)(d0 < 0 ? 0 : d0) * 16 + co) * 16 + 8 * h); } }
#pragma unroll
        for (int e = 0; e < 8; ++e) { const bf16x8 af = *(const LAS bf16x8*)(UT + (e * 32 + c0) * 136 + wave * 16 + 8 * h);
            const int d1 = tl1 - (s0 + e); bf16x8 bb = b1[e]; if (d1 < 0) bb = (bf16x8){0, 0, 0, 0, 0, 0, 0, 0};
            acc1 = __builtin_amdgcn_mfma_f32_32x32x16_bf16(af, bb, acc1, 0, 0, 0);
            if (use0) { const int d0 = tl0 - (s0 + e); bf16x8 ba = b0[e]; if (d0 < 0) ba = (bf16x8){0, 0, 0, 0, 0, 0, 0, 0};
                acc0 = __builtin_amdgcn_mfma_f32_32x32x16_bf16(af, ba, acc0, 0, 0, 0); } }
        __syncthreads();
    }
#pragma unroll
    for (int q = 0; q < 2; ++q) { const int tl = q ? tl1 : tl0;
#pragma unroll
        for (int i = 0; i < 16; ++i) { const int m = crow(i, h); const size_t tok = (size_t)(cb * 32 + m) * 64 + tl; const float u = bf2f(Z[tok * DIN + ZCU + g * 16 + co]);
            const float y = (q ? acc1[i] : acc0[i]) + dsk * u; const float ge = y * sigmoidf_(1.5957691216057308f * (y + 0.044715f * y * y * y));
            OT[(q * 64 + m * 2 + (c0 >> 4)) * 136 + wave * 16 + co] = (bf16_t)f2bf(ge); } }
    __syncthreads();
    { const int tau = tid >> 2, qq = tau >> 6, m = (tau >> 1) & 31, t2 = tau & 1, qt = tid & 3; const int jt = qq ? jt1 : jt0;
      const size_t tok = (size_t)(cb * 32 + m) * 64 + 2 * jt + t2;
      const LAS u32x4* src = (const LAS u32x4*)(OT + tau * 136 + qt * 32); u32x4* dst = (u32x4*)((bf16_t*)(p.ws + WS_YPRE) + tok * 256 + gh * 128 + qt * 32);
#pragma unroll
      for (int e = 0; e < 4; ++e) dst[e] = src[e]; }
}

DI void attn_item(const Params& p, LAS unsigned char* lds, int l, int pt, int id) {
    int tid_o = threadIdx.x; asm volatile("" : "+v"(tid_o));
    const int tid = tid_o, lane = tid & 63, wave = tid >> 6;
    const int dil = pt == 0 ? 1 : (pt == 1 ? 4 : 16), nblk = 32 / dil;
    const int b = id >> 7, hd = (id >> 5) & 3, rn = id & 31, r = rn / nblk, n = rn % nblk;
    LAS bf16_t* Ks = (LAS bf16_t*)lds;
    LAS bf16_t* Vt = (LAS bf16_t*)(lds + 55296);
    LAS float* BT = (LAS float*)(lds + 55296 + 50176);
    const bf16_t* Z = (const bf16_t*)(p.ws + WS_Z);
    const bf16_t* OP = (const bf16_t*)(p.ws + (pt == 1 ? WS_O0 : WS_O1)); const float* LP = (const float*)(p.ws + (pt == 1 ? WS_LSE : WS_LSE1));
    bf16_t* ON = pt == 2 ? (bf16_t*)(p.ws + WS_Z) + ZOD : (bf16_t*)(p.ws + (pt == 0 ? WS_O0 : WS_O1)); const int onp = pt == 2 ? DIN : 256;
    float* LN = (float*)(p.ws + (pt == 0 ? WS_LSE : WS_LSE1));
    const size_t tokb = (size_t)b * SEQ;
    const int c0 = lane & 31, h = lane >> 5;
    const int qi = 32 * wave + c0; const size_t tokq = tokb + (size_t)(n * 256 + qi) * dil + r;
    u32x4 qraw[4]; u32x2 oprev[2][4]; float mprev = 0.f;
#pragma unroll
    for (int ks = 0; ks < 4; ++ks) qraw[ks] = *(const u32x4*)(Z + tokq * DIN + ZDQ + hd * 64 + ks * 16 + 8 * h);
    if (pt > 0) { mprev = LP[tokq * 4 + hd];
#pragma unroll
        for (int vt = 0; vt < 2; ++vt)
#pragma unroll
            for (int g4 = 0; g4 < 4; ++g4) oprev[vt][g4] = *(const u32x2*)(OP + tokq * 256 + hd * 64 + 32 * vt + 8 * g4 + 4 * h); }
    __syncthreads();
    if (tid < 132) BT[tid] = ((const float*)(p.ws + WS_BIAS))[(pt * 4 + hd) * 132 + tid];
    { const float* kg = p.in[I_KG] + l * 64 + (tid & 7) * 8; float kgv[8];
#pragma unroll
      for (int e = 0; e < 8; ++e) kgv[e] = kg[e];
      u32x4 kwv[6], vwv[6];
#pragma unroll
      for (int it = 0; it < 6; ++it) { const int idx = tid + 512 * it, row = idx >> 3, c = idx & 7, si = n * 256 - 128 + row;
        const size_t tok = tokb + (size_t)(si < 0 ? 0 : si) * dil + r;
        kwv[it] = *(const u32x4*)(Z + tok * DIN + ZDK + hd * 64 + c * 8); vwv[it] = *(const u32x4*)(Z + tok * DIN + ZDV + hd * 64 + c * 8); }
#pragma unroll
      for (int it = 0; it < 6; ++it) { const int idx = tid + 512 * it, row = idx >> 3, c = idx & 7, si = n * 256 - 128 + row;
        u32x4 kw = kwv[it], vw = vwv[it];
        if (si < 0) { kw = (u32x4){0u, 0u, 0u, 0u}; vw = (u32x4){0u, 0u, 0u, 0u}; }
        float kf[8]; kf[0] = bflo(kw.x); kf[1] = bfhi(kw.x); kf[2] = bflo(kw.y); kf[3] = bfhi(kw.y); kf[4] = bflo(kw.z); kf[5] = bfhi(kw.z); kf[6] = bflo(kw.w); kf[7] = bfhi(kw.w);
        float ss = 0.f;
#pragma unroll
        for (int e = 0; e < 8; ++e) ss += kf[e] * kf[e];
        ss = sum8_(ss);
        const float rs = rsqrtf(ss * (1.0f / 64.0f) + EPS);
        u32x4 o; o.x = pk2(kf[0] * rs * kgv[0], kf[1] * rs * kgv[1]); o.y = pk2(kf[2] * rs * kgv[2], kf[3] * rs * kgv[3]); o.z = pk2(kf[4] * rs * kgv[4], kf[5] * rs * kgv[5]); o.w = pk2(kf[6] * rs * kgv[6], kf[7] * rs * kgv[7]);
        *(LAS u32x4*)(Ks + row * 72 + c * 8) = o;
        LAS bf16_t* vp = Vt + (c * 8) * 392 + row;
        vp[0 * 392] = (bf16_t)(vw.x & 0xffffu); vp[1 * 392] = (bf16_t)(vw.x >> 16); vp[2 * 392] = (bf16_t)(vw.y & 0xffffu); vp[3 * 392] = (bf16_t)(vw.y >> 16);
        vp[4 * 392] = (bf16_t)(vw.z & 0xffffu); vp[5 * 392] = (bf16_t)(vw.z >> 16); vp[6 * 392] = (bf16_t)(vw.w & 0xffffu); vp[7 * 392] = (bf16_t)(vw.w >> 16); } }
    __syncthreads();
    bf16x8 qf[4];
    { float qv[4][8]; float ss = 0.f;
#pragma unroll
      for (int ks = 0; ks < 4; ++ks) { const u32x4 w = qraw[ks];
        qv[ks][0] = bflo(w.x); qv[ks][1] = bfhi(w.x); qv[ks][2] = bflo(w.y); qv[ks][3] = bfhi(w.y); qv[ks][4] = bflo(w.z); qv[ks][5] = bfhi(w.z); qv[ks][6] = bflo(w.w); qv[ks][7] = bfhi(w.w);
#pragma unroll
        for (int e = 0; e < 8; ++e) ss += qv[ks][e] * qv[ks][e]; }
      ss += __shfl_xor(ss, 32);
      const float rs = rsqrtf(ss * (1.0f / 64.0f) + EPS) * 0.125f;
#pragma unroll
      for (int ks = 0; ks < 4; ++ks) { const float* qg = p.in[I_QG] + l * 64 + ks * 16 + 8 * h; const f32x4 g0 = *(const f32x4*)qg, g1 = *(const f32x4*)(qg + 4);
        u32x4 w; w.x = pk2(qv[ks][0] * rs * g0[0], qv[ks][1] * rs * g0[1]); w.y = pk2(qv[ks][2] * rs * g0[2], qv[ks][3] * rs * g0[3]);
        w.z = pk2(qv[ks][4] * rs * g1[0], qv[ks][5] * rs * g1[1]); w.w = pk2(qv[ks][6] * rs * g1[2], qv[ks][7] * rs * g1[3]);
        qf[ks] = __builtin_bit_cast(bf16x8, w); } }
    f32x16 acc[5];
#pragma unroll
    for (int c = 0; c < 5; ++c) { acc[c] = zero16(); const LAS bf16_t* kb = Ks + (32 * wave + 32 * c + c0) * 72 + 8 * h;
#pragma unroll
        for (int ks = 0; ks < 4; ++ks) acc[c] = __builtin_amdgcn_mfma_f32_32x32x16_bf16(*(const LAS bf16x8*)(kb + ks * 16), qf[ks], acc[c], 0, 0, 0); }
    float mx = -1e30f;
    { const int tq = c0 - 4 * h, kmin = 128 - n * 256; const LAS float* pb = BT + tq - 32;
#pragma unroll
      for (int c = 0; c < 5; ++c) { const int th = kmin - (32 * wave + 32 * c) - 4 * h;
#pragma unroll
        for (int i = 0; i < 16; ++i) { const int ci = (i & 3) + 8 * (i >> 2);
            bool valid = ci >= th;
            if (c == 0) valid = valid && (tq <= ci);
            if (c == 4) valid = valid && (tq >= ci);
            const float lgt = valid ? acc[c][i] + pb[160 - 32 * c - ci] : -1e30f; acc[c][i] = lgt; mx = fmaxf(mx, lgt); } } }
    mx = fmaxf(mx, __shfl_xor(mx, 32));
    float mnew = mx;
    if (pt > 0) mnew = fmaxf(mx, mprev);
    float lsum = 0.f;
#pragma unroll
    for (int c = 0; c < 5; ++c)
#pragma unroll
        for (int i = 0; i < 16; ++i) { const float pv = __expf(acc[c][i] - mnew); acc[c][i] = pv; lsum += pv; }
    lsum += __shfl_xor(lsum, 32);
    f32x16 o[2]; o[0] = zero16(); o[1] = zero16();
#pragma unroll
    for (int c = 0; c < 5; ++c)
#pragma unroll
        for (int s = 0; s < 2; ++s) { u32x4 pw; pw.x = pk2(acc[c][8 * s + 0], acc[c][8 * s + 1]); pw.y = pk2(acc[c][8 * s + 2], acc[c][8 * s + 3]); pw.z = pk2(acc[c][8 * s + 4], acc[c][8 * s + 5]); pw.w = pk2(acc[c][8 * s + 6], acc[c][8 * s + 7]);
            const bf16x8 pf = __builtin_bit_cast(bf16x8, pw);
#pragma unroll
            for (int vt = 0; vt < 2; ++vt) { const LAS bf16_t* va = Vt + (32 * vt + c0) * 392 + 32 * wave + 32 * c + 16 * s + 4 * h;
                const s16x4 lo = *(const LAS s16x4*)va, hi = *(const LAS s16x4*)(va + 8);
                const bf16x8 vf = __builtin_shufflevector(lo, hi, 0, 1, 2, 3, 4, 5, 6, 7);
                o[vt] = __builtin_amdgcn_mfma_f32_32x32x16_bf16(vf, pf, o[vt], 0, 0, 0); } }
    float sp = 0.f; if (pt > 0) sp = __expf(mprev - mnew);
    const float ltot = lsum + sp, inv = __builtin_amdgcn_rcpf(ltot);
#pragma unroll
    for (int vt = 0; vt < 2; ++vt)
#pragma unroll
        for (int g4 = 0; g4 < 4; ++g4) { const int ch = hd * 64 + 32 * vt + 8 * g4 + 4 * h; bf16_t* yo = ON + tokq * onp + ch;
            float v0 = o[vt][4 * g4 + 0], v1 = o[vt][4 * g4 + 1], v2 = o[vt][4 * g4 + 2], v3 = o[vt][4 * g4 + 3];
            if (pt > 0) { const u32x2 w = oprev[vt][g4]; v0 += sp * bflo(w.x); v1 += sp * bfhi(w.x); v2 += sp * bflo(w.y); v3 += sp * bfhi(w.y); }
            u32x2 w; w.x = pk2(v0 * inv, v1 * inv); w.y = pk2(v2 * inv, v3 * inv); *(u32x2*)yo = w; }
    if (h == 0 && pt < 2) __hip_atomic_store(LN + tokq * 4 + hd, mnew + __logf(ltot), __ATOMIC_RELAXED, __HIP_MEMORY_SCOPE_AGENT);
}

#define RLX_AGENT __ATOMIC_RELAXED, __HIP_MEMORY_SCOPE_AGENT
#define XB_TMO      128
#define XB_XCNT(j)  (256  + 64 * (j))
#define XB_XSUB(j)  (1280 + 64 * (j))
#define XB_XGEN(j)  (2304 + 64 * (j))
#define XB_TOP      3328
#define XB_TOPGEN   3392
#define XCD_BAR_WORDS 3456
#define XB_SPIN_CAP (1u << 18)

__device__ __forceinline__ unsigned xb_ld(unsigned* p)              { return __hip_atomic_load(p, __ATOMIC_RELAXED, __HIP_MEMORY_SCOPE_AGENT); }
__device__ __forceinline__ unsigned xb_add(unsigned* p, unsigned v) { return __hip_atomic_fetch_add(p, v, __ATOMIC_RELAXED, __HIP_MEMORY_SCOPE_AGENT); }
__device__ __forceinline__ unsigned xb_xcc_id() { return (unsigned)__builtin_amdgcn_s_getreg((3 << 11) | 20) & 0xFu; }
#define XB_SPIN(cond, bar) do { unsigned _sp = 0; while (cond) { __builtin_amdgcn_s_sleep(1); \
    if ((++_sp & 255u) == 0u) { if (xb_ld(&(bar)[XB_TMO])) break; if (_sp > XB_SPIN_CAP) { atomicAdd(&(bar)[XB_TMO], 1u); break; } } } } while (0)

struct XcdBarrier {
    unsigned* bar; unsigned x;
    volatile LAS unsigned* st;
};

__device__ __forceinline__ XcdBarrier xcd_barrier_post(unsigned* bar, volatile LAS unsigned* st) {
    XcdBarrier b; b.bar = bar; b.x = xb_xcc_id(); b.st = st;
    if (threadIdx.x == 0) (void)xb_add(&bar[XB_XCNT(b.x)], 1u);
    return b;
}
__device__ __forceinline__ void xcd_barrier_complete(unsigned* bar, unsigned x, unsigned& nloc, unsigned& nx) {
    const unsigned G = gridDim.x * gridDim.y * gridDim.z;
    unsigned sum, cnt, mine, sp = 0u;
    for (;;) {
        sum = 0u; cnt = 0u; mine = 0u;
#pragma unroll
        for (unsigned j = 0; j < 16; ++j) { const unsigned c = xb_ld(&bar[XB_XCNT(j)]); sum += c; cnt += (c > 0u) ? 1u : 0u; mine = (j == x) ? c : mine; }
        if (sum == G) break;
        __builtin_amdgcn_s_sleep(1);
        if ((++sp & 255u) == 0u) { if (xb_ld(&bar[XB_TMO])) break; if (sp > XB_SPIN_CAP) { atomicAdd(&bar[XB_TMO], 1u); break; } }
    }
    nloc = mine > 0u ? mine : 1u; nx = cnt > 0u ? cnt : 1u;
}

__device__ __forceinline__ void xcd_barrier(const XcdBarrier& b) {
    asm volatile("s_waitcnt vmcnt(0)" ::: "memory");
    __syncthreads();
    if (threadIdx.x == 0) {
        unsigned* bar = b.bar;
        __builtin_amdgcn_s_waitcnt(0);
        unsigned nloc = b.st[0], nx = b.st[1];
        if (nloc == 0u) { xcd_barrier_complete(bar, b.x, nloc, nx); b.st[0] = nloc; b.st[1] = nx; }
        const unsigned old = xb_add(&bar[XB_XSUB(b.x)], 1u);
        const unsigned gen = old / nloc;
        if (old + 1u == (gen + 1u) * nloc) {
            __builtin_amdgcn_fence(__ATOMIC_RELEASE, "agent");
            asm volatile("s_waitcnt vmcnt(0)" ::: "memory");
            const unsigned og = xb_add(&bar[XB_TOP], 1u);
            const unsigned tg = og / nx;
            if (og + 1u == (tg + 1u) * nx) xb_add(&bar[XB_TOPGEN], 1u);
            else XB_SPIN(xb_ld(&bar[XB_TOPGEN]) == tg, bar);
            __builtin_amdgcn_fence(__ATOMIC_ACQUIRE, "agent");
            xb_add(&bar[XB_XGEN(b.x)], 1u);
            asm volatile("s_waitcnt vmcnt(0)" ::: "memory");
        } else {
            XB_SPIN(xb_ld(&bar[XB_XGEN(b.x)]) == gen, bar);
            __builtin_amdgcn_fence(__ATOMIC_ACQUIRE, "agent");
            asm volatile("s_waitcnt vmcnt(0)" ::: "memory");
        }
    }
    __syncthreads();
}

#ifndef REP_A
#define REP_A 0
#endif
#ifndef REP_B
#define REP_B 0
#endif
#ifndef REP_C
#define REP_C 0
#endif
#ifndef REP_D
#define REP_D 0
#endif
#ifndef MIX_A
#define MIX_A 1
#endif
#ifndef MIX_B
#define MIX_B 1
#endif
#ifndef MIX_C
#define MIX_C 1
#endif
#ifndef MIX_D
#define MIX_D 1
#endif
#define XSWZ(id) ((((id) & 7) << 6) | ((id) >> 3))
__global__ void __launch_bounds__(512, 2) hybrid_fwd(Params p) {
    extern __shared__ __attribute__((aligned(16))) unsigned char lds_raw[];
    LAS unsigned char* lds = (LAS unsigned char*)lds_raw;
    cg::grid_group grid = cg::this_grid();
    { volatile LAS unsigned* st0 = (volatile LAS unsigned*)(lds + LDS_BYTES - 64); if (threadIdx.x < 2) st0[threadIdx.x] = 0u; }
    __syncthreads();
    (void)xcd_barrier_post((unsigned*)(p.ws + WS_BAR), (volatile LAS unsigned*)(lds + LDS_BYTES - 64));
    const int G = gridDim.x, bid = blockIdx.x;
    unsigned char* ws = p.ws;
    bf16_t* XB = (bf16_t*)(ws + WS_XB); bf16_t* Zb = (bf16_t*)(ws + WS_Z); bf16_t* YC_ = (bf16_t*)(ws + WS_YCAT); bf16_t* HM = (bf16_t*)(ws + WS_HM);
    float* SSQP = (float*)(ws + WS_SSQP);

#define GRID_SYNC_() do { asm volatile("s_waitcnt vmcnt(0) lgkmcnt(0)" ::: "memory"); grid.sync(); if (threadIdx.x < 64) { __builtin_amdgcn_fence(__ATOMIC_ACQUIRE, "agent"); asm volatile("s_waitcnt vmcnt(0)" ::: "memory"); } __syncthreads(); } while (0)
#define XBAR_ONCE() do { XcdBarrier b_; b_.bar = (unsigned*)(p.ws + WS_BAR); b_.x = xb_xcc_id(); b_.st = (volatile LAS unsigned*)(lds + LDS_BYTES - 64); xcd_barrier(b_); } while (0)
#ifdef REP_SYNC
#define GRID_SYNC() do { XBAR_ONCE(); XBAR_ONCE(); } while (0)
#else
#define GRID_SYNC() XBAR_ONCE()
#endif
    prologue(p, lds, G);
#ifdef REP_PRO
    GRID_SYNC_(); prologue(p, lds, G);
#endif
#ifdef NANFILL
    { u32x4* q = (u32x4*)(ws + WS_S5H); const size_t n16 = (WS_END - WS_S5H) / 16; const u32x4 nanv = (u32x4){0xffffffffu, 0xffffffffu, 0xffffffffu, 0xffffffffu};
      for (size_t i = (size_t)bid * 512 + threadIdx.x; i < n16; i += (size_t)G * 512) q[i] = nanv;
      u32x4* q2 = (u32x4*)(ws + WS_LSE); const size_t m16 = (WS_S5K - WS_LSE) / 16;
      for (size_t i = (size_t)bid * 512 + threadIdx.x; i < m16; i += (size_t)G * 512) q2[i] = nanv; }
#endif
    if (gridDim.y == 0x7fffffffu) GRID_SYNC_();
    GRID_SYNC();

#ifndef NL_RUN
#define NL_RUN NL
#endif
#ifndef DUMP_LAYER
#define DUMP_LAYER 0
#endif
    for (int lrun = 0; lrun < NL_RUN; ++lrun) {
#ifdef SAME_LAYER
        const int l = 0; const bool firstl = (lrun == 0), lastl = (lrun == NL_RUN - 1);
#else
        const int l = lrun; const bool firstl = (lrun == 0), lastl = (lrun == NL_RUN - 1);
#endif
#define RS_TABLE(SSQ_, NUNITS_) \
          { pg8::Unit ua_, ub_; (void)S.next(0, ua_); (void)S.next((NUNITS_) - 1, ub_); \
              int tq_ = threadIdx.x; asm volatile("" : "+v"(tq_)); const int pm_ = (tq_ >> 8) ? ub_.pm : ua_.pm; \
              const f32x4* sq_ = (const f32x4*)((SSQ_) + ((size_t)pm_ * 256 + (tq_ & 255)) * 16); const f32x4 q0 = sq_[0], q1 = sq_[1], q2 = sq_[2], q3 = sq_[3]; \
              const float tot_ = (((q0[0] + q0[1]) + (q0[2] + q0[3])) + ((q1[0] + q1[1]) + (q1[2] + q1[3]))) + (((q2[0] + q2[1]) + (q2[2] + q2[3])) + ((q3[0] + q3[1]) + (q3[2] + q3[3]))); \
              ((LAS float*)(lds + 131072))[tq_] = rsqrtf(tot_ * (1.0f / 1024.0f) + EPS); __syncthreads(); }
        { pg8::Gemm g{XB, (const bf16_t*)(ws + WS_WIN) + (size_t)l * D * DIN, T, DIN, D, D}; pg8::StaticOrder S; S.init(T, DIN, G, bid);
          RS_TABLE(SSQP, (T / 256) * (DIN / 256) / 256)
          pg8::EpiScale E{Zb, DIN, 0, (const PG8_LAS float*)(lds + 131072)};
          pg8::gemm_phase<pg8::EpiScale, pg8::StaticOrder, true, true>(lds, g, S, E);
#ifdef REPEAT_GEMM
          GRID_SYNC(); pg8::gemm_phase<pg8::EpiScale, pg8::StaticOrder, true, true>(lds, g, S, E);
#endif
        }
        GRID_SYNC();
#ifndef SKIP_MIX
        if (!(MIX_A && MIX_B && MIX_C && MIX_D)) { int tq = threadIdx.x; asm volatile("" : "+v"(tq));
          for (int m = bid * 8 + (tq >> 6); m < T; m += G * 8) { u32x2* yp = (u32x2*)(YC_ + (size_t)m * D) + (tq & 63); const u32x2 z2 = (u32x2){0u, 0u};
              if (!MIX_A) yp[0] = z2; if (!MIX_B) yp[64] = z2; if (!MIX_C) yp[128] = z2; if (!MIX_D) yp[192] = z2; } }
#ifndef MIX_REPEAT
#define MIX_REPEAT 1
#endif
        for (int rep = 0; rep < MIX_REPEAT; ++rep) {
        for (int it = bid; it < 1664; it += G) {
            if (it < 512) { if (MIX_A) { hgrn_item<false>(p, lds, l, it); if (REP_A) hgrn_item<false>(p, lds, l, it); } }
            else if (it < 1024) { if (MIX_B) { conv_item(p, lds, l, it - 512); if (REP_B) conv_item(p, lds, l, it - 512); } }
            else if (it < 1152) { if (MIX_C) { s5_local_item(p, lds, l, it - 1024); if (REP_C) s5_local_item(p, lds, l, it - 1024); } }
            else { if (MIX_D) { attn_item(p, lds, l, 0, XSWZ(it - 1152)); if (REP_D) attn_item(p, lds, l, 0, XSWZ(it - 1152)); } }
        }
        GRID_SYNC();
        if (bid < 128) { if (MIX_A) hgrn_scan_item(p, bid); } else if (bid < 136) { if (MIX_C) s5_scan_item(p, l, bid - 128); }
        if (bid < 136) { if (MIX_D) { attn_item(p, lds, l, 1, 360 + bid); if (REP_D) attn_item(p, lds, l, 1, 360 + bid); if (bid < 16) attn_item(p, lds, l, 1, 496 + bid); } }
        else for (int it = bid - 136; it < 360; it += 120) { if (MIX_D) { attn_item(p, lds, l, 1, it); if (REP_D) attn_item(p, lds, l, 1, it); } }
        GRID_SYNC();
#ifdef REP_P3
        if (bid < 128) { if (MIX_A) hgrn_scan_item(p, bid); } else if (bid < 136) { if (MIX_C) s5_scan_item(p, l, bid - 128); }
        if (bid < 136) { if (MIX_D) { attn_item(p, lds, l, 1, 360 + bid); if (REP_D) attn_item(p, lds, l, 1, 360 + bid); if (bid < 16) attn_item(p, lds, l, 1, 496 + bid); } }
        else for (int it = bid - 136; it < 360; it += 120) { if (MIX_D) { attn_item(p, lds, l, 1, it); if (REP_D) attn_item(p, lds, l, 1, it); } }
        GRID_SYNC();
#endif
        for (int it = bid; it < 1536; it += G) {
            if (it < 512) { if (MIX_A) { hgrn_item<true>(p, lds, l, it); if (REP_A) hgrn_item<true>(p, lds, l, it); } }
            else if (it < 1024) { if (MIX_C) { s5_out_item(p, lds, l, it - 512); if (REP_C) s5_out_item(p, lds, l, it - 512); } }
            else { if (MIX_D) { attn_item(p, lds, l, 2, XSWZ(it - 1024)); if (REP_D) attn_item(p, lds, l, 2, XSWZ(it - 1024)); } }
        }
        GRID_SYNC();
        }
#ifndef NO_GLU
        { pg8::Gemm g{(const bf16_t*)(ws + WS_YPRE), (const bf16_t*)(ws + WS_WGLU) + (size_t)l * 65536, T, 256, 256, 256}; pg8::StaticOrder S; S.init(T, 256, G, bid);
          pg8::EpiGlu E{(const bf16_t*)(ws + WS_YPRE), 256, YC_ + YC};
          pg8::gemm_phase<pg8::EpiGlu, pg8::StaticOrder, false, true>(lds, g, S, E); }
#endif
        { int tq = threadIdx.x; asm volatile("" : "+v"(tq)); const int lane = tq & 63; const int gw = (bid - 128) * 8 + (tq >> 6), NGW = 128 * 8;
          if (bid >= 128) for (int m = gw; m < T; m += NGW) { u32x2* yp = (u32x2*)(YC_ + (size_t)m * D + YD) + lane; const u32x2 w = *((const u32x2*)(Zb + (size_t)m * DIN + ZOD) + lane);
              const float a0 = bflo(w.x), a1 = bfhi(w.x), a2 = bflo(w.y), a3 = bfhi(w.y);
              const float ss = wave_sum((a0 * a0 + a1 * a1) + (a2 * a2 + a3 * a3)); const float rs = rsqrtf(ss * (1.0f / 256.0f) + EPS);
              u32x2 o; o.x = pk2(a0 * rs, a1 * rs); o.y = pk2(a2 * rs, a3 * rs); *yp = o; } }
        GRID_SYNC();
#endif
#ifdef REP_P5
#ifndef NO_GLU
        { pg8::Gemm g{(const bf16_t*)(ws + WS_YPRE), (const bf16_t*)(ws + WS_WGLU) + (size_t)l * 65536, T, 256, 256, 256}; pg8::StaticOrder S; S.init(T, 256, G, bid);
          pg8::EpiGlu E{(const bf16_t*)(ws + WS_YPRE), 256, YC_ + YC};
          pg8::gemm_phase<pg8::EpiGlu, pg8::StaticOrder, false, true>(lds, g, S, E); }
#endif
        { int tq = threadIdx.x; asm volatile("" : "+v"(tq)); const int lane = tq & 63; const int gw = (bid - 128) * 8 + (tq >> 6), NGW = 128 * 8;
          if (bid >= 128) for (int m = gw; m < T; m += NGW) { u32x2* yp = (u32x2*)(YC_ + (size_t)m * D + YD) + lane; const u32x2 w = *((const u32x2*)(Zb + (size_t)m * DIN + ZOD) + lane);
              const float a0 = bflo(w.x), a1 = bfhi(w.x), a2 = bflo(w.y), a3 = bfhi(w.y);
              const float ss = wave_sum((a0 * a0 + a1 * a1) + (a2 * a2 + a3 * a3)); const float rs = rsqrtf(ss * (1.0f / 256.0f) + EPS);
              u32x2 o; o.x = pk2(a0 * rs, a1 * rs); o.y = pk2(a2 * rs, a3 * rs); *yp = o; } }
        GRID_SYNC();
#endif
#ifdef DUMP_SLICE
        if (lrun == DUMP_LAYER) { int tq = threadIdx.x; asm volatile("" : "+v"(tq));
          for (int m = bid * 8 + (tq >> 6); m < T; m += G * 8) { const int ln = tq & 63;
              for (int j = 0; j < 4; ++j) { const int col = j * 256 + ln * 4; const u32x2 w = *(const u32x2*)(YC_ + (size_t)m * D + col);
                  f32x4 o = (f32x4){0.f, 0.f, 0.f, 0.f}; if (j == DUMP_SLICE) o = (f32x4){bflo(w.x), bfhi(w.x), bflo(w.y), bfhi(w.y)};
                  *(f32x4*)(p.out + (size_t)m * D + col) = o; } }
          break; }
#endif
#ifdef SKIP_MIX
        { pg8::Gemm g{Zb, (const bf16_t*)(ws + WS_WOUT) + (size_t)l * D * D, T, D, D, DIN}; pg8::StaticOrder S; S.init(T, D, G, bid);
#else
        { pg8::Gemm g{YC_, (const bf16_t*)(ws + WS_WOUT) + (size_t)l * D * D, T, D, D, D}; pg8::StaticOrder S; S.init(T, D, G, bid);
#endif
          pg8::EpiRes E{firstl ? p.in[I_X] : p.out, p.out, XB, SSQP + (size_t)T * 16};
          pg8::gemm_phase<pg8::EpiRes, pg8::StaticOrder, true, true>(lds, g, S, E); }
        GRID_SYNC();
        { pg8::Gemm g{XB, (const bf16_t*)(ws + WS_WUP) + (size_t)l * D * FF, T, FF, D, D}; pg8::StaticOrder S; S.init(T, FF, G, bid);
          RS_TABLE(SSQP + (size_t)T * 16, (T / 256) * (FF / 256) / 256)
          pg8::EpiScale E{HM, FF, 1, (const PG8_LAS float*)(lds + 131072)};
          pg8::gemm_phase<pg8::EpiScale, pg8::StaticOrder, true, true>(lds, g, S, E);
#ifdef REPEAT_GEMM
          GRID_SYNC(); pg8::gemm_phase<pg8::EpiScale, pg8::StaticOrder, true, true>(lds, g, S, E);
#endif
        }
        GRID_SYNC();
        { pg8::Gemm g{HM, (const bf16_t*)(ws + WS_WDN) + (size_t)l * D * FF, T, D, FF, FF}; pg8::StaticOrder S; S.init(T, D, G, bid);
          pg8::EpiRes E{p.out, p.out, XB, !lastl ? SSQP : nullptr};
          pg8::gemm_phase<pg8::EpiRes, pg8::StaticOrder, true, true>(lds, g, S, E); }
        if (!lastl) GRID_SYNC();
    }
}

extern "C" void kernel_launch(void* const* d_in, const int* in_sizes, int n_in, void* d_out, int out_size, void* d_ws, size_t ws_size, hipStream_t stream) {
    static int grid = 0;
    if (grid == 0) {
        if (n_in != 26 || out_size != T * D || ws_size < WS_END) { fprintf(stderr, "kernel_launch: unexpected shapes (n_in %d, out %d, ws %zu); nothing launched\n", n_in, out_size, ws_size); grid = -1; return; }
        int dev = 0, cus = 0, per_cu = 0;
        (void)hipGetDevice(&dev); (void)hipDeviceGetAttribute(&cus, hipDeviceAttributeMultiprocessorCount, dev);
        if (hipFuncSetAttribute((const void*)hybrid_fwd, hipFuncAttributeMaxDynamicSharedMemorySize, LDS_BYTES) != hipSuccess) { fprintf(stderr, "kernel_launch: hipFuncSetAttribute failed\n"); grid = -1; return; }
        if (hipOccupancyMaxActiveBlocksPerMultiprocessor(&per_cu, (const void*)hybrid_fwd, 512, LDS_BYTES) != hipSuccess || per_cu < 1) { fprintf(stderr, "kernel_launch: occupancy query gave %d\n", per_cu); per_cu = 1; }
        (void)hipGetLastError();
        if (cus <= 0) cus = 256;
        grid = cus * per_cu;
    }
    if (grid < 0) return;
    if (hipMemsetAsync((char*)d_ws + WS_BAR, 0, XCD_BAR_WORDS * 4, stream) != hipSuccess) { fprintf(stderr, "kernel_launch: hipMemsetAsync of the barrier words failed\n"); return; }
    static int rs_ok = -1;
    if (rs_ok < 0) { rs_ok = (grid == 256) ? 1 : 0;
        const int ncol[2] = {DIN / 256, FF / 256};
        for (int ph = 0; ph < 2 && rs_ok; ++ph) { const int nun = (T / 256) * ncol[ph] / 256;
            for (int c = 0; c < grid && rs_ok; ++c) { pg8::StaticOrder S; S.init(T, ncol[ph] * 256, grid, c); pg8::Unit u0, u1, ui; if (!S.next(0, u0) || !S.next(nun - 1, u1) || S.next(nun, ui)) { rs_ok = 0; break; }
                if (((u0.pm >> 3) & 1) != 0 || ((u1.pm >> 3) & 1) != 1) { rs_ok = 0; break; }
                for (int i = 0; i < nun; ++i) { S.next(i, ui); if (ui.pm != (((ui.pm >> 3) & 1) ? u1.pm : u0.pm)) { rs_ok = 0; break; } } } } }
    Params a{};
    for (int i = 0; i < 26; ++i) a.in[i] = (const float*)d_in[i];
    if (!rs_ok) { fprintf(stderr, "kernel_launch: unit order does not keep a workgroup inside two row panels (grid %d); nothing launched\n", grid); return; }
    a.out = (float*)d_out; a.ws = (unsigned char*)d_ws; a.rs_lds = rs_ok; a.pad = 0;
    void* args[] = {&a};
    hipError_t e = hipLaunchCooperativeKernel((const void*)hybrid_fwd, dim3(grid), dim3(512), args, LDS_BYTES, stream);
    if (e != hipSuccess) fprintf(stderr, "cooperative launch failed: %s (grid %d)\n", hipGetErrorString(e), grid);
}
```
